# Optimizing an MI355X kernel written in HIP

```python
import math
import jax, jax.numpy as jnp
from jax import lax
import numpy as np

D_MODEL = 1024
BATCH = 8
SEQ = 4096
DEPTH = 1

HEAD_DIM = 64
NSA_HEADS = 8
NSA_GROUPS = 2
NSA_HPG = NSA_HEADS // NSA_GROUPS
CMP_BLOCK = 32
CMP_STRIDE = 16
CMP_HIDDEN = 256
SLC_BLOCK = 64
SLC_TOPN = 16
SLC_FORCE = 1e4
WINDOW = 512
DSA_HEADS = 8
KV_RANK = 128
IDX_HEADS = 4
IDX_DIM = 64
IDX_TOPK_MAX = 256
REL_BUCKETS = 32
REL_EXACT = 16
REL_MAX_DIST = 1024
N_REL_HEADS = NSA_HEADS + DSA_HEADS
N_EXPERT_GROUPS = 4
EXPERTS_PER_GROUP = 8
N_EXPERTS = N_EXPERT_GROUPS * EXPERTS_PER_GROUP
EXPERT_TOPK = 2
D_EXPERT = 256
EXPERT_BLOCK = 256
QBLK = 128
NSA_WIDTH = NSA_HEADS * HEAD_DIM
DSA_WIDTH = DSA_HEADS * HEAD_DIM
ALPHA = (2.0 * DEPTH) ** 0.25
BETA = (8.0 * DEPTH) ** -0.25
NEG = -1e30
SPLIT_SIZES = (NSA_WIDTH,) + (NSA_GROUPS * HEAD_DIM,) * 6 + (NSA_HEADS * 3, DSA_WIDTH, KV_RANK, IDX_HEADS * IDX_DIM, IDX_DIM, IDX_HEADS, D_MODEL, D_MODEL)
D_IN = int(sum(SPLIT_SIZES))
SPLIT_POINTS = tuple(int(v) for v in np.cumsum(SPLIT_SIZES)[:-1])

kernel_name = 'hybrid_nsa_dsa_hmoe_deepnorm'


def layer_norm(x, g, b, eps=1e-5):
    xf = x.astype(jnp.float32)
    xc = xf - jnp.mean(xf, axis=-1, keepdims=True)
    var = jnp.mean(xc * xc, axis=-1, keepdims=True)
    return (xc * lax.rsqrt(var + eps) * g + b).astype(x.dtype)


def rms_norm(x, g, eps=1e-6):
    xf = x.astype(jnp.float32)
    return (xf * lax.rsqrt(jnp.mean(xf * xf, axis=-1, keepdims=True) + eps) * g).astype(x.dtype)


def masked_softmax(logits, mask):
    l = jnp.where(mask, logits.astype(jnp.float32), NEG)
    m = jnp.max(l, axis=-1, keepdims=True)
    e = jnp.where(mask, jnp.exp(l - m), 0.0)
    p = e / jnp.maximum(jnp.sum(e, axis=-1, keepdims=True), 1e-30)
    return p.astype(logits.dtype)


def rel_bucket(dist):
    n = jnp.maximum(dist, 0)
    nf = jnp.maximum(n, 1).astype(jnp.float32)
    large = REL_EXACT + (jnp.log(nf / REL_EXACT) / math.log(REL_MAX_DIST / REL_EXACT) * (REL_BUCKETS - REL_EXACT)).astype(jnp.int32)
    return jnp.where(n < REL_EXACT, n, jnp.minimum(large, REL_BUCKETS - 1))


def compress_blocks(tok, pe, w1, w2):
    b, t, g, d = tok.shape
    nc = (t - CMP_BLOCK) // CMP_STRIDE + 1
    idx = CMP_STRIDE * np.arange(nc)[:, None] + np.arange(CMP_BLOCK)[None, :]
    blk = tok[:, idx] + pe[None, None, :, None, :]
    blk = jnp.moveaxis(blk, 3, 2).reshape(b, nc, g, CMP_BLOCK * d)
    return jax.nn.gelu(blk @ w1) @ w2


def cmp_to_slc_map(t):
    nc = (t - CMP_BLOCK) // CMP_STRIDE + 1
    ns = t // SLC_BLOCK
    cs = CMP_STRIDE * np.arange(nc)[:, None]
    ss = SLC_BLOCK * np.arange(ns)[None, :]
    ov = np.minimum(cs + CMP_BLOCK, ss + SLC_BLOCK) - np.maximum(cs, ss)
    return np.clip(ov, 0, None).astype(np.float32) / CMP_STRIDE


def nsa_block(q, k_cmp, v_cmp, k_slc, v_slc, k_win, v_win, gates, rel_a, cmp_map, tq, q0):
    scale = HEAD_DIM ** -0.5
    nc = k_cmp.shape[0]
    t = k_slc.shape[0]
    ns = t // SLC_BLOCK
    n_top = min(SLC_TOPN, ns)
    g_ar = jnp.arange(NSA_GROUPS)[:, None, None]
    cmp_end = CMP_STRIDE * jnp.arange(nc) + CMP_BLOCK - 1
    dist = tq[:, None] - cmp_end[None, :]
    logits = jnp.einsum('tghd,cgd->ghtc', q, k_cmp) * scale + rel_a[rel_bucket(dist)].transpose(2, 3, 0, 1)
    p_cmp = masked_softmax(logits, dist >= 0)
    o_cmp = jnp.einsum('ghtc,cgd->tghd', p_cmp, v_cmp)
    imp = jnp.einsum('ghtc,cn->gtn', p_cmp, cmp_map)
    blk = jnp.arange(ns)[None, :]
    cur = (tq // SLC_BLOCK)[:, None]
    forced = (blk == 0) | (blk == cur) | (blk == cur - 1)
    avail = blk * SLC_BLOCK <= tq[:, None]
    score = jnp.where(avail, imp.astype(jnp.float32) + SLC_FORCE * forced, NEG)
    sel_score, sel_idx = lax.top_k(score, n_top)
    sel_ok = sel_score > 0.5 * NEG
    k_sb = k_slc.reshape(ns, SLC_BLOCK, NSA_GROUPS, HEAD_DIM).transpose(2, 0, 1, 3)
    v_sb = v_slc.reshape(ns, SLC_BLOCK, NSA_GROUPS, HEAD_DIM).transpose(2, 0, 1, 3)
    k_g = k_sb[g_ar, sel_idx].reshape(NSA_GROUPS, QBLK, n_top * SLC_BLOCK, HEAD_DIM)
    v_g = v_sb[g_ar, sel_idx].reshape(NSA_GROUPS, QBLK, n_top * SLC_BLOCK, HEAD_DIM)
    kpos = (sel_idx[..., None] * SLC_BLOCK + jnp.arange(SLC_BLOCK)).reshape(NSA_GROUPS, QBLK, n_top * SLC_BLOCK)
    dist = tq[None, :, None] - kpos
    mask = jnp.repeat(sel_ok, SLC_BLOCK, axis=-1) & (dist >= 0)
    bias = jnp.moveaxis(rel_a[rel_bucket(dist), g_ar], -1, 1)
    logits = jnp.einsum('tghd,gtkd->ghtk', q, k_g) * scale + bias
    p = masked_softmax(logits, mask[:, None])
    o_slc = jnp.einsum('ghtk,gtkd->tghd', p, v_g)
    kw = lax.dynamic_slice_in_dim(k_win, q0, WINDOW + QBLK, axis=0)
    vw = lax.dynamic_slice_in_dim(v_win, q0, WINDOW + QBLK, axis=0)
    kpos = q0 - WINDOW + jnp.arange(WINDOW + QBLK)
    dist = tq[:, None] - kpos[None, :]
    mask = (kpos[None, :] >= 0) & (dist >= 0) & (dist < WINDOW)
    logits = jnp.einsum('tghd,kgd->ghtk', q, kw) * scale + rel_a[rel_bucket(dist)].transpose(2, 3, 0, 1)
    p = masked_softmax(logits, mask)
    o_win = jnp.einsum('ghtk,kgd->tghd', p, vw)
    o = gates[..., 0:1] * o_cmp + gates[..., 1:2] * o_slc + gates[..., 2:3] * o_win
    return o.reshape(QBLK, NSA_WIDTH)


def dsa_block(q_lat, ckv, q_idx, k_idx, w_idx, rel_b, tq):
    t = ckv.shape[0]
    k_sel = min(IDX_TOPK_MAX, t // 4)
    rs = jax.nn.relu(jnp.einsum('tid,sd->tis', q_idx, k_idx) * IDX_DIM ** -0.5)
    index = jnp.einsum('tis,ti->ts', rs, w_idx).astype(jnp.float32)
    index = jnp.where(jnp.arange(t)[None, :] <= tq[:, None], index, NEG)
    _, sel = lax.top_k(index, k_sel)
    ok = sel <= tq[:, None]
    c_g = ckv[sel]
    bias = rel_b[rel_bucket(tq[:, None] - sel)].transpose(2, 0, 1)
    logits = jnp.einsum('thr,tkr->htk', q_lat, c_g) * HEAD_DIM ** -0.5 + bias
    p = masked_softmax(logits, ok[None])
    return jnp.einsum('htk,tkr->thr', p, c_g)


def moe(h, w_grp, b_grp, w_rtr, b_rtr, w_gate, w_up, w_down):
    b, t, d = h.shape
    n = b * t
    hf = h.reshape(n, d)
    g_logits = (hf @ w_grp + b_grp).astype(jnp.float32)
    g_sel = jnp.argmax(g_logits, axis=-1)
    p_grp = jnp.take_along_axis(jax.nn.softmax(g_logits, axis=-1), g_sel[:, None], axis=1)[:, 0]
    e_logits = (hf @ w_rtr + b_rtr).astype(jnp.float32).reshape(n, N_EXPERT_GROUPS, EXPERTS_PER_GROUP)
    e_logits = jnp.take_along_axis(e_logits, g_sel[:, None, None], axis=1)[:, 0]
    top_l, top_i = lax.top_k(e_logits, EXPERT_TOPK)
    p_exp = jax.nn.softmax(top_l, axis=-1)
    w_a = (p_grp[:, None] * p_exp).reshape(-1)
    e_a = (g_sel[:, None] * EXPERTS_PER_GROUP + top_i).reshape(-1).astype(jnp.int32)
    tok_a = jnp.repeat(jnp.arange(n, dtype=jnp.int32), EXPERT_TOPK)
    n_a = n * EXPERT_TOPK
    order = jnp.argsort(e_a)
    e_s, tok_s, w_s = e_a[order], tok_a[order], w_a[order]
    counts = jax.ops.segment_sum(jnp.ones_like(e_a), e_a, num_segments=N_EXPERTS)
    padded = (counts + EXPERT_BLOCK - 1) // EXPERT_BLOCK * EXPERT_BLOCK
    off = jnp.cumsum(counts) - counts
    pend = jnp.cumsum(padded)
    poff = pend - padded
    dest = poff[e_s] + jnp.arange(n_a, dtype=jnp.int32) - off[e_s]
    n_blk = -(-n_a // EXPERT_BLOCK) + N_EXPERTS
    tok_pad = jnp.zeros((n_blk * EXPERT_BLOCK,), jnp.int32).at[dest].set(tok_s)
    w_pad = jnp.zeros((n_blk * EXPERT_BLOCK,), jnp.float32).at[dest].set(w_s)
    blk_exp = jnp.minimum(jnp.searchsorted(pend, jnp.arange(n_blk, dtype=jnp.int32) * EXPERT_BLOCK, side='right'), N_EXPERTS - 1)
    x_pad = hf[tok_pad].reshape(n_blk, EXPERT_BLOCK, d)

    def expert_block(args):
        xb, e = args
        return (jax.nn.silu(xb @ w_gate[e]) * (xb @ w_up[e])) @ w_down[e]

    y = lax.map(expert_block, (x_pad, blk_exp)).reshape(-1, d)
    out = jnp.zeros_like(hf).at[tok_pad].add(y * w_pad[:, None].astype(y.dtype))
    return out.reshape(b, t, d)


def setup_inputs(seed: int = 0) -> dict:
    key = jax.random.key(seed)
    ks = jax.random.split(key, 26)
    L = DEPTH

    def nrm(k, shape, scale):
        return jax.random.normal(k, shape, jnp.float32) * scale

    return {
        'x': nrm(ks[0], (BATCH, SEQ, D_MODEL), 1.0),
        'w_in': nrm(ks[1], (L, D_MODEL, D_IN), D_MODEL ** -0.5),
        'cmp_pe_k': nrm(ks[2], (L, CMP_BLOCK, HEAD_DIM), 0.1),
        'cmp_pe_v': nrm(ks[3], (L, CMP_BLOCK, HEAD_DIM), 0.1),
        'cmp_w1_k': nrm(ks[4], (L, CMP_BLOCK * HEAD_DIM, CMP_HIDDEN), (CMP_BLOCK * HEAD_DIM) ** -0.5),
        'cmp_w2_k': nrm(ks[5], (L, CMP_HIDDEN, HEAD_DIM), CMP_HIDDEN ** -0.5),
        'cmp_w1_v': nrm(ks[6], (L, CMP_BLOCK * HEAD_DIM, CMP_HIDDEN), (CMP_BLOCK * HEAD_DIM) ** -0.5),
        'cmp_w2_v': nrm(ks[7], (L, CMP_HIDDEN, HEAD_DIM), CMP_HIDDEN ** -0.5),
        'ckv_norm_g': 1.0 + nrm(ks[8], (L, KV_RANK), 0.02),
        'w_uk': nrm(ks[9], (L, DSA_HEADS, HEAD_DIM, KV_RANK), KV_RANK ** -0.5),
        'w_uv': nrm(ks[10], (L, DSA_HEADS, KV_RANK, HEAD_DIM), KV_RANK ** -0.5),
        'rel_bias': nrm(ks[11], (REL_BUCKETS, N_REL_HEADS), 0.1),
        'w_branch_a': nrm(ks[12], (L, NSA_WIDTH, D_MODEL), NSA_WIDTH ** -0.5 * BETA),
        'w_branch_b': nrm(ks[13], (L, DSA_WIDTH, D_MODEL), DSA_WIDTH ** -0.5 * BETA),
        'w_out': nrm(ks[14], (L, D_MODEL, D_MODEL), D_MODEL ** -0.5 * BETA),
        'ln1_g': 1.0 + nrm(ks[15], (L, D_MODEL), 0.02),
        'ln1_b': nrm(ks[16], (L, D_MODEL), 0.02),
        'w_grp': nrm(ks[17], (L, D_MODEL, N_EXPERT_GROUPS), D_MODEL ** -0.5),
        'b_grp': nrm(ks[18], (L, N_EXPERT_GROUPS), 0.01),
        'w_rtr': nrm(ks[19], (L, D_MODEL, N_EXPERTS), D_MODEL ** -0.5),
        'b_rtr': nrm(ks[20], (L, N_EXPERTS), 0.01),
        'w_gate': nrm(ks[21], (L, N_EXPERTS, D_MODEL, D_EXPERT), D_MODEL ** -0.5),
        'w_up': nrm(ks[22], (L, N_EXPERTS, D_MODEL, D_EXPERT), D_MODEL ** -0.5),
        'w_down': nrm(ks[23], (L, N_EXPERTS, D_EXPERT, D_MODEL), D_EXPERT ** -0.5 * BETA),
        'ln2_g': 1.0 + nrm(ks[24], (L, D_MODEL), 0.02),
        'ln2_b': nrm(ks[25], (L, D_MODEL), 0.02),
    }


def reference(x, w_in, cmp_pe_k, cmp_pe_v, cmp_w1_k, cmp_w2_k, cmp_w1_v, cmp_w2_v, ckv_norm_g, w_uk, w_uv, rel_bias, w_branch_a, w_branch_b, w_out, ln1_g, ln1_b, w_grp, b_grp, w_rtr, b_rtr, w_gate, w_up, w_down, ln2_g, ln2_b):
    b, t, _ = x.shape
    n_qblk = t // QBLK
    cmp_map = jnp.asarray(cmp_to_slc_map(t))
    rel_a = rel_bias[:, :NSA_HEADS].reshape(REL_BUCKETS, NSA_GROUPS, NSA_HPG)
    rel_b = rel_bias[:, NSA_HEADS:]
    kv_shape = (b, t, NSA_GROUPS, HEAD_DIM)
    pad = ((0, 0), (WINDOW, 0), (0, 0), (0, 0))
    h = x
    for l in range(DEPTH):
        z = jnp.einsum('btd,de->bte', h, w_in[l])
        (q_a, kc, vc, ks, vs, kw, vw, g_nsa, q_b, ckv, q_idx, k_idx, w_idx, gate_a, gate_b) = jnp.split(z, SPLIT_POINTS, axis=-1)
        q_a = q_a.reshape(b, t, NSA_GROUPS, NSA_HPG, HEAD_DIM)
        k_cmp = compress_blocks(kc.reshape(kv_shape), cmp_pe_k[l], cmp_w1_k[l], cmp_w2_k[l])
        v_cmp = compress_blocks(vc.reshape(kv_shape), cmp_pe_v[l], cmp_w1_v[l], cmp_w2_v[l])
        ks = ks.reshape(kv_shape)
        vs = vs.reshape(kv_shape)
        kw = jnp.pad(kw.reshape(kv_shape), pad)
        vw = jnp.pad(vw.reshape(kv_shape), pad)
        g_nsa = jax.nn.sigmoid(g_nsa.reshape(b, t, NSA_GROUPS, NSA_HPG, 3))
        q_lat = jnp.einsum('bthd,hdr->bthr', q_b.reshape(b, t, DSA_HEADS, HEAD_DIM), w_uk[l])
        ckv = rms_norm(ckv, ckv_norm_g[l])
        q_idx = q_idx.reshape(b, t, IDX_HEADS, IDX_DIM)
        w_idx = w_idx * IDX_HEADS ** -0.5

        def sweep(i):
            bi = i // n_qblk
            q0 = (i % n_qblk) * QBLK
            tq = q0 + jnp.arange(QBLK)

            def sl(a):
                return lax.dynamic_slice_in_dim(a[bi], q0, QBLK, axis=0)

            o_a = nsa_block(sl(q_a), k_cmp[bi], v_cmp[bi], ks[bi], vs[bi], kw[bi], vw[bi], sl(g_nsa), rel_a, cmp_map, tq, q0)
            o_lat = dsa_block(sl(q_lat), ckv[bi], sl(q_idx), k_idx[bi], sl(w_idx), rel_b, tq)
            return o_a, o_lat

        o_a, o_lat = lax.map(sweep, jnp.arange(b * n_qblk))
        o_a = o_a.reshape(b, t, NSA_WIDTH)
        o_b = jnp.einsum('bthr,hrd->bthd', o_lat.reshape(b, t, DSA_HEADS, KV_RANK), w_uv[l]).reshape(b, t, DSA_WIDTH)
        merged = jax.nn.sigmoid(gate_a) * (o_a @ w_branch_a[l]) + jax.nn.sigmoid(gate_b) * (o_b @ w_branch_b[l])
        h = layer_norm(ALPHA * h + merged @ w_out[l], ln1_g[l], ln1_b[l])
        h = layer_norm(ALPHA * h + moe(h, w_grp[l], b_grp[l], w_rtr[l], b_rtr[l], w_gate[l], w_up[l], w_down[l]), ln2_g[l], ln2_b[l])
    return h
```

```cpp
#include <hip/hip_runtime.h>
#include <cstdio>
#include <cstdint>

#ifndef MK_PER_PHASE
#define MK_PER_PHASE 0
#endif

#define GAS __attribute__((address_space(1)))
#define LAS __attribute__((address_space(3)))
typedef unsigned short bf16;
typedef short bf16x8 __attribute__((ext_vector_type(8)));
typedef short s16x4 __attribute__((ext_vector_type(4)));
typedef float f32x4 __attribute__((ext_vector_type(4)));
typedef float f32x16 __attribute__((ext_vector_type(16)));
typedef float f32x2 __attribute__((ext_vector_type(2)));
typedef unsigned u32x4 __attribute__((ext_vector_type(4)));
typedef unsigned u32x2 __attribute__((ext_vector_type(2)));

constexpr int D = 1024, BATCH = 8, SEQ = 4096, NTOK = BATCH * SEQ;
constexpr int D_IN = 4316;
constexpr int NCMP = 255;
constexpr float ALPHA = 1.189207115002721f;
constexpr float LOG2E = 1.4426950408889634f;
constexpr float NEGBIG = -1e30f;
constexpr int ZA_LD = 2816;
constexpr int ZC_QA = 0, ZC_KC = 512, ZC_VC = 640, ZC_KS = 768, ZC_VS = 896, ZC_KW = 1024, ZC_VW = 1152, ZC_QLAT = 1280, ZC_CKV = 2304,
              ZC_QIDX = 2432, ZC_KIDX = 2688, ZC_GNSA = 2752, ZC_WIDX = 2776;
constexpr int ZG_LD = 2048;
constexpr int NZ = ZA_LD + ZG_LD;
constexpr int NEXP = 32, DEXP = 256;
constexpr int MAXTILES = (2 * NTOK) / 256 + NEXP;

constexpr size_t MiB = 1u << 20;
constexpr size_t WS_CTL = 0, CTL_ZERO_BYTES = 1 * MiB;
constexpr size_t WS_WAT = 1 * MiB;
constexpr size_t WS_WBT = 2 * MiB;
constexpr size_t WS_WOT = 4 * MiB;
constexpr size_t WS_W1K = 6 * MiB;
constexpr size_t WS_W1V = 7 * MiB;
constexpr size_t WS_W2K = 8 * MiB;
constexpr size_t WS_W2V = 8 * MiB + 64 * 1024;
constexpr size_t WS_BIASK = 8 * MiB + 128 * 1024;
constexpr size_t WS_BIASV = 8 * MiB + 132 * 1024;
constexpr size_t WS_TBA = 8 * MiB + 256 * 1024;
constexpr size_t WS_TBB = 8 * MiB + 320 * 1024;
constexpr size_t WS_KCMP = 9 * MiB;
constexpr size_t WS_VCMP = 9 * MiB + 512 * 1024;
constexpr size_t WS_TOKINFO = 10 * MiB;
constexpr size_t WS_LIST = 11 * MiB;
constexpr size_t WS_WINT = 16 * MiB;
constexpr size_t WS_WGU = 32 * MiB;
constexpr size_t WS_WDT = 64 * MiB;
constexpr size_t WS_CKVN = 80 * MiB;
constexpr size_t WS_XB = 96 * MiB;
constexpr size_t WS_OLAT = 96 * MiB;
constexpr size_t WS_H1B = 96 * MiB;
constexpr size_t WS_ZA = 160 * MiB;
constexpr size_t WS_T1 = 160 * MiB;
constexpr size_t WS_ACT = 160 * MiB;
constexpr size_t WS_YBUF = 196 * MiB;
constexpr size_t WS_MERGED = 224 * MiB;
constexpr size_t WS_ZG = 336 * MiB;
constexpr size_t WS_H1 = 336 * MiB;
constexpr size_t WS_OA = 464 * MiB;
constexpr size_t WS_END = 496 * MiB;

constexpr int CW_BAR = 4096;
constexpr int CW_CNT = 16384;

constexpr int LDS_BYTES = 155648;
constexpr int MISC_OFF = 152 * 1024 - 256;

__device__ __forceinline__ unsigned f2bf(float f) { unsigned u = __builtin_bit_cast(unsigned, f); return (u + 0x7fffu + ((u >> 16) & 1u)) >> 16; }
__device__ __forceinline__ unsigned pk2(float lo, float hi) { unsigned r; asm volatile("v_cvt_pk_bf16_f32 %0, %1, %2" : "=v"(r) : "v"(lo), "v"(hi)); return r; }
__device__ __forceinline__ float bf2f(unsigned short b) { return __builtin_bit_cast(float, ((unsigned)b) << 16); }
__device__ __forceinline__ float bflo(unsigned w) { return __builtin_bit_cast(float, w << 16); }
__device__ __forceinline__ float bfhi(unsigned w) { return __builtin_bit_cast(float, w & 0xffff0000u); }
__device__ __forceinline__ float wave_sum(float v) {
#pragma unroll
    for (int o = 1; o < 64; o <<= 1) v += __shfl_xor(v, o);
    return v;
}
__device__ __forceinline__ float sigmoidf_(float x) { return 1.0f / (1.0f + __expf(-x)); }
#define LDS_WAIT() asm volatile("s_waitcnt lgkmcnt(0)" ::: "memory")
#define VM_WAIT() asm volatile("s_waitcnt vmcnt(0)" ::: "memory")

#define XB_TMO      128
#define XB_XCNT(j)  (256  + 64 * (j))
#define XB_XSUB(j)  (1280 + 64 * (j))
#define XB_XGEN(j)  (2304 + 64 * (j))
#define XB_TOP      3328
#define XB_TOPGEN   3392
#define XCD_BAR_WORDS 3456
#define XB_SPIN_CAP (1u << 18)
__device__ __forceinline__ unsigned xb_ld(unsigned* p)              { return __hip_atomic_load(p, __ATOMIC_RELAXED, __HIP_MEMORY_SCOPE_AGENT); }
__device__ __forceinline__ unsigned xb_add(unsigned* p, unsigned v) { return __hip_atomic_fetch_add(p, v, __ATOMIC_RELAXED, __HIP_MEMORY_SCOPE_AGENT); }
__device__ __forceinline__ unsigned xb_xcc_id() { return (unsigned)__builtin_amdgcn_s_getreg((3 << 11) | 20) & 0xFu; }
#define XB_SPIN(cond, bar) do { unsigned _sp = 0; while (cond) { __builtin_amdgcn_s_sleep(1); \
    if ((++_sp & 255u) == 0u) { if (xb_ld(&(bar)[XB_TMO])) break; if (_sp > XB_SPIN_CAP) { atomicAdd(&(bar)[XB_TMO], 1u); break; } } } } while (0)
struct XcdBarrier { unsigned* bar; unsigned x; volatile LAS unsigned* st; };
__device__ __forceinline__ XcdBarrier xcd_barrier_post(unsigned* bar, volatile LAS unsigned* st) {
    XcdBarrier b; b.bar = bar; b.x = xb_xcc_id(); b.st = st;
    if (threadIdx.x == 0) (void)xb_add(&bar[XB_XCNT(b.x)], 1u);
    return b;
}
__device__ __forceinline__ void xcd_barrier_complete(unsigned* bar, unsigned x, unsigned& nloc, unsigned& nx) {
    const unsigned G = gridDim.x * gridDim.y * gridDim.z;
    unsigned sum, cnt, mine, sp = 0u;
    for (;;) {
        sum = 0u; cnt = 0u; mine = 0u;
#pragma unroll
        for (unsigned j = 0; j < 16; ++j) { const unsigned c = xb_ld(&bar[XB_XCNT(j)]); sum += c; cnt += (c > 0u) ? 1u : 0u; mine = (j == x) ? c : mine; }
        if (sum == G) break;
        __builtin_amdgcn_s_sleep(1);
        if ((++sp & 255u) == 0u) { if (xb_ld(&bar[XB_TMO])) break; if (sp > XB_SPIN_CAP) { atomicAdd(&bar[XB_TMO], 1u); break; } }
    }
    nloc = mine > 0u ? mine : 1u; nx = cnt > 0u ? cnt : 1u;
}
__device__ __forceinline__ void xcd_barrier(const XcdBarrier& b) {
    asm volatile("s_waitcnt vmcnt(0)" ::: "memory");
    __syncthreads();
    if (threadIdx.x == 0) {
        unsigned* bar = b.bar;
        __builtin_amdgcn_s_waitcnt(0);
        unsigned nloc = b.st[0], nx = b.st[1];
        if (nloc == 0u) { xcd_barrier_complete(bar, b.x, nloc, nx); b.st[0] = nloc; b.st[1] = nx; }
        const unsigned old = xb_add(&bar[XB_XSUB(b.x)], 1u);
        const unsigned gen = old / nloc;
        if (old + 1u == (gen + 1u) * nloc) {
            __builtin_amdgcn_fence(__ATOMIC_RELEASE, "agent");
            asm volatile("s_waitcnt vmcnt(0)" ::: "memory");
            const unsigned og = xb_add(&bar[XB_TOP], 1u);
            const unsigned tg = og / nx;
            if (og + 1u == (tg + 1u) * nx) xb_add(&bar[XB_TOPGEN], 1u);
            else XB_SPIN(xb_ld(&bar[XB_TOPGEN]) == tg, bar);
            __builtin_amdgcn_fence(__ATOMIC_ACQUIRE, "agent");
            xb_add(&bar[XB_XGEN(b.x)], 1u);
            asm volatile("s_waitcnt vmcnt(0)" ::: "memory");
        } else {
            XB_SPIN(xb_ld(&bar[XB_XGEN(b.x)]) == gen, bar);
            __builtin_amdgcn_fence(__ATOMIC_ACQUIRE, "agent");
            asm volatile("s_waitcnt vmcnt(0)" ::: "memory");
        }
    }
    __syncthreads();
}

namespace pg8 {
constexpr int BM = 256, BK = 64, HALF = 128, HTB = HALF * BK * 2, STAGE_BYTES = 8 * HTB, NXCD = 8, WGM = 8;
__host__ __device__ __forceinline__ int lds_byte(int r, int c) { const int st = (r >> 4) * 2 + (c >> 5), rr = r & 15, cc = c & 31, ob = rr * 64 + cc * 2; return st * 1024 + (ob ^ (((ob >> 9) & 1) << 5)); }
__host__ __device__ __forceinline__ void stage_rc(int b, int& R, int& C) { const int st = b / 1024, sb = b % 1024, swz = sb ^ (((sb >> 9) & 1) << 5); R = (st >> 1) * 16 + swz / 64; C = (st & 1) * 32 + (swz % 64) / 2; }
__host__ __device__ __forceinline__ int perm32(int rho) { const int n = rho >> 4, i = rho & 15; return 8 * (i >> 2) + 4 * n + (i & 3); }
struct Unit { int pm, pn, e, nrows; };
struct StaticOrder {
    int nM, nN, nwg, G, c;
    __device__ void init(int nM_, int nN_, int G_, int c_) { nM = nM_; nN = nN_; nwg = nM * nN; G = G_; c = c_; }
    __device__ bool next(int i, Unit& u) const {
        const long L = (long)i * G + c; if (L >= nwg) return false;
        int wgid = (int)L; { const int q = nwg / NXCD, r = nwg % NXCD, xcd = wgid % NXCD, off = wgid / NXCD; wgid = (xcd < r ? xcd * (q + 1) : r * (q + 1) + (xcd - r) * q) + off; }
        const int nig = WGM * nN, gid = wgid / nig, fm = gid * WGM, gsz = (nM - fm) < WGM ? (nM - fm) : WGM;
        u.pm = fm + ((wgid % nig) % gsz); u.pn = (wgid % nig) / gsz; u.e = 0; u.nrows = 256; return true;
    }
};

template <class Epi, class Sched, class AAddr, class BAddr>
__device__ __forceinline__ void gemm_phase(LAS unsigned char* lds, const int K, const Sched& S, const AAddr& AA, const BAddr& BA, const Epi& E) {
    constexpr bool GA = AAddr::GATHER;
    const int tid = threadIdx.x, wid = __builtin_amdgcn_readfirstlane(tid >> 6), lane = tid & 63, wr = wid >> 2, wc = wid & 3, fr = lane & 15, fq = lane >> 4;
    const int nt = K / BK;
    unsigned voffA[2], voffB[2];
#pragma unroll
    for (int i = 0; i < 2; ++i) { int R, C; stage_rc(tid * 16 + i * 8192, R, C); const int Rb = Epi::PERM ? ((R & ~31) + perm32(R & 31)) : R;
        voffA[i] = GA ? 0u : AA.lane_off(R, C); voffB[i] = (unsigned)(Rb * K + C) * 2u; }
    const size_t kstepA = (size_t)AA.kstep, kstepB = (size_t)(BK * 2);
    const size_t hstepB = (size_t)HALF * K * 2, hstepA = GA ? 0 : AA.hstep();
    const unsigned ldsw = (unsigned)wid * 1024u;
    const int aoff = lds_byte(wr * 64 + fr, fq * 8), boff = lds_byte(wc * 32 + fr, fq * 8);
#define PG8_SA(b, h) (((b) * 2 + (h)) * HTB)
#define PG8_SB(b, h) ((4 + (b) * 2 + (h)) * HTB)
#define PG8_STAGE(bufoff, gbase, voff) do { _Pragma("unroll") for (int _i = 0; _i < 2; ++_i) \
        __builtin_amdgcn_global_load_lds((const unsigned*)((const char*)(gbase) + (voff)[_i]), (LAS unsigned*)(lds + (bufoff) + ldsw + _i * 8192), 16, 0, 0); } while (0)
#define PG8_STA_CUR(bufoff, h, kb) do { if constexpr (GA) { if (h) PG8_STAGE(bufoff, baseA + (kb), cof1); else PG8_STAGE(bufoff, baseA + (kb), cof0); } \
        else PG8_STAGE(bufoff, cA + (h) * hstepA + (kb), voffA); } while (0)
#define PG8_STA_SEL(bufoff, h, kb) do { if constexpr (GA) { if (h) PG8_STAGE(bufoff, baseA + (kb), sof1); else PG8_STAGE(bufoff, baseA + (kb), sof0); } \
        else PG8_STAGE(bufoff, sA + (h) * hstepA + (kb), voffA); } while (0)
#define PG8_LDA(dst, b, h) do { _Pragma("unroll") for (int m = 0; m < 4; ++m) _Pragma("unroll") for (int k = 0; k < 2; ++k) dst[m][k] = *(const LAS bf16x8*)(lds + PG8_SA(b, h) + aoff + m * 2048 + k * 1024); } while (0)
#define PG8_LDB(dst, b, h) do { _Pragma("unroll") for (int n = 0; n < 2; ++n) _Pragma("unroll") for (int k = 0; k < 2; ++k) dst[n][k] = *(const LAS bf16x8*)(lds + PG8_SB(b, h) + boff + n * 2048 + k * 1024); } while (0)
#define PG8_MMA(ai, bj, At, Bt) do { __builtin_amdgcn_s_setprio(1); _Pragma("unroll") for (int m = 0; m < 4; ++m) _Pragma("unroll") for (int n = 0; n < 2; ++n) _Pragma("unroll") for (int k = 0; k < 2; ++k) \
        acc[ai][bj][m][n] = __builtin_amdgcn_mfma_f32_16x16x32_bf16(Bt[n][k], At[m][k], acc[ai][bj][m][n], 0, 0, 0); __builtin_amdgcn_s_setprio(0); } while (0)
#define PG8_WAIT_V(n) asm volatile("s_waitcnt vmcnt(" #n ")" ::: "memory")
#define PG8_WAIT_L(n) asm volatile("s_waitcnt lgkmcnt(" #n ")" ::: "memory")
#define PG8_BAR __builtin_amdgcn_s_barrier()
#define PG8_SCHED __builtin_amdgcn_sched_barrier(0)
#define PG8_GOFF(u, o0, o1) do { _Pragma("unroll") for (int _i = 0; _i < 2; ++_i) { int R_, C_; stage_rc(tid * 16 + _i * 8192, R_, C_); \
        o0[_i] = AA.row_off(u, R_) + (unsigned)C_ * 2u; o1[_i] = AA.row_off(u, R_ + HALF) + (unsigned)C_ * 2u; } } while (0)
    Unit cur, nxt; int ui = 0;
    if (!S.next(0, cur)) return;
    f32x4 acc[2][2][4][2];
#pragma unroll
    for (int a = 0; a < 2; ++a)
#pragma unroll
        for (int b = 0; b < 2; ++b)
#pragma unroll
            for (int m = 0; m < 4; ++m)
#pragma unroll
                for (int n = 0; n < 2; ++n) acc[a][b][m][n] = (f32x4){0.f, 0.f, 0.f, 0.f};
    bf16x8 At[4][2], B0[2][2], B1[2][2];
    const char* const baseA = GA ? (const char*)AA.base : nullptr;
    const char* cA = GA ? nullptr : (const char*)AA.unit_ptr(cur);
    unsigned cof0[2] = {0u, 0u}, cof1[2] = {0u, 0u}, nof0[2] = {0u, 0u}, nof1[2] = {0u, 0u};
    if constexpr (GA) PG8_GOFF(cur, cof0, cof1);
    const char* cB = (const char*)BA.ptr(cur);
    PG8_STAGE(PG8_SB(0, 0), cB, voffB); PG8_STA_CUR(PG8_SA(0, 0), 0, 0); PG8_STAGE(PG8_SB(0, 1), cB + hstepB, voffB); PG8_STA_CUR(PG8_SA(0, 1), 1, 0);
    if (wr == 1) PG8_BAR;
    PG8_WAIT_V(4); PG8_BAR;
    PG8_STAGE(PG8_SB(1, 0), cB + kstepB, voffB); PG8_STA_CUR(PG8_SA(1, 0), 0, kstepA); PG8_STAGE(PG8_SB(1, 1), cB + hstepB + kstepB, voffB);
    PG8_WAIT_V(6); PG8_BAR;
    for (;;) {
        const bool has_next = S.next(ui + 1, nxt);
        const char* nB = cB; const char* nA = cA;
        if (has_next) { nB = (const char*)BA.ptr(nxt); if constexpr (GA) PG8_GOFF(nxt, nof0, nof1); else nA = (const char*)AA.unit_ptr(nxt); }
        else { if constexpr (GA) {
#pragma unroll
            for (int i = 0; i < 2; ++i) { nof0[i] = cof0[i]; nof1[i] = cof1[i]; } } }
#pragma nounroll
        for (int t = 0; t < nt; t += 2) {
            const bool last = (t == nt - 2);
            const size_t k1 = (size_t)(t + 1) * kstepA, k2 = last ? 0 : (size_t)(t + 2) * kstepA, k3 = k2 + kstepA;
            const char* b2 = last ? nB : cB + (size_t)(t + 2) * kstepB; const char* b3 = b2 + kstepB;
            const char* sA = last ? nA : cA;
            unsigned sof0[2], sof1[2];
#pragma unroll
            for (int i = 0; i < 2; ++i) { sof0[i] = last ? nof0[i] : cof0[i]; sof1[i] = last ? nof1[i] : cof1[i]; }
            PG8_LDB(B0, 0, 0); PG8_SCHED; PG8_LDA(At, 0, 0); PG8_STA_CUR(PG8_SA(1, 1), 1, k1);
            PG8_WAIT_L(8); PG8_BAR; PG8_WAIT_L(0); PG8_MMA(0, 0, At, B0); PG8_BAR; PG8_SCHED;
            PG8_LDB(B1, 0, 1); PG8_STAGE(PG8_SB(0, 0), b2, voffB);
            PG8_BAR; PG8_WAIT_L(0); PG8_MMA(0, 1, At, B1); PG8_BAR;
            PG8_LDA(At, 0, 1); PG8_STA_SEL(PG8_SA(0, 0), 0, k2);
            PG8_BAR; PG8_WAIT_L(0); PG8_MMA(1, 0, At, B0); PG8_BAR; PG8_SCHED;
            PG8_STAGE(PG8_SB(0, 1), b2 + hstepB, voffB);
            PG8_WAIT_V(6); PG8_BAR; PG8_MMA(1, 1, At, B1); PG8_BAR;
            PG8_LDB(B0, 1, 0); PG8_SCHED; PG8_LDA(At, 1, 0); PG8_STA_SEL(PG8_SA(0, 1), 1, k2);
            PG8_WAIT_L(8); PG8_BAR; PG8_WAIT_L(0); PG8_MMA(0, 0, At, B0); PG8_BAR; PG8_SCHED;
            PG8_LDB(B1, 1, 1); PG8_STAGE(PG8_SB(1, 0), b3, voffB);
            PG8_BAR; PG8_WAIT_L(0); PG8_MMA(0, 1, At, B1); PG8_BAR;
            PG8_LDA(At, 1, 1); PG8_STA_SEL(PG8_SA(1, 0), 0, k3);
            PG8_BAR; PG8_WAIT_L(0); PG8_MMA(1, 0, At, B0); PG8_BAR; PG8_SCHED;
            PG8_STAGE(PG8_SB(1, 1), b3 + hstepB, voffB);
            PG8_WAIT_V(6); PG8_BAR; PG8_MMA(1, 1, At, B1); PG8_BAR;
        }
        E(acc, cur, wr, wc, fr, fq);
        if (!has_next) break;
#pragma unroll
        for (int a = 0; a < 2; ++a)
#pragma unroll
            for (int b = 0; b < 2; ++b)
#pragma unroll
                for (int m = 0; m < 4; ++m)
#pragma unroll
                    for (int n = 0; n < 2; ++n) acc[a][b][m][n] = (f32x4){0.f, 0.f, 0.f, 0.f};
        cur = nxt; cB = nB; cA = nA; ++ui;
        if constexpr (GA) {
#pragma unroll
            for (int i = 0; i < 2; ++i) { cof0[i] = nof0[i]; cof1[i] = nof1[i]; } }
    }
    PG8_WAIT_V(0);
    if (wr == 0) PG8_BAR;
    PG8_BAR;
#undef PG8_SA
#undef PG8_SB
#undef PG8_STAGE
#undef PG8_STA_CUR
#undef PG8_STA_SEL
#undef PG8_GOFF
#undef PG8_LDA
#undef PG8_LDB
#undef PG8_MMA
#undef PG8_WAIT_V
#undef PG8_WAIT_L
#undef PG8_BAR
#undef PG8_SCHED
}
}

constexpr int NWAVES = 8, NTHR = 512;
struct Args { const float* in[26]; float* out; unsigned char* ws; int ph_lo, ph_hi; };
struct Frame {
    LAS unsigned char* lds;
    int tid, lane, wave, G, bx;
    unsigned char* ws;
};

struct APlain { const void* base; unsigned kstep; unsigned ld2;
    static constexpr bool GATHER = false;
    __device__ __forceinline__ const void* unit_ptr(const pg8::Unit& u) const { return (const char*)base + (size_t)u.pm * 256 * ld2; }
    __device__ __forceinline__ unsigned lane_off(int R, int C) const { return (unsigned)R * ld2 + (unsigned)C * 2u; }
    __device__ __forceinline__ size_t hstep() const { return (size_t)128 * ld2; }
    __device__ __forceinline__ unsigned row_off(const pg8::Unit&, int) const { return 0u; } };
struct BPlain { const bf16* Bt; int K;
    __device__ __forceinline__ const void* ptr(const pg8::Unit& u) const { return Bt + (size_t)u.pn * 256 * K; } };

struct EpiZ {
    static constexpr bool PERM = true;
    bf16* ZA; bf16* ZG;
    __device__ __forceinline__ void operator()(const f32x4 (&acc)[2][2][4][2], const pg8::Unit& u, int wr, int wc, int fr, int fq) const {
        const bool gate = u.pn >= 11;
        bf16* base = gate ? ZG : ZA; const int ld = gate ? ZG_LD : ZA_LD; const int colt = gate ? (u.pn - 11) * 256 : u.pn * 256;
        const int row0 = u.pm * 256 + wr * 64 + fr, col0 = colt + wc * 32 + 8 * fq;
#pragma unroll
        for (int ai = 0; ai < 2; ++ai)
#pragma unroll
            for (int m = 0; m < 4; ++m) { bf16* rowp = base + (size_t)(row0 + ai * 128 + m * 16) * ld + col0;
#pragma unroll
                for (int bj = 0; bj < 2; ++bj) { f32x4 v0 = acc[ai][bj][m][0], v1 = acc[ai][bj][m][1];
                    if (gate) {
#pragma unroll
                        for (int j = 0; j < 4; ++j) { v0[j] = sigmoidf_(v0[j]); v1[j] = sigmoidf_(v1[j]); } }
                    u32x4 w; w.x = pk2(v0[0], v0[1]); w.y = pk2(v0[2], v0[3]); w.z = pk2(v1[0], v1[1]); w.w = pk2(v1[2], v1[3]);
                    *(u32x4*)(rowp + bj * 128) = w; } }
    }
};
template <int MODE> struct EpiGate {
    static constexpr bool PERM = true;
    const bf16* ZG; const bf16* T1; bf16* O;
    __device__ __forceinline__ void operator()(const f32x4 (&acc)[2][2][4][2], const pg8::Unit& u, int wr, int wc, int fr, int fq) const {
        const int row0 = u.pm * 256 + wr * 64 + fr, col0 = u.pn * 256 + wc * 32 + 8 * fq;
#pragma unroll
        for (int ai = 0; ai < 2; ++ai)
#pragma unroll
            for (int m = 0; m < 4; ++m) { const size_t r = (size_t)(row0 + ai * 128 + m * 16);
#pragma unroll
                for (int bj = 0; bj < 2; ++bj) { const int c = col0 + bj * 128;
                    const u32x4 g = *(const u32x4*)(ZG + r * ZG_LD + MODE * 1024 + c);
                    f32x4 v0 = acc[ai][bj][m][0], v1 = acc[ai][bj][m][1];
                    float o[8] = { v0[0] * bflo(g.x), v0[1] * bfhi(g.x), v0[2] * bflo(g.y), v0[3] * bfhi(g.y), v1[0] * bflo(g.z), v1[1] * bfhi(g.z), v1[2] * bflo(g.w), v1[3] * bfhi(g.w) };
                    if (MODE == 1) { const u32x4 t = *(const u32x4*)(T1 + r * 1024 + c);
                        o[0] += bflo(t.x); o[1] += bfhi(t.x); o[2] += bflo(t.y); o[3] += bfhi(t.y); o[4] += bflo(t.z); o[5] += bfhi(t.z); o[6] += bflo(t.w); o[7] += bfhi(t.w); }
                    u32x4 w; w.x = pk2(o[0], o[1]); w.y = pk2(o[2], o[3]); w.z = pk2(o[4], o[5]); w.w = pk2(o[6], o[7]);
                    *(u32x4*)(O + r * 1024 + c) = w; } }
    }
};
struct EpiRes {
    static constexpr bool PERM = false;
    const float* X; float* O;
    __device__ __forceinline__ void operator()(const f32x4 (&acc)[2][2][4][2], const pg8::Unit& u, int wr, int wc, int fr, int fq) const {
        const int row0 = u.pm * 256 + wr * 64 + fr, col0 = u.pn * 256 + wc * 32 + 4 * fq;
#pragma unroll
        for (int ai = 0; ai < 2; ++ai)
#pragma unroll
            for (int m = 0; m < 4; ++m) { const size_t off = (size_t)(row0 + ai * 128 + m * 16) * D + col0;
#pragma unroll
                for (int bj = 0; bj < 2; ++bj)
#pragma unroll
                    for (int n = 0; n < 2; ++n) { const f32x4 xv = *(const f32x4*)(X + off + bj * 128 + n * 16); *(f32x4*)(O + off + bj * 128 + n * 16) = xv * ALPHA + acc[ai][bj][m][n]; } }
    }
};

template <class F>
__device__ __forceinline__ void p0_tile(const F& f, bf16* WT, int ldk, int k0, int n0, LAS float* scr, int lane) {
#pragma unroll 4
    for (int i = 0; i < 32; ++i) { const int kk = 2 * i + (lane >> 5); scr[kk * 33 + (lane & 31)] = f(k0 + kk, n0 + (lane & 31)); }
    LDS_WAIT(); asm volatile("" ::: "memory");
    const int c = lane & 7;
#pragma unroll
    for (int j = 0; j < 4; ++j) { const int n = (lane >> 3) + 8 * j; const LAS float* s = scr + (8 * c) * 33 + n;
        u32x4 o; o.x = pk2(s[0 * 33], s[1 * 33]); o.y = pk2(s[2 * 33], s[3 * 33]); o.z = pk2(s[4 * 33], s[5 * 33]); o.w = pk2(s[6 * 33], s[7 * 33]);
        *(u32x4*)(WT + (size_t)(n0 + n) * ldk + k0 + 8 * c) = o; }
    LDS_WAIT(); asm volatile("" ::: "memory");
}
__device__ __forceinline__ int zsrc_col(int n) {
    if (n < 1280) return n;
    if (n < 2304) return -2;
    if (n < 2432) return 1816 + (n - 2304);
    if (n < 2688) return 1944 + (n - 2432);
    if (n < 2752) return 2200 + (n - 2688);
    if (n < 2776) return 1280 + (n - 2752);
    if (n < 2780) return 2264 + (n - 2776);
    if (n < 2816) return -1;
    if (n < 3840) return 2268 + (n - 2816);
    return 3292 + (n - 3840);
}
struct FWin { const float* w_in; const float* w_uk;
    __device__ __forceinline__ float operator()(int k, int n) const {
        const int s = zsrc_col(n);
        if (s >= 0) return w_in[(size_t)k * D_IN + s];
        if (s == -1) return 0.f;
        const int h = (n - 1280) >> 7, r = (n - 1280) & 127; const float* a = w_in + (size_t)k * D_IN + 1304 + h * 64; const float* b = w_uk + (size_t)h * 64 * 128 + r;
        float acc = 0.f;
#pragma unroll 8
        for (int d = 0; d < 64; ++d) acc += a[d] * b[d * 128];
        return acc; } };
struct FWb { const float* w_uv; const float* w_bb;
    __device__ __forceinline__ float operator()(int k, int n) const {
        const int h = k >> 7; const float* a = w_uv + (size_t)k * 64; const float* b = w_bb + (size_t)h * 64 * D + n;
        float acc = 0.f;
#pragma unroll 8
        for (int d = 0; d < 64; ++d) acc += a[d] * b[(size_t)d * D];
        return acc; } };
struct FPlain { const float* W; int N; __device__ __forceinline__ float operator()(int k, int n) const { return W[(size_t)k * N + n]; } };
struct FOff { const float* W; int N; int noff;
    __device__ __forceinline__ float operator()(int k, int n) const { return W[(size_t)k * N + n + noff]; } };

__device__ __forceinline__ float rel_bucket_bias(const float* rel_bias, int dist, int head) {
    int b;
    if (dist < 16) b = dist;
    else { const float t = (__log2f((float)dist) - 4.0f) * 2.66666675f; b = 16 + (int)t; if (b > 31) b = 31; }
    return rel_bias[b * 16 + head];
}

__device__ __forceinline__ void phase0(const Frame& F, const Args& a) {
    LAS float* scr = (LAS float*)(F.lds + F.wave * 16384);
    const int gw = F.bx * NWAVES + F.wave, NGW = F.G * NWAVES;
    unsigned char* ws = F.ws;
    constexpr int I_WIN = (D / 64) * (NZ / 32);
    constexpr int I_WB = (1024 / 64) * (1024 / 32);
    constexpr int I_WA = (512 / 64) * (1024 / 32);
    constexpr int I_WO = I_WB;
    constexpr int I_W1 = (2048 / 64) * (256 / 32);
    constexpr int I_W2 = (256 / 64) * (64 / 32);
    constexpr int I_GU = (1024 / 64) * (512 / 32);
    constexpr int I_DN = (256 / 64) * (1024 / 32);
    constexpr int NITEMS = I_WIN + I_WB + I_WA + I_WO + 2 * I_W1 + 2 * I_W2 + NEXP * (I_GU + I_DN);
    for (int it = gw; it < NITEMS; it += NGW) {
        int r = it;
        if (r < I_WIN) { const FWin f{a.in[1], a.in[9]}; p0_tile(f, (bf16*)(ws + WS_WINT), D, (r / (NZ / 32)) * 64, (r % (NZ / 32)) * 32, scr, F.lane); continue; } r -= I_WIN;
        if (r < I_WB) { const FWb f{a.in[10], a.in[13]}; p0_tile(f, (bf16*)(ws + WS_WBT), 1024, (r / 32) * 64, (r % 32) * 32, scr, F.lane); continue; } r -= I_WB;
        if (r < I_WA) { const FPlain f{a.in[12], D}; p0_tile(f, (bf16*)(ws + WS_WAT), 512, (r / 32) * 64, (r % 32) * 32, scr, F.lane); continue; } r -= I_WA;
        if (r < I_WO) { const FPlain f{a.in[14], D}; p0_tile(f, (bf16*)(ws + WS_WOT), 1024, (r / 32) * 64, (r % 32) * 32, scr, F.lane); continue; } r -= I_WO;
        if (r < I_W1) { const FPlain f{a.in[4], 256}; p0_tile(f, (bf16*)(ws + WS_W1K), 2048, (r / 8) * 64, (r % 8) * 32, scr, F.lane); continue; } r -= I_W1;
        if (r < I_W1) { const FPlain f{a.in[6], 256}; p0_tile(f, (bf16*)(ws + WS_W1V), 2048, (r / 8) * 64, (r % 8) * 32, scr, F.lane); continue; } r -= I_W1;
        if (r < I_W2) { const FPlain f{a.in[5], 64}; p0_tile(f, (bf16*)(ws + WS_W2K), 256, (r / 2) * 64, (r % 2) * 32, scr, F.lane); continue; } r -= I_W2;
        if (r < I_W2) { const FPlain f{a.in[7], 64}; p0_tile(f, (bf16*)(ws + WS_W2V), 256, (r / 2) * 64, (r % 2) * 32, scr, F.lane); continue; } r -= I_W2;
        const int e = r / (I_GU + I_DN); r -= e * (I_GU + I_DN);
        if (r < I_GU) {
            const int n0 = (r % 16) * 32; const uintptr_t pg = (uintptr_t)a.in[21], pu = (uintptr_t)a.in[22];
            const float* src = (const float*)(pg + (uintptr_t)((n0 >> 7) & 1) * (pu - pg)) + (size_t)e * D * DEXP;
            const FOff f{src, DEXP, ((n0 >> 8) * 128 + (n0 & 127)) - n0};
            p0_tile(f, (bf16*)(ws + WS_WGU) + (size_t)e * 512 * 1024, 1024, (r / 16) * 64, n0, scr, F.lane); continue; } r -= I_GU;
        { const FPlain f{a.in[23] + (size_t)e * DEXP * D, D}; p0_tile(f, (bf16*)(ws + WS_WDT) + (size_t)e * 1024 * 256, 256, (r / 32) * 64, (r % 32) * 32, scr, F.lane); }
    }
    { const f32x4* x4 = (const f32x4*)a.in[0]; u32x2* o = (u32x2*)(ws + WS_XB);
      for (size_t i = (size_t)F.bx * NTHR + F.tid; i < (size_t)NTOK * D / 4; i += (size_t)F.G * NTHR) { const f32x4 v = x4[i]; u32x2 w; w.x = pk2(v[0], v[1]); w.y = pk2(v[2], v[3]); o[i] = w; } }
    if (F.bx < 2 && F.tid < 256) {
        const float* pe = F.bx ? a.in[3] : a.in[2]; const float* w1 = F.bx ? a.in[6] : a.in[4]; float acc = 0.f;
#pragma unroll 8
        for (int k = 0; k < 2048; ++k) acc += pe[k] * w1[(size_t)k * 256 + F.tid];
        ((float*)(ws + (F.bx ? WS_BIASV : WS_BIASK)))[F.tid] = acc;
    }
    if (F.bx >= 2 && F.bx < 34) { const int idx = (F.bx - 2) * NTHR + F.tid;
        const int tab = idx >> 13, head = (idx >> 10) & 7, dist = idx & 1023;
        ((float*)(ws + (tab ? WS_TBB : WS_TBA)))[head * 1024 + dist] = rel_bucket_bias(a.in[11], dist, tab * 8 + head) * LOG2E; }
}

constexpr int NRT = 36;
constexpr int P6_WR = 0;
constexpr int P6_CNT = 147456;
constexpr int P6_ENT = 147456 + 512;
__device__ __forceinline__ void phase6(const Frame& F, const Args& a) {
    unsigned char* ws = F.ws;
    LAS float* WR = (LAS float*)(F.lds + P6_WR);
    LAS int* cntL = (LAS int*)(F.lds + P6_CNT); LAS int* baseL = cntL + 32;
    LAS int* ent = (LAS int*)(F.lds + P6_ENT);
    const float* w_grp = a.in[17]; const float* b_grp = a.in[18]; const float* w_rtr = a.in[19]; const float* b_rtr = a.in[20];
    for (int i = F.tid; i < NRT * 1024; i += NTHR) { const int o = i >> 10, k = i & 1023; WR[i] = o < 4 ? w_grp[k * 4 + o] : w_rtr[k * 32 + (o - 4)]; }
    if (F.tid < 65) cntL[F.tid] = 0;
    __syncthreads();
    float* H1 = (float*)(ws + WS_H1); bf16* H1B = (bf16*)(ws + WS_H1B);
    const float* lg = a.in[15]; const float* lb = a.in[16];
    f32x4 gam[4], bet[4];
#pragma unroll
    for (int j = 0; j < 4; ++j) { gam[j] = *(const f32x4*)(lg + 256 * j + 4 * F.lane); bet[j] = *(const f32x4*)(lb + 256 * j + 4 * F.lane); }
    unsigned* gcnt = (unsigned*)(ws + WS_CTL) + CW_CNT;
    int* list = (int*)(ws + WS_LIST); float* tokinfo = (float*)(ws + WS_TOKINFO);
    const int gw = F.bx * NWAVES + F.wave, NGW = F.G * NWAVES;
    for (int row = gw; row < NTOK; row += NGW) {
        f32x4 v[4]; float s = 0.f;
        f32x4* hr = (f32x4*)(H1 + (size_t)row * D) + F.lane;
#pragma unroll
        for (int j = 0; j < 4; ++j) { v[j] = hr[64 * j]; s += (v[j][0] + v[j][1]) + (v[j][2] + v[j][3]); }
        const float mean = wave_sum(s) * (1.f / D); float s2 = 0.f;
#pragma unroll
        for (int j = 0; j < 4; ++j) { v[j] = v[j] - mean; s2 += (v[j][0] * v[j][0] + v[j][1] * v[j][1]) + (v[j][2] * v[j][2] + v[j][3] * v[j][3]); }
        const float rstd = 1.0f / sqrtf(wave_sum(s2) * (1.f / D) + 1e-5f);
        u32x2* ob = (u32x2*)(H1B + (size_t)row * D) + F.lane;
#pragma unroll
        for (int j = 0; j < 4; ++j) { v[j] = v[j] * rstd * gam[j] + bet[j]; hr[64 * j] = v[j]; u32x2 w; w.x = pk2(v[j][0], v[j][1]); w.y = pk2(v[j][2], v[j][3]); ob[64 * j] = w; }
        float L[NRT];
#pragma unroll
        for (int o = 0; o < NRT; ++o) { float p = 0.f;
#pragma unroll
            for (int j = 0; j < 4; ++j) { const f32x4 w = *(const LAS f32x4*)(WR + o * 1024 + 256 * j + 4 * F.lane); p += (v[j][0] * w[0] + v[j][1] * w[1]) + (v[j][2] * w[2] + v[j][3] * w[3]); }
            L[o] = wave_sum(p); }
        float g[4];
#pragma unroll
        for (int i = 0; i < 4; ++i) g[i] = L[i] + b_grp[i];
        int gs = 0; float gm = g[0];
#pragma unroll
        for (int i = 1; i < 4; ++i) if (g[i] > gm) { gm = g[i]; gs = i; }
        float gsum = 0.f;
#pragma unroll
        for (int i = 0; i < 4; ++i) gsum += __expf(g[i] - gm);
        const float pgrp = 1.0f / gsum;
        float el[8];
#pragma unroll
        for (int i = 0; i < 8; ++i) { const float x0 = L[4 + i], x1 = L[12 + i], x2 = L[20 + i], x3 = L[28 + i]; el[i] = (gs == 0 ? x0 : gs == 1 ? x1 : gs == 2 ? x2 : x3) + b_rtr[gs * 8 + i]; }
        int i1 = 0; float l1 = el[0];
#pragma unroll
        for (int i = 1; i < 8; ++i) if (el[i] > l1) { l1 = el[i]; i1 = i; }
        int i2 = -1; float l2 = -3.0e38f;
#pragma unroll
        for (int i = 0; i < 8; ++i) if (i != i1 && el[i] > l2) { l2 = el[i]; i2 = i; }
        const float e2 = __expf(l2 - l1), inv = 1.0f / (1.0f + e2);
        const float w0 = pgrp * inv, w1 = pgrp * e2 * inv;
        const int e0 = gs * 8 + i1, e1 = gs * 8 + i2;
        if (F.lane == 0) {
            const int p0 = atomicAdd((int*)&cntL[e0], 1), p1 = atomicAdd((int*)&cntL[e1], 1);
            const int n0 = atomicAdd((int*)&cntL[64], 2);
            ent[2 * n0] = (e0 << 16) | p0; ent[2 * n0 + 1] = row * 2;
            ent[2 * n0 + 2] = (e1 << 16) | p1; ent[2 * n0 + 3] = row * 2 + 1;
            tokinfo[row * 2] = w0; tokinfo[row * 2 + 1] = w1;
        }
    }
    __syncthreads();
    if (F.tid < 32) { const int c = cntL[F.tid]; baseL[F.tid] = c > 0 ? (int)__hip_atomic_fetch_add(gcnt + 64 * F.tid, (unsigned)c, __ATOMIC_RELAXED, __HIP_MEMORY_SCOPE_AGENT) : 0; }
    __syncthreads();
    const int nent = cntL[64];
    for (int i = F.tid; i < nent; i += NTHR) { const int ep = ent[2 * i], tk = ent[2 * i + 1]; const int e = ep >> 16, p = ep & 0xffff; list[(size_t)e * NTOK + baseL[e] + p] = tk; }
    __syncthreads();
}

constexpr int MOE_CUM = 131072;
struct MoeOrder {
    int G, c, NP; const LAS int* cum; const LAS int* cnt;
    __device__ bool next(int i, pg8::Unit& u) const {
        const int L = i * G + c, t = L / NP; if (t >= cum[32]) return false;
        int e = 0;
        for (int k = 1; k < 32; ++k) if (t >= cum[k]) e = k;
        const int j = t - cum[e]; u.pm = t; u.pn = L % NP; u.e = e | (j << 8); const int rem = cnt[e] - j * 256; u.nrows = rem < 256 ? rem : 256; return true;
    }
};
__device__ __forceinline__ void moe_setup(const Frame& F) {
    LAS int* cum = (LAS int*)(F.lds + MOE_CUM); LAS int* cnt = cum + 40;
    const unsigned* gcnt = (const unsigned*)(F.ws + WS_CTL) + CW_CNT;
    if (F.tid == 0) { int s = 0; for (int e = 0; e < 32; ++e) { const int c = (int)__hip_atomic_load(gcnt + 64 * e, __ATOMIC_RELAXED, __HIP_MEMORY_SCOPE_AGENT); cnt[e] = c; cum[e] = s; s += (c + 255) >> 8; } cum[32] = s; }
    __syncthreads();
}
struct AGather { const void* base; unsigned kstep; const int* list;
    static constexpr bool GATHER = true;
    __device__ __forceinline__ const void* unit_ptr(const pg8::Unit&) const { return base; }
    __device__ __forceinline__ unsigned lane_off(int, int) const { return 0u; }
    __device__ __forceinline__ size_t hstep() const { return 0; }
    __device__ __forceinline__ unsigned row_off(const pg8::Unit& u, int r) const { const int e = u.e & 255, j = u.e >> 8; const int rr = r < u.nrows ? r : 0;
        const int tk = list[(size_t)e * NTOK + j * 256 + rr]; return (unsigned)(tk >> 1) * (unsigned)(D * 2); } };
struct BGu { const bf16* W; __device__ __forceinline__ const void* ptr(const pg8::Unit& u) const { return W + (size_t)(u.e & 255) * 512 * 1024 + (size_t)u.pn * 256 * 1024; } };
struct BDn { const bf16* W; __device__ __forceinline__ const void* ptr(const pg8::Unit& u) const { return W + (size_t)(u.e & 255) * 1024 * 256 + (size_t)u.pn * 256 * 256; } };
struct EpiAct {
    static constexpr bool PERM = true; bf16* ACT;
    __device__ __forceinline__ void operator()(const f32x4 (&acc)[2][2][4][2], const pg8::Unit& u, int wr, int wc, int fr, int fq) const {
        const int row0 = u.pm * 256 + wr * 64 + fr, col0 = u.pn * 128 + wc * 32 + 8 * fq;
#pragma unroll
        for (int ai = 0; ai < 2; ++ai)
#pragma unroll
            for (int m = 0; m < 4; ++m) { float o[8];
#pragma unroll
                for (int n = 0; n < 2; ++n)
#pragma unroll
                    for (int j = 0; j < 4; ++j) { const float gt = acc[ai][0][m][n][j], up = acc[ai][1][m][n][j]; o[4 * n + j] = gt * sigmoidf_(gt) * up; }
                u32x4 w; w.x = pk2(o[0], o[1]); w.y = pk2(o[2], o[3]); w.z = pk2(o[4], o[5]); w.w = pk2(o[6], o[7]);
                *(u32x4*)(ACT + (size_t)(row0 + ai * 128 + m * 16) * DEXP + col0) = w; }
    }
};
struct EpiDown {
    static constexpr bool PERM = true; bf16* Y; const int* list;
    __device__ __forceinline__ void operator()(const f32x4 (&acc)[2][2][4][2], const pg8::Unit& u, int wr, int wc, int fr, int fq) const {
        const int e = u.e & 255, j = u.e >> 8; const int col0 = u.pn * 256 + wc * 32 + 8 * fq;
#pragma unroll
        for (int ai = 0; ai < 2; ++ai)
#pragma unroll
            for (int m = 0; m < 4; ++m) { const int r = ai * 128 + wr * 64 + m * 16 + fr;
                if (r < u.nrows) { const int tk = list[(size_t)e * NTOK + j * 256 + r]; bf16* rowp = Y + (size_t)tk * D + col0;
#pragma unroll
                    for (int bj = 0; bj < 2; ++bj) { const f32x4 v0 = acc[ai][bj][m][0], v1 = acc[ai][bj][m][1];
                        u32x4 w; w.x = pk2(v0[0], v0[1]); w.y = pk2(v0[2], v0[3]); w.z = pk2(v1[0], v1[1]); w.w = pk2(v1[2], v1[3]);
                        *(u32x4*)(rowp + bj * 128) = w; } }
                asm volatile("" ::: "memory"); }
    }
};

__device__ __forceinline__ void phase9(const Frame& F, const Args& a) {
    unsigned char* ws = F.ws;
    const float* H1 = (const float*)(ws + WS_H1); const bf16* Y = (const bf16*)(ws + WS_YBUF); const float* tokinfo = (const float*)(ws + WS_TOKINFO);
    const float* lg = a.in[24]; const float* lb = a.in[25];
    f32x4 gam[4], bet[4];
#pragma unroll
    for (int j = 0; j < 4; ++j) { gam[j] = *(const f32x4*)(lg + 256 * j + 4 * F.lane); bet[j] = *(const f32x4*)(lb + 256 * j + 4 * F.lane); }
    const int gw = F.bx * NWAVES + F.wave, NGW = F.G * NWAVES;
    for (int row = gw; row < NTOK; row += NGW) {
        const float w0 = tokinfo[row * 2], w1 = tokinfo[row * 2 + 1];
        const f32x4* hr = (const f32x4*)(H1 + (size_t)row * D) + F.lane;
        const u32x2* y0 = (const u32x2*)(Y + (size_t)(row * 2) * D) + F.lane; const u32x2* y1 = (const u32x2*)(Y + (size_t)(row * 2 + 1) * D) + F.lane;
        f32x4 v[4]; float s = 0.f;
#pragma unroll
        for (int j = 0; j < 4; ++j) { const f32x4 h = hr[64 * j]; const u32x2 p = y0[64 * j], q = y1[64 * j];
            v[j][0] = ALPHA * h[0] + w0 * bflo(p.x) + w1 * bflo(q.x); v[j][1] = ALPHA * h[1] + w0 * bfhi(p.x) + w1 * bfhi(q.x);
            v[j][2] = ALPHA * h[2] + w0 * bflo(p.y) + w1 * bflo(q.y); v[j][3] = ALPHA * h[3] + w0 * bfhi(p.y) + w1 * bfhi(q.y);
            s += (v[j][0] + v[j][1]) + (v[j][2] + v[j][3]); }
        const float mean = wave_sum(s) * (1.f / D); float s2 = 0.f;
#pragma unroll
        for (int j = 0; j < 4; ++j) { v[j] = v[j] - mean; s2 += (v[j][0] * v[j][0] + v[j][1] * v[j][1]) + (v[j][2] * v[j][2] + v[j][3] * v[j][3]); }
        const float rstd = 1.0f / sqrtf(wave_sum(s2) * (1.f / D) + 1e-5f);
        f32x4* o = (f32x4*)(a.out + (size_t)row * D) + F.lane;
#pragma unroll
        for (int j = 0; j < 4; ++j) o[64 * j] = v[j] * rstd * gam[j] + bet[j];
    }
}

#define MFMA32(a, b, c) __builtin_amdgcn_mfma_f32_32x32x16_bf16((a), (b), (c), 0, 0, 0)
__device__ __forceinline__ int crow(int r, int hi) { return (r & 3) + 8 * (r >> 2) + 4 * hi; }
__device__ __forceinline__ float gelu_tanh(float x) { const float u = 0.7978845608028654f * (x + 0.044715f * x * x * x); const float e = __expf(2.0f * u); return 0.5f * x * (2.0f - 2.0f / (e + 1.0f)); }
constexpr int P2_AROW = 4096 + 16;
constexpr int P2_HID = 32 * P2_AROW;
constexpr int P2_HROW = 512 + 16;
__device__ __forceinline__ void phase2(const Frame& F, const Args& a) {
    unsigned char* ws = F.ws;
    const bf16* ZA = (const bf16*)(ws + WS_ZA);
    { const float* gn = a.in[8]; bf16* CK = (bf16*)(ws + WS_CKVN);
      const int sub = F.lane >> 4, l16 = F.lane & 15;
      float gv[8];
#pragma unroll
      for (int j = 0; j < 8; ++j) gv[j] = gn[l16 * 8 + j];
      for (int r4 = F.bx * NWAVES + F.wave; r4 < NTOK / 4; r4 += F.G * NWAVES) { const int row = r4 * 4 + sub;
          const u32x4 w = *(const u32x4*)(ZA + (size_t)row * ZA_LD + ZC_CKV + l16 * 8);
          float v[8] = { bflo(w.x), bfhi(w.x), bflo(w.y), bfhi(w.y), bflo(w.z), bfhi(w.z), bflo(w.w), bfhi(w.w) };
          float s = 0.f;
#pragma unroll
          for (int j = 0; j < 8; ++j) s += v[j] * v[j];
          s += __shfl_xor(s, 1); s += __shfl_xor(s, 2); s += __shfl_xor(s, 4); s += __shfl_xor(s, 8);
          const float rs = 1.0f / sqrtf(s * (1.0f / 128.0f) + 1e-6f);
          u32x4 o; o.x = pk2(v[0] * rs * gv[0], v[1] * rs * gv[1]); o.y = pk2(v[2] * rs * gv[2], v[3] * rs * gv[3]); o.z = pk2(v[4] * rs * gv[4], v[5] * rs * gv[5]); o.w = pk2(v[6] * rs * gv[6], v[7] * rs * gv[7]);
          *(u32x4*)(CK + (size_t)row * 128 + l16 * 8) = o; } }
    const int r32 = F.lane & 31, hi = F.lane >> 5;
    for (int u = F.bx; u < 256; u += F.G) {
        const int kv = u >> 7, rt = u & 127, R0 = rt * 32;
        const int zc = kv ? ZC_VC : ZC_KC;
        const bf16* W1T = (const bf16*)(ws + (kv ? WS_W1V : WS_W1K)); const bf16* W2T = (const bf16*)(ws + (kv ? WS_W2V : WS_W2K));
        const float* bias = (const float*)(ws + (kv ? WS_BIASV : WS_BIASK));
        bf16* OUT = (bf16*)(ws + (kv ? WS_VCMP : WS_KCMP));
        __syncthreads();
        for (int q = F.tid; q < 32 * 256; q += NTHR) { const int row = q >> 8, cq = q & 255, l = cq >> 3, dch = cq & 7;
            const int R = R0 + row, b = R >> 9, c = (R >> 1) & 255, g = R & 1; const int cc = c < NCMP ? c : NCMP - 1;
            const u32x4 v = *(const u32x4*)(ZA + (size_t)(b * SEQ + 16 * cc + l) * ZA_LD + zc + g * 64 + dch * 8);
            *(LAS u32x4*)(F.lds + row * P2_AROW + cq * 16) = v; }
        __syncthreads();
        f32x16 acc = {};
        { const bf16* bp = W1T + (size_t)(32 * F.wave + r32) * 2048 + 8 * hi; const LAS unsigned char* ap = F.lds + r32 * P2_AROW + 16 * hi;
#pragma unroll 8
          for (int s = 0; s < 128; ++s) { const bf16x8 af = *(const LAS bf16x8*)(ap + s * 32); const bf16x8 bfr = *(const bf16x8*)(bp + s * 16); acc = MFMA32(af, bfr, acc); } }
        { const float bs = bias[32 * F.wave + r32];
#pragma unroll
          for (int i = 0; i < 16; ++i) { const float h = gelu_tanh(acc[i] + bs); *(LAS unsigned short*)(F.lds + P2_HID + crow(i, hi) * P2_HROW + (32 * F.wave + r32) * 2) = (unsigned short)f2bf(h); } }
        __syncthreads();
        if (F.wave < 2) {
            f32x16 o2 = {};
            const bf16* bp = W2T + (size_t)(32 * F.wave + r32) * 256 + 8 * hi; const LAS unsigned char* ap = F.lds + P2_HID + r32 * P2_HROW + 16 * hi;
#pragma unroll
            for (int s = 0; s < 16; ++s) { const bf16x8 af = *(const LAS bf16x8*)(ap + s * 32); const bf16x8 bfr = *(const bf16x8*)(bp + s * 16); o2 = MFMA32(af, bfr, o2); }
#pragma unroll
            for (int i = 0; i < 16; ++i) OUT[(size_t)(R0 + crow(i, hi)) * 64 + 32 * F.wave + r32] = (bf16)f2bf(o2[i]);
        }
    }
    __syncthreads();
}

typedef short v4i16_t __attribute__((ext_vector_type(4)));
__device__ __forceinline__ s16x4 vtr(const LAS unsigned char* p) { return __builtin_bit_cast(s16x4, __builtin_amdgcn_ds_read_tr16_b64_v4i16((LAS v4i16_t*)p)); }
constexpr int NSA_K = 0;
constexpr int NSA_V = 16384;
constexpr int NSA_TB = 49152;
constexpr int NSA_SC = 65536;
constexpr int NSA_MSK = 81920;
constexpr int NSA_OF = 83968;
constexpr float C2 = 0.125f * LOG2E;

__device__ __forceinline__ void nsa_tile(const LAS unsigned char* Kb, const LAS unsigned char* Vb, const LAS float* tbh, const bf16x8 (&qr)[4], f32x16 (&o)[2], float& m, float& l,
                                         int kt, int tq, int kmul, int kadd, int dmax, bool selbit, int r32, int hi, int lane) {
    const int tqa = tq - kadd, qk = kmul == 16 ? (tqa >> 4) : tqa, rem = kmul == 16 ? (tqa & 15) : 0;
    const int ebase = qk - (kt * 64 + 4 * hi);
    const LAS unsigned char* vp0 = Vb + ((lane >> 4) & 1) * 32 + (lane & 3) * 8 + (4 * hi + ((lane & 15) >> 2)) * 64;
#pragma unroll
    for (int hf = 0; hf < 2; ++hf) {
        f32x16 s0 = {};
#pragma unroll
        for (int d0 = 0; d0 < 4; ++d0) { const bf16x8 k0 = *(const LAS bf16x8*)(Kb + (2 * d0 + hi) * 1024 + (r32 + 32 * hf) * 16); s0 = MFMA32(k0, qr[d0], s0); }
        float tmax = NEGBIG;
#pragma unroll
        for (int r = 0; r < 16; ++r) { const int dist = (ebase - ((r & 3) + 8 * (r >> 2) + 32 * hf)) * kmul + rem;
            const bool valid = selbit && dist >= 0 && dist < dmax;
            int dc = dist < 0 ? 0 : dist; dc = dc > 1023 ? 1023 : dc;
            const float bv = tbh[dc];
            const float x = valid ? s0[r] * C2 + bv : NEGBIG;
            s0[r] = x; tmax = fmaxf(tmax, x); }
        tmax = fmaxf(tmax, __shfl_xor(tmax, 32));
        const float mn = fmaxf(m, tmax);
        const float alpha = __builtin_amdgcn_exp2f(m - mn);
        m = mn;
        float ps = 0.f;
#pragma unroll
        for (int r = 0; r < 16; ++r) { const float p0 = s0[r] > -1e29f ? __builtin_amdgcn_exp2f(s0[r] - mn) : 0.f; s0[r] = p0; ps += p0; }
        l = l * alpha + ps;
#pragma unroll
        for (int c = 0; c < 2; ++c)
#pragma unroll
            for (int r = 0; r < 16; ++r) o[c][r] *= alpha;
        u32x4 pw[2];
#pragma unroll
        for (int q = 0; q < 4; ++q) { pw[0][q] = pk2(s0[2 * q], s0[2 * q + 1]); pw[1][q] = pk2(s0[8 + 2 * q], s0[8 + 2 * q + 1]); }
#pragma unroll
        for (int c = 0; c < 2; ++c)
#pragma unroll
            for (int s2 = 0; s2 < 2; ++s2) { const int s = 2 * hf + s2; const s16x4 vl = vtr(vp0 + c * 4096 + s * 1024), vh = vtr(vp0 + c * 4096 + s * 1024 + 512);
                const bf16x8 vf = {vl[0], vl[1], vl[2], vl[3], vh[0], vh[1], vh[2], vh[3]};
                o[c] = MFMA32(vf, __builtin_bit_cast(bf16x8, pw[s2]), o[c]); }
    }
}

__device__ __forceinline__ void nsa_unit(const Frame& F, int b, int g, int qt) {
    unsigned char* ws = F.ws;
    const bf16* ZA = (const bf16*)(ws + WS_ZA);
    const int r32 = F.lane & 31, hi = F.lane >> 5, qi = r32 >> 2, hh = r32 & 3, head = g * 4 + hh;
    const int q0 = qt * 64, tq = q0 + 8 * F.wave + qi;
    const size_t zrow = (size_t)(b * SEQ + tq) * ZA_LD;
    const int srow = F.tid >> 3, sch = F.tid & 7;
    __syncthreads();
    { const float* TBA = (const float*)(ws + WS_TBA) + (size_t)g * 4 * 1024; LAS float* tb = (LAS float*)(F.lds + NSA_TB);
      for (int i = F.tid; i < 4096; i += NTHR) tb[i] = TBA[i]; }
    const LAS float* tbh = (const LAS float*)(F.lds + NSA_TB) + hh * 1024;
    bf16x8 qr[4];
#pragma unroll
    for (int d0 = 0; d0 < 4; ++d0) qr[d0] = *(const bf16x8*)(ZA + zrow + ZC_QA + head * 64 + d0 * 16 + hi * 8);
    float gate[3];
#pragma unroll
    for (int i = 0; i < 3; ++i) gate[i] = sigmoidf_(bf2f(ZA[zrow + ZC_GNSA + head * 3 + i]));
    LAS float* ofw = (LAS float*)(F.lds + NSA_OF) + F.wave * 2048 + F.lane;
    unsigned mlo = 0u, mhi = 0u; float inv_cmp = 0.f;
#pragma nounroll
    for (int br = 0; br < 4; ++br) {
        const bool iscmp = br < 2, vmap = br == 1;
        const bf16* Kg; const bf16* Vg; size_t pitch; int t_lo, t_hi;
        if (iscmp) { Kg = (const bf16*)(ws + WS_KCMP) + (size_t)(b * 256) * 128 + g * 64; Vg = (const bf16*)(ws + WS_VCMP) + (size_t)(b * 256) * 128 + g * 64; pitch = 128; t_lo = 0; t_hi = (q0 + 32) >> 10; }
        else { const int kc = br == 2 ? ZC_KS : ZC_KW; Kg = ZA + (size_t)(b * SEQ) * ZA_LD + kc + g * 64; Vg = Kg + 128; pitch = ZA_LD; t_lo = (br == 3 && qt > 8) ? qt - 8 : 0; t_hi = qt; }
        const int kmul = iscmp ? 16 : 1, kadd = iscmp ? 31 : 0, dmax = br == 3 ? 512 : 0x40000000;
        f32x16 o[2]; o[0] = f32x16{}; o[1] = f32x16{};
        float m = NEGBIG, l = 0.f;
        u32x4 kreg, vreg = {0u, 0u, 0u, 0u};
#define NSA_GLOAD(kt_) do { const size_t off_ = (size_t)((kt_) * 64 + srow) * pitch + sch * 8; kreg = *(const u32x4*)(Kg + off_); if (!vmap) vreg = *(const u32x4*)(Vg + off_); } while (0)
#define NSA_LSTORE(kt_, buf_) do { \
        *(LAS u32x4*)(F.lds + NSA_K + (buf_) * 8192 + sch * 1024 + srow * 16) = kreg; \
        if (vmap) { const int c_ = (kt_) * 64 + srow, jj_ = c_ >> 2, mm_ = c_ & 3; \
            _Pragma("unroll") for (int i_ = 0; i_ < 4; ++i_) { const int j0_ = sch * 8 + 2 * i_, j1_ = j0_ + 1; \
                const unsigned e0_ = (c_ < NCMP) ? (mm_ < 3 ? (j0_ == jj_ ? 0x4000u : 0u) : ((j0_ == jj_ || j0_ == jj_ + 1) ? 0x3F80u : 0u)) : 0u; \
                const unsigned e1_ = (c_ < NCMP) ? (mm_ < 3 ? (j1_ == jj_ ? 0x4000u : 0u) : ((j1_ == jj_ || j1_ == jj_ + 1) ? 0x3F80u : 0u)) : 0u; \
                vreg[i_] = e0_ | (e1_ << 16); } } \
        *(LAS u32x4*)(F.lds + NSA_V + (buf_) * 8192 + (sch >> 2) * 4096 + srow * 64 + (sch & 3) * 16) = vreg; } while (0)
        __syncthreads();
        NSA_GLOAD(t_lo); NSA_LSTORE(t_lo, 0);
        __syncthreads();
        int buf = 0;
#pragma nounroll
        for (int kt = t_lo; kt <= t_hi; ++kt) {
            if (kt < t_hi) NSA_GLOAD(kt + 1);
            const bool selbit = br == 2 ? (((kt < 32 ? (mlo >> kt) : (mhi >> (kt - 32))) & 1u) != 0u) : true;
            nsa_tile(F.lds + NSA_K + buf * 8192, F.lds + NSA_V + buf * 8192, tbh, qr, o, m, l, kt, tq, kmul, kadd, dmax, selbit, r32, hi, F.lane);
            if (kt < t_hi) NSA_LSTORE(kt + 1, buf ^ 1);
            __syncthreads();
            buf ^= 1;
        }
#undef NSA_GLOAD
#undef NSA_LSTORE
        l += __shfl_xor(l, 32);
        const float inv = l > 0.f ? 1.0f / l : 0.f;
        if (br == 0) inv_cmp = inv;
        if (br != 1) { const float sc = inv * (br == 0 ? gate[0] : br == 2 ? gate[1] : gate[2]);
#pragma unroll
            for (int c = 0; c < 2; ++c)
#pragma unroll
                for (int r = 0; r < 16; ++r) { const float prev = br == 0 ? 0.f : ofw[(c * 16 + r) * 64]; ofw[(c * 16 + r) * 64] = prev + o[c][r] * sc; }
        } else {
            LAS float* scw = (LAS float*)(F.lds + NSA_SC) + F.wave * 512;
#pragma unroll
            for (int c = 0; c < 2; ++c)
#pragma unroll
                for (int r = 0; r < 16; ++r) { float v = o[c][r] * inv_cmp; v += __shfl_xor(v, 1); v += __shfl_xor(v, 2);
                    if (hh == 0) scw[qi * 64 + 32 * c + crow(r, hi)] = v; }
            LDS_WAIT();
            LAS unsigned* mskw = (LAS unsigned*)(F.lds + NSA_MSK) + F.wave * 16;
#pragma nounroll
            for (int q = 0; q < 8; ++q) {
                const int curq = (q0 + 8 * F.wave + q) >> 6, j = F.lane;
                const bool avail = j <= curq, forced = (j == 0) || (j == curq) || (j == curq - 1);
                const float sj = avail ? scw[q * 64 + j] + (forced ? 1e4f : 0.f) : NEGBIG;
                LDS_WAIT();
                scw[q * 64 + j] = sj;
                LDS_WAIT();
                int rank = 0;
#pragma unroll 4
                for (int j2 = 0; j2 < 64; ++j2) { const float s2 = scw[q * 64 + j2]; rank += (s2 > sj || (s2 == sj && j2 < j)) ? 1 : 0; }
                const bool sel = rank < 16 && avail;
                const unsigned long long bm = __ballot(sel);
                if (F.lane == 0) { mskw[2 * q] = (unsigned)bm; mskw[2 * q + 1] = (unsigned)(bm >> 32); } }
            LDS_WAIT();
            mlo = mskw[2 * qi]; mhi = mskw[2 * qi + 1];
        }
    }
    bf16* OA = (bf16*)(ws + WS_OA) + (size_t)(b * SEQ + tq) * 512 + head * 64;
#pragma unroll
    for (int c = 0; c < 2; ++c)
#pragma unroll
        for (int r4 = 0; r4 < 4; ++r4) { u32x2 w; w.x = pk2(ofw[(c * 16 + 4 * r4) * 64], ofw[(c * 16 + 4 * r4 + 1) * 64]); w.y = pk2(ofw[(c * 16 + 4 * r4 + 2) * 64], ofw[(c * 16 + 4 * r4 + 3) * 64]);
            *(u32x2*)(OA + 32 * c + 8 * r4 + 4 * hi) = w; }
}
__device__ __forceinline__ void phase3(const Frame& F) {
#pragma nounroll
    for (int p2 = 2 * F.bx; p2 < 1024; p2 += (p2 & 1) ? 2 * F.G - 1 : 1) { const int p = p2 >> 1, b = p >> 6, g = (p >> 5) & 1, qt = p & 31;
        nsa_unit(F, b, g, (p2 & 1) ? qt : 63 - qt); }
    __syncthreads();
}

#define MFMA16(a, b, c) __builtin_amdgcn_mfma_f32_16x16x32_bf16((a), (b), (c), 0, 0, 0)
constexpr int DSA_SCP = 8200;
constexpr int DSA_SC = 0;
constexpr int DSA_LIST = 16 * DSA_SCP;
constexpr int DSA_NSEL = DSA_LIST + 8192;
constexpr int DSA_BIAS = DSA_NSEL + 64;
constexpr int KSEL = 256;
__device__ __forceinline__ unsigned dsa_offb(unsigned row, unsigned ch) { return 256u * row + 16u * (ch ^ (((row & 3u) << 2) | ((row >> 2) & 3u))); }
__device__ __forceinline__ unsigned sortkey16(float x) { x = x + 0.0f; const unsigned short h = __builtin_bit_cast(unsigned short, (_Float16)x); return (h & 0x8000u) ? (unsigned)(unsigned short)~h : (unsigned)(h | 0x8000u); }
__device__ __forceinline__ int prefix_cnt(unsigned long long b) { return (int)__builtin_amdgcn_mbcnt_hi((unsigned)(b >> 32), __builtin_amdgcn_mbcnt_lo((unsigned)b, 0u)); }

__device__ __forceinline__ void dsa_unit(const Frame& F, const Args& a, int b, int qt16) {
    unsigned char* ws = F.ws;
    const bf16* ZA = (const bf16*)(ws + WS_ZA);
    const int lane = F.lane, l16 = lane & 15, quad = lane >> 4, q0 = qt16 * 16;
    __syncthreads();
    {
        const size_t qrow = (size_t)(b * SEQ + q0 + l16) * ZA_LD;
        bf16x8 qf[4][2];
#pragma unroll
        for (int i = 0; i < 4; ++i)
#pragma unroll
            for (int ks = 0; ks < 2; ++ks) qf[i][ks] = *(const bf16x8*)(ZA + qrow + ZC_QIDX + i * 64 + 32 * ks + 8 * quad);
        float wq[4];
#pragma unroll
        for (int i = 0; i < 4; ++i) wq[i] = bf2f(ZA[qrow + ZC_WIDX + i]) * 0.0625f;
        const int tq = q0 + l16, nkt = qt16 + 1;
        const bf16* kbase = ZA + (size_t)(b * SEQ + l16) * ZA_LD + ZC_KIDX + 8 * quad;
        bf16x8 ka0, ka1;
        int kt = F.wave;
        if (kt < nkt) { ka0 = *(const bf16x8*)(kbase + (size_t)(kt * 16) * ZA_LD); ka1 = *(const bf16x8*)(kbase + (size_t)(kt * 16) * ZA_LD + 32); }
#pragma nounroll
        for (; kt < nkt; kt += 8) {
            const bf16x8 c0 = ka0, c1 = ka1;
            if (kt + 8 < nkt) { ka0 = *(const bf16x8*)(kbase + (size_t)((kt + 8) * 16) * ZA_LD); ka1 = *(const bf16x8*)(kbase + (size_t)((kt + 8) * 16) * ZA_LD + 32); }
            float idx[4] = {0.f, 0.f, 0.f, 0.f};
#pragma unroll
            for (int i = 0; i < 4; ++i) { f32x4 acc = {0.f, 0.f, 0.f, 0.f}; acc = MFMA16(c0, qf[i][0], acc); acc = MFMA16(c1, qf[i][1], acc);
#pragma unroll
                for (int r = 0; r < 4; ++r) idx[r] += fmaxf(acc[r], 0.f) * wq[i]; }
            unsigned k16[4];
#pragma unroll
            for (int r = 0; r < 4; ++r) { const int key = kt * 16 + 4 * quad + r; k16[r] = key <= tq ? sortkey16(idx[r]) : 0u; }
            u32x2 w; w.x = k16[0] | (k16[1] << 16); w.y = k16[2] | (k16[3] << 16);
            *(LAS u32x2*)(F.lds + DSA_SC + l16 * DSA_SCP + (kt * 16 + 4 * quad) * 2) = w;
        }
    }
    if (F.tid < 256) { const float* rb = a.in[11]; ((LAS float*)(F.lds + DSA_BIAS))[F.tid] = rb[(F.tid >> 3) * 16 + 8 + (F.tid & 7)] * LOG2E; }
    __syncthreads();
#pragma nounroll
    for (int qq = 0; qq < 2; ++qq) {
        const int n = 2 * F.wave + qq, tq = q0 + n, N = tq + 1;
        LAS unsigned char* scq = F.lds + DSA_SC + n * DSA_SCP;
        LAS unsigned short* lst = (LAS unsigned short*)(F.lds + DSA_LIST) + n * 256;
        if (N <= KSEL) {
            for (int s = lane; s < KSEL; s += 64) lst[s] = (unsigned short)(s < N ? s : 0);
            if (lane == 0) ((LAS int*)(F.lds + DSA_NSEL))[n] = N;
        } else {
            const int nit = (N + 255) >> 8;
            { const int it = nit - 1; const int s0 = 4 * (lane + 64 * it); u32x2 w = *(LAS u32x2*)(scq + s0 * 2);
              if (s0 + 0 > tq) w.x &= 0xffff0000u; if (s0 + 1 > tq) w.x &= 0x0000ffffu; if (s0 + 2 > tq) w.y &= 0xffff0000u; if (s0 + 3 > tq) w.y &= 0x0000ffffu;
              *(LAS u32x2*)(scq + s0 * 2) = w; }
            LDS_WAIT();
            unsigned T = 0u;
#pragma nounroll
            for (int bit = 15; bit >= 0; --bit) { const unsigned cand = T | (1u << bit); int cnt = 0;
#pragma nounroll
                for (int it = 0; it < nit; ++it) { const u32x2 w = *(LAS u32x2*)(scq + (lane + 64 * it) * 8);
                    cnt += __popcll(__ballot((w.x & 0xffffu) >= cand)) + __popcll(__ballot((w.x >> 16) >= cand)) + __popcll(__ballot((w.y & 0xffffu) >= cand)) + __popcll(__ballot((w.y >> 16) >= cand)); }
                if (cnt >= KSEL) T = cand; }
            int cgt = 0;
#pragma nounroll
            for (int it = 0; it < nit; ++it) { const u32x2 w = *(LAS u32x2*)(scq + (lane + 64 * it) * 8);
                cgt += __popcll(__ballot((w.x & 0xffffu) > T)) + __popcll(__ballot((w.x >> 16) > T)) + __popcll(__ballot((w.y & 0xffffu) > T)) + __popcll(__ballot((w.y >> 16) > T)); }
            const int rties = KSEL - cgt;
            int tiebase = 0, outbase = 0;
#pragma nounroll
            for (int it = 0; it < nit; ++it) { const u32x2 w = *(LAS u32x2*)(scq + (lane + 64 * it) * 8);
                const unsigned k0 = w.x & 0xffffu, k1 = w.x >> 16, k2 = w.y & 0xffffu, k3 = w.y >> 16;
                const bool e0 = k0 == T, e1 = k1 == T, e2 = k2 == T, e3 = k3 == T;
                const unsigned long long be0 = __ballot(e0), be1 = __ballot(e1), be2 = __ballot(e2), be3 = __ballot(e3);
                const int tpre = tiebase + prefix_cnt(be0) + prefix_cnt(be1) + prefix_cnt(be2) + prefix_cnt(be3);
                const int t0 = tpre, t1 = t0 + (e0 ? 1 : 0), t2 = t1 + (e1 ? 1 : 0), t3 = t2 + (e2 ? 1 : 0);
                const bool s0 = k0 > T || (e0 && t0 < rties), s1 = k1 > T || (e1 && t1 < rties), s2 = k2 > T || (e2 && t2 < rties), s3 = k3 > T || (e3 && t3 < rties);
                const unsigned long long bs0 = __ballot(s0), bs1 = __ballot(s1), bs2 = __ballot(s2), bs3 = __ballot(s3);
                int pos = outbase + prefix_cnt(bs0) + prefix_cnt(bs1) + prefix_cnt(bs2) + prefix_cnt(bs3);
                const int sidx = 4 * (lane + 64 * it);
                if (s0) { if (pos < KSEL) lst[pos] = (unsigned short)(sidx + 0); ++pos; }
                if (s1) { if (pos < KSEL) lst[pos] = (unsigned short)(sidx + 1); ++pos; }
                if (s2) { if (pos < KSEL) lst[pos] = (unsigned short)(sidx + 2); ++pos; }
                if (s3) { if (pos < KSEL) lst[pos] = (unsigned short)(sidx + 3); ++pos; }
                tiebase += __popcll(be0) + __popcll(be1) + __popcll(be2) + __popcll(be3);
                outbase += __popcll(bs0) + __popcll(bs1) + __popcll(bs2) + __popcll(bs3); }
            if (lane == 0) ((LAS int*)(F.lds + DSA_NSEL))[n] = outbase < KSEL ? outbase : KSEL;
        }
    }
    __syncthreads();
    const bf16* CK = (const bf16*)(ws + WS_CKVN) + (size_t)(b * SEQ) * 128;
    LAS unsigned char* gb = F.lds + F.wave * 8192;
    const LAS float* biasb = (const LAS float*)(F.lds + DSA_BIAS);
#pragma nounroll
    for (int qq = 0; qq < 2; ++qq) {
        const int n = 2 * F.wave + qq, tq = q0 + n;
        const int nsel = ((const LAS int*)(F.lds + DSA_NSEL))[n];
        const LAS unsigned short* lst = (const LAS unsigned short*)(F.lds + DSA_LIST) + n * 256;
        bf16x8 ql[4];
#pragma unroll
        for (int s = 0; s < 4; ++s) { const bf16x8 v = *(const bf16x8*)(ZA + (size_t)(b * SEQ + tq) * ZA_LD + ZC_QLAT + (l16 & 7) * 128 + 32 * s + 8 * quad); ql[s] = l16 < 8 ? v : (bf16x8){0, 0, 0, 0, 0, 0, 0, 0}; }
        f32x4 o[8];
#pragma unroll
        for (int c = 0; c < 8; ++c) o[c] = (f32x4){0.f, 0.f, 0.f, 0.f};
        float m = NEGBIG, l = 0.f;
        const int nch = (nsel + 31) >> 5;
#pragma nounroll
        for (int ch = 0; ch < nch; ++ch) {
            LDS_WAIT();
#pragma unroll
            for (int i = 0; i < 8; ++i) { const int pid = lane + 64 * i, row = pid >> 4, c16 = pid & 15; const int e = ch * 32 + row; const int key = e < nsel ? (int)lst[e] : 0;
                const u32x4 v = *(const u32x4*)(CK + (size_t)key * 128 + c16 * 8);
                *(LAS u32x4*)(gb + dsa_offb(row, c16)) = v; }
            LDS_WAIT();
            float x[2][4]; float tmax = NEGBIG;
#pragma unroll
            for (int rb = 0; rb < 2; ++rb) { f32x4 acc = {0.f, 0.f, 0.f, 0.f};
#pragma unroll
                for (int s = 0; s < 4; ++s) { const bf16x8 af = *(const LAS bf16x8*)(gb + dsa_offb(rb * 16 + l16, 4 * s + quad)); acc = MFMA16(af, ql[s], acc); }
                const int e0 = ch * 32 + rb * 16 + 4 * quad;
                const u32x2 kp = *(const LAS u32x2*)((const LAS unsigned char*)lst + e0 * 2);
                const int kpos[4] = {(int)(kp.x & 0xffffu), (int)(kp.x >> 16), (int)(kp.y & 0xffffu), (int)(kp.y >> 16)};
#pragma unroll
                for (int r = 0; r < 4; ++r) { const int dist = tq - kpos[r]; const bool valid = (e0 + r) < nsel && dist >= 0;
                    int bk; if (dist < 16) bk = dist < 0 ? 0 : dist; else { bk = 16 + (int)((__log2f((float)dist) - 4.0f) * 2.66666675f); bk = bk > 31 ? 31 : bk; }
                    const float bv = biasb[bk * 8 + (l16 & 7)];
                    const float xv = valid ? acc[r] * C2 + bv : NEGBIG; x[rb][r] = xv; tmax = fmaxf(tmax, xv); } }
            tmax = fmaxf(tmax, __shfl_xor(tmax, 16)); tmax = fmaxf(tmax, __shfl_xor(tmax, 32));
            const float mn = fmaxf(m, tmax), alpha = __builtin_amdgcn_exp2f(m - mn); m = mn;
            float ps = 0.f;
#pragma unroll
            for (int rb = 0; rb < 2; ++rb)
#pragma unroll
                for (int r = 0; r < 4; ++r) { const float p = x[rb][r] > -1e29f ? __builtin_amdgcn_exp2f(x[rb][r] - mn) : 0.f; x[rb][r] = p; ps += p; }
            l = l * alpha + ps;
            u32x4 pw; pw.x = pk2(x[0][0], x[0][1]); pw.y = pk2(x[0][2], x[0][3]); pw.z = pk2(x[1][0], x[1][1]); pw.w = pk2(x[1][2], x[1][3]);
            const unsigned qd = (unsigned)(l16 >> 2), pp = (unsigned)(lane & 3);
#pragma unroll
            for (int c = 0; c < 8; ++c) {
                const s16x4 v0 = vtr(gb + dsa_offb(4 * quad + qd, 2 * c + (pp >> 1)) + 8 * (pp & 1)), v1 = vtr(gb + dsa_offb(16 + 4 * quad + qd, 2 * c + (pp >> 1)) + 8 * (pp & 1));
                const bf16x8 vf = {v0[0], v0[1], v0[2], v0[3], v1[0], v1[1], v1[2], v1[3]};
                o[c] = o[c] * alpha; o[c] = MFMA16(vf, __builtin_bit_cast(bf16x8, pw), o[c]); }
        }
        l += __shfl_xor(l, 16); l += __shfl_xor(l, 32);
        const float inv = l > 0.f ? 1.0f / l : 0.f;
        if (l16 < 8) { bf16* op = (bf16*)(ws + WS_OLAT) + (size_t)(b * SEQ + tq) * 1024 + l16 * 128 + 4 * quad;
#pragma unroll
            for (int c = 0; c < 8; ++c) { u32x2 w; w.x = pk2(o[c][0] * inv, o[c][1] * inv); w.y = pk2(o[c][2] * inv, o[c][3] * inv); *(u32x2*)(op + 16 * c) = w; } }
    }
}
__device__ __forceinline__ void phase4(const Frame& F, const Args& a) {
#pragma nounroll
    for (int p2 = 2 * F.bx; p2 < 2048; p2 += (p2 & 1) ? 2 * F.G - 1 : 1) { const int p = p2 >> 1, b = p >> 7, j = p & 127;
        dsa_unit(F, a, b, (p2 & 1) ? j : 255 - j); }
    __syncthreads();
}

constexpr int NPHASE = 11;
__global__ void __launch_bounds__(NTHR, 2) fwd_kernel(Args args) {
    extern __shared__ __attribute__((aligned(16))) unsigned char lds_raw[];
    Frame F;
    F.lds = (LAS unsigned char*)lds_raw;
    F.tid = threadIdx.x; F.lane = F.tid & 63; F.wave = __builtin_amdgcn_readfirstlane(F.tid >> 6);
    F.G = gridDim.x; F.bx = blockIdx.x; F.ws = args.ws;
    unsigned char* ws = args.ws;
    volatile LAS unsigned* MISC = (volatile LAS unsigned*)(F.lds + MISC_OFF);
    if (F.tid < 64) MISC[F.tid] = 0u;
    __syncthreads();
    const int lo = args.ph_lo, hi = args.ph_hi;
    XcdBarrier bar; bar.bar = (unsigned*)(ws + WS_CTL) + CW_BAR; bar.x = 0; bar.st = nullptr;
    if (hi - lo > 1) bar = xcd_barrier_post((unsigned*)(ws + WS_CTL) + CW_BAR, MISC + 8);
#ifndef PH_MASK
#define PH_MASK 0xFFFF
#endif
#define IN(k) ((((PH_MASK) >> (k)) & 1) && lo <= (k) && (k) < hi)
#define SEAM(k) do { if (IN(k) && IN((k) + 1)) xcd_barrier(bar); } while (0)

    if (IN(0)) { phase0(F, args); }
    SEAM(0);
    if (IN(1)) {
        pg8::StaticOrder S; S.init(NTOK / 256, NZ / 256, F.G, F.bx);
        const APlain AA{ws + WS_XB, 128u, (unsigned)(D * 2)}; const BPlain BA{(const bf16*)(ws + WS_WINT), D};
        const EpiZ E{(bf16*)(ws + WS_ZA), (bf16*)(ws + WS_ZG)};
        pg8::gemm_phase(F.lds, D, S, AA, BA, E);
    }
    SEAM(1);
    if (IN(2)) { phase2(F, args); }
    SEAM(2);
    if (IN(3)) { phase3(F); }
    if (IN(4)) { phase4(F, args); }
    SEAM(4);
    if (IN(5)) {
        pg8::StaticOrder S; S.init(NTOK / 256, D / 256, F.G, F.bx);
        { const APlain AA{ws + WS_OA, 128u, 1024u}; const BPlain BA{(const bf16*)(ws + WS_WAT), 512};
          const EpiGate<0> E{(const bf16*)(ws + WS_ZG), nullptr, (bf16*)(ws + WS_T1)};
          pg8::gemm_phase(F.lds, 512, S, AA, BA, E); }
        { const APlain AA{ws + WS_OLAT, 128u, 2048u}; const BPlain BA{(const bf16*)(ws + WS_WBT), 1024};
          const EpiGate<1> E{(const bf16*)(ws + WS_ZG), (const bf16*)(ws + WS_T1), (bf16*)(ws + WS_MERGED)};
          pg8::gemm_phase(F.lds, 1024, S, AA, BA, E); }
    }
    SEAM(5);
    if (IN(6)) {
        pg8::StaticOrder S; S.init(NTOK / 256, D / 256, F.G, F.bx);
        const APlain AA{ws + WS_MERGED, 128u, 2048u}; const BPlain BA{(const bf16*)(ws + WS_WOT), 1024};
        const EpiRes E{args.in[0], (float*)(ws + WS_H1)};
        pg8::gemm_phase(F.lds, 1024, S, AA, BA, E);
    }
    SEAM(6);
    if (IN(7)) { phase6(F, args); }
    SEAM(7);
    if (IN(8)) {
        moe_setup(F);
        const MoeOrder S{F.G, F.bx, 2, (const LAS int*)(F.lds + MOE_CUM), (const LAS int*)(F.lds + MOE_CUM) + 40};
        const AGather AA{ws + WS_H1B, 128u, (const int*)(ws + WS_LIST)}; const BGu BA{(const bf16*)(ws + WS_WGU)};
        const EpiAct E{(bf16*)(ws + WS_ACT)};
        pg8::gemm_phase(F.lds, 1024, S, AA, BA, E);
    }
    SEAM(8);
    if (IN(9)) {
        moe_setup(F);
        const MoeOrder S{F.G, F.bx, 4, (const LAS int*)(F.lds + MOE_CUM), (const LAS int*)(F.lds + MOE_CUM) + 40};
        const APlain AA{ws + WS_ACT, 128u, 512u}; const BDn BA{(const bf16*)(ws + WS_WDT)};
        const EpiDown E{(bf16*)(ws + WS_YBUF), (const int*)(ws + WS_LIST)};
        pg8::gemm_phase(F.lds, 256, S, AA, BA, E);
    }
    SEAM(9);
    if (IN(10)) { phase9(F, args); }
#undef IN
#undef SEAM
}

extern "C" void kernel_launch(void* const* d_in, const int* in_sizes, int n_in, void* d_out, int out_size, void* d_ws, size_t ws_size, hipStream_t stream) {
    static int grid = 0;
    if (grid == 0) {
        if (n_in != 26 || in_sizes[0] != NTOK * D || out_size != NTOK * D || ws_size < WS_END) {
            fprintf(stderr, "kernel_launch: unexpected problem: n_in %d in0 %d out %d ws %zu (need %zu)\n", n_in, n_in > 0 ? in_sizes[0] : -1, out_size, ws_size, (size_t)WS_END); grid = -1; return; }
        int dev = 0, cus = 0, per_cu = 0;
        if (hipGetDevice(&dev) != hipSuccess || hipDeviceGetAttribute(&cus, hipDeviceAttributeMultiprocessorCount, dev) != hipSuccess) { grid = -1; return; }
        if (hipFuncSetAttribute((const void*)fwd_kernel, hipFuncAttributeMaxDynamicSharedMemorySize, LDS_BYTES) != hipSuccess) { fprintf(stderr, "kernel_launch: hipFuncSetAttribute failed\n"); grid = -1; return; }
        if (hipOccupancyMaxActiveBlocksPerMultiprocessor(&per_cu, (const void*)fwd_kernel, NTHR, LDS_BYTES) != hipSuccess || per_cu < 1)
            fprintf(stderr, "kernel_launch: occupancy query reports %d\n", per_cu);
        (void)hipGetLastError();
        grid = cus;
    }
    if (grid < 0) return;
    if (hipMemsetAsync((char*)d_ws + WS_CTL, 0, CTL_ZERO_BYTES, stream) != hipSuccess) return;
    Args a{};
    for (int i = 0; i < 26; ++i) a.in[i] = (const float*)d_in[i];
    a.out = (float*)d_out; a.ws = (unsigned char*)d_ws;
#if MK_PER_PHASE
    for (int p = 0; p < NPHASE; ++p) { a.ph_lo = p; a.ph_hi = p + 1; hipLaunchKernelGGL(fwd_kernel, dim3(grid), dim3(NTHR), LDS_BYTES, stream, a); }
#else
    a.ph_lo = 0; a.ph_hi = NPHASE;
    hipLaunchKernelGGL(fwd_kernel, dim3(grid), dim3(NTHR), LDS_BYTES, stream, a);
#endif
}
```

```cpp
#include <hip/hip_runtime.h>
#include <cstdio>
#include <cstdint>

#ifndef MK_PER_PHASE
#define MK_PER_PHASE 0
#endif

#define GAS __attribute__((address_space(1)))
#define LAS __attribute__((address_space(3)))
typedef unsigned short bf16;
typedef short bf16x8 __attribute__((ext_vector_type(8)));
typedef short s16x4 __attribute__((ext_vector_type(4)));
typedef float f32x4 __attribute__((ext_vector_type(4)));
typedef float f32x16 __attribute__((ext_vector_type(16)));
typedef float f32x2 __attribute__((ext_vector_type(2)));
typedef unsigned u32x4 __attribute__((ext_vector_type(4)));
typedef unsigned u32x2 __attribute__((ext_vector_type(2)));

constexpr int D = 1024, BATCH = 8, SEQ = 4096, NTOK = BATCH * SEQ;
constexpr int D_IN = 4316;
constexpr int NCMP = 255;
constexpr float ALPHA = 1.189207115002721f;
constexpr float LOG2E = 1.4426950408889634f;
constexpr float NEGBIG = -1e30f;
constexpr int ZA_LD = 2816;
constexpr int ZC_QA = 0, ZC_KC = 512, ZC_VC = 640, ZC_KS = 768, ZC_VS = 896, ZC_KW = 1024, ZC_VW = 1152, ZC_QLAT = 1280, ZC_CKV = 2304,
              ZC_QIDX = 2432, ZC_KIDX = 2688, ZC_GNSA = 2752, ZC_WIDX = 2776;
constexpr int ZG_LD = 2048;
constexpr int NZ = ZA_LD + ZG_LD;
constexpr int NEXP = 32, DEXP = 256;
constexpr int MAXTILES = (2 * NTOK) / 256 + NEXP;

constexpr size_t MiB = 1u << 20;
constexpr size_t WS_CTL = 0, CTL_ZERO_BYTES = 1 * MiB;
constexpr size_t WS_WAT = 1 * MiB;
constexpr size_t WS_WBT = 2 * MiB;
constexpr size_t WS_WOT = 4 * MiB;
constexpr size_t WS_W1K = 6 * MiB;
constexpr size_t WS_W1V = 7 * MiB;
constexpr size_t WS_W2K = 8 * MiB;
constexpr size_t WS_W2V = 8 * MiB + 64 * 1024;
constexpr size_t WS_BIASK = 8 * MiB + 128 * 1024;
constexpr size_t WS_TBA = 8 * MiB + 256 * 1024;
constexpr size_t WS_TBB = 8 * MiB + 320 * 1024;
constexpr size_t WS_KCMP = 9 * MiB;
constexpr size_t WS_VCMP = 9 * MiB + 512 * 1024;
constexpr size_t WS_TOKINFO = 10 * MiB;
constexpr size_t WS_LIST = 11 * MiB;
constexpr size_t WS_WINT = 16 * MiB;
constexpr size_t WS_WGU = 32 * MiB;
constexpr size_t WS_WDT = 64 * MiB;
constexpr size_t WS_CKVN = 80 * MiB;
constexpr size_t WS_XB = 96 * MiB;
constexpr size_t WS_OLAT = 96 * MiB;
constexpr size_t WS_H1B = 96 * MiB;
constexpr size_t WS_ZA = 160 * MiB;
constexpr size_t WS_T1 = 160 * MiB;
constexpr size_t WS_ACT = 160 * MiB;
constexpr size_t WS_YBUF = 196 * MiB;
constexpr size_t WS_MERGED = 224 * MiB;
constexpr size_t WS_ZG = 336 * MiB;
constexpr size_t WS_H1 = 336 * MiB;
constexpr size_t WS_OA = 464 * MiB;
constexpr size_t WS_END = 496 * MiB;

constexpr int CW_BAR = 4096;
constexpr int CW_CNT = 16384;

constexpr int LDS_BYTES = 163840;
constexpr int MISC_OFF = 160 * 1024 - 256;

__device__ __forceinline__ unsigned f2bf(float f) { unsigned u = __builtin_bit_cast(unsigned, f); return (u + 0x7fffu + ((u >> 16) & 1u)) >> 16; }
__device__ __forceinline__ unsigned pk2(float lo, float hi) { unsigned r; asm volatile("v_cvt_pk_bf16_f32 %0, %1, %2" : "=v"(r) : "v"(lo), "v"(hi)); return r; }
__device__ __forceinline__ float bf2f(unsigned short b) { return __builtin_bit_cast(float, ((unsigned)b) << 16); }
__device__ __forceinline__ float bflo(unsigned w) { return __builtin_bit_cast(float, w << 16); }
__device__ __forceinline__ float bfhi(unsigned w) { return __builtin_bit_cast(float, w & 0xffff0000u); }
__device__ __forceinline__ float wave_sum(float v) {
#pragma unroll
    for (int o = 1; o < 64; o <<= 1) v += __shfl_xor(v, o);
    return v;
}
__device__ __forceinline__ float sigmoidf_(float x) { return 1.0f / (1.0f + __expf(-x)); }
#define LDS_WAIT() asm volatile("s_waitcnt lgkmcnt(0)" ::: "memory")
#define VM_WAIT() asm volatile("s_waitcnt vmcnt(0)" ::: "memory")

#define XB_TMO      128
#define XB_XCNT(j)  (256  + 64 * (j))
#define XB_XSUB(j)  (1280 + 64 * (j))
#define XB_XGEN(j)  (2304 + 64 * (j))
#define XB_TOP      3328
#define XB_TOPGEN   3392
#define XCD_BAR_WORDS 3456
#define XB_SPIN_CAP (1u << 18)
__device__ __forceinline__ unsigned xb_ld(unsigned* p)              { return __hip_atomic_load(p, __ATOMIC_RELAXED, __HIP_MEMORY_SCOPE_AGENT); }
__device__ __forceinline__ unsigned xb_add(unsigned* p, unsigned v) { return __hip_atomic_fetch_add(p, v, __ATOMIC_RELAXED, __HIP_MEMORY_SCOPE_AGENT); }
__device__ __forceinline__ unsigned xb_xcc_id() { return (unsigned)__builtin_amdgcn_s_getreg((3 << 11) | 20) & 0xFu; }
#define XB_SPIN(cond, bar) do { unsigned _sp = 0; while (cond) { __builtin_amdgcn_s_sleep(1); \
    if ((++_sp & 255u) == 0u) { if (xb_ld(&(bar)[XB_TMO])) break; if (_sp > XB_SPIN_CAP) { atomicAdd(&(bar)[XB_TMO], 1u); break; } } } } while (0)
struct XcdBarrier { unsigned* bar; unsigned x; volatile LAS unsigned* st; };
__device__ __forceinline__ XcdBarrier xcd_barrier_post(unsigned* bar, volatile LAS unsigned* st) {
    XcdBarrier b; b.bar = bar; b.x = xb_xcc_id(); b.st = st;
    if (threadIdx.x == 0) (void)xb_add(&bar[XB_XCNT(b.x)], 1u);
    return b;
}
__device__ __forceinline__ void xcd_barrier_complete(unsigned* bar, unsigned x, unsigned& nloc, unsigned& nx) {
    const unsigned G = gridDim.x * gridDim.y * gridDim.z;
    unsigned sum, cnt, mine, sp = 0u;
    for (;;) {
        sum = 0u; cnt = 0u; mine = 0u;
#pragma unroll
        for (unsigned j = 0; j < 16; ++j) { const unsigned c = xb_ld(&bar[XB_XCNT(j)]); sum += c; cnt += (c > 0u) ? 1u : 0u; mine = (j == x) ? c : mine; }
        if (sum == G) break;
        __builtin_amdgcn_s_sleep(1);
        if ((++sp & 255u) == 0u) { if (xb_ld(&bar[XB_TMO])) break; if (sp > XB_SPIN_CAP) { atomicAdd(&bar[XB_TMO], 1u); break; } }
    }
    nloc = mine > 0u ? mine : 1u; nx = cnt > 0u ? cnt : 1u;
}
__device__ __forceinline__ void xcd_barrier(const XcdBarrier& b) {
    asm volatile("s_waitcnt vmcnt(0)" ::: "memory");
    __syncthreads();
    if (threadIdx.x == 0) {
        unsigned* bar = b.bar;
        __builtin_amdgcn_s_waitcnt(0);
        unsigned nloc = b.st[0], nx = b.st[1];
        if (nloc == 0u) { xcd_barrier_complete(bar, b.x, nloc, nx); b.st[0] = nloc; b.st[1] = nx; }
        const unsigned old = xb_add(&bar[XB_XSUB(b.x)], 1u);
        const unsigned gen = old / nloc;
        if (old + 1u == (gen + 1u) * nloc) {
            __builtin_amdgcn_fence(__ATOMIC_RELEASE, "agent");
            asm volatile("s_waitcnt vmcnt(0)" ::: "memory");
            const unsigned og = xb_add(&bar[XB_TOP], 1u);
            const unsigned tg = og / nx;
            if (og + 1u == (tg + 1u) * nx) xb_add(&bar[XB_TOPGEN], 1u);
            else XB_SPIN(xb_ld(&bar[XB_TOPGEN]) == tg, bar);
            __builtin_amdgcn_fence(__ATOMIC_ACQUIRE, "agent");
            xb_add(&bar[XB_XGEN(b.x)], 1u);
            asm volatile("s_waitcnt vmcnt(0)" ::: "memory");
        } else {
            XB_SPIN(xb_ld(&bar[XB_XGEN(b.x)]) == gen, bar);
            __builtin_amdgcn_fence(__ATOMIC_ACQUIRE, "agent");
            asm volatile("s_waitcnt vmcnt(0)" ::: "memory");
        }
    }
    __syncthreads();
}

namespace pg8 {
constexpr int BM = 256, BK = 64, HALF = 128, HTB = HALF * BK * 2, STAGE_BYTES = 8 * HTB, NXCD = 8, WGM = 8;
__host__ __device__ __forceinline__ int lds_byte(int r, int c) { const int st = (r >> 4) * 2 + (c >> 5), rr = r & 15, cc = c & 31, ob = rr * 64 + cc * 2; return st * 1024 + (ob ^ (((ob >> 9) & 1) << 5)); }
__host__ __device__ __forceinline__ void stage_rc(int b, int& R, int& C) { const int st = b / 1024, sb = b % 1024, swz = sb ^ (((sb >> 9) & 1) << 5); R = (st >> 1) * 16 + swz / 64; C = (st & 1) * 32 + (swz % 64) / 2; }
__host__ __device__ __forceinline__ int perm32(int rho) { const int n = rho >> 4, i = rho & 15; return 8 * (i >> 2) + 4 * n + (i & 3); }
struct Unit { int pm, pn, e, nrows; };
struct StaticOrder {
    int nM, nN, nwg, G, c;
    __device__ void init(int nM_, int nN_, int G_, int c_) { nM = nM_; nN = nN_; nwg = nM * nN; G = G_; c = c_; }
    __device__ bool next(int i, Unit& u) const {
        const long L = (long)i * G + c; if (L >= nwg) return false;
        int wgid = (int)L; { const int q = nwg / NXCD, r = nwg % NXCD, xcd = wgid % NXCD, off = wgid / NXCD; wgid = (xcd < r ? xcd * (q + 1) : r * (q + 1) + (xcd - r) * q) + off; }
        const int nig = WGM * nN, gid = wgid / nig, fm = gid * WGM, gsz = (nM - fm) < WGM ? (nM - fm) : WGM;
        u.pm = fm + ((wgid % nig) % gsz); u.pn = (wgid % nig) / gsz; u.e = 0; u.nrows = 256; return true;
    }
};

template <class Epi, class Sched, class AAddr, class BAddr>
__device__ __forceinline__ void gemm_phase(LAS unsigned char* lds, const int K, const Sched& S, const AAddr& AA, const BAddr& BA, const Epi& E) {
    constexpr bool GA = AAddr::GATHER;
    const int tid = threadIdx.x, wid = __builtin_amdgcn_readfirstlane(tid >> 6), lane = tid & 63, wr = wid >> 2, wc = wid & 3, fr = lane & 15, fq = lane >> 4;
    const int nt = K / BK;
    unsigned voffA[2], voffB[2];
#pragma unroll
    for (int i = 0; i < 2; ++i) { int R, C; stage_rc(tid * 16 + i * 8192, R, C); const int Rb = Epi::PERM ? ((R & ~31) + perm32(R & 31)) : R;
        voffA[i] = GA ? 0u : AA.lane_off(R, C); voffB[i] = (unsigned)(Rb * K + C) * 2u; }
    const size_t kstepA = (size_t)AA.kstep, kstepB = (size_t)(BK * 2);
    const size_t hstepB = (size_t)HALF * K * 2, hstepA = GA ? 0 : AA.hstep();
    const unsigned ldsw = (unsigned)wid * 1024u;
    const int aoff = lds_byte(wr * 64 + fr, fq * 8), boff = lds_byte(wc * 32 + fr, fq * 8);
#define PG8_SA(b, h) (((b) * 2 + (h)) * HTB)
#define PG8_SB(b, h) ((4 + (b) * 2 + (h)) * HTB)
#define PG8_STAGE(bufoff, gbase, voff) do { _Pragma("unroll") for (int _i = 0; _i < 2; ++_i) \
        __builtin_amdgcn_global_load_lds((const unsigned*)((const char*)(gbase) + (voff)[_i]), (LAS unsigned*)(lds + (bufoff) + ldsw + _i * 8192), 16, 0, 0); } while (0)
#define PG8_STA_CUR(bufoff, h, kb) do { if constexpr (GA) { if (h) PG8_STAGE(bufoff, baseA + (kb), cof1); else PG8_STAGE(bufoff, baseA + (kb), cof0); } \
        else PG8_STAGE(bufoff, cA + (h) * hstepA + (kb), voffA); } while (0)
#define PG8_STA_SEL(bufoff, h, kb) do { if constexpr (GA) { if (h) PG8_STAGE(bufoff, baseA + (kb), sof1); else PG8_STAGE(bufoff, baseA + (kb), sof0); } \
        else PG8_STAGE(bufoff, sA + (h) * hstepA + (kb), voffA); } while (0)
#define PG8_LDA(dst, b, h) do { _Pragma("unroll") for (int m = 0; m < 4; ++m) _Pragma("unroll") for (int k = 0; k < 2; ++k) dst[m][k] = *(const LAS bf16x8*)(lds + PG8_SA(b, h) + aoff + m * 2048 + k * 1024); } while (0)
#define PG8_LDB(dst, b, h) do { _Pragma("unroll") for (int n = 0; n < 2; ++n) _Pragma("unroll") for (int k = 0; k < 2; ++k) dst[n][k] = *(const LAS bf16x8*)(lds + PG8_SB(b, h) + boff + n * 2048 + k * 1024); } while (0)
#define PG8_MMA(ai, bj, At, Bt) do { __builtin_amdgcn_s_setprio(1); _Pragma("unroll") for (int m = 0; m < 4; ++m) _Pragma("unroll") for (int n = 0; n < 2; ++n) _Pragma("unroll") for (int k = 0; k < 2; ++k) \
        acc[ai][bj][m][n] = __builtin_amdgcn_mfma_f32_16x16x32_bf16(Bt[n][k], At[m][k], acc[ai][bj][m][n], 0, 0, 0); __builtin_amdgcn_s_setprio(0); } while (0)
#define PG8_WAIT_V(n) asm volatile("s_waitcnt vmcnt(" #n ")" ::: "memory")
#define PG8_WAIT_L(n) asm volatile("s_waitcnt lgkmcnt(" #n ")" ::: "memory")
#define PG8_BAR __builtin_amdgcn_s_barrier()
#define PG8_SCHED __builtin_amdgcn_sched_barrier(0)
#define PG8_GOFF(u, o0, o1) do { _Pragma("unroll") for (int _i = 0; _i < 2; ++_i) { int R_, C_; stage_rc(tid * 16 + _i * 8192, R_, C_); \
        o0[_i] = AA.row_off(u, R_) + (unsigned)C_ * 2u; o1[_i] = AA.row_off(u, R_ + HALF) + (unsigned)C_ * 2u; } } while (0)
    Unit cur, nxt; int ui = 0;
    if (!S.next(0, cur)) return;
    f32x4 acc[2][2][4][2];
#pragma unroll
    for (int a = 0; a < 2; ++a)
#pragma unroll
        for (int b = 0; b < 2; ++b)
#pragma unroll
            for (int m = 0; m < 4; ++m)
#pragma unroll
                for (int n = 0; n < 2; ++n) acc[a][b][m][n] = (f32x4){0.f, 0.f, 0.f, 0.f};
    bf16x8 At[4][2], B0[2][2], B1[2][2];
    const char* const baseA = GA ? (const char*)AA.base : nullptr;
    const char* cA = GA ? nullptr : (const char*)AA.unit_ptr(cur);
    unsigned cof0[2] = {0u, 0u}, cof1[2] = {0u, 0u}, nof0[2] = {0u, 0u}, nof1[2] = {0u, 0u};
    if constexpr (GA) PG8_GOFF(cur, cof0, cof1);
    const char* cB = (const char*)BA.ptr(cur);
    PG8_STAGE(PG8_SB(0, 0), cB, voffB); PG8_STA_CUR(PG8_SA(0, 0), 0, 0); PG8_STAGE(PG8_SB(0, 1), cB + hstepB, voffB); PG8_STA_CUR(PG8_SA(0, 1), 1, 0);
    if (wr == 1) PG8_BAR;
    PG8_WAIT_V(4); PG8_BAR;
    PG8_STAGE(PG8_SB(1, 0), cB + kstepB, voffB); PG8_STA_CUR(PG8_SA(1, 0), 0, kstepA); PG8_STAGE(PG8_SB(1, 1), cB + hstepB + kstepB, voffB);
    PG8_WAIT_V(6); PG8_BAR;
    for (;;) {
        const bool has_next = S.next(ui + 1, nxt);
        const char* nB = cB; const char* nA = cA;
        if (has_next) { nB = (const char*)BA.ptr(nxt); if constexpr (GA) PG8_GOFF(nxt, nof0, nof1); else nA = (const char*)AA.unit_ptr(nxt); }
        else { if constexpr (GA) {
#pragma unroll
            for (int i = 0; i < 2; ++i) { nof0[i] = cof0[i]; nof1[i] = cof1[i]; } } }
#pragma nounroll
        for (int t = 0; t < nt; t += 2) {
            const bool last = (t == nt - 2);
            const size_t k1 = (size_t)(t + 1) * kstepA, k2 = last ? 0 : (size_t)(t + 2) * kstepA, k3 = k2 + kstepA;
            const char* b2 = last ? nB : cB + (size_t)(t + 2) * kstepB; const char* b3 = b2 + kstepB;
            const char* sA = last ? nA : cA;
            unsigned sof0[2], sof1[2];
#pragma unroll
            for (int i = 0; i < 2; ++i) { sof0[i] = last ? nof0[i] : cof0[i]; sof1[i] = last ? nof1[i] : cof1[i]; }
            PG8_LDB(B0, 0, 0); PG8_SCHED; PG8_LDA(At, 0, 0); PG8_STA_CUR(PG8_SA(1, 1), 1, k1);
            PG8_WAIT_L(8); PG8_BAR; PG8_WAIT_L(0); PG8_MMA(0, 0, At, B0); PG8_BAR; PG8_SCHED;
            PG8_LDB(B1, 0, 1); PG8_STAGE(PG8_SB(0, 0), b2, voffB);
            PG8_BAR; PG8_WAIT_L(0); PG8_MMA(0, 1, At, B1); PG8_BAR;
            PG8_LDA(At, 0, 1); PG8_STA_SEL(PG8_SA(0, 0), 0, k2);
            PG8_BAR; PG8_WAIT_L(0); PG8_MMA(1, 0, At, B0); PG8_BAR; PG8_SCHED;
            PG8_STAGE(PG8_SB(0, 1), b2 + hstepB, voffB);
            PG8_WAIT_V(6); PG8_BAR; PG8_MMA(1, 1, At, B1); PG8_BAR;
            PG8_LDB(B0, 1, 0); PG8_SCHED; PG8_LDA(At, 1, 0); PG8_STA_SEL(PG8_SA(0, 1), 1, k2);
            PG8_WAIT_L(8); PG8_BAR; PG8_WAIT_L(0); PG8_MMA(0, 0, At, B0); PG8_BAR; PG8_SCHED;
            PG8_LDB(B1, 1, 1); PG8_STAGE(PG8_SB(1, 0), b3, voffB);
            PG8_BAR; PG8_WAIT_L(0); PG8_MMA(0, 1, At, B1); PG8_BAR;
            PG8_LDA(At, 1, 1); PG8_STA_SEL(PG8_SA(1, 0), 0, k3);
            PG8_BAR; PG8_WAIT_L(0); PG8_MMA(1, 0, At, B0); PG8_BAR; PG8_SCHED;
            PG8_STAGE(PG8_SB(1, 1), b3 + hstepB, voffB);
            PG8_WAIT_V(6); PG8_BAR; PG8_MMA(1, 1, At, B1); PG8_BAR;
        }
        E(acc, cur, wr, wc, fr, fq);
        if (!has_next) break;
#pragma unroll
        for (int a = 0; a < 2; ++a)
#pragma unroll
            for (int b = 0; b < 2; ++b)
#pragma unroll
                for (int m = 0; m < 4; ++m)
#pragma unroll
                    for (int n = 0; n < 2; ++n) acc[a][b][m][n] = (f32x4){0.f, 0.f, 0.f, 0.f};
        cur = nxt; cB = nB; cA = nA; ++ui;
        if constexpr (GA) {
#pragma unroll
            for (int i = 0; i < 2; ++i) { cof0[i] = nof0[i]; cof1[i] = nof1[i]; } }
    }
    PG8_WAIT_V(0);
    if (wr == 0) PG8_BAR;
    PG8_BAR;
#undef PG8_SA
#undef PG8_SB
#undef PG8_STAGE
#undef PG8_STA_CUR
#undef PG8_STA_SEL
#undef PG8_GOFF
#undef PG8_LDA
#undef PG8_LDB
#undef PG8_MMA
#undef PG8_WAIT_V
#undef PG8_WAIT_L
#undef PG8_BAR
#undef PG8_SCHED
}
}

constexpr int NWAVES = 8, NTHR = 512;
struct Args { const float* in[26]; float* out; unsigned char* ws; int ph_lo, ph_hi; unsigned repmask; int pad; };
struct Frame {
    LAS unsigned char* lds;
    int tid, lane, wave, G, bx;
    unsigned char* ws;
};

struct APlain { const void* base; unsigned kstep; unsigned ld2;
    static constexpr bool GATHER = false;
    __device__ __forceinline__ const void* unit_ptr(const pg8::Unit& u) const { return (const char*)base + (size_t)u.pm * 256 * ld2; }
    __device__ __forceinline__ unsigned lane_off(int R, int C) const { return (unsigned)R * ld2 + (unsigned)C * 2u; }
    __device__ __forceinline__ size_t hstep() const { return (size_t)128 * ld2; }
    __device__ __forceinline__ unsigned row_off(const pg8::Unit&, int) const { return 0u; } };
struct BPlain { const bf16* Bt; int K;
    __device__ __forceinline__ const void* ptr(const pg8::Unit& u) const { return Bt + (size_t)u.pn * 256 * K; } };

struct EpiZ {
    static constexpr bool PERM = true;
    bf16* ZA; bf16* ZG;
    __device__ __forceinline__ void operator()(const f32x4 (&acc)[2][2][4][2], const pg8::Unit& u, int wr, int wc, int fr, int fq) const {
        const bool gate = u.pn >= 11;
        bf16* base = gate ? ZG : ZA; const int ld = gate ? ZG_LD : ZA_LD; const int colt = gate ? (u.pn - 11) * 256 : u.pn * 256;
        const int row0 = u.pm * 256 + wr * 64 + fr, col0 = colt + wc * 32 + 8 * fq;
#pragma unroll
        for (int ai = 0; ai < 2; ++ai)
#pragma unroll
            for (int m = 0; m < 4; ++m) { bf16* rowp = base + (size_t)(row0 + ai * 128 + m * 16) * ld + col0;
#pragma unroll
                for (int bj = 0; bj < 2; ++bj) { f32x4 v0 = acc[ai][bj][m][0], v1 = acc[ai][bj][m][1];
                    if (gate) {
#pragma unroll
                        for (int j = 0; j < 4; ++j) { v0[j] = sigmoidf_(v0[j]); v1[j] = sigmoidf_(v1[j]); } }
                    u32x4 w; w.x = pk2(v0[0], v0[1]); w.y = pk2(v0[2], v0[3]); w.z = pk2(v1[0], v1[1]); w.w = pk2(v1[2], v1[3]);
                    *(u32x4*)(rowp + bj * 128) = w; } }
    }
};
template <int MODE> struct EpiGate {
    static constexpr bool PERM = true;
    const bf16* ZG; const bf16* T1; bf16* O;
    __device__ __forceinline__ void operator()(const f32x4 (&acc)[2][2][4][2], const pg8::Unit& u, int wr, int wc, int fr, int fq) const {
        const int row0 = u.pm * 256 + wr * 64 + fr, col0 = u.pn * 256 + wc * 32 + 8 * fq;
#pragma unroll
        for (int ai = 0; ai < 2; ++ai)
#pragma unroll
            for (int m = 0; m < 4; ++m) { const size_t r = (size_t)(row0 + ai * 128 + m * 16);
#pragma unroll
                for (int bj = 0; bj < 2; ++bj) { const int c = col0 + bj * 128;
                    const u32x4 g = *(const u32x4*)(ZG + r * ZG_LD + MODE * 1024 + c);
                    f32x4 v0 = acc[ai][bj][m][0], v1 = acc[ai][bj][m][1];
                    float o[8] = { v0[0] * bflo(g.x), v0[1] * bfhi(g.x), v0[2] * bflo(g.y), v0[3] * bfhi(g.y), v1[0] * bflo(g.z), v1[1] * bfhi(g.z), v1[2] * bflo(g.w), v1[3] * bfhi(g.w) };
                    if (MODE == 1) { const u32x4 t = *(const u32x4*)(T1 + r * 1024 + c);
                        o[0] += bflo(t.x); o[1] += bfhi(t.x); o[2] += bflo(t.y); o[3] += bfhi(t.y); o[4] += bflo(t.z); o[5] += bfhi(t.z); o[6] += bflo(t.w); o[7] += bfhi(t.w); }
                    u32x4 w; w.x = pk2(o[0], o[1]); w.y = pk2(o[2], o[3]); w.z = pk2(o[4], o[5]); w.w = pk2(o[6], o[7]);
                    *(u32x4*)(O + r * 1024 + c) = w; } }
    }
};
struct EpiRes {
    static constexpr bool PERM = false;
    const float* X; float* O;
    __device__ __forceinline__ void operator()(const f32x4 (&acc)[2][2][4][2], const pg8::Unit& u, int wr, int wc, int fr, int fq) const {
        const int row0 = u.pm * 256 + wr * 64 + fr, col0 = u.pn * 256 + wc * 32 + 4 * fq;
#pragma unroll
        for (int ai = 0; ai < 2; ++ai)
#pragma unroll
            for (int m = 0; m < 4; ++m) { const size_t off = (size_t)(row0 + ai * 128 + m * 16) * D + col0;
#pragma unroll
                for (int bj = 0; bj < 2; ++bj)
#pragma unroll
                    for (int n = 0; n < 2; ++n) { const f32x4 xv = *(const f32x4*)(X + off + bj * 128 + n * 16); *(f32x4*)(O + off + bj * 128 + n * 16) = xv * ALPHA + acc[ai][bj][m][n]; } }
    }
};

template <class F>
__device__ __forceinline__ void p0_tile(const F& f, bf16* WT, int ldk, int k0, int n0, LAS float* scr, int lane) {
    if constexpr (F::FOLD) {
        float bc[64];
#pragma unroll
        for (int d = 0; d < 64; ++d) bc[d] = f.bval(k0, d, n0 + (lane & 31));
#pragma unroll 2
        for (int i = 0; i < 32; ++i) { const int kk = 2 * i + (lane >> 5); const f32x4* ar = (const f32x4*)f.arow(k0 + kk, n0); float acc = 0.f;
#pragma unroll
            for (int q = 0; q < 16; ++q) { const f32x4 av = ar[q]; acc += (av[0] * bc[4 * q] + av[1] * bc[4 * q + 1]) + (av[2] * bc[4 * q + 2] + av[3] * bc[4 * q + 3]); }
            scr[kk * 33 + (lane & 31)] = acc; }
    } else {
        float v[32];
#pragma unroll
        for (int i = 0; i < 32; ++i) { const int kk = 2 * i + (lane >> 5); v[i] = f(k0 + kk, n0 + (lane & 31)); }
#pragma unroll
        for (int i = 0; i < 32; ++i) { const int kk = 2 * i + (lane >> 5); scr[kk * 33 + (lane & 31)] = v[i]; }
    }
    LDS_WAIT(); asm volatile("" ::: "memory");
    const int c = lane & 7;
#pragma unroll
    for (int j = 0; j < 4; ++j) { const int n = (lane >> 3) + 8 * j; const LAS float* s = scr + (8 * c) * 33 + n;
        u32x4 o; o.x = pk2(s[0 * 33], s[1 * 33]); o.y = pk2(s[2 * 33], s[3 * 33]); o.z = pk2(s[4 * 33], s[5 * 33]); o.w = pk2(s[6 * 33], s[7 * 33]);
        *(u32x4*)(WT + (size_t)(n0 + n) * ldk + k0 + 8 * c) = o; }
    LDS_WAIT(); asm volatile("" ::: "memory");
}
__device__ __forceinline__ int zsrc_col(int n) {
    if (n < 1280) return n;
    if (n < 2304) return -2;
    if (n < 2432) return 1816 + (n - 2304);
    if (n < 2688) return 1944 + (n - 2432);
    if (n < 2752) return 2200 + (n - 2688);
    if (n < 2776) return 1280 + (n - 2752);
    if (n < 2780) return 2264 + (n - 2776);
    if (n < 2816) return -1;
    if (n < 3840) return 2268 + (n - 2816);
    return 3292 + (n - 3840);
}
struct FWin { const float* w_in; static constexpr bool FOLD = false;
    __device__ __forceinline__ float operator()(int k, int n) const { const int s = zsrc_col(n); return s >= 0 ? w_in[(size_t)k * D_IN + s] : 0.f; } };
struct FWinQ { const float* w_in; const float* w_uk; static constexpr bool FOLD = true;
    __device__ __forceinline__ const float* arow(int k, int n0) const { return w_in + (size_t)k * D_IN + 1304 + ((n0 - 1280) >> 7) * 64; }
    __device__ __forceinline__ float bval(int, int d, int n) const { return w_uk[(size_t)((n - 1280) >> 7) * 64 * 128 + d * 128 + ((n - 1280) & 127)]; }
    __device__ __forceinline__ float operator()(int, int) const { return 0.f; } };
struct FWb { const float* w_uv; const float* w_bb; static constexpr bool FOLD = true;
    __device__ __forceinline__ const float* arow(int k, int) const { return w_uv + (size_t)k * 64; }
    __device__ __forceinline__ float bval(int k0, int d, int n) const { return w_bb[(size_t)((k0 >> 7) * 64 + d) * D + n]; }
    __device__ __forceinline__ float operator()(int, int) const { return 0.f; } };
struct FPlain { const float* W; int N; static constexpr bool FOLD = false; __device__ __forceinline__ float operator()(int k, int n) const { return W[(size_t)k * N + n]; } };
struct FOff { const float* W; int N; int noff; static constexpr bool FOLD = false;
    __device__ __forceinline__ float operator()(int k, int n) const { return W[(size_t)k * N + n + noff]; } };

__device__ __forceinline__ float rel_bucket_bias(const float* rel_bias, int dist, int head) {
    int b;
    if (dist < 16) b = dist;
    else { const float t = (__log2f((float)dist) - 4.0f) * 2.66666675f; b = 16 + (int)t; if (b > 31) b = 31; }
    return rel_bias[b * 16 + head];
}

__device__ __forceinline__ void phase0(const Frame& F, const Args& a) {
    LAS float* scr = (LAS float*)(F.lds + F.wave * 16384);
    const int gw = F.bx * NWAVES + F.wave, NGW = F.G * NWAVES;
    unsigned char* ws = F.ws;
    constexpr int I_WIN = (D / 64) * (NZ / 32);
    constexpr int I_WB = (1024 / 64) * (1024 / 32);
    constexpr int I_WA = (512 / 64) * (1024 / 32);
    constexpr int I_WO = I_WB;
    constexpr int I_W1 = (2048 / 64) * (256 / 32);
    constexpr int I_W2 = (256 / 64) * (64 / 32);
    constexpr int I_GU = (1024 / 64) * (512 / 32);
    constexpr int I_DN = (256 / 64) * (1024 / 32);
    constexpr int NITEMS = I_WIN + I_WB + I_WA + I_WO + 2 * I_W1 + 2 * I_W2 + NEXP * (I_GU + I_DN);
    for (int it = gw; it < NITEMS; it += NGW) {
        int r = it;
        if (r < I_WIN) { const int k0 = (r / (NZ / 32)) * 64, n0 = (r % (NZ / 32)) * 32;
            if (n0 >= 1280 && n0 < 2304) { const FWinQ f{a.in[1], a.in[9]}; p0_tile(f, (bf16*)(ws + WS_WINT), D, k0, n0, scr, F.lane); }
            else { const FWin f{a.in[1]}; p0_tile(f, (bf16*)(ws + WS_WINT), D, k0, n0, scr, F.lane); }
            continue; } r -= I_WIN;
        if (r < I_WB) { const FWb f{a.in[10], a.in[13]}; p0_tile(f, (bf16*)(ws + WS_WBT), 1024, (r / 32) * 64, (r % 32) * 32, scr, F.lane); continue; } r -= I_WB;
        if (r < I_WA) { const FPlain f{a.in[12], D}; p0_tile(f, (bf16*)(ws + WS_WAT), 512, (r / 32) * 64, (r % 32) * 32, scr, F.lane); continue; } r -= I_WA;
        if (r < I_WO) { const FPlain f{a.in[14], D}; p0_tile(f, (bf16*)(ws + WS_WOT), 1024, (r / 32) * 64, (r % 32) * 32, scr, F.lane); continue; } r -= I_WO;
        if (r < I_W1) { const FPlain f{a.in[4], 256}; p0_tile(f, (bf16*)(ws + WS_W1K), 2048, (r / 8) * 64, (r % 8) * 32, scr, F.lane); continue; } r -= I_W1;
        if (r < I_W1) { const FPlain f{a.in[6], 256}; p0_tile(f, (bf16*)(ws + WS_W1V), 2048, (r / 8) * 64, (r % 8) * 32, scr, F.lane); continue; } r -= I_W1;
        if (r < I_W2) { const FPlain f{a.in[5], 64}; p0_tile(f, (bf16*)(ws + WS_W2K), 256, (r / 2) * 64, (r % 2) * 32, scr, F.lane); continue; } r -= I_W2;
        if (r < I_W2) { const FPlain f{a.in[7], 64}; p0_tile(f, (bf16*)(ws + WS_W2V), 256, (r / 2) * 64, (r % 2) * 32, scr, F.lane); continue; } r -= I_W2;
        const int e = r / (I_GU + I_DN); r -= e * (I_GU + I_DN);
        if (r < I_GU) {
            const int n0 = (r % 16) * 32; const uintptr_t pg = (uintptr_t)a.in[21], pu = (uintptr_t)a.in[22];
            const float* src = (const float*)(pg + (uintptr_t)((n0 >> 7) & 1) * (pu - pg)) + (size_t)e * D * DEXP;
            const FOff f{src, DEXP, ((n0 >> 8) * 128 + (n0 & 127)) - n0};
            p0_tile(f, (bf16*)(ws + WS_WGU) + (size_t)e * 512 * 1024, 1024, (r / 16) * 64, n0, scr, F.lane); continue; } r -= I_GU;
        { const FPlain f{a.in[23] + (size_t)e * DEXP * D, D}; p0_tile(f, (bf16*)(ws + WS_WDT) + (size_t)e * 1024 * 256, 256, (r / 32) * 64, (r % 32) * 32, scr, F.lane); }
    }
    { const f32x4* x4 = (const f32x4*)a.in[0]; u32x2* o = (u32x2*)(ws + WS_XB);
      const size_t total = (size_t)NTOK * D / 4, stride = (size_t)F.G * NTHR;
      for (size_t i0 = (size_t)F.bx * NTHR + F.tid; i0 < total; i0 += 8 * stride) { f32x4 v[8];
#pragma unroll
          for (int j = 0; j < 8; ++j) { const size_t i = i0 + j * stride; v[j] = i < total ? x4[i] : (f32x4){0.f, 0.f, 0.f, 0.f}; }
#pragma unroll
          for (int j = 0; j < 8; ++j) { const size_t i = i0 + j * stride; if (i < total) { u32x2 w; w.x = pk2(v[j][0], v[j][1]); w.y = pk2(v[j][2], v[j][3]); o[i] = w; } } } }
    if (F.bx < 64 && F.tid < 256) {
        const int kv = F.bx >> 5, j = F.bx & 31;
        const float* pe = (kv ? a.in[3] : a.in[2]) + 64 * j; const float* w1 = (kv ? a.in[6] : a.in[4]) + (size_t)(64 * j) * 256 + F.tid; float acc = 0.f;
#pragma unroll 16
        for (int k = 0; k < 64; ++k) acc += pe[k] * w1[(size_t)k * 256];
        ((float*)(ws + WS_BIASK))[(kv * 32 + j) * 256 + F.tid] = acc;
    }
    if (F.bx >= 64 && F.bx < 96) { const int idx = (F.bx - 64) * NTHR + F.tid;
        const int tab = idx >> 13, head = (idx >> 10) & 7, dist = idx & 1023;
        ((float*)(ws + (tab ? WS_TBB : WS_TBA)))[head * 1024 + dist] = rel_bucket_bias(a.in[11], dist, tab * 8 + head) * LOG2E; }
}

constexpr int NRT = 36;
constexpr int P6_WR = 0;
constexpr int P6_CNT = 147456;
constexpr int P6_ENT = 147456 + 512;
__device__ __forceinline__ void phase6(const Frame& F, const Args& a) {
    unsigned char* ws = F.ws;
    LAS float* WR = (LAS float*)(F.lds + P6_WR);
    LAS int* cntL = (LAS int*)(F.lds + P6_CNT); LAS int* baseL = cntL + 32;
    LAS int* ent = (LAS int*)(F.lds + P6_ENT);
    const float* w_grp = a.in[17]; const float* b_grp = a.in[18]; const float* w_rtr = a.in[19]; const float* b_rtr = a.in[20];
    for (int i = F.tid; i < NRT * 1024; i += NTHR) { const int o = i >> 10, k = i & 1023; WR[i] = o < 4 ? w_grp[k * 4 + o] : w_rtr[k * 32 + (o - 4)]; }
    if (F.tid < 65) cntL[F.tid] = 0;
    __syncthreads();
    float* H1 = (float*)(ws + WS_H1); bf16* H1B = (bf16*)(ws + WS_H1B);
    const float* lg = a.in[15]; const float* lb = a.in[16];
    f32x4 gam[4], bet[4];
#pragma unroll
    for (int j = 0; j < 4; ++j) { gam[j] = *(const f32x4*)(lg + 256 * j + 4 * F.lane); bet[j] = *(const f32x4*)(lb + 256 * j + 4 * F.lane); }
    unsigned* gcnt = (unsigned*)(ws + WS_CTL) + CW_CNT;
    int* list = (int*)(ws + WS_LIST); float* tokinfo = (float*)(ws + WS_TOKINFO);
    const int gw = F.bx * NWAVES + F.wave, NGW = F.G * NWAVES;
    for (int row = gw; row < NTOK; row += NGW) {
        f32x4 v[4]; float s = 0.f;
        f32x4* hr = (f32x4*)(H1 + (size_t)row * D) + F.lane;
#pragma unroll
        for (int j = 0; j < 4; ++j) { v[j] = hr[64 * j]; s += (v[j][0] + v[j][1]) + (v[j][2] + v[j][3]); }
        const float mean = wave_sum(s) * (1.f / D); float s2 = 0.f;
#pragma unroll
        for (int j = 0; j < 4; ++j) { v[j] = v[j] - mean; s2 += (v[j][0] * v[j][0] + v[j][1] * v[j][1]) + (v[j][2] * v[j][2] + v[j][3] * v[j][3]); }
        const float rstd = 1.0f / sqrtf(wave_sum(s2) * (1.f / D) + 1e-5f);
        u32x2* ob = (u32x2*)(H1B + (size_t)row * D) + F.lane;
#pragma unroll
        for (int j = 0; j < 4; ++j) { v[j] = v[j] * rstd * gam[j] + bet[j]; hr[64 * j] = v[j]; u32x2 w; w.x = pk2(v[j][0], v[j][1]); w.y = pk2(v[j][2], v[j][3]); ob[64 * j] = w; }
        float L[NRT];
#pragma unroll
        for (int o = 0; o < NRT; ++o) { float p = 0.f;
#pragma unroll
            for (int j = 0; j < 4; ++j) { const f32x4 w = *(const LAS f32x4*)(WR + o * 1024 + 256 * j + 4 * F.lane); p += (v[j][0] * w[0] + v[j][1] * w[1]) + (v[j][2] * w[2] + v[j][3] * w[3]); }
            L[o] = wave_sum(p); }
        float g[4];
#pragma unroll
        for (int i = 0; i < 4; ++i) g[i] = L[i] + b_grp[i];
        int gs = 0; float gm = g[0];
#pragma unroll
        for (int i = 1; i < 4; ++i) if (g[i] > gm) { gm = g[i]; gs = i; }
        float gsum = 0.f;
#pragma unroll
        for (int i = 0; i < 4; ++i) gsum += __expf(g[i] - gm);
        const float pgrp = 1.0f / gsum;
        float el[8];
#pragma unroll
        for (int i = 0; i < 8; ++i) { const float x0 = L[4 + i], x1 = L[12 + i], x2 = L[20 + i], x3 = L[28 + i]; el[i] = (gs == 0 ? x0 : gs == 1 ? x1 : gs == 2 ? x2 : x3) + b_rtr[gs * 8 + i]; }
        int i1 = 0; float l1 = el[0];
#pragma unroll
        for (int i = 1; i < 8; ++i) if (el[i] > l1) { l1 = el[i]; i1 = i; }
        int i2 = -1; float l2 = -3.0e38f;
#pragma unroll
        for (int i = 0; i < 8; ++i) if (i != i1 && el[i] > l2) { l2 = el[i]; i2 = i; }
        const float e2 = __expf(l2 - l1), inv = 1.0f / (1.0f + e2);
        const float w0 = pgrp * inv, w1 = pgrp * e2 * inv;
        const int e0 = gs * 8 + i1, e1 = gs * 8 + i2;
        if (F.lane == 0) {
            const int p0 = atomicAdd((int*)&cntL[e0], 1), p1 = atomicAdd((int*)&cntL[e1], 1);
            const int n0 = atomicAdd((int*)&cntL[64], 2);
            ent[2 * n0] = (e0 << 16) | p0; ent[2 * n0 + 1] = row * 2;
            ent[2 * n0 + 2] = (e1 << 16) | p1; ent[2 * n0 + 3] = row * 2 + 1;
            tokinfo[row * 2] = w0; tokinfo[row * 2 + 1] = w1;
        }
    }
    __syncthreads();
    if (F.tid < 32) { const int c = cntL[F.tid]; baseL[F.tid] = c > 0 ? (int)__hip_atomic_fetch_add(gcnt + 64 * F.tid, (unsigned)c, __ATOMIC_RELAXED, __HIP_MEMORY_SCOPE_AGENT) : 0; }
    __syncthreads();
    const int nent = cntL[64];
    for (int i = F.tid; i < nent; i += NTHR) { const int ep = ent[2 * i], tk = ent[2 * i + 1]; const int e = ep >> 16, p = ep & 0xffff; list[(size_t)e * NTOK + baseL[e] + p] = tk; }
    __syncthreads();
}

constexpr int MOE_CUM = 131072;
struct MoeOrder {
    int G, c, NP; const LAS int* cum; const LAS int* cnt;
    __device__ bool next(int i, pg8::Unit& u) const {
        const int L = i * G + c, t = L / NP; if (t >= cum[32]) return false;
        int e = 0;
        for (int k = 1; k < 32; ++k) if (t >= cum[k]) e = k;
        const int j = t - cum[e]; u.pm = t; u.pn = L % NP; u.e = e | (j << 8); const int rem = cnt[e] - j * 256; u.nrows = rem < 256 ? rem : 256; return true;
    }
};
__device__ __forceinline__ void moe_setup(const Frame& F) {
    LAS int* cum = (LAS int*)(F.lds + MOE_CUM); LAS int* cnt = cum + 40;
    const unsigned* gcnt = (const unsigned*)(F.ws + WS_CTL) + CW_CNT;
    if (F.tid == 0) { int s = 0; for (int e = 0; e < 32; ++e) { const int c = (int)__hip_atomic_load(gcnt + 64 * e, __ATOMIC_RELAXED, __HIP_MEMORY_SCOPE_AGENT); cnt[e] = c; cum[e] = s; s += (c + 255) >> 8; } cum[32] = s; }
    __syncthreads();
}
struct AGather { const void* base; unsigned kstep; const int* list;
    static constexpr bool GATHER = true;
    __device__ __forceinline__ const void* unit_ptr(const pg8::Unit&) const { return base; }
    __device__ __forceinline__ unsigned lane_off(int, int) const { return 0u; }
    __device__ __forceinline__ size_t hstep() const { return 0; }
    __device__ __forceinline__ unsigned row_off(const pg8::Unit& u, int r) const { const int e = u.e & 255, j = u.e >> 8; const int rr = r < u.nrows ? r : 0;
        const int tk = list[(size_t)e * NTOK + j * 256 + rr]; return (unsigned)(tk >> 1) * (unsigned)(D * 2); } };
struct BGu { const bf16* W; __device__ __forceinline__ const void* ptr(const pg8::Unit& u) const { return W + (size_t)(u.e & 255) * 512 * 1024 + (size_t)u.pn * 256 * 1024; } };
struct BDn { const bf16* W; __device__ __forceinline__ const void* ptr(const pg8::Unit& u) const { return W + (size_t)(u.e & 255) * 1024 * 256 + (size_t)u.pn * 256 * 256; } };
struct EpiAct {
    static constexpr bool PERM = true; bf16* ACT;
    __device__ __forceinline__ void operator()(const f32x4 (&acc)[2][2][4][2], const pg8::Unit& u, int wr, int wc, int fr, int fq) const {
        const int row0 = u.pm * 256 + wr * 64 + fr, col0 = u.pn * 128 + wc * 32 + 8 * fq;
#pragma unroll
        for (int ai = 0; ai < 2; ++ai)
#pragma unroll
            for (int m = 0; m < 4; ++m) { float o[8];
#pragma unroll
                for (int n = 0; n < 2; ++n)
#pragma unroll
                    for (int j = 0; j < 4; ++j) { const float gt = acc[ai][0][m][n][j], up = acc[ai][1][m][n][j]; o[4 * n + j] = gt * sigmoidf_(gt) * up; }
                u32x4 w; w.x = pk2(o[0], o[1]); w.y = pk2(o[2], o[3]); w.z = pk2(o[4], o[5]); w.w = pk2(o[6], o[7]);
                *(u32x4*)(ACT + (size_t)(row0 + ai * 128 + m * 16) * DEXP + col0) = w; }
    }
};
struct EpiDown {
    static constexpr bool PERM = true; bf16* Y; const int* list;
    __device__ __forceinline__ void operator()(const f32x4 (&acc)[2][2][4][2], const pg8::Unit& u, int wr, int wc, int fr, int fq) const {
        const int e = u.e & 255, j = u.e >> 8; const int col0 = u.pn * 256 + wc * 32 + 8 * fq;
#pragma unroll
        for (int ai = 0; ai < 2; ++ai)
#pragma unroll
            for (int m = 0; m < 4; ++m) { const int r = ai * 128 + wr * 64 + m * 16 + fr;
                if (r < u.nrows) { const int tk = list[(size_t)e * NTOK + j * 256 + r]; bf16* rowp = Y + (size_t)tk * D + col0;
#pragma unroll
                    for (int bj = 0; bj < 2; ++bj) { const f32x4 v0 = acc[ai][bj][m][0], v1 = acc[ai][bj][m][1];
                        u32x4 w; w.x = pk2(v0[0], v0[1]); w.y = pk2(v0[2], v0[3]); w.z = pk2(v1[0], v1[1]); w.w = pk2(v1[2], v1[3]);
                        *(u32x4*)(rowp + bj * 128) = w; } }
                asm volatile("" ::: "memory"); }
    }
};

__device__ __forceinline__ void phase9(const Frame& F, const Args& a) {
    unsigned char* ws = F.ws;
    const float* H1 = (const float*)(ws + WS_H1); const bf16* Y = (const bf16*)(ws + WS_YBUF); const float* tokinfo = (const float*)(ws + WS_TOKINFO);
    const float* lg = a.in[24]; const float* lb = a.in[25];
    f32x4 gam[4], bet[4];
#pragma unroll
    for (int j = 0; j < 4; ++j) { gam[j] = *(const f32x4*)(lg + 256 * j + 4 * F.lane); bet[j] = *(const f32x4*)(lb + 256 * j + 4 * F.lane); }
    const int gw = F.bx * NWAVES + F.wave, NGW = F.G * NWAVES;
    for (int row = gw; row < NTOK; row += NGW) {
        const float w0 = tokinfo[row * 2], w1 = tokinfo[row * 2 + 1];
        const f32x4* hr = (const f32x4*)(H1 + (size_t)row * D) + F.lane;
        const u32x2* y0 = (const u32x2*)(Y + (size_t)(row * 2) * D) + F.lane; const u32x2* y1 = (const u32x2*)(Y + (size_t)(row * 2 + 1) * D) + F.lane;
        f32x4 v[4]; float s = 0.f;
#pragma unroll
        for (int j = 0; j < 4; ++j) { const f32x4 h = hr[64 * j]; const u32x2 p = y0[64 * j], q = y1[64 * j];
            v[j][0] = ALPHA * h[0] + w0 * bflo(p.x) + w1 * bflo(q.x); v[j][1] = ALPHA * h[1] + w0 * bfhi(p.x) + w1 * bfhi(q.x);
            v[j][2] = ALPHA * h[2] + w0 * bflo(p.y) + w1 * bflo(q.y); v[j][3] = ALPHA * h[3] + w0 * bfhi(p.y) + w1 * bfhi(q.y);
            s += (v[j][0] + v[j][1]) + (v[j][2] + v[j][3]); }
        const float mean = wave_sum(s) * (1.f / D); float s2 = 0.f;
#pragma unroll
        for (int j = 0; j < 4; ++j) { v[j] = v[j] - mean; s2 += (v[j][0] * v[j][0] + v[j][1] * v[j][1]) + (v[j][2] * v[j][2] + v[j][3] * v[j][3]); }
        const float rstd = 1.0f / sqrtf(wave_sum(s2) * (1.f / D) + 1e-5f);
        f32x4* o = (f32x4*)(a.out + (size_t)row * D) + F.lane;
#pragma unroll
        for (int j = 0; j < 4; ++j) o[64 * j] = v[j] * rstd * gam[j] + bet[j];
    }
}

#define MFMA32(a, b, c) __builtin_amdgcn_mfma_f32_32x32x16_bf16((a), (b), (c), 0, 0, 0)
__device__ __forceinline__ int crow(int r, int hi) { return (r & 3) + 8 * (r >> 2) + 4 * hi; }
__device__ __forceinline__ float gelu_tanh(float x) { const float u = 0.7978845608028654f * (x + 0.044715f * x * x * x); const float e = __expf(2.0f * u); return 0.5f * x * (2.0f - 2.0f / (e + 1.0f)); }
constexpr int P2_AROW = 4096 + 16;
constexpr int P2_HID = 32 * P2_AROW;
constexpr int P2_HROW = 512 + 16;
__device__ __forceinline__ void phase2(const Frame& F, const Args& a) {
    unsigned char* ws = F.ws;
    const bf16* ZA = (const bf16*)(ws + WS_ZA);
    { const float* gn = a.in[8]; bf16* CK = (bf16*)(ws + WS_CKVN);
      const int sub = F.lane >> 4, l16 = F.lane & 15;
      float gv[8];
#pragma unroll
      for (int j = 0; j < 8; ++j) gv[j] = gn[l16 * 8 + j];
      for (int r4 = F.bx * NWAVES + F.wave; r4 < NTOK / 4; r4 += F.G * NWAVES) { const int row = r4 * 4 + sub;
          const u32x4 w = *(const u32x4*)(ZA + (size_t)row * ZA_LD + ZC_CKV + l16 * 8);
          float v[8] = { bflo(w.x), bfhi(w.x), bflo(w.y), bfhi(w.y), bflo(w.z), bfhi(w.z), bflo(w.w), bfhi(w.w) };
          float s = 0.f;
#pragma unroll
          for (int j = 0; j < 8; ++j) s += v[j] * v[j];
          s += __shfl_xor(s, 1); s += __shfl_xor(s, 2); s += __shfl_xor(s, 4); s += __shfl_xor(s, 8);
          const float rs = 1.0f / sqrtf(s * (1.0f / 128.0f) + 1e-6f);
          u32x4 o; o.x = pk2(v[0] * rs * gv[0], v[1] * rs * gv[1]); o.y = pk2(v[2] * rs * gv[2], v[3] * rs * gv[3]); o.z = pk2(v[4] * rs * gv[4], v[5] * rs * gv[5]); o.w = pk2(v[6] * rs * gv[6], v[7] * rs * gv[7]);
          *(u32x4*)(CK + (size_t)row * 128 + l16 * 8) = o; } }
    const int r32 = F.lane & 31, hi = F.lane >> 5;
    for (int u = F.bx; u < 256; u += F.G) {
        const int kv = u >> 7, rt = u & 127, R0 = rt * 32;
        const int zc = kv ? ZC_VC : ZC_KC;
        const bf16* W1T = (const bf16*)(ws + (kv ? WS_W1V : WS_W1K)); const bf16* W2T = (const bf16*)(ws + (kv ? WS_W2V : WS_W2K));
        const float* bias = (const float*)(ws + WS_BIASK) + (size_t)kv * 32 * 256;
        bf16* OUT = (bf16*)(ws + (kv ? WS_VCMP : WS_KCMP));
        __syncthreads();
        for (int q = F.tid; q < 32 * 256; q += NTHR) { const int row = q >> 8, cq = q & 255, l = cq >> 3, dch = cq & 7;
            const int R = R0 + row, b = R >> 9, c = (R >> 1) & 255, g = R & 1; const int cc = c < NCMP ? c : NCMP - 1;
            const u32x4 v = *(const u32x4*)(ZA + (size_t)(b * SEQ + 16 * cc + l) * ZA_LD + zc + g * 64 + dch * 8);
            *(LAS u32x4*)(F.lds + row * P2_AROW + cq * 16) = v; }
        __syncthreads();
        f32x16 acc = {};
        { const bf16* bp = W1T + (size_t)(32 * F.wave + r32) * 2048 + 8 * hi; const LAS unsigned char* ap = F.lds + r32 * P2_AROW + 16 * hi;
#pragma unroll 8
          for (int s = 0; s < 128; ++s) { const bf16x8 af = *(const LAS bf16x8*)(ap + s * 32); const bf16x8 bfr = *(const bf16x8*)(bp + s * 16); acc = MFMA32(af, bfr, acc); } }
        { float bs = 0.f;
#pragma unroll 8
          for (int j = 0; j < 32; ++j) bs += bias[j * 256 + 32 * F.wave + r32];
#pragma unroll
          for (int i = 0; i < 16; ++i) { const float h = gelu_tanh(acc[i] + bs); *(LAS unsigned short*)(F.lds + P2_HID + crow(i, hi) * P2_HROW + (32 * F.wave + r32) * 2) = (unsigned short)f2bf(h); } }
        __syncthreads();
        if (F.wave < 2) {
            f32x16 o2 = {};
            const bf16* bp = W2T + (size_t)(32 * F.wave + r32) * 256 + 8 * hi; const LAS unsigned char* ap = F.lds + P2_HID + r32 * P2_HROW + 16 * hi;
#pragma unroll
            for (int s = 0; s < 16; ++s) { const bf16x8 af = *(const LAS bf16x8*)(ap + s * 32); const bf16x8 bfr = *(const bf16x8*)(bp + s * 16); o2 = MFMA32(af, bfr, o2); }
#pragma unroll
            for (int i = 0; i < 16; ++i) OUT[(size_t)(R0 + crow(i, hi)) * 64 + 32 * F.wave + r32] = (bf16)f2bf(o2[i]);
        }
    }
    __syncthreads();
}

typedef short v4i16_t __attribute__((ext_vector_type(4)));
__device__ __forceinline__ s16x4 vtr(const LAS unsigned char* p) { return __builtin_bit_cast(s16x4, __builtin_amdgcn_ds_read_tr16_b64_v4i16((LAS v4i16_t*)p)); }
constexpr int NSA_K = 0;
constexpr int NSA_V = 16384;
constexpr int NSA_TB = 49152;
constexpr int NSA_SC = 65536;
constexpr int NSA_MSK = 81920;
constexpr int NSA_OF = 83968;
constexpr float C2 = 0.125f * LOG2E;

__device__ __forceinline__ void nsa_tile(const LAS unsigned char* Kb, const LAS unsigned char* Vb, const LAS float* tbh, const bf16x8 (&qr)[4], f32x16 (&o)[2], float& m, float& l,
                                         int kt, int tq, int kmul, int kadd, int dmax, bool selbit, int mode, float b31, int r32, int hi, int lane) {
    const int tqa = tq - kadd, qk = kmul == 16 ? (tqa >> 4) : tqa, rem = kmul == 16 ? (tqa & 15) : 0;
    const int ebase = qk - (kt * 64 + 4 * hi);
    const LAS unsigned char* vp0 = Vb + ((lane >> 4) & 1) * 32 + (lane & 3) * 8 + (4 * hi + ((lane & 15) >> 2)) * 64;
#pragma unroll
    for (int hf = 0; hf < 2; ++hf) {
        f32x16 s0 = {};
#pragma unroll
        for (int d0 = 0; d0 < 4; ++d0) { const bf16x8 k0 = *(const LAS bf16x8*)(Kb + (2 * d0 + hi) * 1024 + (r32 + 32 * hf) * 16); s0 = MFMA32(k0, qr[d0], s0); }
        float tmax, mn, ps = 0.f;
        if (mode == 2) {
            float a0 = fmaxf(fmaxf(s0[0], s0[1]), s0[2]), a1 = fmaxf(fmaxf(s0[3], s0[4]), s0[5]);
            a0 = fmaxf(fmaxf(a0, s0[6]), s0[7]); a1 = fmaxf(fmaxf(a1, s0[8]), s0[9]); a0 = fmaxf(fmaxf(a0, s0[10]), s0[11]); a1 = fmaxf(fmaxf(a1, s0[12]), s0[13]); a0 = fmaxf(fmaxf(a0, s0[14]), s0[15]);
            const float cb = selbit ? b31 : NEGBIG;
            tmax = fmaxf(a0, a1) * C2 + cb;
            tmax = fmaxf(tmax, __shfl_xor(tmax, 32));
            mn = fmaxf(m, tmax);
            const float cc = cb - mn;
#pragma unroll
            for (int r = 0; r < 16; ++r) { const float p0 = __builtin_amdgcn_exp2f(s0[r] * C2 + cc); s0[r] = p0; ps += p0; }
        } else if (mode == 1) {
            const LAS float* tb1 = tbh + (ebase - 96);
            float bv[16];
#pragma unroll
            for (int r = 0; r < 16; ++r) bv[r] = tb1[96 - ((r & 3) + 8 * (r >> 2) + 32 * hf)];
#pragma unroll
            for (int r = 0; r < 16; ++r) asm volatile("" : "+v"(bv[r]));
            tmax = NEGBIG;
#pragma unroll
            for (int r = 0; r < 16; ++r) { const float x = s0[r] * C2 + bv[r]; s0[r] = x; tmax = fmaxf(tmax, x); }
            tmax = selbit ? tmax : NEGBIG;
            tmax = fmaxf(tmax, __shfl_xor(tmax, 32));
            mn = fmaxf(m, tmax);
            const float mne = selbit ? mn : 1e30f;
#pragma unroll
            for (int r = 0; r < 16; ++r) { const float p0 = __builtin_amdgcn_exp2f(s0[r] - mne); s0[r] = p0; ps += p0; }
        } else {
            tmax = NEGBIG;
            float bv[16];
#pragma unroll
            for (int r = 0; r < 16; ++r) { const int dist = (ebase - ((r & 3) + 8 * (r >> 2) + 32 * hf)) * kmul + rem; int dc = dist < 0 ? 0 : dist; dc = dc > 1023 ? 1023 : dc; bv[r] = tbh[dc]; }
#pragma unroll
            for (int r = 0; r < 16; ++r) asm volatile("" : "+v"(bv[r]));
#pragma unroll
            for (int r = 0; r < 16; ++r) { const int dist = (ebase - ((r & 3) + 8 * (r >> 2) + 32 * hf)) * kmul + rem;
                const bool valid = selbit && dist >= 0 && dist < dmax;
                const float x = valid ? s0[r] * C2 + bv[r] : NEGBIG;
                s0[r] = x; tmax = fmaxf(tmax, x); }
            tmax = fmaxf(tmax, __shfl_xor(tmax, 32));
            mn = fmaxf(m, tmax);
#pragma unroll
            for (int r = 0; r < 16; ++r) { const float p0 = s0[r] > -1e29f ? __builtin_amdgcn_exp2f(s0[r] - mn) : 0.f; s0[r] = p0; ps += p0; }
        }
        if (__any(mn != m)) {
            const float alpha = __builtin_amdgcn_exp2f(m - mn);
            l *= alpha;
#pragma unroll
            for (int c = 0; c < 2; ++c)
#pragma unroll
                for (int r = 0; r < 16; ++r) o[c][r] *= alpha;
        }
        m = mn;
        l += ps;
        u32x4 pw[2];
#pragma unroll
        for (int q = 0; q < 4; ++q) { pw[0][q] = pk2(s0[2 * q], s0[2 * q + 1]); pw[1][q] = pk2(s0[8 + 2 * q], s0[8 + 2 * q + 1]); }
#pragma unroll
        for (int c = 0; c < 2; ++c)
#pragma unroll
            for (int s2 = 0; s2 < 2; ++s2) { const int s = 2 * hf + s2; const s16x4 vl = vtr(vp0 + c * 4096 + s * 1024), vh = vtr(vp0 + c * 4096 + s * 1024 + 512);
                const bf16x8 vf = {vl[0], vl[1], vl[2], vl[3], vh[0], vh[1], vh[2], vh[3]};
                o[c] = MFMA32(vf, __builtin_bit_cast(bf16x8, pw[s2]), o[c]); }
    }
}

__device__ __forceinline__ void nsa_unit(const Frame& F, int b, int g, int qt) {
    unsigned char* ws = F.ws;
    const bf16* ZA = (const bf16*)(ws + WS_ZA);
    const int r32 = F.lane & 31, hi = F.lane >> 5, qi = r32 >> 2, hh = r32 & 3, head = g * 4 + hh;
    const int q0 = qt * 64, tq = q0 + 8 * F.wave + qi;
    const size_t zrow = (size_t)(b * SEQ + tq) * ZA_LD;
    const int srow = F.tid >> 3, sch = F.tid & 7;
    __syncthreads();
    { const float* TBA = (const float*)(ws + WS_TBA) + (size_t)g * 4 * 1024; LAS float* tb = (LAS float*)(F.lds + NSA_TB);
      for (int i = F.tid; i < 4096; i += NTHR) tb[i] = TBA[i]; }
    const LAS float* tbh = (const LAS float*)(F.lds + NSA_TB) + hh * 1024;
    const int wq0 = q0 + 8 * F.wave;
    const float b31 = ((const float*)(ws + WS_TBA))[(size_t)head * 1024 + 1023];
    bf16x8 qr[4];
#pragma unroll
    for (int d0 = 0; d0 < 4; ++d0) qr[d0] = *(const bf16x8*)(ZA + zrow + ZC_QA + head * 64 + d0 * 16 + hi * 8);
    float gate[3];
#pragma unroll
    for (int i = 0; i < 3; ++i) gate[i] = sigmoidf_(bf2f(ZA[zrow + ZC_GNSA + head * 3 + i]));
    LAS float* ofw = (LAS float*)(F.lds + NSA_OF) + F.wave * 2048 + F.lane;
    unsigned mlo = 0u, mhi = 0u; float inv_cmp = 0.f;
#pragma nounroll
    for (int br = 0; br < 4; ++br) {
        const bool iscmp = br < 2, vmap = br == 1;
        const bf16* Kg; const bf16* Vg; size_t pitch; int t_lo, t_hi;
        if (iscmp) { Kg = (const bf16*)(ws + WS_KCMP) + (size_t)(b * 256) * 128 + g * 64; Vg = (const bf16*)(ws + WS_VCMP) + (size_t)(b * 256) * 128 + g * 64; pitch = 128; t_lo = 0; t_hi = (q0 + 32) >> 10; }
        else { const int kc = br == 2 ? ZC_KS : ZC_KW; Kg = ZA + (size_t)(b * SEQ) * ZA_LD + kc + g * 64; Vg = Kg + 128; pitch = ZA_LD; t_lo = (br == 3 && qt > 8) ? qt - 8 : 0; t_hi = qt; }
        const int kmul = iscmp ? 16 : 1, kadd = iscmp ? 31 : 0, dmax = br == 3 ? 512 : 0x40000000;
        f32x16 o[2]; o[0] = f32x16{}; o[1] = f32x16{};
        float m = NEGBIG, l = 0.f;
        u32x4 kreg, vreg = {0u, 0u, 0u, 0u};
#define NSA_GLOAD(kt_) do { const size_t off_ = (size_t)((kt_) * 64 + srow) * pitch + sch * 8; kreg = *(const u32x4*)(Kg + off_); if (!vmap) vreg = *(const u32x4*)(Vg + off_); } while (0)
#define NSA_LSTORE(kt_, buf_) do { \
        *(LAS u32x4*)(F.lds + NSA_K + (buf_) * 8192 + sch * 1024 + srow * 16) = kreg; \
        if (vmap) { const int c_ = (kt_) * 64 + srow, jj_ = c_ >> 2, mm_ = c_ & 3; \
            _Pragma("unroll") for (int i_ = 0; i_ < 4; ++i_) { const int j0_ = sch * 8 + 2 * i_, j1_ = j0_ + 1; \
                const unsigned e0_ = (c_ < NCMP) ? (mm_ < 3 ? (j0_ == jj_ ? 0x4000u : 0u) : ((j0_ == jj_ || j0_ == jj_ + 1) ? 0x3F80u : 0u)) : 0u; \
                const unsigned e1_ = (c_ < NCMP) ? (mm_ < 3 ? (j1_ == jj_ ? 0x4000u : 0u) : ((j1_ == jj_ || j1_ == jj_ + 1) ? 0x3F80u : 0u)) : 0u; \
                vreg[i_] = e0_ | (e1_ << 16); } } \
        *(LAS u32x4*)(F.lds + NSA_V + (buf_) * 8192 + (sch >> 2) * 4096 + srow * 64 + (sch & 3) * 16) = vreg; } while (0)
        __syncthreads();
        NSA_GLOAD(t_lo); NSA_LSTORE(t_lo, 0);
        __syncthreads();
        int buf = 0;
#pragma nounroll
        for (int kt = t_lo; kt <= t_hi; ++kt) {
            if (kt < t_hi) NSA_GLOAD(kt + 1);
            const bool selbit = br == 2 ? (((kt < 32 ? (mlo >> kt) : (mhi >> (kt - 32))) & 1u) != 0u) : true;
            int mode = 0;
            { const int dmin = wq0 - (64 * kt + 63), dmx = wq0 + 7 - 64 * kt;
              if (br == 2) mode = dmin >= 790 ? 2 : (dmin >= 0 ? 1 : 0);
              if (br < 2) mode = 16 * (((wq0 - 31) >> 4) - (64 * kt + 63)) >= 790 ? 2 : 0;
              if (br == 3) mode = (dmin >= 0 && dmx <= 511) ? 1 : 0; }
            nsa_tile(F.lds + NSA_K + buf * 8192, F.lds + NSA_V + buf * 8192, tbh, qr, o, m, l, kt, tq, kmul, kadd, dmax, selbit, mode, b31, r32, hi, F.lane);
            if (kt < t_hi) NSA_LSTORE(kt + 1, buf ^ 1);
            __syncthreads();
            buf ^= 1;
        }
#undef NSA_GLOAD
#undef NSA_LSTORE
        l += __shfl_xor(l, 32);
        const float inv = l > 0.f ? 1.0f / l : 0.f;
        if (br == 0) inv_cmp = inv;
        if (br != 1) { const float sc = inv * (br == 0 ? gate[0] : br == 2 ? gate[1] : gate[2]);
#pragma unroll
            for (int c = 0; c < 2; ++c)
#pragma unroll
                for (int r = 0; r < 16; ++r) { const float prev = br == 0 ? 0.f : ofw[(c * 16 + r) * 64]; ofw[(c * 16 + r) * 64] = prev + o[c][r] * sc; }
        } else {
            LAS float* scw = (LAS float*)(F.lds + NSA_SC) + F.wave * 512;
#pragma unroll
            for (int c = 0; c < 2; ++c)
#pragma unroll
                for (int r = 0; r < 16; ++r) { float v = o[c][r] * inv_cmp; v += __shfl_xor(v, 1); v += __shfl_xor(v, 2);
                    if (hh == 0) scw[qi * 64 + 32 * c + crow(r, hi)] = v; }
            LDS_WAIT();
            LAS unsigned* mskw = (LAS unsigned*)(F.lds + NSA_MSK) + F.wave * 16;
#pragma nounroll
            for (int q = 0; q < 8; ++q) {
                const int curq = (q0 + 8 * F.wave + q) >> 6, j = F.lane;
                const bool avail = j <= curq, forced = (j == 0) || (j == curq) || (j == curq - 1);
                const float sj = avail ? scw[q * 64 + j] + (forced ? 1e4f : 0.f) : NEGBIG;
                LDS_WAIT();
                scw[q * 64 + j] = sj;
                LDS_WAIT();
                int rank = 0;
#pragma unroll 4
                for (int j2 = 0; j2 < 64; ++j2) { const float s2 = scw[q * 64 + j2]; rank += (s2 > sj || (s2 == sj && j2 < j)) ? 1 : 0; }
                const bool sel = rank < 16 && avail;
                const unsigned long long bm = __ballot(sel);
                if (F.lane == 0) { mskw[2 * q] = (unsigned)bm; mskw[2 * q + 1] = (unsigned)(bm >> 32); } }
            LDS_WAIT();
            mlo = mskw[2 * qi]; mhi = mskw[2 * qi + 1];
        }
    }
    bf16* OA = (bf16*)(ws + WS_OA) + (size_t)(b * SEQ + tq) * 512 + head * 64;
#pragma unroll
    for (int c = 0; c < 2; ++c)
#pragma unroll
        for (int r4 = 0; r4 < 4; ++r4) { u32x2 w; w.x = pk2(ofw[(c * 16 + 4 * r4) * 64], ofw[(c * 16 + 4 * r4 + 1) * 64]); w.y = pk2(ofw[(c * 16 + 4 * r4 + 2) * 64], ofw[(c * 16 + 4 * r4 + 3) * 64]);
            *(u32x2*)(OA + 32 * c + 8 * r4 + 4 * hi) = w; }
}
__device__ __forceinline__ void phase3(const Frame& F) {
    const bool xcd = (F.G == 256);
    const int pstart = xcd ? (F.bx >> 3) : F.bx, pstep = xcd ? 32 : F.G, pend = xcd ? 64 : 512;
#pragma nounroll
    for (int p2 = 2 * pstart; p2 < 2 * pend; p2 += (p2 & 1) ? 2 * pstep - 1 : 1) { const int p = p2 >> 1;
        const int b = xcd ? (F.bx & 7) : (p >> 6), g = (p >> 5) & 1, qt = p & 31;
        nsa_unit(F, b, g, (p2 & 1) ? qt : 63 - qt); }
    __syncthreads();
}

#define MFMA16(a, b, c) __builtin_amdgcn_mfma_f32_16x16x32_bf16((a), (b), (c), 0, 0, 0)
constexpr int DSA_SCP = 8200;
constexpr int DSA_SC = 0;
constexpr int DSA_LIST = 16 * DSA_SCP;
constexpr int DSA_NSEL = DSA_LIST + 8192;
constexpr int DSA_BIAS = DSA_NSEL + 64;
constexpr int DSA_HIST = DSA_BIAS + 1088;
constexpr int DSA_BKI = DSA_HIST + 8192;
constexpr int KSEL = 256;
__device__ __forceinline__ unsigned dsa_offb(unsigned row, unsigned ch) { return 256u * row + 16u * (ch ^ (((row & 3u) << 2) | ((row >> 2) & 3u))); }
__device__ __forceinline__ unsigned sortkey16(float x) { x = x + 0.0f; const unsigned short h = __builtin_bit_cast(unsigned short, (_Float16)x); return (h & 0x8000u) ? (unsigned)(unsigned short)~h : (unsigned)(h | 0x8000u); }
__device__ __forceinline__ int prefix_cnt(unsigned long long b) { return (int)__builtin_amdgcn_mbcnt_hi((unsigned)(b >> 32), __builtin_amdgcn_mbcnt_lo((unsigned)b, 0u)); }

__device__ __forceinline__ void dsa_unit(const Frame& F, const Args& a, int b, int qt16) {
    unsigned char* ws = F.ws;
    const bf16* ZA = (const bf16*)(ws + WS_ZA);
    const int lane = F.lane, l16 = lane & 15, quad = lane >> 4, q0 = qt16 * 16;
    __syncthreads();
#ifndef PROBE_DSA
#define PROBE_DSA 0
#endif
    for (int rep1_ = 0; rep1_ < (PROBE_DSA == 1 ? 2 : 1); ++rep1_) {
        const size_t qrow = (size_t)(b * SEQ + q0 + l16) * ZA_LD;
        bf16x8 qf[4][2];
#pragma unroll
        for (int i = 0; i < 4; ++i)
#pragma unroll
            for (int ks = 0; ks < 2; ++ks) qf[i][ks] = *(const bf16x8*)(ZA + qrow + ZC_QIDX + i * 64 + 32 * ks + 8 * quad);
        float wq[4];
#pragma unroll
        for (int i = 0; i < 4; ++i) wq[i] = bf2f(ZA[qrow + ZC_WIDX + i]) * 0.0625f;
        const int tq = q0 + l16, nkt = qt16 + 1;
        const bf16* kbase = ZA + (size_t)(b * SEQ + l16) * ZA_LD + ZC_KIDX + 8 * quad;
        bf16x8 ka[4][2], kn[4][2];
#define DSA_KLOAD(dst, kt0_) do { _Pragma("unroll") for (int t_ = 0; t_ < 4; ++t_) { const int k_ = (kt0_) + 8 * t_; const int kc_ = k_ < nkt ? k_ : nkt - 1; \
            dst[t_][0] = *(const bf16x8*)(kbase + (size_t)(kc_ * 16) * ZA_LD); dst[t_][1] = *(const bf16x8*)(kbase + (size_t)(kc_ * 16) * ZA_LD + 32); } } while (0)
        if (F.wave < nkt) DSA_KLOAD(ka, F.wave);
#pragma nounroll
        for (int kt0 = F.wave; kt0 < nkt; kt0 += 32) {
            if (kt0 + 32 < nkt) DSA_KLOAD(kn, kt0 + 32);
#pragma unroll
            for (int t = 0; t < 4; ++t) { const int kt = kt0 + 8 * t;
                if (kt < nkt) {
                    float idx[4] = {0.f, 0.f, 0.f, 0.f};
#pragma unroll
                    for (int i = 0; i < 4; ++i) { f32x4 acc = {0.f, 0.f, 0.f, 0.f}; acc = MFMA16(ka[t][0], qf[i][0], acc); acc = MFMA16(ka[t][1], qf[i][1], acc);
#pragma unroll
                        for (int r = 0; r < 4; ++r) idx[r] += fmaxf(acc[r], 0.f) * wq[i]; }
                    unsigned k16[4];
#pragma unroll
                    for (int r = 0; r < 4; ++r) { const int key = kt * 16 + 4 * quad + r; k16[r] = key <= tq ? sortkey16(idx[r]) : 0u; }
                    u32x2 w; w.x = k16[0] | (k16[1] << 16); w.y = k16[2] | (k16[3] << 16);
                    *(LAS u32x2*)(F.lds + DSA_SC + l16 * DSA_SCP + (kt * 16 + 4 * quad) * 2) = w; } }
#pragma unroll
            for (int t = 0; t < 4; ++t) { ka[t][0] = kn[t][0]; ka[t][1] = kn[t][1]; }
        }
#undef DSA_KLOAD
    }
    if (F.tid < 264) { const float* rb = a.in[11]; ((LAS float*)(F.lds + DSA_BIAS))[F.tid] = F.tid < 256 ? rb[(F.tid >> 3) * 16 + 8 + (F.tid & 7)] * LOG2E : NEGBIG; }
    __syncthreads();
#pragma nounroll
    for (int qq = 0; qq < (PROBE_DSA == 2 ? 4 : 2); ++qq) {
        const int n = 2 * F.wave + (qq & 1), tq = q0 + n, N = tq + 1;
        LAS unsigned char* scq = F.lds + DSA_SC + n * DSA_SCP;
        LAS unsigned short* lst = (LAS unsigned short*)(F.lds + DSA_LIST) + n * 256;
        LAS unsigned short* bki = (LAS unsigned short*)(F.lds + DSA_BKI) + n * 256;
        if (N <= KSEL) {
            for (int s = lane; s < KSEL; s += 64) lst[s] = (unsigned short)(s < N ? s : 0);
            if (lane == 0) ((LAS int*)(F.lds + DSA_NSEL))[n] = N;
        } else {
            const int nit = (N + 255) >> 8;
            { const int it = nit - 1; const int s0 = 4 * (lane + 64 * it); u32x2 w = *(LAS u32x2*)(scq + s0 * 2);
              if (s0 + 0 > tq) w.x &= 0xffff0000u; if (s0 + 1 > tq) w.x &= 0x0000ffffu; if (s0 + 2 > tq) w.y &= 0xffff0000u; if (s0 + 3 > tq) w.y &= 0x0000ffffu;
              *(LAS u32x2*)(scq + s0 * 2) = w; }
            LDS_WAIT();
            LAS unsigned* hist = (LAS unsigned*)(F.lds + DSA_HIST) + F.wave * 256;
            unsigned T = 0u; int cgt = 0; int need = KSEL;
#pragma nounroll
            for (int lvl = 0; lvl < 2; ++lvl) {
                *(LAS u32x4*)(hist + 4 * lane) = (u32x4){0u, 0u, 0u, 0u};
                LDS_WAIT();
#pragma nounroll
                for (int it = 0; it < nit; ++it) { const u32x2 w = *(LAS u32x2*)(scq + (lane + 64 * it) * 8);
                    const unsigned k[4] = {w.x & 0xffffu, w.x >> 16, w.y & 0xffffu, w.y >> 16};
#pragma unroll
                    for (int e = 0; e < 4; ++e) { const bool in = lvl == 0 ? true : (k[e] >> 8) == (T >> 8); const unsigned bin = lvl == 0 ? (k[e] >> 8) : (k[e] & 255u);
                        if (in) __hip_atomic_fetch_add(hist + bin, 1u, __ATOMIC_RELAXED, __HIP_MEMORY_SCOPE_WORKGROUP); } }
                LDS_WAIT();
                const u32x4 h = *(LAS u32x4*)(hist + 4 * lane);
                const int sl = (int)(h.x + h.y + h.z + h.w); int suf = sl;
#pragma unroll
                for (int d = 1; d < 64; d <<= 1) { const int o = __shfl_down(suf, d); suf += (lane + d < 64) ? o : 0; }
                const int above = suf - sl;
                const bool here = above < need && above + sl >= need;
                int bsel = 4 * lane + 3, ca = above;
                if (ca + (int)h.w < need) { ca += (int)h.w; bsel = 4 * lane + 2; if (ca + (int)h.z < need) { ca += (int)h.z; bsel = 4 * lane + 1; if (ca + (int)h.y < need) { ca += (int)h.y; bsel = 4 * lane; } } }
                const unsigned long long bm = __ballot(here);
                const int src = bm ? (int)__builtin_ctzll(bm) : 0;
                const int B = __shfl(bsel, src), CA = __shfl(ca, src);
                if (lvl == 0) T = (unsigned)B << 8; else T |= (unsigned)B;
                cgt += CA; need -= CA;
                LDS_WAIT();
            }
            const int rties = KSEL - cgt;
            int tiebase = 0, outbase = 0;
#define DSA_PUT(pos_, idx_) do { const int p_ = (pos_); if (p_ >= 0 && p_ < KSEL) lst[p_] = (unsigned short)(idx_); } while (0)
#pragma nounroll
            for (int it = 0; it < nit; ++it) { const u32x2 w = *(LAS u32x2*)(scq + (lane + 64 * it) * 8);
                const unsigned k0 = w.x & 0xffffu, k1 = w.x >> 16, k2 = w.y & 0xffffu, k3 = w.y >> 16;
                const int sidx = 4 * (lane + 64 * it);
                const bool g0 = k0 > T, g1 = k1 > T, g2 = k2 > T, g3 = k3 > T;
                const unsigned long long bg0 = __ballot(g0), bg1 = __ballot(g1), bg2 = __ballot(g2), bg3 = __ballot(g3);
                if (bg0 | bg1 | bg2 | bg3) {
                    int pos = outbase + prefix_cnt(bg0) + prefix_cnt(bg1) + prefix_cnt(bg2) + prefix_cnt(bg3);
                    if (g0) { DSA_PUT(pos, sidx + 0); ++pos; }
                    if (g1) { DSA_PUT(pos, sidx + 1); ++pos; }
                    if (g2) { DSA_PUT(pos, sidx + 2); ++pos; }
                    if (g3) { DSA_PUT(pos, sidx + 3); ++pos; }
                    outbase += __popcll(bg0) + __popcll(bg1) + __popcll(bg2) + __popcll(bg3); }
                const bool e0 = k0 == T, e1 = k1 == T, e2 = k2 == T, e3 = k3 == T;
                const unsigned long long be0 = __ballot(e0), be1 = __ballot(e1), be2 = __ballot(e2), be3 = __ballot(e3);
                if ((be0 | be1 | be2 | be3) && tiebase < rties) {
                    const int t0 = tiebase + prefix_cnt(be0) + prefix_cnt(be1) + prefix_cnt(be2) + prefix_cnt(be3), t1 = t0 + (e0 ? 1 : 0), t2 = t1 + (e1 ? 1 : 0), t3 = t2 + (e2 ? 1 : 0);
                    if (e0 && t0 < rties) DSA_PUT(KSEL - 1 - t0, sidx + 0);
                    if (e1 && t1 < rties) DSA_PUT(KSEL - 1 - t1, sidx + 1);
                    if (e2 && t2 < rties) DSA_PUT(KSEL - 1 - t2, sidx + 2);
                    if (e3 && t3 < rties) DSA_PUT(KSEL - 1 - t3, sidx + 3);
                    tiebase += __popcll(be0) + __popcll(be1) + __popcll(be2) + __popcll(be3); } }
#undef DSA_PUT
            outbase = KSEL;
            if (lane == 0) ((LAS int*)(F.lds + DSA_NSEL))[n] = outbase < KSEL ? outbase : KSEL;
        }
        LDS_WAIT();
        { const int nsl = N < KSEL ? N : KSEL;
#pragma unroll
          for (int i = 0; i < 4; ++i) { const int e = lane + 64 * i; const int dist = tq - (int)lst[e];
              const int dpos = dist < 1 ? 1 : dist; int bl = 16 + (int)((__log2f((float)dpos) - 4.0f) * 2.66666675f); bl = bl > 31 ? 31 : bl;
              const int bk = dist < 1 ? 0 : (dpos < 16 ? dpos : bl);
              bki[e] = (unsigned short)(e < nsl ? bk * 32 : 1024); } }
    }
    __syncthreads();
    const bf16* CK = (const bf16*)(ws + WS_CKVN) + (size_t)(b * SEQ) * 128;
    LAS unsigned char* gb0 = F.lds + F.wave * 16384;
    const LAS unsigned char* biasb = F.lds + DSA_BIAS + (l16 & 7) * 4;
#define DSA_GATHER(chunk_, buf_) do { const unsigned key_ = lst[(chunk_) * 32 + (lane >> 1)]; const char* src_ = (const char*)CK + (key_ * 256u + (unsigned)(lane & 1) * 16u); \
        _Pragma("unroll") for (int c_ = 0; c_ < 8; ++c_) __builtin_amdgcn_global_load_lds((const unsigned*)(src_ + c_ * 32), (LAS unsigned*)(gb0 + (buf_) * 8192 + c_ * 1024), 16, 0, 0); } while (0)
    int tqs[2], nsels[2]; const LAS unsigned short* lsts[2]; const LAS unsigned short* bkis[2]; bf16x8 ql[2][4]; f32x4 o[2][8]; float ms[2], ls[2];
#pragma unroll
    for (int qq = 0; qq < 2; ++qq) { const int n = 2 * F.wave + qq; tqs[qq] = q0 + n; nsels[qq] = ((const LAS int*)(F.lds + DSA_NSEL))[n]; lsts[qq] = (const LAS unsigned short*)(F.lds + DSA_LIST) + n * 256; bkis[qq] = (const LAS unsigned short*)(F.lds + DSA_BKI) + n * 256;
#pragma unroll
        for (int s2 = 0; s2 < 4; ++s2) { const bf16x8 v = *(const bf16x8*)(ZA + (size_t)(b * SEQ + tqs[qq]) * ZA_LD + ZC_QLAT + (l16 & 7) * 128 + 32 * s2 + 8 * quad); ql[qq][s2] = l16 < 8 ? v : (bf16x8){0, 0, 0, 0, 0, 0, 0, 0}; }
#pragma unroll
        for (int c = 0; c < 8; ++c) o[qq][c] = (f32x4){0.f, 0.f, 0.f, 0.f};
        ms[qq] = NEGBIG; ls[qq] = 0.f; }
#pragma unroll
    for (int qq = 0; qq < 2; ++qq)
#pragma unroll
        for (int s2 = 0; s2 < 4; ++s2) asm volatile("" : "+v"(ql[qq][s2]));
    const int nch1 = (nsels[1] + 31) >> 5, nch = PROBE_DSA == 3 ? 2 * nch1 : nch1;
    LDS_WAIT();
    { const LAS unsigned short* lst = lsts[0]; DSA_GATHER(0, 0); }
    { const LAS unsigned short* lst = lsts[1]; DSA_GATHER(0, 1); }
    const unsigned offA = (unsigned)((quad >> 1) * 1024 + l16 * 32 + (quad & 1) * 16);
    const unsigned offT = (unsigned)((4 * quad + (l16 >> 2)) * 32 + 8 * (lane & 3));
#pragma nounroll
    for (int ch = 0; ch < nch; ++ch) {
#pragma unroll
        for (int qq = 0; qq < 2; ++qq) {
            const int chd = ch >= nch1 ? ch - nch1 : ch;
            const LAS unsigned short* lst = lsts[qq];
            const LAS unsigned char* gb = gb0 + qq * 8192;
            if (qq == 0 || ch + 1 < nch) asm volatile("s_waitcnt vmcnt(8)" ::: "memory"); else asm volatile("s_waitcnt vmcnt(0)" ::: "memory");
            f32x4 acc2[2]; float bvs[2][4];
#pragma unroll
            for (int rb = 0; rb < 2; ++rb) { f32x4 acc = {0.f, 0.f, 0.f, 0.f};
#pragma unroll
                for (int s2 = 0; s2 < 4; ++s2) { const bf16x8 af = *(const LAS bf16x8*)(gb + offA + rb * 512 + s2 * 2048); acc = MFMA16(af, ql[qq][s2], acc); }
                acc2[rb] = acc;
                const u32x2 kb = *(const LAS u32x2*)((const LAS unsigned char*)bkis[qq] + (chd * 32 + rb * 16 + 4 * quad) * 2);
                bvs[rb][0] = *(const LAS float*)(biasb + (kb.x & 0xffffu)); bvs[rb][1] = *(const LAS float*)(biasb + (kb.x >> 16));
                bvs[rb][2] = *(const LAS float*)(biasb + (kb.y & 0xffffu)); bvs[rb][3] = *(const LAS float*)(biasb + (kb.y >> 16)); }
#pragma unroll
            for (int rb = 0; rb < 2; ++rb)
#pragma unroll
                for (int r = 0; r < 4; ++r) asm volatile("" : "+v"(bvs[rb][r]));
            float x[2][4]; float tmax = NEGBIG;
#pragma unroll
            for (int rb = 0; rb < 2; ++rb)
#pragma unroll
                for (int r = 0; r < 4; ++r) { const float xv = acc2[rb][r] * C2 + bvs[rb][r]; x[rb][r] = xv; tmax = fmaxf(tmax, xv); }
            tmax = fmaxf(tmax, __shfl_xor(tmax, 16)); tmax = fmaxf(tmax, __shfl_xor(tmax, 32));
            const float mn = fmaxf(ms[qq], tmax); const bool resc = __any(mn != ms[qq]); const float alpha = __builtin_amdgcn_exp2f(ms[qq] - mn); ms[qq] = mn;
            float ps = 0.f;
#pragma unroll
            for (int rb = 0; rb < 2; ++rb)
#pragma unroll
                for (int r = 0; r < 4; ++r) { const float pv = __builtin_amdgcn_exp2f(x[rb][r] - mn); x[rb][r] = pv; ps += pv; }
            ls[qq] = ls[qq] * alpha + ps;
            if (resc) {
#pragma unroll
                for (int c = 0; c < 8; ++c) o[qq][c] = o[qq][c] * alpha; }
            u32x4 pw; pw.x = pk2(x[0][0], x[0][1]); pw.y = pk2(x[0][2], x[0][3]); pw.z = pk2(x[1][0], x[1][1]); pw.w = pk2(x[1][2], x[1][3]);
            const unsigned gba = (unsigned)(unsigned long long)gb + offT;
#pragma unroll
            for (int cb = 0; cb < 2; ++cb) {
                s16x4 v[8];
                if (cb == 0) asm volatile("ds_read_b64_tr_b16 %0, %8\n\tds_read_b64_tr_b16 %1, %8 offset:512\n\tds_read_b64_tr_b16 %2, %8 offset:1024\n\tds_read_b64_tr_b16 %3, %8 offset:1536\n\t"
                             "ds_read_b64_tr_b16 %4, %8 offset:2048\n\tds_read_b64_tr_b16 %5, %8 offset:2560\n\tds_read_b64_tr_b16 %6, %8 offset:3072\n\tds_read_b64_tr_b16 %7, %8 offset:3584\n\ts_waitcnt lgkmcnt(0)"
                             : "=&v"(v[0]), "=&v"(v[1]), "=&v"(v[2]), "=&v"(v[3]), "=&v"(v[4]), "=&v"(v[5]), "=&v"(v[6]), "=&v"(v[7]) : "v"(gba) : "memory");
                else asm volatile("ds_read_b64_tr_b16 %0, %8 offset:4096\n\tds_read_b64_tr_b16 %1, %8 offset:4608\n\tds_read_b64_tr_b16 %2, %8 offset:5120\n\tds_read_b64_tr_b16 %3, %8 offset:5632\n\t"
                             "ds_read_b64_tr_b16 %4, %8 offset:6144\n\tds_read_b64_tr_b16 %5, %8 offset:6656\n\tds_read_b64_tr_b16 %6, %8 offset:7168\n\tds_read_b64_tr_b16 %7, %8 offset:7680\n\ts_waitcnt lgkmcnt(0)"
                             : "=&v"(v[0]), "=&v"(v[1]), "=&v"(v[2]), "=&v"(v[3]), "=&v"(v[4]), "=&v"(v[5]), "=&v"(v[6]), "=&v"(v[7]) : "v"(gba) : "memory");
#pragma unroll
                for (int c4 = 0; c4 < 4; ++c4) { const int c = 4 * cb + c4; const s16x4 v0 = v[2 * c4], v1 = v[2 * c4 + 1];
                    const bf16x8 vf = {v0[0], v0[1], v0[2], v0[3], v1[0], v1[1], v1[2], v1[3]};
                    o[qq][c] = MFMA16(vf, __builtin_bit_cast(bf16x8, pw), o[qq][c]); }
            }
            LDS_WAIT();
            if (ch + 1 < nch) DSA_GATHER((ch + 1 >= nch1 ? ch + 1 - nch1 : ch + 1), qq);
        }
    }
#pragma unroll
    for (int qq = 0; qq < 2; ++qq) {
        float l = ls[qq]; const int tq = tqs[qq];
        l += __shfl_xor(l, 16); l += __shfl_xor(l, 32);
        const float inv = l > 0.f ? 1.0f / l : 0.f;
        if (l16 < 8) { bf16* op = (bf16*)(ws + WS_OLAT) + (size_t)(b * SEQ + tq) * 1024 + l16 * 128 + 4 * quad;
#pragma unroll
            for (int c = 0; c < 8; ++c) { u32x2 w; w.x = pk2(o[qq][c][0] * inv, o[qq][c][1] * inv); w.y = pk2(o[qq][c][2] * inv, o[qq][c][3] * inv); *(u32x2*)(op + 16 * c) = w; } }
    }
}
#undef DSA_GATHER
__device__ __forceinline__ void phase4(const Frame& F, const Args& a) {
    const bool xcd = (F.G == 256);
    const int pstart = xcd ? (F.bx >> 3) : F.bx, pstep = xcd ? 32 : F.G, pend = xcd ? 128 : 1024;
#pragma nounroll
    for (int p2 = 2 * pstart; p2 < 2 * pend; p2 += (p2 & 1) ? 2 * pstep - 1 : 1) { const int p = p2 >> 1;
        const int b = xcd ? (F.bx & 7) : (p >> 7), j = p & 127;
        dsa_unit(F, a, b, (p2 & 1) ? j : 255 - j); }
    __syncthreads();
}

constexpr int NPHASE = 11;
__global__ void __launch_bounds__(NTHR, 2) fwd_kernel(Args args) {
    extern __shared__ __attribute__((aligned(16))) unsigned char lds_raw[];
    Frame F;
    F.lds = (LAS unsigned char*)lds_raw;
    F.tid = threadIdx.x; F.lane = F.tid & 63; F.wave = __builtin_amdgcn_readfirstlane(F.tid >> 6);
    F.G = gridDim.x; F.bx = blockIdx.x; F.ws = args.ws;
    unsigned char* ws = args.ws;
    volatile LAS unsigned* MISC = (volatile LAS unsigned*)(F.lds + MISC_OFF);
    if (F.tid < 64) MISC[F.tid] = 0u;
    __syncthreads();
    const int lo = args.ph_lo, hi = args.ph_hi;
    XcdBarrier bar; bar.bar = (unsigned*)(ws + WS_CTL) + CW_BAR; bar.x = 0; bar.st = nullptr;
    if (hi - lo > 1) bar = xcd_barrier_post((unsigned*)(ws + WS_CTL) + CW_BAR, MISC + 8);
#ifndef PH_MASK
#define PH_MASK 0xFFFF
#endif
#define IN(k) ((((PH_MASK) >> (k)) & 1) && lo <= (k) && (k) < hi)
#define SEAM(k) do { if (IN(k) && IN((k) + 1)) xcd_barrier(bar); } while (0)
#ifndef PROBE_PHASE
#define PROBE_PHASE -1
#endif
#define REPEAT(k) for (int rep_ = 0; rep_ < ((PROBE_PHASE) == (k) ? 2 : 1); ++rep_, ((PROBE_PHASE) == (k) && rep_ < 2 ? xcd_barrier(bar) : (void)0))

    if (IN(0)) REPEAT(0) { phase0(F, args); }
    SEAM(0);
    if (IN(1)) REPEAT(1) {
        pg8::StaticOrder S; S.init(NTOK / 256, NZ / 256, F.G, F.bx);
        const APlain AA{ws + WS_XB, 128u, (unsigned)(D * 2)}; const BPlain BA{(const bf16*)(ws + WS_WINT), D};
        const EpiZ E{(bf16*)(ws + WS_ZA), (bf16*)(ws + WS_ZG)};
        pg8::gemm_phase(F.lds, D, S, AA, BA, E);
    }
    SEAM(1);
    if (IN(2)) REPEAT(2) { phase2(F, args); }
    SEAM(2);
    if (IN(3)) REPEAT(3) { phase3(F); }
    if (IN(4)) REPEAT(4) { phase4(F, args); }
    SEAM(4);
    if (IN(5)) REPEAT(5) {
        pg8::StaticOrder S; S.init(NTOK / 256, D / 256, F.G, F.bx);
        { const APlain AA{ws + WS_OA, 128u, 1024u}; const BPlain BA{(const bf16*)(ws + WS_WAT), 512};
          const EpiGate<0> E{(const bf16*)(ws + WS_ZG), nullptr, (bf16*)(ws + WS_T1)};
          pg8::gemm_phase(F.lds, 512, S, AA, BA, E); }
        { const APlain AA{ws + WS_OLAT, 128u, 2048u}; const BPlain BA{(const bf16*)(ws + WS_WBT), 1024};
          const EpiGate<1> E{(const bf16*)(ws + WS_ZG), (const bf16*)(ws + WS_T1), (bf16*)(ws + WS_MERGED)};
          pg8::gemm_phase(F.lds, 1024, S, AA, BA, E); }
    }
    SEAM(5);
    if (IN(6)) REPEAT(6) {
        pg8::StaticOrder S; S.init(NTOK / 256, D / 256, F.G, F.bx);
        const APlain AA{ws + WS_MERGED, 128u, 2048u}; const BPlain BA{(const bf16*)(ws + WS_WOT), 1024};
        const EpiRes E{args.in[0], (float*)(ws + WS_H1)};
        pg8::gemm_phase(F.lds, 1024, S, AA, BA, E);
    }
    SEAM(6);
    if (IN(7)) { phase6(F, args); }
    SEAM(7);
    if (IN(8)) REPEAT(8) {
        moe_setup(F);
        const MoeOrder S{F.G, F.bx, 2, (const LAS int*)(F.lds + MOE_CUM), (const LAS int*)(F.lds + MOE_CUM) + 40};
        const AGather AA{ws + WS_H1B, 128u, (const int*)(ws + WS_LIST)}; const BGu BA{(const bf16*)(ws + WS_WGU)};
        const EpiAct E{(bf16*)(ws + WS_ACT)};
        pg8::gemm_phase(F.lds, 1024, S, AA, BA, E);
    }
    SEAM(8);
    if (IN(9)) REPEAT(9) {
        moe_setup(F);
        const MoeOrder S{F.G, F.bx, 4, (const LAS int*)(F.lds + MOE_CUM), (const LAS int*)(F.lds + MOE_CUM) + 40};
        const APlain AA{ws + WS_ACT, 128u, 512u}; const BDn BA{(const bf16*)(ws + WS_WDT)};
        const EpiDown E{(bf16*)(ws + WS_YBUF), (const int*)(ws + WS_LIST)};
        pg8::gemm_phase(F.lds, 256, S, AA, BA, E);
    }
    SEAM(9);
    if (IN(10)) REPEAT(10) { phase9(F, args); }
#undef IN
#undef SEAM
#undef REPEAT
}

extern "C" void kernel_launch(void* const* d_in, const int* in_sizes, int n_in, void* d_out, int out_size, void* d_ws, size_t ws_size, hipStream_t stream) {
    static int grid = 0;
    if (grid == 0) {
        if (n_in != 26 || in_sizes[0] != NTOK * D || out_size != NTOK * D || ws_size < WS_END) {
            fprintf(stderr, "kernel_launch: unexpected problem: n_in %d in0 %d out %d ws %zu (need %zu)\n", n_in, n_in > 0 ? in_sizes[0] : -1, out_size, ws_size, (size_t)WS_END); grid = -1; return; }
        int dev = 0, cus = 0, per_cu = 0;
        if (hipGetDevice(&dev) != hipSuccess || hipDeviceGetAttribute(&cus, hipDeviceAttributeMultiprocessorCount, dev) != hipSuccess) { grid = -1; return; }
        if (hipFuncSetAttribute((const void*)fwd_kernel, hipFuncAttributeMaxDynamicSharedMemorySize, LDS_BYTES) != hipSuccess) { fprintf(stderr, "kernel_launch: hipFuncSetAttribute failed\n"); grid = -1; return; }
        if (hipOccupancyMaxActiveBlocksPerMultiprocessor(&per_cu, (const void*)fwd_kernel, NTHR, LDS_BYTES) != hipSuccess || per_cu < 1)
            fprintf(stderr, "kernel_launch: occupancy query reports %d\n", per_cu);
        (void)hipGetLastError();
        grid = cus;
    }
    if (grid < 0) return;
    if (hipMemsetAsync((char*)d_ws + WS_CTL, 0, CTL_ZERO_BYTES, stream) != hipSuccess) return;
    Args a{};
    for (int i = 0; i < 26; ++i) a.in[i] = (const float*)d_in[i];
    a.out = (float*)d_out; a.ws = (unsigned char*)d_ws;
#if MK_PER_PHASE
    for (int p = 0; p < NPHASE; ++p) { a.ph_lo = p; a.ph_hi = p + 1; hipLaunchKernelGGL(fwd_kernel, dim3(grid), dim3(NTHR), LDS_BYTES, stream, a); }
#else
    a.ph_lo = 0; a.ph_hi = NPHASE;
    hipLaunchKernelGGL(fwd_kernel, dim3(grid), dim3(NTHR), LDS_BYTES, stream, a);
#endif
}
```

```cpp
#include <hip/hip_runtime.h>
#include <cstdio>
#include <cstdint>

#ifndef MK_PER_PHASE
#define MK_PER_PHASE 0
#endif

#define GAS __attribute__((address_space(1)))
#define LAS __attribute__((address_space(3)))
typedef unsigned short bf16;
typedef short bf16x8 __attribute__((ext_vector_type(8)));
typedef short s16x4 __attribute__((ext_vector_type(4)));
typedef float f32x4 __attribute__((ext_vector_type(4)));
typedef float f32x16 __attribute__((ext_vector_type(16)));
typedef float f32x2 __attribute__((ext_vector_type(2)));
typedef unsigned u32x4 __attribute__((ext_vector_type(4)));
typedef unsigned u32x2 __attribute__((ext_vector_type(2)));

constexpr int D = 1024, BATCH = 8, SEQ = 4096, NTOK = BATCH * SEQ;
constexpr int D_IN = 4316;
constexpr int NCMP = 255;
constexpr float ALPHA = 1.189207115002721f;
constexpr float LOG2E = 1.4426950408889634f;
constexpr float NEGBIG = -1e30f;
constexpr int ZA_LD = 2816;
constexpr int ZC_QA = 0, ZC_KC = 512, ZC_VC = 640, ZC_KS = 768, ZC_VS = 896, ZC_KW = 1024, ZC_VW = 1152, ZC_QLAT = 1280, ZC_CKV = 2304,
              ZC_QIDX = 2432, ZC_KIDX = 2688, ZC_GNSA = 2752, ZC_WIDX = 2776;
constexpr int ZG_LD = 2048;
constexpr int NZ = ZA_LD + ZG_LD;
constexpr int NEXP = 32, DEXP = 256;
constexpr int MAXTILES = (2 * NTOK) / 256 + NEXP;

constexpr size_t MiB = 1u << 20;
constexpr size_t WS_CTL = 0, CTL_ZERO_BYTES = 1 * MiB;
constexpr size_t WS_WAT = 1 * MiB;
constexpr size_t WS_WBT = 2 * MiB;
constexpr size_t WS_WOT = 4 * MiB;
constexpr size_t WS_W1K = 6 * MiB;
constexpr size_t WS_W1V = 7 * MiB;
constexpr size_t WS_W2K = 8 * MiB;
constexpr size_t WS_W2V = 8 * MiB + 64 * 1024;
constexpr size_t WS_BIASK = 8 * MiB + 128 * 1024;
constexpr size_t WS_TBA = 8 * MiB + 256 * 1024;
constexpr size_t WS_TBB = 8 * MiB + 320 * 1024;
constexpr size_t WS_KCMP = 9 * MiB;
constexpr size_t WS_VCMP = 9 * MiB + 512 * 1024;
constexpr size_t WS_TOKINFO = 10 * MiB;
constexpr size_t WS_LIST = 11 * MiB;
constexpr size_t WS_WINT = 16 * MiB;
constexpr size_t WS_WGU = 32 * MiB;
constexpr size_t WS_WDT = 64 * MiB;
constexpr size_t WS_CKVN = 80 * MiB;
constexpr size_t WS_XB = 96 * MiB;
constexpr size_t WS_OLAT = 96 * MiB;
constexpr size_t WS_H1B = 96 * MiB;
constexpr size_t WS_ZA = 160 * MiB;
constexpr size_t WS_T1 = 160 * MiB;
constexpr size_t WS_ACT = 160 * MiB;
constexpr size_t WS_YBUF = 196 * MiB;
constexpr size_t WS_MERGED = 224 * MiB;
constexpr size_t WS_ZG = 336 * MiB;
constexpr size_t WS_H1 = 336 * MiB;
constexpr size_t WS_OA = 464 * MiB;
constexpr size_t WS_END = 496 * MiB;

constexpr int CW_BAR = 4096;
constexpr int CW_CNT = 16384;

constexpr int LDS_BYTES = 163840;
constexpr int MISC_OFF = 160 * 1024 - 256;

__device__ __forceinline__ unsigned f2bf(float f) { unsigned u = __builtin_bit_cast(unsigned, f); return (u + 0x7fffu + ((u >> 16) & 1u)) >> 16; }
__device__ __forceinline__ unsigned pk2(float lo, float hi) { unsigned r; asm volatile("v_cvt_pk_bf16_f32 %0, %1, %2" : "=v"(r) : "v"(lo), "v"(hi)); return r; }
__device__ __forceinline__ float bf2f(unsigned short b) { return __builtin_bit_cast(float, ((unsigned)b) << 16); }
__device__ __forceinline__ float bflo(unsigned w) { return __builtin_bit_cast(float, w << 16); }
__device__ __forceinline__ float bfhi(unsigned w) { return __builtin_bit_cast(float, w & 0xffff0000u); }
__device__ __forceinline__ float wave_sum(float v) {
#pragma unroll
    for (int o = 1; o < 64; o <<= 1) v += __shfl_xor(v, o);
    return v;
}
__device__ __forceinline__ float sigmoidf_(float x) { return 1.0f / (1.0f + __expf(-x)); }
#define LDS_WAIT() asm volatile("s_waitcnt lgkmcnt(0)" ::: "memory")
#define VM_WAIT() asm volatile("s_waitcnt vmcnt(0)" ::: "memory")

#define XB_TMO      128
#define XB_XCNT(j)  (256  + 64 * (j))
#define XB_XSUB(j)  (1280 + 64 * (j))
#define XB_XGEN(j)  (2304 + 64 * (j))
#define XB_TOP      3328
#define XB_TOPGEN   3392
#define XCD_BAR_WORDS 3456
#define XB_SPIN_CAP (1u << 18)
__device__ __forceinline__ unsigned xb_ld(unsigned* p)              { return __hip_atomic_load(p, __ATOMIC_RELAXED, __HIP_MEMORY_SCOPE_AGENT); }
__device__ __forceinline__ unsigned xb_add(unsigned* p, unsigned v) { return __hip_atomic_fetch_add(p, v, __ATOMIC_RELAXED, __HIP_MEMORY_SCOPE_AGENT); }
__device__ __forceinline__ unsigned xb_xcc_id() { return (unsigned)__builtin_amdgcn_s_getreg((3 << 11) | 20) & 0xFu; }
#define XB_SPIN(cond, bar) do { unsigned _sp = 0; while (cond) { __builtin_amdgcn_s_sleep(1); \
    if ((++_sp & 255u) == 0u) { if (xb_ld(&(bar)[XB_TMO])) break; if (_sp > XB_SPIN_CAP) { atomicAdd(&(bar)[XB_TMO], 1u); break; } } } } while (0)
struct XcdBarrier { unsigned* bar; unsigned x; volatile LAS unsigned* st; };
__device__ __forceinline__ XcdBarrier xcd_barrier_post(unsigned* bar, volatile LAS unsigned* st) {
    XcdBarrier b; b.bar = bar; b.x = xb_xcc_id(); b.st = st;
    if (threadIdx.x == 0) (void)xb_add(&bar[XB_XCNT(b.x)], 1u);
    return b;
}
__device__ __forceinline__ void xcd_barrier_complete(unsigned* bar, unsigned x, unsigned& nloc, unsigned& nx) {
    const unsigned G = gridDim.x * gridDim.y * gridDim.z;
    unsigned sum, cnt, mine, sp = 0u;
    for (;;) {
        sum = 0u; cnt = 0u; mine = 0u;
#pragma unroll
        for (unsigned j = 0; j < 16; ++j) { const unsigned c = xb_ld(&bar[XB_XCNT(j)]); sum += c; cnt += (c > 0u) ? 1u : 0u; mine = (j == x) ? c : mine; }
        if (sum == G) break;
        __builtin_amdgcn_s_sleep(1);
        if ((++sp & 255u) == 0u) { if (xb_ld(&bar[XB_TMO])) break; if (sp > XB_SPIN_CAP) { atomicAdd(&bar[XB_TMO], 1u); break; } }
    }
    nloc = mine > 0u ? mine : 1u; nx = cnt > 0u ? cnt : 1u;
}
__device__ __forceinline__ void xcd_barrier(const XcdBarrier& b) {
    asm volatile("s_waitcnt vmcnt(0)" ::: "memory");
    __syncthreads();
    if (threadIdx.x == 0) {
        unsigned* bar = b.bar;
        __builtin_amdgcn_s_waitcnt(0);
        unsigned nloc = b.st[0], nx = b.st[1];
        if (nloc == 0u) { xcd_barrier_complete(bar, b.x, nloc, nx); b.st[0] = nloc; b.st[1] = nx; }
        const unsigned old = xb_add(&bar[XB_XSUB(b.x)], 1u);
        const unsigned gen = old / nloc;
        if (old + 1u == (gen + 1u) * nloc) {
            __builtin_amdgcn_fence(__ATOMIC_RELEASE, "agent");
            asm volatile("s_waitcnt vmcnt(0)" ::: "memory");
            const unsigned og = xb_add(&bar[XB_TOP], 1u);
            const unsigned tg = og / nx;
            if (og + 1u == (tg + 1u) * nx) xb_add(&bar[XB_TOPGEN], 1u);
            else XB_SPIN(xb_ld(&bar[XB_TOPGEN]) == tg, bar);
            __builtin_amdgcn_fence(__ATOMIC_ACQUIRE, "agent");
            xb_add(&bar[XB_XGEN(b.x)], 1u);
            asm volatile("s_waitcnt vmcnt(0)" ::: "memory");
        } else {
            XB_SPIN(xb_ld(&bar[XB_XGEN(b.x)]) == gen, bar);
            __builtin_amdgcn_fence(__ATOMIC_ACQUIRE, "agent");
            asm volatile("s_waitcnt vmcnt(0)" ::: "memory");
        }
    }
    __syncthreads();
}

namespace pg8 {
constexpr int BM = 256, BK = 64, HALF = 128, HTB = HALF * BK * 2, STAGE_BYTES = 8 * HTB, NXCD = 8, WGM = 8;
__host__ __device__ __forceinline__ int lds_byte(int r, int c) { const int st = (r >> 4) * 2 + (c >> 5), rr = r & 15, cc = c & 31, ob = rr * 64 + cc * 2; return st * 1024 + (ob ^ (((ob >> 9) & 1) << 5)); }
__host__ __device__ __forceinline__ void stage_rc(int b, int& R, int& C) { const int st = b / 1024, sb = b % 1024, swz = sb ^ (((sb >> 9) & 1) << 5); R = (st >> 1) * 16 + swz / 64; C = (st & 1) * 32 + (swz % 64) / 2; }
__host__ __device__ __forceinline__ int perm32(int rho) { const int n = rho >> 4, i = rho & 15; return 8 * (i >> 2) + 4 * n + (i & 3); }
struct Unit { int pm, pn, e, nrows; };
struct StaticOrder {
    int nM, nN, nwg, G, c;
    __device__ void init(int nM_, int nN_, int G_, int c_) { nM = nM_; nN = nN_; nwg = nM * nN; G = G_; c = c_; }
    __device__ bool next(int i, Unit& u) const {
        const long L = (long)i * G + c; if (L >= nwg) return false;
        int wgid = (int)L; { const int q = nwg / NXCD, r = nwg % NXCD, xcd = wgid % NXCD, off = wgid / NXCD; wgid = (xcd < r ? xcd * (q + 1) : r * (q + 1) + (xcd - r) * q) + off; }
        const int nig = WGM * nN, gid = wgid / nig, fm = gid * WGM, gsz = (nM - fm) < WGM ? (nM - fm) : WGM;
        u.pm = fm + ((wgid % nig) % gsz); u.pn = (wgid % nig) / gsz; u.e = 0; u.nrows = 256; return true;
    }
};

template <class Epi, class Sched, class AAddr, class BAddr>
__device__ __forceinline__ void gemm_phase(LAS unsigned char* lds, const int K, const Sched& S, const AAddr& AA, const BAddr& BA, const Epi& E) {
    constexpr bool GA = AAddr::GATHER;
    const int tid = threadIdx.x, wid = __builtin_amdgcn_readfirstlane(tid >> 6), lane = tid & 63, wr = wid >> 2, wc = wid & 3, fr = lane & 15, fq = lane >> 4;
    const int nt = K / BK;
    unsigned voffA[2], voffB[2];
#pragma unroll
    for (int i = 0; i < 2; ++i) { int R, C; stage_rc(tid * 16 + i * 8192, R, C); const int Rb = Epi::PERM ? ((R & ~31) + perm32(R & 31)) : R;
        voffA[i] = GA ? 0u : AA.lane_off(R, C); voffB[i] = (unsigned)(Rb * K + C) * 2u; }
    const size_t kstepA = (size_t)AA.kstep, kstepB = (size_t)(BK * 2);
    const size_t hstepB = (size_t)HALF * K * 2, hstepA = GA ? 0 : AA.hstep();
    const unsigned ldsw = (unsigned)wid * 1024u;
    const int aoff = lds_byte(wr * 64 + fr, fq * 8), boff = lds_byte(wc * 32 + fr, fq * 8);
#define PG8_SA(b, h) (((b) * 2 + (h)) * HTB)
#define PG8_SB(b, h) ((4 + (b) * 2 + (h)) * HTB)
#define PG8_STAGE(bufoff, gbase, voff) do { _Pragma("unroll") for (int _i = 0; _i < 2; ++_i) \
        __builtin_amdgcn_global_load_lds((const unsigned*)((const char*)(gbase) + (voff)[_i]), (LAS unsigned*)(lds + (bufoff) + ldsw + _i * 8192), 16, 0, 0); } while (0)
#define PG8_STA_CUR(bufoff, h, kb) do { if constexpr (GA) { if (h) PG8_STAGE(bufoff, baseA + (kb), cof1); else PG8_STAGE(bufoff, baseA + (kb), cof0); } \
        else PG8_STAGE(bufoff, cA + (h) * hstepA + (kb), voffA); } while (0)
#define PG8_STA_SEL(bufoff, h, kb) do { if constexpr (GA) { if (h) PG8_STAGE(bufoff, baseA + (kb), sof1); else PG8_STAGE(bufoff, baseA + (kb), sof0); } \
        else PG8_STAGE(bufoff, sA + (h) * hstepA + (kb), voffA); } while (0)
#define PG8_LDA(dst, b, h) do { _Pragma("unroll") for (int m = 0; m < 4; ++m) _Pragma("unroll") for (int k = 0; k < 2; ++k) dst[m][k] = *(const LAS bf16x8*)(lds + PG8_SA(b, h) + aoff + m * 2048 + k * 1024); } while (0)
#define PG8_LDB(dst, b, h) do { _Pragma("unroll") for (int n = 0; n < 2; ++n) _Pragma("unroll") for (int k = 0; k < 2; ++k) dst[n][k] = *(const LAS bf16x8*)(lds + PG8_SB(b, h) + boff + n * 2048 + k * 1024); } while (0)
#define PG8_MMA(ai, bj, At, Bt) do { __builtin_amdgcn_s_setprio(1); _Pragma("unroll") for (int m = 0; m < 4; ++m) _Pragma("unroll") for (int n = 0; n < 2; ++n) _Pragma("unroll") for (int k = 0; k < 2; ++k) \
        acc[ai][bj][m][n] = __builtin_amdgcn_mfma_f32_16x16x32_bf16(Bt[n][k], At[m][k], acc[ai][bj][m][n], 0, 0, 0); __builtin_amdgcn_s_setprio(0); } while (0)
#define PG8_WAIT_V(n) asm volatile("s_waitcnt vmcnt(" #n ")" ::: "memory")
#define PG8_WAIT_L(n) asm volatile("s_waitcnt lgkmcnt(" #n ")" ::: "memory")
#define PG8_BAR __builtin_amdgcn_s_barrier()
#define PG8_SCHED __builtin_amdgcn_sched_barrier(0)
#define PG8_GOFF(u, o0, o1) do { _Pragma("unroll") for (int _i = 0; _i < 2; ++_i) { int R_, C_; stage_rc(tid * 16 + _i * 8192, R_, C_); \
        o0[_i] = AA.row_off(u, R_) + (unsigned)C_ * 2u; o1[_i] = AA.row_off(u, R_ + HALF) + (unsigned)C_ * 2u; } } while (0)
    Unit cur, nxt; int ui = 0;
    if (!S.next(0, cur)) return;
    f32x4 acc[2][2][4][2];
#pragma unroll
    for (int a = 0; a < 2; ++a)
#pragma unroll
        for (int b = 0; b < 2; ++b)
#pragma unroll
            for (int m = 0; m < 4; ++m)
#pragma unroll
                for (int n = 0; n < 2; ++n) acc[a][b][m][n] = (f32x4){0.f, 0.f, 0.f, 0.f};
    bf16x8 At[4][2], B0[2][2], B1[2][2];
    const char* const baseA = GA ? (const char*)AA.base : nullptr;
    const char* cA = GA ? nullptr : (const char*)AA.unit_ptr(cur);
    unsigned cof0[2] = {0u, 0u}, cof1[2] = {0u, 0u}, nof0[2] = {0u, 0u}, nof1[2] = {0u, 0u};
    if constexpr (GA) PG8_GOFF(cur, cof0, cof1);
    const char* cB = (const char*)BA.ptr(cur);
    PG8_STAGE(PG8_SB(0, 0), cB, voffB); PG8_STA_CUR(PG8_SA(0, 0), 0, 0); PG8_STAGE(PG8_SB(0, 1), cB + hstepB, voffB); PG8_STA_CUR(PG8_SA(0, 1), 1, 0);
    if (wr == 1) PG8_BAR;
    PG8_WAIT_V(4); PG8_BAR;
    PG8_STAGE(PG8_SB(1, 0), cB + kstepB, voffB); PG8_STA_CUR(PG8_SA(1, 0), 0, kstepA); PG8_STAGE(PG8_SB(1, 1), cB + hstepB + kstepB, voffB);
    PG8_WAIT_V(6); PG8_BAR;
    for (;;) {
        const bool has_next = S.next(ui + 1, nxt);
        const char* nB = cB; const char* nA = cA;
        if (has_next) { nB = (const char*)BA.ptr(nxt); if constexpr (GA) PG8_GOFF(nxt, nof0, nof1); else nA = (const char*)AA.unit_ptr(nxt); }
        else { if constexpr (GA) {
#pragma unroll
            for (int i = 0; i < 2; ++i) { nof0[i] = cof0[i]; nof1[i] = cof1[i]; } } }
#pragma nounroll
        for (int t = 0; t < nt; t += 2) {
            const bool last = (t == nt - 2);
            const size_t k1 = (size_t)(t + 1) * kstepA, k2 = last ? 0 : (size_t)(t + 2) * kstepA, k3 = k2 + kstepA;
            const char* b2 = last ? nB : cB + (size_t)(t + 2) * kstepB; const char* b3 = b2 + kstepB;
            const char* sA = last ? nA : cA;
            unsigned sof0[2], sof1[2];
#pragma unroll
            for (int i = 0; i < 2; ++i) { sof0[i] = last ? nof0[i] : cof0[i]; sof1[i] = last ? nof1[i] : cof1[i]; }
            PG8_LDB(B0, 0, 0); PG8_SCHED; PG8_LDA(At, 0, 0); PG8_STA_CUR(PG8_SA(1, 1), 1, k1);
            PG8_WAIT_L(8); PG8_BAR; PG8_WAIT_L(0); PG8_MMA(0, 0, At, B0); PG8_BAR; PG8_SCHED;
            PG8_LDB(B1, 0, 1); PG8_STAGE(PG8_SB(0, 0), b2, voffB);
            PG8_BAR; PG8_WAIT_L(0); PG8_MMA(0, 1, At, B1); PG8_BAR;
            PG8_LDA(At, 0, 1); PG8_STA_SEL(PG8_SA(0, 0), 0, k2);
            PG8_BAR; PG8_WAIT_L(0); PG8_MMA(1, 0, At, B0); PG8_BAR; PG8_SCHED;
            PG8_STAGE(PG8_SB(0, 1), b2 + hstepB, voffB);
            PG8_WAIT_V(6); PG8_BAR; PG8_MMA(1, 1, At, B1); PG8_BAR;
            PG8_LDB(B0, 1, 0); PG8_SCHED; PG8_LDA(At, 1, 0); PG8_STA_SEL(PG8_SA(0, 1), 1, k2);
            PG8_WAIT_L(8); PG8_BAR; PG8_WAIT_L(0); PG8_MMA(0, 0, At, B0); PG8_BAR; PG8_SCHED;
            PG8_LDB(B1, 1, 1); PG8_STAGE(PG8_SB(1, 0), b3, voffB);
            PG8_BAR; PG8_WAIT_L(0); PG8_MMA(0, 1, At, B1); PG8_BAR;
            PG8_LDA(At, 1, 1); PG8_STA_SEL(PG8_SA(1, 0), 0, k3);
            PG8_BAR; PG8_WAIT_L(0); PG8_MMA(1, 0, At, B0); PG8_BAR; PG8_SCHED;
            PG8_STAGE(PG8_SB(1, 1), b3 + hstepB, voffB);
            PG8_WAIT_V(6); PG8_BAR; PG8_MMA(1, 1, At, B1); PG8_BAR;
        }
        E(acc, cur, wr, wc, fr, fq);
        if (!has_next) break;
#pragma unroll
        for (int a = 0; a < 2; ++a)
#pragma unroll
            for (int b = 0; b < 2; ++b)
#pragma unroll
                for (int m = 0; m < 4; ++m)
#pragma unroll
                    for (int n = 0; n < 2; ++n) acc[a][b][m][n] = (f32x4){0.f, 0.f, 0.f, 0.f};
        cur = nxt; cB = nB; cA = nA; ++ui;
        if constexpr (GA) {
#pragma unroll
            for (int i = 0; i < 2; ++i) { cof0[i] = nof0[i]; cof1[i] = nof1[i]; } }
    }
    PG8_WAIT_V(0);
    if (wr == 0) PG8_BAR;
    PG8_BAR;
#undef PG8_SA
#undef PG8_SB
#undef PG8_STAGE
#undef PG8_STA_CUR
#undef PG8_STA_SEL
#undef PG8_GOFF
#undef PG8_LDA
#undef PG8_LDB
#undef PG8_MMA
#undef PG8_WAIT_V
#undef PG8_WAIT_L
#undef PG8_BAR
#undef PG8_SCHED
}
}

constexpr int NWAVES = 8, NTHR = 512;
struct Args { const float* in[26]; float* out; unsigned char* ws; int ph_lo, ph_hi; unsigned repmask; int pad; };
struct Frame {
    LAS unsigned char* lds;
    int tid, lane, wave, G, bx;
    unsigned char* ws;
};

struct APlain { const void* base; unsigned kstep; unsigned ld2;
    static constexpr bool GATHER = false;
    __device__ __forceinline__ const void* unit_ptr(const pg8::Unit& u) const { return (const char*)base + (size_t)u.pm * 256 * ld2; }
    __device__ __forceinline__ unsigned lane_off(int R, int C) const { return (unsigned)R * ld2 + (unsigned)C * 2u; }
    __device__ __forceinline__ size_t hstep() const { return (size_t)128 * ld2; }
    __device__ __forceinline__ unsigned row_off(const pg8::Unit&, int) const { return 0u; } };
struct BPlain { const bf16* Bt; int K;
    __device__ __forceinline__ const void* ptr(const pg8::Unit& u) const { return Bt + (size_t)u.pn * 256 * K; } };

struct EpiZ {
    static constexpr bool PERM = true;
    bf16* ZA; bf16* ZG;
    __device__ __forceinline__ void operator()(const f32x4 (&acc)[2][2][4][2], const pg8::Unit& u, int wr, int wc, int fr, int fq) const {
        const bool gate = u.pn >= 11;
        bf16* base = gate ? ZG : ZA; const int ld = gate ? ZG_LD : ZA_LD; const int colt = gate ? (u.pn - 11) * 256 : u.pn * 256;
        const int row0 = u.pm * 256 + wr * 64 + fr, col0 = colt + wc * 32 + 8 * fq;
#pragma unroll
        for (int ai = 0; ai < 2; ++ai)
#pragma unroll
            for (int m = 0; m < 4; ++m) { bf16* rowp = base + (size_t)(row0 + ai * 128 + m * 16) * ld + col0;
#pragma unroll
                for (int bj = 0; bj < 2; ++bj) { f32x4 v0 = acc[ai][bj][m][0], v1 = acc[ai][bj][m][1];
                    if (gate) {
#pragma unroll
                        for (int j = 0; j < 4; ++j) { v0[j] = sigmoidf_(v0[j]); v1[j] = sigmoidf_(v1[j]); } }
                    u32x4 w; w.x = pk2(v0[0], v0[1]); w.y = pk2(v0[2], v0[3]); w.z = pk2(v1[0], v1[1]); w.w = pk2(v1[2], v1[3]);
                    *(u32x4*)(rowp + bj * 128) = w; } }
    }
};
template <int MODE> struct EpiGate {
    static constexpr bool PERM = true;
    const bf16* ZG; const bf16* T1; bf16* O;
    __device__ __forceinline__ void operator()(const f32x4 (&acc)[2][2][4][2], const pg8::Unit& u, int wr, int wc, int fr, int fq) const {
        const int row0 = u.pm * 256 + wr * 64 + fr, col0 = u.pn * 256 + wc * 32 + 8 * fq;
#pragma unroll
        for (int ai = 0; ai < 2; ++ai)
#pragma unroll
            for (int m = 0; m < 4; ++m) { const size_t r = (size_t)(row0 + ai * 128 + m * 16);
#pragma unroll
                for (int bj = 0; bj < 2; ++bj) { const int c = col0 + bj * 128;
                    const u32x4 g = *(const u32x4*)(ZG + r * ZG_LD + MODE * 1024 + c);
                    f32x4 v0 = acc[ai][bj][m][0], v1 = acc[ai][bj][m][1];
                    float o[8] = { v0[0] * bflo(g.x), v0[1] * bfhi(g.x), v0[2] * bflo(g.y), v0[3] * bfhi(g.y), v1[0] * bflo(g.z), v1[1] * bfhi(g.z), v1[2] * bflo(g.w), v1[3] * bfhi(g.w) };
                    if (MODE == 1) { const u32x4 t = *(const u32x4*)(T1 + r * 1024 + c);
                        o[0] += bflo(t.x); o[1] += bfhi(t.x); o[2] += bflo(t.y); o[3] += bfhi(t.y); o[4] += bflo(t.z); o[5] += bfhi(t.z); o[6] += bflo(t.w); o[7] += bfhi(t.w); }
                    u32x4 w; w.x = pk2(o[0], o[1]); w.y = pk2(o[2], o[3]); w.z = pk2(o[4], o[5]); w.w = pk2(o[6], o[7]);
                    *(u32x4*)(O + r * 1024 + c) = w; } }
    }
};
struct EpiRes {
    static constexpr bool PERM = true;
    const float* X; bf16* O;
    __device__ __forceinline__ void operator()(const f32x4 (&acc)[2][2][4][2], const pg8::Unit& u, int wr, int wc, int fr, int fq) const {
        const int row0 = u.pm * 256 + wr * 64 + fr, col0 = u.pn * 256 + wc * 32 + 8 * fq;
#pragma unroll
        for (int ai = 0; ai < 2; ++ai)
#pragma unroll
            for (int m = 0; m < 4; ++m) { const size_t off = (size_t)(row0 + ai * 128 + m * 16) * D + col0;
#pragma unroll
                for (int bj = 0; bj < 2; ++bj) { const f32x4 x0 = *(const f32x4*)(X + off + bj * 128), x1 = *(const f32x4*)(X + off + bj * 128 + 4);
                    const f32x4 v0 = x0 * ALPHA + acc[ai][bj][m][0], v1 = x1 * ALPHA + acc[ai][bj][m][1];
                    u32x4 w; w.x = pk2(v0[0], v0[1]); w.y = pk2(v0[2], v0[3]); w.z = pk2(v1[0], v1[1]); w.w = pk2(v1[2], v1[3]);
                    *(u32x4*)(O + off + bj * 128) = w; } }
    }
};

template <class F>
__device__ __forceinline__ void p0_tile(const F& f, bf16* WT, int ldk, int k0, int n0, LAS float* scr, int lane) {
    if constexpr (F::FOLD) {
        float bc[64];
#pragma unroll
        for (int d = 0; d < 64; ++d) bc[d] = f.bval(k0, d, n0 + (lane & 31));
#pragma unroll 2
        for (int i = 0; i < 32; ++i) { const int kk = 2 * i + (lane >> 5); const f32x4* ar = (const f32x4*)f.arow(k0 + kk, n0); float acc = 0.f;
#pragma unroll
            for (int q = 0; q < 16; ++q) { const f32x4 av = ar[q]; acc += (av[0] * bc[4 * q] + av[1] * bc[4 * q + 1]) + (av[2] * bc[4 * q + 2] + av[3] * bc[4 * q + 3]); }
            scr[kk * 33 + (lane & 31)] = acc; }
    } else {
        float v[32];
#pragma unroll
        for (int i = 0; i < 32; ++i) { const int kk = 2 * i + (lane >> 5); v[i] = f(k0 + kk, n0 + (lane & 31)); }
#pragma unroll
        for (int i = 0; i < 32; ++i) { const int kk = 2 * i + (lane >> 5); scr[kk * 33 + (lane & 31)] = v[i]; }
    }
    LDS_WAIT(); asm volatile("" ::: "memory");
    const int c = lane & 7;
#pragma unroll
    for (int j = 0; j < 4; ++j) { const int n = (lane >> 3) + 8 * j; const LAS float* s = scr + (8 * c) * 33 + n;
        u32x4 o; o.x = pk2(s[0 * 33], s[1 * 33]); o.y = pk2(s[2 * 33], s[3 * 33]); o.z = pk2(s[4 * 33], s[5 * 33]); o.w = pk2(s[6 * 33], s[7 * 33]);
        *(u32x4*)(WT + (size_t)(n0 + n) * ldk + k0 + 8 * c) = o; }
    LDS_WAIT(); asm volatile("" ::: "memory");
}
struct P0Item { const float* src; int N, noff; bf16* dst; int ldk, k0, n0; };
__device__ __forceinline__ void p0_item_load(const P0Item& it, float (&v)[32], int lane) {
#pragma unroll
    for (int i = 0; i < 32; ++i) { const int kk = 2 * i + (lane >> 5); v[i] = it.src[(size_t)(it.k0 + kk) * it.N + it.n0 + (lane & 31) + it.noff]; }
}
__device__ __forceinline__ void p0_item_finish(const P0Item& it, const float (&v)[32], LAS float* scr, int lane) {
#pragma unroll
    for (int i = 0; i < 32; ++i) { const int kk = 2 * i + (lane >> 5); scr[kk * 33 + (lane & 31)] = v[i]; }
    LDS_WAIT(); asm volatile("" ::: "memory");
    const int c = lane & 7;
#pragma unroll
    for (int j = 0; j < 4; ++j) { const int n = (lane >> 3) + 8 * j; const LAS float* s = scr + (8 * c) * 33 + n;
        u32x4 o; o.x = pk2(s[0 * 33], s[1 * 33]); o.y = pk2(s[2 * 33], s[3 * 33]); o.z = pk2(s[4 * 33], s[5 * 33]); o.w = pk2(s[6 * 33], s[7 * 33]);
        *(u32x4*)(it.dst + (size_t)(it.n0 + n) * it.ldk + it.k0 + 8 * c) = o; }
    LDS_WAIT(); asm volatile("" ::: "memory");
}
__device__ __forceinline__ int zsrc_col(int n) {
    if (n < 1280) return n;
    if (n < 2304) return -2;
    if (n < 2432) return 1816 + (n - 2304);
    if (n < 2688) return 1944 + (n - 2432);
    if (n < 2752) return 2200 + (n - 2688);
    if (n < 2776) return 1280 + (n - 2752);
    if (n < 2780) return 2264 + (n - 2776);
    if (n < 2816) return -1;
    if (n < 3840) return 2268 + (n - 2816);
    return 3292 + (n - 3840);
}
struct FWin { const float* w_in; static constexpr bool FOLD = false;
    __device__ __forceinline__ float operator()(int k, int n) const { const int s = zsrc_col(n); return s >= 0 ? w_in[(size_t)k * D_IN + s] : 0.f; } };
struct FWinQ { const float* w_in; const float* w_uk; static constexpr bool FOLD = true;
    __device__ __forceinline__ const float* arow(int k, int n0) const { return w_in + (size_t)k * D_IN + 1304 + ((n0 - 1280) >> 7) * 64; }
    __device__ __forceinline__ float bval(int, int d, int n) const { return w_uk[(size_t)((n - 1280) >> 7) * 64 * 128 + d * 128 + ((n - 1280) & 127)]; }
    __device__ __forceinline__ float operator()(int, int) const { return 0.f; } };
struct FWb { const float* w_uv; const float* w_bb; static constexpr bool FOLD = true;
    __device__ __forceinline__ const float* arow(int k, int) const { return w_uv + (size_t)k * 64; }
    __device__ __forceinline__ float bval(int k0, int d, int n) const { return w_bb[(size_t)((k0 >> 7) * 64 + d) * D + n]; }
    __device__ __forceinline__ float operator()(int, int) const { return 0.f; } };
struct FPlain { const float* W; int N; static constexpr bool FOLD = false; __device__ __forceinline__ float operator()(int k, int n) const { return W[(size_t)k * N + n]; } };
struct FOff { const float* W; int N; int noff; static constexpr bool FOLD = false;
    __device__ __forceinline__ float operator()(int k, int n) const { return W[(size_t)k * N + n + noff]; } };

__device__ __forceinline__ float rel_bucket_bias(const float* rel_bias, int dist, int head) {
    int b;
    if (dist < 16) b = dist;
    else { const float t = (__log2f((float)dist) - 4.0f) * 2.66666675f; b = 16 + (int)t; if (b > 31) b = 31; }
    return rel_bias[b * 16 + head];
}

__device__ __forceinline__ void phase0(const Frame& F, const Args& a) {
    LAS float* scr = (LAS float*)(F.lds + F.wave * 16384);
    const int gw = F.bx * NWAVES + F.wave, NGW = F.G * NWAVES;
    unsigned char* ws = F.ws;
    constexpr int I_WIN = (D / 64) * (NZ / 32);
    constexpr int I_WB = (1024 / 64) * (1024 / 32);
    constexpr int I_WA = (512 / 64) * (1024 / 32);
    constexpr int I_WO = I_WB;
    constexpr int I_W1 = (2048 / 64) * (256 / 32);
    constexpr int I_W2 = (256 / 64) * (64 / 32);
    constexpr int I_GU = (1024 / 64) * (512 / 32);
    constexpr int I_DN = (256 / 64) * (1024 / 32);
    constexpr int NITEMS = I_WIN + I_WB + I_WA + I_WO + 2 * I_W1 + 2 * I_W2;
    for (int it = gw; it < NITEMS; it += NGW) {
        int r = it;
        if (r < I_WIN) { const int k0 = (r / (NZ / 32)) * 64, n0 = (r % (NZ / 32)) * 32;
            if (n0 >= 1280 && n0 < 2304) { const FWinQ f{a.in[1], a.in[9]}; p0_tile(f, (bf16*)(ws + WS_WINT), D, k0, n0, scr, F.lane); }
            else { const FWin f{a.in[1]}; p0_tile(f, (bf16*)(ws + WS_WINT), D, k0, n0, scr, F.lane); }
            continue; } r -= I_WIN;
        if (r < I_WB) { const FWb f{a.in[10], a.in[13]}; p0_tile(f, (bf16*)(ws + WS_WBT), 1024, (r / 32) * 64, (r % 32) * 32, scr, F.lane); continue; } r -= I_WB;
        if (r < I_WA) { const FPlain f{a.in[12], D}; p0_tile(f, (bf16*)(ws + WS_WAT), 512, (r / 32) * 64, (r % 32) * 32, scr, F.lane); continue; } r -= I_WA;
        if (r < I_WO) { const FPlain f{a.in[14], D}; p0_tile(f, (bf16*)(ws + WS_WOT), 1024, (r / 32) * 64, (r % 32) * 32, scr, F.lane); continue; } r -= I_WO;
        if (r < I_W1) { const FPlain f{a.in[4], 256}; p0_tile(f, (bf16*)(ws + WS_W1K), 2048, (r / 8) * 64, (r % 8) * 32, scr, F.lane); continue; } r -= I_W1;
        if (r < I_W1) { const FPlain f{a.in[6], 256}; p0_tile(f, (bf16*)(ws + WS_W1V), 2048, (r / 8) * 64, (r % 8) * 32, scr, F.lane); continue; } r -= I_W1;
        if (r < I_W2) { const FPlain f{a.in[5], 64}; p0_tile(f, (bf16*)(ws + WS_W2K), 256, (r / 2) * 64, (r % 2) * 32, scr, F.lane); continue; } r -= I_W2;
        { const FPlain f{a.in[7], 64}; p0_tile(f, (bf16*)(ws + WS_W2V), 256, (r / 2) * 64, (r % 2) * 32, scr, F.lane); }
    }
    {
        constexpr int NEI = NEXP * (I_GU + I_DN);
        auto mk = [&](int idx) { P0Item it; const int e = idx / (I_GU + I_DN); int r = idx - e * (I_GU + I_DN);
            if (r < I_GU) {
                const int n0 = (r % 16) * 32; const uintptr_t pg = (uintptr_t)a.in[21], pu = (uintptr_t)a.in[22];
                it.src = (const float*)(pg + (uintptr_t)((n0 >> 7) & 1) * (pu - pg)) + (size_t)e * D * DEXP; it.N = DEXP; it.noff = ((n0 >> 8) * 128 + (n0 & 127)) - n0;
                it.dst = (bf16*)(ws + WS_WGU) + (size_t)e * 512 * 1024; it.ldk = 1024; it.k0 = (r / 16) * 64; it.n0 = n0; }
            else { r -= I_GU; it.src = a.in[23] + (size_t)e * DEXP * D; it.N = D; it.noff = 0; it.dst = (bf16*)(ws + WS_WDT) + (size_t)e * 1024 * 256; it.ldk = 256; it.k0 = (r / 32) * 64; it.n0 = (r % 32) * 32; }
            return it; };
        float va[32], vb[32];
        int idx = gw;
        if (idx < NEI) { P0Item cur = mk(idx); p0_item_load(cur, va, F.lane);
            for (;;) {
                const int nidx = idx + NGW; const bool more = nidx < NEI; P0Item nxt = cur;
                if (more) { nxt = mk(nidx); p0_item_load(nxt, vb, F.lane); }
                p0_item_finish(cur, va, scr, F.lane);
                if (!more) break;
#pragma unroll
                for (int i = 0; i < 32; ++i) va[i] = vb[i];
                cur = nxt; idx = nidx; } }
    }
    { const f32x4* x4 = (const f32x4*)a.in[0]; u32x2* o = (u32x2*)(ws + WS_XB);
      const size_t total = (size_t)NTOK * D / 4, stride = (size_t)F.G * NTHR;
      for (size_t i0 = (size_t)F.bx * NTHR + F.tid; i0 < total; i0 += 8 * stride) { f32x4 v[8];
#pragma unroll
          for (int j = 0; j < 8; ++j) { const size_t i = i0 + j * stride; v[j] = i < total ? x4[i] : (f32x4){0.f, 0.f, 0.f, 0.f}; }
#pragma unroll
          for (int j = 0; j < 8; ++j) { const size_t i = i0 + j * stride; if (i < total) { u32x2 w; w.x = pk2(v[j][0], v[j][1]); w.y = pk2(v[j][2], v[j][3]); o[i] = w; } } } }
    if (F.bx < 64 && F.tid < 256) {
        const int kv = F.bx >> 5, j = F.bx & 31;
        const float* pe = (kv ? a.in[3] : a.in[2]) + 64 * j; const float* w1 = (kv ? a.in[6] : a.in[4]) + (size_t)(64 * j) * 256 + F.tid; float acc = 0.f;
#pragma unroll 16
        for (int k = 0; k < 64; ++k) acc += pe[k] * w1[(size_t)k * 256];
        ((float*)(ws + WS_BIASK))[(kv * 32 + j) * 256 + F.tid] = acc;
    }
    if (F.bx >= 64 && F.bx < 96) { const int idx = (F.bx - 64) * NTHR + F.tid;
        const int tab = idx >> 13, head = (idx >> 10) & 7, dist = idx & 1023;
        ((float*)(ws + (tab ? WS_TBB : WS_TBA)))[head * 1024 + dist] = rel_bucket_bias(a.in[11], dist, tab * 8 + head) * LOG2E; }
}

constexpr int NRT = 36;
constexpr int P6_WR = 0;
constexpr int P6_CNT = 147456;
constexpr int P6_ENT = 147456 + 512;
__device__ __forceinline__ float row16_sum(float v) {
    v += __builtin_bit_cast(float, __builtin_amdgcn_update_dpp(0, __builtin_bit_cast(int, v), 0xB1, 0xf, 0xf, true));
    v += __builtin_bit_cast(float, __builtin_amdgcn_update_dpp(0, __builtin_bit_cast(int, v), 0x4E, 0xf, 0xf, true));
    v += __builtin_bit_cast(float, __builtin_amdgcn_update_dpp(0, __builtin_bit_cast(int, v), 0x141, 0xf, 0xf, true));
    v += __builtin_bit_cast(float, __builtin_amdgcn_update_dpp(0, __builtin_bit_cast(int, v), 0x140, 0xf, 0xf, true));
    return v;
}
__device__ __forceinline__ float wave_sum_dpp(float v) { v = row16_sum(v); v += __shfl_xor(v, 16); v += __shfl_xor(v, 32); return v; }
__device__ __forceinline__ void phase6(const Frame& F, const Args& a) {
    unsigned char* ws = F.ws;
    LAS float* WR = (LAS float*)(F.lds + P6_WR);
    LAS int* cntL = (LAS int*)(F.lds + P6_CNT); LAS int* baseL = cntL + 32;
    LAS int* ent = (LAS int*)(F.lds + P6_ENT);
    const float* w_grp = a.in[17]; const float* b_grp = a.in[18]; const float* w_rtr = a.in[19]; const float* b_rtr = a.in[20];
    for (int i = F.tid; i < NRT * 1024; i += NTHR) { const int o = i >> 10, k = i & 1023; WR[i] = o < 4 ? w_grp[k * 4 + o] : w_rtr[k * 32 + (o - 4)]; }
    if (F.tid < 65) cntL[F.tid] = 0;
    __syncthreads();
    const bf16* HP = (const bf16*)(ws + WS_H1); bf16* H1B = (bf16*)(ws + WS_H1B);
    const float* lg = a.in[15]; const float* lb = a.in[16];
    f32x2 gam[8], bet[8];
#pragma unroll
    for (int j = 0; j < 2; ++j)
#pragma unroll
        for (int q = 0; q < 4; ++q) { gam[4 * j + q] = *(const f32x2*)(lg + 512 * j + 8 * F.lane + 2 * q); bet[4 * j + q] = *(const f32x2*)(lb + 512 * j + 8 * F.lane + 2 * q); }
    unsigned* gcnt = (unsigned*)(ws + WS_CTL) + CW_CNT;
    int* list = (int*)(ws + WS_LIST); float* tokinfo = (float*)(ws + WS_TOKINFO);
    const int gw = F.bx * NWAVES + F.wave, NGW = F.G * NWAVES;
    u32x4 nx0, nx1;
    if (gw < NTOK) { const u32x4* hr = (const u32x4*)(HP + (size_t)gw * D) + F.lane; nx0 = hr[0]; nx1 = hr[64]; }
    for (int row = gw; row < NTOK; row += NGW) {
        const u32x4 r0 = nx0, r1 = nx1;
        if (row + NGW < NTOK) { const u32x4* hr = (const u32x4*)(HP + (size_t)(row + NGW) * D) + F.lane; nx0 = hr[0]; nx1 = hr[64]; }
        f32x2 v[8];
        v[0] = (f32x2){bflo(r0.x), bfhi(r0.x)}; v[1] = (f32x2){bflo(r0.y), bfhi(r0.y)}; v[2] = (f32x2){bflo(r0.z), bfhi(r0.z)}; v[3] = (f32x2){bflo(r0.w), bfhi(r0.w)};
        v[4] = (f32x2){bflo(r1.x), bfhi(r1.x)}; v[5] = (f32x2){bflo(r1.y), bfhi(r1.y)}; v[6] = (f32x2){bflo(r1.z), bfhi(r1.z)}; v[7] = (f32x2){bflo(r1.w), bfhi(r1.w)};
        f32x2 s2 = v[0];
#pragma unroll
        for (int q = 1; q < 8; ++q) s2 += v[q];
        const float mean = wave_sum_dpp(s2[0] + s2[1]) * (1.f / D);
        f32x2 q2 = {0.f, 0.f};
#pragma unroll
        for (int q = 0; q < 8; ++q) { v[q] = v[q] - mean; q2 += v[q] * v[q]; }
        const float rstd = 1.0f / sqrtf(wave_sum_dpp(q2[0] + q2[1]) * (1.f / D) + 1e-5f);
#pragma unroll
        for (int q = 0; q < 8; ++q) v[q] = v[q] * rstd * gam[q] + bet[q];
        { u32x4 w0, w1; w0.x = pk2(v[0][0], v[0][1]); w0.y = pk2(v[1][0], v[1][1]); w0.z = pk2(v[2][0], v[2][1]); w0.w = pk2(v[3][0], v[3][1]);
          w1.x = pk2(v[4][0], v[4][1]); w1.y = pk2(v[5][0], v[5][1]); w1.z = pk2(v[6][0], v[6][1]); w1.w = pk2(v[7][0], v[7][1]);
          u32x4* ob = (u32x4*)(H1B + (size_t)row * D) + F.lane; ob[0] = w0; ob[64] = w1; }
        float L[NRT];
#pragma unroll
        for (int o = 0; o < NRT; ++o) { f32x2 p2 = {0.f, 0.f};
#pragma unroll
            for (int j = 0; j < 2; ++j) { const f32x4 wa = *(const LAS f32x4*)(WR + o * 1024 + 512 * j + 8 * F.lane), wb = *(const LAS f32x4*)(WR + o * 1024 + 512 * j + 8 * F.lane + 4);
                p2 += v[4 * j] * (f32x2){wa[0], wa[1]}; p2 += v[4 * j + 1] * (f32x2){wa[2], wa[3]}; p2 += v[4 * j + 2] * (f32x2){wb[0], wb[1]}; p2 += v[4 * j + 3] * (f32x2){wb[2], wb[3]}; }
            L[o] = row16_sum(p2[0] + p2[1]); }
#pragma unroll
        for (int o = 0; o < NRT; ++o) { float t = L[o]; t += __shfl_xor(t, 16); t += __shfl_xor(t, 32); L[o] = t; }
        float g[4];
#pragma unroll
        for (int i = 0; i < 4; ++i) g[i] = L[i] + b_grp[i];
        int gs = 0; float gm = g[0];
#pragma unroll
        for (int i = 1; i < 4; ++i) if (g[i] > gm) { gm = g[i]; gs = i; }
        float gsum = 0.f;
#pragma unroll
        for (int i = 0; i < 4; ++i) gsum += __expf(g[i] - gm);
        const float pgrp = 1.0f / gsum;
        float el[8];
#pragma unroll
        for (int i = 0; i < 8; ++i) { const float x0 = L[4 + i], x1 = L[12 + i], x2 = L[20 + i], x3 = L[28 + i]; el[i] = (gs == 0 ? x0 : gs == 1 ? x1 : gs == 2 ? x2 : x3) + b_rtr[gs * 8 + i]; }
        int i1 = 0; float l1 = el[0];
#pragma unroll
        for (int i = 1; i < 8; ++i) if (el[i] > l1) { l1 = el[i]; i1 = i; }
        int i2 = -1; float l2 = -3.0e38f;
#pragma unroll
        for (int i = 0; i < 8; ++i) if (i != i1 && el[i] > l2) { l2 = el[i]; i2 = i; }
        const float e2 = __expf(l2 - l1), inv = 1.0f / (1.0f + e2);
        const float w0 = pgrp * inv, w1 = pgrp * e2 * inv;
        const int e0 = gs * 8 + i1, e1 = gs * 8 + i2;
        if (F.lane == 0) {
            const int p0 = atomicAdd((int*)&cntL[e0], 1), p1 = atomicAdd((int*)&cntL[e1], 1);
            const int n0 = atomicAdd((int*)&cntL[64], 2);
            ent[2 * n0] = (e0 << 16) | p0; ent[2 * n0 + 1] = row * 2;
            ent[2 * n0 + 2] = (e1 << 16) | p1; ent[2 * n0 + 3] = row * 2 + 1;
            tokinfo[row * 2] = w0; tokinfo[row * 2 + 1] = w1;
        }
    }
    __syncthreads();
    if (F.tid < 32) { const int c = cntL[F.tid]; baseL[F.tid] = c > 0 ? (int)__hip_atomic_fetch_add(gcnt + 64 * F.tid, (unsigned)c, __ATOMIC_RELAXED, __HIP_MEMORY_SCOPE_AGENT) : 0; }
    __syncthreads();
    const int nent = cntL[64];
    for (int i = F.tid; i < nent; i += NTHR) { const int ep = ent[2 * i], tk = ent[2 * i + 1]; const int e = ep >> 16, p = ep & 0xffff; list[(size_t)e * NTOK + baseL[e] + p] = tk; }
    __syncthreads();
}

constexpr int MOE_CUM = 131072;
struct MoeOrder {
    int G, c, NP; const LAS int* cum; const LAS int* cnt;
    __device__ bool next(int i, pg8::Unit& u) const {
        const int L = i * G + c, t = L / NP; if (t >= cum[32]) return false;
        const int e = cum[80 + t];
        const int j = t - cum[e]; u.pm = t; u.pn = L % NP; u.e = e | (j << 8); const int rem = cnt[e] - j * 256; u.nrows = rem < 256 ? rem : 256; return true;
    }
};
__device__ __forceinline__ void moe_setup(const Frame& F) {
    LAS int* cum = (LAS int*)(F.lds + MOE_CUM); LAS int* cnt = cum + 40;
    const unsigned* gcnt = (const unsigned*)(F.ws + WS_CTL) + CW_CNT;
    if (F.tid == 0) { int s = 0; for (int e = 0; e < 32; ++e) { const int c = (int)__hip_atomic_load(gcnt + 64 * e, __ATOMIC_RELAXED, __HIP_MEMORY_SCOPE_AGENT); cnt[e] = c; cum[e] = s; s += (c + 255) >> 8; } cum[32] = s; }
    __syncthreads();
    for (int t = F.tid; t < cum[32]; t += NTHR) { int e = 0; for (int k = 1; k < 32; ++k) if (t >= cum[k]) e = k; cum[80 + t] = e; }
    __syncthreads();
}
struct AGather { const void* base; unsigned kstep; const int* list;
    static constexpr bool GATHER = true;
    __device__ __forceinline__ const void* unit_ptr(const pg8::Unit&) const { return base; }
    __device__ __forceinline__ unsigned lane_off(int, int) const { return 0u; }
    __device__ __forceinline__ size_t hstep() const { return 0; }
    __device__ __forceinline__ unsigned row_off(const pg8::Unit& u, int r) const { const int e = u.e & 255, j = u.e >> 8; const int rr = r < u.nrows ? r : 0;
        const int tk = list[(size_t)e * NTOK + j * 256 + rr]; return (unsigned)(tk >> 1) * (unsigned)(D * 2); } };
struct BGu { const bf16* W; __device__ __forceinline__ const void* ptr(const pg8::Unit& u) const { return W + (size_t)(u.e & 255) * 512 * 1024 + (size_t)u.pn * 256 * 1024; } };
struct BDn { const bf16* W; __device__ __forceinline__ const void* ptr(const pg8::Unit& u) const { return W + (size_t)(u.e & 255) * 1024 * 256 + (size_t)u.pn * 256 * 256; } };
struct EpiAct {
    static constexpr bool PERM = true; bf16* ACT;
    __device__ __forceinline__ void operator()(const f32x4 (&acc)[2][2][4][2], const pg8::Unit& u, int wr, int wc, int fr, int fq) const {
        const int row0 = u.pm * 256 + wr * 64 + fr, col0 = u.pn * 128 + wc * 32 + 8 * fq;
#pragma unroll
        for (int ai = 0; ai < 2; ++ai)
#pragma unroll
            for (int m = 0; m < 4; ++m) { float o[8];
#pragma unroll
                for (int n = 0; n < 2; ++n)
#pragma unroll
                    for (int j = 0; j < 4; ++j) { const float gt = acc[ai][0][m][n][j], up = acc[ai][1][m][n][j]; o[4 * n + j] = gt * sigmoidf_(gt) * up; }
                u32x4 w; w.x = pk2(o[0], o[1]); w.y = pk2(o[2], o[3]); w.z = pk2(o[4], o[5]); w.w = pk2(o[6], o[7]);
                *(u32x4*)(ACT + (size_t)(row0 + ai * 128 + m * 16) * DEXP + col0) = w; }
    }
};
struct EpiDown {
    static constexpr bool PERM = true; bf16* Y; const int* list;
    __device__ __forceinline__ void operator()(const f32x4 (&acc)[2][2][4][2], const pg8::Unit& u, int wr, int wc, int fr, int fq) const {
        const int e = u.e & 255, j = u.e >> 8; const int col0 = u.pn * 256 + wc * 32 + 8 * fq;
#pragma unroll
        for (int ai = 0; ai < 2; ++ai)
#pragma unroll
            for (int m = 0; m < 4; ++m) { const int r = ai * 128 + wr * 64 + m * 16 + fr;
                if (r < u.nrows) { const int tk = list[(size_t)e * NTOK + j * 256 + r]; bf16* rowp = Y + (size_t)tk * D + col0;
#pragma unroll
                    for (int bj = 0; bj < 2; ++bj) { const f32x4 v0 = acc[ai][bj][m][0], v1 = acc[ai][bj][m][1];
                        u32x4 w; w.x = pk2(v0[0], v0[1]); w.y = pk2(v0[2], v0[3]); w.z = pk2(v1[0], v1[1]); w.w = pk2(v1[2], v1[3]);
                        *(u32x4*)(rowp + bj * 128) = w; } }
                asm volatile("" ::: "memory"); }
    }
};

__device__ __forceinline__ void phase9(const Frame& F, const Args& a) {
    unsigned char* ws = F.ws;
    const bf16* H1B = (const bf16*)(ws + WS_H1B); const bf16* Y = (const bf16*)(ws + WS_YBUF); const float* tokinfo = (const float*)(ws + WS_TOKINFO);
    const float* lg = a.in[24]; const float* lb = a.in[25];
    f32x4 gam[4], bet[4];
#pragma unroll
    for (int j = 0; j < 2; ++j) { gam[2 * j] = *(const f32x4*)(lg + 512 * j + 8 * F.lane); gam[2 * j + 1] = *(const f32x4*)(lg + 512 * j + 8 * F.lane + 4); bet[2 * j] = *(const f32x4*)(lb + 512 * j + 8 * F.lane); bet[2 * j + 1] = *(const f32x4*)(lb + 512 * j + 8 * F.lane + 4); }
    const int gw = F.bx * NWAVES + F.wave, NGW = F.G * NWAVES;
    u32x4 nh[2], ny0[2], ny1[2]; float nw0 = 0.f, nw1 = 0.f;
#define P9_LOAD(row_) do { const u32x4* hp_ = (const u32x4*)(H1B + (size_t)(row_) * D) + F.lane; const u32x4* y0_ = (const u32x4*)(Y + (size_t)((row_) * 2) * D) + F.lane; const u32x4* y1_ = (const u32x4*)(Y + (size_t)((row_) * 2 + 1) * D) + F.lane; \
        nh[0] = hp_[0]; nh[1] = hp_[64]; ny0[0] = y0_[0]; ny0[1] = y0_[64]; ny1[0] = y1_[0]; ny1[1] = y1_[64]; nw0 = tokinfo[(row_) * 2]; nw1 = tokinfo[(row_) * 2 + 1]; } while (0)
    if (gw < NTOK) P9_LOAD(gw);
    for (int row = gw; row < NTOK; row += NGW) {
        u32x4 h[2] = {nh[0], nh[1]}, p[2] = {ny0[0], ny0[1]}, q[2] = {ny1[0], ny1[1]}; const float w0 = nw0, w1 = nw1;
        if (row + NGW < NTOK) P9_LOAD(row + NGW);
        f32x4 v[4]; float s = 0.f;
#pragma unroll
        for (int j = 0; j < 2; ++j) {
            v[2 * j][0] = ALPHA * bflo(h[j].x) + w0 * bflo(p[j].x) + w1 * bflo(q[j].x); v[2 * j][1] = ALPHA * bfhi(h[j].x) + w0 * bfhi(p[j].x) + w1 * bfhi(q[j].x);
            v[2 * j][2] = ALPHA * bflo(h[j].y) + w0 * bflo(p[j].y) + w1 * bflo(q[j].y); v[2 * j][3] = ALPHA * bfhi(h[j].y) + w0 * bfhi(p[j].y) + w1 * bfhi(q[j].y);
            v[2 * j + 1][0] = ALPHA * bflo(h[j].z) + w0 * bflo(p[j].z) + w1 * bflo(q[j].z); v[2 * j + 1][1] = ALPHA * bfhi(h[j].z) + w0 * bfhi(p[j].z) + w1 * bfhi(q[j].z);
            v[2 * j + 1][2] = ALPHA * bflo(h[j].w) + w0 * bflo(p[j].w) + w1 * bflo(q[j].w); v[2 * j + 1][3] = ALPHA * bfhi(h[j].w) + w0 * bfhi(p[j].w) + w1 * bfhi(q[j].w); }
#pragma unroll
        for (int j = 0; j < 4; ++j) s += (v[j][0] + v[j][1]) + (v[j][2] + v[j][3]);
        const float mean = wave_sum_dpp(s) * (1.f / D); float s2 = 0.f;
#pragma unroll
        for (int j = 0; j < 4; ++j) { v[j] = v[j] - mean; s2 += (v[j][0] * v[j][0] + v[j][1] * v[j][1]) + (v[j][2] * v[j][2] + v[j][3] * v[j][3]); }
        const float rstd = 1.0f / sqrtf(wave_sum_dpp(s2) * (1.f / D) + 1e-5f);
        float* orow = a.out + (size_t)row * D + 8 * F.lane;
#pragma unroll
        for (int j = 0; j < 2; ++j) { *(f32x4*)(orow + 512 * j) = v[2 * j] * rstd * gam[2 * j] + bet[2 * j]; *(f32x4*)(orow + 512 * j + 4) = v[2 * j + 1] * rstd * gam[2 * j + 1] + bet[2 * j + 1]; }
    }
#undef P9_LOAD
}
#define MFMA32(a, b, c) __builtin_amdgcn_mfma_f32_32x32x16_bf16((a), (b), (c), 0, 0, 0)
__device__ __forceinline__ int crow(int r, int hi) { return (r & 3) + 8 * (r >> 2) + 4 * hi; }
__device__ __forceinline__ float gelu_tanh(float x) { const float u = 0.7978845608028654f * (x + 0.044715f * x * x * x); const float e = __expf(2.0f * u); return 0.5f * x * (2.0f - 2.0f / (e + 1.0f)); }
constexpr int P2_AROW = 4096 + 16;
constexpr int P2_HID = 32 * P2_AROW;
constexpr int P2_HROW = 512 + 16;
__device__ __forceinline__ void phase2(const Frame& F, const Args& a) {
    unsigned char* ws = F.ws;
    const bf16* ZA = (const bf16*)(ws + WS_ZA);
    { const float* gn = a.in[8]; bf16* CK = (bf16*)(ws + WS_CKVN);
      const int sub = F.lane >> 4, l16 = F.lane & 15;
      float gv[8];
#pragma unroll
      for (int j = 0; j < 8; ++j) gv[j] = gn[l16 * 8 + j];
      for (int r4 = F.bx * NWAVES + F.wave; r4 < NTOK / 4; r4 += F.G * NWAVES) { const int row = r4 * 4 + sub;
          const u32x4 w = *(const u32x4*)(ZA + (size_t)row * ZA_LD + ZC_CKV + l16 * 8);
          float v[8] = { bflo(w.x), bfhi(w.x), bflo(w.y), bfhi(w.y), bflo(w.z), bfhi(w.z), bflo(w.w), bfhi(w.w) };
          float s = 0.f;
#pragma unroll
          for (int j = 0; j < 8; ++j) s += v[j] * v[j];
          s += __shfl_xor(s, 1); s += __shfl_xor(s, 2); s += __shfl_xor(s, 4); s += __shfl_xor(s, 8);
          const float rs = 1.0f / sqrtf(s * (1.0f / 128.0f) + 1e-6f);
          u32x4 o; o.x = pk2(v[0] * rs * gv[0], v[1] * rs * gv[1]); o.y = pk2(v[2] * rs * gv[2], v[3] * rs * gv[3]); o.z = pk2(v[4] * rs * gv[4], v[5] * rs * gv[5]); o.w = pk2(v[6] * rs * gv[6], v[7] * rs * gv[7]);
          *(u32x4*)(CK + (size_t)row * 128 + l16 * 8) = o; } }
    const int r32 = F.lane & 31, hi = F.lane >> 5;
    for (int u = F.bx; u < 256; u += F.G) {
        const int kv = u >> 7, rt = u & 127, R0 = rt * 32;
        const int zc = kv ? ZC_VC : ZC_KC;
        const bf16* W1T = (const bf16*)(ws + (kv ? WS_W1V : WS_W1K)); const bf16* W2T = (const bf16*)(ws + (kv ? WS_W2V : WS_W2K));
        const float* bias = (const float*)(ws + WS_BIASK) + (size_t)kv * 32 * 256;
        bf16* OUT = (bf16*)(ws + (kv ? WS_VCMP : WS_KCMP));
        __syncthreads();
        for (int q = F.tid; q < 32 * 256; q += NTHR) { const int row = q >> 8, cq = q & 255, l = cq >> 3, dch = cq & 7;
            const int R = R0 + row, b = R >> 9, c = (R >> 1) & 255, g = R & 1; const int cc = c < NCMP ? c : NCMP - 1;
            const u32x4 v = *(const u32x4*)(ZA + (size_t)(b * SEQ + 16 * cc + l) * ZA_LD + zc + g * 64 + dch * 8);
            *(LAS u32x4*)(F.lds + row * P2_AROW + cq * 16) = v; }
        __syncthreads();
        f32x16 acc = {};
        { const bf16* bp = W1T + (size_t)(32 * F.wave + r32) * 2048 + 8 * hi; const LAS unsigned char* ap = F.lds + r32 * P2_AROW + 16 * hi;
#pragma unroll 8
          for (int s = 0; s < 128; ++s) { const bf16x8 af = *(const LAS bf16x8*)(ap + s * 32); const bf16x8 bfr = *(const bf16x8*)(bp + s * 16); acc = MFMA32(af, bfr, acc); } }
        { float bs = 0.f;
#pragma unroll 8
          for (int j = 0; j < 32; ++j) bs += bias[j * 256 + 32 * F.wave + r32];
#pragma unroll
          for (int i = 0; i < 16; ++i) { const float h = gelu_tanh(acc[i] + bs); *(LAS unsigned short*)(F.lds + P2_HID + crow(i, hi) * P2_HROW + (32 * F.wave + r32) * 2) = (unsigned short)f2bf(h); } }
        __syncthreads();
        if (F.wave < 2) {
            f32x16 o2 = {};
            const bf16* bp = W2T + (size_t)(32 * F.wave + r32) * 256 + 8 * hi; const LAS unsigned char* ap = F.lds + P2_HID + r32 * P2_HROW + 16 * hi;
#pragma unroll
            for (int s = 0; s < 16; ++s) { const bf16x8 af = *(const LAS bf16x8*)(ap + s * 32); const bf16x8 bfr = *(const bf16x8*)(bp + s * 16); o2 = MFMA32(af, bfr, o2); }
#pragma unroll
            for (int i = 0; i < 16; ++i) OUT[(size_t)(R0 + crow(i, hi)) * 64 + 32 * F.wave + r32] = (bf16)f2bf(o2[i]);
        }
    }
    __syncthreads();
}

typedef short v4i16_t __attribute__((ext_vector_type(4)));
__device__ __forceinline__ s16x4 vtr(const LAS unsigned char* p) { return __builtin_bit_cast(s16x4, __builtin_amdgcn_ds_read_tr16_b64_v4i16((LAS v4i16_t*)p)); }
constexpr int NSA_K = 0;
constexpr int NSA_V = 16384;
constexpr int NSA_TB = 49152;
constexpr int NSA_SC = 65536;
constexpr int NSA_MSK = 81920;
constexpr int NSA_OF = 83968;
constexpr float C2 = 0.125f * LOG2E;

__device__ __forceinline__ void nsa_tile(const LAS unsigned char* Kb, const LAS unsigned char* Vb, const LAS float* tbh, const bf16x8 (&qr)[4], f32x16 (&o)[2], float& m, float& l,
                                         int kt, int tq, int kmul, int kadd, int dmax, bool selbit, int mode, float b31, int r32, int hi, int lane) {
    const int tqa = tq - kadd, qk = kmul == 16 ? (tqa >> 4) : tqa, rem = kmul == 16 ? (tqa & 15) : 0;
    const int ebase = qk - (kt * 64 + 4 * hi);
    const LAS unsigned char* vp0 = Vb + ((lane >> 4) & 1) * 32 + (lane & 3) * 8 + (4 * hi + ((lane & 15) >> 2)) * 64;
#pragma unroll
    for (int hf = 0; hf < 2; ++hf) {
        f32x16 s0 = {};
#pragma unroll
        for (int d0 = 0; d0 < 4; ++d0) { const bf16x8 k0 = *(const LAS bf16x8*)(Kb + (2 * d0 + hi) * 1024 + (r32 + 32 * hf) * 16); s0 = MFMA32(k0, qr[d0], s0); }
        float tmax, mn, ps = 0.f;
        if (mode == 2) {
            float a0 = fmaxf(fmaxf(s0[0], s0[1]), s0[2]), a1 = fmaxf(fmaxf(s0[3], s0[4]), s0[5]);
            a0 = fmaxf(fmaxf(a0, s0[6]), s0[7]); a1 = fmaxf(fmaxf(a1, s0[8]), s0[9]); a0 = fmaxf(fmaxf(a0, s0[10]), s0[11]); a1 = fmaxf(fmaxf(a1, s0[12]), s0[13]); a0 = fmaxf(fmaxf(a0, s0[14]), s0[15]);
            const float cb = selbit ? b31 : NEGBIG;
            tmax = fmaxf(a0, a1) * C2 + cb;
            tmax = fmaxf(tmax, __shfl_xor(tmax, 32));
            mn = fmaxf(m, tmax);
            const float cc = cb - mn;
#pragma unroll
            for (int r = 0; r < 16; ++r) { const float p0 = __builtin_amdgcn_exp2f(s0[r] * C2 + cc); s0[r] = p0; ps += p0; }
        } else if (mode == 1) {
            int eb1 = ebase; asm volatile("" : "+v"(eb1));
            const LAS float* tb1 = tbh + (eb1 - 96);
            float bv[16];
#pragma unroll
            for (int r = 0; r < 16; ++r) bv[r] = tb1[96 - ((r & 3) + 8 * (r >> 2) + 32 * hf)];
#pragma unroll
            for (int r = 0; r < 16; ++r) asm volatile("" : "+v"(bv[r]));
            tmax = NEGBIG;
#pragma unroll
            for (int r = 0; r < 16; ++r) { const float x = s0[r] * C2 + bv[r]; s0[r] = x; tmax = fmaxf(tmax, x); }
            tmax = selbit ? tmax : NEGBIG;
            tmax = fmaxf(tmax, __shfl_xor(tmax, 32));
            mn = fmaxf(m, tmax);
            const float mne = selbit ? mn : 1e30f;
#pragma unroll
            for (int r = 0; r < 16; ++r) { const float p0 = __builtin_amdgcn_exp2f(s0[r] - mne); s0[r] = p0; ps += p0; }
        } else {
            tmax = NEGBIG;
            float bv[16];
            int eb0 = ebase; asm volatile("" : "+v"(eb0));
#pragma unroll
            for (int r = 0; r < 16; ++r) { const int dist = __mul24(eb0 - ((r & 3) + 8 * (r >> 2) + 32 * hf), kmul) + rem; int dc = dist < 0 ? 0 : dist; dc = dc > 1023 ? 1023 : dc; bv[r] = tbh[dc]; }
#pragma unroll
            for (int r = 0; r < 16; ++r) asm volatile("" : "+v"(bv[r]));
#pragma unroll
            for (int r = 0; r < 16; ++r) { const int dist = __mul24(eb0 - ((r & 3) + 8 * (r >> 2) + 32 * hf), kmul) + rem;
                const bool valid = selbit && dist >= 0 && dist < dmax;
                const float x = valid ? s0[r] * C2 + bv[r] : NEGBIG;
                s0[r] = x; tmax = fmaxf(tmax, x); }
            tmax = fmaxf(tmax, __shfl_xor(tmax, 32));
            mn = fmaxf(m, tmax);
#pragma unroll
            for (int r = 0; r < 16; ++r) { const float p0 = s0[r] > -1e29f ? __builtin_amdgcn_exp2f(s0[r] - mn) : 0.f; s0[r] = p0; ps += p0; }
        }
        if (__any(mn != m)) {
            const float alpha = __builtin_amdgcn_exp2f(m - mn);
            l *= alpha;
#pragma unroll
            for (int c = 0; c < 2; ++c)
#pragma unroll
                for (int r = 0; r < 16; ++r) o[c][r] *= alpha;
        }
        m = mn;
        l += ps;
        u32x4 pw[2];
#pragma unroll
        for (int q = 0; q < 4; ++q) { pw[0][q] = pk2(s0[2 * q], s0[2 * q + 1]); pw[1][q] = pk2(s0[8 + 2 * q], s0[8 + 2 * q + 1]); }
#pragma unroll
        for (int c = 0; c < 2; ++c)
#pragma unroll
            for (int s2 = 0; s2 < 2; ++s2) { const int s = 2 * hf + s2; const s16x4 vl = vtr(vp0 + c * 4096 + s * 1024), vh = vtr(vp0 + c * 4096 + s * 1024 + 512);
                const bf16x8 vf = {vl[0], vl[1], vl[2], vl[3], vh[0], vh[1], vh[2], vh[3]};
                o[c] = MFMA32(vf, __builtin_bit_cast(bf16x8, pw[s2]), o[c]); }
    }
}

__device__ __forceinline__ void nsa_unit(const Frame& F, int b, int g, int qt) {
    unsigned char* ws = F.ws;
    const bf16* ZA = (const bf16*)(ws + WS_ZA);
    const int r32 = F.lane & 31, hi = F.lane >> 5, qi = r32 >> 2, hh = r32 & 3, head = g * 4 + hh;
    const int q0 = qt * 64, tq = q0 + 8 * F.wave + qi;
    const size_t zrow = (size_t)(b * SEQ + tq) * ZA_LD;
    const int srow = F.tid >> 3, sch = F.tid & 7;
    __syncthreads();
    { const float* TBA = (const float*)(ws + WS_TBA) + (size_t)g * 4 * 1024; LAS float* tb = (LAS float*)(F.lds + NSA_TB);
      for (int i = F.tid; i < 4096; i += NTHR) tb[i] = TBA[i]; }
    const LAS float* tbh = (const LAS float*)(F.lds + NSA_TB) + hh * 1024;
    const int wq0 = q0 + 8 * F.wave;
    const float b31 = ((const float*)(ws + WS_TBA))[(size_t)head * 1024 + 1023];
    bf16x8 qr[4];
#pragma unroll
    for (int d0 = 0; d0 < 4; ++d0) qr[d0] = *(const bf16x8*)(ZA + zrow + ZC_QA + head * 64 + d0 * 16 + hi * 8);
    float gate[3];
#pragma unroll
    for (int i = 0; i < 3; ++i) gate[i] = sigmoidf_(bf2f(ZA[zrow + ZC_GNSA + head * 3 + i]));
    LAS float* ofw = (LAS float*)(F.lds + NSA_OF) + F.wave * 2048 + F.lane;
    unsigned mlo = 0u, mhi = 0u; float inv_cmp = 0.f;
#pragma nounroll
    for (int br = 0; br < 4; ++br) {
        const bool iscmp = br < 2, vmap = br == 1;
        const bf16* Kg; const bf16* Vg; size_t pitch; int t_lo, t_hi;
        if (iscmp) { Kg = (const bf16*)(ws + WS_KCMP) + (size_t)(b * 256) * 128 + g * 64; Vg = (const bf16*)(ws + WS_VCMP) + (size_t)(b * 256) * 128 + g * 64; pitch = 128; t_lo = 0; t_hi = (q0 + 32) >> 10; }
        else { const int kc = br == 2 ? ZC_KS : ZC_KW; Kg = ZA + (size_t)(b * SEQ) * ZA_LD + kc + g * 64; Vg = Kg + 128; pitch = ZA_LD; t_lo = (br == 3 && qt > 8) ? qt - 8 : 0; t_hi = qt; }
        const int kmul = iscmp ? 16 : 1, kadd = iscmp ? 31 : 0, dmax = br == 3 ? 512 : 0x40000000;
        f32x16 o[2]; o[0] = f32x16{}; o[1] = f32x16{};
        float m = NEGBIG, l = 0.f;
        u32x4 kreg, vreg = {0u, 0u, 0u, 0u};
#define NSA_GLOAD(kt_) do { const size_t off_ = (size_t)((kt_) * 64 + srow) * pitch + sch * 8; kreg = *(const u32x4*)(Kg + off_); if (!vmap) vreg = *(const u32x4*)(Vg + off_); } while (0)
#define NSA_LSTORE(kt_, buf_) do { \
        *(LAS u32x4*)(F.lds + NSA_K + (buf_) * 8192 + sch * 1024 + srow * 16) = kreg; \
        if (vmap) { const int c_ = (kt_) * 64 + srow, jj_ = c_ >> 2, mm_ = c_ & 3; \
            _Pragma("unroll") for (int i_ = 0; i_ < 4; ++i_) { const int j0_ = sch * 8 + 2 * i_, j1_ = j0_ + 1; \
                const unsigned e0_ = (c_ < NCMP) ? (mm_ < 3 ? (j0_ == jj_ ? 0x4000u : 0u) : ((j0_ == jj_ || j0_ == jj_ + 1) ? 0x3F80u : 0u)) : 0u; \
                const unsigned e1_ = (c_ < NCMP) ? (mm_ < 3 ? (j1_ == jj_ ? 0x4000u : 0u) : ((j1_ == jj_ || j1_ == jj_ + 1) ? 0x3F80u : 0u)) : 0u; \
                vreg[i_] = e0_ | (e1_ << 16); } } \
        *(LAS u32x4*)(F.lds + NSA_V + (buf_) * 8192 + (sch >> 2) * 4096 + srow * 64 + (sch & 3) * 16) = vreg; } while (0)
        __syncthreads();
        NSA_GLOAD(t_lo); NSA_LSTORE(t_lo, 0);
        __syncthreads();
        int buf = 0;
#ifndef PROBE_NSA
#define PROBE_NSA -1
#endif
        const int ntile = t_hi - t_lo + 1, nrun = (PROBE_NSA == br || (PROBE_NSA == 0 && br == 1)) ? 2 * ntile : ntile;
#pragma nounroll
        for (int it = 0; it < nrun; ++it) {
            const int kt = t_lo + (it >= ntile ? it - ntile : it), ktn = t_lo + (it + 1 >= ntile ? it + 1 - ntile : it + 1);
            if (it + 1 < nrun) NSA_GLOAD(ktn);
            const bool selbit = br == 2 ? (((kt < 32 ? (mlo >> kt) : (mhi >> (kt - 32))) & 1u) != 0u) : true;
            int mode = 0;
            { const int dmin = wq0 - (64 * kt + 63), dmx = wq0 + 7 - 64 * kt;
              if (br == 2) mode = dmin >= 790 ? 2 : (dmin >= 0 ? 1 : 0);
              if (br < 2) mode = 16 * (((wq0 - 31) >> 4) - (64 * kt + 63)) >= 790 ? 2 : 0;
              if (br == 3) mode = (dmin >= 0 && dmx <= 511) ? 1 : 0; }
            nsa_tile(F.lds + NSA_K + buf * 8192, F.lds + NSA_V + buf * 8192, tbh, qr, o, m, l, kt, tq, kmul, kadd, dmax, selbit, mode, b31, r32, hi, F.lane);
            if (it + 1 < nrun) NSA_LSTORE(ktn, buf ^ 1);
            __syncthreads();
            buf ^= 1;
        }
#undef NSA_GLOAD
#undef NSA_LSTORE
        l += __shfl_xor(l, 32);
        const float inv = l > 0.f ? 1.0f / l : 0.f;
        if (br == 0) inv_cmp = inv;
        if (br != 1) { const float sc = inv * (br == 0 ? gate[0] : br == 2 ? gate[1] : gate[2]);
#pragma unroll
            for (int c = 0; c < 2; ++c)
#pragma unroll
                for (int r = 0; r < 16; ++r) { const float prev = br == 0 ? 0.f : ofw[(c * 16 + r) * 64]; ofw[(c * 16 + r) * 64] = prev + o[c][r] * sc; }
        } else {
            LAS float* scw = (LAS float*)(F.lds + NSA_SC) + F.wave * 512;
#pragma unroll
            for (int c = 0; c < 2; ++c)
#pragma unroll
                for (int r = 0; r < 16; ++r) { float v = o[c][r] * inv_cmp; v += __shfl_xor(v, 1); v += __shfl_xor(v, 2);
                    if (hh == 0) scw[qi * 64 + 32 * c + crow(r, hi)] = v; }
            LDS_WAIT();
            LAS unsigned* mskw = (LAS unsigned*)(F.lds + NSA_MSK) + F.wave * 16;
#pragma nounroll
            for (int q = 0; q < 8; ++q) {
                const int curq = (q0 + 8 * F.wave + q) >> 6, j = F.lane;
                const bool avail = j <= curq, forced = (j == 0) || (j == curq) || (j == curq - 1);
                const float sj = avail ? scw[q * 64 + j] + (forced ? 1e4f : 0.f) : NEGBIG;
                LDS_WAIT();
                scw[q * 64 + j] = sj;
                LDS_WAIT();
                int rank = 0;
#pragma unroll 4
                for (int j2 = 0; j2 < 64; ++j2) { const float s2 = scw[q * 64 + j2]; rank += (s2 > sj || (s2 == sj && j2 < j)) ? 1 : 0; }
                const bool sel = rank < 16 && avail;
                const unsigned long long bm = __ballot(sel);
                if (F.lane == 0) { mskw[2 * q] = (unsigned)bm; mskw[2 * q + 1] = (unsigned)(bm >> 32); } }
            LDS_WAIT();
            mlo = mskw[2 * qi]; mhi = mskw[2 * qi + 1];
        }
    }
    bf16* OA = (bf16*)(ws + WS_OA) + (size_t)(b * SEQ + tq) * 512 + head * 64;
#pragma unroll
    for (int c = 0; c < 2; ++c)
#pragma unroll
        for (int r4 = 0; r4 < 4; ++r4) { u32x2 w; w.x = pk2(ofw[(c * 16 + 4 * r4) * 64], ofw[(c * 16 + 4 * r4 + 1) * 64]); w.y = pk2(ofw[(c * 16 + 4 * r4 + 2) * 64], ofw[(c * 16 + 4 * r4 + 3) * 64]);
            *(u32x2*)(OA + 32 * c + 8 * r4 + 4 * hi) = w; }
}
__device__ __forceinline__ void phase3(const Frame& F) {
    const bool xcd = (F.G == 256);
    const int pstart = xcd ? (F.bx >> 3) : F.bx, pstep = xcd ? 32 : F.G, pend = xcd ? 64 : 512;
#pragma nounroll
    for (int p2 = 2 * pstart; p2 < 2 * pend; p2 += (p2 & 1) ? 2 * pstep - 1 : 1) { const int p = p2 >> 1;
        const int b = xcd ? (F.bx & 7) : (p >> 6), g = (p >> 5) & 1, qt = p & 31;
        nsa_unit(F, b, g, (p2 & 1) ? qt : 63 - qt); }
    __syncthreads();
}

#define MFMA16(a, b, c) __builtin_amdgcn_mfma_f32_16x16x32_bf16((a), (b), (c), 0, 0, 0)
constexpr int DSA_SCP = 8200;
constexpr int DSA_SC = 0;
constexpr int DSA_LIST = 16 * DSA_SCP;
constexpr int DSA_NSEL = DSA_LIST + 8192;
constexpr int DSA_BIAS = DSA_NSEL + 64;
constexpr int DSA_HIST = DSA_BIAS + 1088;
constexpr int DSA_BKI = DSA_HIST + 8192;
constexpr int KSEL = 256;
__device__ __forceinline__ unsigned dsa_offb(unsigned row, unsigned ch) { return 256u * row + 16u * (ch ^ (((row & 3u) << 2) | ((row >> 2) & 3u))); }
__device__ __forceinline__ unsigned sortkey16(float x) { x = x + 0.0f; const unsigned short h = __builtin_bit_cast(unsigned short, (_Float16)x); return (h & 0x8000u) ? (unsigned)(unsigned short)~h : (unsigned)(h | 0x8000u); }
__device__ __forceinline__ int prefix_cnt(unsigned long long b) { return (int)__builtin_amdgcn_mbcnt_hi((unsigned)(b >> 32), __builtin_amdgcn_mbcnt_lo((unsigned)b, 0u)); }

__device__ __forceinline__ void dsa_unit(const Frame& F, const Args& a, int b, int qt16) {
    unsigned char* ws = F.ws;
    const bf16* ZA = (const bf16*)(ws + WS_ZA);
    const int lane = F.lane, l16 = lane & 15, quad = lane >> 4, q0 = qt16 * 16;
    __syncthreads();
#ifndef PROBE_DSA
#define PROBE_DSA 0
#endif
    for (int rep1_ = 0; rep1_ < (PROBE_DSA == 1 ? 2 : 1); ++rep1_) {
        const size_t qrow = (size_t)(b * SEQ + q0 + l16) * ZA_LD;
        bf16x8 qf[4][2];
#pragma unroll
        for (int i = 0; i < 4; ++i)
#pragma unroll
            for (int ks = 0; ks < 2; ++ks) qf[i][ks] = *(const bf16x8*)(ZA + qrow + ZC_QIDX + i * 64 + 32 * ks + 8 * quad);
        float wq[4];
#pragma unroll
        for (int i = 0; i < 4; ++i) wq[i] = bf2f(ZA[qrow + ZC_WIDX + i]) * 0.0625f;
        const int tq = q0 + l16, nkt = qt16 + 1;
        const bf16* kbase = ZA + (size_t)(b * SEQ + l16) * ZA_LD + ZC_KIDX + 8 * quad;
        bf16x8 ka[4][2], kn[4][2];
#define DSA_KLOAD(dst, kt0_) do { _Pragma("unroll") for (int t_ = 0; t_ < 4; ++t_) { const int k_ = (kt0_) + 8 * t_; const int kc_ = k_ < nkt ? k_ : nkt - 1; \
            dst[t_][0] = *(const bf16x8*)(kbase + (size_t)(kc_ * 16) * ZA_LD); dst[t_][1] = *(const bf16x8*)(kbase + (size_t)(kc_ * 16) * ZA_LD + 32); } } while (0)
        if (F.wave < nkt) DSA_KLOAD(ka, F.wave);
#pragma nounroll
        for (int kt0 = F.wave; kt0 < nkt; kt0 += 32) {
            if (kt0 + 32 < nkt) DSA_KLOAD(kn, kt0 + 32);
#pragma unroll
            for (int t = 0; t < 4; ++t) { const int kt = kt0 + 8 * t;
                if (kt < nkt) {
                    float idx[4] = {0.f, 0.f, 0.f, 0.f};
#pragma unroll
                    for (int i = 0; i < 4; ++i) { f32x4 acc = {0.f, 0.f, 0.f, 0.f}; acc = MFMA16(ka[t][0], qf[i][0], acc); acc = MFMA16(ka[t][1], qf[i][1], acc);
#pragma unroll
                        for (int r = 0; r < 4; ++r) idx[r] += fmaxf(acc[r], 0.f) * wq[i]; }
                    unsigned k16[4];
#pragma unroll
                    for (int r = 0; r < 4; ++r) { const int key = kt * 16 + 4 * quad + r; k16[r] = key <= tq ? sortkey16(idx[r]) : 0u; }
                    u32x2 w; w.x = k16[0] | (k16[1] << 16); w.y = k16[2] | (k16[3] << 16);
                    *(LAS u32x2*)(F.lds + DSA_SC + l16 * DSA_SCP + (kt * 16 + 4 * quad) * 2) = w; } }
#pragma unroll
            for (int t = 0; t < 4; ++t) { ka[t][0] = kn[t][0]; ka[t][1] = kn[t][1]; }
        }
#undef DSA_KLOAD
    }
    if (F.tid < 264) { const float* rb = a.in[11]; ((LAS float*)(F.lds + DSA_BIAS))[F.tid] = F.tid < 256 ? rb[(F.tid >> 3) * 16 + 8 + (F.tid & 7)] * LOG2E : NEGBIG; }
    __syncthreads();
#pragma nounroll
    for (int qq = 0; qq < (PROBE_DSA == 2 ? 4 : 2); ++qq) {
        const int n = 2 * F.wave + (qq & 1), tq = q0 + n, N = tq + 1;
        LAS unsigned char* scq = F.lds + DSA_SC + n * DSA_SCP;
        LAS unsigned short* lst = (LAS unsigned short*)(F.lds + DSA_LIST) + n * 256;
        LAS unsigned short* bki = (LAS unsigned short*)(F.lds + DSA_BKI) + n * 256;
        if (N <= KSEL) {
            for (int s = lane; s < KSEL; s += 64) lst[s] = (unsigned short)(s < N ? s : 0);
            if (lane == 0) ((LAS int*)(F.lds + DSA_NSEL))[n] = N;
        } else {
            const int nit = (N + 255) >> 8;
            { const int it = nit - 1; const int s0 = 4 * (lane + 64 * it); u32x2 w = *(LAS u32x2*)(scq + s0 * 2);
              if (s0 + 0 > tq) w.x &= 0xffff0000u; if (s0 + 1 > tq) w.x &= 0x0000ffffu; if (s0 + 2 > tq) w.y &= 0xffff0000u; if (s0 + 3 > tq) w.y &= 0x0000ffffu;
              *(LAS u32x2*)(scq + s0 * 2) = w; }
            LDS_WAIT();
            LAS unsigned* hist = (LAS unsigned*)(F.lds + DSA_HIST) + F.wave * 256;
            unsigned T = 0u; int cgt = 0; int need = KSEL;
#pragma nounroll
            for (int lvl = 0; lvl < 2; ++lvl) {
                *(LAS u32x4*)(hist + 4 * lane) = (u32x4){0u, 0u, 0u, 0u};
                LDS_WAIT();
#pragma nounroll
                for (int it = 0; it < nit; ++it) { const u32x2 w = *(LAS u32x2*)(scq + (lane + 64 * it) * 8);
                    const unsigned k[4] = {w.x & 0xffffu, w.x >> 16, w.y & 0xffffu, w.y >> 16};
#pragma unroll
                    for (int e = 0; e < 4; ++e) { const bool in = lvl == 0 ? true : (k[e] >> 8) == (T >> 8); const unsigned bin = lvl == 0 ? (k[e] >> 8) : (k[e] & 255u);
                        if (in) __hip_atomic_fetch_add(hist + bin, 1u, __ATOMIC_RELAXED, __HIP_MEMORY_SCOPE_WORKGROUP); } }
                LDS_WAIT();
                const u32x4 h = *(LAS u32x4*)(hist + 4 * lane);
                const int sl = (int)(h.x + h.y + h.z + h.w); int suf = sl;
#pragma unroll
                for (int d = 1; d < 64; d <<= 1) { const int o = __shfl_down(suf, d); suf += (lane + d < 64) ? o : 0; }
                const int above = suf - sl;
                const bool here = above < need && above + sl >= need;
                int bsel = 4 * lane + 3, ca = above;
                if (ca + (int)h.w < need) { ca += (int)h.w; bsel = 4 * lane + 2; if (ca + (int)h.z < need) { ca += (int)h.z; bsel = 4 * lane + 1; if (ca + (int)h.y < need) { ca += (int)h.y; bsel = 4 * lane; } } }
                const unsigned long long bm = __ballot(here);
                const int src = bm ? (int)__builtin_ctzll(bm) : 0;
                const int B = __shfl(bsel, src), CA = __shfl(ca, src);
                if (lvl == 0) T = (unsigned)B << 8; else T |= (unsigned)B;
                cgt += CA; need -= CA;
                LDS_WAIT();
            }
            const int rties = KSEL - cgt;
            int tiebase = 0, outbase = 0;
#define DSA_PUT(pos_, idx_) do { const int p_ = (pos_); if (p_ >= 0 && p_ < KSEL) lst[p_] = (unsigned short)(idx_); } while (0)
#pragma nounroll
            for (int it = 0; it < nit; ++it) { const u32x2 w = *(LAS u32x2*)(scq + (lane + 64 * it) * 8);
                const unsigned k0 = w.x & 0xffffu, k1 = w.x >> 16, k2 = w.y & 0xffffu, k3 = w.y >> 16;
                const int sidx = 4 * (lane + 64 * it);
                const bool g0 = k0 > T, g1 = k1 > T, g2 = k2 > T, g3 = k3 > T;
                const unsigned long long bg0 = __ballot(g0), bg1 = __ballot(g1), bg2 = __ballot(g2), bg3 = __ballot(g3);
                if (bg0 | bg1 | bg2 | bg3) {
                    int pos = outbase + prefix_cnt(bg0) + prefix_cnt(bg1) + prefix_cnt(bg2) + prefix_cnt(bg3);
                    if (g0) { DSA_PUT(pos, sidx + 0); ++pos; }
                    if (g1) { DSA_PUT(pos, sidx + 1); ++pos; }
                    if (g2) { DSA_PUT(pos, sidx + 2); ++pos; }
                    if (g3) { DSA_PUT(pos, sidx + 3); ++pos; }
                    outbase += __popcll(bg0) + __popcll(bg1) + __popcll(bg2) + __popcll(bg3); }
                const bool e0 = k0 == T, e1 = k1 == T, e2 = k2 == T, e3 = k3 == T;
                const unsigned long long be0 = __ballot(e0), be1 = __ballot(e1), be2 = __ballot(e2), be3 = __ballot(e3);
                if ((be0 | be1 | be2 | be3) && tiebase < rties) {
                    const int t0 = tiebase + prefix_cnt(be0) + prefix_cnt(be1) + prefix_cnt(be2) + prefix_cnt(be3), t1 = t0 + (e0 ? 1 : 0), t2 = t1 + (e1 ? 1 : 0), t3 = t2 + (e2 ? 1 : 0);
                    if (e0 && t0 < rties) DSA_PUT(KSEL - 1 - t0, sidx + 0);
                    if (e1 && t1 < rties) DSA_PUT(KSEL - 1 - t1, sidx + 1);
                    if (e2 && t2 < rties) DSA_PUT(KSEL - 1 - t2, sidx + 2);
                    if (e3 && t3 < rties) DSA_PUT(KSEL - 1 - t3, sidx + 3);
                    tiebase += __popcll(be0) + __popcll(be1) + __popcll(be2) + __popcll(be3); } }
#undef DSA_PUT
            outbase = KSEL;
            if (lane == 0) ((LAS int*)(F.lds + DSA_NSEL))[n] = outbase < KSEL ? outbase : KSEL;
        }
        LDS_WAIT();
        { const int nsl = N < KSEL ? N : KSEL;
#pragma unroll
          for (int i = 0; i < 4; ++i) { const int e = lane + 64 * i; const int dist = tq - (int)lst[e];
              const int dpos = dist < 1 ? 1 : dist; int bl = 16 + (int)((__log2f((float)dpos) - 4.0f) * 2.66666675f); bl = bl > 31 ? 31 : bl;
              const int bk = dist < 1 ? 0 : (dpos < 16 ? dpos : bl);
              bki[e] = (unsigned short)(e < nsl ? bk * 32 : 1024); } }
    }
    __syncthreads();
    const bf16* CK = (const bf16*)(ws + WS_CKVN) + (size_t)(b * SEQ) * 128;
    LAS unsigned char* gb0 = F.lds + F.wave * 16384;
    const LAS unsigned char* biasb = F.lds + DSA_BIAS + (l16 & 7) * 4;
#define DSA_GATHER(chunk_, buf_) do { const unsigned key_ = lst[(chunk_) * 32 + (lane >> 1)]; const char* src_ = (const char*)CK + (key_ * 256u + (unsigned)(lane & 1) * 16u); \
        _Pragma("unroll") for (int c_ = 0; c_ < 8; ++c_) __builtin_amdgcn_global_load_lds((const unsigned*)(src_ + c_ * 32), (LAS unsigned*)(gb0 + (buf_) * 8192 + c_ * 1024), 16, 0, 0); } while (0)
    int tqs[2], nsels[2]; const LAS unsigned short* lsts[2]; const LAS unsigned short* bkis[2]; bf16x8 ql[2][4]; f32x4 o[2][8]; float ms[2], ls[2];
#pragma unroll
    for (int qq = 0; qq < 2; ++qq) { const int n = 2 * F.wave + qq; tqs[qq] = q0 + n; nsels[qq] = ((const LAS int*)(F.lds + DSA_NSEL))[n]; lsts[qq] = (const LAS unsigned short*)(F.lds + DSA_LIST) + n * 256; bkis[qq] = (const LAS unsigned short*)(F.lds + DSA_BKI) + n * 256;
#pragma unroll
        for (int s2 = 0; s2 < 4; ++s2) { const bf16x8 v = *(const bf16x8*)(ZA + (size_t)(b * SEQ + tqs[qq]) * ZA_LD + ZC_QLAT + (l16 & 7) * 128 + 32 * s2 + 8 * quad); ql[qq][s2] = l16 < 8 ? v : (bf16x8){0, 0, 0, 0, 0, 0, 0, 0}; }
#pragma unroll
        for (int c = 0; c < 8; ++c) o[qq][c] = (f32x4){0.f, 0.f, 0.f, 0.f};
        ms[qq] = NEGBIG; ls[qq] = 0.f; }
#pragma unroll
    for (int qq = 0; qq < 2; ++qq)
#pragma unroll
        for (int s2 = 0; s2 < 4; ++s2) asm volatile("" : "+v"(ql[qq][s2]));
    const int nch1 = (nsels[1] + 31) >> 5, nch = PROBE_DSA == 3 ? 2 * nch1 : nch1;
    LDS_WAIT();
    { const LAS unsigned short* lst = lsts[0]; DSA_GATHER(0, 0); }
    { const LAS unsigned short* lst = lsts[1]; DSA_GATHER(0, 1); }
    const unsigned offA = (unsigned)((quad >> 1) * 1024 + l16 * 32 + (quad & 1) * 16);
    const unsigned offT = (unsigned)((4 * quad + (l16 >> 2)) * 32 + 8 * (lane & 3));
#pragma nounroll
    for (int ch = 0; ch < nch; ++ch) {
#pragma unroll
        for (int qq = 0; qq < 2; ++qq) {
            const int chd = ch >= nch1 ? ch - nch1 : ch;
            const LAS unsigned short* lst = lsts[qq];
            const LAS unsigned char* gb = gb0 + qq * 8192;
            if (qq == 0 || ch + 1 < nch) asm volatile("s_waitcnt vmcnt(8)" ::: "memory"); else asm volatile("s_waitcnt vmcnt(0)" ::: "memory");
            f32x4 acc2[2]; float bvs[2][4];
#pragma unroll
            for (int rb = 0; rb < 2; ++rb) { f32x4 acc = {0.f, 0.f, 0.f, 0.f};
#pragma unroll
                for (int s2 = 0; s2 < 4; ++s2) { const bf16x8 af = *(const LAS bf16x8*)(gb + offA + rb * 512 + s2 * 2048); acc = MFMA16(af, ql[qq][s2], acc); }
                acc2[rb] = acc;
                const u32x2 kb = *(const LAS u32x2*)((const LAS unsigned char*)bkis[qq] + (chd * 32 + rb * 16 + 4 * quad) * 2);
                bvs[rb][0] = *(const LAS float*)(biasb + (kb.x & 0xffffu)); bvs[rb][1] = *(const LAS float*)(biasb + (kb.x >> 16));
                bvs[rb][2] = *(const LAS float*)(biasb + (kb.y & 0xffffu)); bvs[rb][3] = *(const LAS float*)(biasb + (kb.y >> 16)); }
#pragma unroll
            for (int rb = 0; rb < 2; ++rb)
#pragma unroll
                for (int r = 0; r < 4; ++r) asm volatile("" : "+v"(bvs[rb][r]));
            float x[2][4]; float tmax = NEGBIG;
#pragma unroll
            for (int rb = 0; rb < 2; ++rb)
#pragma unroll
                for (int r = 0; r < 4; ++r) { const float xv = acc2[rb][r] * C2 + bvs[rb][r]; x[rb][r] = xv; tmax = fmaxf(tmax, xv); }
            tmax = fmaxf(tmax, __shfl_xor(tmax, 16)); tmax = fmaxf(tmax, __shfl_xor(tmax, 32));
            const float mn = fmaxf(ms[qq], tmax); const bool resc = __any(mn != ms[qq]); const float alpha = __builtin_amdgcn_exp2f(ms[qq] - mn); ms[qq] = mn;
            float ps = 0.f;
#pragma unroll
            for (int rb = 0; rb < 2; ++rb)
#pragma unroll
                for (int r = 0; r < 4; ++r) { const float pv = __builtin_amdgcn_exp2f(x[rb][r] - mn); x[rb][r] = pv; ps += pv; }
            ls[qq] = ls[qq] * alpha + ps;
            if (resc) {
#pragma unroll
                for (int c = 0; c < 8; ++c) o[qq][c] = o[qq][c] * alpha; }
            u32x4 pw; pw.x = pk2(x[0][0], x[0][1]); pw.y = pk2(x[0][2], x[0][3]); pw.z = pk2(x[1][0], x[1][1]); pw.w = pk2(x[1][2], x[1][3]);
            const unsigned gba = (unsigned)(unsigned long long)gb + offT;
#pragma unroll
            for (int cb = 0; cb < 2; ++cb) {
                s16x4 v[8];
                if (cb == 0) asm volatile("ds_read_b64_tr_b16 %0, %8\n\tds_read_b64_tr_b16 %1, %8 offset:512\n\tds_read_b64_tr_b16 %2, %8 offset:1024\n\tds_read_b64_tr_b16 %3, %8 offset:1536\n\t"
                             "ds_read_b64_tr_b16 %4, %8 offset:2048\n\tds_read_b64_tr_b16 %5, %8 offset:2560\n\tds_read_b64_tr_b16 %6, %8 offset:3072\n\tds_read_b64_tr_b16 %7, %8 offset:3584\n\ts_waitcnt lgkmcnt(0)"
                             : "=&v"(v[0]), "=&v"(v[1]), "=&v"(v[2]), "=&v"(v[3]), "=&v"(v[4]), "=&v"(v[5]), "=&v"(v[6]), "=&v"(v[7]) : "v"(gba) : "memory");
                else asm volatile("ds_read_b64_tr_b16 %0, %8 offset:4096\n\tds_read_b64_tr_b16 %1, %8 offset:4608\n\tds_read_b64_tr_b16 %2, %8 offset:5120\n\tds_read_b64_tr_b16 %3, %8 offset:5632\n\t"
                             "ds_read_b64_tr_b16 %4, %8 offset:6144\n\tds_read_b64_tr_b16 %5, %8 offset:6656\n\tds_read_b64_tr_b16 %6, %8 offset:7168\n\tds_read_b64_tr_b16 %7, %8 offset:7680\n\ts_waitcnt lgkmcnt(0)"
                             : "=&v"(v[0]), "=&v"(v[1]), "=&v"(v[2]), "=&v"(v[3]), "=&v"(v[4]), "=&v"(v[5]), "=&v"(v[6]), "=&v"(v[7]) : "v"(gba) : "memory");
#pragma unroll
                for (int c4 = 0; c4 < 4; ++c4) { const int c = 4 * cb + c4; const s16x4 v0 = v[2 * c4], v1 = v[2 * c4 + 1];
                    const bf16x8 vf = {v0[0], v0[1], v0[2], v0[3], v1[0], v1[1], v1[2], v1[3]};
                    o[qq][c] = MFMA16(vf, __builtin_bit_cast(bf16x8, pw), o[qq][c]); }
            }
            LDS_WAIT();
            if (ch + 1 < nch) DSA_GATHER((ch + 1 >= nch1 ? ch + 1 - nch1 : ch + 1), qq);
        }
    }
#pragma unroll
    for (int qq = 0; qq < 2; ++qq) {
        float l = ls[qq]; const int tq = tqs[qq];
        l += __shfl_xor(l, 16); l += __shfl_xor(l, 32);
        const float inv = l > 0.f ? 1.0f / l : 0.f;
        if (l16 < 8) { bf16* op = (bf16*)(ws + WS_OLAT) + (size_t)(b * SEQ + tq) * 1024 + l16 * 128 + 4 * quad;
#pragma unroll
            for (int c = 0; c < 8; ++c) { u32x2 w; w.x = pk2(o[qq][c][0] * inv, o[qq][c][1] * inv); w.y = pk2(o[qq][c][2] * inv, o[qq][c][3] * inv); *(u32x2*)(op + 16 * c) = w; } }
    }
}
#undef DSA_GATHER
__device__ __forceinline__ void phase4(const Frame& F, const Args& a) {
    const bool xcd = (F.G == 256);
    const int pstart = xcd ? (F.bx >> 3) : F.bx, pstep = xcd ? 32 : F.G, pend = xcd ? 128 : 1024;
#pragma nounroll
    for (int p2 = 2 * pstart; p2 < 2 * pend; p2 += (p2 & 1) ? 2 * pstep - 1 : 1) { const int p = p2 >> 1;
        const int b = xcd ? (F.bx & 7) : (p >> 7), j = p & 127;
        dsa_unit(F, a, b, (p2 & 1) ? j : 255 - j); }
    __syncthreads();
}

constexpr int NPHASE = 11;
__global__ void __launch_bounds__(NTHR, 2) fwd_kernel(Args args) {
    extern __shared__ __attribute__((aligned(16))) unsigned char lds_raw[];
    Frame F;
    F.lds = (LAS unsigned char*)lds_raw;
    F.tid = threadIdx.x; F.lane = F.tid & 63; F.wave = __builtin_amdgcn_readfirstlane(F.tid >> 6);
    F.G = gridDim.x; F.bx = blockIdx.x; F.ws = args.ws;
    unsigned char* ws = args.ws;
    volatile LAS unsigned* MISC = (volatile LAS unsigned*)(F.lds + MISC_OFF);
    if (F.tid < 64) MISC[F.tid] = 0u;
    __syncthreads();
    const int lo = args.ph_lo, hi = args.ph_hi;
    XcdBarrier bar; bar.bar = (unsigned*)(ws + WS_CTL) + CW_BAR; bar.x = 0; bar.st = nullptr;
    if (hi - lo > 1) bar = xcd_barrier_post((unsigned*)(ws + WS_CTL) + CW_BAR, MISC + 8);
#ifndef PH_MASK
#define PH_MASK 0xFFFF
#endif
#define IN(k) ((((PH_MASK) >> (k)) & 1) && lo <= (k) && (k) < hi)
#define SEAM(k) do { if (IN(k) && IN((k) + 1)) xcd_barrier(bar); } while (0)
#ifndef PROBE_PHASE
#define PROBE_PHASE -1
#endif
#define REPEAT(k) for (int rep_ = 0; rep_ < ((PROBE_PHASE) == (k) ? 2 : 1); ++rep_, ((PROBE_PHASE) == (k) && rep_ < 2 ? xcd_barrier(bar) : (void)0))

    if (IN(0)) REPEAT(0) { phase0(F, args); }
    SEAM(0);
    if (IN(1)) REPEAT(1) {
        pg8::StaticOrder S; S.init(NTOK / 256, NZ / 256, F.G, F.bx);
        const APlain AA{ws + WS_XB, 128u, (unsigned)(D * 2)}; const BPlain BA{(const bf16*)(ws + WS_WINT), D};
        const EpiZ E{(bf16*)(ws + WS_ZA), (bf16*)(ws + WS_ZG)};
        pg8::gemm_phase(F.lds, D, S, AA, BA, E);
    }
    SEAM(1);
    if (IN(2)) REPEAT(2) { phase2(F, args); }
    SEAM(2);
    if (IN(3)) REPEAT(3) { phase3(F); }
    if (IN(4)) REPEAT(4) { phase4(F, args); }
    SEAM(4);
    if (IN(5)) REPEAT(5) {
        pg8::StaticOrder S; S.init(NTOK / 256, D / 256, F.G, F.bx);
        { const APlain AA{ws + WS_OA, 128u, 1024u}; const BPlain BA{(const bf16*)(ws + WS_WAT), 512};
          const EpiGate<0> E{(const bf16*)(ws + WS_ZG), nullptr, (bf16*)(ws + WS_T1)};
          pg8::gemm_phase(F.lds, 512, S, AA, BA, E); }
        { const APlain AA{ws + WS_OLAT, 128u, 2048u}; const BPlain BA{(const bf16*)(ws + WS_WBT), 1024};
          const EpiGate<1> E{(const bf16*)(ws + WS_ZG), (const bf16*)(ws + WS_T1), (bf16*)(ws + WS_MERGED)};
          pg8::gemm_phase(F.lds, 1024, S, AA, BA, E); }
    }
    SEAM(5);
    if (IN(6)) REPEAT(6) {
        pg8::StaticOrder S; S.init(NTOK / 256, D / 256, F.G, F.bx);
        const APlain AA{ws + WS_MERGED, 128u, 2048u}; const BPlain BA{(const bf16*)(ws + WS_WOT), 1024};
        const EpiRes E{args.in[0], (bf16*)(ws + WS_H1)};
        pg8::gemm_phase(F.lds, 1024, S, AA, BA, E);
    }
    SEAM(6);
    if (IN(7)) { phase6(F, args); }
    SEAM(7);
    if (IN(8)) REPEAT(8) {
        moe_setup(F);
        const MoeOrder S{F.G, F.bx, 2, (const LAS int*)(F.lds + MOE_CUM), (const LAS int*)(F.lds + MOE_CUM) + 40};
        const AGather AA{ws + WS_H1B, 128u, (const int*)(ws + WS_LIST)}; const BGu BA{(const bf16*)(ws + WS_WGU)};
        const EpiAct E{(bf16*)(ws + WS_ACT)};
        pg8::gemm_phase(F.lds, 1024, S, AA, BA, E);
    }
    SEAM(8);
    if (IN(9)) REPEAT(9) {
        moe_setup(F);
        const MoeOrder S{F.G, F.bx, 4, (const LAS int*)(F.lds + MOE_CUM), (const LAS int*)(F.lds + MOE_CUM) + 40};
        const APlain AA{ws + WS_ACT, 128u, 512u}; const BDn BA{(const bf16*)(ws + WS_WDT)};
        const EpiDown E{(bf16*)(ws + WS_YBUF), (const int*)(ws + WS_LIST)};
        pg8::gemm_phase(F.lds, 256, S, AA, BA, E);
    }
    SEAM(9);
    if (IN(10)) REPEAT(10) { phase9(F, args); }
#undef IN
#undef SEAM
#undef REPEAT
}

extern "C" void kernel_launch(void* const* d_in, const int* in_sizes, int n_in, void* d_out, int out_size, void* d_ws, size_t ws_size, hipStream_t stream) {
    static int grid = 0;
    if (grid == 0) {
        if (n_in != 26 || in_sizes[0] != NTOK * D || out_size != NTOK * D || ws_size < WS_END) {
            fprintf(stderr, "kernel_launch: unexpected problem: n_in %d in0 %d out %d ws %zu (need %zu)\n", n_in, n_in > 0 ? in_sizes[0] : -1, out_size, ws_size, (size_t)WS_END); grid = -1; return; }
        int dev = 0, cus = 0, per_cu = 0;
        if (hipGetDevice(&dev) != hipSuccess || hipDeviceGetAttribute(&cus, hipDeviceAttributeMultiprocessorCount, dev) != hipSuccess) { grid = -1; return; }
        if (hipFuncSetAttribute((const void*)fwd_kernel, hipFuncAttributeMaxDynamicSharedMemorySize, LDS_BYTES) != hipSuccess) { fprintf(stderr, "kernel_launch: hipFuncSetAttribute failed\n"); grid = -1; return; }
        if (hipOccupancyMaxActiveBlocksPerMultiprocessor(&per_cu, (const void*)fwd_kernel, NTHR, LDS_BYTES) != hipSuccess || per_cu < 1)
            fprintf(stderr, "kernel_launch: occupancy query reports %d\n", per_cu);
        (void)hipGetLastError();
        grid = cus;
    }
    if (grid < 0) return;
    if (hipMemsetAsync((char*)d_ws + WS_CTL, 0, CTL_ZERO_BYTES, stream) != hipSuccess) return;
    Args a{};
    for (int i = 0; i < 26; ++i) a.in[i] = (const float*)d_in[i];
    a.out = (float*)d_out; a.ws = (unsigned char*)d_ws;
#if MK_PER_PHASE
    for (int p = 0; p < NPHASE; ++p) { a.ph_lo = p; a.ph_hi = p + 1; hipLaunchKernelGGL(fwd_kernel, dim3(grid), dim3(NTHR), LDS_BYTES, stream, a); }
#else
    a.ph_lo = 0; a.ph_hi = NPHASE;
    hipLaunchKernelGGL(fwd_kernel, dim3(grid), dim3(NTHR), LDS_BYTES, stream, a);
#endif
}
```

```cpp
#include <hip/hip_runtime.h>
#include <cstdio>
#include <cstdint>

#ifndef MK_PER_PHASE
#define MK_PER_PHASE 0
#endif

#define GAS __attribute__((address_space(1)))
#define LAS __attribute__((address_space(3)))
typedef unsigned short bf16;
typedef short bf16x8 __attribute__((ext_vector_type(8)));
typedef short s16x4 __attribute__((ext_vector_type(4)));
typedef float f32x4 __attribute__((ext_vector_type(4)));
typedef float f32x16 __attribute__((ext_vector_type(16)));
typedef float f32x2 __attribute__((ext_vector_type(2)));
typedef unsigned u32x4 __attribute__((ext_vector_type(4)));
typedef unsigned u32x2 __attribute__((ext_vector_type(2)));

constexpr int D = 1024, BATCH = 8, SEQ = 4096, NTOK = BATCH * SEQ;
constexpr int D_IN = 4316;
constexpr int NCMP = 255;
constexpr float ALPHA = 1.189207115002721f;
constexpr float LOG2E = 1.4426950408889634f;
constexpr float NEGBIG = -1e30f;
constexpr int ZA_LD = 2816;
constexpr int ZC_QA = 0, ZC_KC = 512, ZC_VC = 640, ZC_KS = 768, ZC_VS = 896, ZC_KW = 1024, ZC_VW = 1152, ZC_QLAT = 1280, ZC_CKV = 2304,
              ZC_QIDX = 2432, ZC_KIDX = 2688, ZC_GNSA = 2752, ZC_WIDX = 2776;
constexpr int ZG_LD = 2048;
constexpr int NZ = ZA_LD + ZG_LD;
constexpr int NEXP = 32, DEXP = 256;
constexpr int MAXTILES = (2 * NTOK) / 256 + NEXP;

constexpr size_t MiB = 1u << 20;
constexpr size_t WS_CTL = 0, CTL_ZERO_BYTES = 1 * MiB;
constexpr size_t WS_WAT = 1 * MiB;
constexpr size_t WS_WBT = 2 * MiB;
constexpr size_t WS_WOT = 4 * MiB;
constexpr size_t WS_W1K = 6 * MiB;
constexpr size_t WS_W1V = 7 * MiB;
constexpr size_t WS_W2K = 8 * MiB;
constexpr size_t WS_W2V = 8 * MiB + 64 * 1024;
constexpr size_t WS_BIASK = 8 * MiB + 128 * 1024;
constexpr size_t WS_TBA = 8 * MiB + 256 * 1024;
constexpr size_t WS_TBB = 8 * MiB + 320 * 1024;
constexpr size_t WS_KCMP = 9 * MiB;
constexpr size_t WS_VCMP = 9 * MiB + 512 * 1024;
constexpr size_t WS_TOKINFO = 10 * MiB;
constexpr size_t WS_LIST = 11 * MiB;
constexpr size_t WS_WINT = 16 * MiB;
constexpr size_t WS_WGU = 32 * MiB;
constexpr size_t WS_WDT = 64 * MiB;
constexpr size_t WS_CKVN = 80 * MiB;
constexpr size_t WS_XB = 96 * MiB;
constexpr size_t WS_OLAT = 96 * MiB;
constexpr size_t WS_H1B = 96 * MiB;
constexpr size_t WS_ZA = 160 * MiB;
constexpr size_t WS_T1 = 160 * MiB;
constexpr size_t WS_ACT = 160 * MiB;
constexpr size_t WS_YBUF = 196 * MiB;
constexpr size_t WS_MERGED = 224 * MiB;
constexpr size_t WS_ZG = 336 * MiB;
constexpr size_t WS_H1 = 336 * MiB;
constexpr size_t WS_OA = 464 * MiB;
constexpr size_t WS_END = 496 * MiB;

constexpr int CW_BAR = 4096;
constexpr int CW_CNT = 16384;

constexpr int LDS_BYTES = 163840;
constexpr int MISC_OFF = 160 * 1024 - 256;

__device__ __forceinline__ unsigned f2bf(float f) { unsigned u = __builtin_bit_cast(unsigned, f); return (u + 0x7fffu + ((u >> 16) & 1u)) >> 16; }
__device__ __forceinline__ unsigned pk2(float lo, float hi) { unsigned r; asm volatile("v_cvt_pk_bf16_f32 %0, %1, %2" : "=v"(r) : "v"(lo), "v"(hi)); return r; }
__device__ __forceinline__ float bf2f(unsigned short b) { return __builtin_bit_cast(float, ((unsigned)b) << 16); }
__device__ __forceinline__ float bflo(unsigned w) { return __builtin_bit_cast(float, w << 16); }
__device__ __forceinline__ float bfhi(unsigned w) { return __builtin_bit_cast(float, w & 0xffff0000u); }
__device__ __forceinline__ float wave_sum(float v) {
#pragma unroll
    for (int o = 1; o < 64; o <<= 1) v += __shfl_xor(v, o);
    return v;
}
__device__ __forceinline__ float sigmoidf_(float x) { return 1.0f / (1.0f + __expf(-x)); }
#define LDS_WAIT() asm volatile("s_waitcnt lgkmcnt(0)" ::: "memory")
#define VM_WAIT() asm volatile("s_waitcnt vmcnt(0)" ::: "memory")

#define XB_TMO      128
#define XB_XCNT(j)  (256  + 64 * (j))
#define XB_XSUB(j)  (1280 + 64 * (j))
#define XB_XGEN(j)  (2304 + 64 * (j))
#define XB_TOP      3328
#define XB_TOPGEN   3392
#define XCD_BAR_WORDS 3456
#define XB_SPIN_CAP (1u << 18)
__device__ __forceinline__ unsigned xb_ld(unsigned* p)              { return __hip_atomic_load(p, __ATOMIC_RELAXED, __HIP_MEMORY_SCOPE_AGENT); }
__device__ __forceinline__ unsigned xb_add(unsigned* p, unsigned v) { return __hip_atomic_fetch_add(p, v, __ATOMIC_RELAXED, __HIP_MEMORY_SCOPE_AGENT); }
__device__ __forceinline__ unsigned xb_xcc_id() { return (unsigned)__builtin_amdgcn_s_getreg((3 << 11) | 20) & 0xFu; }
#define XB_SPIN(cond, bar) do { unsigned _sp = 0; while (cond) { __builtin_amdgcn_s_sleep(1); \
    if ((++_sp & 255u) == 0u) { if (xb_ld(&(bar)[XB_TMO])) break; if (_sp > XB_SPIN_CAP) { atomicAdd(&(bar)[XB_TMO], 1u); break; } } } } while (0)
struct XcdBarrier { unsigned* bar; unsigned x; volatile LAS unsigned* st; };
__device__ __forceinline__ XcdBarrier xcd_barrier_post(unsigned* bar, volatile LAS unsigned* st) {
    XcdBarrier b; b.bar = bar; b.x = xb_xcc_id(); b.st = st;
    if (threadIdx.x == 0) (void)xb_add(&bar[XB_XCNT(b.x)], 1u);
    return b;
}
__device__ __forceinline__ void xcd_barrier_complete(unsigned* bar, unsigned x, unsigned& nloc, unsigned& nx) {
    const unsigned G = gridDim.x * gridDim.y * gridDim.z;
    unsigned sum, cnt, mine, sp = 0u;
    for (;;) {
        sum = 0u; cnt = 0u; mine = 0u;
#pragma unroll
        for (unsigned j = 0; j < 16; ++j) { const unsigned c = xb_ld(&bar[XB_XCNT(j)]); sum += c; cnt += (c > 0u) ? 1u : 0u; mine = (j == x) ? c : mine; }
        if (sum == G) break;
        __builtin_amdgcn_s_sleep(1);
        if ((++sp & 255u) == 0u) { if (xb_ld(&bar[XB_TMO])) break; if (sp > XB_SPIN_CAP) { atomicAdd(&bar[XB_TMO], 1u); break; } }
    }
    nloc = mine > 0u ? mine : 1u; nx = cnt > 0u ? cnt : 1u;
}
__device__ __forceinline__ void xcd_barrier(const XcdBarrier& b) {
    asm volatile("s_waitcnt vmcnt(0)" ::: "memory");
    __syncthreads();
    if (threadIdx.x == 0) {
        unsigned* bar = b.bar;
        __builtin_amdgcn_s_waitcnt(0);
        unsigned nloc = b.st[0], nx = b.st[1];
        if (nloc == 0u) { xcd_barrier_complete(bar, b.x, nloc, nx); b.st[0] = nloc; b.st[1] = nx; }
        const unsigned old = xb_add(&bar[XB_XSUB(b.x)], 1u);
        const unsigned gen = old / nloc;
        if (old + 1u == (gen + 1u) * nloc) {
            __builtin_amdgcn_fence(__ATOMIC_RELEASE, "agent");
            asm volatile("s_waitcnt vmcnt(0)" ::: "memory");
            const unsigned og = xb_add(&bar[XB_TOP], 1u);
            const unsigned tg = og / nx;
            if (og + 1u == (tg + 1u) * nx) xb_add(&bar[XB_TOPGEN], 1u);
            else XB_SPIN(xb_ld(&bar[XB_TOPGEN]) == tg, bar);
            __builtin_amdgcn_fence(__ATOMIC_ACQUIRE, "agent");
            xb_add(&bar[XB_XGEN(b.x)], 1u);
            asm volatile("s_waitcnt vmcnt(0)" ::: "memory");
        } else {
            XB_SPIN(xb_ld(&bar[XB_XGEN(b.x)]) == gen, bar);
            __builtin_amdgcn_fence(__ATOMIC_ACQUIRE, "agent");
            asm volatile("s_waitcnt vmcnt(0)" ::: "memory");
        }
    }
    __syncthreads();
}

namespace pg8 {
constexpr int BM = 256, BK = 64, HALF = 128, HTB = HALF * BK * 2, STAGE_BYTES = 8 * HTB, NXCD = 8, WGM = 8;
__host__ __device__ __forceinline__ int lds_byte(int r, int c) { const int st = (r >> 4) * 2 + (c >> 5), rr = r & 15, cc = c & 31, ob = rr * 64 + cc * 2; return st * 1024 + (ob ^ (((ob >> 9) & 1) << 5)); }
__host__ __device__ __forceinline__ void stage_rc(int b, int& R, int& C) { const int st = b / 1024, sb = b % 1024, swz = sb ^ (((sb >> 9) & 1) << 5); R = (st >> 1) * 16 + swz / 64; C = (st & 1) * 32 + (swz % 64) / 2; }
__host__ __device__ __forceinline__ int perm32(int rho) { const int n = rho >> 4, i = rho & 15; return 8 * (i >> 2) + 4 * n + (i & 3); }
struct Unit { int pm, pn, e, nrows; };
struct StaticOrder {
    int nM, nN, nwg, G, c;
    __device__ void init(int nM_, int nN_, int G_, int c_) { nM = nM_; nN = nN_; nwg = nM * nN; G = G_; c = c_; }
    __device__ bool next(int i, Unit& u) const {
        const long L = (long)i * G + c; if (L >= nwg) return false;
        int wgid = (int)L; { const int q = nwg / NXCD, r = nwg % NXCD, xcd = wgid % NXCD, off = wgid / NXCD; wgid = (xcd < r ? xcd * (q + 1) : r * (q + 1) + (xcd - r) * q) + off; }
        const int nig = WGM * nN, gid = wgid / nig, fm = gid * WGM, gsz = (nM - fm) < WGM ? (nM - fm) : WGM;
        u.pm = fm + ((wgid % nig) % gsz); u.pn = (wgid % nig) / gsz; u.e = 0; u.nrows = 256; return true;
    }
};

template <class Epi, class Sched, class AAddr, class BAddr>
__device__ __forceinline__ void gemm_phase(LAS unsigned char* lds, const int K, const Sched& S, const AAddr& AA, const BAddr& BA, const Epi& E) {
    constexpr bool GA = AAddr::GATHER;
    const int tid = threadIdx.x, wid = __builtin_amdgcn_readfirstlane(tid >> 6), lane = tid & 63, wr = wid >> 2, wc = wid & 3, fr = lane & 15, fq = lane >> 4;
    const int nt = K / BK;
    unsigned voffA[2], voffB[2];
#pragma unroll
    for (int i = 0; i < 2; ++i) { int R, C; stage_rc(tid * 16 + i * 8192, R, C); const int Rb = Epi::PERM ? ((R & ~31) + perm32(R & 31)) : R;
        voffA[i] = GA ? 0u : AA.lane_off(R, C); voffB[i] = (unsigned)(Rb * K + C) * 2u; }
    const size_t kstepA = (size_t)AA.kstep, kstepB = (size_t)(BK * 2);
    const size_t hstepB = (size_t)HALF * K * 2, hstepA = GA ? 0 : AA.hstep();
    const unsigned ldsw = (unsigned)wid * 1024u;
    const int aoff = lds_byte(wr * 64 + fr, fq * 8), boff = lds_byte(wc * 32 + fr, fq * 8);
#define PG8_SA(b, h) (((b) * 2 + (h)) * HTB)
#define PG8_SB(b, h) ((4 + (b) * 2 + (h)) * HTB)
#define PG8_STAGE(bufoff, gbase, voff) do { _Pragma("unroll") for (int _i = 0; _i < 2; ++_i) \
        __builtin_amdgcn_global_load_lds((const unsigned*)((const char*)(gbase) + (voff)[_i]), (LAS unsigned*)(lds + (bufoff) + ldsw + _i * 8192), 16, 0, 0); } while (0)
#define PG8_STA_CUR(bufoff, h, kb) do { if constexpr (GA) { if (h) PG8_STAGE(bufoff, baseA + (kb), cof1); else PG8_STAGE(bufoff, baseA + (kb), cof0); } \
        else PG8_STAGE(bufoff, cA + (h) * hstepA + (kb), voffA); } while (0)
#define PG8_STA_SEL(bufoff, h, kb) do { if constexpr (GA) { if (h) PG8_STAGE(bufoff, baseA + (kb), sof1); else PG8_STAGE(bufoff, baseA + (kb), sof0); } \
        else PG8_STAGE(bufoff, sA + (h) * hstepA + (kb), voffA); } while (0)
#define PG8_LDA(dst, b, h) do { _Pragma("unroll") for (int m = 0; m < 4; ++m) _Pragma("unroll") for (int k = 0; k < 2; ++k) dst[m][k] = *(const LAS bf16x8*)(lds + PG8_SA(b, h) + aoff + m * 2048 + k * 1024); } while (0)
#define PG8_LDB(dst, b, h) do { _Pragma("unroll") for (int n = 0; n < 2; ++n) _Pragma("unroll") for (int k = 0; k < 2; ++k) dst[n][k] = *(const LAS bf16x8*)(lds + PG8_SB(b, h) + boff + n * 2048 + k * 1024); } while (0)
#define PG8_MMA(ai, bj, At, Bt) do { __builtin_amdgcn_s_setprio(1); _Pragma("unroll") for (int m = 0; m < 4; ++m) _Pragma("unroll") for (int n = 0; n < 2; ++n) _Pragma("unroll") for (int k = 0; k < 2; ++k) \
        acc[ai][bj][m][n] = __builtin_amdgcn_mfma_f32_16x16x32_bf16(Bt[n][k], At[m][k], acc[ai][bj][m][n], 0, 0, 0); __builtin_amdgcn_s_setprio(0); } while (0)
#define PG8_WAIT_V(n) asm volatile("s_waitcnt vmcnt(" #n ")" ::: "memory")
#define PG8_WAIT_L(n) asm volatile("s_waitcnt lgkmcnt(" #n ")" ::: "memory")
#define PG8_BAR __builtin_amdgcn_s_barrier()
#define PG8_SCHED __builtin_amdgcn_sched_barrier(0)
#define PG8_GOFF(u, o0, o1) do { _Pragma("unroll") for (int _i = 0; _i < 2; ++_i) { int R_, C_; stage_rc(tid * 16 + _i * 8192, R_, C_); \
        o0[_i] = AA.row_off(u, R_) + (unsigned)C_ * 2u; o1[_i] = AA.row_off(u, R_ + HALF) + (unsigned)C_ * 2u; } } while (0)
    Unit cur, nxt; int ui = 0;
    if (!S.next(0, cur)) return;
    f32x4 acc[2][2][4][2];
#pragma unroll
    for (int a = 0; a < 2; ++a)
#pragma unroll
        for (int b = 0; b < 2; ++b)
#pragma unroll
            for (int m = 0; m < 4; ++m)
#pragma unroll
                for (int n = 0; n < 2; ++n) acc[a][b][m][n] = (f32x4){0.f, 0.f, 0.f, 0.f};
    bf16x8 At[4][2], B0[2][2], B1[2][2];
    const char* const baseA = GA ? (const char*)AA.base : nullptr;
    const char* cA = GA ? nullptr : (const char*)AA.unit_ptr(cur);
    unsigned cof0[2] = {0u, 0u}, cof1[2] = {0u, 0u}, nof0[2] = {0u, 0u}, nof1[2] = {0u, 0u};
    if constexpr (GA) PG8_GOFF(cur, cof0, cof1);
    const char* cB = (const char*)BA.ptr(cur);
    PG8_STAGE(PG8_SB(0, 0), cB, voffB); PG8_STA_CUR(PG8_SA(0, 0), 0, 0); PG8_STAGE(PG8_SB(0, 1), cB + hstepB, voffB); PG8_STA_CUR(PG8_SA(0, 1), 1, 0);
    if (wr == 1) PG8_BAR;
    PG8_WAIT_V(4); PG8_BAR;
    PG8_STAGE(PG8_SB(1, 0), cB + kstepB, voffB); PG8_STA_CUR(PG8_SA(1, 0), 0, kstepA); PG8_STAGE(PG8_SB(1, 1), cB + hstepB + kstepB, voffB);
    PG8_WAIT_V(6); PG8_BAR;
    for (;;) {
        const bool has_next = S.next(ui + 1, nxt);
        const char* nB = cB; const char* nA = cA;
        if (has_next) { nB = (const char*)BA.ptr(nxt); if constexpr (GA) PG8_GOFF(nxt, nof0, nof1); else nA = (const char*)AA.unit_ptr(nxt); }
        else { if constexpr (GA) {
#pragma unroll
            for (int i = 0; i < 2; ++i) { nof0[i] = cof0[i]; nof1[i] = cof1[i]; } } }
#pragma nounroll
        for (int t = 0; t < nt; t += 2) {
            const bool last = (t == nt - 2);
            const size_t k1 = (size_t)(t + 1) * kstepA, k2 = last ? 0 : (size_t)(t + 2) * kstepA, k3 = k2 + kstepA;
            const char* b2 = last ? nB : cB + (size_t)(t + 2) * kstepB; const char* b3 = b2 + kstepB;
            const char* sA = last ? nA : cA;
            unsigned sof0[2], sof1[2];
#pragma unroll
            for (int i = 0; i < 2; ++i) { sof0[i] = last ? nof0[i] : cof0[i]; sof1[i] = last ? nof1[i] : cof1[i]; }
            PG8_LDB(B0, 0, 0); PG8_SCHED; PG8_LDA(At, 0, 0); PG8_STA_CUR(PG8_SA(1, 1), 1, k1);
            PG8_WAIT_L(8); PG8_BAR; PG8_WAIT_L(0); PG8_MMA(0, 0, At, B0); PG8_BAR; PG8_SCHED;
            PG8_LDB(B1, 0, 1); PG8_STAGE(PG8_SB(0, 0), b2, voffB);
            PG8_BAR; PG8_WAIT_L(0); PG8_MMA(0, 1, At, B1); PG8_BAR;
            PG8_LDA(At, 0, 1); PG8_STA_SEL(PG8_SA(0, 0), 0, k2);
            PG8_BAR; PG8_WAIT_L(0); PG8_MMA(1, 0, At, B0); PG8_BAR; PG8_SCHED;
            PG8_STAGE(PG8_SB(0, 1), b2 + hstepB, voffB);
            PG8_WAIT_V(6); PG8_BAR; PG8_MMA(1, 1, At, B1); PG8_BAR;
            PG8_LDB(B0, 1, 0); PG8_SCHED; PG8_LDA(At, 1, 0); PG8_STA_SEL(PG8_SA(0, 1), 1, k2);
            PG8_WAIT_L(8); PG8_BAR; PG8_WAIT_L(0); PG8_MMA(0, 0, At, B0); PG8_BAR; PG8_SCHED;
            PG8_LDB(B1, 1, 1); PG8_STAGE(PG8_SB(1, 0), b3, voffB);
            PG8_BAR; PG8_WAIT_L(0); PG8_MMA(0, 1, At, B1); PG8_BAR;
            PG8_LDA(At, 1, 1); PG8_STA_SEL(PG8_SA(1, 0), 0, k3);
            PG8_BAR; PG8_WAIT_L(0); PG8_MMA(1, 0, At, B0); PG8_BAR; PG8_SCHED;
            PG8_STAGE(PG8_SB(1, 1), b3 + hstepB, voffB);
            PG8_WAIT_V(6); PG8_BAR; PG8_MMA(1, 1, At, B1); PG8_BAR;
        }
        E(acc, cur, wr, wc, fr, fq);
        if (!has_next) break;
#pragma unroll
        for (int a = 0; a < 2; ++a)
#pragma unroll
            for (int b = 0; b < 2; ++b)
#pragma unroll
                for (int m = 0; m < 4; ++m)
#pragma unroll
                    for (int n = 0; n < 2; ++n) acc[a][b][m][n] = (f32x4){0.f, 0.f, 0.f, 0.f};
        cur = nxt; cB = nB; cA = nA; ++ui;
        if constexpr (GA) {
#pragma unroll
            for (int i = 0; i < 2; ++i) { cof0[i] = nof0[i]; cof1[i] = nof1[i]; } }
    }
    PG8_WAIT_V(0);
    if (wr == 0) PG8_BAR;
    PG8_BAR;
#undef PG8_SA
#undef PG8_SB
#undef PG8_STAGE
#undef PG8_STA_CUR
#undef PG8_STA_SEL
#undef PG8_GOFF
#undef PG8_LDA
#undef PG8_LDB
#undef PG8_MMA
#undef PG8_WAIT_V
#undef PG8_WAIT_L
#undef PG8_BAR
#undef PG8_SCHED
}
}

constexpr int NWAVES = 8, NTHR = 512;
struct Args { const float* in[26]; float* out; unsigned char* ws; int ph_lo, ph_hi; unsigned repmask; int pad; };
struct Frame {
    LAS unsigned char* lds;
    int tid, lane, wave, G, bx;
    unsigned char* ws;
};

struct APlain { const void* base; unsigned kstep; unsigned ld2;
    static constexpr bool GATHER = false;
    __device__ __forceinline__ const void* unit_ptr(const pg8::Unit& u) const { return (const char*)base + (size_t)u.pm * 256 * ld2; }
    __device__ __forceinline__ unsigned lane_off(int R, int C) const { return (unsigned)R * ld2 + (unsigned)C * 2u; }
    __device__ __forceinline__ size_t hstep() const { return (size_t)128 * ld2; }
    __device__ __forceinline__ unsigned row_off(const pg8::Unit&, int) const { return 0u; } };
struct BPlain { const bf16* Bt; int K;
    __device__ __forceinline__ const void* ptr(const pg8::Unit& u) const { return Bt + (size_t)u.pn * 256 * K; } };

struct EpiZ {
    static constexpr bool PERM = true;
    bf16* ZA; bf16* ZG;
    __device__ __forceinline__ void operator()(const f32x4 (&acc)[2][2][4][2], const pg8::Unit& u, int wr, int wc, int fr, int fq) const {
        const bool gate = u.pn >= 11;
        bf16* base = gate ? ZG : ZA; const int ld = gate ? ZG_LD : ZA_LD; const int colt = gate ? (u.pn - 11) * 256 : u.pn * 256;
        const int row0 = u.pm * 256 + wr * 64 + fr, col0 = colt + wc * 32 + 8 * fq;
#pragma unroll
        for (int ai = 0; ai < 2; ++ai)
#pragma unroll
            for (int m = 0; m < 4; ++m) { bf16* rowp = base + (size_t)(row0 + ai * 128 + m * 16) * ld + col0;
#pragma unroll
                for (int bj = 0; bj < 2; ++bj) { f32x4 v0 = acc[ai][bj][m][0], v1 = acc[ai][bj][m][1];
                    if (gate) {
#pragma unroll
                        for (int j = 0; j < 4; ++j) { v0[j] = sigmoidf_(v0[j]); v1[j] = sigmoidf_(v1[j]); } }
                    u32x4 w; w.x = pk2(v0[0], v0[1]); w.y = pk2(v0[2], v0[3]); w.z = pk2(v1[0], v1[1]); w.w = pk2(v1[2], v1[3]);
                    *(u32x4*)(rowp + bj * 128) = w; } }
    }
};
template <int MODE> struct EpiGate {
    static constexpr bool PERM = true;
    const bf16* ZG; const bf16* T1; bf16* O;
    __device__ __forceinline__ void operator()(const f32x4 (&acc)[2][2][4][2], const pg8::Unit& u, int wr, int wc, int fr, int fq) const {
        const int row0 = u.pm * 256 + wr * 64 + fr, col0 = u.pn * 256 + wc * 32 + 8 * fq;
#pragma unroll
        for (int ai = 0; ai < 2; ++ai)
#pragma unroll
            for (int m = 0; m < 4; ++m) { const size_t r = (size_t)(row0 + ai * 128 + m * 16);
#pragma unroll
                for (int bj = 0; bj < 2; ++bj) { const int c = col0 + bj * 128;
                    const u32x4 g = *(const u32x4*)(ZG + r * ZG_LD + MODE * 1024 + c);
                    f32x4 v0 = acc[ai][bj][m][0], v1 = acc[ai][bj][m][1];
                    float o[8] = { v0[0] * bflo(g.x), v0[1] * bfhi(g.x), v0[2] * bflo(g.y), v0[3] * bfhi(g.y), v1[0] * bflo(g.z), v1[1] * bfhi(g.z), v1[2] * bflo(g.w), v1[3] * bfhi(g.w) };
                    if (MODE == 1) { const u32x4 t = *(const u32x4*)(T1 + r * 1024 + c);
                        o[0] += bflo(t.x); o[1] += bfhi(t.x); o[2] += bflo(t.y); o[3] += bfhi(t.y); o[4] += bflo(t.z); o[5] += bfhi(t.z); o[6] += bflo(t.w); o[7] += bfhi(t.w); }
                    u32x4 w; w.x = pk2(o[0], o[1]); w.y = pk2(o[2], o[3]); w.z = pk2(o[4], o[5]); w.w = pk2(o[6], o[7]);
                    *(u32x4*)(O + r * 1024 + c) = w; } }
    }
};
struct EpiRes {
    static constexpr bool PERM = true;
    const float* X; bf16* O;
    __device__ __forceinline__ void operator()(const f32x4 (&acc)[2][2][4][2], const pg8::Unit& u, int wr, int wc, int fr, int fq) const {
        const int row0 = u.pm * 256 + wr * 64 + fr, col0 = u.pn * 256 + wc * 32 + 8 * fq;
#pragma unroll
        for (int ai = 0; ai < 2; ++ai)
#pragma unroll
            for (int m = 0; m < 4; ++m) { const size_t off = (size_t)(row0 + ai * 128 + m * 16) * D + col0;
#pragma unroll
                for (int bj = 0; bj < 2; ++bj) { const f32x4 x0 = *(const f32x4*)(X + off + bj * 128), x1 = *(const f32x4*)(X + off + bj * 128 + 4);
                    const f32x4 v0 = x0 * ALPHA + acc[ai][bj][m][0], v1 = x1 * ALPHA + acc[ai][bj][m][1];
                    u32x4 w; w.x = pk2(v0[0], v0[1]); w.y = pk2(v0[2], v0[3]); w.z = pk2(v1[0], v1[1]); w.w = pk2(v1[2], v1[3]);
                    *(u32x4*)(O + off + bj * 128) = w; } }
    }
};

template <class F>
__device__ __forceinline__ void p0_tile(const F& f, bf16* WT, int ldk, int k0, int n0, LAS float* scr, int lane) {
    if constexpr (F::FOLD) {
        float bc[64];
#pragma unroll
        for (int d = 0; d < 64; ++d) bc[d] = f.bval(k0, d, n0 + (lane & 31));
#pragma unroll 4
        for (int i = 0; i < 32; ++i) { const int kk = 2 * i + (lane >> 5); const f32x4* ar = (const f32x4*)f.arow(k0 + kk, n0); f32x4 a4 = {0.f, 0.f, 0.f, 0.f};
#pragma unroll
            for (int q = 0; q < 16; ++q) { const f32x4 av = ar[q]; a4[0] += av[0] * bc[4 * q]; a4[1] += av[1] * bc[4 * q + 1]; a4[2] += av[2] * bc[4 * q + 2]; a4[3] += av[3] * bc[4 * q + 3]; }
            scr[kk * 33 + (lane & 31)] = (a4[0] + a4[1]) + (a4[2] + a4[3]); }
    } else {
        float v[32];
#pragma unroll
        for (int i = 0; i < 32; ++i) { const int kk = 2 * i + (lane >> 5); v[i] = f(k0 + kk, n0 + (lane & 31)); }
#pragma unroll
        for (int i = 0; i < 32; ++i) { const int kk = 2 * i + (lane >> 5); scr[kk * 33 + (lane & 31)] = v[i]; }
    }
    LDS_WAIT(); asm volatile("" ::: "memory");
    const int c = lane & 7;
#pragma unroll
    for (int j = 0; j < 4; ++j) { const int n = (lane >> 3) + 8 * j; const LAS float* s = scr + (8 * c) * 33 + n;
        u32x4 o; o.x = pk2(s[0 * 33], s[1 * 33]); o.y = pk2(s[2 * 33], s[3 * 33]); o.z = pk2(s[4 * 33], s[5 * 33]); o.w = pk2(s[6 * 33], s[7 * 33]);
        *(u32x4*)(WT + (size_t)(n0 + n) * ldk + k0 + 8 * c) = o; }
    LDS_WAIT(); asm volatile("" ::: "memory");
}
struct P0Item { const float* src; int N, noff; bf16* dst; int ldk, k0, n0; };
__device__ __forceinline__ void p0_item_load(const P0Item& it, float (&v)[32], int lane) {
#pragma unroll
    for (int i = 0; i < 32; ++i) { const int kk = 2 * i + (lane >> 5); v[i] = it.src[(size_t)(it.k0 + kk) * it.N + it.n0 + (lane & 31) + it.noff]; }
}
__device__ __forceinline__ void p0_item_finish(const P0Item& it, const float (&v)[32], LAS float* scr, int lane) {
#pragma unroll
    for (int i = 0; i < 32; ++i) { const int kk = 2 * i + (lane >> 5); scr[kk * 33 + (lane & 31)] = v[i]; }
    LDS_WAIT(); asm volatile("" ::: "memory");
    const int c = lane & 7;
#pragma unroll
    for (int j = 0; j < 4; ++j) { const int n = (lane >> 3) + 8 * j; const LAS float* s = scr + (8 * c) * 33 + n;
        u32x4 o; o.x = pk2(s[0 * 33], s[1 * 33]); o.y = pk2(s[2 * 33], s[3 * 33]); o.z = pk2(s[4 * 33], s[5 * 33]); o.w = pk2(s[6 * 33], s[7 * 33]);
        *(u32x4*)(it.dst + (size_t)(it.n0 + n) * it.ldk + it.k0 + 8 * c) = o; }
    LDS_WAIT(); asm volatile("" ::: "memory");
}
__device__ __forceinline__ int zsrc_col(int n) {
    if (n < 1280) return n;
    if (n < 2304) return -2;
    if (n < 2432) return 1816 + (n - 2304);
    if (n < 2688) return 1944 + (n - 2432);
    if (n < 2752) return 2200 + (n - 2688);
    if (n < 2776) return 1280 + (n - 2752);
    if (n < 2780) return 2264 + (n - 2776);
    if (n < 2816) return -1;
    if (n < 3840) return 2268 + (n - 2816);
    return 3292 + (n - 3840);
}
struct FWin { const float* w_in; static constexpr bool FOLD = false;
    __device__ __forceinline__ float operator()(int k, int n) const { const int s = zsrc_col(n); return s >= 0 ? w_in[(size_t)k * D_IN + s] : 0.f; } };
struct FWinQ { const float* w_in; const float* w_uk; static constexpr bool FOLD = true;
    __device__ __forceinline__ const float* arow(int k, int n0) const { return w_in + (size_t)k * D_IN + 1304 + ((n0 - 1280) >> 7) * 64; }
    __device__ __forceinline__ float bval(int, int d, int n) const { return w_uk[(size_t)((n - 1280) >> 7) * 64 * 128 + d * 128 + ((n - 1280) & 127)]; }
    __device__ __forceinline__ float operator()(int, int) const { return 0.f; } };
struct FWb { const float* w_uv; const float* w_bb; static constexpr bool FOLD = true;
    __device__ __forceinline__ const float* arow(int k, int) const { return w_uv + (size_t)k * 64; }
    __device__ __forceinline__ float bval(int k0, int d, int n) const { return w_bb[(size_t)((k0 >> 7) * 64 + d) * D + n]; }
    __device__ __forceinline__ float operator()(int, int) const { return 0.f; } };
struct FPlain { const float* W; int N; static constexpr bool FOLD = false; __device__ __forceinline__ float operator()(int k, int n) const { return W[(size_t)k * N + n]; } };
struct FOff { const float* W; int N; int noff; static constexpr bool FOLD = false;
    __device__ __forceinline__ float operator()(int k, int n) const { return W[(size_t)k * N + n + noff]; } };

__device__ __forceinline__ float rel_bucket_bias(const float* rel_bias, int dist, int head) {
    int b;
    if (dist < 16) b = dist;
    else { const float t = (__log2f((float)dist) - 4.0f) * 2.66666675f; b = 16 + (int)t; if (b > 31) b = 31; }
    return rel_bias[b * 16 + head];
}

__device__ __forceinline__ void phase0(const Frame& F, const Args& a) {
    LAS float* scr = (LAS float*)(F.lds + F.wave * 16384);
    const int gw = F.bx * NWAVES + F.wave, NGW = F.G * NWAVES;
    unsigned char* ws = F.ws;
    constexpr int I_WIN = (D / 64) * (NZ / 32);
    constexpr int I_WB = (1024 / 64) * (1024 / 32);
    constexpr int I_WA = (512 / 64) * (1024 / 32);
    constexpr int I_WO = I_WB;
    constexpr int I_W1 = (2048 / 64) * (256 / 32);
    constexpr int I_W2 = (256 / 64) * (64 / 32);
    constexpr int I_GU = (1024 / 64) * (512 / 32);
    constexpr int I_DN = (256 / 64) * (1024 / 32);
    constexpr int NITEMS = I_WIN + I_WB + I_WA + I_WO + 2 * I_W1 + 2 * I_W2;
    (void)NITEMS;
    constexpr int I_WINP = (D / 64) * ((NZ - 1024) / 32);
    for (int it = gw; it < 1024; it += NGW) {
        if (it < 512) { const int k0 = (it >> 5) * 64, n0 = 1280 + (it & 31) * 32; const FWinQ f{a.in[1], a.in[9]}; p0_tile(f, (bf16*)(ws + WS_WINT), D, k0, n0, scr, F.lane); }
        else { const int r = it - 512; const FWb f{a.in[10], a.in[13]}; p0_tile(f, (bf16*)(ws + WS_WBT), 1024, (r / 32) * 64, (r % 32) * 32, scr, F.lane); }
    }
    { constexpr int NPL = I_WINP + I_WA + I_WO + 2 * I_W1 + 2 * I_W2;
      const int pw0 = NGW > 1024 ? (gw >= 1024 ? gw - 1024 : -1) : gw, pws = NGW > 1024 ? NGW - 1024 : NGW;
      if (pw0 >= 0) for (int it = pw0; it < NPL; it += pws) {
        int r = it;
        if (r < I_WINP) { const int k0 = (r / 120) * 64; int nb = r % 120; nb = nb < 40 ? nb : nb + 32; const FWin f{a.in[1]}; p0_tile(f, (bf16*)(ws + WS_WINT), D, k0, nb * 32, scr, F.lane); continue; } r -= I_WINP;
        if (r < I_WA) { const FPlain f{a.in[12], D}; p0_tile(f, (bf16*)(ws + WS_WAT), 512, (r / 32) * 64, (r % 32) * 32, scr, F.lane); continue; } r -= I_WA;
        if (r < I_WO) { const FPlain f{a.in[14], D}; p0_tile(f, (bf16*)(ws + WS_WOT), 1024, (r / 32) * 64, (r % 32) * 32, scr, F.lane); continue; } r -= I_WO;
        if (r < I_W1) { const FPlain f{a.in[4], 256}; p0_tile(f, (bf16*)(ws + WS_W1K), 2048, (r / 8) * 64, (r % 8) * 32, scr, F.lane); continue; } r -= I_W1;
        if (r < I_W1) { const FPlain f{a.in[6], 256}; p0_tile(f, (bf16*)(ws + WS_W1V), 2048, (r / 8) * 64, (r % 8) * 32, scr, F.lane); continue; } r -= I_W1;
        if (r < I_W2) { const FPlain f{a.in[5], 64}; p0_tile(f, (bf16*)(ws + WS_W2K), 256, (r / 2) * 64, (r % 2) * 32, scr, F.lane); continue; } r -= I_W2;
        { const FPlain f{a.in[7], 64}; p0_tile(f, (bf16*)(ws + WS_W2V), 256, (r / 2) * 64, (r % 2) * 32, scr, F.lane); }
      } }
    {
        constexpr int NEI = NEXP * (I_GU + I_DN);
        auto mk = [&](int idx) { P0Item it; const int e = idx / (I_GU + I_DN); int r = idx - e * (I_GU + I_DN);
            if (r < I_GU) {
                const int n0 = (r % 16) * 32; const uintptr_t pg = (uintptr_t)a.in[21], pu = (uintptr_t)a.in[22];
                it.src = (const float*)(pg + (uintptr_t)((n0 >> 7) & 1) * (pu - pg)) + (size_t)e * D * DEXP; it.N = DEXP; it.noff = ((n0 >> 8) * 128 + (n0 & 127)) - n0;
                it.dst = (bf16*)(ws + WS_WGU) + (size_t)e * 512 * 1024; it.ldk = 1024; it.k0 = (r / 16) * 64; it.n0 = n0; }
            else { r -= I_GU; it.src = a.in[23] + (size_t)e * DEXP * D; it.N = D; it.noff = 0; it.dst = (bf16*)(ws + WS_WDT) + (size_t)e * 1024 * 256; it.ldk = 256; it.k0 = (r / 32) * 64; it.n0 = (r % 32) * 32; }
            return it; };
        float va[32], vb[32];
        {
        int idx = gw;
        if (idx < NEI) { P0Item cur = mk(idx); p0_item_load(cur, va, F.lane);
            for (;;) {
                const int nidx = idx + NGW; const bool more = nidx < NEI; P0Item nxt = cur;
                if (more) { nxt = mk(nidx); p0_item_load(nxt, vb, F.lane); }
                p0_item_finish(cur, va, scr, F.lane);
                if (!more) break;
#pragma unroll
                for (int i = 0; i < 32; ++i) va[i] = vb[i];
                cur = nxt; idx = nidx; } }
        }
    }
    { const f32x4* x4 = (const f32x4*)a.in[0]; u32x2* o = (u32x2*)(ws + WS_XB);
      const size_t total = (size_t)NTOK * D / 4, stride = (size_t)F.G * NTHR;
      for (size_t i0 = (size_t)F.bx * NTHR + F.tid; i0 < total; i0 += 8 * stride) { f32x4 v[8];
#pragma unroll
          for (int j = 0; j < 8; ++j) { const size_t i = i0 + j * stride; v[j] = i < total ? x4[i] : (f32x4){0.f, 0.f, 0.f, 0.f}; }
#pragma unroll
          for (int j = 0; j < 8; ++j) { const size_t i = i0 + j * stride; if (i < total) { u32x2 w; w.x = pk2(v[j][0], v[j][1]); w.y = pk2(v[j][2], v[j][3]); o[i] = w; } } } }
    if (F.bx < 64 && F.tid < 256) {
        const int kv = F.bx >> 5, j = F.bx & 31;
        const float* pe = (kv ? a.in[3] : a.in[2]) + 64 * j; const float* w1 = (kv ? a.in[6] : a.in[4]) + (size_t)(64 * j) * 256 + F.tid; float acc = 0.f;
#pragma unroll 16
        for (int k = 0; k < 64; ++k) acc += pe[k] * w1[(size_t)k * 256];
        ((float*)(ws + WS_BIASK))[(kv * 32 + j) * 256 + F.tid] = acc;
    }
    if (F.bx >= 64 && F.bx < 96) { const int idx = (F.bx - 64) * NTHR + F.tid;
        const int tab = idx >> 13, head = (idx >> 10) & 7, dist = idx & 1023;
        ((float*)(ws + (tab ? WS_TBB : WS_TBA)))[head * 1024 + dist] = rel_bucket_bias(a.in[11], dist, tab * 8 + head) * LOG2E; }
}

constexpr int NRT = 36;
constexpr int P6_WR = 0;
constexpr int P6_CNT = 147456;
constexpr int P6_ENT = 147456 + 512;
__device__ __forceinline__ float row16_sum(float v) {
    v += __builtin_bit_cast(float, __builtin_amdgcn_update_dpp(0, __builtin_bit_cast(int, v), 0xB1, 0xf, 0xf, true));
    v += __builtin_bit_cast(float, __builtin_amdgcn_update_dpp(0, __builtin_bit_cast(int, v), 0x4E, 0xf, 0xf, true));
    v += __builtin_bit_cast(float, __builtin_amdgcn_update_dpp(0, __builtin_bit_cast(int, v), 0x141, 0xf, 0xf, true));
    v += __builtin_bit_cast(float, __builtin_amdgcn_update_dpp(0, __builtin_bit_cast(int, v), 0x140, 0xf, 0xf, true));
    return v;
}
__device__ __forceinline__ float wave_sum_dpp(float v) { v = row16_sum(v); v += __shfl_xor(v, 16); v += __shfl_xor(v, 32); return v; }
__device__ __forceinline__ void phase6(const Frame& F, const Args& a) {
    unsigned char* ws = F.ws;
    LAS float* WR = (LAS float*)(F.lds + P6_WR);
    LAS int* cntL = (LAS int*)(F.lds + P6_CNT); LAS int* baseL = cntL + 32;
    LAS int* ent = (LAS int*)(F.lds + P6_ENT);
    const float* w_grp = a.in[17]; const float* b_grp = a.in[18]; const float* w_rtr = a.in[19]; const float* b_rtr = a.in[20];
    for (int i = F.tid; i < NRT * 1024; i += NTHR) { const int o = i >> 10, k = i & 1023; WR[i] = o < 4 ? w_grp[k * 4 + o] : w_rtr[k * 32 + (o - 4)]; }
    if (F.tid < 65) cntL[F.tid] = 0;
    __syncthreads();
    const bf16* HP = (const bf16*)(ws + WS_H1); bf16* H1B = (bf16*)(ws + WS_H1B);
    const float* lg = a.in[15]; const float* lb = a.in[16];
    f32x2 gam[8], bet[8];
#pragma unroll
    for (int j = 0; j < 2; ++j)
#pragma unroll
        for (int q = 0; q < 4; ++q) { gam[4 * j + q] = *(const f32x2*)(lg + 512 * j + 8 * F.lane + 2 * q); bet[4 * j + q] = *(const f32x2*)(lb + 512 * j + 8 * F.lane + 2 * q); }
    unsigned* gcnt = (unsigned*)(ws + WS_CTL) + CW_CNT;
    int* list = (int*)(ws + WS_LIST); float* tokinfo = (float*)(ws + WS_TOKINFO);
    const int gw = F.bx * NWAVES + F.wave, NGW = F.G * NWAVES;
    u32x4 nx0, nx1;
    const int rpb = (NTOK + F.G - 1) / F.G, rbeg = F.bx * rpb, rend = (rbeg + rpb < NTOK) ? rbeg + rpb : NTOK;
    (void)gw; (void)NGW;
    if (rbeg + F.wave < rend) { const u32x4* hr = (const u32x4*)(HP + (size_t)(rbeg + F.wave) * D) + F.lane; nx0 = hr[0]; nx1 = hr[64]; }
    for (int row = rbeg + F.wave; row < rend; row += NWAVES) {
        const u32x4 r0 = nx0, r1 = nx1;
        if (row + NWAVES < rend) { const u32x4* hr = (const u32x4*)(HP + (size_t)(row + NWAVES) * D) + F.lane; nx0 = hr[0]; nx1 = hr[64]; }
        f32x2 v[8];
        v[0] = (f32x2){bflo(r0.x), bfhi(r0.x)}; v[1] = (f32x2){bflo(r0.y), bfhi(r0.y)}; v[2] = (f32x2){bflo(r0.z), bfhi(r0.z)}; v[3] = (f32x2){bflo(r0.w), bfhi(r0.w)};
        v[4] = (f32x2){bflo(r1.x), bfhi(r1.x)}; v[5] = (f32x2){bflo(r1.y), bfhi(r1.y)}; v[6] = (f32x2){bflo(r1.z), bfhi(r1.z)}; v[7] = (f32x2){bflo(r1.w), bfhi(r1.w)};
        f32x2 s2 = v[0];
#pragma unroll
        for (int q = 1; q < 8; ++q) s2 += v[q];
        const float mean = wave_sum_dpp(s2[0] + s2[1]) * (1.f / D);
        f32x2 q2 = {0.f, 0.f};
#pragma unroll
        for (int q = 0; q < 8; ++q) { v[q] = v[q] - mean; q2 += v[q] * v[q]; }
        const float rstd = 1.0f / sqrtf(wave_sum_dpp(q2[0] + q2[1]) * (1.f / D) + 1e-5f);
#pragma unroll
        for (int q = 0; q < 8; ++q) v[q] = v[q] * rstd * gam[q] + bet[q];
        { u32x4 w0, w1; w0.x = pk2(v[0][0], v[0][1]); w0.y = pk2(v[1][0], v[1][1]); w0.z = pk2(v[2][0], v[2][1]); w0.w = pk2(v[3][0], v[3][1]);
          w1.x = pk2(v[4][0], v[4][1]); w1.y = pk2(v[5][0], v[5][1]); w1.z = pk2(v[6][0], v[6][1]); w1.w = pk2(v[7][0], v[7][1]);
          u32x4* ob = (u32x4*)(H1B + (size_t)row * D) + F.lane; ob[0] = w0; ob[64] = w1; }
        float L[NRT];
#pragma unroll
        for (int o = 0; o < NRT; ++o) { f32x2 p2 = {0.f, 0.f};
#pragma unroll
            for (int j = 0; j < 2; ++j) { const f32x4 wa = *(const LAS f32x4*)(WR + o * 1024 + 512 * j + 8 * F.lane), wb = *(const LAS f32x4*)(WR + o * 1024 + 512 * j + 8 * F.lane + 4);
                p2 += v[4 * j] * (f32x2){wa[0], wa[1]}; p2 += v[4 * j + 1] * (f32x2){wa[2], wa[3]}; p2 += v[4 * j + 2] * (f32x2){wb[0], wb[1]}; p2 += v[4 * j + 3] * (f32x2){wb[2], wb[3]}; }
            L[o] = row16_sum(p2[0] + p2[1]); }
#pragma unroll
        for (int o = 0; o < NRT; ++o) { float t = L[o]; t += __shfl_xor(t, 16); t += __shfl_xor(t, 32); L[o] = t; }
        float g[4];
#pragma unroll
        for (int i = 0; i < 4; ++i) g[i] = L[i] + b_grp[i];
        int gs = 0; float gm = g[0];
#pragma unroll
        for (int i = 1; i < 4; ++i) if (g[i] > gm) { gm = g[i]; gs = i; }
        float gsum = 0.f;
#pragma unroll
        for (int i = 0; i < 4; ++i) gsum += __expf(g[i] - gm);
        const float pgrp = 1.0f / gsum;
        float el[8];
#pragma unroll
        for (int i = 0; i < 8; ++i) { const float x0 = L[4 + i], x1 = L[12 + i], x2 = L[20 + i], x3 = L[28 + i]; el[i] = (gs == 0 ? x0 : gs == 1 ? x1 : gs == 2 ? x2 : x3) + b_rtr[gs * 8 + i]; }
        int i1 = 0; float l1 = el[0];
#pragma unroll
        for (int i = 1; i < 8; ++i) if (el[i] > l1) { l1 = el[i]; i1 = i; }
        int i2 = -1; float l2 = -3.0e38f;
#pragma unroll
        for (int i = 0; i < 8; ++i) if (i != i1 && el[i] > l2) { l2 = el[i]; i2 = i; }
        const float e2 = __expf(l2 - l1), inv = 1.0f / (1.0f + e2);
        const float w0 = pgrp * inv, w1 = pgrp * e2 * inv;
        const int e0 = gs * 8 + i1, e1 = gs * 8 + i2;
        if (F.lane == 0) {
            const int p0 = atomicAdd((int*)&cntL[e0], 1), p1 = atomicAdd((int*)&cntL[e1], 1);
            const int n0 = atomicAdd((int*)&cntL[64], 2);
            ent[2 * n0] = (e0 << 16) | p0; ent[2 * n0 + 1] = row * 2;
            ent[2 * n0 + 2] = (e1 << 16) | p1; ent[2 * n0 + 3] = row * 2 + 1;
            tokinfo[row * 2] = w0; tokinfo[row * 2 + 1] = w1;
        }
    }
    __syncthreads();
    if (F.tid < 32) { const int c = cntL[F.tid]; baseL[F.tid] = c > 0 ? (int)__hip_atomic_fetch_add(gcnt + 64 * F.tid, (unsigned)c, __ATOMIC_RELAXED, __HIP_MEMORY_SCOPE_AGENT) : 0; }
    __syncthreads();
    const int nent = cntL[64];
    for (int i = F.tid; i < nent; i += NTHR) { const int ep = ent[2 * i], tk = ent[2 * i + 1]; const int e = ep >> 16, p = ep & 0xffff; list[(size_t)e * NTOK + baseL[e] + p] = tk; }
    __syncthreads();
}

constexpr int MOE_CUM = 131072;
struct MoeOrder {
    int G, c, NP; const LAS int* cum; const LAS int* cnt;
    __device__ bool next(int i, pg8::Unit& u) const {
        const int L = i * G + c, t = L / NP; if (t >= cum[32]) return false;
        const int e = cum[80 + t];
        const int j = t - cum[e]; u.pm = t; u.pn = L % NP; u.e = e | (j << 8); const int rem = cnt[e] - j * 256; u.nrows = rem < 256 ? rem : 256; return true;
    }
};
__device__ __forceinline__ void moe_setup(const Frame& F) {
    LAS int* cum = (LAS int*)(F.lds + MOE_CUM); LAS int* cnt = cum + 40;
    const unsigned* gcnt = (const unsigned*)(F.ws + WS_CTL) + CW_CNT;
    if (F.tid == 0) { int s = 0; for (int e = 0; e < 32; ++e) { const int c = (int)__hip_atomic_load(gcnt + 64 * e, __ATOMIC_RELAXED, __HIP_MEMORY_SCOPE_AGENT); cnt[e] = c; cum[e] = s; s += (c + 255) >> 8; } cum[32] = s; }
    __syncthreads();
    for (int t = F.tid; t < cum[32]; t += NTHR) { int e = 0; for (int k = 1; k < 32; ++k) if (t >= cum[k]) e = k; cum[80 + t] = e; }
    __syncthreads();
}
struct AGather { const void* base; unsigned kstep; const int* list;
    static constexpr bool GATHER = true;
    __device__ __forceinline__ const void* unit_ptr(const pg8::Unit&) const { return base; }
    __device__ __forceinline__ unsigned lane_off(int, int) const { return 0u; }
    __device__ __forceinline__ size_t hstep() const { return 0; }
    __device__ __forceinline__ unsigned row_off(const pg8::Unit& u, int r) const { const int e = u.e & 255, j = u.e >> 8; const int rr = r < u.nrows ? r : 0;
        const int tk = list[(size_t)e * NTOK + j * 256 + rr]; return (unsigned)(tk >> 1) * (unsigned)(D * 2); } };
struct BGu { const bf16* W; __device__ __forceinline__ const void* ptr(const pg8::Unit& u) const { return W + (size_t)(u.e & 255) * 512 * 1024 + (size_t)u.pn * 256 * 1024; } };
struct BDn { const bf16* W; __device__ __forceinline__ const void* ptr(const pg8::Unit& u) const { return W + (size_t)(u.e & 255) * 1024 * 256 + (size_t)u.pn * 256 * 256; } };
struct EpiAct {
    static constexpr bool PERM = true; bf16* ACT;
    __device__ __forceinline__ void operator()(const f32x4 (&acc)[2][2][4][2], const pg8::Unit& u, int wr, int wc, int fr, int fq) const {
        const int row0 = u.pm * 256 + wr * 64 + fr, col0 = u.pn * 128 + wc * 32 + 8 * fq;
#pragma unroll
        for (int ai = 0; ai < 2; ++ai)
#pragma unroll
            for (int m = 0; m < 4; ++m) { float o[8];
#pragma unroll
                for (int n = 0; n < 2; ++n)
#pragma unroll
                    for (int j = 0; j < 4; ++j) { const float gt = acc[ai][0][m][n][j], up = acc[ai][1][m][n][j]; o[4 * n + j] = gt * sigmoidf_(gt) * up; }
                u32x4 w; w.x = pk2(o[0], o[1]); w.y = pk2(o[2], o[3]); w.z = pk2(o[4], o[5]); w.w = pk2(o[6], o[7]);
                *(u32x4*)(ACT + (size_t)(row0 + ai * 128 + m * 16) * DEXP + col0) = w; }
    }
};
struct EpiDown {
    static constexpr bool PERM = true; bf16* Y; const int* list;
    __device__ __forceinline__ void operator()(const f32x4 (&acc)[2][2][4][2], const pg8::Unit& u, int wr, int wc, int fr, int fq) const {
        const int e = u.e & 255, j = u.e >> 8; const int col0 = u.pn * 256 + wc * 32 + 8 * fq;
        int tks[2][4];
#pragma unroll
        for (int ai = 0; ai < 2; ++ai)
#pragma unroll
            for (int m = 0; m < 4; ++m) { const int r = ai * 128 + wr * 64 + m * 16 + fr; tks[ai][m] = r < u.nrows ? list[(size_t)e * NTOK + j * 256 + r] : -1; }
#pragma unroll
        for (int ai = 0; ai < 2; ++ai)
#pragma unroll
            for (int m = 0; m < 4; ++m) { const int tk = tks[ai][m];
                if (tk >= 0) { bf16* rowp = Y + (size_t)tk * D + col0;
#pragma unroll
                    for (int bj = 0; bj < 2; ++bj) { const f32x4 v0 = acc[ai][bj][m][0], v1 = acc[ai][bj][m][1];
                        u32x4 w; w.x = pk2(v0[0], v0[1]); w.y = pk2(v0[2], v0[3]); w.z = pk2(v1[0], v1[1]); w.w = pk2(v1[2], v1[3]);
                        *(u32x4*)(rowp + bj * 128) = w; } } }
    }
};

__device__ __forceinline__ void phase9(const Frame& F, const Args& a) {
    unsigned char* ws = F.ws;
    const bf16* H1B = (const bf16*)(ws + WS_H1B); const bf16* Y = (const bf16*)(ws + WS_YBUF); const float* tokinfo = (const float*)(ws + WS_TOKINFO);
    const float* lg = a.in[24]; const float* lb = a.in[25];
    f32x4 gam[4], bet[4];
#pragma unroll
    for (int j = 0; j < 2; ++j) { gam[2 * j] = *(const f32x4*)(lg + 512 * j + 8 * F.lane); gam[2 * j + 1] = *(const f32x4*)(lg + 512 * j + 8 * F.lane + 4); bet[2 * j] = *(const f32x4*)(lb + 512 * j + 8 * F.lane); bet[2 * j + 1] = *(const f32x4*)(lb + 512 * j + 8 * F.lane + 4); }
    const int gw = F.bx * NWAVES + F.wave, NGW = F.G * NWAVES;
    u32x4 nh[2], ny0[2], ny1[2]; float nw0 = 0.f, nw1 = 0.f;
#define P9_LOAD(row_) do { const u32x4* hp_ = (const u32x4*)(H1B + (size_t)(row_) * D) + F.lane; const u32x4* y0_ = (const u32x4*)(Y + (size_t)((row_) * 2) * D) + F.lane; const u32x4* y1_ = (const u32x4*)(Y + (size_t)((row_) * 2 + 1) * D) + F.lane; \
        nh[0] = hp_[0]; nh[1] = hp_[64]; ny0[0] = y0_[0]; ny0[1] = y0_[64]; ny1[0] = y1_[0]; ny1[1] = y1_[64]; nw0 = tokinfo[(row_) * 2]; nw1 = tokinfo[(row_) * 2 + 1]; } while (0)
    if (gw < NTOK) P9_LOAD(gw);
    for (int row = gw; row < NTOK; row += NGW) {
        u32x4 h[2] = {nh[0], nh[1]}, p[2] = {ny0[0], ny0[1]}, q[2] = {ny1[0], ny1[1]}; const float w0 = nw0, w1 = nw1;
        if (row + NGW < NTOK) P9_LOAD(row + NGW);
        f32x4 v[4]; float s = 0.f;
#pragma unroll
        for (int j = 0; j < 2; ++j) {
            v[2 * j][0] = ALPHA * bflo(h[j].x) + w0 * bflo(p[j].x) + w1 * bflo(q[j].x); v[2 * j][1] = ALPHA * bfhi(h[j].x) + w0 * bfhi(p[j].x) + w1 * bfhi(q[j].x);
            v[2 * j][2] = ALPHA * bflo(h[j].y) + w0 * bflo(p[j].y) + w1 * bflo(q[j].y); v[2 * j][3] = ALPHA * bfhi(h[j].y) + w0 * bfhi(p[j].y) + w1 * bfhi(q[j].y);
            v[2 * j + 1][0] = ALPHA * bflo(h[j].z) + w0 * bflo(p[j].z) + w1 * bflo(q[j].z); v[2 * j + 1][1] = ALPHA * bfhi(h[j].z) + w0 * bfhi(p[j].z) + w1 * bfhi(q[j].z);
            v[2 * j + 1][2] = ALPHA * bflo(h[j].w) + w0 * bflo(p[j].w) + w1 * bflo(q[j].w); v[2 * j + 1][3] = ALPHA * bfhi(h[j].w) + w0 * bfhi(p[j].w) + w1 * bfhi(q[j].w); }
#pragma unroll
        for (int j = 0; j < 4; ++j) s += (v[j][0] + v[j][1]) + (v[j][2] + v[j][3]);
        const float mean = wave_sum_dpp(s) * (1.f / D); float s2 = 0.f;
#pragma unroll
        for (int j = 0; j < 4; ++j) { v[j] = v[j] - mean; s2 += (v[j][0] * v[j][0] + v[j][1] * v[j][1]) + (v[j][2] * v[j][2] + v[j][3] * v[j][3]); }
        const float rstd = 1.0f / sqrtf(wave_sum_dpp(s2) * (1.f / D) + 1e-5f);
        float* orow = a.out + (size_t)row * D + 8 * F.lane;
#pragma unroll
        for (int j = 0; j < 2; ++j) { *(f32x4*)(orow + 512 * j) = v[2 * j] * rstd * gam[2 * j] + bet[2 * j]; *(f32x4*)(orow + 512 * j + 4) = v[2 * j + 1] * rstd * gam[2 * j + 1] + bet[2 * j + 1]; }
    }
#undef P9_LOAD
}
#define MFMA32(a, b, c) __builtin_amdgcn_mfma_f32_32x32x16_bf16((a), (b), (c), 0, 0, 0)
__device__ __forceinline__ int crow(int r, int hi) { return (r & 3) + 8 * (r >> 2) + 4 * hi; }
__device__ __forceinline__ float gelu_tanh(float x) { const float u = 0.7978845608028654f * (x + 0.044715f * x * x * x); const float e = __expf(2.0f * u); return 0.5f * x * (2.0f - 2.0f / (e + 1.0f)); }
constexpr int P2_AROW = 4096 + 16;
constexpr int P2_HID = 32 * P2_AROW;
constexpr int P2_HROW = 512 + 16;
__device__ __forceinline__ void phase2(const Frame& F, const Args& a) {
    unsigned char* ws = F.ws;
    const bf16* ZA = (const bf16*)(ws + WS_ZA);
    { const float* gn = a.in[8]; bf16* CK = (bf16*)(ws + WS_CKVN);
      const int sub = F.lane >> 4, l16 = F.lane & 15;
      float gv[8];
#pragma unroll
      for (int j = 0; j < 8; ++j) gv[j] = gn[l16 * 8 + j];
      for (int r4 = F.bx * NWAVES + F.wave; r4 < NTOK / 4; r4 += F.G * NWAVES) { const int row = r4 * 4 + sub;
          const u32x4 w = *(const u32x4*)(ZA + (size_t)row * ZA_LD + ZC_CKV + l16 * 8);
          float v[8] = { bflo(w.x), bfhi(w.x), bflo(w.y), bfhi(w.y), bflo(w.z), bfhi(w.z), bflo(w.w), bfhi(w.w) };
          float s = 0.f;
#pragma unroll
          for (int j = 0; j < 8; ++j) s += v[j] * v[j];
          s += __shfl_xor(s, 1); s += __shfl_xor(s, 2); s += __shfl_xor(s, 4); s += __shfl_xor(s, 8);
          const float rs = 1.0f / sqrtf(s * (1.0f / 128.0f) + 1e-6f);
          u32x4 o; o.x = pk2(v[0] * rs * gv[0], v[1] * rs * gv[1]); o.y = pk2(v[2] * rs * gv[2], v[3] * rs * gv[3]); o.z = pk2(v[4] * rs * gv[4], v[5] * rs * gv[5]); o.w = pk2(v[6] * rs * gv[6], v[7] * rs * gv[7]);
          *(u32x4*)(CK + (size_t)row * 128 + l16 * 8) = o; } }
    const int r32 = F.lane & 31, hi = F.lane >> 5;
    for (int u = F.bx; u < 256; u += F.G) {
        const int kv = u >> 7, rt = u & 127, R0 = rt * 32;
        const int zc = kv ? ZC_VC : ZC_KC;
        const bf16* W1T = (const bf16*)(ws + (kv ? WS_W1V : WS_W1K)); const bf16* W2T = (const bf16*)(ws + (kv ? WS_W2V : WS_W2K));
        const float* bias = (const float*)(ws + WS_BIASK) + (size_t)kv * 32 * 256;
        bf16* OUT = (bf16*)(ws + (kv ? WS_VCMP : WS_KCMP));
        __syncthreads();
        for (int q = F.tid; q < 32 * 256; q += NTHR) { const int row = q >> 8, cq = q & 255, l = cq >> 3, dch = cq & 7;
            const int R = R0 + row, b = R >> 9, c = (R >> 1) & 255, g = R & 1; const int cc = c < NCMP ? c : NCMP - 1;
            const u32x4 v = *(const u32x4*)(ZA + (size_t)(b * SEQ + 16 * cc + l) * ZA_LD + zc + g * 64 + dch * 8);
            *(LAS u32x4*)(F.lds + row * P2_AROW + cq * 16) = v; }
        __syncthreads();
        f32x16 acc = {};
        { const bf16* bp = W1T + (size_t)(32 * F.wave + r32) * 2048 + 8 * hi; const LAS unsigned char* ap = F.lds + r32 * P2_AROW + 16 * hi;
          f32x16 acc1 = {};
#pragma unroll 1
          for (int s0 = 0; s0 < 128; s0 += 32) { bf16x8 bfr[32];
#pragma unroll
              for (int j = 0; j < 32; ++j) bfr[j] = *(const bf16x8*)(bp + (s0 + j) * 16);
#pragma unroll
              for (int j = 0; j < 32; j += 2) { const bf16x8 a0 = *(const LAS bf16x8*)(ap + (s0 + j) * 32), a1 = *(const LAS bf16x8*)(ap + (s0 + j + 1) * 32); acc = MFMA32(a0, bfr[j], acc); acc1 = MFMA32(a1, bfr[j + 1], acc1); } }
#pragma unroll
          for (int i = 0; i < 16; ++i) acc[i] += acc1[i]; }
        { float bs = 0.f;
#pragma unroll 8
          for (int j = 0; j < 32; ++j) bs += bias[j * 256 + 32 * F.wave + r32];
#pragma unroll
          for (int i = 0; i < 16; ++i) { const float h = gelu_tanh(acc[i] + bs); *(LAS unsigned short*)(F.lds + P2_HID + crow(i, hi) * P2_HROW + (32 * F.wave + r32) * 2) = (unsigned short)f2bf(h); } }
        __syncthreads();
        if (F.wave < 2) {
            f32x16 o2 = {};
            const bf16* bp = W2T + (size_t)(32 * F.wave + r32) * 256 + 8 * hi; const LAS unsigned char* ap = F.lds + P2_HID + r32 * P2_HROW + 16 * hi;
#pragma unroll
            for (int s = 0; s < 16; ++s) { const bf16x8 af = *(const LAS bf16x8*)(ap + s * 32); const bf16x8 bfr = *(const bf16x8*)(bp + s * 16); o2 = MFMA32(af, bfr, o2); }
#pragma unroll
            for (int i = 0; i < 16; ++i) OUT[(size_t)(R0 + crow(i, hi)) * 64 + 32 * F.wave + r32] = (bf16)f2bf(o2[i]);
        }
    }
    __syncthreads();
}

typedef short v4i16_t __attribute__((ext_vector_type(4)));
__device__ __forceinline__ s16x4 vtr(const LAS unsigned char* p) { return __builtin_bit_cast(s16x4, __builtin_amdgcn_ds_read_tr16_b64_v4i16((LAS v4i16_t*)p)); }
constexpr int NSA_K = 0;
constexpr int NSA_V = 16384;
constexpr int NSA_TB = 49152;
constexpr int NSA_SC = 65536;
constexpr int NSA_MSK = 81920;
constexpr int NSA_OF = 83968;
constexpr float C2 = 0.125f * LOG2E;

__device__ __forceinline__ float halfmax(float v) { return fmaxf(v, __shfl_xor(v, 32)); }
__device__ __forceinline__ void nsa_tile(const LAS unsigned char* Kb, const LAS unsigned char* Vb, const LAS float* tbh, const bf16x8 (&qr)[4], f32x16 (&o)[2], float& m, float& l,
                                         int kt, int tq, int kmul, int kadd, int dmax, bool selbit, int mode, float b31, int r32, int hi, int lane) {
    const int tqa = tq - kadd, qk = kmul == 16 ? (tqa >> 4) : tqa, rem = kmul == 16 ? (tqa & 15) : 0;
    const int ebase = qk - (kt * 64 + 4 * hi);
    const LAS unsigned char* vp0 = Vb + ((lane >> 4) & 1) * 32 + (lane & 3) * 8 + (4 * hi + ((lane & 15) >> 2)) * 64;
#pragma unroll
    for (int hf = 0; hf < 2; ++hf) {
        f32x16 s0 = {};
#pragma unroll
        for (int d0 = 0; d0 < 4; ++d0) { const bf16x8 k0 = *(const LAS bf16x8*)(Kb + (2 * d0 + hi) * 1024 + (r32 + 32 * hf) * 16); s0 = MFMA32(k0, qr[d0], s0); }
        float tmax, mn, ps = 0.f;
        if (mode == 2) {
            float a0 = fmaxf(fmaxf(s0[0], s0[1]), s0[2]), a1 = fmaxf(fmaxf(s0[3], s0[4]), s0[5]);
            a0 = fmaxf(fmaxf(a0, s0[6]), s0[7]); a1 = fmaxf(fmaxf(a1, s0[8]), s0[9]); a0 = fmaxf(fmaxf(a0, s0[10]), s0[11]); a1 = fmaxf(fmaxf(a1, s0[12]), s0[13]); a0 = fmaxf(fmaxf(a0, s0[14]), s0[15]);
            const float cb = selbit ? b31 : NEGBIG;
            tmax = fmaxf(a0, a1) * C2 + cb;
            tmax = halfmax(tmax);
            mn = fmaxf(m, tmax);
            const float cc = cb - mn;
#pragma unroll
            for (int r = 0; r < 16; ++r) { const float p0 = __builtin_amdgcn_exp2f(s0[r] * C2 + cc); s0[r] = p0; ps += p0; }
        } else if (mode == 1) {
            int eb1 = ebase; asm volatile("" : "+v"(eb1));
            const LAS float* tb1 = tbh + (eb1 - 96);
            float bv[16];
#pragma unroll
            for (int r = 0; r < 16; ++r) bv[r] = tb1[96 - ((r & 3) + 8 * (r >> 2) + 32 * hf)];
#pragma unroll
            for (int r = 0; r < 16; ++r) asm volatile("" : "+v"(bv[r]));
            tmax = NEGBIG;
#pragma unroll
            for (int r = 0; r < 16; ++r) { const float x = s0[r] * C2 + bv[r]; s0[r] = x; tmax = fmaxf(tmax, x); }
            tmax = selbit ? tmax : NEGBIG;
            tmax = halfmax(tmax);
            mn = fmaxf(m, tmax);
            const float mne = selbit ? mn : 1e30f;
#pragma unroll
            for (int r = 0; r < 16; ++r) { const float p0 = __builtin_amdgcn_exp2f(s0[r] - mne); s0[r] = p0; ps += p0; }
        } else {
            tmax = NEGBIG;
            float bv[16];
            int eb0 = ebase; asm volatile("" : "+v"(eb0));
#pragma unroll
            for (int r = 0; r < 16; ++r) { const int dist = __mul24(eb0 - ((r & 3) + 8 * (r >> 2) + 32 * hf), kmul) + rem; int dc = dist < 0 ? 0 : dist; dc = dc > 1023 ? 1023 : dc; bv[r] = tbh[dc]; }
#pragma unroll
            for (int r = 0; r < 16; ++r) asm volatile("" : "+v"(bv[r]));
#pragma unroll
            for (int r = 0; r < 16; ++r) { const int dist = __mul24(eb0 - ((r & 3) + 8 * (r >> 2) + 32 * hf), kmul) + rem;
                const bool valid = selbit && dist >= 0 && dist < dmax;
                const float x = valid ? s0[r] * C2 + bv[r] : NEGBIG;
                s0[r] = x; tmax = fmaxf(tmax, x); }
            tmax = halfmax(tmax);
            mn = fmaxf(m, tmax);
#pragma unroll
            for (int r = 0; r < 16; ++r) { const float p0 = s0[r] > -1e29f ? __builtin_amdgcn_exp2f(s0[r] - mn) : 0.f; s0[r] = p0; ps += p0; }
        }
        if (__any(mn != m)) {
            const float alpha = __builtin_amdgcn_exp2f(m - mn);
            l *= alpha;
#pragma unroll
            for (int c = 0; c < 2; ++c)
#pragma unroll
                for (int r = 0; r < 16; ++r) o[c][r] *= alpha;
        }
        m = mn;
        l += ps;
        u32x4 pw[2];
#pragma unroll
        for (int q = 0; q < 4; ++q) { pw[0][q] = pk2(s0[2 * q], s0[2 * q + 1]); pw[1][q] = pk2(s0[8 + 2 * q], s0[8 + 2 * q + 1]); }
#pragma unroll
        for (int c = 0; c < 2; ++c)
#pragma unroll
            for (int s2 = 0; s2 < 2; ++s2) { const int s = 2 * hf + s2; const s16x4 vl = vtr(vp0 + c * 4096 + s * 1024), vh = vtr(vp0 + c * 4096 + s * 1024 + 512);
                const bf16x8 vf = {vl[0], vl[1], vl[2], vl[3], vh[0], vh[1], vh[2], vh[3]};
                o[c] = MFMA32(vf, __builtin_bit_cast(bf16x8, pw[s2]), o[c]); }
    }
}

__device__ __forceinline__ void nsa_unit(const Frame& F, int b, int g, int qt) {
    unsigned char* ws = F.ws;
    const bf16* ZA = (const bf16*)(ws + WS_ZA);
    const int r32 = F.lane & 31, hi = F.lane >> 5, qi = r32 >> 2, hh = r32 & 3, head = g * 4 + hh;
    const int q0 = qt * 64, tq = q0 + 8 * F.wave + qi;
    const size_t zrow = (size_t)(b * SEQ + tq) * ZA_LD;
    const int srow = F.tid >> 3, sch = F.tid & 7;
    __syncthreads();
    { const float* TBA = (const float*)(ws + WS_TBA) + (size_t)g * 4 * 1024; LAS float* tb = (LAS float*)(F.lds + NSA_TB);
      for (int i = F.tid; i < 4096; i += NTHR) tb[i] = TBA[i]; }
    const LAS float* tbh = (const LAS float*)(F.lds + NSA_TB) + hh * 1024;
    const int wq0 = q0 + 8 * F.wave;
    const float b31 = ((const float*)(ws + WS_TBA))[(size_t)head * 1024 + 1023];
    bf16x8 qr[4];
#pragma unroll
    for (int d0 = 0; d0 < 4; ++d0) qr[d0] = *(const bf16x8*)(ZA + zrow + ZC_QA + head * 64 + d0 * 16 + hi * 8);
    float gate[3];
#pragma unroll
    for (int i = 0; i < 3; ++i) gate[i] = sigmoidf_(bf2f(ZA[zrow + ZC_GNSA + head * 3 + i]));
    LAS float* ofw = (LAS float*)(F.lds + NSA_OF) + F.wave * 2048 + F.lane;
    unsigned mlo = 0u, mhi = 0u; float inv_cmp = 0.f;
    u32x4 kreg, vreg = {0u, 0u, 0u, 0u};
    const bf16* kgp; size_t vdel, tstep; bool vmap_ld;
#define NSA_SETUP(br_) do { const int b_ = (br_); const bf16* Kg_; size_t pitch_; int tl_; \
        if (b_ < 2) { Kg_ = (const bf16*)(ws + WS_KCMP) + (size_t)(b * 256) * 128 + g * 64; vdel = (size_t)((const bf16*)(ws + WS_VCMP) - (const bf16*)(ws + WS_KCMP)); pitch_ = 128; tl_ = 0; } \
        else { Kg_ = ZA + (size_t)(b * SEQ) * ZA_LD + (b_ == 2 ? ZC_KS : ZC_KW) + g * 64; vdel = 128; pitch_ = ZA_LD; tl_ = (b_ == 3 && qt > 8) ? qt - 8 : 0; } \
        kgp = Kg_ + (size_t)(tl_ * 64 + srow) * pitch_ + sch * 8; tstep = (size_t)64 * pitch_; vmap_ld = b_ == 1; } while (0)
#define NSA_GLOAD(kt_) do { kreg = *(const u32x4*)kgp; if (!vmap_ld) vreg = *(const u32x4*)(kgp + vdel); kgp += tstep; } while (0)
    NSA_SETUP(0); NSA_GLOAD(0);
#pragma nounroll
    for (int br = 0; br < 4; ++br) {
        const bool iscmp = br < 2, vmap = br == 1;
        const int t_lo = iscmp ? 0 : ((br == 3 && qt > 8) ? qt - 8 : 0), t_hi = iscmp ? ((q0 + 32) >> 10) : qt;
        const int kmul = iscmp ? 16 : 1, kadd = iscmp ? 31 : 0, dmax = br == 3 ? 512 : 0x40000000;
        f32x16 o[2]; o[0] = f32x16{}; o[1] = f32x16{};
        float m = NEGBIG, l = 0.f;
#define NSA_LSTORE(kt_, buf_) do { \
        *(LAS u32x4*)(F.lds + NSA_K + (buf_) * 8192 + sch * 1024 + srow * 16) = kreg; \
        if (vmap) { const int c_ = (kt_) * 64 + srow, jj_ = c_ >> 2, mm_ = c_ & 3; \
            _Pragma("unroll") for (int i_ = 0; i_ < 4; ++i_) { const int j0_ = sch * 8 + 2 * i_, j1_ = j0_ + 1; \
                const unsigned e0_ = (c_ < NCMP) ? (mm_ < 3 ? (j0_ == jj_ ? 0x4000u : 0u) : ((j0_ == jj_ || j0_ == jj_ + 1) ? 0x3F80u : 0u)) : 0u; \
                const unsigned e1_ = (c_ < NCMP) ? (mm_ < 3 ? (j1_ == jj_ ? 0x4000u : 0u) : ((j1_ == jj_ || j1_ == jj_ + 1) ? 0x3F80u : 0u)) : 0u; \
                vreg[i_] = e0_ | (e1_ << 16); } } \
        *(LAS u32x4*)(F.lds + NSA_V + (buf_) * 8192 + (sch >> 2) * 4096 + srow * 64 + (sch & 3) * 16) = vreg; } while (0)
        __syncthreads();
        NSA_LSTORE(t_lo, 0);
        __syncthreads();
        int buf = 0;
#pragma nounroll
        for (int kt = t_lo; kt <= t_hi; ++kt) {
            const int ktn = kt + 1; const bool more = kt < t_hi;
            if (more) NSA_GLOAD(ktn);
            const bool selbit = br == 2 ? (((kt < 32 ? (mlo >> kt) : (mhi >> (kt - 32))) & 1u) != 0u) : true;
            int mode = 0;
            { const int dmin = wq0 - (64 * kt + 63), dmx = wq0 + 7 - 64 * kt;
              if (br == 2) mode = dmin >= 790 ? 2 : (dmin >= 0 ? 1 : 0);
              if (br < 2) mode = 16 * (((wq0 - 31) >> 4) - (64 * kt + 63)) >= 790 ? 2 : 0;
              if (br == 3) mode = (dmin >= 0 && dmx <= 511) ? 1 : 0; }
            if (__any(selbit))
            nsa_tile(F.lds + NSA_K + buf * 8192, F.lds + NSA_V + buf * 8192, tbh, qr, o, m, l, kt, tq, kmul, kadd, dmax, selbit, mode, b31, r32, hi, F.lane);
            if (more) NSA_LSTORE(ktn, buf ^ 1);
            __syncthreads();
            buf ^= 1;
        }
#undef NSA_LSTORE
        if (br < 3) { NSA_SETUP(br + 1); NSA_GLOAD(0); }
        l += __shfl_xor(l, 32);
        const float inv = l > 0.f ? 1.0f / l : 0.f;
        if (br == 0) inv_cmp = inv;
        if (br != 1) { const float sc = inv * (br == 0 ? gate[0] : br == 2 ? gate[1] : gate[2]);
#pragma unroll
            for (int c = 0; c < 2; ++c)
#pragma unroll
                for (int r = 0; r < 16; ++r) { const float prev = br == 0 ? 0.f : ofw[(c * 16 + r) * 64]; ofw[(c * 16 + r) * 64] = prev + o[c][r] * sc; }
        } else {
            LAS float* scw = (LAS float*)(F.lds + NSA_SC) + F.wave * 512;
#pragma unroll
            for (int c = 0; c < 2; ++c)
#pragma unroll
                for (int r = 0; r < 16; ++r) { float v = o[c][r] * inv_cmp; v += __shfl_xor(v, 1); v += __shfl_xor(v, 2);
                    if (hh == 0) scw[qi * 64 + 32 * c + crow(r, hi)] = v; }
            LDS_WAIT();
            LAS unsigned* mskw = (LAS unsigned*)(F.lds + NSA_MSK) + F.wave * 16;
#pragma nounroll
            for (int q = 0; q < 8; ++q) {
                const int curq = (q0 + 8 * F.wave + q) >> 6, j = F.lane;
                const bool avail = j <= curq, forced = (j == 0) || (j == curq) || (j == curq - 1);
                const float sj = avail ? scw[q * 64 + j] + (forced ? 1e4f : 0.f) : NEGBIG;
                LDS_WAIT();
                scw[q * 64 + j] = sj;
                LDS_WAIT();
                int rank = 0;
#pragma unroll 4
                for (int j2 = 0; j2 < 64; ++j2) { const float s2 = scw[q * 64 + j2]; rank += (s2 > sj || (s2 == sj && j2 < j)) ? 1 : 0; }
                const bool sel = rank < 16 && avail;
                const unsigned long long bm = __ballot(sel);
                if (F.lane == 0) { mskw[2 * q] = (unsigned)bm; mskw[2 * q + 1] = (unsigned)(bm >> 32); } }
            LDS_WAIT();
            mlo = mskw[2 * qi]; mhi = mskw[2 * qi + 1];
        }
    }
#undef NSA_GLOAD
#undef NSA_SETUP
    bf16* OA = (bf16*)(ws + WS_OA) + (size_t)(b * SEQ + tq) * 512 + head * 64;
#pragma unroll
    for (int c = 0; c < 2; ++c)
#pragma unroll
        for (int r4 = 0; r4 < 4; ++r4) { u32x2 w; w.x = pk2(ofw[(c * 16 + 4 * r4) * 64], ofw[(c * 16 + 4 * r4 + 1) * 64]); w.y = pk2(ofw[(c * 16 + 4 * r4 + 2) * 64], ofw[(c * 16 + 4 * r4 + 3) * 64]);
            *(u32x2*)(OA + 32 * c + 8 * r4 + 4 * hi) = w; }
}
__device__ __forceinline__ void phase3(const Frame& F) {
    const bool xcd = (F.G == 256);
    const int pstart = xcd ? (F.bx >> 3) : F.bx, pstep = xcd ? 32 : F.G, pend = xcd ? 64 : 512;
#pragma nounroll
    for (int p2 = 2 * pstart; p2 < 2 * pend; p2 += (p2 & 1) ? 2 * pstep - 1 : 1) { const int p = p2 >> 1;
        const int b = xcd ? (F.bx & 7) : (p >> 6), g = (p >> 5) & 1, qt = p & 31;
        nsa_unit(F, b, g, (p2 & 1) ? qt : 63 - qt); }
    __syncthreads();
}

#define MFMA16(a, b, c) __builtin_amdgcn_mfma_f32_16x16x32_bf16((a), (b), (c), 0, 0, 0)
constexpr int DSA_SCP = 8200;
constexpr int DSA_SC = 0;
constexpr int DSA_LIST = 16 * DSA_SCP;
constexpr int DSA_NSEL = DSA_LIST + 8192;
constexpr int DSA_BIAS = DSA_NSEL + 64;
constexpr int DSA_HIST = DSA_BIAS + 1088;
constexpr int DSA_BKI = DSA_HIST + 8192;
constexpr int KSEL = 256;
__device__ __forceinline__ unsigned dsa_offb(unsigned row, unsigned ch) { return 256u * row + 16u * (ch ^ (((row & 3u) << 2) | ((row >> 2) & 3u))); }
__device__ __forceinline__ unsigned sortkey16(float x) { x = x + 0.0f; const unsigned short h = __builtin_bit_cast(unsigned short, (_Float16)x); return (h & 0x8000u) ? (unsigned)(unsigned short)~h : (unsigned)(h | 0x8000u); }
__device__ __forceinline__ int prefix_cnt(unsigned long long b) { return (int)__builtin_amdgcn_mbcnt_hi((unsigned)(b >> 32), __builtin_amdgcn_mbcnt_lo((unsigned)b, 0u)); }

__device__ __forceinline__ void dsa_unit(const Frame& F, const Args& a, int b, int qt16) {
    unsigned char* ws = F.ws;
    const bf16* ZA = (const bf16*)(ws + WS_ZA);
    const int lane = F.lane, l16 = lane & 15, quad = lane >> 4, q0 = qt16 * 16;
    __syncthreads();
#ifndef PROBE_DSA
#define PROBE_DSA 0
#endif
    for (int rep1_ = 0; rep1_ < (PROBE_DSA == 1 ? 2 : 1); ++rep1_) {
        const size_t qrow = (size_t)(b * SEQ + q0 + l16) * ZA_LD;
        bf16x8 qf[4][2];
#pragma unroll
        for (int i = 0; i < 4; ++i)
#pragma unroll
            for (int ks = 0; ks < 2; ++ks) qf[i][ks] = *(const bf16x8*)(ZA + qrow + ZC_QIDX + i * 64 + 32 * ks + 8 * quad);
        float wq[4];
#pragma unroll
        for (int i = 0; i < 4; ++i) wq[i] = bf2f(ZA[qrow + ZC_WIDX + i]) * 0.0625f;
        const int tq = q0 + l16, nkt = qt16 + 1;
        const bf16* kbase = ZA + (size_t)(b * SEQ + l16) * ZA_LD + ZC_KIDX + 8 * quad;
        bf16x8 ka[4][2], kn[4][2];
#define DSA_KLOAD(dst, kt0_) do { _Pragma("unroll") for (int t_ = 0; t_ < 4; ++t_) { const int k_ = (kt0_) + 8 * t_; const int kc_ = k_ < nkt ? k_ : nkt - 1; \
            dst[t_][0] = *(const bf16x8*)(kbase + (size_t)(kc_ * 16) * ZA_LD); dst[t_][1] = *(const bf16x8*)(kbase + (size_t)(kc_ * 16) * ZA_LD + 32); } } while (0)
        if (F.wave < nkt) DSA_KLOAD(ka, F.wave);
#pragma nounroll
        for (int kt0 = F.wave; kt0 < nkt; kt0 += 32) {
            if (kt0 + 32 < nkt) DSA_KLOAD(kn, kt0 + 32);
#pragma unroll
            for (int t = 0; t < 4; ++t) { const int kt = kt0 + 8 * t;
                if (kt < nkt) {
                    float idx[4] = {0.f, 0.f, 0.f, 0.f};
#pragma unroll
                    for (int i = 0; i < 4; ++i) { f32x4 acc = {0.f, 0.f, 0.f, 0.f}; acc = MFMA16(ka[t][0], qf[i][0], acc); acc = MFMA16(ka[t][1], qf[i][1], acc);
#pragma unroll
                        for (int r = 0; r < 4; ++r) idx[r] += fmaxf(acc[r], 0.f) * wq[i]; }
                    unsigned k16[4];
#pragma unroll
                    for (int r = 0; r < 4; ++r) { const int key = kt * 16 + 4 * quad + r; k16[r] = key <= tq ? sortkey16(idx[r]) : 0u; }
                    u32x2 w; w.x = k16[0] | (k16[1] << 16); w.y = k16[2] | (k16[3] << 16);
                    *(LAS u32x2*)(F.lds + DSA_SC + l16 * DSA_SCP + (kt * 16 + 4 * quad) * 2) = w; } }
#pragma unroll
            for (int t = 0; t < 4; ++t) { ka[t][0] = kn[t][0]; ka[t][1] = kn[t][1]; }
        }
#undef DSA_KLOAD
    }
    if (F.tid < 264) { const float* rb = a.in[11]; ((LAS float*)(F.lds + DSA_BIAS))[F.tid] = F.tid < 256 ? rb[(F.tid >> 3) * 16 + 8 + (F.tid & 7)] * LOG2E : NEGBIG; }
    __syncthreads();
#pragma nounroll
    for (int qq = 0; qq < (PROBE_DSA == 2 ? 4 : 2); ++qq) {
        const int n = 2 * F.wave + (qq & 1), tq = q0 + n, N = tq + 1;
        LAS unsigned char* scq = F.lds + DSA_SC + n * DSA_SCP;
        LAS unsigned short* lst = (LAS unsigned short*)(F.lds + DSA_LIST) + n * 256;
        LAS unsigned short* bki = (LAS unsigned short*)(F.lds + DSA_BKI) + n * 256;
        if (N <= KSEL) {
            for (int s = lane; s < KSEL; s += 64) lst[s] = (unsigned short)(s < N ? s : 0);
            if (lane == 0) ((LAS int*)(F.lds + DSA_NSEL))[n] = N;
        } else {
            const int nit = (N + 255) >> 8;
            { const int it = nit - 1; const int s0 = 4 * (lane + 64 * it); u32x2 w = *(LAS u32x2*)(scq + s0 * 2);
              if (s0 + 0 > tq) w.x &= 0xffff0000u; if (s0 + 1 > tq) w.x &= 0x0000ffffu; if (s0 + 2 > tq) w.y &= 0xffff0000u; if (s0 + 3 > tq) w.y &= 0x0000ffffu;
              *(LAS u32x2*)(scq + s0 * 2) = w; }
            LDS_WAIT();
            LAS unsigned* hist = (LAS unsigned*)(F.lds + DSA_HIST) + F.wave * 256;
            unsigned T = 0u; int cgt = 0; int need = KSEL;
#pragma nounroll
            for (int lvl = 0; lvl < 2; ++lvl) {
                *(LAS u32x4*)(hist + 4 * lane) = (u32x4){0u, 0u, 0u, 0u};
                LDS_WAIT();
#pragma nounroll
                for (int it = 0; it < nit; ++it) { const u32x2 w = *(LAS u32x2*)(scq + (lane + 64 * it) * 8);
                    const unsigned k[4] = {w.x & 0xffffu, w.x >> 16, w.y & 0xffffu, w.y >> 16};
#pragma unroll
                    for (int e = 0; e < 4; ++e) { const bool in = lvl == 0 ? true : (k[e] >> 8) == (T >> 8); const unsigned bin = lvl == 0 ? (k[e] >> 8) : (k[e] & 255u);
                        if (in) __hip_atomic_fetch_add(hist + bin, 1u, __ATOMIC_RELAXED, __HIP_MEMORY_SCOPE_WORKGROUP); } }
                LDS_WAIT();
                const u32x4 h = *(LAS u32x4*)(hist + 4 * lane);
                const int sl = (int)(h.x + h.y + h.z + h.w); int suf = sl;
#pragma unroll
                for (int d = 1; d < 64; d <<= 1) { const int o = __shfl_down(suf, d); suf += (lane + d < 64) ? o : 0; }
                const int above = suf - sl;
                const bool here = above < need && above + sl >= need;
                int bsel = 4 * lane + 3, ca = above;
                if (ca + (int)h.w < need) { ca += (int)h.w; bsel = 4 * lane + 2; if (ca + (int)h.z < need) { ca += (int)h.z; bsel = 4 * lane + 1; if (ca + (int)h.y < need) { ca += (int)h.y; bsel = 4 * lane; } } }
                const unsigned long long bm = __ballot(here);
                const int src = bm ? (int)__builtin_ctzll(bm) : 0;
                const int B = __shfl(bsel, src), CA = __shfl(ca, src);
                if (lvl == 0) T = (unsigned)B << 8; else T |= (unsigned)B;
                cgt += CA; need -= CA;
                LDS_WAIT();
            }
            const int rties = KSEL - cgt;
            int tiebase = 0, outbase = 0;
#define DSA_PUT(pos_, idx_) do { const int p_ = (pos_); if (p_ >= 0 && p_ < KSEL) lst[p_] = (unsigned short)(idx_); } while (0)
#pragma nounroll
            for (int it = 0; it < nit; ++it) { const u32x2 w = *(LAS u32x2*)(scq + (lane + 64 * it) * 8);
                const unsigned k0 = w.x & 0xffffu, k1 = w.x >> 16, k2 = w.y & 0xffffu, k3 = w.y >> 16;
                const int sidx = 4 * (lane + 64 * it);
                const bool g0 = k0 > T, g1 = k1 > T, g2 = k2 > T, g3 = k3 > T;
                const unsigned long long bg0 = __ballot(g0), bg1 = __ballot(g1), bg2 = __ballot(g2), bg3 = __ballot(g3);
                if (bg0 | bg1 | bg2 | bg3) {
                    int pos = outbase + prefix_cnt(bg0) + prefix_cnt(bg1) + prefix_cnt(bg2) + prefix_cnt(bg3);
                    if (g0) { DSA_PUT(pos, sidx + 0); ++pos; }
                    if (g1) { DSA_PUT(pos, sidx + 1); ++pos; }
                    if (g2) { DSA_PUT(pos, sidx + 2); ++pos; }
                    if (g3) { DSA_PUT(pos, sidx + 3); ++pos; }
                    outbase += __popcll(bg0) + __popcll(bg1) + __popcll(bg2) + __popcll(bg3); }
                const bool e0 = k0 == T, e1 = k1 == T, e2 = k2 == T, e3 = k3 == T;
                const unsigned long long be0 = __ballot(e0), be1 = __ballot(e1), be2 = __ballot(e2), be3 = __ballot(e3);
                if ((be0 | be1 | be2 | be3) && tiebase < rties) {
                    const int t0 = tiebase + prefix_cnt(be0) + prefix_cnt(be1) + prefix_cnt(be2) + prefix_cnt(be3), t1 = t0 + (e0 ? 1 : 0), t2 = t1 + (e1 ? 1 : 0), t3 = t2 + (e2 ? 1 : 0);
                    if (e0 && t0 < rties) DSA_PUT(KSEL - 1 - t0, sidx + 0);
                    if (e1 && t1 < rties) DSA_PUT(KSEL - 1 - t1, sidx + 1);
                    if (e2 && t2 < rties) DSA_PUT(KSEL - 1 - t2, sidx + 2);
                    if (e3 && t3 < rties) DSA_PUT(KSEL - 1 - t3, sidx + 3);
                    tiebase += __popcll(be0) + __popcll(be1) + __popcll(be2) + __popcll(be3); } }
#undef DSA_PUT
            outbase = KSEL;
            if (lane == 0) ((LAS int*)(F.lds + DSA_NSEL))[n] = outbase < KSEL ? outbase : KSEL;
        }
        LDS_WAIT();
        { const int nsl = N < KSEL ? N : KSEL;
#pragma unroll
          for (int i = 0; i < 4; ++i) { const int e = lane + 64 * i; const int dist = tq - (int)lst[e];
              const int dpos = dist < 1 ? 1 : dist; int bl = 16 + (int)((__log2f((float)dpos) - 4.0f) * 2.66666675f); bl = bl > 31 ? 31 : bl;
              const int bk = dist < 1 ? 0 : (dpos < 16 ? dpos : bl);
              bki[e] = (unsigned short)(e < nsl ? bk * 32 : 1024); } }
    }
    __syncthreads();
    const bf16* CK = (const bf16*)(ws + WS_CKVN) + (size_t)(b * SEQ) * 128;
    LAS unsigned char* gb0 = F.lds + F.wave * 16384;
    const LAS unsigned char* biasb = F.lds + DSA_BIAS + (l16 & 7) * 4;
#define DSA_GATHER(chunk_, buf_) do { const unsigned key_ = lst[(chunk_) * 32 + (lane >> 1)]; const char* src_ = (const char*)CK + (key_ * 256u + (unsigned)(lane & 1) * 16u); \
        _Pragma("unroll") for (int c_ = 0; c_ < 8; ++c_) __builtin_amdgcn_global_load_lds((const unsigned*)(src_ + c_ * 32), (LAS unsigned*)(gb0 + (buf_) * 8192 + c_ * 1024), 16, 0, 0); } while (0)
    int tqs[2], nsels[2]; const LAS unsigned short* lsts[2]; const LAS unsigned short* bkis[2]; bf16x8 ql[2][4]; f32x4 o[2][8]; float ms[2], ls[2];
#pragma unroll
    for (int qq = 0; qq < 2; ++qq) { const int n = 2 * F.wave + qq; tqs[qq] = q0 + n; nsels[qq] = ((const LAS int*)(F.lds + DSA_NSEL))[n]; lsts[qq] = (const LAS unsigned short*)(F.lds + DSA_LIST) + n * 256; bkis[qq] = (const LAS unsigned short*)(F.lds + DSA_BKI) + n * 256;
#pragma unroll
        for (int s2 = 0; s2 < 4; ++s2) { const bf16x8 v = *(const bf16x8*)(ZA + (size_t)(b * SEQ + tqs[qq]) * ZA_LD + ZC_QLAT + (l16 & 7) * 128 + 32 * s2 + 8 * quad); ql[qq][s2] = l16 < 8 ? v : (bf16x8){0, 0, 0, 0, 0, 0, 0, 0}; }
#pragma unroll
        for (int c = 0; c < 8; ++c) o[qq][c] = (f32x4){0.f, 0.f, 0.f, 0.f};
        ms[qq] = NEGBIG; ls[qq] = 0.f; }
#pragma unroll
    for (int qq = 0; qq < 2; ++qq)
#pragma unroll
        for (int s2 = 0; s2 < 4; ++s2) asm volatile("" : "+v"(ql[qq][s2]));
    const int nch1 = (nsels[1] + 31) >> 5, nch = PROBE_DSA == 3 ? 2 * nch1 : nch1;
    LDS_WAIT();
    { const LAS unsigned short* lst = lsts[0]; DSA_GATHER(0, 0); }
    { const LAS unsigned short* lst = lsts[1]; DSA_GATHER(0, 1); }
    const unsigned offA = (unsigned)((quad >> 1) * 1024 + l16 * 32 + (quad & 1) * 16);
    const unsigned offT = (unsigned)((4 * quad + (l16 >> 2)) * 32 + 8 * (lane & 3));
#pragma nounroll
    for (int ch = 0; ch < nch; ++ch) {
#pragma unroll
        for (int qq = 0; qq < 2; ++qq) {
            const int chd = ch >= nch1 ? ch - nch1 : ch;
            const LAS unsigned short* lst = lsts[qq];
            const LAS unsigned char* gb = gb0 + qq * 8192;
            if (qq == 0 || ch + 1 < nch) asm volatile("s_waitcnt vmcnt(8)" ::: "memory"); else asm volatile("s_waitcnt vmcnt(0)" ::: "memory");
            f32x4 acc2[2]; float bvs[2][4];
#pragma unroll
            for (int rb = 0; rb < 2; ++rb) { f32x4 acc = {0.f, 0.f, 0.f, 0.f};
#pragma unroll
                for (int s2 = 0; s2 < 4; ++s2) { const bf16x8 af = *(const LAS bf16x8*)(gb + offA + rb * 512 + s2 * 2048); acc = MFMA16(af, ql[qq][s2], acc); }
                acc2[rb] = acc;
                const u32x2 kb = *(const LAS u32x2*)((const LAS unsigned char*)bkis[qq] + (chd * 32 + rb * 16 + 4 * quad) * 2);
                bvs[rb][0] = *(const LAS float*)(biasb + (kb.x & 0xffffu)); bvs[rb][1] = *(const LAS float*)(biasb + (kb.x >> 16));
                bvs[rb][2] = *(const LAS float*)(biasb + (kb.y & 0xffffu)); bvs[rb][3] = *(const LAS float*)(biasb + (kb.y >> 16)); }
#pragma unroll
            for (int rb = 0; rb < 2; ++rb)
#pragma unroll
                for (int r = 0; r < 4; ++r) asm volatile("" : "+v"(bvs[rb][r]));
            float x[2][4]; float tmax = NEGBIG;
#pragma unroll
            for (int rb = 0; rb < 2; ++rb)
#pragma unroll
                for (int r = 0; r < 4; ++r) { const float xv = acc2[rb][r] * C2 + bvs[rb][r]; x[rb][r] = xv; tmax = fmaxf(tmax, xv); }
            tmax = fmaxf(tmax, __shfl_xor(tmax, 16)); tmax = fmaxf(tmax, __shfl_xor(tmax, 32));
            const float mn = fmaxf(ms[qq], tmax); const bool resc = __any(mn != ms[qq]); const float alpha = __builtin_amdgcn_exp2f(ms[qq] - mn); ms[qq] = mn;
            float ps = 0.f;
#pragma unroll
            for (int rb = 0; rb < 2; ++rb)
#pragma unroll
                for (int r = 0; r < 4; ++r) { const float pv = __builtin_amdgcn_exp2f(x[rb][r] - mn); x[rb][r] = pv; ps += pv; }
            ls[qq] = ls[qq] * alpha + ps;
            if (resc) {
#pragma unroll
                for (int c = 0; c < 8; ++c) o[qq][c] = o[qq][c] * alpha; }
            u32x4 pw; pw.x = pk2(x[0][0], x[0][1]); pw.y = pk2(x[0][2], x[0][3]); pw.z = pk2(x[1][0], x[1][1]); pw.w = pk2(x[1][2], x[1][3]);
            const unsigned gba = (unsigned)(unsigned long long)gb + offT;
#pragma unroll
            for (int cb = 0; cb < 2; ++cb) {
                s16x4 v[8];
                if (cb == 0) asm volatile("ds_read_b64_tr_b16 %0, %8\n\tds_read_b64_tr_b16 %1, %8 offset:512\n\tds_read_b64_tr_b16 %2, %8 offset:1024\n\tds_read_b64_tr_b16 %3, %8 offset:1536\n\t"
                             "ds_read_b64_tr_b16 %4, %8 offset:2048\n\tds_read_b64_tr_b16 %5, %8 offset:2560\n\tds_read_b64_tr_b16 %6, %8 offset:3072\n\tds_read_b64_tr_b16 %7, %8 offset:3584\n\ts_waitcnt lgkmcnt(0)"
                             : "=&v"(v[0]), "=&v"(v[1]), "=&v"(v[2]), "=&v"(v[3]), "=&v"(v[4]), "=&v"(v[5]), "=&v"(v[6]), "=&v"(v[7]) : "v"(gba) : "memory");
                else asm volatile("ds_read_b64_tr_b16 %0, %8 offset:4096\n\tds_read_b64_tr_b16 %1, %8 offset:4608\n\tds_read_b64_tr_b16 %2, %8 offset:5120\n\tds_read_b64_tr_b16 %3, %8 offset:5632\n\t"
                             "ds_read_b64_tr_b16 %4, %8 offset:6144\n\tds_read_b64_tr_b16 %5, %8 offset:6656\n\tds_read_b64_tr_b16 %6, %8 offset:7168\n\tds_read_b64_tr_b16 %7, %8 offset:7680\n\ts_waitcnt lgkmcnt(0)"
                             : "=&v"(v[0]), "=&v"(v[1]), "=&v"(v[2]), "=&v"(v[3]), "=&v"(v[4]), "=&v"(v[5]), "=&v"(v[6]), "=&v"(v[7]) : "v"(gba) : "memory");
#pragma unroll
                for (int c4 = 0; c4 < 4; ++c4) { const int c = 4 * cb + c4; const s16x4 v0 = v[2 * c4], v1 = v[2 * c4 + 1];
                    const bf16x8 vf = {v0[0], v0[1], v0[2], v0[3], v1[0], v1[1], v1[2], v1[3]};
                    o[qq][c] = MFMA16(vf, __builtin_bit_cast(bf16x8, pw), o[qq][c]); }
            }
            LDS_WAIT();
            if (ch + 1 < nch) DSA_GATHER((ch + 1 >= nch1 ? ch + 1 - nch1 : ch + 1), qq);
        }
    }
#pragma unroll
    for (int qq = 0; qq < 2; ++qq) {
        float l = ls[qq]; const int tq = tqs[qq];
        l += __shfl_xor(l, 16); l += __shfl_xor(l, 32);
        const float inv = l > 0.f ? 1.0f / l : 0.f;
        if (l16 < 8) { bf16* op = (bf16*)(ws + WS_OLAT) + (size_t)(b * SEQ + tq) * 1024 + l16 * 128 + 4 * quad;
#pragma unroll
            for (int c = 0; c < 8; ++c) { u32x2 w; w.x = pk2(o[qq][c][0] * inv, o[qq][c][1] * inv); w.y = pk2(o[qq][c][2] * inv, o[qq][c][3] * inv); *(u32x2*)(op + 16 * c) = w; } }
    }
}
#undef DSA_GATHER
__device__ __forceinline__ void phase4(const Frame& F, const Args& a) {
    const bool xcd = (F.G == 256);
    const int pstart = xcd ? (F.bx >> 3) : F.bx, pstep = xcd ? 32 : F.G, pend = xcd ? 128 : 1024;
#pragma nounroll
    for (int p2 = 2 * pstart; p2 < 2 * pend; p2 += (p2 & 1) ? 2 * pstep - 1 : 1) { const int p = p2 >> 1;
        const int b = xcd ? (F.bx & 7) : (p >> 7), j = p & 127;
        dsa_unit(F, a, b, (p2 & 1) ? j : 255 - j); }
    __syncthreads();
}

constexpr int NPHASE = 11;
__global__ void __launch_bounds__(NTHR, 2) fwd_kernel(Args args) {
    extern __shared__ __attribute__((aligned(16))) unsigned char lds_raw[];
    Frame F;
    F.lds = (LAS unsigned char*)lds_raw;
    F.tid = threadIdx.x; F.lane = F.tid & 63; F.wave = __builtin_amdgcn_readfirstlane(F.tid >> 6);
    F.G = gridDim.x; F.bx = blockIdx.x; F.ws = args.ws;
    unsigned char* ws = args.ws;
    volatile LAS unsigned* MISC = (volatile LAS unsigned*)(F.lds + MISC_OFF);
    if (F.tid < 64) MISC[F.tid] = 0u;
    __syncthreads();
    const int lo = args.ph_lo, hi = args.ph_hi;
    XcdBarrier bar; bar.bar = (unsigned*)(ws + WS_CTL) + CW_BAR; bar.x = 0; bar.st = nullptr;
    if (hi - lo > 1) bar = xcd_barrier_post((unsigned*)(ws + WS_CTL) + CW_BAR, MISC + 8);
#ifndef PH_MASK
#define PH_MASK 0xFFFF
#endif
#define IN(k) ((((PH_MASK) >> (k)) & 1) && lo <= (k) && (k) < hi)
#define SEAM(k) do { if (IN(k) && IN((k) + 1)) xcd_barrier(bar); } while (0)
#ifndef PROBE_PHASE
#define PROBE_PHASE -1
#endif
#define REPEAT(k) for (int rep_ = 0; rep_ < ((PROBE_PHASE) == (k) ? 2 : 1); ++rep_, ((PROBE_PHASE) == (k) && rep_ < 2 ? xcd_barrier(bar) : (void)0))

    if (IN(0)) REPEAT(0) { phase0(F, args); }
    SEAM(0);
    if (IN(1)) REPEAT(1) {
        pg8::StaticOrder S; S.init(NTOK / 256, NZ / 256, F.G, F.bx);
        const APlain AA{ws + WS_XB, 128u, (unsigned)(D * 2)}; const BPlain BA{(const bf16*)(ws + WS_WINT), D};
        const EpiZ E{(bf16*)(ws + WS_ZA), (bf16*)(ws + WS_ZG)};
        pg8::gemm_phase(F.lds, D, S, AA, BA, E);
    }
    SEAM(1);
    if (IN(2)) REPEAT(2) { phase2(F, args); }
    SEAM(2);
    if (IN(3)) REPEAT(3) { phase3(F); }
    if (IN(4)) REPEAT(4) { phase4(F, args); }
    SEAM(4);
    if (IN(5)) REPEAT(5) {
        pg8::StaticOrder S; S.init(NTOK / 256, D / 256, F.G, F.bx);
        { const APlain AA{ws + WS_OA, 128u, 1024u}; const BPlain BA{(const bf16*)(ws + WS_WAT), 512};
          const EpiGate<0> E{(const bf16*)(ws + WS_ZG), nullptr, (bf16*)(ws + WS_T1)};
          pg8::gemm_phase(F.lds, 512, S, AA, BA, E); }
        { const APlain AA{ws + WS_OLAT, 128u, 2048u}; const BPlain BA{(const bf16*)(ws + WS_WBT), 1024};
          const EpiGate<1> E{(const bf16*)(ws + WS_ZG), (const bf16*)(ws + WS_T1), (bf16*)(ws + WS_MERGED)};
          pg8::gemm_phase(F.lds, 1024, S, AA, BA, E); }
    }
    SEAM(5);
    if (IN(6)) REPEAT(6) {
        pg8::StaticOrder S; S.init(NTOK / 256, D / 256, F.G, F.bx);
        const APlain AA{ws + WS_MERGED, 128u, 2048u}; const BPlain BA{(const bf16*)(ws + WS_WOT), 1024};
        const EpiRes E{args.in[0], (bf16*)(ws + WS_H1)};
        pg8::gemm_phase(F.lds, 1024, S, AA, BA, E);
    }
    SEAM(6);
    if (IN(7)) { phase6(F, args); }
    SEAM(7);
    if (IN(8)) REPEAT(8) {
        moe_setup(F);
        const MoeOrder S{F.G, F.bx, 2, (const LAS int*)(F.lds + MOE_CUM), (const LAS int*)(F.lds + MOE_CUM) + 40};
        const AGather AA{ws + WS_H1B, 128u, (const int*)(ws + WS_LIST)}; const BGu BA{(const bf16*)(ws + WS_WGU)};
        const EpiAct E{(bf16*)(ws + WS_ACT)};
        pg8::gemm_phase(F.lds, 1024, S, AA, BA, E);
    }
    SEAM(8);
    if (IN(9)) REPEAT(9) {
        moe_setup(F);
        const MoeOrder S{F.G, F.bx, 4, (const LAS int*)(F.lds + MOE_CUM), (const LAS int*)(F.lds + MOE_CUM) + 40};
        const APlain AA{ws + WS_ACT, 128u, 512u}; const BDn BA{(const bf16*)(ws + WS_WDT)};
        const EpiDown E{(bf16*)(ws + WS_YBUF), (const int*)(ws + WS_LIST)};
        pg8::gemm_phase(F.lds, 256, S, AA, BA, E);
    }
    SEAM(9);
    if (IN(10)) REPEAT(10) { phase9(F, args); }
#undef IN
#undef SEAM
#undef REPEAT
}

extern "C" void kernel_launch(void* const* d_in, const int* in_sizes, int n_in, void* d_out, int out_size, void* d_ws, size_t ws_size, hipStream_t stream) {
    static int grid = 0;
    if (grid == 0) {
        if (n_in != 26 || in_sizes[0] != NTOK * D || out_size != NTOK * D || ws_size < WS_END) {
            fprintf(stderr, "kernel_launch: unexpected problem: n_in %d in0 %d out %d ws %zu (need %zu)\n", n_in, n_in > 0 ? in_sizes[0] : -1, out_size, ws_size, (size_t)WS_END); grid = -1; return; }
        int dev = 0, cus = 0, per_cu = 0;
        if (hipGetDevice(&dev) != hipSuccess || hipDeviceGetAttribute(&cus, hipDeviceAttributeMultiprocessorCount, dev) != hipSuccess) { grid = -1; return; }
        if (hipFuncSetAttribute((const void*)fwd_kernel, hipFuncAttributeMaxDynamicSharedMemorySize, LDS_BYTES) != hipSuccess) { fprintf(stderr, "kernel_launch: hipFuncSetAttribute failed\n"); grid = -1; return; }
        if (hipOccupancyMaxActiveBlocksPerMultiprocessor(&per_cu, (const void*)fwd_kernel, NTHR, LDS_BYTES) != hipSuccess || per_cu < 1)
            fprintf(stderr, "kernel_launch: occupancy query reports %d\n", per_cu);
        (void)hipGetLastError();
        grid = cus;
    }
    if (grid < 0) return;
    if (hipMemsetAsync((char*)d_ws + WS_CTL, 0, CTL_ZERO_BYTES, stream) != hipSuccess) return;
    Args a{};
    for (int i = 0; i < 26; ++i) a.in[i] = (const float*)d_in[i];
    a.out = (float*)d_out; a.ws = (unsigned char*)d_ws;
#if MK_PER_PHASE
    for (int p = 0; p < NPHASE; ++p) { a.ph_lo = p; a.ph_hi = p + 1; hipLaunchKernelGGL(fwd_kernel, dim3(grid), dim3(NTHR), LDS_BYTES, stream, a); }
#else
    a.ph_lo = 0; a.ph_hi = NPHASE;
    hipLaunchKernelGGL(fwd_kernel, dim3(grid), dim3(NTHR), LDS_BYTES, stream, a);
#endif
}
```

```cpp
#include <hip/hip_runtime.h>
#include <cstdio>
#include <cstdint>

#ifndef MK_PER_PHASE
#define MK_PER_PHASE 0
#endif

#define GAS __attribute__((address_space(1)))
#define LAS __attribute__((address_space(3)))
typedef unsigned short bf16;
typedef short bf16x8 __attribute__((ext_vector_type(8)));
typedef short s16x4 __attribute__((ext_vector_type(4)));
typedef float f32x4 __attribute__((ext_vector_type(4)));
typedef float f32x16 __attribute__((ext_vector_type(16)));
typedef float f32x2 __attribute__((ext_vector_type(2)));
typedef unsigned u32x4 __attribute__((ext_vector_type(4)));
typedef unsigned u32x2 __attribute__((ext_vector_type(2)));

constexpr int D = 1024, BATCH = 8, SEQ = 4096, NTOK = BATCH * SEQ;
constexpr int D_IN = 4316;
constexpr int NCMP = 255;
constexpr float ALPHA = 1.189207115002721f;
constexpr float LOG2E = 1.4426950408889634f;
constexpr float NEGBIG = -1e30f;
constexpr int ZA_LD = 2816;
constexpr int ZC_QA = 0, ZC_KC = 512, ZC_VC = 640, ZC_KS = 768, ZC_VS = 896, ZC_KW = 1024, ZC_VW = 1152, ZC_QLAT = 1280, ZC_CKV = 2304,
              ZC_QIDX = 2432, ZC_KIDX = 2688, ZC_GNSA = 2752, ZC_WIDX = 2776;
constexpr int ZG_LD = 2048;
constexpr int NZ = ZA_LD + ZG_LD;
constexpr int NEXP = 32, DEXP = 256;
constexpr int MAXTILES = (2 * NTOK) / 256 + NEXP;

constexpr size_t MiB = 1u << 20;
constexpr size_t WS_CTL = 0, CTL_ZERO_BYTES = 1 * MiB;
constexpr size_t WS_WAT = 1 * MiB;
constexpr size_t WS_WBT = 2 * MiB;
constexpr size_t WS_WOT = 4 * MiB;
constexpr size_t WS_W1K = 6 * MiB;
constexpr size_t WS_W1V = 7 * MiB;
constexpr size_t WS_W2K = 8 * MiB;
constexpr size_t WS_W2V = 8 * MiB + 64 * 1024;
constexpr size_t WS_BIASK = 8 * MiB + 128 * 1024;
constexpr size_t WS_TBA = 8 * MiB + 256 * 1024;
constexpr size_t WS_TBB = 8 * MiB + 320 * 1024;
constexpr size_t WS_KCMP = 9 * MiB;
constexpr size_t WS_VCMP = 9 * MiB + 512 * 1024;
constexpr size_t WS_TOKINFO = 10 * MiB;
constexpr size_t WS_LIST = 11 * MiB;
constexpr size_t WS_WINT = 16 * MiB;
constexpr size_t WS_WGU = 32 * MiB;
constexpr size_t WS_WDT = 64 * MiB;
constexpr size_t WS_CKVN = 80 * MiB;
constexpr size_t WS_XB = 96 * MiB;
constexpr size_t WS_OLAT = 96 * MiB;
constexpr size_t WS_H1B = 96 * MiB;
constexpr size_t WS_ZA = 160 * MiB;
constexpr size_t WS_T1 = 160 * MiB;
constexpr size_t WS_ACT = 160 * MiB;
constexpr size_t WS_YBUF = 196 * MiB;
constexpr size_t WS_MERGED = 224 * MiB;
constexpr size_t WS_ZG = 336 * MiB;
constexpr size_t WS_H1 = 336 * MiB;
constexpr size_t WS_OA = 464 * MiB;
constexpr size_t WS_END = 496 * MiB;

constexpr int CW_BAR = 4096;
constexpr int CW_CNT = 16384;

constexpr int LDS_BYTES = 163840;
constexpr int MISC_OFF = 160 * 1024 - 256;

__device__ __forceinline__ unsigned f2bf(float f) { unsigned u = __builtin_bit_cast(unsigned, f); return (u + 0x7fffu + ((u >> 16) & 1u)) >> 16; }
__device__ __forceinline__ unsigned pk2(float lo, float hi) { unsigned r; asm volatile("v_cvt_pk_bf16_f32 %0, %1, %2" : "=v"(r) : "v"(lo), "v"(hi)); return r; }
__device__ __forceinline__ float bf2f(unsigned short b) { return __builtin_bit_cast(float, ((unsigned)b) << 16); }
__device__ __forceinline__ float bflo(unsigned w) { return __builtin_bit_cast(float, w << 16); }
__device__ __forceinline__ float bfhi(unsigned w) { return __builtin_bit_cast(float, w & 0xffff0000u); }
__device__ __forceinline__ float wave_sum(float v) {
#pragma unroll
    for (int o = 1; o < 64; o <<= 1) v += __shfl_xor(v, o);
    return v;
}
__device__ __forceinline__ float sigmoidf_(float x) { return 1.0f / (1.0f + __expf(-x)); }
#define LDS_WAIT() asm volatile("s_waitcnt lgkmcnt(0)" ::: "memory")
#define VM_WAIT() asm volatile("s_waitcnt vmcnt(0)" ::: "memory")

#define XB_TMO      128
#define XB_XCNT(j)  (256  + 64 * (j))
#define XB_XSUB(j)  (1280 + 64 * (j))
#define XB_XGEN(j)  (2304 + 64 * (j))
#define XB_TOP      3328
#define XB_TOPGEN   3392
#define XCD_BAR_WORDS 3456
#define XB_SPIN_CAP (1u << 18)
__device__ __forceinline__ unsigned xb_ld(unsigned* p)              { return __hip_atomic_load(p, __ATOMIC_RELAXED, __HIP_MEMORY_SCOPE_AGENT); }
__device__ __forceinline__ unsigned xb_add(unsigned* p, unsigned v) { return __hip_atomic_fetch_add(p, v, __ATOMIC_RELAXED, __HIP_MEMORY_SCOPE_AGENT); }
__device__ __forceinline__ unsigned xb_xcc_id() { return (unsigned)__builtin_amdgcn_s_getreg((3 << 11) | 20) & 0xFu; }
#define XB_SPIN(cond, bar) do { unsigned _sp = 0; while (cond) { __builtin_amdgcn_s_sleep(1); \
    if ((++_sp & 255u) == 0u) { if (xb_ld(&(bar)[XB_TMO])) break; if (_sp > XB_SPIN_CAP) { atomicAdd(&(bar)[XB_TMO], 1u); break; } } } } while (0)
struct XcdBarrier { unsigned* bar; unsigned x; volatile LAS unsigned* st; };
__device__ __forceinline__ XcdBarrier xcd_barrier_post(unsigned* bar, volatile LAS unsigned* st) {
    XcdBarrier b; b.bar = bar; b.x = xb_xcc_id(); b.st = st;
    if (threadIdx.x == 0) (void)xb_add(&bar[XB_XCNT(b.x)], 1u);
    return b;
}
__device__ __forceinline__ void xcd_barrier_complete(unsigned* bar, unsigned x, unsigned& nloc, unsigned& nx) {
    const unsigned G = gridDim.x * gridDim.y * gridDim.z;
    unsigned sum, cnt, mine, sp = 0u;
    for (;;) {
        sum = 0u; cnt = 0u; mine = 0u;
#pragma unroll
        for (unsigned j = 0; j < 16; ++j) { const unsigned c = xb_ld(&bar[XB_XCNT(j)]); sum += c; cnt += (c > 0u) ? 1u : 0u; mine = (j == x) ? c : mine; }
        if (sum == G) break;
        __builtin_amdgcn_s_sleep(1);
        if ((++sp & 255u) == 0u) { if (xb_ld(&bar[XB_TMO])) break; if (sp > XB_SPIN_CAP) { atomicAdd(&bar[XB_TMO], 1u); break; } }
    }
    nloc = mine > 0u ? mine : 1u; nx = cnt > 0u ? cnt : 1u;
}
__device__ __forceinline__ void xcd_barrier(const XcdBarrier& b) {
    asm volatile("s_waitcnt vmcnt(0)" ::: "memory");
    __syncthreads();
    if (threadIdx.x == 0) {
        unsigned* bar = b.bar;
        __builtin_amdgcn_s_waitcnt(0);
        unsigned nloc = b.st[0], nx = b.st[1];
        if (nloc == 0u) { xcd_barrier_complete(bar, b.x, nloc, nx); b.st[0] = nloc; b.st[1] = nx; }
        const unsigned old = xb_add(&bar[XB_XSUB(b.x)], 1u);
        const unsigned gen = old / nloc;
        if (old + 1u == (gen + 1u) * nloc) {
            __builtin_amdgcn_fence(__ATOMIC_RELEASE, "agent");
            asm volatile("s_waitcnt vmcnt(0)" ::: "memory");
            const unsigned og = xb_add(&bar[XB_TOP], 1u);
            const unsigned tg = og / nx;
            if (og + 1u == (tg + 1u) * nx) xb_add(&bar[XB_TOPGEN], 1u);
            else XB_SPIN(xb_ld(&bar[XB_TOPGEN]) == tg, bar);
            __builtin_amdgcn_fence(__ATOMIC_ACQUIRE, "agent");
            xb_add(&bar[XB_XGEN(b.x)], 1u);
            asm volatile("s_waitcnt vmcnt(0)" ::: "memory");
        } else {
            XB_SPIN(xb_ld(&bar[XB_XGEN(b.x)]) == gen, bar);
            __builtin_amdgcn_fence(__ATOMIC_ACQUIRE, "agent");
            asm volatile("s_waitcnt vmcnt(0)" ::: "memory");
        }
    }
    __syncthreads();
}

namespace pg8 {
constexpr int BM = 256, BK = 64, HALF = 128, HTB = HALF * BK * 2, STAGE_BYTES = 8 * HTB, NXCD = 8, WGM = 8;
__host__ __device__ __forceinline__ int lds_byte(int r, int c) { const int st = (r >> 4) * 2 + (c >> 5), rr = r & 15, cc = c & 31, ob = rr * 64 + cc * 2; return st * 1024 + (ob ^ (((ob >> 9) & 1) << 5)); }
__host__ __device__ __forceinline__ void stage_rc(int b, int& R, int& C) { const int st = b / 1024, sb = b % 1024, swz = sb ^ (((sb >> 9) & 1) << 5); R = (st >> 1) * 16 + swz / 64; C = (st & 1) * 32 + (swz % 64) / 2; }
__host__ __device__ __forceinline__ int perm32(int rho) { const int n = rho >> 4, i = rho & 15; return 8 * (i >> 2) + 4 * n + (i & 3); }
struct Unit { int pm, pn, e, nrows; };
struct StaticOrder {
    int nM, nN, nwg, G, c;
    __device__ void init(int nM_, int nN_, int G_, int c_) { nM = nM_; nN = nN_; nwg = nM * nN; G = G_; c = c_; }
    __device__ bool next(int i, Unit& u) const {
        const long L = (long)i * G + c; if (L >= nwg) return false;
        int wgid = (int)L; { const int q = nwg / NXCD, r = nwg % NXCD, xcd = wgid % NXCD, off = wgid / NXCD; wgid = (xcd < r ? xcd * (q + 1) : r * (q + 1) + (xcd - r) * q) + off; }
        const int nig = WGM * nN, gid = wgid / nig, fm = gid * WGM, gsz = (nM - fm) < WGM ? (nM - fm) : WGM;
        u.pm = fm + ((wgid % nig) % gsz); u.pn = (wgid % nig) / gsz; u.e = 0; u.nrows = 256; return true;
    }
};

template <class Epi, class Sched, class AAddr, class BAddr>
__device__ __forceinline__ void gemm_phase(LAS unsigned char* lds, const int K, const Sched& S, const AAddr& AA, const BAddr& BA, const Epi& E) {
    constexpr bool GA = AAddr::GATHER;
    const int tid = threadIdx.x, wid = __builtin_amdgcn_readfirstlane(tid >> 6), lane = tid & 63, wr = wid >> 2, wc = wid & 3, fr = lane & 15, fq = lane >> 4;
    const int nt = K / BK;
    unsigned voffA[2], voffB[2];
#pragma unroll
    for (int i = 0; i < 2; ++i) { int R, C; stage_rc(tid * 16 + i * 8192, R, C); const int Rb = Epi::PERM ? ((R & ~31) + perm32(R & 31)) : R;
        voffA[i] = GA ? 0u : AA.lane_off(R, C); voffB[i] = (unsigned)(Rb * K + C) * 2u; }
    const size_t kstepA = (size_t)AA.kstep, kstepB = (size_t)(BK * 2);
    const size_t hstepB = (size_t)HALF * K * 2, hstepA = GA ? 0 : AA.hstep();
    const unsigned ldsw = (unsigned)wid * 1024u;
    const int aoff = lds_byte(wr * 64 + fr, fq * 8), boff = lds_byte(wc * 32 + fr, fq * 8);
#define PG8_SA(b, h) (((b) * 2 + (h)) * HTB)
#define PG8_SB(b, h) ((4 + (b) * 2 + (h)) * HTB)
#define PG8_STAGE(bufoff, gbase, voff) do { _Pragma("unroll") for (int _i = 0; _i < 2; ++_i) \
        __builtin_amdgcn_global_load_lds((const unsigned*)((const char*)(gbase) + (voff)[_i]), (LAS unsigned*)(lds + (bufoff) + ldsw + _i * 8192), 16, 0, 0); } while (0)
#define PG8_STA_CUR(bufoff, h, kb) do { if constexpr (GA) { if (h) PG8_STAGE(bufoff, baseA + (kb), cof1); else PG8_STAGE(bufoff, baseA + (kb), cof0); } \
        else PG8_STAGE(bufoff, cA + (h) * hstepA + (kb), voffA); } while (0)
#define PG8_STA_SEL(bufoff, h, kb) do { if constexpr (GA) { if (h) PG8_STAGE(bufoff, baseA + (kb), sof1); else PG8_STAGE(bufoff, baseA + (kb), sof0); } \
        else PG8_STAGE(bufoff, sA + (h) * hstepA + (kb), voffA); } while (0)
#define PG8_LDA(dst, b, h) do { _Pragma("unroll") for (int m = 0; m < 4; ++m) _Pragma("unroll") for (int k = 0; k < 2; ++k) dst[m][k] = *(const LAS bf16x8*)(lds + PG8_SA(b, h) + aoff + m * 2048 + k * 1024); } while (0)
#define PG8_LDB(dst, b, h) do { _Pragma("unroll") for (int n = 0; n < 2; ++n) _Pragma("unroll") for (int k = 0; k < 2; ++k) dst[n][k] = *(const LAS bf16x8*)(lds + PG8_SB(b, h) + boff + n * 2048 + k * 1024); } while (0)
#define PG8_MMA(ai, bj, At, Bt) do { __builtin_amdgcn_s_setprio(1); _Pragma("unroll") for (int m = 0; m < 4; ++m) _Pragma("unroll") for (int n = 0; n < 2; ++n) _Pragma("unroll") for (int k = 0; k < 2; ++k) \
        acc[ai][bj][m][n] = __builtin_amdgcn_mfma_f32_16x16x32_bf16(Bt[n][k], At[m][k], acc[ai][bj][m][n], 0, 0, 0); __builtin_amdgcn_s_setprio(0); } while (0)
#define PG8_WAIT_V(n) asm volatile("s_waitcnt vmcnt(" #n ")" ::: "memory")
#define PG8_WAIT_L(n) asm volatile("s_waitcnt lgkmcnt(" #n ")" ::: "memory")
#define PG8_BAR __builtin_amdgcn_s_barrier()
#define PG8_SCHED __builtin_amdgcn_sched_barrier(0)
#define PG8_GOFF(u, o0, o1) do { _Pragma("unroll") for (int _i = 0; _i < 2; ++_i) { int R_, C_; stage_rc(tid * 16 + _i * 8192, R_, C_); \
        o0[_i] = AA.row_off(u, R_) + (unsigned)C_ * 2u; o1[_i] = AA.row_off(u, R_ + HALF) + (unsigned)C_ * 2u; } } while (0)
    Unit cur, nxt; int ui = 0;
    if (!S.next(0, cur)) return;
    f32x4 acc[2][2][4][2];
#pragma unroll
    for (int a = 0; a < 2; ++a)
#pragma unroll
        for (int b = 0; b < 2; ++b)
#pragma unroll
            for (int m = 0; m < 4; ++m)
#pragma unroll
                for (int n = 0; n < 2; ++n) acc[a][b][m][n] = (f32x4){0.f, 0.f, 0.f, 0.f};
    bf16x8 At[4][2], B0[2][2], B1[2][2];
    const char* const baseA = GA ? (const char*)AA.base : nullptr;
    const char* cA = GA ? nullptr : (const char*)AA.unit_ptr(cur);
    unsigned cof0[2] = {0u, 0u}, cof1[2] = {0u, 0u}, nof0[2] = {0u, 0u}, nof1[2] = {0u, 0u};
    if constexpr (GA) PG8_GOFF(cur, cof0, cof1);
    const char* cB = (const char*)BA.ptr(cur);
    PG8_STAGE(PG8_SB(0, 0), cB, voffB); PG8_STA_CUR(PG8_SA(0, 0), 0, 0); PG8_STAGE(PG8_SB(0, 1), cB + hstepB, voffB); PG8_STA_CUR(PG8_SA(0, 1), 1, 0);
    if (wr == 1) PG8_BAR;
    PG8_WAIT_V(4); PG8_BAR;
    PG8_STAGE(PG8_SB(1, 0), cB + kstepB, voffB); PG8_STA_CUR(PG8_SA(1, 0), 0, kstepA); PG8_STAGE(PG8_SB(1, 1), cB + hstepB + kstepB, voffB);
    PG8_WAIT_V(6); PG8_BAR;
    for (;;) {
        const bool has_next = S.next(ui + 1, nxt);
        const char* nB = cB; const char* nA = cA;
        if (has_next) { nB = (const char*)BA.ptr(nxt); if constexpr (GA) PG8_GOFF(nxt, nof0, nof1); else nA = (const char*)AA.unit_ptr(nxt); }
        else { if constexpr (GA) {
#pragma unroll
            for (int i = 0; i < 2; ++i) { nof0[i] = cof0[i]; nof1[i] = cof1[i]; } } }
#pragma nounroll
        for (int t = 0; t < nt; t += 2) {
            const bool last = (t == nt - 2);
            const size_t k1 = (size_t)(t + 1) * kstepA, k2 = last ? 0 : (size_t)(t + 2) * kstepA, k3 = k2 + kstepA;
            const char* b2 = last ? nB : cB + (size_t)(t + 2) * kstepB; const char* b3 = b2 + kstepB;
            const char* sA = last ? nA : cA;
            unsigned sof0[2], sof1[2];
#pragma unroll
            for (int i = 0; i < 2; ++i) { sof0[i] = last ? nof0[i] : cof0[i]; sof1[i] = last ? nof1[i] : cof1[i]; }
            PG8_LDB(B0, 0, 0); PG8_SCHED; PG8_LDA(At, 0, 0); PG8_STA_CUR(PG8_SA(1, 1), 1, k1);
            PG8_WAIT_L(8); PG8_BAR; PG8_WAIT_L(0); PG8_MMA(0, 0, At, B0); PG8_BAR; PG8_SCHED;
            PG8_LDB(B1, 0, 1); PG8_STAGE(PG8_SB(0, 0), b2, voffB);
            PG8_BAR; PG8_WAIT_L(0); PG8_MMA(0, 1, At, B1); PG8_BAR;
            PG8_LDA(At, 0, 1); PG8_STA_SEL(PG8_SA(0, 0), 0, k2);
            PG8_BAR; PG8_WAIT_L(0); PG8_MMA(1, 0, At, B0); PG8_BAR; PG8_SCHED;
            PG8_STAGE(PG8_SB(0, 1), b2 + hstepB, voffB);
            PG8_WAIT_V(6); PG8_BAR; PG8_MMA(1, 1, At, B1); PG8_BAR;
            PG8_LDB(B0, 1, 0); PG8_SCHED; PG8_LDA(At, 1, 0); PG8_STA_SEL(PG8_SA(0, 1), 1, k2);
            PG8_WAIT_L(8); PG8_BAR; PG8_WAIT_L(0); PG8_MMA(0, 0, At, B0); PG8_BAR; PG8_SCHED;
            PG8_LDB(B1, 1, 1); PG8_STAGE(PG8_SB(1, 0), b3, voffB);
            PG8_BAR; PG8_WAIT_L(0); PG8_MMA(0, 1, At, B1); PG8_BAR;
            PG8_LDA(At, 1, 1); PG8_STA_SEL(PG8_SA(1, 0), 0, k3);
            PG8_BAR; PG8_WAIT_L(0); PG8_MMA(1, 0, At, B0); PG8_BAR; PG8_SCHED;
            PG8_STAGE(PG8_SB(1, 1), b3 + hstepB, voffB);
            PG8_WAIT_V(6); PG8_BAR; PG8_MMA(1, 1, At, B1); PG8_BAR;
        }
        E(acc, cur, wr, wc, fr, fq);
        if (!has_next) break;
#pragma unroll
        for (int a = 0; a < 2; ++a)
#pragma unroll
            for (int b = 0; b < 2; ++b)
#pragma unroll
                for (int m = 0; m < 4; ++m)
#pragma unroll
                    for (int n = 0; n < 2; ++n) acc[a][b][m][n] = (f32x4){0.f, 0.f, 0.f, 0.f};
        cur = nxt; cB = nB; cA = nA; ++ui;
        if constexpr (GA) {
#pragma unroll
            for (int i = 0; i < 2; ++i) { cof0[i] = nof0[i]; cof1[i] = nof1[i]; } }
    }
    PG8_WAIT_V(0);
    if (wr == 0) PG8_BAR;
    PG8_BAR;
#undef PG8_SA
#undef PG8_SB
#undef PG8_STAGE
#undef PG8_STA_CUR
#undef PG8_STA_SEL
#undef PG8_GOFF
#undef PG8_LDA
#undef PG8_LDB
#undef PG8_MMA
#undef PG8_WAIT_V
#undef PG8_WAIT_L
#undef PG8_BAR
#undef PG8_SCHED
}
}

constexpr int NWAVES = 8, NTHR = 512;
struct Args { const float* in[26]; float* out; unsigned char* ws; int ph_lo, ph_hi; unsigned repmask; int pad; };
struct Frame {
    LAS unsigned char* lds;
    int tid, lane, wave, G, bx;
    unsigned char* ws;
};

struct APlain { const void* base; unsigned kstep; unsigned ld2;
    static constexpr bool GATHER = false;
    __device__ __forceinline__ const void* unit_ptr(const pg8::Unit& u) const { return (const char*)base + (size_t)u.pm * 256 * ld2; }
    __device__ __forceinline__ unsigned lane_off(int R, int C) const { return (unsigned)R * ld2 + (unsigned)C * 2u; }
    __device__ __forceinline__ size_t hstep() const { return (size_t)128 * ld2; }
    __device__ __forceinline__ unsigned row_off(const pg8::Unit&, int) const { return 0u; } };
struct BPlain { const bf16* Bt; int K;
    __device__ __forceinline__ const void* ptr(const pg8::Unit& u) const { return Bt + (size_t)u.pn * 256 * K; } };

struct EpiZ {
    static constexpr bool PERM = true;
    bf16* ZA; bf16* ZG;
    __device__ __forceinline__ void operator()(const f32x4 (&acc)[2][2][4][2], const pg8::Unit& u, int wr, int wc, int fr, int fq) const {
        const bool gate = u.pn >= 11;
        bf16* base = gate ? ZG : ZA; const int ld = gate ? ZG_LD : ZA_LD; const int colt = gate ? (u.pn - 11) * 256 : u.pn * 256;
        const int row0 = u.pm * 256 + wr * 64 + fr, col0 = colt + wc * 32 + 8 * fq;
#pragma unroll
        for (int ai = 0; ai < 2; ++ai)
#pragma unroll
            for (int m = 0; m < 4; ++m) { bf16* rowp = base + (size_t)(row0 + ai * 128 + m * 16) * ld + col0;
#pragma unroll
                for (int bj = 0; bj < 2; ++bj) { f32x4 v0 = acc[ai][bj][m][0], v1 = acc[ai][bj][m][1];
                    if (gate) {
#pragma unroll
                        for (int j = 0; j < 4; ++j) { v0[j] = sigmoidf_(v0[j]); v1[j] = sigmoidf_(v1[j]); } }
                    u32x4 w; w.x = pk2(v0[0], v0[1]); w.y = pk2(v0[2], v0[3]); w.z = pk2(v1[0], v1[1]); w.w = pk2(v1[2], v1[3]);
                    *(u32x4*)(rowp + bj * 128) = w; } }
    }
};
template <int MODE> struct EpiGate {
    static constexpr bool PERM = true;
    const bf16* ZG; const bf16* T1; bf16* O;
    __device__ __forceinline__ void operator()(const f32x4 (&acc)[2][2][4][2], const pg8::Unit& u, int wr, int wc, int fr, int fq) const {
        const int row0 = u.pm * 256 + wr * 64 + fr, col0 = u.pn * 256 + wc * 32 + 8 * fq;
#pragma unroll
        for (int ai = 0; ai < 2; ++ai)
#pragma unroll
            for (int m = 0; m < 4; ++m) { const size_t r = (size_t)(row0 + ai * 128 + m * 16);
#pragma unroll
                for (int bj = 0; bj < 2; ++bj) { const int c = col0 + bj * 128;
                    const u32x4 g = *(const u32x4*)(ZG + r * ZG_LD + MODE * 1024 + c);
                    f32x4 v0 = acc[ai][bj][m][0], v1 = acc[ai][bj][m][1];
                    float o[8] = { v0[0] * bflo(g.x), v0[1] * bfhi(g.x), v0[2] * bflo(g.y), v0[3] * bfhi(g.y), v1[0] * bflo(g.z), v1[1] * bfhi(g.z), v1[2] * bflo(g.w), v1[3] * bfhi(g.w) };
                    if (MODE == 1) { const u32x4 t = *(const u32x4*)(T1 + r * 1024 + c);
                        o[0] += bflo(t.x); o[1] += bfhi(t.x); o[2] += bflo(t.y); o[3] += bfhi(t.y); o[4] += bflo(t.z); o[5] += bfhi(t.z); o[6] += bflo(t.w); o[7] += bfhi(t.w); }
                    u32x4 w; w.x = pk2(o[0], o[1]); w.y = pk2(o[2], o[3]); w.z = pk2(o[4], o[5]); w.w = pk2(o[6], o[7]);
                    *(u32x4*)(O + r * 1024 + c) = w; } }
    }
};
struct EpiRes {
    static constexpr bool PERM = true;
    const float* X; bf16* O;
    __device__ __forceinline__ void operator()(const f32x4 (&acc)[2][2][4][2], const pg8::Unit& u, int wr, int wc, int fr, int fq) const {
        const int row0 = u.pm * 256 + wr * 64 + fr, col0 = u.pn * 256 + wc * 32 + 8 * fq;
#pragma unroll
        for (int ai = 0; ai < 2; ++ai)
#pragma unroll
            for (int m = 0; m < 4; ++m) { const size_t off = (size_t)(row0 + ai * 128 + m * 16) * D + col0;
#pragma unroll
                for (int bj = 0; bj < 2; ++bj) { const f32x4 x0 = *(const f32x4*)(X + off + bj * 128), x1 = *(const f32x4*)(X + off + bj * 128 + 4);
                    const f32x4 v0 = x0 * ALPHA + acc[ai][bj][m][0], v1 = x1 * ALPHA + acc[ai][bj][m][1];
                    u32x4 w; w.x = pk2(v0[0], v0[1]); w.y = pk2(v0[2], v0[3]); w.z = pk2(v1[0], v1[1]); w.w = pk2(v1[2], v1[3]);
                    *(u32x4*)(O + off + bj * 128) = w; } }
    }
};

template <class F>
__device__ __forceinline__ void p0_tile(const F& f, bf16* WT, int ldk, int k0, int n0, LAS float* scr, int lane) {
    if constexpr (F::FOLD) {
        float bc[64];
#pragma unroll
        for (int d = 0; d < 64; ++d) bc[d] = f.bval(k0, d, n0 + (lane & 31));
#pragma unroll 4
        for (int i = 0; i < 32; ++i) { const int kk = 2 * i + (lane >> 5); const f32x4* ar = (const f32x4*)f.arow(k0 + kk, n0); f32x4 a4 = {0.f, 0.f, 0.f, 0.f};
#pragma unroll
            for (int q = 0; q < 16; ++q) { const f32x4 av = ar[q]; a4[0] += av[0] * bc[4 * q]; a4[1] += av[1] * bc[4 * q + 1]; a4[2] += av[2] * bc[4 * q + 2]; a4[3] += av[3] * bc[4 * q + 3]; }
            scr[kk * 33 + (lane & 31)] = (a4[0] + a4[1]) + (a4[2] + a4[3]); }
    } else {
        float v[32];
#pragma unroll
        for (int i = 0; i < 32; ++i) { const int kk = 2 * i + (lane >> 5); v[i] = f(k0 + kk, n0 + (lane & 31)); }
#pragma unroll
        for (int i = 0; i < 32; ++i) { const int kk = 2 * i + (lane >> 5); scr[kk * 33 + (lane & 31)] = v[i]; }
    }
    LDS_WAIT(); asm volatile("" ::: "memory");
    const int c = lane & 7;
#pragma unroll
    for (int j = 0; j < 4; ++j) { const int n = (lane >> 3) + 8 * j; const LAS float* s = scr + (8 * c) * 33 + n;
        u32x4 o; o.x = pk2(s[0 * 33], s[1 * 33]); o.y = pk2(s[2 * 33], s[3 * 33]); o.z = pk2(s[4 * 33], s[5 * 33]); o.w = pk2(s[6 * 33], s[7 * 33]);
        *(u32x4*)(WT + (size_t)(n0 + n) * ldk + k0 + 8 * c) = o; }
    LDS_WAIT(); asm volatile("" ::: "memory");
}
struct P0Item { const float* src; int N, noff; bf16* dst; int ldk, k0, n0; };
__device__ __forceinline__ void p0_item_load(const P0Item& it, float (&v)[32], int lane) {
#pragma unroll
    for (int i = 0; i < 32; ++i) { const int kk = 2 * i + (lane >> 5); v[i] = it.src[(size_t)(it.k0 + kk) * it.N + it.n0 + (lane & 31) + it.noff]; }
}
__device__ __forceinline__ void p0_item_finish(const P0Item& it, const float (&v)[32], LAS float* scr, int lane) {
#pragma unroll
    for (int i = 0; i < 32; ++i) { const int kk = 2 * i + (lane >> 5); scr[kk * 33 + (lane & 31)] = v[i]; }
    LDS_WAIT(); asm volatile("" ::: "memory");
    const int c = lane & 7;
#pragma unroll
    for (int j = 0; j < 4; ++j) { const int n = (lane >> 3) + 8 * j; const LAS float* s = scr + (8 * c) * 33 + n;
        u32x4 o; o.x = pk2(s[0 * 33], s[1 * 33]); o.y = pk2(s[2 * 33], s[3 * 33]); o.z = pk2(s[4 * 33], s[5 * 33]); o.w = pk2(s[6 * 33], s[7 * 33]);
        *(u32x4*)(it.dst + (size_t)(it.n0 + n) * it.ldk + it.k0 + 8 * c) = o; }
    LDS_WAIT(); asm volatile("" ::: "memory");
}
__device__ __forceinline__ int zsrc_col(int n) {
    if (n < 1280) return n;
    if (n < 2304) return -2;
    if (n < 2432) return 1816 + (n - 2304);
    if (n < 2688) return 1944 + (n - 2432);
    if (n < 2752) return 2200 + (n - 2688);
    if (n < 2776) return 1280 + (n - 2752);
    if (n < 2780) return 2264 + (n - 2776);
    if (n < 2816) return -1;
    if (n < 3840) return 2268 + (n - 2816);
    return 3292 + (n - 3840);
}
struct FWin { const float* w_in; static constexpr bool FOLD = false;
    __device__ __forceinline__ float operator()(int k, int n) const { const int s = zsrc_col(n); return s >= 0 ? w_in[(size_t)k * D_IN + s] : 0.f; } };
struct FWinQ { const float* w_in; const float* w_uk; static constexpr bool FOLD = true;
    __device__ __forceinline__ const float* arow(int k, int n0) const { return w_in + (size_t)k * D_IN + 1304 + ((n0 - 1280) >> 7) * 64; }
    __device__ __forceinline__ float bval(int, int d, int n) const { return w_uk[(size_t)((n - 1280) >> 7) * 64 * 128 + d * 128 + ((n - 1280) & 127)]; }
    __device__ __forceinline__ float operator()(int, int) const { return 0.f; } };
struct FWb { const float* w_uv; const float* w_bb; static constexpr bool FOLD = true;
    __device__ __forceinline__ const float* arow(int k, int) const { return w_uv + (size_t)k * 64; }
    __device__ __forceinline__ float bval(int k0, int d, int n) const { return w_bb[(size_t)((k0 >> 7) * 64 + d) * D + n]; }
    __device__ __forceinline__ float operator()(int, int) const { return 0.f; } };
struct FPlain { const float* W; int N; static constexpr bool FOLD = false; __device__ __forceinline__ float operator()(int k, int n) const { return W[(size_t)k * N + n]; } };
struct FOff { const float* W; int N; int noff; static constexpr bool FOLD = false;
    __device__ __forceinline__ float operator()(int k, int n) const { return W[(size_t)k * N + n + noff]; } };

__device__ __forceinline__ float rel_bucket_bias(const float* rel_bias, int dist, int head) {
    int b;
    if (dist < 16) b = dist;
    else { const float t = (__log2f((float)dist) - 4.0f) * 2.66666675f; b = 16 + (int)t; if (b > 31) b = 31; }
    return rel_bias[b * 16 + head];
}

constexpr int P0_EXP_ITEMS = NEXP * ((1024 / 64) * (512 / 32) + (256 / 64) * (1024 / 32)), P0_EXP_SPLIT = (P0_EXP_ITEMS * 2) / 3;
__device__ __forceinline__ void p0_experts(const Frame& F, const Args& a, int wv, int nwv, int ibeg, int iend) {
    LAS float* scr = (LAS float*)(F.lds + F.wave * 16384);
    unsigned char* ws = F.ws;
    constexpr int I_GU = (1024 / 64) * (512 / 32), I_DN = (256 / 64) * (1024 / 32);
    const int gw = wv, NGW = nwv;
    {
        constexpr int NEI = NEXP * (I_GU + I_DN);
        auto mk = [&](int idx) { P0Item it; const int e = idx / (I_GU + I_DN); int r = idx - e * (I_GU + I_DN);
            if (r < I_GU) {
                const int n0 = (r % 16) * 32; const uintptr_t pg = (uintptr_t)a.in[21], pu = (uintptr_t)a.in[22];
                it.src = (const float*)(pg + (uintptr_t)((n0 >> 7) & 1) * (pu - pg)) + (size_t)e * D * DEXP; it.N = DEXP; it.noff = ((n0 >> 8) * 128 + (n0 & 127)) - n0;
                it.dst = (bf16*)(ws + WS_WGU) + (size_t)e * 512 * 1024; it.ldk = 1024; it.k0 = (r / 16) * 64; it.n0 = n0; }
            else { r -= I_GU; it.src = a.in[23] + (size_t)e * DEXP * D; it.N = D; it.noff = 0; it.dst = (bf16*)(ws + WS_WDT) + (size_t)e * 1024 * 256; it.ldk = 256; it.k0 = (r / 32) * 64; it.n0 = (r % 32) * 32; }
            return it; };
        float va[32], vb[32];
        {
        (void)NEI;
        int idx = ibeg + gw;
        if (idx < iend) { P0Item cur = mk(idx); p0_item_load(cur, va, F.lane);
            for (;;) {
                const int nidx = idx + NGW; const bool more = nidx < iend; P0Item nxt = cur;
                if (more) { nxt = mk(nidx); p0_item_load(nxt, vb, F.lane); }
                p0_item_finish(cur, va, scr, F.lane);
                if (!more) break;
#pragma unroll
                for (int i = 0; i < 32; ++i) va[i] = vb[i];
                cur = nxt; idx = nidx; } }
        }
    }
}
__device__ __forceinline__ void phase0(const Frame& F, const Args& a) {
    LAS float* scr = (LAS float*)(F.lds + F.wave * 16384);
    const int gw = F.bx * NWAVES + F.wave, NGW = F.G * NWAVES;
    unsigned char* ws = F.ws;
    constexpr int I_WIN = (D / 64) * (NZ / 32);
    constexpr int I_WB = (1024 / 64) * (1024 / 32);
    constexpr int I_WA = (512 / 64) * (1024 / 32);
    constexpr int I_WO = I_WB;
    constexpr int I_W1 = (2048 / 64) * (256 / 32);
    constexpr int I_W2 = (256 / 64) * (64 / 32);
    constexpr int I_GU = (1024 / 64) * (512 / 32);
    constexpr int I_DN = (256 / 64) * (1024 / 32);
    constexpr int NITEMS = I_WIN + I_WB + I_WA + I_WO + 2 * I_W1 + 2 * I_W2;
    (void)NITEMS;
    constexpr int I_WINP = (D / 64) * ((NZ - 1024) / 32);
    for (int it = gw; it < 1024; it += NGW) {
        if (it < 512) { const int k0 = (it >> 5) * 64, n0 = 1280 + (it & 31) * 32; const FWinQ f{a.in[1], a.in[9]}; p0_tile(f, (bf16*)(ws + WS_WINT), D, k0, n0, scr, F.lane); }
        else { const int r = it - 512; const FWb f{a.in[10], a.in[13]}; p0_tile(f, (bf16*)(ws + WS_WBT), 1024, (r / 32) * 64, (r % 32) * 32, scr, F.lane); }
    }
    { constexpr int NPL = I_WINP + I_WA + I_WO + 2 * I_W1 + 2 * I_W2;
      const int pw0 = NGW > 1024 ? (gw >= 1024 ? gw - 1024 : -1) : gw, pws = NGW > 1024 ? NGW - 1024 : NGW;
      if (pw0 >= 0) for (int it = pw0; it < NPL; it += pws) {
        int r = it;
        if (r < I_WINP) { const int k0 = (r / 120) * 64; int nb = r % 120; nb = nb < 40 ? nb : nb + 32; const FWin f{a.in[1]}; p0_tile(f, (bf16*)(ws + WS_WINT), D, k0, nb * 32, scr, F.lane); continue; } r -= I_WINP;
        if (r < I_WA) { const FPlain f{a.in[12], D}; p0_tile(f, (bf16*)(ws + WS_WAT), 512, (r / 32) * 64, (r % 32) * 32, scr, F.lane); continue; } r -= I_WA;
        if (r < I_WO) { const FPlain f{a.in[14], D}; p0_tile(f, (bf16*)(ws + WS_WOT), 1024, (r / 32) * 64, (r % 32) * 32, scr, F.lane); continue; } r -= I_WO;
        if (r < I_W1) { const FPlain f{a.in[4], 256}; p0_tile(f, (bf16*)(ws + WS_W1K), 2048, (r / 8) * 64, (r % 8) * 32, scr, F.lane); continue; } r -= I_W1;
        if (r < I_W1) { const FPlain f{a.in[6], 256}; p0_tile(f, (bf16*)(ws + WS_W1V), 2048, (r / 8) * 64, (r % 8) * 32, scr, F.lane); continue; } r -= I_W1;
        if (r < I_W2) { const FPlain f{a.in[5], 64}; p0_tile(f, (bf16*)(ws + WS_W2K), 256, (r / 2) * 64, (r % 2) * 32, scr, F.lane); continue; } r -= I_W2;
        { const FPlain f{a.in[7], 64}; p0_tile(f, (bf16*)(ws + WS_W2V), 256, (r / 2) * 64, (r % 2) * 32, scr, F.lane); }
      } }
    { const int nu = (NTOK / 256) * (NZ / 256); if ((nu % F.G) == 0) p0_experts(F, a, gw, NGW, 0, P0_EXP_ITEMS); }
    { const f32x4* x4 = (const f32x4*)a.in[0]; u32x2* o = (u32x2*)(ws + WS_XB);
      const size_t total = (size_t)NTOK * D / 4, stride = (size_t)F.G * NTHR;
      for (size_t i0 = (size_t)F.bx * NTHR + F.tid; i0 < total; i0 += 8 * stride) { f32x4 v[8];
#pragma unroll
          for (int j = 0; j < 8; ++j) { const size_t i = i0 + j * stride; v[j] = i < total ? x4[i] : (f32x4){0.f, 0.f, 0.f, 0.f}; }
#pragma unroll
          for (int j = 0; j < 8; ++j) { const size_t i = i0 + j * stride; if (i < total) { u32x2 w; w.x = pk2(v[j][0], v[j][1]); w.y = pk2(v[j][2], v[j][3]); o[i] = w; } } } }
    if (F.bx < 64 && F.tid < 256) {
        const int kv = F.bx >> 5, j = F.bx & 31;
        const float* pe = (kv ? a.in[3] : a.in[2]) + 64 * j; const float* w1 = (kv ? a.in[6] : a.in[4]) + (size_t)(64 * j) * 256 + F.tid; float acc = 0.f;
#pragma unroll 16
        for (int k = 0; k < 64; ++k) acc += pe[k] * w1[(size_t)k * 256];
        ((float*)(ws + WS_BIASK))[(kv * 32 + j) * 256 + F.tid] = acc;
    }
    if (F.bx >= 64 && F.bx < 96) { const int idx = (F.bx - 64) * NTHR + F.tid;
        const int tab = idx >> 13, head = (idx >> 10) & 7, dist = idx & 1023;
        ((float*)(ws + (tab ? WS_TBB : WS_TBA)))[head * 1024 + dist] = rel_bucket_bias(a.in[11], dist, tab * 8 + head) * LOG2E; }
}

constexpr int NRT = 36;
constexpr int P6_WR = 0;
constexpr int P6_CNT = 147456;
constexpr int P6_ENT = 147456 + 512;
__device__ __forceinline__ float row16_sum(float v) {
    v += __builtin_bit_cast(float, __builtin_amdgcn_update_dpp(0, __builtin_bit_cast(int, v), 0xB1, 0xf, 0xf, true));
    v += __builtin_bit_cast(float, __builtin_amdgcn_update_dpp(0, __builtin_bit_cast(int, v), 0x4E, 0xf, 0xf, true));
    v += __builtin_bit_cast(float, __builtin_amdgcn_update_dpp(0, __builtin_bit_cast(int, v), 0x141, 0xf, 0xf, true));
    v += __builtin_bit_cast(float, __builtin_amdgcn_update_dpp(0, __builtin_bit_cast(int, v), 0x140, 0xf, 0xf, true));
    return v;
}
__device__ __forceinline__ float wave_sum_dpp(float v) { v = row16_sum(v); v += __shfl_xor(v, 16); v += __shfl_xor(v, 32); return v; }
__device__ __forceinline__ void phase6(const Frame& F, const Args& a) {
    unsigned char* ws = F.ws;
    LAS float* WR = (LAS float*)(F.lds + P6_WR);
    LAS int* cntL = (LAS int*)(F.lds + P6_CNT); LAS int* baseL = cntL + 32;
    LAS int* ent = (LAS int*)(F.lds + P6_ENT);
    const float* w_grp = a.in[17]; const float* b_grp = a.in[18]; const float* w_rtr = a.in[19]; const float* b_rtr = a.in[20];
    for (int i = F.tid; i < NRT * 1024; i += NTHR) { const int o = i >> 10, k = i & 1023; WR[i] = o < 4 ? w_grp[k * 4 + o] : w_rtr[k * 32 + (o - 4)]; }
    if (F.tid < 65) cntL[F.tid] = 0;
    __syncthreads();
    const bf16* HP = (const bf16*)(ws + WS_H1); bf16* H1B = (bf16*)(ws + WS_H1B);
    const float* lg = a.in[15]; const float* lb = a.in[16];
    f32x2 gam[8], bet[8];
#pragma unroll
    for (int j = 0; j < 2; ++j)
#pragma unroll
        for (int q = 0; q < 4; ++q) { gam[4 * j + q] = *(const f32x2*)(lg + 512 * j + 8 * F.lane + 2 * q); bet[4 * j + q] = *(const f32x2*)(lb + 512 * j + 8 * F.lane + 2 * q); }
    unsigned* gcnt = (unsigned*)(ws + WS_CTL) + CW_CNT;
    int* list = (int*)(ws + WS_LIST); float* tokinfo = (float*)(ws + WS_TOKINFO);
    const int gw = F.bx * NWAVES + F.wave, NGW = F.G * NWAVES;
    u32x4 nx0, nx1;
    const int rpb = (NTOK + F.G - 1) / F.G, rbeg = F.bx * rpb, rend = (rbeg + rpb < NTOK) ? rbeg + rpb : NTOK;
    (void)gw; (void)NGW;
    if (rbeg + F.wave < rend) { const u32x4* hr = (const u32x4*)(HP + (size_t)(rbeg + F.wave) * D) + F.lane; nx0 = hr[0]; nx1 = hr[64]; }
    for (int row = rbeg + F.wave; row < rend; row += NWAVES) {
        const u32x4 r0 = nx0, r1 = nx1;
        if (row + NWAVES < rend) { const u32x4* hr = (const u32x4*)(HP + (size_t)(row + NWAVES) * D) + F.lane; nx0 = hr[0]; nx1 = hr[64]; }
        f32x2 v[8];
        v[0] = (f32x2){bflo(r0.x), bfhi(r0.x)}; v[1] = (f32x2){bflo(r0.y), bfhi(r0.y)}; v[2] = (f32x2){bflo(r0.z), bfhi(r0.z)}; v[3] = (f32x2){bflo(r0.w), bfhi(r0.w)};
        v[4] = (f32x2){bflo(r1.x), bfhi(r1.x)}; v[5] = (f32x2){bflo(r1.y), bfhi(r1.y)}; v[6] = (f32x2){bflo(r1.z), bfhi(r1.z)}; v[7] = (f32x2){bflo(r1.w), bfhi(r1.w)};
        f32x2 s2 = v[0];
#pragma unroll
        for (int q = 1; q < 8; ++q) s2 += v[q];
        const float mean = wave_sum_dpp(s2[0] + s2[1]) * (1.f / D);
        f32x2 q2 = {0.f, 0.f};
#pragma unroll
        for (int q = 0; q < 8; ++q) { v[q] = v[q] - mean; q2 += v[q] * v[q]; }
        const float rstd = 1.0f / sqrtf(wave_sum_dpp(q2[0] + q2[1]) * (1.f / D) + 1e-5f);
#pragma unroll
        for (int q = 0; q < 8; ++q) v[q] = v[q] * rstd * gam[q] + bet[q];
        { u32x4 w0, w1; w0.x = pk2(v[0][0], v[0][1]); w0.y = pk2(v[1][0], v[1][1]); w0.z = pk2(v[2][0], v[2][1]); w0.w = pk2(v[3][0], v[3][1]);
          w1.x = pk2(v[4][0], v[4][1]); w1.y = pk2(v[5][0], v[5][1]); w1.z = pk2(v[6][0], v[6][1]); w1.w = pk2(v[7][0], v[7][1]);
          u32x4* ob = (u32x4*)(H1B + (size_t)row * D) + F.lane; ob[0] = w0; ob[64] = w1; }
        auto rdot = [&](int o) { f32x2 p2 = {0.f, 0.f};
#pragma unroll
            for (int j = 0; j < 2; ++j) { const f32x4 wa = *(const LAS f32x4*)(WR + o * 1024 + 512 * j + 8 * F.lane), wb = *(const LAS f32x4*)(WR + o * 1024 + 512 * j + 8 * F.lane + 4);
                p2 += v[4 * j] * (f32x2){wa[0], wa[1]}; p2 += v[4 * j + 1] * (f32x2){wa[2], wa[3]}; p2 += v[4 * j + 2] * (f32x2){wb[0], wb[1]}; p2 += v[4 * j + 3] * (f32x2){wb[2], wb[3]}; }
            return row16_sum(p2[0] + p2[1]); };
        float g[4];
#pragma unroll
        for (int i = 0; i < 4; ++i) g[i] = rdot(i);
#pragma unroll
        for (int i = 0; i < 4; ++i) { float t = g[i]; t += __shfl_xor(t, 16); t += __shfl_xor(t, 32); g[i] = t + b_grp[i]; }
        int gs = 0; float gm = g[0];
#pragma unroll
        for (int i = 1; i < 4; ++i) if (g[i] > gm) { gm = g[i]; gs = i; }
        gs = __builtin_amdgcn_readfirstlane(gs);
        float gsum = 0.f;
#pragma unroll
        for (int i = 0; i < 4; ++i) gsum += __expf(g[i] - gm);
        const float pgrp = 1.0f / gsum;
        float el[8];
#pragma unroll
        for (int i = 0; i < 8; ++i) el[i] = rdot(4 + gs * 8 + i);
#pragma unroll
        for (int i = 0; i < 8; ++i) { float t = el[i]; t += __shfl_xor(t, 16); t += __shfl_xor(t, 32); el[i] = t + b_rtr[gs * 8 + i]; }
        int i1 = 0; float l1 = el[0];
#pragma unroll
        for (int i = 1; i < 8; ++i) if (el[i] > l1) { l1 = el[i]; i1 = i; }
        int i2 = -1; float l2 = -3.0e38f;
#pragma unroll
        for (int i = 0; i < 8; ++i) if (i != i1 && el[i] > l2) { l2 = el[i]; i2 = i; }
        const float e2 = __expf(l2 - l1), inv = 1.0f / (1.0f + e2);
        const float w0 = pgrp * inv, w1 = pgrp * e2 * inv;
        const int e0 = gs * 8 + i1, e1 = gs * 8 + i2;
        if (F.lane == 0) {
            const int p0 = atomicAdd((int*)&cntL[e0], 1), p1 = atomicAdd((int*)&cntL[e1], 1);
            const int n0 = atomicAdd((int*)&cntL[64], 2);
            ent[2 * n0] = (e0 << 16) | p0; ent[2 * n0 + 1] = row * 2;
            ent[2 * n0 + 2] = (e1 << 16) | p1; ent[2 * n0 + 3] = row * 2 + 1;
            tokinfo[row * 2] = w0; tokinfo[row * 2 + 1] = w1;
        }
    }
    __syncthreads();
    if (F.tid < 32) { const int c = cntL[F.tid]; baseL[F.tid] = c > 0 ? (int)__hip_atomic_fetch_add(gcnt + 64 * F.tid, (unsigned)c, __ATOMIC_RELAXED, __HIP_MEMORY_SCOPE_AGENT) : 0; }
    __syncthreads();
    const int nent = cntL[64];
    for (int i = F.tid; i < nent; i += NTHR) { const int ep = ent[2 * i], tk = ent[2 * i + 1]; const int e = ep >> 16, p = ep & 0xffff; list[(size_t)e * NTOK + baseL[e] + p] = tk; }
    __syncthreads();
}

constexpr int MOE_CUM = 131072;
struct MoeOrder {
    int G, c, NP; const LAS int* cum; const LAS int* cnt;
    __device__ bool next(int i, pg8::Unit& u) const {
        const int L = i * G + c, t = L / NP; if (t >= cum[32]) return false;
        const int e = cum[80 + t];
        const int j = t - cum[e]; u.pm = t; u.pn = L % NP; u.e = e | (j << 8); const int rem = cnt[e] - j * 256; u.nrows = rem < 256 ? rem : 256; return true;
    }
};
__device__ __forceinline__ void moe_setup(const Frame& F) {
    LAS int* cum = (LAS int*)(F.lds + MOE_CUM); LAS int* cnt = cum + 40;
    const unsigned* gcnt = (const unsigned*)(F.ws + WS_CTL) + CW_CNT;
    if (F.tid == 0) { int s = 0; for (int e = 0; e < 32; ++e) { const int c = (int)__hip_atomic_load(gcnt + 64 * e, __ATOMIC_RELAXED, __HIP_MEMORY_SCOPE_AGENT); cnt[e] = c; cum[e] = s; s += (c + 255) >> 8; } cum[32] = s; }
    __syncthreads();
    for (int t = F.tid; t < cum[32]; t += NTHR) { int e = 0; for (int k = 1; k < 32; ++k) if (t >= cum[k]) e = k; cum[80 + t] = e; }
    __syncthreads();
}
struct AGather { const void* base; unsigned kstep; const int* list;
    static constexpr bool GATHER = true;
    __device__ __forceinline__ const void* unit_ptr(const pg8::Unit&) const { return base; }
    __device__ __forceinline__ unsigned lane_off(int, int) const { return 0u; }
    __device__ __forceinline__ size_t hstep() const { return 0; }
    __device__ __forceinline__ unsigned row_off(const pg8::Unit& u, int r) const { const int e = u.e & 255, j = u.e >> 8; const int rr = r < u.nrows ? r : 0;
        const int tk = list[(size_t)e * NTOK + j * 256 + rr]; return (unsigned)(tk >> 1) * (unsigned)(D * 2); } };
struct BGu { const bf16* W; __device__ __forceinline__ const void* ptr(const pg8::Unit& u) const { return W + (size_t)(u.e & 255) * 512 * 1024 + (size_t)u.pn * 256 * 1024; } };
struct BDn { const bf16* W; __device__ __forceinline__ const void* ptr(const pg8::Unit& u) const { return W + (size_t)(u.e & 255) * 1024 * 256 + (size_t)u.pn * 256 * 256; } };
struct EpiAct {
    static constexpr bool PERM = true; bf16* ACT;
    __device__ __forceinline__ void operator()(const f32x4 (&acc)[2][2][4][2], const pg8::Unit& u, int wr, int wc, int fr, int fq) const {
        const int row0 = u.pm * 256 + wr * 64 + fr, col0 = u.pn * 128 + wc * 32 + 8 * fq;
#pragma unroll
        for (int ai = 0; ai < 2; ++ai)
#pragma unroll
            for (int m = 0; m < 4; ++m) { float o[8];
#pragma unroll
                for (int n = 0; n < 2; ++n)
#pragma unroll
                    for (int j = 0; j < 4; ++j) { const float gt = acc[ai][0][m][n][j], up = acc[ai][1][m][n][j]; o[4 * n + j] = gt * sigmoidf_(gt) * up; }
                u32x4 w; w.x = pk2(o[0], o[1]); w.y = pk2(o[2], o[3]); w.z = pk2(o[4], o[5]); w.w = pk2(o[6], o[7]);
                *(u32x4*)(ACT + (size_t)(row0 + ai * 128 + m * 16) * DEXP + col0) = w; }
    }
};
struct EpiDown {
    static constexpr bool PERM = true; bf16* Y; const int* list;
    __device__ __forceinline__ void operator()(const f32x4 (&acc)[2][2][4][2], const pg8::Unit& u, int wr, int wc, int fr, int fq) const {
        const int e = u.e & 255, j = u.e >> 8; const int col0 = u.pn * 256 + wc * 32 + 8 * fq;
        int tks[2][4];
#pragma unroll
        for (int ai = 0; ai < 2; ++ai)
#pragma unroll
            for (int m = 0; m < 4; ++m) { const int r = ai * 128 + wr * 64 + m * 16 + fr; tks[ai][m] = r < u.nrows ? list[(size_t)e * NTOK + j * 256 + r] : -1; }
#pragma unroll
        for (int ai = 0; ai < 2; ++ai)
#pragma unroll
            for (int m = 0; m < 4; ++m) { const int tk = tks[ai][m];
                if (tk >= 0) { bf16* rowp = Y + (size_t)tk * D + col0;
#pragma unroll
                    for (int bj = 0; bj < 2; ++bj) { const f32x4 v0 = acc[ai][bj][m][0], v1 = acc[ai][bj][m][1];
                        u32x4 w; w.x = pk2(v0[0], v0[1]); w.y = pk2(v0[2], v0[3]); w.z = pk2(v1[0], v1[1]); w.w = pk2(v1[2], v1[3]);
                        *(u32x4*)(rowp + bj * 128) = w; } } }
    }
};

__device__ __forceinline__ void phase9(const Frame& F, const Args& a) {
    unsigned char* ws = F.ws;
    const bf16* H1B = (const bf16*)(ws + WS_H1B); const bf16* Y = (const bf16*)(ws + WS_YBUF); const float* tokinfo = (const float*)(ws + WS_TOKINFO);
    const float* lg = a.in[24]; const float* lb = a.in[25];
    f32x4 gam[4], bet[4];
#pragma unroll
    for (int j = 0; j < 2; ++j) { gam[2 * j] = *(const f32x4*)(lg + 512 * j + 8 * F.lane); gam[2 * j + 1] = *(const f32x4*)(lg + 512 * j + 8 * F.lane + 4); bet[2 * j] = *(const f32x4*)(lb + 512 * j + 8 * F.lane); bet[2 * j + 1] = *(const f32x4*)(lb + 512 * j + 8 * F.lane + 4); }
    const int gw = F.bx * NWAVES + F.wave, NGW = F.G * NWAVES;
    u32x4 nh[2], ny0[2], ny1[2]; float nw0 = 0.f, nw1 = 0.f;
#define P9_LOAD(row_) do { const u32x4* hp_ = (const u32x4*)(H1B + (size_t)(row_) * D) + F.lane; const u32x4* y0_ = (const u32x4*)(Y + (size_t)((row_) * 2) * D) + F.lane; const u32x4* y1_ = (const u32x4*)(Y + (size_t)((row_) * 2 + 1) * D) + F.lane; \
        nh[0] = hp_[0]; nh[1] = hp_[64]; ny0[0] = y0_[0]; ny0[1] = y0_[64]; ny1[0] = y1_[0]; ny1[1] = y1_[64]; nw0 = tokinfo[(row_) * 2]; nw1 = tokinfo[(row_) * 2 + 1]; } while (0)
    if (gw < NTOK) P9_LOAD(gw);
    for (int row = gw; row < NTOK; row += NGW) {
        u32x4 h[2] = {nh[0], nh[1]}, p[2] = {ny0[0], ny0[1]}, q[2] = {ny1[0], ny1[1]}; const float w0 = nw0, w1 = nw1;
        if (row + NGW < NTOK) P9_LOAD(row + NGW);
        f32x4 v[4]; float s = 0.f;
#pragma unroll
        for (int j = 0; j < 2; ++j) {
            v[2 * j][0] = ALPHA * bflo(h[j].x) + w0 * bflo(p[j].x) + w1 * bflo(q[j].x); v[2 * j][1] = ALPHA * bfhi(h[j].x) + w0 * bfhi(p[j].x) + w1 * bfhi(q[j].x);
            v[2 * j][2] = ALPHA * bflo(h[j].y) + w0 * bflo(p[j].y) + w1 * bflo(q[j].y); v[2 * j][3] = ALPHA * bfhi(h[j].y) + w0 * bfhi(p[j].y) + w1 * bfhi(q[j].y);
            v[2 * j + 1][0] = ALPHA * bflo(h[j].z) + w0 * bflo(p[j].z) + w1 * bflo(q[j].z); v[2 * j + 1][1] = ALPHA * bfhi(h[j].z) + w0 * bfhi(p[j].z) + w1 * bfhi(q[j].z);
            v[2 * j + 1][2] = ALPHA * bflo(h[j].w) + w0 * bflo(p[j].w) + w1 * bflo(q[j].w); v[2 * j + 1][3] = ALPHA * bfhi(h[j].w) + w0 * bfhi(p[j].w) + w1 * bfhi(q[j].w); }
#pragma unroll
        for (int j = 0; j < 4; ++j) s += (v[j][0] + v[j][1]) + (v[j][2] + v[j][3]);
        const float mean = wave_sum_dpp(s) * (1.f / D); float s2 = 0.f;
#pragma unroll
        for (int j = 0; j < 4; ++j) { v[j] = v[j] - mean; s2 += (v[j][0] * v[j][0] + v[j][1] * v[j][1]) + (v[j][2] * v[j][2] + v[j][3] * v[j][3]); }
        const float rstd = 1.0f / sqrtf(wave_sum_dpp(s2) * (1.f / D) + 1e-5f);
        float* orow = a.out + (size_t)row * D + 8 * F.lane;
#pragma unroll
        for (int j = 0; j < 2; ++j) { *(f32x4*)(orow + 512 * j) = v[2 * j] * rstd * gam[2 * j] + bet[2 * j]; *(f32x4*)(orow + 512 * j + 4) = v[2 * j + 1] * rstd * gam[2 * j + 1] + bet[2 * j + 1]; }
    }
#undef P9_LOAD
}
#define MFMA32(a, b, c) __builtin_amdgcn_mfma_f32_32x32x16_bf16((a), (b), (c), 0, 0, 0)
__device__ __forceinline__ int crow(int r, int hi) { return (r & 3) + 8 * (r >> 2) + 4 * hi; }
__device__ __forceinline__ float gelu_tanh(float x) { const float u = 0.7978845608028654f * (x + 0.044715f * x * x * x); const float e = __expf(2.0f * u); return 0.5f * x * (2.0f - 2.0f / (e + 1.0f)); }
constexpr int P2_AROW = 4096 + 16;
constexpr int P2_HID = 32 * P2_AROW;
constexpr int P2_HROW = 512 + 16;
__device__ __forceinline__ void phase2(const Frame& F, const Args& a) {
    unsigned char* ws = F.ws;
    const bf16* ZA = (const bf16*)(ws + WS_ZA);
    { const float* gn = a.in[8]; bf16* CK = (bf16*)(ws + WS_CKVN);
      const int sub = F.lane >> 4, l16 = F.lane & 15;
      float gv[8];
#pragma unroll
      for (int j = 0; j < 8; ++j) gv[j] = gn[l16 * 8 + j];
      for (int r4 = F.bx * NWAVES + F.wave; r4 < NTOK / 4; r4 += F.G * NWAVES) { const int row = r4 * 4 + sub;
          const u32x4 w = *(const u32x4*)(ZA + (size_t)row * ZA_LD + ZC_CKV + l16 * 8);
          float v[8] = { bflo(w.x), bfhi(w.x), bflo(w.y), bfhi(w.y), bflo(w.z), bfhi(w.z), bflo(w.w), bfhi(w.w) };
          float s = 0.f;
#pragma unroll
          for (int j = 0; j < 8; ++j) s += v[j] * v[j];
          s += __shfl_xor(s, 1); s += __shfl_xor(s, 2); s += __shfl_xor(s, 4); s += __shfl_xor(s, 8);
          const float rs = 1.0f / sqrtf(s * (1.0f / 128.0f) + 1e-6f);
          u32x4 o; o.x = pk2(v[0] * rs * gv[0], v[1] * rs * gv[1]); o.y = pk2(v[2] * rs * gv[2], v[3] * rs * gv[3]); o.z = pk2(v[4] * rs * gv[4], v[5] * rs * gv[5]); o.w = pk2(v[6] * rs * gv[6], v[7] * rs * gv[7]);
          *(u32x4*)(CK + (size_t)row * 128 + l16 * 8) = o; } }
    const int r32 = F.lane & 31, hi = F.lane >> 5;
    for (int u = F.bx; u < 256; u += F.G) {
        const int kv = u >> 7, rt = u & 127, R0 = rt * 32;
        const int zc = kv ? ZC_VC : ZC_KC;
        const bf16* W1T = (const bf16*)(ws + (kv ? WS_W1V : WS_W1K)); const bf16* W2T = (const bf16*)(ws + (kv ? WS_W2V : WS_W2K));
        const float* bias = (const float*)(ws + WS_BIASK) + (size_t)kv * 32 * 256;
        bf16* OUT = (bf16*)(ws + (kv ? WS_VCMP : WS_KCMP));
        __syncthreads();
        for (int q = F.tid; q < 32 * 256; q += NTHR) { const int row = q >> 8, cq = q & 255, l = cq >> 3, dch = cq & 7;
            const int R = R0 + row, b = R >> 9, c = (R >> 1) & 255, g = R & 1; const int cc = c < NCMP ? c : NCMP - 1;
            const u32x4 v = *(const u32x4*)(ZA + (size_t)(b * SEQ + 16 * cc + l) * ZA_LD + zc + g * 64 + dch * 8);
            *(LAS u32x4*)(F.lds + row * P2_AROW + cq * 16) = v; }
        __syncthreads();
        f32x16 acc = {};
        { const bf16* bp = W1T + (size_t)(32 * F.wave + r32) * 2048 + 8 * hi; const LAS unsigned char* ap = F.lds + r32 * P2_AROW + 16 * hi;
          f32x16 acc1 = {};
#pragma unroll 1
          for (int s0 = 0; s0 < 128; s0 += 32) { bf16x8 bfr[32];
#pragma unroll
              for (int j = 0; j < 32; ++j) bfr[j] = *(const bf16x8*)(bp + (s0 + j) * 16);
#pragma unroll
              for (int j = 0; j < 32; j += 2) { const bf16x8 a0 = *(const LAS bf16x8*)(ap + (s0 + j) * 32), a1 = *(const LAS bf16x8*)(ap + (s0 + j + 1) * 32); acc = MFMA32(a0, bfr[j], acc); acc1 = MFMA32(a1, bfr[j + 1], acc1); } }
#pragma unroll
          for (int i = 0; i < 16; ++i) acc[i] += acc1[i]; }
        { float bs = 0.f;
#pragma unroll 8
          for (int j = 0; j < 32; ++j) bs += bias[j * 256 + 32 * F.wave + r32];
#pragma unroll
          for (int i = 0; i < 16; ++i) { const float h = gelu_tanh(acc[i] + bs); *(LAS unsigned short*)(F.lds + P2_HID + crow(i, hi) * P2_HROW + (32 * F.wave + r32) * 2) = (unsigned short)f2bf(h); } }
        __syncthreads();
        if (F.wave < 2) {
            f32x16 o2 = {};
            const bf16* bp = W2T + (size_t)(32 * F.wave + r32) * 256 + 8 * hi; const LAS unsigned char* ap = F.lds + P2_HID + r32 * P2_HROW + 16 * hi;
#pragma unroll
            for (int s = 0; s < 16; ++s) { const bf16x8 af = *(const LAS bf16x8*)(ap + s * 32); const bf16x8 bfr = *(const bf16x8*)(bp + s * 16); o2 = MFMA32(af, bfr, o2); }
#pragma unroll
            for (int i = 0; i < 16; ++i) OUT[(size_t)(R0 + crow(i, hi)) * 64 + 32 * F.wave + r32] = (bf16)f2bf(o2[i]);
        }
    }
    __syncthreads();
}

typedef short v4i16_t __attribute__((ext_vector_type(4)));
__device__ __forceinline__ s16x4 vtr(const LAS unsigned char* p) { return __builtin_bit_cast(s16x4, __builtin_amdgcn_ds_read_tr16_b64_v4i16((LAS v4i16_t*)p)); }
constexpr int NSA_K = 0;
constexpr int NSA_V = 16384;
constexpr int NSA_TB = 49152;
constexpr int NSA_SC = 65536;
constexpr int NSA_MSK = 81920;
constexpr int NSA_OF = 83968;
constexpr float C2 = 0.125f * LOG2E;

__device__ __forceinline__ float halfmax(float v) { return fmaxf(v, __shfl_xor(v, 32)); }
__device__ __forceinline__ void nsa_tile(const LAS unsigned char* Kb, const LAS unsigned char* Vb, const LAS float* tbh, const bf16x8 (&qr)[4], f32x16 (&o)[2], float& m, float& l,
                                         int kt, int tq, int kmul, int kadd, int dmax, bool selbit, int mode, float b31, int r32, int hi, int lane) {
    const int tqa = tq - kadd, qk = kmul == 16 ? (tqa >> 4) : tqa, rem = kmul == 16 ? (tqa & 15) : 0;
    const int ebase = qk - (kt * 64 + 4 * hi);
    const LAS unsigned char* vp0 = Vb + ((lane >> 4) & 1) * 32 + (lane & 3) * 8 + (4 * hi + ((lane & 15) >> 2)) * 64;
#pragma unroll
    for (int hf = 0; hf < 2; ++hf) {
        f32x16 s0 = {};
#pragma unroll
        for (int d0 = 0; d0 < 4; ++d0) { const bf16x8 k0 = *(const LAS bf16x8*)(Kb + (2 * d0 + hi) * 1024 + (r32 + 32 * hf) * 16); s0 = MFMA32(k0, qr[d0], s0); }
        float tmax, mn, ps = 0.f;
        if (mode == 2) {
            float a0 = fmaxf(fmaxf(s0[0], s0[1]), s0[2]), a1 = fmaxf(fmaxf(s0[3], s0[4]), s0[5]);
            a0 = fmaxf(fmaxf(a0, s0[6]), s0[7]); a1 = fmaxf(fmaxf(a1, s0[8]), s0[9]); a0 = fmaxf(fmaxf(a0, s0[10]), s0[11]); a1 = fmaxf(fmaxf(a1, s0[12]), s0[13]); a0 = fmaxf(fmaxf(a0, s0[14]), s0[15]);
            const float cb = selbit ? b31 : NEGBIG;
            tmax = fmaxf(a0, a1) * C2 + cb;
            tmax = halfmax(tmax);
            mn = fmaxf(m, tmax);
            const float cc = cb - mn;
#pragma unroll
            for (int r = 0; r < 16; ++r) { const float p0 = __builtin_amdgcn_exp2f(s0[r] * C2 + cc); s0[r] = p0; ps += p0; }
        } else if (mode == 1) {
            int eb1 = ebase; asm volatile("" : "+v"(eb1));
            const LAS float* tb1 = tbh + (eb1 - 96);
            float bv[16];
#pragma unroll
            for (int r = 0; r < 16; ++r) bv[r] = tb1[96 - ((r & 3) + 8 * (r >> 2) + 32 * hf)];
#pragma unroll
            for (int r = 0; r < 16; ++r) asm volatile("" : "+v"(bv[r]));
            tmax = NEGBIG;
#pragma unroll
            for (int r = 0; r < 16; ++r) { const float x = s0[r] * C2 + bv[r]; s0[r] = x; tmax = fmaxf(tmax, x); }
            tmax = selbit ? tmax : NEGBIG;
            tmax = halfmax(tmax);
            mn = fmaxf(m, tmax);
            const float mne = selbit ? mn : 1e30f;
#pragma unroll
            for (int r = 0; r < 16; ++r) { const float p0 = __builtin_amdgcn_exp2f(s0[r] - mne); s0[r] = p0; ps += p0; }
        } else {
            tmax = NEGBIG;
            float bv[16];
            int eb0 = ebase; asm volatile("" : "+v"(eb0));
#pragma unroll
            for (int r = 0; r < 16; ++r) { const int dist = __mul24(eb0 - ((r & 3) + 8 * (r >> 2) + 32 * hf), kmul) + rem; int dc = dist < 0 ? 0 : dist; dc = dc > 1023 ? 1023 : dc; bv[r] = tbh[dc]; }
#pragma unroll
            for (int r = 0; r < 16; ++r) asm volatile("" : "+v"(bv[r]));
#pragma unroll
            for (int r = 0; r < 16; ++r) { const int dist = __mul24(eb0 - ((r & 3) + 8 * (r >> 2) + 32 * hf), kmul) + rem;
                const bool valid = selbit && dist >= 0 && dist < dmax;
                const float x = valid ? s0[r] * C2 + bv[r] : NEGBIG;
                s0[r] = x; tmax = fmaxf(tmax, x); }
            tmax = halfmax(tmax);
            mn = fmaxf(m, tmax);
#pragma unroll
            for (int r = 0; r < 16; ++r) { const float p0 = s0[r] > -1e29f ? __builtin_amdgcn_exp2f(s0[r] - mn) : 0.f; s0[r] = p0; ps += p0; }
        }
        if (__any(mn != m)) {
            const float alpha = __builtin_amdgcn_exp2f(m - mn);
            l *= alpha;
#pragma unroll
            for (int c = 0; c < 2; ++c)
#pragma unroll
                for (int r = 0; r < 16; ++r) o[c][r] *= alpha;
        }
        m = mn;
        l += ps;
        u32x4 pw[2];
#pragma unroll
        for (int q = 0; q < 4; ++q) { pw[0][q] = pk2(s0[2 * q], s0[2 * q + 1]); pw[1][q] = pk2(s0[8 + 2 * q], s0[8 + 2 * q + 1]); }
#pragma unroll
        for (int c = 0; c < 2; ++c)
#pragma unroll
            for (int s2 = 0; s2 < 2; ++s2) { const int s = 2 * hf + s2; const s16x4 vl = vtr(vp0 + c * 4096 + s * 1024), vh = vtr(vp0 + c * 4096 + s * 1024 + 512);
                const bf16x8 vf = {vl[0], vl[1], vl[2], vl[3], vh[0], vh[1], vh[2], vh[3]};
                o[c] = MFMA32(vf, __builtin_bit_cast(bf16x8, pw[s2]), o[c]); }
    }
}

__device__ __forceinline__ void nsa_unit(const Frame& F, int b, int g, int qt) {
    unsigned char* ws = F.ws;
    const bf16* ZA = (const bf16*)(ws + WS_ZA);
    const int r32 = F.lane & 31, hi = F.lane >> 5, qi = r32 >> 2, hh = r32 & 3, head = g * 4 + hh;
    const int q0 = qt * 64, tq = q0 + 8 * F.wave + qi;
    const size_t zrow = (size_t)(b * SEQ + tq) * ZA_LD;
    const int srow = F.tid >> 3, sch = F.tid & 7;
    { const float* TBA = (const float*)(ws + WS_TBA) + (size_t)g * 4 * 1024; LAS float* tb = (LAS float*)(F.lds + NSA_TB);
      for (int i = F.tid; i < 4096; i += NTHR) tb[i] = TBA[i]; }
    const LAS float* tbh = (const LAS float*)(F.lds + NSA_TB) + hh * 1024;
    const int wq0 = q0 + 8 * F.wave;
    const float b31 = ((const float*)(ws + WS_TBA))[(size_t)head * 1024 + 1023];
    bf16x8 qr[4];
#pragma unroll
    for (int d0 = 0; d0 < 4; ++d0) qr[d0] = *(const bf16x8*)(ZA + zrow + ZC_QA + head * 64 + d0 * 16 + hi * 8);
    float gate[3];
#pragma unroll
    for (int i = 0; i < 3; ++i) gate[i] = sigmoidf_(bf2f(ZA[zrow + ZC_GNSA + head * 3 + i]));
    LAS float* ofw = (LAS float*)(F.lds + NSA_OF) + F.wave * 2048 + F.lane;
    unsigned mlo = 0u, mhi = 0u; float inv_cmp = 0.f;
    u32x4 kreg, vreg = {0u, 0u, 0u, 0u};
    const bf16* kgp; size_t vdel, tstep; bool vmap_ld;
#define NSA_SETUP(br_) do { const int b_ = (br_); const bf16* Kg_; size_t pitch_; int tl_; \
        if (b_ < 2) { Kg_ = (const bf16*)(ws + WS_KCMP) + (size_t)(b * 256) * 128 + g * 64; vdel = (size_t)((const bf16*)(ws + WS_VCMP) - (const bf16*)(ws + WS_KCMP)); pitch_ = 128; tl_ = 0; } \
        else { Kg_ = ZA + (size_t)(b * SEQ) * ZA_LD + (b_ == 2 ? ZC_KS : ZC_KW) + g * 64; vdel = 128; pitch_ = ZA_LD; tl_ = (b_ == 3 && qt > 8) ? qt - 8 : 0; } \
        kgp = Kg_ + (size_t)(tl_ * 64 + srow) * pitch_ + sch * 8; tstep = (size_t)64 * pitch_; vmap_ld = b_ == 1; } while (0)
#define NSA_GLOAD(kt_) do { kreg = *(const u32x4*)kgp; if (!vmap_ld) vreg = *(const u32x4*)(kgp + vdel); kgp += tstep; } while (0)
    NSA_SETUP(0); NSA_GLOAD(0);
#pragma nounroll
    for (int br = 0; br < 4; ++br) {
        const bool iscmp = br < 2, vmap = br == 1;
        const int t_lo = iscmp ? 0 : ((br == 3 && qt > 8) ? qt - 8 : 0), t_hi = iscmp ? ((q0 + 32) >> 10) : qt;
        const int kmul = iscmp ? 16 : 1, kadd = iscmp ? 31 : 0, dmax = br == 3 ? 512 : 0x40000000;
        f32x16 o[2]; o[0] = f32x16{}; o[1] = f32x16{};
        float m = NEGBIG, l = 0.f;
#define NSA_LSTORE(kt_, buf_) do { \
        *(LAS u32x4*)(F.lds + NSA_K + (buf_) * 8192 + sch * 1024 + srow * 16) = kreg; \
        if (vmap) { const int c_ = (kt_) * 64 + srow, jj_ = c_ >> 2, mm_ = c_ & 3; \
            _Pragma("unroll") for (int i_ = 0; i_ < 4; ++i_) { const int j0_ = sch * 8 + 2 * i_, j1_ = j0_ + 1; \
                const unsigned e0_ = (c_ < NCMP) ? (mm_ < 3 ? (j0_ == jj_ ? 0x4000u : 0u) : ((j0_ == jj_ || j0_ == jj_ + 1) ? 0x3F80u : 0u)) : 0u; \
                const unsigned e1_ = (c_ < NCMP) ? (mm_ < 3 ? (j1_ == jj_ ? 0x4000u : 0u) : ((j1_ == jj_ || j1_ == jj_ + 1) ? 0x3F80u : 0u)) : 0u; \
                vreg[i_] = e0_ | (e1_ << 16); } } \
        *(LAS u32x4*)(F.lds + NSA_V + (buf_) * 8192 + (sch >> 2) * 4096 + srow * 64 + (sch & 3) * 16) = vreg; } while (0)
        NSA_LSTORE(t_lo, 0);
        __syncthreads();
        int buf = 0;
#pragma nounroll
        for (int kt = t_lo; kt <= t_hi; ++kt) {
            const int ktn = kt + 1; const bool more = kt < t_hi;
            if (more) NSA_GLOAD(ktn);
            const bool selbit = br == 2 ? (((kt < 32 ? (mlo >> kt) : (mhi >> (kt - 32))) & 1u) != 0u) : true;
            int mode = 0;
            { const int dmin = wq0 - (64 * kt + 63), dmx = wq0 + 7 - 64 * kt;
              if (br == 2) mode = dmin >= 790 ? 2 : (dmin >= 0 ? 1 : 0);
              if (br < 2) mode = 16 * (((wq0 - 31) >> 4) - (64 * kt + 63)) >= 790 ? 2 : 0;
              if (br == 3) mode = (dmin >= 0 && dmx <= 511) ? 1 : 0; }
            if (__any(selbit))
            nsa_tile(F.lds + NSA_K + buf * 8192, F.lds + NSA_V + buf * 8192, tbh, qr, o, m, l, kt, tq, kmul, kadd, dmax, selbit, mode, b31, r32, hi, F.lane);
            if (more) NSA_LSTORE(ktn, buf ^ 1);
            __syncthreads();
            buf ^= 1;
        }
#undef NSA_LSTORE
        if (br < 3) { NSA_SETUP(br + 1); NSA_GLOAD(0); }
        l += __shfl_xor(l, 32);
        const float inv = l > 0.f ? 1.0f / l : 0.f;
        if (br == 0) inv_cmp = inv;
        if (br != 1) { const float sc = inv * (br == 0 ? gate[0] : br == 2 ? gate[1] : gate[2]);
#pragma unroll
            for (int c = 0; c < 2; ++c)
#pragma unroll
                for (int r = 0; r < 16; ++r) { const float prev = br == 0 ? 0.f : ofw[(c * 16 + r) * 64]; ofw[(c * 16 + r) * 64] = prev + o[c][r] * sc; }
        } else {
            LAS float* scw = (LAS float*)(F.lds + NSA_SC) + F.wave * 512;
#pragma unroll
            for (int c = 0; c < 2; ++c)
#pragma unroll
                for (int r = 0; r < 16; ++r) { float v = o[c][r] * inv_cmp;
                    v += __builtin_bit_cast(float, __builtin_amdgcn_update_dpp(0, __builtin_bit_cast(int, v), 0xB1, 0xf, 0xf, true));
                    v += __builtin_bit_cast(float, __builtin_amdgcn_update_dpp(0, __builtin_bit_cast(int, v), 0x4E, 0xf, 0xf, true));
                    if (hh == 0) scw[qi * 64 + 32 * c + crow(r, hi)] = v; }
            LDS_WAIT();
            LAS unsigned* mskw = (LAS unsigned*)(F.lds + NSA_MSK) + F.wave * 16;
#pragma nounroll
            for (int q = 0; q < 8; ++q) {
                const int curq = (q0 + 8 * F.wave + q) >> 6, j = F.lane;
                const bool avail = j <= curq, forced = (j == 0) || (j == curq) || (j == curq - 1);
                const float sj = avail ? scw[q * 64 + j] + (forced ? 1e4f : 0.f) : NEGBIG;
                int rank = 0; const int sjb = __builtin_bit_cast(int, sj);
#pragma unroll
                for (int j2 = 0; j2 < 64; ++j2) { const float s2 = __builtin_bit_cast(float, __builtin_amdgcn_readlane(sjb, j2)); rank += (s2 > sj || (s2 == sj && j2 < j)) ? 1 : 0; }
                const bool sel = rank < 16 && avail;
                const unsigned long long bm = __ballot(sel);
                if (F.lane == 0) { mskw[2 * q] = (unsigned)bm; mskw[2 * q + 1] = (unsigned)(bm >> 32); } }
            LDS_WAIT();
            mlo = mskw[2 * qi]; mhi = mskw[2 * qi + 1];
        }
    }
#undef NSA_GLOAD
#undef NSA_SETUP
    bf16* OA = (bf16*)(ws + WS_OA) + (size_t)(b * SEQ + tq) * 512 + head * 64;
#pragma unroll
    for (int c = 0; c < 2; ++c)
#pragma unroll
        for (int r4 = 0; r4 < 4; ++r4) { u32x2 w; w.x = pk2(ofw[(c * 16 + 4 * r4) * 64], ofw[(c * 16 + 4 * r4 + 1) * 64]); w.y = pk2(ofw[(c * 16 + 4 * r4 + 2) * 64], ofw[(c * 16 + 4 * r4 + 3) * 64]);
            *(u32x2*)(OA + 32 * c + 8 * r4 + 4 * hi) = w; }
}
__device__ __forceinline__ void phase3(const Frame& F) {
    const bool xcd = (F.G == 256);
    const int pstart = xcd ? (F.bx >> 3) : F.bx, pstep = xcd ? 32 : F.G, pend = xcd ? 64 : 512;
#pragma nounroll
    for (int p2 = 2 * pstart; p2 < 2 * pend; p2 += (p2 & 1) ? 2 * pstep - 1 : 1) { const int p = p2 >> 1;
        const int b = xcd ? (F.bx & 7) : (p >> 6), g = (p >> 5) & 1, qt = p & 31;
        nsa_unit(F, b, g, (p2 & 1) ? qt : 63 - qt); }
    __syncthreads();
}

#define MFMA16(a, b, c) __builtin_amdgcn_mfma_f32_16x16x32_bf16((a), (b), (c), 0, 0, 0)
constexpr int DSA_SCP = 8200;
constexpr int DSA_SC = 0;
constexpr int DSA_LIST = 16 * DSA_SCP;
constexpr int DSA_NSEL = DSA_LIST + 8192;
constexpr int DSA_BIAS = DSA_NSEL + 64;
constexpr int DSA_HIST = DSA_BIAS + 1088;
constexpr int DSA_BKI = DSA_HIST + 8192;
constexpr int KSEL = 256;
__device__ __forceinline__ unsigned dsa_offb(unsigned row, unsigned ch) { return 256u * row + 16u * (ch ^ (((row & 3u) << 2) | ((row >> 2) & 3u))); }
__device__ __forceinline__ unsigned sortkey16(float x) { x = x + 0.0f; const unsigned short h = __builtin_bit_cast(unsigned short, (_Float16)x); return (h & 0x8000u) ? (unsigned)(unsigned short)~h : (unsigned)(h | 0x8000u); }
__device__ __forceinline__ int prefix_cnt(unsigned long long b) { return (int)__builtin_amdgcn_mbcnt_hi((unsigned)(b >> 32), __builtin_amdgcn_mbcnt_lo((unsigned)b, 0u)); }

__device__ __forceinline__ void dsa_unit(const Frame& F, const Args& a, int b, int qt16) {
    unsigned char* ws = F.ws;
    const bf16* ZA = (const bf16*)(ws + WS_ZA);
    const int lane = F.lane, l16 = lane & 15, quad = lane >> 4, q0 = qt16 * 16;
    __syncthreads();
#ifndef PROBE_DSA
#define PROBE_DSA 0
#endif
    for (int rep1_ = 0; rep1_ < (PROBE_DSA == 1 ? 2 : 1); ++rep1_) {
        const size_t qrow = (size_t)(b * SEQ + q0 + l16) * ZA_LD;
        bf16x8 qf[4][2];
#pragma unroll
        for (int i = 0; i < 4; ++i)
#pragma unroll
            for (int ks = 0; ks < 2; ++ks) qf[i][ks] = *(const bf16x8*)(ZA + qrow + ZC_QIDX + i * 64 + 32 * ks + 8 * quad);
        float wq[4];
#pragma unroll
        for (int i = 0; i < 4; ++i) wq[i] = bf2f(ZA[qrow + ZC_WIDX + i]) * 0.0625f;
        const int tq = q0 + l16, nkt = qt16 + 1;
        const bf16* kbase = ZA + (size_t)(b * SEQ + l16) * ZA_LD + ZC_KIDX + 8 * quad;
        bf16x8 ka[4][2], kn[4][2];
#define DSA_KLOAD(dst, kt0_) do { _Pragma("unroll") for (int t_ = 0; t_ < 4; ++t_) { const int k_ = (kt0_) + 8 * t_; const int kc_ = k_ < nkt ? k_ : nkt - 1; \
            dst[t_][0] = *(const bf16x8*)(kbase + (size_t)(kc_ * 16) * ZA_LD); dst[t_][1] = *(const bf16x8*)(kbase + (size_t)(kc_ * 16) * ZA_LD + 32); } } while (0)
        if (F.wave < nkt) DSA_KLOAD(ka, F.wave);
#pragma nounroll
        for (int kt0 = F.wave; kt0 < nkt; kt0 += 32) {
            if (kt0 + 32 < nkt) DSA_KLOAD(kn, kt0 + 32);
#pragma unroll
            for (int t = 0; t < 4; ++t) { const int kt = kt0 + 8 * t;
                if (kt < nkt) {
                    float idx[4] = {0.f, 0.f, 0.f, 0.f};
#pragma unroll
                    for (int i = 0; i < 4; ++i) { f32x4 acc = {0.f, 0.f, 0.f, 0.f}; acc = MFMA16(ka[t][0], qf[i][0], acc); acc = MFMA16(ka[t][1], qf[i][1], acc);
#pragma unroll
                        for (int r = 0; r < 4; ++r) idx[r] += fmaxf(acc[r], 0.f) * wq[i]; }
                    unsigned k16[4];
#pragma unroll
                    for (int r = 0; r < 4; ++r) { const int key = kt * 16 + 4 * quad + r; k16[r] = key <= tq ? sortkey16(idx[r]) : 0u; }
                    u32x2 w; w.x = k16[0] | (k16[1] << 16); w.y = k16[2] | (k16[3] << 16);
                    *(LAS u32x2*)(F.lds + DSA_SC + l16 * DSA_SCP + (kt * 16 + 4 * quad) * 2) = w; } }
#pragma unroll
            for (int t = 0; t < 4; ++t) { ka[t][0] = kn[t][0]; ka[t][1] = kn[t][1]; }
        }
#undef DSA_KLOAD
    }
    if (F.tid < 264) { const float* rb = a.in[11]; ((LAS float*)(F.lds + DSA_BIAS))[F.tid] = F.tid < 256 ? rb[(F.tid >> 3) * 16 + 8 + (F.tid & 7)] * LOG2E : NEGBIG; }
    __syncthreads();
#pragma nounroll
    for (int qq = 0; qq < (PROBE_DSA == 2 ? 4 : 2); ++qq) {
        const int n = 2 * F.wave + (qq & 1), tq = q0 + n, N = tq + 1;
        LAS unsigned char* scq = F.lds + DSA_SC + n * DSA_SCP;
        LAS unsigned short* lst = (LAS unsigned short*)(F.lds + DSA_LIST) + n * 256;
        LAS unsigned short* bki = (LAS unsigned short*)(F.lds + DSA_BKI) + n * 256;
        if (N <= KSEL) {
            for (int s = lane; s < KSEL; s += 64) lst[s] = (unsigned short)(s < N ? s : 0);
            if (lane == 0) ((LAS int*)(F.lds + DSA_NSEL))[n] = N;
        } else {
            const int nit = (N + 255) >> 8;
            { const int it = nit - 1; const int s0 = 4 * (lane + 64 * it); u32x2 w = *(LAS u32x2*)(scq + s0 * 2);
              if (s0 + 0 > tq) w.x &= 0xffff0000u; if (s0 + 1 > tq) w.x &= 0x0000ffffu; if (s0 + 2 > tq) w.y &= 0xffff0000u; if (s0 + 3 > tq) w.y &= 0x0000ffffu;
              *(LAS u32x2*)(scq + s0 * 2) = w; }
            LDS_WAIT();
            LAS unsigned* hist = (LAS unsigned*)(F.lds + DSA_HIST) + F.wave * 256;
            unsigned T = 0u; int cgt = 0; int need = KSEL;
#pragma nounroll
            for (int lvl = 0; lvl < 2; ++lvl) {
                *(LAS u32x4*)(hist + 4 * lane) = (u32x4){0u, 0u, 0u, 0u};
                LDS_WAIT();
#pragma nounroll
                for (int it = 0; it < nit; ++it) { const u32x2 w = *(LAS u32x2*)(scq + (lane + 64 * it) * 8);
                    const unsigned k[4] = {w.x & 0xffffu, w.x >> 16, w.y & 0xffffu, w.y >> 16};
#pragma unroll
                    for (int e = 0; e < 4; ++e) { const bool in = lvl == 0 ? true : (k[e] >> 8) == (T >> 8); const unsigned bin = lvl == 0 ? (k[e] >> 8) : (k[e] & 255u);
                        if (in) __hip_atomic_fetch_add(hist + bin, 1u, __ATOMIC_RELAXED, __HIP_MEMORY_SCOPE_WORKGROUP); } }
                LDS_WAIT();
                const u32x4 h = *(LAS u32x4*)(hist + 4 * lane);
                const int sl = (int)(h.x + h.y + h.z + h.w); int suf = sl;
#pragma unroll
                for (int d = 1; d < 64; d <<= 1) { const int o = __shfl_down(suf, d); suf += (lane + d < 64) ? o : 0; }
                const int above = suf - sl;
                const bool here = above < need && above + sl >= need;
                int bsel = 4 * lane + 3, ca = above;
                if (ca + (int)h.w < need) { ca += (int)h.w; bsel = 4 * lane + 2; if (ca + (int)h.z < need) { ca += (int)h.z; bsel = 4 * lane + 1; if (ca + (int)h.y < need) { ca += (int)h.y; bsel = 4 * lane; } } }
                const unsigned long long bm = __ballot(here);
                const int src = bm ? (int)__builtin_ctzll(bm) : 0;
                const int B = __shfl(bsel, src), CA = __shfl(ca, src);
                if (lvl == 0) T = (unsigned)B << 8; else T |= (unsigned)B;
                cgt += CA; need -= CA;
                LDS_WAIT();
            }
            const int rties = KSEL - cgt;
            int tiebase = 0, outbase = 0;
#define DSA_PUT(pos_, idx_) do { const int p_ = (pos_); if (p_ >= 0 && p_ < KSEL) lst[p_] = (unsigned short)(idx_); } while (0)
#pragma nounroll
            for (int it = 0; it < nit; ++it) { const u32x2 w = *(LAS u32x2*)(scq + (lane + 64 * it) * 8);
                const unsigned k0 = w.x & 0xffffu, k1 = w.x >> 16, k2 = w.y & 0xffffu, k3 = w.y >> 16;
                const int sidx = 4 * (lane + 64 * it);
                const bool g0 = k0 > T, g1 = k1 > T, g2 = k2 > T, g3 = k3 > T;
                const unsigned long long bg0 = __ballot(g0), bg1 = __ballot(g1), bg2 = __ballot(g2), bg3 = __ballot(g3);
                if (bg0 | bg1 | bg2 | bg3) {
                    int pos = outbase + prefix_cnt(bg0) + prefix_cnt(bg1) + prefix_cnt(bg2) + prefix_cnt(bg3);
                    if (g0) { DSA_PUT(pos, sidx + 0); ++pos; }
                    if (g1) { DSA_PUT(pos, sidx + 1); ++pos; }
                    if (g2) { DSA_PUT(pos, sidx + 2); ++pos; }
                    if (g3) { DSA_PUT(pos, sidx + 3); ++pos; }
                    outbase += __popcll(bg0) + __popcll(bg1) + __popcll(bg2) + __popcll(bg3); }
                const bool e0 = k0 == T, e1 = k1 == T, e2 = k2 == T, e3 = k3 == T;
                const unsigned long long be0 = __ballot(e0), be1 = __ballot(e1), be2 = __ballot(e2), be3 = __ballot(e3);
                if ((be0 | be1 | be2 | be3) && tiebase < rties) {
                    const int t0 = tiebase + prefix_cnt(be0) + prefix_cnt(be1) + prefix_cnt(be2) + prefix_cnt(be3), t1 = t0 + (e0 ? 1 : 0), t2 = t1 + (e1 ? 1 : 0), t3 = t2 + (e2 ? 1 : 0);
                    if (e0 && t0 < rties) DSA_PUT(KSEL - 1 - t0, sidx + 0);
                    if (e1 && t1 < rties) DSA_PUT(KSEL - 1 - t1, sidx + 1);
                    if (e2 && t2 < rties) DSA_PUT(KSEL - 1 - t2, sidx + 2);
                    if (e3 && t3 < rties) DSA_PUT(KSEL - 1 - t3, sidx + 3);
                    tiebase += __popcll(be0) + __popcll(be1) + __popcll(be2) + __popcll(be3); } }
#undef DSA_PUT
            outbase = KSEL;
            if (lane == 0) ((LAS int*)(F.lds + DSA_NSEL))[n] = outbase < KSEL ? outbase : KSEL;
        }
        LDS_WAIT();
        { const int nsl = N < KSEL ? N : KSEL;
#pragma unroll
          for (int i = 0; i < 4; ++i) { const int e = lane + 64 * i; const int dist = tq - (int)lst[e];
              const int dpos = dist < 1 ? 1 : dist; int bl = 16 + (int)((__log2f((float)dpos) - 4.0f) * 2.66666675f); bl = bl > 31 ? 31 : bl;
              const int bk = dist < 1 ? 0 : (dpos < 16 ? dpos : bl);
              bki[e] = (unsigned short)(e < nsl ? bk * 32 : 1024); } }
    }
    LDS_WAIT();
    const bf16* CK = (const bf16*)(ws + WS_CKVN) + (size_t)(b * SEQ) * 128;
    LAS unsigned char* gb0 = F.lds + DSA_SC + (2 * F.wave) * DSA_SCP;
    const LAS unsigned char* biasb = F.lds + DSA_BIAS + (l16 & 7) * 4;
#define DSA_GATHER(chunk_, buf_) do { const unsigned key_ = lst[(chunk_) * 32 + (lane >> 1)]; const char* src_ = (const char*)CK + (key_ * 256u + (unsigned)(lane & 1) * 16u); \
        _Pragma("unroll") for (int c_ = 0; c_ < 8; ++c_) __builtin_amdgcn_global_load_lds((const unsigned*)(src_ + c_ * 32), (LAS unsigned*)(gb0 + (buf_) * 8192 + c_ * 1024), 16, 0, 0); } while (0)
    int tqs[2], nsels[2]; const LAS unsigned short* lsts[2]; const LAS unsigned short* bkis[2]; bf16x8 ql[2][4]; f32x4 o[2][8]; float ms[2], ls[2];
#pragma unroll
    for (int qq = 0; qq < 2; ++qq) { const int n = 2 * F.wave + qq; tqs[qq] = q0 + n; nsels[qq] = ((const LAS int*)(F.lds + DSA_NSEL))[n]; lsts[qq] = (const LAS unsigned short*)(F.lds + DSA_LIST) + n * 256; bkis[qq] = (const LAS unsigned short*)(F.lds + DSA_BKI) + n * 256;
#pragma unroll
        for (int s2 = 0; s2 < 4; ++s2) { const bf16x8 v = *(const bf16x8*)(ZA + (size_t)(b * SEQ + tqs[qq]) * ZA_LD + ZC_QLAT + (l16 & 7) * 128 + 32 * s2 + 8 * quad); ql[qq][s2] = l16 < 8 ? v : (bf16x8){0, 0, 0, 0, 0, 0, 0, 0}; }
#pragma unroll
        for (int c = 0; c < 8; ++c) o[qq][c] = (f32x4){0.f, 0.f, 0.f, 0.f};
        ms[qq] = NEGBIG; ls[qq] = 0.f; }
#pragma unroll
    for (int qq = 0; qq < 2; ++qq)
#pragma unroll
        for (int s2 = 0; s2 < 4; ++s2) asm volatile("" : "+v"(ql[qq][s2]));
    const int nch1 = (nsels[1] + 31) >> 5, nch = PROBE_DSA == 3 ? 2 * nch1 : nch1;
    LDS_WAIT();
    { const LAS unsigned short* lst = lsts[0]; DSA_GATHER(0, 0); }
    { const LAS unsigned short* lst = lsts[1]; DSA_GATHER(0, 1); }
    const unsigned offA = (unsigned)((quad >> 1) * 1024 + l16 * 32 + (quad & 1) * 16);
    const unsigned offT = (unsigned)((4 * quad + (l16 >> 2)) * 32 + 8 * (lane & 3));
#pragma nounroll
    for (int ch = 0; ch < nch; ++ch) {
#pragma unroll
        for (int qq = 0; qq < 2; ++qq) {
            const int chd = ch >= nch1 ? ch - nch1 : ch;
            const LAS unsigned short* lst = lsts[qq];
            const LAS unsigned char* gb = gb0 + qq * 8192;
            if (qq == 0 || ch + 1 < nch) asm volatile("s_waitcnt vmcnt(8)" ::: "memory"); else asm volatile("s_waitcnt vmcnt(0)" ::: "memory");
            f32x4 acc2[2]; float bvs[2][4];
#pragma unroll
            for (int rb = 0; rb < 2; ++rb) { f32x4 acc = {0.f, 0.f, 0.f, 0.f};
#pragma unroll
                for (int s2 = 0; s2 < 4; ++s2) { const bf16x8 af = *(const LAS bf16x8*)(gb + offA + rb * 512 + s2 * 2048); acc = MFMA16(af, ql[qq][s2], acc); }
                acc2[rb] = acc;
                const u32x2 kb = *(const LAS u32x2*)((const LAS unsigned char*)bkis[qq] + (chd * 32 + rb * 16 + 4 * quad) * 2);
                bvs[rb][0] = *(const LAS float*)(biasb + (kb.x & 0xffffu)); bvs[rb][1] = *(const LAS float*)(biasb + (kb.x >> 16));
                bvs[rb][2] = *(const LAS float*)(biasb + (kb.y & 0xffffu)); bvs[rb][3] = *(const LAS float*)(biasb + (kb.y >> 16)); }
#pragma unroll
            for (int rb = 0; rb < 2; ++rb)
#pragma unroll
                for (int r = 0; r < 4; ++r) asm volatile("" : "+v"(bvs[rb][r]));
            float x[2][4]; float tmax = NEGBIG;
#pragma unroll
            for (int rb = 0; rb < 2; ++rb)
#pragma unroll
                for (int r = 0; r < 4; ++r) { const float xv = acc2[rb][r] * C2 + bvs[rb][r]; x[rb][r] = xv; tmax = fmaxf(tmax, xv); }
            tmax = fmaxf(tmax, __shfl_xor(tmax, 16)); tmax = fmaxf(tmax, __shfl_xor(tmax, 32));
            const float mn = fmaxf(ms[qq], tmax); const bool resc = __any(mn != ms[qq]); const float alpha = __builtin_amdgcn_exp2f(ms[qq] - mn); ms[qq] = mn;
            float ps = 0.f;
#pragma unroll
            for (int rb = 0; rb < 2; ++rb)
#pragma unroll
                for (int r = 0; r < 4; ++r) { const float pv = __builtin_amdgcn_exp2f(x[rb][r] - mn); x[rb][r] = pv; ps += pv; }
            ls[qq] = ls[qq] * alpha + ps;
            if (resc) {
#pragma unroll
                for (int c = 0; c < 8; ++c) o[qq][c] = o[qq][c] * alpha; }
            u32x4 pw; pw.x = pk2(x[0][0], x[0][1]); pw.y = pk2(x[0][2], x[0][3]); pw.z = pk2(x[1][0], x[1][1]); pw.w = pk2(x[1][2], x[1][3]);
            const unsigned gba = (unsigned)(unsigned long long)gb + offT;
#pragma unroll
            for (int cb = 0; cb < 2; ++cb) {
                s16x4 v[8];
                if (cb == 0) asm volatile("ds_read_b64_tr_b16 %0, %8\n\tds_read_b64_tr_b16 %1, %8 offset:512\n\tds_read_b64_tr_b16 %2, %8 offset:1024\n\tds_read_b64_tr_b16 %3, %8 offset:1536\n\t"
                             "ds_read_b64_tr_b16 %4, %8 offset:2048\n\tds_read_b64_tr_b16 %5, %8 offset:2560\n\tds_read_b64_tr_b16 %6, %8 offset:3072\n\tds_read_b64_tr_b16 %7, %8 offset:3584\n\ts_waitcnt lgkmcnt(0)"
                             : "=&v"(v[0]), "=&v"(v[1]), "=&v"(v[2]), "=&v"(v[3]), "=&v"(v[4]), "=&v"(v[5]), "=&v"(v[6]), "=&v"(v[7]) : "v"(gba) : "memory");
                else asm volatile("ds_read_b64_tr_b16 %0, %8 offset:4096\n\tds_read_b64_tr_b16 %1, %8 offset:4608\n\tds_read_b64_tr_b16 %2, %8 offset:5120\n\tds_read_b64_tr_b16 %3, %8 offset:5632\n\t"
                             "ds_read_b64_tr_b16 %4, %8 offset:6144\n\tds_read_b64_tr_b16 %5, %8 offset:6656\n\tds_read_b64_tr_b16 %6, %8 offset:7168\n\tds_read_b64_tr_b16 %7, %8 offset:7680\n\ts_waitcnt lgkmcnt(0)"
                             : "=&v"(v[0]), "=&v"(v[1]), "=&v"(v[2]), "=&v"(v[3]), "=&v"(v[4]), "=&v"(v[5]), "=&v"(v[6]), "=&v"(v[7]) : "v"(gba) : "memory");
#pragma unroll
                for (int c4 = 0; c4 < 4; ++c4) { const int c = 4 * cb + c4; const s16x4 v0 = v[2 * c4], v1 = v[2 * c4 + 1];
                    const bf16x8 vf = {v0[0], v0[1], v0[2], v0[3], v1[0], v1[1], v1[2], v1[3]};
                    o[qq][c] = MFMA16(vf, __builtin_bit_cast(bf16x8, pw), o[qq][c]); }
            }
            LDS_WAIT();
            if (ch + 1 < nch) DSA_GATHER((ch + 1 >= nch1 ? ch + 1 - nch1 : ch + 1), qq);
        }
    }
#pragma unroll
    for (int qq = 0; qq < 2; ++qq) {
        float l = ls[qq]; const int tq = tqs[qq];
        l += __shfl_xor(l, 16); l += __shfl_xor(l, 32);
        const float inv = l > 0.f ? 1.0f / l : 0.f;
        if (l16 < 8) { bf16* op = (bf16*)(ws + WS_OLAT) + (size_t)(b * SEQ + tq) * 1024 + l16 * 128 + 4 * quad;
#pragma unroll
            for (int c = 0; c < 8; ++c) { u32x2 w; w.x = pk2(o[qq][c][0] * inv, o[qq][c][1] * inv); w.y = pk2(o[qq][c][2] * inv, o[qq][c][3] * inv); *(u32x2*)(op + 16 * c) = w; } }
    }
}
#undef DSA_GATHER
__device__ __forceinline__ void phase4(const Frame& F, const Args& a) {
    const bool xcd = (F.G == 256);
    const int pstart = xcd ? (F.bx >> 3) : F.bx, pstep = xcd ? 32 : F.G, pend = xcd ? 128 : 1024;
#pragma nounroll
    for (int p2 = 2 * pstart; p2 < 2 * pend; p2 += (p2 & 1) ? 2 * pstep - 1 : 1) { const int p = p2 >> 1;
        const int b = xcd ? (F.bx & 7) : (p >> 7), j = p & 127;
        dsa_unit(F, a, b, (p2 & 1) ? j : 255 - j); }
    __syncthreads();
}

constexpr int NPHASE = 11;
__global__ void __launch_bounds__(NTHR, 2) fwd_kernel(Args args) {
    extern __shared__ __attribute__((aligned(16))) unsigned char lds_raw[];
    Frame F;
    F.lds = (LAS unsigned char*)lds_raw;
    F.tid = threadIdx.x; F.lane = F.tid & 63; F.wave = __builtin_amdgcn_readfirstlane(F.tid >> 6);
    F.G = gridDim.x; F.bx = blockIdx.x; F.ws = args.ws;
    unsigned char* ws = args.ws;
    volatile LAS unsigned* MISC = (volatile LAS unsigned*)(F.lds + MISC_OFF);
    if (F.tid < 64) MISC[F.tid] = 0u;
    __syncthreads();
    const int lo = args.ph_lo, hi = args.ph_hi;
    XcdBarrier bar; bar.bar = (unsigned*)(ws + WS_CTL) + CW_BAR; bar.x = 0; bar.st = nullptr;
    if (hi - lo > 1) bar = xcd_barrier_post((unsigned*)(ws + WS_CTL) + CW_BAR, MISC + 8);
#ifndef PH_MASK
#define PH_MASK 0xFFFF
#endif
#define IN(k) ((((PH_MASK) >> (k)) & 1) && lo <= (k) && (k) < hi)
#define SEAM(k) do { if (IN(k) && IN((k) + 1)) xcd_barrier(bar); } while (0)
#ifndef PROBE_PHASE
#define PROBE_PHASE -1
#endif
#define REPEAT(k) for (int rep_ = 0; rep_ < ((PROBE_PHASE) == (k) ? 2 : 1); ++rep_, ((PROBE_PHASE) == (k) && rep_ < 2 ? xcd_barrier(bar) : (void)0))

    if (IN(0)) REPEAT(0) { phase0(F, args); }
    SEAM(0);
    if (IN(1)) REPEAT(1) {
        pg8::StaticOrder S; S.init(NTOK / 256, NZ / 256, F.G, F.bx);
        const APlain AA{ws + WS_XB, 128u, (unsigned)(D * 2)}; const BPlain BA{(const bf16*)(ws + WS_WINT), D};
        const EpiZ E{(bf16*)(ws + WS_ZA), (bf16*)(ws + WS_ZG)};
        pg8::gemm_phase(F.lds, D, S, AA, BA, E);
        { const int nu = (NTOK / 256) * (NZ / 256), rem = nu % F.G;
          if (rem != 0 && F.bx >= rem) p0_experts(F, args, (F.bx - rem) * NWAVES + F.wave, (F.G - rem) * NWAVES, 0, P0_EXP_ITEMS); }
    }
    SEAM(1);
    if (IN(2)) REPEAT(2) { phase2(F, args); }
    SEAM(2);
    if (IN(3)) REPEAT(3) { phase3(F); }
    if (IN(4)) REPEAT(4) { phase4(F, args); }
    SEAM(4);
    if (IN(5)) REPEAT(5) {
        pg8::StaticOrder S; S.init(NTOK / 256, D / 256, F.G, F.bx);
        { const APlain AA{ws + WS_OA, 128u, 1024u}; const BPlain BA{(const bf16*)(ws + WS_WAT), 512};
          const EpiGate<0> E{(const bf16*)(ws + WS_ZG), nullptr, (bf16*)(ws + WS_T1)};
          pg8::gemm_phase(F.lds, 512, S, AA, BA, E); }
        { const APlain AA{ws + WS_OLAT, 128u, 2048u}; const BPlain BA{(const bf16*)(ws + WS_WBT), 1024};
          const EpiGate<1> E{(const bf16*)(ws + WS_ZG), (const bf16*)(ws + WS_T1), (bf16*)(ws + WS_MERGED)};
          pg8::gemm_phase(F.lds, 1024, S, AA, BA, E); }
    }
    SEAM(5);
    if (IN(6)) REPEAT(6) {
        pg8::StaticOrder S; S.init(NTOK / 256, D / 256, F.G, F.bx);
        const APlain AA{ws + WS_MERGED, 128u, 2048u}; const BPlain BA{(const bf16*)(ws + WS_WOT), 1024};
        const EpiRes E{args.in[0], (bf16*)(ws + WS_H1)};
        pg8::gemm_phase(F.lds, 1024, S, AA, BA, E);
    }
    SEAM(6);
    if (IN(7)) { phase6(F, args); }
    SEAM(7);
    if (IN(8)) REPEAT(8) {
        moe_setup(F);
        const MoeOrder S{F.G, F.bx, 2, (const LAS int*)(F.lds + MOE_CUM), (const LAS int*)(F.lds + MOE_CUM) + 40};
        const AGather AA{ws + WS_H1B, 128u, (const int*)(ws + WS_LIST)}; const BGu BA{(const bf16*)(ws + WS_WGU)};
        const EpiAct E{(bf16*)(ws + WS_ACT)};
        pg8::gemm_phase(F.lds, 1024, S, AA, BA, E);
    }
    SEAM(8);
    if (IN(9)) REPEAT(9) {
        moe_setup(F);
        const MoeOrder S{F.G, F.bx, 4, (const LAS int*)(F.lds + MOE_CUM), (const LAS int*)(F.lds + MOE_CUM) + 40};
        const APlain AA{ws + WS_ACT, 128u, 512u}; const BDn BA{(const bf16*)(ws + WS_WDT)};
        const EpiDown E{(bf16*)(ws + WS_YBUF), (const int*)(ws + WS_LIST)};
        pg8::gemm_phase(F.lds, 256, S, AA, BA, E);
    }
    SEAM(9);
    if (IN(10)) REPEAT(10) { phase9(F, args); }
#undef IN
#undef SEAM
#undef REPEAT
}

extern "C" void kernel_launch(void* const* d_in, const int* in_sizes, int n_in, void* d_out, int out_size, void* d_ws, size_t ws_size, hipStream_t stream) {
    static int grid = 0;
    if (grid == 0) {
        if (n_in != 26 || in_sizes[0] != NTOK * D || out_size != NTOK * D || ws_size < WS_END) {
            fprintf(stderr, "kernel_launch: unexpected problem: n_in %d in0 %d out %d ws %zu (need %zu)\n", n_in, n_in > 0 ? in_sizes[0] : -1, out_size, ws_size, (size_t)WS_END); grid = -1; return; }
        int dev = 0, cus = 0, per_cu = 0;
        if (hipGetDevice(&dev) != hipSuccess || hipDeviceGetAttribute(&cus, hipDeviceAttributeMultiprocessorCount, dev) != hipSuccess) { grid = -1; return; }
        if (hipFuncSetAttribute((const void*)fwd_kernel, hipFuncAttributeMaxDynamicSharedMemorySize, LDS_BYTES) != hipSuccess) { fprintf(stderr, "kernel_launch: hipFuncSetAttribute failed\n"); grid = -1; return; }
        if (hipOccupancyMaxActiveBlocksPerMultiprocessor(&per_cu, (const void*)fwd_kernel, NTHR, LDS_BYTES) != hipSuccess || per_cu < 1)
            fprintf(stderr, "kernel_launch: occupancy query reports %d\n", per_cu);
        (void)hipGetLastError();
        grid = cus;
    }
    if (grid < 0) return;
    if (hipMemsetAsync((char*)d_ws + WS_CTL, 0, CTL_ZERO_BYTES, stream) != hipSuccess) return;
    Args a{};
    for (int i = 0; i < 26; ++i) a.in[i] = (const float*)d_in[i];
    a.out = (float*)d_out; a.ws = (unsigned char*)d_ws;
#if MK_PER_PHASE
    for (int p = 0; p < NPHASE; ++p) { a.ph_lo = p; a.ph_hi = p + 1; hipLaunchKernelGGL(fwd_kernel, dim3(grid), dim3(NTHR), LDS_BYTES, stream, a); }
#else
    a.ph_lo = 0; a.ph_hi = NPHASE;
    hipLaunchKernelGGL(fwd_kernel, dim3(grid), dim3(NTHR), LDS_BYTES, stream, a);
#endif
}
```

```cpp
#include <hip/hip_runtime.h>
#include <cstdio>
#include <cstdint>

#ifndef MK_PER_PHASE
#define MK_PER_PHASE 0
#endif

#define GAS __attribute__((address_space(1)))
#define LAS __attribute__((address_space(3)))
typedef unsigned short bf16;
typedef short bf16x8 __attribute__((ext_vector_type(8)));
typedef short s16x4 __attribute__((ext_vector_type(4)));
typedef float f32x4 __attribute__((ext_vector_type(4)));
typedef float f32x16 __attribute__((ext_vector_type(16)));
typedef float f32x2 __attribute__((ext_vector_type(2)));
typedef unsigned u32x4 __attribute__((ext_vector_type(4)));
typedef unsigned u32x2 __attribute__((ext_vector_type(2)));

constexpr int D = 1024, BATCH = 8, SEQ = 4096, NTOK = BATCH * SEQ;
constexpr int D_IN = 4316;
constexpr int NCMP = 255;
constexpr float ALPHA = 1.189207115002721f;
constexpr float LOG2E = 1.4426950408889634f;
constexpr float NEGBIG = -1e30f;
constexpr int ZA_LD = 2816;
constexpr int ZC_QA = 0, ZC_KC = 512, ZC_VC = 640, ZC_KS = 768, ZC_VS = 896, ZC_KW = 1024, ZC_VW = 1152, ZC_QLAT = 1280, ZC_CKV = 2304,
              ZC_QIDX = 2432, ZC_KIDX = 2688, ZC_GNSA = 2752, ZC_WIDX = 2776;
constexpr int ZG_LD = 2048;
constexpr int NZ = ZA_LD + ZG_LD;
constexpr int NEXP = 32, DEXP = 256;
constexpr int MAXTILES = (2 * NTOK) / 256 + NEXP;

constexpr size_t MiB = 1u << 20;
constexpr size_t WS_CTL = 0, CTL_ZERO_BYTES = 1 * MiB;
constexpr size_t WS_WAT = 1 * MiB;
constexpr size_t WS_WBT = 2 * MiB;
constexpr size_t WS_WOT = 4 * MiB;
constexpr size_t WS_W1K = 6 * MiB;
constexpr size_t WS_W1V = 7 * MiB;
constexpr size_t WS_W2K = 8 * MiB;
constexpr size_t WS_W2V = 8 * MiB + 64 * 1024;
constexpr size_t WS_BIASK = 8 * MiB + 128 * 1024;
constexpr size_t WS_TBA = 8 * MiB + 256 * 1024;
constexpr size_t WS_TBB = 8 * MiB + 320 * 1024;
constexpr size_t WS_KCMP = 9 * MiB;
constexpr size_t WS_VCMP = 9 * MiB + 512 * 1024;
constexpr size_t WS_TOKINFO = 10 * MiB;
constexpr size_t WS_LIST = 11 * MiB;
constexpr size_t WS_WINT = 16 * MiB;
constexpr size_t WS_WGU = 32 * MiB;
constexpr size_t WS_WDT = 64 * MiB;
constexpr size_t WS_CKVN = 80 * MiB;
constexpr size_t WS_XB = 96 * MiB;
constexpr size_t WS_OLAT = 96 * MiB;
constexpr size_t WS_H1B = 96 * MiB;
constexpr size_t WS_ZA = 160 * MiB;
constexpr size_t WS_T1 = 160 * MiB;
constexpr size_t WS_ACT = 160 * MiB;
constexpr size_t WS_YBUF = 196 * MiB;
constexpr size_t WS_MERGED = 224 * MiB;
constexpr size_t WS_ZG = 336 * MiB;
constexpr size_t WS_H1 = 336 * MiB;
constexpr size_t WS_OA = 464 * MiB;
constexpr size_t WS_END = 496 * MiB;

constexpr int CW_BAR = 4096;
constexpr int CW_CNT = 16384;

constexpr int LDS_BYTES = 163840;
constexpr int MISC_OFF = 160 * 1024 - 256;

__device__ __forceinline__ unsigned f2bf(float f) { unsigned u = __builtin_bit_cast(unsigned, f); return (u + 0x7fffu + ((u >> 16) & 1u)) >> 16; }
__device__ __forceinline__ unsigned pk2(float lo, float hi) { unsigned r; asm volatile("v_cvt_pk_bf16_f32 %0, %1, %2" : "=v"(r) : "v"(lo), "v"(hi)); return r; }
__device__ __forceinline__ float bf2f(unsigned short b) { return __builtin_bit_cast(float, ((unsigned)b) << 16); }
__device__ __forceinline__ float bflo(unsigned w) { return __builtin_bit_cast(float, w << 16); }
__device__ __forceinline__ float bfhi(unsigned w) { return __builtin_bit_cast(float, w & 0xffff0000u); }
__device__ __forceinline__ float wave_sum(float v) {
#pragma unroll
    for (int o = 1; o < 64; o <<= 1) v += __shfl_xor(v, o);
    return v;
}
__device__ __forceinline__ float sigmoidf_(float x) { return __builtin_amdgcn_rcpf(1.0f + __builtin_amdgcn_exp2f(-1.4426950408889634f * x)); }
#define LDS_WAIT() asm volatile("s_waitcnt lgkmcnt(0)" ::: "memory")
#define VM_WAIT() asm volatile("s_waitcnt vmcnt(0)" ::: "memory")

#define XB_TMO      128
#define XB_XCNT(j)  (256  + 64 * (j))
#define XB_XSUB(j)  (1280 + 64 * (j))
#define XB_XGEN(j)  (2304 + 64 * (j))
#define XB_TOP      3328
#define XB_TOPGEN   3392
#define XCD_BAR_WORDS 3456
#define XB_SPIN_CAP (1u << 18)
__device__ __forceinline__ unsigned xb_ld(unsigned* p)              { return __hip_atomic_load(p, __ATOMIC_RELAXED, __HIP_MEMORY_SCOPE_AGENT); }
__device__ __forceinline__ unsigned xb_add(unsigned* p, unsigned v) { return __hip_atomic_fetch_add(p, v, __ATOMIC_RELAXED, __HIP_MEMORY_SCOPE_AGENT); }
__device__ __forceinline__ unsigned xb_xcc_id() { return (unsigned)__builtin_amdgcn_s_getreg((3 << 11) | 20) & 0xFu; }
#define XB_SPIN(cond, bar) do { unsigned _sp = 0; while (cond) { __builtin_amdgcn_s_sleep(1); \
    if ((++_sp & 255u) == 0u) { if (xb_ld(&(bar)[XB_TMO])) break; if (_sp > XB_SPIN_CAP) { atomicAdd(&(bar)[XB_TMO], 1u); break; } } } } while (0)
struct XcdBarrier { unsigned* bar; unsigned x; volatile LAS unsigned* st; };
__device__ __forceinline__ XcdBarrier xcd_barrier_post(unsigned* bar, volatile LAS unsigned* st) {
    XcdBarrier b; b.bar = bar; b.x = xb_xcc_id(); b.st = st;
    if (threadIdx.x == 0) (void)xb_add(&bar[XB_XCNT(b.x)], 1u);
    return b;
}
__device__ __forceinline__ void xcd_barrier_complete(unsigned* bar, unsigned x, unsigned& nloc, unsigned& nx) {
    const unsigned G = gridDim.x * gridDim.y * gridDim.z;
    unsigned sum, cnt, mine, sp = 0u;
    for (;;) {
        sum = 0u; cnt = 0u; mine = 0u;
#pragma unroll
        for (unsigned j = 0; j < 16; ++j) { const unsigned c = xb_ld(&bar[XB_XCNT(j)]); sum += c; cnt += (c > 0u) ? 1u : 0u; mine = (j == x) ? c : mine; }
        if (sum == G) break;
        __builtin_amdgcn_s_sleep(1);
        if ((++sp & 255u) == 0u) { if (xb_ld(&bar[XB_TMO])) break; if (sp > XB_SPIN_CAP) { atomicAdd(&bar[XB_TMO], 1u); break; } }
    }
    nloc = mine > 0u ? mine : 1u; nx = cnt > 0u ? cnt : 1u;
}
__device__ __forceinline__ void xcd_barrier(const XcdBarrier& b) {
    asm volatile("s_waitcnt vmcnt(0)" ::: "memory");
    __syncthreads();
    if (threadIdx.x == 0) {
        unsigned* bar = b.bar;
        __builtin_amdgcn_s_waitcnt(0);
        unsigned nloc = b.st[0], nx = b.st[1];
        if (nloc == 0u) { xcd_barrier_complete(bar, b.x, nloc, nx); b.st[0] = nloc; b.st[1] = nx; }
        const unsigned old = xb_add(&bar[XB_XSUB(b.x)], 1u);
        const unsigned gen = old / nloc;
        if (old + 1u == (gen + 1u) * nloc) {
            __builtin_amdgcn_fence(__ATOMIC_RELEASE, "agent");
            asm volatile("s_waitcnt vmcnt(0)" ::: "memory");
            const unsigned og = xb_add(&bar[XB_TOP], 1u);
            const unsigned tg = og / nx;
            if (og + 1u == (tg + 1u) * nx) xb_add(&bar[XB_TOPGEN], 1u);
            else XB_SPIN(xb_ld(&bar[XB_TOPGEN]) == tg, bar);
            __builtin_amdgcn_fence(__ATOMIC_ACQUIRE, "agent");
            xb_add(&bar[XB_XGEN(b.x)], 1u);
            asm volatile("s_waitcnt vmcnt(0)" ::: "memory");
        } else {
            XB_SPIN(xb_ld(&bar[XB_XGEN(b.x)]) == gen, bar);
            __builtin_amdgcn_fence(__ATOMIC_ACQUIRE, "agent");
            asm volatile("s_waitcnt vmcnt(0)" ::: "memory");
        }
    }
    __syncthreads();
}

namespace pg8 {
constexpr int BM = 256, BK = 64, HALF = 128, HTB = HALF * BK * 2, STAGE_BYTES = 8 * HTB, NXCD = 8, WGM = 8;
__host__ __device__ __forceinline__ int lds_byte(int r, int c) { const int st = (r >> 4) * 2 + (c >> 5), rr = r & 15, cc = c & 31, ob = rr * 64 + cc * 2; return st * 1024 + (ob ^ (((ob >> 9) & 1) << 5)); }
__host__ __device__ __forceinline__ void stage_rc(int b, int& R, int& C) { const int st = b / 1024, sb = b % 1024, swz = sb ^ (((sb >> 9) & 1) << 5); R = (st >> 1) * 16 + swz / 64; C = (st & 1) * 32 + (swz % 64) / 2; }
__host__ __device__ __forceinline__ int perm32(int rho) { const int n = rho >> 4, i = rho & 15; return 8 * (i >> 2) + 4 * n + (i & 3); }
struct Unit { int pm, pn, e, nrows; };
struct StaticOrder {
    int nM, nN, nwg, G, c, dup;
    __device__ void init(int nM_, int nN_, int G_, int c_, int dup_ = 1) { nM = nM_; nN = nN_; nwg = nM * nN; G = G_; c = c_; dup = dup_; }
    __device__ bool next(int i, Unit& u) const {
        const long L0 = (long)i * G + c; if (L0 >= (long)nwg * dup) return false;
        const long L = L0 % nwg;
        int wgid = (int)L; { const int q = nwg / NXCD, r = nwg % NXCD, xcd = wgid % NXCD, off = wgid / NXCD; wgid = (xcd < r ? xcd * (q + 1) : r * (q + 1) + (xcd - r) * q) + off; }
        const int nig = WGM * nN, gid = wgid / nig, fm = gid * WGM, gsz = (nM - fm) < WGM ? (nM - fm) : WGM;
        u.pm = fm + ((wgid % nig) % gsz); u.pn = (wgid % nig) / gsz; u.e = 0; u.nrows = 256; return true;
    }
};

template <class Epi, class Sched, class AAddr, class BAddr>
__device__ __forceinline__ void gemm_phase(LAS unsigned char* lds, const int K, const Sched& S, const AAddr& AA, const BAddr& BA, const Epi& E) {
    constexpr bool GA = AAddr::GATHER;
    const int tid = threadIdx.x, wid = __builtin_amdgcn_readfirstlane(tid >> 6), lane = tid & 63, wr = wid >> 2, wc = wid & 3, fr = lane & 15, fq = lane >> 4;
    const int nt = K / BK;
    unsigned voffA[2], voffB[2];
#pragma unroll
    for (int i = 0; i < 2; ++i) { int R, C; stage_rc(tid * 16 + i * 8192, R, C); const int Rb = Epi::PERM ? ((R & ~31) + perm32(R & 31)) : R;
        voffA[i] = GA ? 0u : AA.lane_off(R, C); voffB[i] = (unsigned)(Rb * K + C) * 2u; }
    const size_t kstepA = (size_t)AA.kstep, kstepB = (size_t)(BK * 2);
    const size_t hstepB = (size_t)HALF * K * 2, hstepA = GA ? 0 : AA.hstep();
    const unsigned ldsw = (unsigned)wid * 1024u;
    const int aoff = lds_byte(wr * 64 + fr, fq * 8), boff = lds_byte(wc * 32 + fr, fq * 8);
#define PG8_SA(b, h) (((b) * 2 + (h)) * HTB)
#define PG8_SB(b, h) ((4 + (b) * 2 + (h)) * HTB)
#define PG8_STAGE(bufoff, gbase, voff) do { _Pragma("unroll") for (int _i = 0; _i < 2; ++_i) \
        __builtin_amdgcn_global_load_lds((const unsigned*)((const char*)(gbase) + (voff)[_i]), (LAS unsigned*)(lds + (bufoff) + ldsw + _i * 8192), 16, 0, 0); } while (0)
#define PG8_STA_CUR(bufoff, h, kb) do { if constexpr (GA) { if (h) PG8_STAGE(bufoff, baseA + (kb), cof1); else PG8_STAGE(bufoff, baseA + (kb), cof0); } \
        else PG8_STAGE(bufoff, cA + (h) * hstepA + (kb), voffA); } while (0)
#define PG8_STA_SEL(bufoff, h, kb) do { if constexpr (GA) { if (h) PG8_STAGE(bufoff, baseA + (kb), sof1); else PG8_STAGE(bufoff, baseA + (kb), sof0); } \
        else PG8_STAGE(bufoff, sA + (h) * hstepA + (kb), voffA); } while (0)
#define PG8_LDA(dst, b, h) do { _Pragma("unroll") for (int m = 0; m < 4; ++m) _Pragma("unroll") for (int k = 0; k < 2; ++k) dst[m][k] = *(const LAS bf16x8*)(lds + PG8_SA(b, h) + aoff + m * 2048 + k * 1024); } while (0)
#define PG8_LDB(dst, b, h) do { _Pragma("unroll") for (int n = 0; n < 2; ++n) _Pragma("unroll") for (int k = 0; k < 2; ++k) dst[n][k] = *(const LAS bf16x8*)(lds + PG8_SB(b, h) + boff + n * 2048 + k * 1024); } while (0)
#define PG8_MMA(ai, bj, At, Bt) do { __builtin_amdgcn_s_setprio(1); _Pragma("unroll") for (int m = 0; m < 4; ++m) _Pragma("unroll") for (int n = 0; n < 2; ++n) _Pragma("unroll") for (int k = 0; k < 2; ++k) \
        acc[ai][bj][m][n] = __builtin_amdgcn_mfma_f32_16x16x32_bf16(Bt[n][k], At[m][k], acc[ai][bj][m][n], 0, 0, 0); __builtin_amdgcn_s_setprio(0); } while (0)
#define PG8_WAIT_V(n) asm volatile("s_waitcnt vmcnt(" #n ")" ::: "memory")
#define PG8_WAIT_L(n) asm volatile("s_waitcnt lgkmcnt(" #n ")" ::: "memory")
#define PG8_BAR __builtin_amdgcn_s_barrier()
#define PG8_SCHED __builtin_amdgcn_sched_barrier(0)
#define PG8_GOFF(u, o0, o1) do { _Pragma("unroll") for (int _i = 0; _i < 2; ++_i) { int R_, C_; stage_rc(tid * 16 + _i * 8192, R_, C_); \
        o0[_i] = AA.row_off(u, R_) + (unsigned)C_ * 2u; o1[_i] = AA.row_off(u, R_ + HALF) + (unsigned)C_ * 2u; } } while (0)
    Unit cur, nxt; int ui = 0;
    if (!S.next(0, cur)) return;
    f32x4 acc[2][2][4][2];
#pragma unroll
    for (int a = 0; a < 2; ++a)
#pragma unroll
        for (int b = 0; b < 2; ++b)
#pragma unroll
            for (int m = 0; m < 4; ++m)
#pragma unroll
                for (int n = 0; n < 2; ++n) acc[a][b][m][n] = (f32x4){0.f, 0.f, 0.f, 0.f};
    bf16x8 At[4][2], B0[2][2], B1[2][2];
    const char* const baseA = GA ? (const char*)AA.base : nullptr;
    const char* cA = GA ? nullptr : (const char*)AA.unit_ptr(cur);
    unsigned cof0[2] = {0u, 0u}, cof1[2] = {0u, 0u}, nof0[2] = {0u, 0u}, nof1[2] = {0u, 0u};
    if constexpr (GA) PG8_GOFF(cur, cof0, cof1);
    const char* cB = (const char*)BA.ptr(cur);
    PG8_STAGE(PG8_SB(0, 0), cB, voffB); PG8_STA_CUR(PG8_SA(0, 0), 0, 0); PG8_STAGE(PG8_SB(0, 1), cB + hstepB, voffB); PG8_STA_CUR(PG8_SA(0, 1), 1, 0);
    if (wr == 1) PG8_BAR;
    PG8_WAIT_V(4); PG8_BAR;
    PG8_STAGE(PG8_SB(1, 0), cB + kstepB, voffB); PG8_STA_CUR(PG8_SA(1, 0), 0, kstepA); PG8_STAGE(PG8_SB(1, 1), cB + hstepB + kstepB, voffB);
    PG8_WAIT_V(6); PG8_BAR;
    for (;;) {
        const bool has_next = S.next(ui + 1, nxt);
        const char* nB = cB; const char* nA = cA;
        if (has_next) { nB = (const char*)BA.ptr(nxt); if constexpr (GA) PG8_GOFF(nxt, nof0, nof1); else nA = (const char*)AA.unit_ptr(nxt); }
        else { if constexpr (GA) {
#pragma unroll
            for (int i = 0; i < 2; ++i) { nof0[i] = cof0[i]; nof1[i] = cof1[i]; } } }
#pragma nounroll
        for (int t = 0; t < nt; t += 2) {
            const bool last = (t == nt - 2);
            const size_t k1 = (size_t)(t + 1) * kstepA, k2 = last ? 0 : (size_t)(t + 2) * kstepA, k3 = k2 + kstepA;
            const char* b2 = last ? nB : cB + (size_t)(t + 2) * kstepB; const char* b3 = b2 + kstepB;
            const char* sA = last ? nA : cA;
            unsigned sof0[2], sof1[2];
#pragma unroll
            for (int i = 0; i < 2; ++i) { sof0[i] = last ? nof0[i] : cof0[i]; sof1[i] = last ? nof1[i] : cof1[i]; }
            PG8_LDB(B0, 0, 0); PG8_SCHED; PG8_LDA(At, 0, 0); PG8_STA_CUR(PG8_SA(1, 1), 1, k1);
            PG8_WAIT_L(8); PG8_BAR; PG8_WAIT_L(0); PG8_MMA(0, 0, At, B0); PG8_BAR; PG8_SCHED;
            PG8_LDB(B1, 0, 1); PG8_STAGE(PG8_SB(0, 0), b2, voffB);
            PG8_BAR; PG8_WAIT_L(0); PG8_MMA(0, 1, At, B1); PG8_BAR;
            PG8_LDA(At, 0, 1); PG8_STA_SEL(PG8_SA(0, 0), 0, k2);
            PG8_BAR; PG8_WAIT_L(0); PG8_MMA(1, 0, At, B0); PG8_BAR; PG8_SCHED;
            PG8_STAGE(PG8_SB(0, 1), b2 + hstepB, voffB);
            PG8_WAIT_V(6); PG8_BAR; PG8_MMA(1, 1, At, B1); PG8_BAR;
            PG8_LDB(B0, 1, 0); PG8_SCHED; PG8_LDA(At, 1, 0); PG8_STA_SEL(PG8_SA(0, 1), 1, k2);
            PG8_WAIT_L(8); PG8_BAR; PG8_WAIT_L(0); PG8_MMA(0, 0, At, B0); PG8_BAR; PG8_SCHED;
            PG8_LDB(B1, 1, 1); PG8_STAGE(PG8_SB(1, 0), b3, voffB);
            PG8_BAR; PG8_WAIT_L(0); PG8_MMA(0, 1, At, B1); PG8_BAR;
            PG8_LDA(At, 1, 1); PG8_STA_SEL(PG8_SA(1, 0), 0, k3);
            PG8_BAR; PG8_WAIT_L(0); PG8_MMA(1, 0, At, B0); PG8_BAR; PG8_SCHED;
            PG8_STAGE(PG8_SB(1, 1), b3 + hstepB, voffB);
            PG8_WAIT_V(6); PG8_BAR; PG8_MMA(1, 1, At, B1); PG8_BAR;
        }
        E(acc, cur, wr, wc, fr, fq);
        if (!has_next) break;
#pragma unroll
        for (int a = 0; a < 2; ++a)
#pragma unroll
            for (int b = 0; b < 2; ++b)
#pragma unroll
                for (int m = 0; m < 4; ++m)
#pragma unroll
                    for (int n = 0; n < 2; ++n) acc[a][b][m][n] = (f32x4){0.f, 0.f, 0.f, 0.f};
        cur = nxt; cB = nB; cA = nA; ++ui;
        if constexpr (GA) {
#pragma unroll
            for (int i = 0; i < 2; ++i) { cof0[i] = nof0[i]; cof1[i] = nof1[i]; } }
    }
    PG8_WAIT_V(0);
    if (wr == 0) PG8_BAR;
    PG8_BAR;
#undef PG8_SA
#undef PG8_SB
#undef PG8_STAGE
#undef PG8_STA_CUR
#undef PG8_STA_SEL
#undef PG8_GOFF
#undef PG8_LDA
#undef PG8_LDB
#undef PG8_MMA
#undef PG8_WAIT_V
#undef PG8_WAIT_L
#undef PG8_BAR
#undef PG8_SCHED
}
}

constexpr int NWAVES = 8, NTHR = 512;
struct Args { const float* in[26]; float* out; unsigned char* ws; int ph_lo, ph_hi; unsigned repmask; int pad; };
struct Frame {
    LAS unsigned char* lds;
    int tid, lane, wave, G, bx;
    unsigned char* ws;
};

struct APlain { const void* base; unsigned kstep; unsigned ld2;
    static constexpr bool GATHER = false;
    __device__ __forceinline__ const void* unit_ptr(const pg8::Unit& u) const { return (const char*)base + (size_t)u.pm * 256 * ld2; }
    __device__ __forceinline__ unsigned lane_off(int R, int C) const { return (unsigned)R * ld2 + (unsigned)C * 2u; }
    __device__ __forceinline__ size_t hstep() const { return (size_t)128 * ld2; }
    __device__ __forceinline__ unsigned row_off(const pg8::Unit&, int) const { return 0u; } };
struct BPlain { const bf16* Bt; int K;
    __device__ __forceinline__ const void* ptr(const pg8::Unit& u) const { return Bt + (size_t)u.pn * 256 * K; } };

struct EpiZ {
    static constexpr bool PERM = true;
    bf16* ZA; bf16* ZG;
    __device__ __forceinline__ void operator()(const f32x4 (&acc)[2][2][4][2], const pg8::Unit& u, int wr, int wc, int fr, int fq) const {
        const bool gate = u.pn >= 11;
        bf16* base = gate ? ZG : ZA; const int ld = gate ? ZG_LD : ZA_LD; const int colt = gate ? (u.pn - 11) * 256 : u.pn * 256;
        const int row0 = u.pm * 256 + wr * 64 + fr, col0 = colt + wc * 32 + 8 * fq;
#pragma unroll
        for (int ai = 0; ai < 2; ++ai)
#pragma unroll
            for (int m = 0; m < 4; ++m) { bf16* rowp = base + (size_t)(row0 + ai * 128 + m * 16) * ld + col0;
#pragma unroll
                for (int bj = 0; bj < 2; ++bj) { f32x4 v0 = acc[ai][bj][m][0], v1 = acc[ai][bj][m][1];
                    if (gate) {
#pragma unroll
                        for (int j = 0; j < 4; ++j) { v0[j] = sigmoidf_(v0[j]); v1[j] = sigmoidf_(v1[j]); } }
                    u32x4 w; w.x = pk2(v0[0], v0[1]); w.y = pk2(v0[2], v0[3]); w.z = pk2(v1[0], v1[1]); w.w = pk2(v1[2], v1[3]);
                    *(u32x4*)(rowp + bj * 128) = w; } }
    }
};
template <int MODE> struct EpiGate {
    static constexpr bool PERM = true;
    const bf16* ZG; const bf16* T1; bf16* O;
    __device__ __forceinline__ void operator()(const f32x4 (&acc)[2][2][4][2], const pg8::Unit& u, int wr, int wc, int fr, int fq) const {
        const int row0 = u.pm * 256 + wr * 64 + fr, col0 = u.pn * 256 + wc * 32 + 8 * fq;
#pragma unroll
        for (int ai = 0; ai < 2; ++ai) {
            u32x4 gv[4][2], tv[4][2];
#pragma unroll
            for (int m = 0; m < 4; ++m)
#pragma unroll
                for (int bj = 0; bj < 2; ++bj) { const size_t r = (size_t)(row0 + ai * 128 + m * 16); const int c = col0 + bj * 128;
                    gv[m][bj] = *(const u32x4*)(ZG + r * ZG_LD + MODE * 1024 + c); if (MODE == 1) tv[m][bj] = *(const u32x4*)(T1 + r * 1024 + c); }
#pragma unroll
            for (int m = 0; m < 4; ++m)
#pragma unroll
                for (int bj = 0; bj < 2; ++bj) { asm volatile("" : "+v"(gv[m][bj])); if (MODE == 1) asm volatile("" : "+v"(tv[m][bj])); }
#pragma unroll
            for (int m = 0; m < 4; ++m) { const size_t r = (size_t)(row0 + ai * 128 + m * 16);
#pragma unroll
                for (int bj = 0; bj < 2; ++bj) { const int c = col0 + bj * 128; const u32x4 g = gv[m][bj];
                    const f32x4 v0 = acc[ai][bj][m][0], v1 = acc[ai][bj][m][1];
                    float o[8] = { v0[0] * bflo(g.x), v0[1] * bfhi(g.x), v0[2] * bflo(g.y), v0[3] * bfhi(g.y), v1[0] * bflo(g.z), v1[1] * bfhi(g.z), v1[2] * bflo(g.w), v1[3] * bfhi(g.w) };
                    if (MODE == 1) { const u32x4 t = tv[m][bj];
                        o[0] += bflo(t.x); o[1] += bfhi(t.x); o[2] += bflo(t.y); o[3] += bfhi(t.y); o[4] += bflo(t.z); o[5] += bfhi(t.z); o[6] += bflo(t.w); o[7] += bfhi(t.w); }
                    u32x4 w; w.x = pk2(o[0], o[1]); w.y = pk2(o[2], o[3]); w.z = pk2(o[4], o[5]); w.w = pk2(o[6], o[7]);
                    *(u32x4*)(O + r * 1024 + c) = w; } }
        }
    }
};
struct EpiRes {
    static constexpr bool PERM = true;
    const float* X; bf16* O;
    __device__ __forceinline__ void operator()(const f32x4 (&acc)[2][2][4][2], const pg8::Unit& u, int wr, int wc, int fr, int fq) const {
        const int row0 = u.pm * 256 + wr * 64 + fr, col0 = u.pn * 256 + wc * 32 + 8 * fq;
#pragma unroll
        for (int ai = 0; ai < 2; ++ai) {
            f32x4 xv[4][2][2];
#pragma unroll
            for (int m = 0; m < 4; ++m)
#pragma unroll
                for (int bj = 0; bj < 2; ++bj) { const size_t off = (size_t)(row0 + ai * 128 + m * 16) * D + col0 + bj * 128; xv[m][bj][0] = *(const f32x4*)(X + off); xv[m][bj][1] = *(const f32x4*)(X + off + 4); }
#pragma unroll
            for (int m = 0; m < 4; ++m)
#pragma unroll
                for (int bj = 0; bj < 2; ++bj) { asm volatile("" : "+v"(xv[m][bj][0])); asm volatile("" : "+v"(xv[m][bj][1])); }
#pragma unroll
            for (int m = 0; m < 4; ++m)
#pragma unroll
                for (int bj = 0; bj < 2; ++bj) { const size_t off = (size_t)(row0 + ai * 128 + m * 16) * D + col0 + bj * 128;
                    const f32x4 v0 = xv[m][bj][0] * ALPHA + acc[ai][bj][m][0], v1 = xv[m][bj][1] * ALPHA + acc[ai][bj][m][1];
                    u32x4 w; w.x = pk2(v0[0], v0[1]); w.y = pk2(v0[2], v0[3]); w.z = pk2(v1[0], v1[1]); w.w = pk2(v1[2], v1[3]);
                    *(u32x4*)(O + off) = w; }
        }
    }
};

template <class F>
__device__ __forceinline__ void p0_tile(const F& f, bf16* WT, int ldk, int k0, int n0, LAS float* scr, int lane) {
    if constexpr (F::FOLD) {
        float bc[64];
#pragma unroll
        for (int d = 0; d < 64; ++d) bc[d] = f.bval(k0, d, n0 + (lane & 31));
#pragma unroll 4
        for (int i = 0; i < 32; ++i) { const int kk = 2 * i + (lane >> 5); const f32x4* ar = (const f32x4*)f.arow(k0 + kk, n0); f32x4 a4 = {0.f, 0.f, 0.f, 0.f};
#pragma unroll
            for (int q = 0; q < 16; ++q) { const f32x4 av = ar[q]; a4[0] += av[0] * bc[4 * q]; a4[1] += av[1] * bc[4 * q + 1]; a4[2] += av[2] * bc[4 * q + 2]; a4[3] += av[3] * bc[4 * q + 3]; }
            scr[kk * 33 + (lane & 31)] = (a4[0] + a4[1]) + (a4[2] + a4[3]); }
    } else {
        float v[32];
#pragma unroll
        for (int i = 0; i < 32; ++i) { const int kk = 2 * i + (lane >> 5); v[i] = f(k0 + kk, n0 + (lane & 31)); }
#pragma unroll
        for (int i = 0; i < 32; ++i) { const int kk = 2 * i + (lane >> 5); scr[kk * 33 + (lane & 31)] = v[i]; }
    }
    LDS_WAIT(); asm volatile("" ::: "memory");
    const int c = lane & 7;
#pragma unroll
    for (int j = 0; j < 4; ++j) { const int n = (lane >> 3) + 8 * j; const LAS float* s = scr + (8 * c) * 33 + n;
        u32x4 o; o.x = pk2(s[0 * 33], s[1 * 33]); o.y = pk2(s[2 * 33], s[3 * 33]); o.z = pk2(s[4 * 33], s[5 * 33]); o.w = pk2(s[6 * 33], s[7 * 33]);
        *(u32x4*)(WT + (size_t)(n0 + n) * ldk + k0 + 8 * c) = o; }
    LDS_WAIT(); asm volatile("" ::: "memory");
}
struct P0Item { const float* src; int N, noff; bf16* dst; int ldk, k0, n0; };
__device__ __forceinline__ void p0_item_load(const P0Item& it, float (&v)[32], int lane) {
#pragma unroll
    for (int i = 0; i < 32; ++i) { const int kk = 2 * i + (lane >> 5); v[i] = it.src[(size_t)(it.k0 + kk) * it.N + it.n0 + (lane & 31) + it.noff]; }
}
__device__ __forceinline__ void p0_item_finish(const P0Item& it, const float (&v)[32], LAS float* scr, int lane) {
#pragma unroll
    for (int i = 0; i < 32; ++i) { const int kk = 2 * i + (lane >> 5); scr[kk * 33 + (lane & 31)] = v[i]; }
    LDS_WAIT(); asm volatile("" ::: "memory");
    const int c = lane & 7;
#pragma unroll
    for (int j = 0; j < 4; ++j) { const int n = (lane >> 3) + 8 * j; const LAS float* s = scr + (8 * c) * 33 + n;
        u32x4 o; o.x = pk2(s[0 * 33], s[1 * 33]); o.y = pk2(s[2 * 33], s[3 * 33]); o.z = pk2(s[4 * 33], s[5 * 33]); o.w = pk2(s[6 * 33], s[7 * 33]);
        *(u32x4*)(it.dst + (size_t)(it.n0 + n) * it.ldk + it.k0 + 8 * c) = o; }
    LDS_WAIT(); asm volatile("" ::: "memory");
}
__device__ __forceinline__ int zsrc_col(int n) {
    if (n < 1280) return n;
    if (n < 2304) return -2;
    if (n < 2432) return 1816 + (n - 2304);
    if (n < 2688) return 1944 + (n - 2432);
    if (n < 2752) return 2200 + (n - 2688);
    if (n < 2776) return 1280 + (n - 2752);
    if (n < 2780) return 2264 + (n - 2776);
    if (n < 2816) return -1;
    if (n < 3840) return 2268 + (n - 2816);
    return 3292 + (n - 3840);
}
struct FWin { const float* w_in; static constexpr bool FOLD = false;
    __device__ __forceinline__ float operator()(int k, int n) const { const int s = zsrc_col(n); return s >= 0 ? w_in[(size_t)k * D_IN + s] : 0.f; } };
struct FWinQ { const float* w_in; const float* w_uk; static constexpr bool FOLD = true;
    __device__ __forceinline__ const float* arow(int k, int n0) const { return w_in + (size_t)k * D_IN + 1304 + ((n0 - 1280) >> 7) * 64; }
    __device__ __forceinline__ float bval(int, int d, int n) const { return w_uk[(size_t)((n - 1280) >> 7) * 64 * 128 + d * 128 + ((n - 1280) & 127)]; }
    __device__ __forceinline__ float operator()(int, int) const { return 0.f; } };
struct FWb { const float* w_uv; const float* w_bb; static constexpr bool FOLD = true;
    __device__ __forceinline__ const float* arow(int k, int) const { return w_uv + (size_t)k * 64; }
    __device__ __forceinline__ float bval(int k0, int d, int n) const { return w_bb[(size_t)((k0 >> 7) * 64 + d) * D + n]; }
    __device__ __forceinline__ float operator()(int, int) const { return 0.f; } };
struct FPlain { const float* W; int N; static constexpr bool FOLD = false; __device__ __forceinline__ float operator()(int k, int n) const { return W[(size_t)k * N + n]; } };
struct FOff { const float* W; int N; int noff; static constexpr bool FOLD = false;
    __device__ __forceinline__ float operator()(int k, int n) const { return W[(size_t)k * N + n + noff]; } };

__device__ __forceinline__ float rel_bucket_bias(const float* rel_bias, int dist, int head) {
    int b;
    if (dist < 16) b = dist;
    else { const float t = (__log2f((float)dist) - 4.0f) * 2.66666675f; b = 16 + (int)t; if (b > 31) b = 31; }
    return rel_bias[b * 16 + head];
}

constexpr int P0_EXP_ITEMS = NEXP * ((1024 / 64) * (512 / 32) + (256 / 64) * (1024 / 32)), P0_EXP_SPLIT = (P0_EXP_ITEMS * 2) / 3;
__device__ __forceinline__ void p0_experts(const Frame& F, const Args& a, int wv, int nwv, int ibeg, int iend) {
    LAS float* scr = (LAS float*)(F.lds + F.wave * 16384);
    unsigned char* ws = F.ws;
    constexpr int I_GU = (1024 / 64) * (512 / 32), I_DN = (256 / 64) * (1024 / 32);
    const int gw = wv, NGW = nwv;
    {
        constexpr int NEI = NEXP * (I_GU + I_DN);
        auto mk = [&](int idx) { P0Item it; const int e = idx / (I_GU + I_DN); int r = idx - e * (I_GU + I_DN);
            if (r < I_GU) {
                const int n0 = (r % 16) * 32; const uintptr_t pg = (uintptr_t)a.in[21], pu = (uintptr_t)a.in[22];
                it.src = (const float*)(pg + (uintptr_t)((n0 >> 7) & 1) * (pu - pg)) + (size_t)e * D * DEXP; it.N = DEXP; it.noff = ((n0 >> 8) * 128 + (n0 & 127)) - n0;
                it.dst = (bf16*)(ws + WS_WGU) + (size_t)e * 512 * 1024; it.ldk = 1024; it.k0 = (r / 16) * 64; it.n0 = n0; }
            else { r -= I_GU; it.src = a.in[23] + (size_t)e * DEXP * D; it.N = D; it.noff = 0; it.dst = (bf16*)(ws + WS_WDT) + (size_t)e * 1024 * 256; it.ldk = 256; it.k0 = (r / 32) * 64; it.n0 = (r % 32) * 32; }
            return it; };
        float va[32], vb[32];
        {
        (void)NEI;
        int idx = ibeg + gw;
        if (idx < iend) { P0Item cur = mk(idx); p0_item_load(cur, va, F.lane);
            for (;;) {
                const int nidx = idx + NGW; const bool more = nidx < iend; P0Item nxt = cur;
                if (more) { nxt = mk(nidx); p0_item_load(nxt, vb, F.lane); }
                p0_item_finish(cur, va, scr, F.lane);
                if (!more) break;
#pragma unroll
                for (int i = 0; i < 32; ++i) va[i] = vb[i];
                cur = nxt; idx = nidx; } }
        }
    }
}
__device__ __forceinline__ void phase0(const Frame& F, const Args& a) {
    LAS float* scr = (LAS float*)(F.lds + F.wave * 16384);
    const int gw = F.bx * NWAVES + F.wave, NGW = F.G * NWAVES;
    unsigned char* ws = F.ws;
    constexpr int I_WIN = (D / 64) * (NZ / 32);
    constexpr int I_WB = (1024 / 64) * (1024 / 32);
    constexpr int I_WA = (512 / 64) * (1024 / 32);
    constexpr int I_WO = I_WB;
    constexpr int I_W1 = (2048 / 64) * (256 / 32);
    constexpr int I_W2 = (256 / 64) * (64 / 32);
    constexpr int I_GU = (1024 / 64) * (512 / 32);
    constexpr int I_DN = (256 / 64) * (1024 / 32);
    constexpr int NITEMS = I_WIN + I_WB + I_WA + I_WO + 2 * I_W1 + 2 * I_W2;
    (void)NITEMS;
    constexpr int I_WINP = (D / 64) * ((NZ - 1024) / 32);
    for (int it = gw; it < 1024; it += NGW) {
        if (it < 512) { const int k0 = (it >> 5) * 64, n0 = 1280 + (it & 31) * 32; const FWinQ f{a.in[1], a.in[9]}; p0_tile(f, (bf16*)(ws + WS_WINT), D, k0, n0, scr, F.lane); }
        else { const int r = it - 512; const FWb f{a.in[10], a.in[13]}; p0_tile(f, (bf16*)(ws + WS_WBT), 1024, (r / 32) * 64, (r % 32) * 32, scr, F.lane); }
    }
    { constexpr int NPL = I_WINP + I_WA + I_WO + 2 * I_W1 + 2 * I_W2;
      const int pw0 = NGW > 1024 ? (gw >= 1024 ? gw - 1024 : -1) : gw, pws = NGW > 1024 ? NGW - 1024 : NGW;
      if (pw0 >= 0) for (int it = pw0; it < NPL; it += pws) {
        int r = it;
        if (r < I_WINP) { const int k0 = (r / 120) * 64; int nb = r % 120; nb = nb < 40 ? nb : nb + 32; const FWin f{a.in[1]}; p0_tile(f, (bf16*)(ws + WS_WINT), D, k0, nb * 32, scr, F.lane); continue; } r -= I_WINP;
        if (r < I_WA) { const FPlain f{a.in[12], D}; p0_tile(f, (bf16*)(ws + WS_WAT), 512, (r / 32) * 64, (r % 32) * 32, scr, F.lane); continue; } r -= I_WA;
        if (r < I_WO) { const FPlain f{a.in[14], D}; p0_tile(f, (bf16*)(ws + WS_WOT), 1024, (r / 32) * 64, (r % 32) * 32, scr, F.lane); continue; } r -= I_WO;
        if (r < I_W1) { const FPlain f{a.in[4], 256}; p0_tile(f, (bf16*)(ws + WS_W1K), 2048, (r / 8) * 64, (r % 8) * 32, scr, F.lane); continue; } r -= I_W1;
        if (r < I_W1) { const FPlain f{a.in[6], 256}; p0_tile(f, (bf16*)(ws + WS_W1V), 2048, (r / 8) * 64, (r % 8) * 32, scr, F.lane); continue; } r -= I_W1;
        if (r < I_W2) { const FPlain f{a.in[5], 64}; p0_tile(f, (bf16*)(ws + WS_W2K), 256, (r / 2) * 64, (r % 2) * 32, scr, F.lane); continue; } r -= I_W2;
        { const FPlain f{a.in[7], 64}; p0_tile(f, (bf16*)(ws + WS_W2V), 256, (r / 2) * 64, (r % 2) * 32, scr, F.lane); }
      } }
    { const int nu = (NTOK / 256) * (NZ / 256); if ((nu % F.G) == 0) p0_experts(F, a, gw, NGW, 0, P0_EXP_ITEMS); }
    { const f32x4* x4 = (const f32x4*)a.in[0]; u32x2* o = (u32x2*)(ws + WS_XB);
      const size_t total = (size_t)NTOK * D / 4, stride = (size_t)F.G * NTHR;
      for (size_t i0 = (size_t)F.bx * NTHR + F.tid; i0 < total; i0 += 8 * stride) { f32x4 v[8];
#pragma unroll
          for (int j = 0; j < 8; ++j) { const size_t i = i0 + j * stride; v[j] = i < total ? x4[i] : (f32x4){0.f, 0.f, 0.f, 0.f}; }
#pragma unroll
          for (int j = 0; j < 8; ++j) { const size_t i = i0 + j * stride; if (i < total) { u32x2 w; w.x = pk2(v[j][0], v[j][1]); w.y = pk2(v[j][2], v[j][3]); o[i] = w; } } } }
    if (F.bx < 64 && F.tid < 256) {
        const int kv = F.bx >> 5, j = F.bx & 31;
        const float* pe = (kv ? a.in[3] : a.in[2]) + 64 * j; const float* w1 = (kv ? a.in[6] : a.in[4]) + (size_t)(64 * j) * 256 + F.tid; float acc = 0.f;
#pragma unroll 16
        for (int k = 0; k < 64; ++k) acc += pe[k] * w1[(size_t)k * 256];
        ((float*)(ws + WS_BIASK))[(kv * 32 + j) * 256 + F.tid] = acc;
    }
    if (F.bx >= 64 && F.bx < 96) { const int idx = (F.bx - 64) * NTHR + F.tid;
        const int tab = idx >> 13, head = (idx >> 10) & 7, dist = idx & 1023;
        ((float*)(ws + (tab ? WS_TBB : WS_TBA)))[head * 1024 + dist] = rel_bucket_bias(a.in[11], dist, tab * 8 + head) * LOG2E; }
}

constexpr int NRT = 36;
constexpr int P6_WR = 0;
constexpr int P6_CNT = 147456;
constexpr int P6_ENT = 147456 + 512;
__device__ __forceinline__ float row16_sum(float v) {
    v += __builtin_bit_cast(float, __builtin_amdgcn_update_dpp(0, __builtin_bit_cast(int, v), 0xB1, 0xf, 0xf, true));
    v += __builtin_bit_cast(float, __builtin_amdgcn_update_dpp(0, __builtin_bit_cast(int, v), 0x4E, 0xf, 0xf, true));
    v += __builtin_bit_cast(float, __builtin_amdgcn_update_dpp(0, __builtin_bit_cast(int, v), 0x141, 0xf, 0xf, true));
    v += __builtin_bit_cast(float, __builtin_amdgcn_update_dpp(0, __builtin_bit_cast(int, v), 0x140, 0xf, 0xf, true));
    return v;
}
__device__ __forceinline__ float wave_sum_dpp(float v) { v = row16_sum(v); v += __shfl_xor(v, 16); v += __shfl_xor(v, 32); return v; }
__device__ __forceinline__ void phase6(const Frame& F, const Args& a) {
    unsigned char* ws = F.ws;
    LAS float* WR = (LAS float*)(F.lds + P6_WR);
    LAS int* cntL = (LAS int*)(F.lds + P6_CNT); LAS int* baseL = cntL + 32;
    LAS int* ent = (LAS int*)(F.lds + P6_ENT);
    const float* w_grp = a.in[17]; const float* b_grp = a.in[18]; const float* w_rtr = a.in[19]; const float* b_rtr = a.in[20];
    {
        f32x4 wv[16], gv2[2];
#pragma unroll
        for (int i = 0; i < 16; ++i) wv[i] = *(const f32x4*)(w_rtr + 4 * (F.tid + NTHR * i));
#pragma unroll
        for (int i = 0; i < 2; ++i) gv2[i] = *(const f32x4*)(w_grp + 4 * (F.tid + NTHR * i));
#pragma unroll
        for (int i = 0; i < 16; ++i) { const int e = 4 * (F.tid + NTHR * i), k = e >> 5, o = e & 31;
#pragma unroll
            for (int c = 0; c < 4; ++c) WR[(4 + o + c) * 1024 + k] = wv[i][c]; }
#pragma unroll
        for (int i = 0; i < 2; ++i) { const int k = F.tid + NTHR * i;
#pragma unroll
            for (int c = 0; c < 4; ++c) WR[c * 1024 + k] = gv2[i][c]; }
    }
    if (F.tid < 65) cntL[F.tid] = 0;
    __syncthreads();
    const bf16* HP = (const bf16*)(ws + WS_H1); bf16* H1B = (bf16*)(ws + WS_H1B);
    const float* lg = a.in[15]; const float* lb = a.in[16];
    f32x2 gam[8], bet[8];
#pragma unroll
    for (int j = 0; j < 2; ++j)
#pragma unroll
        for (int q = 0; q < 4; ++q) { gam[4 * j + q] = *(const f32x2*)(lg + 512 * j + 8 * F.lane + 2 * q); bet[4 * j + q] = *(const f32x2*)(lb + 512 * j + 8 * F.lane + 2 * q); }
    unsigned* gcnt = (unsigned*)(ws + WS_CTL) + CW_CNT;
    int* list = (int*)(ws + WS_LIST); float* tokinfo = (float*)(ws + WS_TOKINFO);
    const int gw = F.bx * NWAVES + F.wave, NGW = F.G * NWAVES;
    u32x4 nx0, nx1;
    const int rpb = (NTOK + F.G - 1) / F.G, rbeg = F.bx * rpb, rend = (rbeg + rpb < NTOK) ? rbeg + rpb : NTOK;
    (void)gw; (void)NGW;
    if (rbeg + F.wave < rend) { const u32x4* hr = (const u32x4*)(HP + (size_t)(rbeg + F.wave) * D) + F.lane; nx0 = hr[0]; nx1 = hr[64]; }
    for (int row = rbeg + F.wave; row < rend; row += NWAVES) {
        const u32x4 r0 = nx0, r1 = nx1;
        if (row + NWAVES < rend) { const u32x4* hr = (const u32x4*)(HP + (size_t)(row + NWAVES) * D) + F.lane; nx0 = hr[0]; nx1 = hr[64]; }
        f32x2 v[8];
        v[0] = (f32x2){bflo(r0.x), bfhi(r0.x)}; v[1] = (f32x2){bflo(r0.y), bfhi(r0.y)}; v[2] = (f32x2){bflo(r0.z), bfhi(r0.z)}; v[3] = (f32x2){bflo(r0.w), bfhi(r0.w)};
        v[4] = (f32x2){bflo(r1.x), bfhi(r1.x)}; v[5] = (f32x2){bflo(r1.y), bfhi(r1.y)}; v[6] = (f32x2){bflo(r1.z), bfhi(r1.z)}; v[7] = (f32x2){bflo(r1.w), bfhi(r1.w)};
        f32x2 s2 = v[0];
#pragma unroll
        for (int q = 1; q < 8; ++q) s2 += v[q];
        const float mean = wave_sum_dpp(s2[0] + s2[1]) * (1.f / D);
        f32x2 q2 = {0.f, 0.f};
#pragma unroll
        for (int q = 0; q < 8; ++q) { v[q] = v[q] - mean; q2 += v[q] * v[q]; }
        const float rstd = 1.0f / sqrtf(wave_sum_dpp(q2[0] + q2[1]) * (1.f / D) + 1e-5f);
#pragma unroll
        for (int q = 0; q < 8; ++q) v[q] = v[q] * rstd * gam[q] + bet[q];
        { u32x4 w0, w1; w0.x = pk2(v[0][0], v[0][1]); w0.y = pk2(v[1][0], v[1][1]); w0.z = pk2(v[2][0], v[2][1]); w0.w = pk2(v[3][0], v[3][1]);
          w1.x = pk2(v[4][0], v[4][1]); w1.y = pk2(v[5][0], v[5][1]); w1.z = pk2(v[6][0], v[6][1]); w1.w = pk2(v[7][0], v[7][1]);
          u32x4* ob = (u32x4*)(H1B + (size_t)row * D) + F.lane; ob[0] = w0; ob[64] = w1; }
        auto rdot = [&](int o) { f32x2 p2 = {0.f, 0.f};
#pragma unroll
            for (int j = 0; j < 2; ++j) { const f32x4 wa = *(const LAS f32x4*)(WR + o * 1024 + 512 * j + 8 * F.lane), wb = *(const LAS f32x4*)(WR + o * 1024 + 512 * j + 8 * F.lane + 4);
                p2 += v[4 * j] * (f32x2){wa[0], wa[1]}; p2 += v[4 * j + 1] * (f32x2){wa[2], wa[3]}; p2 += v[4 * j + 2] * (f32x2){wb[0], wb[1]}; p2 += v[4 * j + 3] * (f32x2){wb[2], wb[3]}; }
            return row16_sum(p2[0] + p2[1]); };
        float g[4];
#pragma unroll
        for (int i = 0; i < 4; ++i) g[i] = rdot(i);
#pragma unroll
        for (int i = 0; i < 4; ++i) { float t = g[i]; t += __shfl_xor(t, 16); t += __shfl_xor(t, 32); g[i] = t + b_grp[i]; }
        int gs = 0; float gm = g[0];
#pragma unroll
        for (int i = 1; i < 4; ++i) if (g[i] > gm) { gm = g[i]; gs = i; }
        gs = __builtin_amdgcn_readfirstlane(gs);
        float gsum = 0.f;
#pragma unroll
        for (int i = 0; i < 4; ++i) gsum += __expf(g[i] - gm);
        const float pgrp = 1.0f / gsum;
        float el[8];
#pragma unroll
        for (int i = 0; i < 8; ++i) el[i] = rdot(4 + gs * 8 + i);
#pragma unroll
        for (int i = 0; i < 8; ++i) { float t = el[i]; t += __shfl_xor(t, 16); t += __shfl_xor(t, 32); el[i] = t + b_rtr[gs * 8 + i]; }
        int i1 = 0; float l1 = el[0];
#pragma unroll
        for (int i = 1; i < 8; ++i) if (el[i] > l1) { l1 = el[i]; i1 = i; }
        int i2 = -1; float l2 = -3.0e38f;
#pragma unroll
        for (int i = 0; i < 8; ++i) if (i != i1 && el[i] > l2) { l2 = el[i]; i2 = i; }
        const float e2 = __expf(l2 - l1), inv = 1.0f / (1.0f + e2);
        const float w0 = pgrp * inv, w1 = pgrp * e2 * inv;
        const int e0 = gs * 8 + i1, e1 = gs * 8 + i2;
        if (F.lane == 0) {
            const int p0 = atomicAdd((int*)&cntL[e0], 1), p1 = atomicAdd((int*)&cntL[e1], 1);
            const int n0 = atomicAdd((int*)&cntL[64], 2);
            ent[2 * n0] = (e0 << 16) | p0; ent[2 * n0 + 1] = row * 2;
            ent[2 * n0 + 2] = (e1 << 16) | p1; ent[2 * n0 + 3] = row * 2 + 1;
            tokinfo[row * 2] = w0; tokinfo[row * 2 + 1] = w1;
        }
    }
    __syncthreads();
    if (F.tid < 32) { const int c = cntL[F.tid]; baseL[F.tid] = c > 0 ? (int)__hip_atomic_fetch_add(gcnt + 64 * F.tid, (unsigned)c, __ATOMIC_RELAXED, __HIP_MEMORY_SCOPE_AGENT) : 0; }
    __syncthreads();
    const int nent = cntL[64];
    for (int i = F.tid; i < nent; i += NTHR) { const int ep = ent[2 * i], tk = ent[2 * i + 1]; const int e = ep >> 16, p = ep & 0xffff; list[(size_t)e * NTOK + baseL[e] + p] = tk; }
    __syncthreads();
}

constexpr int MOE_CUM = 131072;
struct MoeOrder {
    int G, c, NP; const LAS int* cum; const LAS int* cnt;
    __device__ bool next(int i, pg8::Unit& u) const {
        const int L = i * G + c, t = L / NP; if (t >= cum[32]) return false;
        const int e = cum[80 + t];
        const int j = t - cum[e]; u.pm = t; u.pn = L % NP; u.e = e | (j << 8); const int rem = cnt[e] - j * 256; u.nrows = rem < 256 ? rem : 256; return true;
    }
};
__device__ __forceinline__ void moe_setup(const Frame& F) {
    LAS int* cum = (LAS int*)(F.lds + MOE_CUM); LAS int* cnt = cum + 40;
    const unsigned* gcnt = (const unsigned*)(F.ws + WS_CTL) + CW_CNT;
    if (F.tid < 32) cnt[F.tid] = (int)__hip_atomic_load(gcnt + 64 * F.tid, __ATOMIC_RELAXED, __HIP_MEMORY_SCOPE_AGENT);
    __syncthreads();
    if (F.tid == 0) { int s = 0; for (int e = 0; e < 32; ++e) { cum[e] = s; s += (cnt[e] + 255) >> 8; } cum[32] = s; }
    __syncthreads();
    for (int t = F.tid; t < cum[32]; t += NTHR) { int e = 0; for (int k = 1; k < 32; ++k) if (t >= cum[k]) e = k; cum[80 + t] = e; }
    __syncthreads();
}
struct AGather { const void* base; unsigned kstep; const int* list;
    static constexpr bool GATHER = true;
    __device__ __forceinline__ const void* unit_ptr(const pg8::Unit&) const { return base; }
    __device__ __forceinline__ unsigned lane_off(int, int) const { return 0u; }
    __device__ __forceinline__ size_t hstep() const { return 0; }
    __device__ __forceinline__ unsigned row_off(const pg8::Unit& u, int r) const { const int e = u.e & 255, j = u.e >> 8; const int rr = r < u.nrows ? r : 0;
        const int tk = list[(size_t)e * NTOK + j * 256 + rr]; return (unsigned)(tk >> 1) * (unsigned)(D * 2); } };
struct BGu { const bf16* W; __device__ __forceinline__ const void* ptr(const pg8::Unit& u) const { return W + (size_t)(u.e & 255) * 512 * 1024 + (size_t)u.pn * 256 * 1024; } };
struct BDn { const bf16* W; __device__ __forceinline__ const void* ptr(const pg8::Unit& u) const { return W + (size_t)(u.e & 255) * 1024 * 256 + (size_t)u.pn * 256 * 256; } };
struct EpiAct {
    static constexpr bool PERM = true; bf16* ACT;
    __device__ __forceinline__ void operator()(const f32x4 (&acc)[2][2][4][2], const pg8::Unit& u, int wr, int wc, int fr, int fq) const {
        const int row0 = u.pm * 256 + wr * 64 + fr, col0 = u.pn * 128 + wc * 32 + 8 * fq;
#pragma unroll
        for (int ai = 0; ai < 2; ++ai)
#pragma unroll
            for (int m = 0; m < 4; ++m) { float o[8];
#pragma unroll
                for (int n = 0; n < 2; ++n)
#pragma unroll
                    for (int j = 0; j < 4; ++j) { const float gt = acc[ai][0][m][n][j], up = acc[ai][1][m][n][j]; o[4 * n + j] = gt * sigmoidf_(gt) * up; }
                u32x4 w; w.x = pk2(o[0], o[1]); w.y = pk2(o[2], o[3]); w.z = pk2(o[4], o[5]); w.w = pk2(o[6], o[7]);
                *(u32x4*)(ACT + (size_t)(row0 + ai * 128 + m * 16) * DEXP + col0) = w; }
    }
};
struct EpiDown {
    static constexpr bool PERM = true; bf16* Y; const int* list;
    __device__ __forceinline__ void operator()(const f32x4 (&acc)[2][2][4][2], const pg8::Unit& u, int wr, int wc, int fr, int fq) const {
        const int e = u.e & 255, j = u.e >> 8; const int col0 = u.pn * 256 + wc * 32 + 8 * fq;
        int tks[2][4];
#pragma unroll
        for (int ai = 0; ai < 2; ++ai)
#pragma unroll
            for (int m = 0; m < 4; ++m) { const int r = ai * 128 + wr * 64 + m * 16 + fr; tks[ai][m] = r < u.nrows ? list[(size_t)e * NTOK + j * 256 + r] : -1; }
#pragma unroll
        for (int ai = 0; ai < 2; ++ai)
#pragma unroll
            for (int m = 0; m < 4; ++m) { const int tk = tks[ai][m];
                if (tk >= 0) { bf16* rowp = Y + (size_t)tk * D + col0;
#pragma unroll
                    for (int bj = 0; bj < 2; ++bj) { const f32x4 v0 = acc[ai][bj][m][0], v1 = acc[ai][bj][m][1];
                        u32x4 w; w.x = pk2(v0[0], v0[1]); w.y = pk2(v0[2], v0[3]); w.z = pk2(v1[0], v1[1]); w.w = pk2(v1[2], v1[3]);
                        *(u32x4*)(rowp + bj * 128) = w; } } }
    }
};

__device__ __forceinline__ void phase9(const Frame& F, const Args& a) {
    unsigned char* ws = F.ws;
    const bf16* H1B = (const bf16*)(ws + WS_H1B); const bf16* Y = (const bf16*)(ws + WS_YBUF); const float* tokinfo = (const float*)(ws + WS_TOKINFO);
    const float* lg = a.in[24]; const float* lb = a.in[25];
    f32x4 gam[4], bet[4];
#pragma unroll
    for (int j = 0; j < 2; ++j) { gam[2 * j] = *(const f32x4*)(lg + 512 * j + 8 * F.lane); gam[2 * j + 1] = *(const f32x4*)(lg + 512 * j + 8 * F.lane + 4); bet[2 * j] = *(const f32x4*)(lb + 512 * j + 8 * F.lane); bet[2 * j + 1] = *(const f32x4*)(lb + 512 * j + 8 * F.lane + 4); }
    const int gw = F.bx * NWAVES + F.wave, NGW = F.G * NWAVES;
    u32x4 nh[2], ny0[2], ny1[2]; float nw0 = 0.f, nw1 = 0.f;
#define P9_LOAD(row_) do { const u32x4* hp_ = (const u32x4*)(H1B + (size_t)(row_) * D) + F.lane; const u32x4* y0_ = (const u32x4*)(Y + (size_t)((row_) * 2) * D) + F.lane; const u32x4* y1_ = (const u32x4*)(Y + (size_t)((row_) * 2 + 1) * D) + F.lane; \
        nh[0] = hp_[0]; nh[1] = hp_[64]; ny0[0] = y0_[0]; ny0[1] = y0_[64]; ny1[0] = y1_[0]; ny1[1] = y1_[64]; nw0 = tokinfo[(row_) * 2]; nw1 = tokinfo[(row_) * 2 + 1]; } while (0)
    if (gw < NTOK) P9_LOAD(gw);
    for (int row = gw; row < NTOK; row += NGW) {
        u32x4 h[2] = {nh[0], nh[1]}, p[2] = {ny0[0], ny0[1]}, q[2] = {ny1[0], ny1[1]}; const float w0 = nw0, w1 = nw1;
        if (row + NGW < NTOK) P9_LOAD(row + NGW);
        f32x4 v[4]; float s = 0.f;
#pragma unroll
        for (int j = 0; j < 2; ++j) {
            v[2 * j][0] = ALPHA * bflo(h[j].x) + w0 * bflo(p[j].x) + w1 * bflo(q[j].x); v[2 * j][1] = ALPHA * bfhi(h[j].x) + w0 * bfhi(p[j].x) + w1 * bfhi(q[j].x);
            v[2 * j][2] = ALPHA * bflo(h[j].y) + w0 * bflo(p[j].y) + w1 * bflo(q[j].y); v[2 * j][3] = ALPHA * bfhi(h[j].y) + w0 * bfhi(p[j].y) + w1 * bfhi(q[j].y);
            v[2 * j + 1][0] = ALPHA * bflo(h[j].z) + w0 * bflo(p[j].z) + w1 * bflo(q[j].z); v[2 * j + 1][1] = ALPHA * bfhi(h[j].z) + w0 * bfhi(p[j].z) + w1 * bfhi(q[j].z);
            v[2 * j + 1][2] = ALPHA * bflo(h[j].w) + w0 * bflo(p[j].w) + w1 * bflo(q[j].w); v[2 * j + 1][3] = ALPHA * bfhi(h[j].w) + w0 * bfhi(p[j].w) + w1 * bfhi(q[j].w); }
#pragma unroll
        for (int j = 0; j < 4; ++j) s += (v[j][0] + v[j][1]) + (v[j][2] + v[j][3]);
        const float mean = wave_sum_dpp(s) * (1.f / D); float s2 = 0.f;
#pragma unroll
        for (int j = 0; j < 4; ++j) { v[j] = v[j] - mean; s2 += (v[j][0] * v[j][0] + v[j][1] * v[j][1]) + (v[j][2] * v[j][2] + v[j][3] * v[j][3]); }
        const float rstd = 1.0f / sqrtf(wave_sum_dpp(s2) * (1.f / D) + 1e-5f);
        float* orow = a.out + (size_t)row * D + 8 * F.lane;
#pragma unroll
        for (int j = 0; j < 2; ++j) { *(f32x4*)(orow + 512 * j) = v[2 * j] * rstd * gam[2 * j] + bet[2 * j]; *(f32x4*)(orow + 512 * j + 4) = v[2 * j + 1] * rstd * gam[2 * j + 1] + bet[2 * j + 1]; }
    }
#undef P9_LOAD
}
#define MFMA32(a, b, c) __builtin_amdgcn_mfma_f32_32x32x16_bf16((a), (b), (c), 0, 0, 0)
__device__ __forceinline__ int crow(int r, int hi) { return (r & 3) + 8 * (r >> 2) + 4 * hi; }
__device__ __forceinline__ float gelu_tanh(float x) { const float u = 0.7978845608028654f * (x + 0.044715f * x * x * x); const float e = __builtin_amdgcn_exp2f(2.885390081777927f * u); return 0.5f * x * (2.0f - 2.0f * __builtin_amdgcn_rcpf(e + 1.0f)); }
constexpr int P2_AROW = 4096 + 16;
constexpr int P2_HID = 32 * P2_AROW;
constexpr int P2_HROW = 512 + 16;
__device__ __forceinline__ void phase2(const Frame& F, const Args& a) {
    unsigned char* ws = F.ws;
    const bf16* ZA = (const bf16*)(ws + WS_ZA);
    { const float* gn = a.in[8]; bf16* CK = (bf16*)(ws + WS_CKVN);
      const int sub = F.lane >> 4, l16 = F.lane & 15;
      float gv[8];
#pragma unroll
      for (int j = 0; j < 8; ++j) gv[j] = gn[l16 * 8 + j];
      const int r4b = F.bx * NWAVES + F.wave, r4s = F.G * NWAVES;
      for (int r4 = r4b; r4 < NTOK / 4; r4 += 4 * r4s) { u32x4 wv[4];
#pragma unroll
          for (int t = 0; t < 4; ++t) { const int rr = r4 + t * r4s; const int row = (rr < NTOK / 4 ? rr : r4) * 4 + sub; wv[t] = *(const u32x4*)(ZA + (size_t)row * ZA_LD + ZC_CKV + l16 * 8); }
#pragma unroll
          for (int t = 0; t < 4; ++t) { const int rr = r4 + t * r4s; if (rr < NTOK / 4) { const int row = rr * 4 + sub; const u32x4 w = wv[t];
              float v[8] = { bflo(w.x), bfhi(w.x), bflo(w.y), bfhi(w.y), bflo(w.z), bfhi(w.z), bflo(w.w), bfhi(w.w) };
              float s2 = 0.f;
#pragma unroll
              for (int j = 0; j < 8; ++j) s2 += v[j] * v[j];
              s2 += __shfl_xor(s2, 1); s2 += __shfl_xor(s2, 2); s2 += __shfl_xor(s2, 4); s2 += __shfl_xor(s2, 8);
              const float rs = 1.0f / sqrtf(s2 * (1.0f / 128.0f) + 1e-6f);
              u32x4 o; o.x = pk2(v[0] * rs * gv[0], v[1] * rs * gv[1]); o.y = pk2(v[2] * rs * gv[2], v[3] * rs * gv[3]); o.z = pk2(v[4] * rs * gv[4], v[5] * rs * gv[5]); o.w = pk2(v[6] * rs * gv[6], v[7] * rs * gv[7]);
              *(u32x4*)(CK + (size_t)row * 128 + l16 * 8) = o; } } } }
    const int r32 = F.lane & 31, hi = F.lane >> 5;
    for (int u = F.bx; u < 256; u += F.G) {
        const int kv = u >> 7, rt = u & 127, R0 = rt * 32;
        const int zc = kv ? ZC_VC : ZC_KC;
        const bf16* W1T = (const bf16*)(ws + (kv ? WS_W1V : WS_W1K)); const bf16* W2T = (const bf16*)(ws + (kv ? WS_W2V : WS_W2K));
        const float* bias = (const float*)(ws + WS_BIASK) + (size_t)kv * 32 * 256;
        bf16* OUT = (bf16*)(ws + (kv ? WS_VCMP : WS_KCMP));
        __syncthreads();
        { u32x4 av[16];
#pragma unroll
          for (int i = 0; i < 16; ++i) { const int q = F.tid + NTHR * i; const int row = q >> 8, cq = q & 255, l = cq >> 3, dch = cq & 7;
              const int R = R0 + row, b = R >> 9, c = (R >> 1) & 255, g = R & 1; const int cc = c < NCMP ? c : NCMP - 1;
              av[i] = *(const u32x4*)(ZA + (size_t)(b * SEQ + 16 * cc + l) * ZA_LD + zc + g * 64 + dch * 8); }
#pragma unroll
          for (int i = 0; i < 16; ++i) { const int q = F.tid + NTHR * i; const int row = q >> 8, cq = q & 255; *(LAS u32x4*)(F.lds + row * P2_AROW + cq * 16) = av[i]; } }
        __syncthreads();
        f32x16 acc = {};
        { const bf16* bp = W1T + (size_t)(32 * F.wave + r32) * 2048 + 8 * hi; const LAS unsigned char* ap = F.lds + r32 * P2_AROW + 16 * hi;
          f32x16 acc1 = {};
#pragma unroll 1
          for (int s0 = 0; s0 < 128; s0 += 32) { bf16x8 bfr[32];
#pragma unroll
              for (int j = 0; j < 32; ++j) bfr[j] = *(const bf16x8*)(bp + (s0 + j) * 16);
#pragma unroll
              for (int j = 0; j < 32; j += 2) { const bf16x8 a0 = *(const LAS bf16x8*)(ap + (s0 + j) * 32), a1 = *(const LAS bf16x8*)(ap + (s0 + j + 1) * 32); acc = MFMA32(a0, bfr[j], acc); acc1 = MFMA32(a1, bfr[j + 1], acc1); } }
#pragma unroll
          for (int i = 0; i < 16; ++i) acc[i] += acc1[i]; }
        { float bs = 0.f;
#pragma unroll 8
          for (int j = 0; j < 32; ++j) bs += bias[j * 256 + 32 * F.wave + r32];
#pragma unroll
          for (int i = 0; i < 16; ++i) { const float h = gelu_tanh(acc[i] + bs); *(LAS unsigned short*)(F.lds + P2_HID + crow(i, hi) * P2_HROW + (32 * F.wave + r32) * 2) = (unsigned short)f2bf(h); } }
        __syncthreads();
        if (F.wave < 2) {
            f32x16 o2 = {};
            const bf16* bp = W2T + (size_t)(32 * F.wave + r32) * 256 + 8 * hi; const LAS unsigned char* ap = F.lds + P2_HID + r32 * P2_HROW + 16 * hi;
#pragma unroll
            for (int s = 0; s < 16; ++s) { const bf16x8 af = *(const LAS bf16x8*)(ap + s * 32); const bf16x8 bfr = *(const bf16x8*)(bp + s * 16); o2 = MFMA32(af, bfr, o2); }
#pragma unroll
            for (int i = 0; i < 16; ++i) OUT[(size_t)(R0 + crow(i, hi)) * 64 + 32 * F.wave + r32] = (bf16)f2bf(o2[i]);
        }
    }
    __syncthreads();
}

typedef short v4i16_t __attribute__((ext_vector_type(4)));
__device__ __forceinline__ s16x4 vtr(const LAS unsigned char* p) { return __builtin_bit_cast(s16x4, __builtin_amdgcn_ds_read_tr16_b64_v4i16((LAS v4i16_t*)p)); }
constexpr int NSA_K = 0;
constexpr int NSA_V = 16384;
constexpr int NSA_TB = 49152;
constexpr int NSA_SC = 65536;
constexpr int NSA_MSK = 81920;
constexpr int NSA_OF = 83968;
constexpr float C2 = 0.125f * LOG2E;

__device__ __forceinline__ float halfmax(float v) { return fmaxf(v, __shfl_xor(v, 32)); }
__device__ __forceinline__ void nsa_tile(const LAS unsigned char* Kb, const LAS unsigned char* Vb, const LAS float* tbh, const bf16x8 (&qr)[4], f32x16 (&o)[2], float& m, float& l,
                                         int kt, int tq, int kmul, int kadd, int dmax, bool selbit, int mode, float b31, int r32, int hi, int lane) {
    const int tqa = tq - kadd, qk = kmul == 16 ? (tqa >> 4) : tqa, rem = kmul == 16 ? (tqa & 15) : 0;
    const int ebase = qk - (kt * 64 + 4 * hi);
    const LAS unsigned char* vp0 = Vb + ((lane >> 4) & 1) * 32 + (lane & 3) * 8 + (4 * hi + ((lane & 15) >> 2)) * 64;
#pragma unroll
    for (int hf = 0; hf < 2; ++hf) {
        f32x16 s0 = {};
#pragma unroll
        for (int d0 = 0; d0 < 4; ++d0) { const bf16x8 k0 = *(const LAS bf16x8*)(Kb + (2 * d0 + hi) * 1024 + (r32 + 32 * hf) * 16); s0 = MFMA32(k0, qr[d0], s0); }
        float tmax, mn, ps = 0.f;
        if (mode == 2) {
            float a0 = fmaxf(fmaxf(s0[0], s0[1]), s0[2]), a1 = fmaxf(fmaxf(s0[3], s0[4]), s0[5]);
            a0 = fmaxf(fmaxf(a0, s0[6]), s0[7]); a1 = fmaxf(fmaxf(a1, s0[8]), s0[9]); a0 = fmaxf(fmaxf(a0, s0[10]), s0[11]); a1 = fmaxf(fmaxf(a1, s0[12]), s0[13]); a0 = fmaxf(fmaxf(a0, s0[14]), s0[15]);
            const float cb = selbit ? b31 : NEGBIG;
            tmax = fmaxf(a0, a1) * C2 + cb;
            tmax = halfmax(tmax);
            mn = fmaxf(m, tmax);
            const float cc = cb - mn;
#pragma unroll
            for (int r = 0; r < 16; ++r) { const float p0 = __builtin_amdgcn_exp2f(s0[r] * C2 + cc); s0[r] = p0; ps += p0; }
        } else if (mode == 1) {
            int eb1 = ebase; asm volatile("" : "+v"(eb1));
            const LAS float* tb1 = tbh + (eb1 - 96);
            float bv[16];
#pragma unroll
            for (int r = 0; r < 16; ++r) bv[r] = tb1[96 - ((r & 3) + 8 * (r >> 2) + 32 * hf)];
#pragma unroll
            for (int r = 0; r < 16; ++r) asm volatile("" : "+v"(bv[r]));
            tmax = NEGBIG;
#pragma unroll
            for (int r = 0; r < 16; ++r) { const float x = s0[r] * C2 + bv[r]; s0[r] = x; tmax = fmaxf(tmax, x); }
            tmax = selbit ? tmax : NEGBIG;
            tmax = halfmax(tmax);
            mn = fmaxf(m, tmax);
            const float mne = selbit ? mn : 1e30f;
#pragma unroll
            for (int r = 0; r < 16; ++r) { const float p0 = __builtin_amdgcn_exp2f(s0[r] - mne); s0[r] = p0; ps += p0; }
        } else {
            tmax = NEGBIG;
            float bv[16];
            int eb0 = ebase; asm volatile("" : "+v"(eb0));
#pragma unroll
            for (int r = 0; r < 16; ++r) { const int dist = __mul24(eb0 - ((r & 3) + 8 * (r >> 2) + 32 * hf), kmul) + rem; int dc = dist < 0 ? 0 : dist; dc = dc > 1023 ? 1023 : dc; bv[r] = tbh[dc]; }
#pragma unroll
            for (int r = 0; r < 16; ++r) asm volatile("" : "+v"(bv[r]));
#pragma unroll
            for (int r = 0; r < 16; ++r) { const int dist = __mul24(eb0 - ((r & 3) + 8 * (r >> 2) + 32 * hf), kmul) + rem;
                const bool valid = selbit && dist >= 0 && dist < dmax;
                const float x = valid ? s0[r] * C2 + bv[r] : NEGBIG;
                s0[r] = x; tmax = fmaxf(tmax, x); }
            tmax = halfmax(tmax);
            mn = fmaxf(m, tmax);
#pragma unroll
            for (int r = 0; r < 16; ++r) { const float p0 = s0[r] > -1e29f ? __builtin_amdgcn_exp2f(s0[r] - mn) : 0.f; s0[r] = p0; ps += p0; }
        }
        if (__any(mn != m)) {
            const float alpha = __builtin_amdgcn_exp2f(m - mn);
            l *= alpha;
#pragma unroll
            for (int c = 0; c < 2; ++c)
#pragma unroll
                for (int r = 0; r < 16; ++r) o[c][r] *= alpha;
        }
        m = mn;
        l += ps;
        u32x4 pw[2];
#pragma unroll
        for (int q = 0; q < 4; ++q) { pw[0][q] = pk2(s0[2 * q], s0[2 * q + 1]); pw[1][q] = pk2(s0[8 + 2 * q], s0[8 + 2 * q + 1]); }
#pragma unroll
        for (int c = 0; c < 2; ++c)
#pragma unroll
            for (int s2 = 0; s2 < 2; ++s2) { const int s = 2 * hf + s2; const s16x4 vl = vtr(vp0 + c * 4096 + s * 1024), vh = vtr(vp0 + c * 4096 + s * 1024 + 512);
                const bf16x8 vf = {vl[0], vl[1], vl[2], vl[3], vh[0], vh[1], vh[2], vh[3]};
                o[c] = MFMA32(vf, __builtin_bit_cast(bf16x8, pw[s2]), o[c]); }
    }
}

__device__ __forceinline__ void nsa_unit(const Frame& F, int b, int g, int qt) {
    unsigned char* ws = F.ws;
    const bf16* ZA = (const bf16*)(ws + WS_ZA);
    const int r32 = F.lane & 31, hi = F.lane >> 5, qi = r32 >> 2, hh = r32 & 3, head = g * 4 + hh;
    const int q0 = qt * 64, tq = q0 + 8 * F.wave + qi;
    const size_t zrow = (size_t)(b * SEQ + tq) * ZA_LD;
    const int srow = F.tid >> 3, sch = F.tid & 7;
    const f32x4* TBA4 = (const f32x4*)((const float*)(ws + WS_TBA) + (size_t)g * 4 * 1024);
    const f32x4 tbv0 = TBA4[F.tid], tbv1 = TBA4[F.tid + NTHR];
    const LAS float* tbh = (const LAS float*)(F.lds + NSA_TB) + hh * 1024;
    const int wq0 = q0 + 8 * F.wave;
    const float b31 = ((const float*)(ws + WS_TBA))[(size_t)head * 1024 + 1023];
    bf16x8 qr[4];
#pragma unroll
    for (int d0 = 0; d0 < 4; ++d0) qr[d0] = *(const bf16x8*)(ZA + zrow + ZC_QA + head * 64 + d0 * 16 + hi * 8);
    unsigned short graw[3];
#pragma unroll
    for (int i = 0; i < 3; ++i) graw[i] = ZA[zrow + ZC_GNSA + head * 3 + i];
    { LAS f32x4* tb4 = (LAS f32x4*)(F.lds + NSA_TB); tb4[F.tid] = tbv0; tb4[F.tid + NTHR] = tbv1; }
    float gate[3];
#pragma unroll
    for (int i = 0; i < 3; ++i) gate[i] = sigmoidf_(bf2f(graw[i]));
    LAS float* ofw = (LAS float*)(F.lds + NSA_OF) + F.wave * 2048 + F.lane;
    unsigned mlo = 0u, mhi = 0u; float inv_cmp = 0.f;
    u32x4 kreg, vreg = {0u, 0u, 0u, 0u};
    const bf16* kgp; size_t vdel, tstep; bool vmap_ld;
#define NSA_SETUP(br_) do { const int b_ = (br_); const bf16* Kg_; size_t pitch_; int tl_; \
        if (b_ < 2) { Kg_ = (const bf16*)(ws + WS_KCMP) + (size_t)(b * 256) * 128 + g * 64; vdel = (size_t)((const bf16*)(ws + WS_VCMP) - (const bf16*)(ws + WS_KCMP)); pitch_ = 128; tl_ = 0; } \
        else { Kg_ = ZA + (size_t)(b * SEQ) * ZA_LD + (b_ == 2 ? ZC_KS : ZC_KW) + g * 64; vdel = 128; pitch_ = ZA_LD; tl_ = (b_ == 3 && qt > 8) ? qt - 8 : 0; } \
        kgp = Kg_ + (size_t)(tl_ * 64 + srow) * pitch_ + sch * 8; tstep = (size_t)64 * pitch_; vmap_ld = b_ == 1; } while (0)
#define NSA_GLOAD(kt_) do { kreg = *(const u32x4*)kgp; if (!vmap_ld) vreg = *(const u32x4*)(kgp + vdel); kgp += tstep; } while (0)
    NSA_SETUP(0); NSA_GLOAD(0);
#pragma nounroll
    for (int br = 0; br < 4; ++br) {
        const bool iscmp = br < 2, vmap = br == 1;
        const int t_lo = iscmp ? 0 : ((br == 3 && qt > 8) ? qt - 8 : 0), t_hi = iscmp ? ((q0 + 32) >> 10) : qt;
        const int kmul = iscmp ? 16 : 1, kadd = iscmp ? 31 : 0, dmax = br == 3 ? 512 : 0x40000000;
        f32x16 o[2]; o[0] = f32x16{}; o[1] = f32x16{};
        float m = NEGBIG, l = 0.f;
#define NSA_LSTORE(kt_, buf_) do { \
        *(LAS u32x4*)(F.lds + NSA_K + (buf_) * 8192 + sch * 1024 + srow * 16) = kreg; \
        if (vmap) { const int c_ = (kt_) * 64 + srow, jj_ = c_ >> 2, mm_ = c_ & 3; \
            _Pragma("unroll") for (int i_ = 0; i_ < 4; ++i_) { const int j0_ = sch * 8 + 2 * i_, j1_ = j0_ + 1; \
                const unsigned e0_ = (c_ < NCMP) ? (mm_ < 3 ? (j0_ == jj_ ? 0x4000u : 0u) : ((j0_ == jj_ || j0_ == jj_ + 1) ? 0x3F80u : 0u)) : 0u; \
                const unsigned e1_ = (c_ < NCMP) ? (mm_ < 3 ? (j1_ == jj_ ? 0x4000u : 0u) : ((j1_ == jj_ || j1_ == jj_ + 1) ? 0x3F80u : 0u)) : 0u; \
                vreg[i_] = e0_ | (e1_ << 16); } } \
        *(LAS u32x4*)(F.lds + NSA_V + (buf_) * 8192 + (sch >> 2) * 4096 + srow * 64 + (sch & 3) * 16) = vreg; } while (0)
        NSA_LSTORE(t_lo, 0);
        __syncthreads();
        int buf = 0;
#pragma nounroll
        for (int kt = t_lo; kt <= t_hi; ++kt) {
            const int ktn = kt + 1; const bool more = kt < t_hi;
            if (more) NSA_GLOAD(ktn);
            const bool selbit = br == 2 ? (((kt < 32 ? (mlo >> kt) : (mhi >> (kt - 32))) & 1u) != 0u) : true;
            int mode = 0;
            { const int dmin = wq0 - (64 * kt + 63), dmx = wq0 + 7 - 64 * kt;
              if (br == 2) mode = dmin >= 790 ? 2 : (dmin >= 0 ? 1 : 0);
              if (br < 2) mode = 16 * (((wq0 - 31) >> 4) - (64 * kt + 63)) >= 790 ? 2 : 0;
              if (br == 3) mode = (dmin >= 0 && dmx <= 511) ? 1 : 0; }
            if (__any(selbit))
            nsa_tile(F.lds + NSA_K + buf * 8192, F.lds + NSA_V + buf * 8192, tbh, qr, o, m, l, kt, tq, kmul, kadd, dmax, selbit, mode, b31, r32, hi, F.lane);
            if (more) NSA_LSTORE(ktn, buf ^ 1);
            __syncthreads();
            buf ^= 1;
        }
#undef NSA_LSTORE
        if (br < 3) { NSA_SETUP(br + 1); NSA_GLOAD(0); }
        l += __shfl_xor(l, 32);
        const float inv = l > 0.f ? 1.0f / l : 0.f;
        if (br == 0) inv_cmp = inv;
        if (br != 1) { const float sc = inv * (br == 0 ? gate[0] : br == 2 ? gate[1] : gate[2]);
#pragma unroll
            for (int c = 0; c < 2; ++c)
#pragma unroll
                for (int r = 0; r < 16; ++r) { const float prev = br == 0 ? 0.f : ofw[(c * 16 + r) * 64]; ofw[(c * 16 + r) * 64] = prev + o[c][r] * sc; }
        } else {
            LAS float* scw = (LAS float*)(F.lds + NSA_SC) + F.wave * 512;
#pragma unroll
            for (int c = 0; c < 2; ++c)
#pragma unroll
                for (int r = 0; r < 16; ++r) { float v = o[c][r] * inv_cmp;
                    v += __builtin_bit_cast(float, __builtin_amdgcn_update_dpp(0, __builtin_bit_cast(int, v), 0xB1, 0xf, 0xf, true));
                    v += __builtin_bit_cast(float, __builtin_amdgcn_update_dpp(0, __builtin_bit_cast(int, v), 0x4E, 0xf, 0xf, true));
                    if (hh == 0) scw[qi * 64 + 32 * c + crow(r, hi)] = v; }
            LDS_WAIT();
            LAS unsigned* mskw = (LAS unsigned*)(F.lds + NSA_MSK) + F.wave * 16;
#pragma nounroll
            for (int q = 0; q < 8; ++q) {
                const int curq = (q0 + 8 * F.wave + q) >> 6, j = F.lane;
                const bool avail = j <= curq, forced = (j == 0) || (j == curq) || (j == curq - 1);
                const float sj = avail ? scw[q * 64 + j] + (forced ? 1e4f : 0.f) : NEGBIG;
                int rank = 0; const int sjb = __builtin_bit_cast(int, sj);
#pragma unroll
                for (int j2 = 0; j2 < 64; ++j2) { const float s2 = __builtin_bit_cast(float, __builtin_amdgcn_readlane(sjb, j2)); rank += (s2 > sj || (s2 == sj && j2 < j)) ? 1 : 0; }
                const bool sel = rank < 16 && avail;
                const unsigned long long bm = __ballot(sel);
                if (F.lane == 0) { mskw[2 * q] = (unsigned)bm; mskw[2 * q + 1] = (unsigned)(bm >> 32); } }
            LDS_WAIT();
            mlo = mskw[2 * qi]; mhi = mskw[2 * qi + 1];
        }
    }
#undef NSA_GLOAD
#undef NSA_SETUP
    bf16* OA = (bf16*)(ws + WS_OA) + (size_t)(b * SEQ + tq) * 512 + head * 64;
#pragma unroll
    for (int c = 0; c < 2; ++c)
#pragma unroll
        for (int r4 = 0; r4 < 4; ++r4) { u32x2 w; w.x = pk2(ofw[(c * 16 + 4 * r4) * 64], ofw[(c * 16 + 4 * r4 + 1) * 64]); w.y = pk2(ofw[(c * 16 + 4 * r4 + 2) * 64], ofw[(c * 16 + 4 * r4 + 3) * 64]);
            *(u32x2*)(OA + 32 * c + 8 * r4 + 4 * hi) = w; }
}
__device__ __forceinline__ void phase3(const Frame& F) {
    const bool xcd = (F.G == 256);
    const int pstart = xcd ? (F.bx >> 3) : F.bx, pstep = xcd ? 32 : F.G, pend = xcd ? 64 : 512;
#pragma nounroll
    for (int p2 = 2 * pstart; p2 < 2 * pend; p2 += (p2 & 1) ? 2 * pstep - 1 : 1) { const int p = p2 >> 1;
        const int b = xcd ? (F.bx & 7) : (p >> 6), g = (p >> 5) & 1, qt = p & 31;
        nsa_unit(F, b, g, (p2 & 1) ? qt : 63 - qt); }
    __syncthreads();
}

#define MFMA16(a, b, c) __builtin_amdgcn_mfma_f32_16x16x32_bf16((a), (b), (c), 0, 0, 0)
constexpr int DSA_SCP = 8200;
constexpr int DSA_SC = 0;
constexpr int DSA_LIST = 16 * DSA_SCP;
constexpr int DSA_NSEL = DSA_LIST + 8192;
constexpr int DSA_BIAS = DSA_NSEL + 64;
constexpr int DSA_HIST = DSA_BIAS + 1088;
constexpr int DSA_BKI = DSA_HIST + 8192;
constexpr int KSEL = 256;
__device__ __forceinline__ unsigned dsa_offb(unsigned row, unsigned ch) { return 256u * row + 16u * (ch ^ (((row & 3u) << 2) | ((row >> 2) & 3u))); }
__device__ __forceinline__ unsigned sortkey16(float x) { x = x + 0.0f; const unsigned short h = __builtin_bit_cast(unsigned short, (_Float16)x); return (h & 0x8000u) ? (unsigned)(unsigned short)~h : (unsigned)(h | 0x8000u); }
__device__ __forceinline__ int prefix_cnt(unsigned long long b) { return (int)__builtin_amdgcn_mbcnt_hi((unsigned)(b >> 32), __builtin_amdgcn_mbcnt_lo((unsigned)b, 0u)); }

__device__ __forceinline__ void dsa_unit(const Frame& F, const Args& a, int b, int qt16) {
    unsigned char* ws = F.ws;
    const bf16* ZA = (const bf16*)(ws + WS_ZA);
    const int lane = F.lane, l16 = lane & 15, quad = lane >> 4, q0 = qt16 * 16;
    __syncthreads();
#ifndef PROBE_DSA
#define PROBE_DSA 0
#endif
    for (int rep1_ = 0; rep1_ < (PROBE_DSA == 1 ? 2 : 1); ++rep1_) {
        const size_t qrow = (size_t)(b * SEQ + q0 + l16) * ZA_LD;
        bf16x8 qf[4][2];
#pragma unroll
        for (int i = 0; i < 4; ++i)
#pragma unroll
            for (int ks = 0; ks < 2; ++ks) qf[i][ks] = *(const bf16x8*)(ZA + qrow + ZC_QIDX + i * 64 + 32 * ks + 8 * quad);
        float wq[4];
#pragma unroll
        for (int i = 0; i < 4; ++i) wq[i] = bf2f(ZA[qrow + ZC_WIDX + i]) * 0.0625f;
        const int tq = q0 + l16, nkt = qt16 + 1;
        const bf16* kbase = ZA + (size_t)(b * SEQ + l16) * ZA_LD + ZC_KIDX + 8 * quad;
        bf16x8 ka[4][2], kn[4][2];
#define DSA_KLOAD(dst, kt0_) do { _Pragma("unroll") for (int t_ = 0; t_ < 4; ++t_) { const int k_ = (kt0_) + 8 * t_; const int kc_ = k_ < nkt ? k_ : nkt - 1; \
            dst[t_][0] = *(const bf16x8*)(kbase + (size_t)(kc_ * 16) * ZA_LD); dst[t_][1] = *(const bf16x8*)(kbase + (size_t)(kc_ * 16) * ZA_LD + 32); } } while (0)
        if (F.wave < nkt) DSA_KLOAD(ka, F.wave);
#pragma nounroll
        for (int kt0 = F.wave; kt0 < nkt; kt0 += 32) {
            if (kt0 + 32 < nkt) DSA_KLOAD(kn, kt0 + 32);
#pragma unroll
            for (int t = 0; t < 4; ++t) { const int kt = kt0 + 8 * t;
                if (kt < nkt) {
                    float idx[4] = {0.f, 0.f, 0.f, 0.f};
#pragma unroll
                    for (int i = 0; i < 4; ++i) { f32x4 acc = {0.f, 0.f, 0.f, 0.f}; acc = MFMA16(ka[t][0], qf[i][0], acc); acc = MFMA16(ka[t][1], qf[i][1], acc);
#pragma unroll
                        for (int r = 0; r < 4; ++r) idx[r] += fmaxf(acc[r], 0.f) * wq[i]; }
                    unsigned k16[4];
#pragma unroll
                    for (int r = 0; r < 4; ++r) { const int key = kt * 16 + 4 * quad + r; k16[r] = key <= tq ? sortkey16(idx[r]) : 0u; }
                    u32x2 w; w.x = k16[0] | (k16[1] << 16); w.y = k16[2] | (k16[3] << 16);
                    *(LAS u32x2*)(F.lds + DSA_SC + l16 * DSA_SCP + (kt * 16 + 4 * quad) * 2) = w; } }
#pragma unroll
            for (int t = 0; t < 4; ++t) { ka[t][0] = kn[t][0]; ka[t][1] = kn[t][1]; }
        }
#undef DSA_KLOAD
    }
    if (F.tid < 264) { const float* rb = a.in[11]; ((LAS float*)(F.lds + DSA_BIAS))[F.tid] = F.tid < 256 ? rb[(F.tid >> 3) * 16 + 8 + (F.tid & 7)] * LOG2E : NEGBIG; }
    __syncthreads();
#pragma nounroll
    for (int qq = 0; qq < (PROBE_DSA == 2 ? 4 : 2); ++qq) {
        const int n = 2 * F.wave + (qq & 1), tq = q0 + n, N = tq + 1;
        LAS unsigned char* scq = F.lds + DSA_SC + n * DSA_SCP;
        LAS unsigned short* lst = (LAS unsigned short*)(F.lds + DSA_LIST) + n * 256;
        LAS unsigned short* bki = (LAS unsigned short*)(F.lds + DSA_BKI) + n * 256;
        if (N <= KSEL) {
            for (int s = lane; s < KSEL; s += 64) lst[s] = (unsigned short)(s < N ? s : 0);
            if (lane == 0) ((LAS int*)(F.lds + DSA_NSEL))[n] = N;
        } else {
            const int nit = (N + 255) >> 8;
            { const int it = nit - 1; const int s0 = 4 * (lane + 64 * it); u32x2 w = *(LAS u32x2*)(scq + s0 * 2);
              if (s0 + 0 > tq) w.x &= 0xffff0000u; if (s0 + 1 > tq) w.x &= 0x0000ffffu; if (s0 + 2 > tq) w.y &= 0xffff0000u; if (s0 + 3 > tq) w.y &= 0x0000ffffu;
              *(LAS u32x2*)(scq + s0 * 2) = w; }
            LDS_WAIT();
            LAS unsigned* hist = (LAS unsigned*)(F.lds + DSA_HIST) + F.wave * 256;
            unsigned T = 0u; int cgt = 0; int need = KSEL;
#pragma nounroll
            for (int lvl = 0; lvl < 2; ++lvl) {
                *(LAS u32x4*)(hist + 4 * lane) = (u32x4){0u, 0u, 0u, 0u};
                LDS_WAIT();
#pragma nounroll
                for (int it = 0; it < nit; ++it) { const u32x2 w = *(LAS u32x2*)(scq + (lane + 64 * it) * 8);
                    const unsigned k[4] = {w.x & 0xffffu, w.x >> 16, w.y & 0xffffu, w.y >> 16};
#pragma unroll
                    for (int e = 0; e < 4; ++e) { const bool in = lvl == 0 ? true : (k[e] >> 8) == (T >> 8); const unsigned bin = lvl == 0 ? (k[e] >> 8) : (k[e] & 255u);
                        if (in) __hip_atomic_fetch_add(hist + bin, 1u, __ATOMIC_RELAXED, __HIP_MEMORY_SCOPE_WORKGROUP); } }
                LDS_WAIT();
                const u32x4 h = *(LAS u32x4*)(hist + 4 * lane);
                const int sl = (int)(h.x + h.y + h.z + h.w); int suf = sl;
#pragma unroll
                for (int d = 1; d < 64; d <<= 1) { const int o = __shfl_down(suf, d); suf += (lane + d < 64) ? o : 0; }
                const int above = suf - sl;
                const bool here = above < need && above + sl >= need;
                int bsel = 4 * lane + 3, ca = above;
                if (ca + (int)h.w < need) { ca += (int)h.w; bsel = 4 * lane + 2; if (ca + (int)h.z < need) { ca += (int)h.z; bsel = 4 * lane + 1; if (ca + (int)h.y < need) { ca += (int)h.y; bsel = 4 * lane; } } }
                const unsigned long long bm = __ballot(here);
                const int src = bm ? (int)__builtin_ctzll(bm) : 0;
                const int B = __shfl(bsel, src), CA = __shfl(ca, src);
                if (lvl == 0) T = (unsigned)B << 8; else T |= (unsigned)B;
                cgt += CA; need -= CA;
                LDS_WAIT();
            }
            const int rties = KSEL - cgt;
            int tiebase = 0, outbase = 0;
#define DSA_PUT(pos_, idx_) do { const int p_ = (pos_); if (p_ >= 0 && p_ < KSEL) lst[p_] = (unsigned short)(idx_); } while (0)
#pragma nounroll
            for (int it = 0; it < nit; ++it) { const u32x2 w = *(LAS u32x2*)(scq + (lane + 64 * it) * 8);
                const unsigned k0 = w.x & 0xffffu, k1 = w.x >> 16, k2 = w.y & 0xffffu, k3 = w.y >> 16;
                const int sidx = 4 * (lane + 64 * it);
                const bool g0 = k0 > T, g1 = k1 > T, g2 = k2 > T, g3 = k3 > T;
                const unsigned long long bg0 = __ballot(g0), bg1 = __ballot(g1), bg2 = __ballot(g2), bg3 = __ballot(g3);
                if (bg0 | bg1 | bg2 | bg3) {
                    int pos = outbase + prefix_cnt(bg0) + prefix_cnt(bg1) + prefix_cnt(bg2) + prefix_cnt(bg3);
                    if (g0) { DSA_PUT(pos, sidx + 0); ++pos; }
                    if (g1) { DSA_PUT(pos, sidx + 1); ++pos; }
                    if (g2) { DSA_PUT(pos, sidx + 2); ++pos; }
                    if (g3) { DSA_PUT(pos, sidx + 3); ++pos; }
                    outbase += __popcll(bg0) + __popcll(bg1) + __popcll(bg2) + __popcll(bg3); }
                const bool e0 = k0 == T, e1 = k1 == T, e2 = k2 == T, e3 = k3 == T;
                const unsigned long long be0 = __ballot(e0), be1 = __ballot(e1), be2 = __ballot(e2), be3 = __ballot(e3);
                if ((be0 | be1 | be2 | be3) && tiebase < rties) {
                    const int t0 = tiebase + prefix_cnt(be0) + prefix_cnt(be1) + prefix_cnt(be2) + prefix_cnt(be3), t1 = t0 + (e0 ? 1 : 0), t2 = t1 + (e1 ? 1 : 0), t3 = t2 + (e2 ? 1 : 0);
                    if (e0 && t0 < rties) DSA_PUT(KSEL - 1 - t0, sidx + 0);
                    if (e1 && t1 < rties) DSA_PUT(KSEL - 1 - t1, sidx + 1);
                    if (e2 && t2 < rties) DSA_PUT(KSEL - 1 - t2, sidx + 2);
                    if (e3 && t3 < rties) DSA_PUT(KSEL - 1 - t3, sidx + 3);
                    tiebase += __popcll(be0) + __popcll(be1) + __popcll(be2) + __popcll(be3); } }
#undef DSA_PUT
            outbase = KSEL;
            if (lane == 0) ((LAS int*)(F.lds + DSA_NSEL))[n] = outbase < KSEL ? outbase : KSEL;
        }
        LDS_WAIT();
        { const int nsl = N < KSEL ? N : KSEL;
#pragma unroll
          for (int i = 0; i < 4; ++i) { const int e = lane + 64 * i; const int dist = tq - (int)lst[e];
              const int dpos = dist < 1 ? 1 : dist; int bl = 16 + (int)((__log2f((float)dpos) - 4.0f) * 2.66666675f); bl = bl > 31 ? 31 : bl;
              const int bk = dist < 1 ? 0 : (dpos < 16 ? dpos : bl);
              bki[e] = (unsigned short)(e < nsl ? bk * 32 : 1024); } }
    }
    LDS_WAIT();
    const bf16* CK = (const bf16*)(ws + WS_CKVN) + (size_t)(b * SEQ) * 128;
    LAS unsigned char* gb0 = F.lds + DSA_SC + (2 * F.wave) * DSA_SCP;
    const LAS unsigned char* biasb = F.lds + DSA_BIAS + (l16 & 7) * 4;
#define DSA_GATHER(chunk_, buf_) do { const unsigned key_ = lst[(chunk_) * 32 + (lane >> 1)]; const char* src_ = (const char*)CK + (key_ * 256u + (unsigned)(lane & 1) * 16u); \
        _Pragma("unroll") for (int c_ = 0; c_ < 8; ++c_) __builtin_amdgcn_global_load_lds((const unsigned*)(src_ + c_ * 32), (LAS unsigned*)(gb0 + (buf_) * 8192 + c_ * 1024), 16, 0, 0); } while (0)
    int tqs[2], nsels[2]; const LAS unsigned short* lsts[2]; const LAS unsigned short* bkis[2]; bf16x8 ql[2][4]; f32x4 o[2][8]; float ms[2], ls[2];
#pragma unroll
    for (int qq = 0; qq < 2; ++qq) { const int n = 2 * F.wave + qq; tqs[qq] = q0 + n; nsels[qq] = ((const LAS int*)(F.lds + DSA_NSEL))[n]; lsts[qq] = (const LAS unsigned short*)(F.lds + DSA_LIST) + n * 256; bkis[qq] = (const LAS unsigned short*)(F.lds + DSA_BKI) + n * 256;
#pragma unroll
        for (int s2 = 0; s2 < 4; ++s2) { const bf16x8 v = *(const bf16x8*)(ZA + (size_t)(b * SEQ + tqs[qq]) * ZA_LD + ZC_QLAT + (l16 & 7) * 128 + 32 * s2 + 8 * quad); ql[qq][s2] = l16 < 8 ? v : (bf16x8){0, 0, 0, 0, 0, 0, 0, 0}; }
#pragma unroll
        for (int c = 0; c < 8; ++c) o[qq][c] = (f32x4){0.f, 0.f, 0.f, 0.f};
        ms[qq] = NEGBIG; ls[qq] = 0.f; }
#pragma unroll
    for (int qq = 0; qq < 2; ++qq)
#pragma unroll
        for (int s2 = 0; s2 < 4; ++s2) asm volatile("" : "+v"(ql[qq][s2]));
    const int nch1 = (nsels[1] + 31) >> 5, nch = PROBE_DSA == 3 ? 2 * nch1 : nch1;
    LDS_WAIT();
    { const LAS unsigned short* lst = lsts[0]; DSA_GATHER(0, 0); }
    { const LAS unsigned short* lst = lsts[1]; DSA_GATHER(0, 1); }
    const unsigned offA = (unsigned)((quad >> 1) * 1024 + l16 * 32 + (quad & 1) * 16);
    const unsigned offT = (unsigned)((4 * quad + (l16 >> 2)) * 32 + 8 * (lane & 3));
#pragma nounroll
    for (int ch = 0; ch < nch; ++ch) {
#pragma unroll
        for (int qq = 0; qq < 2; ++qq) {
            const int chd = ch >= nch1 ? ch - nch1 : ch;
            const LAS unsigned short* lst = lsts[qq];
            const LAS unsigned char* gb = gb0 + qq * 8192;
            if (qq == 0 || ch + 1 < nch) asm volatile("s_waitcnt vmcnt(8)" ::: "memory"); else asm volatile("s_waitcnt vmcnt(0)" ::: "memory");
            f32x4 acc2[2]; float bvs[2][4];
#pragma unroll
            for (int rb = 0; rb < 2; ++rb) { f32x4 acc = {0.f, 0.f, 0.f, 0.f};
#pragma unroll
                for (int s2 = 0; s2 < 4; ++s2) { const bf16x8 af = *(const LAS bf16x8*)(gb + offA + rb * 512 + s2 * 2048); acc = MFMA16(af, ql[qq][s2], acc); }
                acc2[rb] = acc;
                const u32x2 kb = *(const LAS u32x2*)((const LAS unsigned char*)bkis[qq] + (chd * 32 + rb * 16 + 4 * quad) * 2);
                bvs[rb][0] = *(const LAS float*)(biasb + (kb.x & 0xffffu)); bvs[rb][1] = *(const LAS float*)(biasb + (kb.x >> 16));
                bvs[rb][2] = *(const LAS float*)(biasb + (kb.y & 0xffffu)); bvs[rb][3] = *(const LAS float*)(biasb + (kb.y >> 16)); }
#pragma unroll
            for (int rb = 0; rb < 2; ++rb)
#pragma unroll
                for (int r = 0; r < 4; ++r) asm volatile("" : "+v"(bvs[rb][r]));
            float x[2][4]; float tmax = NEGBIG;
#pragma unroll
            for (int rb = 0; rb < 2; ++rb)
#pragma unroll
                for (int r = 0; r < 4; ++r) { const float xv = acc2[rb][r] * C2 + bvs[rb][r]; x[rb][r] = xv; tmax = fmaxf(tmax, xv); }
            tmax = fmaxf(tmax, __shfl_xor(tmax, 16)); tmax = fmaxf(tmax, __shfl_xor(tmax, 32));
            const float mn = fmaxf(ms[qq], tmax); const bool resc = __any(mn != ms[qq]); const float alpha = __builtin_amdgcn_exp2f(ms[qq] - mn); ms[qq] = mn;
            float ps = 0.f;
#pragma unroll
            for (int rb = 0; rb < 2; ++rb)
#pragma unroll
                for (int r = 0; r < 4; ++r) { const float pv = __builtin_amdgcn_exp2f(x[rb][r] - mn); x[rb][r] = pv; ps += pv; }
            ls[qq] = ls[qq] * alpha + ps;
            if (resc) {
#pragma unroll
                for (int c = 0; c < 8; ++c) o[qq][c] = o[qq][c] * alpha; }
            u32x4 pw; pw.x = pk2(x[0][0], x[0][1]); pw.y = pk2(x[0][2], x[0][3]); pw.z = pk2(x[1][0], x[1][1]); pw.w = pk2(x[1][2], x[1][3]);
            const unsigned gba = (unsigned)(unsigned long long)gb + offT;
#pragma unroll
            for (int cb = 0; cb < 2; ++cb) {
                s16x4 v[8];
                if (cb == 0) asm volatile("ds_read_b64_tr_b16 %0, %8\n\tds_read_b64_tr_b16 %1, %8 offset:512\n\tds_read_b64_tr_b16 %2, %8 offset:1024\n\tds_read_b64_tr_b16 %3, %8 offset:1536\n\t"
                             "ds_read_b64_tr_b16 %4, %8 offset:2048\n\tds_read_b64_tr_b16 %5, %8 offset:2560\n\tds_read_b64_tr_b16 %6, %8 offset:3072\n\tds_read_b64_tr_b16 %7, %8 offset:3584\n\ts_waitcnt lgkmcnt(0)"
                             : "=&v"(v[0]), "=&v"(v[1]), "=&v"(v[2]), "=&v"(v[3]), "=&v"(v[4]), "=&v"(v[5]), "=&v"(v[6]), "=&v"(v[7]) : "v"(gba) : "memory");
                else asm volatile("ds_read_b64_tr_b16 %0, %8 offset:4096\n\tds_read_b64_tr_b16 %1, %8 offset:4608\n\tds_read_b64_tr_b16 %2, %8 offset:5120\n\tds_read_b64_tr_b16 %3, %8 offset:5632\n\t"
                             "ds_read_b64_tr_b16 %4, %8 offset:6144\n\tds_read_b64_tr_b16 %5, %8 offset:6656\n\tds_read_b64_tr_b16 %6, %8 offset:7168\n\tds_read_b64_tr_b16 %7, %8 offset:7680\n\ts_waitcnt lgkmcnt(0)"
                             : "=&v"(v[0]), "=&v"(v[1]), "=&v"(v[2]), "=&v"(v[3]), "=&v"(v[4]), "=&v"(v[5]), "=&v"(v[6]), "=&v"(v[7]) : "v"(gba) : "memory");
#pragma unroll
                for (int c4 = 0; c4 < 4; ++c4) { const int c = 4 * cb + c4; const s16x4 v0 = v[2 * c4], v1 = v[2 * c4 + 1];
                    const bf16x8 vf = {v0[0], v0[1], v0[2], v0[3], v1[0], v1[1], v1[2], v1[3]};
                    o[qq][c] = MFMA16(vf, __builtin_bit_cast(bf16x8, pw), o[qq][c]); }
            }
            LDS_WAIT();
            if (ch + 1 < nch) DSA_GATHER((ch + 1 >= nch1 ? ch + 1 - nch1 : ch + 1), qq);
        }
    }
#pragma unroll
    for (int qq = 0; qq < 2; ++qq) {
        float l = ls[qq]; const int tq = tqs[qq];
        l += __shfl_xor(l, 16); l += __shfl_xor(l, 32);
        const float inv = l > 0.f ? 1.0f / l : 0.f;
        if (l16 < 8) { bf16* op = (bf16*)(ws + WS_OLAT) + (size_t)(b * SEQ + tq) * 1024 + l16 * 128 + 4 * quad;
#pragma unroll
            for (int c = 0; c < 8; ++c) { u32x2 w; w.x = pk2(o[qq][c][0] * inv, o[qq][c][1] * inv); w.y = pk2(o[qq][c][2] * inv, o[qq][c][3] * inv); *(u32x2*)(op + 16 * c) = w; } }
    }
}
#undef DSA_GATHER
__device__ __forceinline__ void phase4(const Frame& F, const Args& a) {
    const bool xcd = (F.G == 256);
    const int pstart = xcd ? (F.bx >> 3) : F.bx, pstep = xcd ? 32 : F.G, pend = xcd ? 128 : 1024;
#pragma nounroll
    for (int p2 = 2 * pstart; p2 < 2 * pend; p2 += (p2 & 1) ? 2 * pstep - 1 : 1) { const int p = p2 >> 1;
        const int b = xcd ? (F.bx & 7) : (p >> 7), j = p & 127;
        dsa_unit(F, a, b, (p2 & 1) ? j : 255 - j); }
    __syncthreads();
}

constexpr int NPHASE = 11;
__global__ void __launch_bounds__(NTHR, 2) fwd_kernel(Args args) {
    extern __shared__ __attribute__((aligned(16))) unsigned char lds_raw[];
    Frame F;
    F.lds = (LAS unsigned char*)lds_raw;
    F.tid = threadIdx.x; F.lane = F.tid & 63; F.wave = __builtin_amdgcn_readfirstlane(F.tid >> 6);
    F.G = gridDim.x; F.bx = blockIdx.x; F.ws = args.ws;
    unsigned char* ws = args.ws;
    volatile LAS unsigned* MISC = (volatile LAS unsigned*)(F.lds + MISC_OFF);
    if (F.tid < 64) MISC[F.tid] = 0u;
    __syncthreads();
    const int lo = args.ph_lo, hi = args.ph_hi;
    XcdBarrier bar; bar.bar = (unsigned*)(ws + WS_CTL) + CW_BAR; bar.x = 0; bar.st = nullptr;
    if (hi - lo > 1) bar = xcd_barrier_post((unsigned*)(ws + WS_CTL) + CW_BAR, MISC + 8);
#ifndef PH_MASK
#define PH_MASK 0xFFFF
#endif
#define IN(k) ((((PH_MASK) >> (k)) & 1) && lo <= (k) && (k) < hi)
#define SEAM(k) do { if (IN(k) && IN((k) + 1)) xcd_barrier(bar); } while (0)
#ifndef PROBE_PHASE
#define PROBE_PHASE -1
#endif
#define REPEAT(k) for (int rep_ = 0; rep_ < ((PROBE_PHASE) == (k) ? 2 : 1); ++rep_, ((PROBE_PHASE) == (k) && rep_ < 2 ? xcd_barrier(bar) : (void)0))

    if (IN(0)) REPEAT(0) { phase0(F, args); }
    SEAM(0);
    if (IN(1)) REPEAT(1) {
#ifndef PROBE_GEMM
#define PROBE_GEMM 0
#endif
        pg8::StaticOrder S; S.init(NTOK / 256, NZ / 256, F.G, F.bx, PROBE_GEMM == 1 ? 2 : 1);
        const APlain AA{ws + WS_XB, 128u, (unsigned)(D * 2)}; const BPlain BA{(const bf16*)(ws + WS_WINT), D};
        const EpiZ E{(bf16*)(ws + WS_ZA), (bf16*)(ws + WS_ZG)};
        pg8::gemm_phase(F.lds, D, S, AA, BA, E);
        { const int nu = (NTOK / 256) * (NZ / 256), rem = nu % F.G;
          if (rem != 0 && F.bx >= rem) p0_experts(F, args, (F.bx - rem) * NWAVES + F.wave, (F.G - rem) * NWAVES, 0, P0_EXP_ITEMS); }
    }
    SEAM(1);
    if (IN(2)) REPEAT(2) { phase2(F, args); }
    SEAM(2);
    if (IN(3)) REPEAT(3) { phase3(F); }
    if (IN(4)) REPEAT(4) { phase4(F, args); }
    SEAM(4);
    if (IN(5)) REPEAT(5) {
        pg8::StaticOrder S; S.init(NTOK / 256, D / 256, F.G, F.bx);
        { const APlain AA{ws + WS_OA, 128u, 1024u}; const BPlain BA{(const bf16*)(ws + WS_WAT), 512};
          const EpiGate<0> E{(const bf16*)(ws + WS_ZG), nullptr, (bf16*)(ws + WS_T1)};
          pg8::gemm_phase(F.lds, 512, S, AA, BA, E); }
        { const APlain AA{ws + WS_OLAT, 128u, 2048u}; const BPlain BA{(const bf16*)(ws + WS_WBT), 1024};
          const EpiGate<1> E{(const bf16*)(ws + WS_ZG), (const bf16*)(ws + WS_T1), (bf16*)(ws + WS_MERGED)};
          pg8::gemm_phase(F.lds, 1024, S, AA, BA, E); }
    }
    SEAM(5);
    if (IN(6)) REPEAT(6) {
        pg8::StaticOrder S; S.init(NTOK / 256, D / 256, F.G, F.bx, PROBE_GEMM == 6 ? 2 : 1);
        const APlain AA{ws + WS_MERGED, 128u, 2048u}; const BPlain BA{(const bf16*)(ws + WS_WOT), 1024};
        const EpiRes E{args.in[0], (bf16*)(ws + WS_H1)};
        pg8::gemm_phase(F.lds, 1024, S, AA, BA, E);
    }
    SEAM(6);
    if (IN(7)) { phase6(F, args); }
    SEAM(7);
    if (IN(8)) REPEAT(8) {
        moe_setup(F);
        const MoeOrder S{F.G, F.bx, 2, (const LAS int*)(F.lds + MOE_CUM), (const LAS int*)(F.lds + MOE_CUM) + 40};
        const AGather AA{ws + WS_H1B, 128u, (const int*)(ws + WS_LIST)}; const BGu BA{(const bf16*)(ws + WS_WGU)};
        const EpiAct E{(bf16*)(ws + WS_ACT)};
        pg8::gemm_phase(F.lds, 1024, S, AA, BA, E);
    }
    SEAM(8);
    if (IN(9)) REPEAT(9) {
        moe_setup(F);
        const MoeOrder S{F.G, F.bx, 4, (const LAS int*)(F.lds + MOE_CUM), (const LAS int*)(F.lds + MOE_CUM) + 40};
        const APlain AA{ws + WS_ACT, 128u, 512u}; const BDn BA{(const bf16*)(ws + WS_WDT)};
        const EpiDown E{(bf16*)(ws + WS_YBUF), (const int*)(ws + WS_LIST)};
        pg8::gemm_phase(F.lds, 256, S, AA, BA, E);
    }
    SEAM(9);
    if (IN(10)) REPEAT(10) { phase9(F, args); }
#undef IN
#undef SEAM
#undef REPEAT
}

extern "C" void kernel_launch(void* const* d_in, const int* in_sizes, int n_in, void* d_out, int out_size, void* d_ws, size_t ws_size, hipStream_t stream) {
    static int grid = 0;
    if (grid == 0) {
        if (n_in != 26 || in_sizes[0] != NTOK * D || out_size != NTOK * D || ws_size < WS_END) {
            fprintf(stderr, "kernel_launch: unexpected problem: n_in %d in0 %d out %d ws %zu (need %zu)\n", n_in, n_in > 0 ? in_sizes[0] : -1, out_size, ws_size, (size_t)WS_END); grid = -1; return; }
        int dev = 0, cus = 0, per_cu = 0;
        if (hipGetDevice(&dev) != hipSuccess || hipDeviceGetAttribute(&cus, hipDeviceAttributeMultiprocessorCount, dev) != hipSuccess) { grid = -1; return; }
        if (hipFuncSetAttribute((const void*)fwd_kernel, hipFuncAttributeMaxDynamicSharedMemorySize, LDS_BYTES) != hipSuccess) { fprintf(stderr, "kernel_launch: hipFuncSetAttribute failed\n"); grid = -1; return; }
        if (hipOccupancyMaxActiveBlocksPerMultiprocessor(&per_cu, (const void*)fwd_kernel, NTHR, LDS_BYTES) != hipSuccess || per_cu < 1)
            fprintf(stderr, "kernel_launch: occupancy query reports %d\n", per_cu);
        (void)hipGetLastError();
        grid = cus;
    }
    if (grid < 0) return;
    if (hipMemsetAsync((char*)d_ws + WS_CTL, 0, CTL_ZERO_BYTES, stream) != hipSuccess) return;
    Args a{};
    for (int i = 0; i < 26; ++i) a.in[i] = (const float*)d_in[i];
    a.out = (float*)d_out; a.ws = (unsigned char*)d_ws;
#if MK_PER_PHASE
    for (int p = 0; p < NPHASE; ++p) { a.ph_lo = p; a.ph_hi = p + 1; hipLaunchKernelGGL(fwd_kernel, dim3(grid), dim3(NTHR), LDS_BYTES, stream, a); }
#else
    a.ph_lo = 0; a.ph_hi = NPHASE;
    hipLaunchKernelGGL(fwd_kernel, dim3(grid), dim3(NTHR), LDS_BYTES, stream, a);
#endif
}
```

```cpp
#include <hip/hip_runtime.h>
#include <cstdio>
#include <cstdint>

#ifndef MK_PER_PHASE
#define MK_PER_PHASE 0
#endif

#define GAS __attribute__((address_space(1)))
#define LAS __attribute__((address_space(3)))
typedef unsigned short bf16;
typedef short bf16x8 __attribute__((ext_vector_type(8)));
typedef short s16x4 __attribute__((ext_vector_type(4)));
typedef float f32x4 __attribute__((ext_vector_type(4)));
typedef float f32x16 __attribute__((ext_vector_type(16)));
typedef float f32x2 __attribute__((ext_vector_type(2)));
typedef unsigned u32x4 __attribute__((ext_vector_type(4)));
typedef unsigned u32x2 __attribute__((ext_vector_type(2)));

constexpr int D = 1024, BATCH = 8, SEQ = 4096, NTOK = BATCH * SEQ;
constexpr int D_IN = 4316;
constexpr int NCMP = 255;
constexpr float ALPHA = 1.189207115002721f;
constexpr float LOG2E = 1.4426950408889634f;
constexpr float NEGBIG = -1e30f;
constexpr int ZA_LD = 2816;
constexpr int ZC_QA = 0, ZC_KC = 512, ZC_VC = 640, ZC_KS = 768, ZC_VS = 896, ZC_KW = 1024, ZC_VW = 1152, ZC_QLAT = 1280, ZC_CKV = 2304,
              ZC_QIDX = 2432, ZC_KIDX = 2688, ZC_GNSA = 2752, ZC_WIDX = 2776;
constexpr int ZG_LD = 2048;
constexpr int NZ = ZA_LD + ZG_LD;
constexpr int NEXP = 32, DEXP = 256;
constexpr int MAXTILES = (2 * NTOK) / 256 + NEXP;

constexpr size_t MiB = 1u << 20;
constexpr size_t WS_CTL = 0, CTL_ZERO_BYTES = 1 * MiB;
constexpr size_t WS_WAT = 1 * MiB;
constexpr size_t WS_WBT = 2 * MiB;
constexpr size_t WS_WOT = 4 * MiB;
constexpr size_t WS_W1K = 6 * MiB;
constexpr size_t WS_W1V = 7 * MiB;
constexpr size_t WS_W2K = 8 * MiB;
constexpr size_t WS_W2V = 8 * MiB + 64 * 1024;
constexpr size_t WS_BIASK = 8 * MiB + 128 * 1024;
constexpr size_t WS_TBA = 8 * MiB + 256 * 1024;
constexpr size_t WS_TBB = 8 * MiB + 320 * 1024;
constexpr size_t WS_KCMP = 9 * MiB;
constexpr size_t WS_VCMP = 9 * MiB + 512 * 1024;
constexpr size_t WS_TOKINFO = 10 * MiB;
constexpr size_t WS_LIST = 11 * MiB;
constexpr size_t WS_WINT = 16 * MiB;
constexpr size_t WS_WGU = 32 * MiB;
constexpr size_t WS_WDT = 64 * MiB;
constexpr size_t WS_CKVN = 80 * MiB;
constexpr size_t WS_XB = 96 * MiB;
constexpr size_t WS_OLAT = 96 * MiB;
constexpr size_t WS_H1B = 96 * MiB;
constexpr size_t WS_ZA = 160 * MiB;
constexpr size_t WS_T1 = 160 * MiB;
constexpr size_t WS_ACT = 160 * MiB;
constexpr size_t WS_YBUF = 196 * MiB;
constexpr size_t WS_MERGED = 224 * MiB;
constexpr size_t WS_ZG = 336 * MiB;
constexpr size_t WS_H1 = 336 * MiB;
constexpr size_t WS_OA = 464 * MiB;
constexpr size_t WS_END = 496 * MiB;

constexpr int CW_BAR = 4096;
constexpr int CW_CNT = 16384;

constexpr int LDS_BYTES = 163840;
constexpr int MISC_OFF = 160 * 1024 - 256;

__device__ __forceinline__ unsigned f2bf(float f) { unsigned u = __builtin_bit_cast(unsigned, f); return (u + 0x7fffu + ((u >> 16) & 1u)) >> 16; }
__device__ __forceinline__ unsigned pk2(float lo, float hi) { unsigned r; asm volatile("v_cvt_pk_bf16_f32 %0, %1, %2" : "=v"(r) : "v"(lo), "v"(hi)); return r; }
__device__ __forceinline__ float bf2f(unsigned short b) { return __builtin_bit_cast(float, ((unsigned)b) << 16); }
__device__ __forceinline__ float bflo(unsigned w) { return __builtin_bit_cast(float, w << 16); }
__device__ __forceinline__ float bfhi(unsigned w) { return __builtin_bit_cast(float, w & 0xffff0000u); }
__device__ __forceinline__ float wave_sum(float v) {
#pragma unroll
    for (int o = 1; o < 64; o <<= 1) v += __shfl_xor(v, o);
    return v;
}
__device__ __forceinline__ float sigmoidf_(float x) { return __builtin_amdgcn_rcpf(1.0f + __builtin_amdgcn_exp2f(-1.4426950408889634f * x)); }
#define LDS_WAIT() asm volatile("s_waitcnt lgkmcnt(0)" ::: "memory")
#define VM_WAIT() asm volatile("s_waitcnt vmcnt(0)" ::: "memory")

#define XB_TMO      128
#define XB_XCNT(j)  (256  + 64 * (j))
#define XB_XSUB(j)  (1280 + 64 * (j))
#define XB_XGEN(j)  (2304 + 64 * (j))
#define XB_TOP      3328
#define XB_TOPGEN   3392
#define XCD_BAR_WORDS 3456
#define XB_SPIN_CAP (1u << 18)
__device__ __forceinline__ unsigned xb_ld(unsigned* p)              { return __hip_atomic_load(p, __ATOMIC_RELAXED, __HIP_MEMORY_SCOPE_AGENT); }
__device__ __forceinline__ unsigned xb_add(unsigned* p, unsigned v) { return __hip_atomic_fetch_add(p, v, __ATOMIC_RELAXED, __HIP_MEMORY_SCOPE_AGENT); }
__device__ __forceinline__ unsigned xb_xcc_id() { return (unsigned)__builtin_amdgcn_s_getreg((3 << 11) | 20) & 0xFu; }
#define XB_SPIN(cond, bar) do { unsigned _sp = 0; while (cond) { __builtin_amdgcn_s_sleep(1); \
    if ((++_sp & 255u) == 0u) { if (xb_ld(&(bar)[XB_TMO])) break; if (_sp > XB_SPIN_CAP) { atomicAdd(&(bar)[XB_TMO], 1u); break; } } } } while (0)
struct XcdBarrier { unsigned* bar; unsigned x; volatile LAS unsigned* st; };
__device__ __forceinline__ XcdBarrier xcd_barrier_post(unsigned* bar, volatile LAS unsigned* st) {
    XcdBarrier b; b.bar = bar; b.x = xb_xcc_id(); b.st = st;
    if (threadIdx.x == 0) (void)xb_add(&bar[XB_XCNT(b.x)], 1u);
    return b;
}
__device__ __forceinline__ void xcd_barrier_complete(unsigned* bar, unsigned x, unsigned& nloc, unsigned& nx) {
    const unsigned G = gridDim.x * gridDim.y * gridDim.z;
    unsigned sum, cnt, mine, sp = 0u;
    for (;;) {
        sum = 0u; cnt = 0u; mine = 0u;
#pragma unroll
        for (unsigned j = 0; j < 16; ++j) { const unsigned c = xb_ld(&bar[XB_XCNT(j)]); sum += c; cnt += (c > 0u) ? 1u : 0u; mine = (j == x) ? c : mine; }
        if (sum == G) break;
        __builtin_amdgcn_s_sleep(1);
        if ((++sp & 255u) == 0u) { if (xb_ld(&bar[XB_TMO])) break; if (sp > XB_SPIN_CAP) { atomicAdd(&bar[XB_TMO], 1u); break; } }
    }
    nloc = mine > 0u ? mine : 1u; nx = cnt > 0u ? cnt : 1u;
}
__device__ __forceinline__ void xcd_barrier(const XcdBarrier& b) {
    asm volatile("s_waitcnt vmcnt(0)" ::: "memory");
    __syncthreads();
    if (threadIdx.x == 0) {
        unsigned* bar = b.bar;
        __builtin_amdgcn_s_waitcnt(0);
        unsigned nloc = b.st[0], nx = b.st[1];
        if (nloc == 0u) { xcd_barrier_complete(bar, b.x, nloc, nx); b.st[0] = nloc; b.st[1] = nx; }
        const unsigned old = xb_add(&bar[XB_XSUB(b.x)], 1u);
        const unsigned gen = old / nloc;
        if (old + 1u == (gen + 1u) * nloc) {
            __builtin_amdgcn_fence(__ATOMIC_RELEASE, "agent");
            asm volatile("s_waitcnt vmcnt(0)" ::: "memory");
            const unsigned og = xb_add(&bar[XB_TOP], 1u);
            const unsigned tg = og / nx;
            if (og + 1u == (tg + 1u) * nx) xb_add(&bar[XB_TOPGEN], 1u);
            else XB_SPIN(xb_ld(&bar[XB_TOPGEN]) == tg, bar);
            __builtin_amdgcn_fence(__ATOMIC_ACQUIRE, "agent");
            xb_add(&bar[XB_XGEN(b.x)], 1u);
            asm volatile("s_waitcnt vmcnt(0)" ::: "memory");
        } else {
            XB_SPIN(xb_ld(&bar[XB_XGEN(b.x)]) == gen, bar);
            __builtin_amdgcn_fence(__ATOMIC_ACQUIRE, "agent");
            asm volatile("s_waitcnt vmcnt(0)" ::: "memory");
        }
    }
    __syncthreads();
}

namespace pg8 {
constexpr int BM = 256, BK = 64, HALF = 128, HTB = HALF * BK * 2, STAGE_BYTES = 8 * HTB, NXCD = 8, WGM = 8;
__host__ __device__ __forceinline__ int lds_byte(int r, int c) { const int st = (r >> 4) * 2 + (c >> 5), rr = r & 15, cc = c & 31, ob = rr * 64 + cc * 2; return st * 1024 + (ob ^ (((ob >> 9) & 1) << 5)); }
__host__ __device__ __forceinline__ void stage_rc(int b, int& R, int& C) { const int st = b / 1024, sb = b % 1024, swz = sb ^ (((sb >> 9) & 1) << 5); R = (st >> 1) * 16 + swz / 64; C = (st & 1) * 32 + (swz % 64) / 2; }
__host__ __device__ __forceinline__ int perm32(int rho) { const int n = rho >> 4, i = rho & 15; return 8 * (i >> 2) + 4 * n + (i & 3); }
struct Unit { int pm, pn, e, nrows; };
struct StaticOrder {
    int nM, nN, nwg, G, c, dup;
    __device__ void init(int nM_, int nN_, int G_, int c_, int dup_ = 1) { nM = nM_; nN = nN_; nwg = nM * nN; G = G_; c = c_; dup = dup_; }
    __device__ bool next(int i, Unit& u) const {
        const long L0 = (long)i * G + c; if (L0 >= (long)nwg * dup) return false;
        const long L = L0 % nwg;
        int wgid = (int)L; { const int q = nwg / NXCD, r = nwg % NXCD, xcd = wgid % NXCD, off = wgid / NXCD; wgid = (xcd < r ? xcd * (q + 1) : r * (q + 1) + (xcd - r) * q) + off; }
        const int nig = WGM * nN, gid = wgid / nig, fm = gid * WGM, gsz = (nM - fm) < WGM ? (nM - fm) : WGM;
        u.pm = fm + ((wgid % nig) % gsz); u.pn = (wgid % nig) / gsz; u.e = 0; u.nrows = 256; return true;
    }
};

template <class Epi, class Sched, class AAddr, class BAddr>
__device__ __forceinline__ void gemm_phase(LAS unsigned char* lds, const int K, const Sched& S, const AAddr& AA, const BAddr& BA, const Epi& E) {
    constexpr bool GA = AAddr::GATHER;
    const int tid = threadIdx.x, wid = __builtin_amdgcn_readfirstlane(tid >> 6), lane = tid & 63, wr = wid >> 2, wc = wid & 3, fr = lane & 15, fq = lane >> 4;
    const int nt = K / BK;
    unsigned voffA[2], voffB[2];
#pragma unroll
    for (int i = 0; i < 2; ++i) { int R, C; stage_rc(tid * 16 + i * 8192, R, C); const int Rb = Epi::PERM ? ((R & ~31) + perm32(R & 31)) : R;
        voffA[i] = GA ? 0u : AA.lane_off(R, C); voffB[i] = (unsigned)(Rb * K + C) * 2u; }
    const size_t kstepA = (size_t)AA.kstep, kstepB = (size_t)(BK * 2);
    const size_t hstepB = (size_t)HALF * K * 2, hstepA = GA ? 0 : AA.hstep();
    const unsigned ldsw = (unsigned)wid * 1024u;
    const int aoff = lds_byte(wr * 64 + fr, fq * 8), boff = lds_byte(wc * 32 + fr, fq * 8);
#define PG8_SA(b, h) (((b) * 2 + (h)) * HTB)
#define PG8_SB(b, h) ((4 + (b) * 2 + (h)) * HTB)
#define PG8_STAGE(bufoff, gbase, voff) do { _Pragma("unroll") for (int _i = 0; _i < 2; ++_i) \
        __builtin_amdgcn_global_load_lds((const unsigned*)((const char*)(gbase) + (voff)[_i]), (LAS unsigned*)(lds + (bufoff) + ldsw + _i * 8192), 16, 0, 0); } while (0)
#define PG8_STA_CUR(bufoff, h, kb) do { if constexpr (GA) { if (h) PG8_STAGE(bufoff, baseA + (kb), cof1); else PG8_STAGE(bufoff, baseA + (kb), cof0); } \
        else PG8_STAGE(bufoff, cA + (h) * hstepA + (kb), voffA); } while (0)
#define PG8_STA_SEL(bufoff, h, kb) do { if constexpr (GA) { if (h) PG8_STAGE(bufoff, baseA + (kb), sof1); else PG8_STAGE(bufoff, baseA + (kb), sof0); } \
        else PG8_STAGE(bufoff, sA + (h) * hstepA + (kb), voffA); } while (0)
#define PG8_LDA(dst, b, h) do { _Pragma("unroll") for (int m = 0; m < 4; ++m) _Pragma("unroll") for (int k = 0; k < 2; ++k) dst[m][k] = *(const LAS bf16x8*)(lds + PG8_SA(b, h) + aoff + m * 2048 + k * 1024); } while (0)
#define PG8_LDB(dst, b, h) do { _Pragma("unroll") for (int n = 0; n < 2; ++n) _Pragma("unroll") for (int k = 0; k < 2; ++k) dst[n][k] = *(const LAS bf16x8*)(lds + PG8_SB(b, h) + boff + n * 2048 + k * 1024); } while (0)
#define PG8_MMA(ai, bj, At, Bt) do { __builtin_amdgcn_s_setprio(1); _Pragma("unroll") for (int m = 0; m < 4; ++m) _Pragma("unroll") for (int n = 0; n < 2; ++n) _Pragma("unroll") for (int k = 0; k < 2; ++k) \
        acc[ai][bj][m][n] = __builtin_amdgcn_mfma_f32_16x16x32_bf16(Bt[n][k], At[m][k], acc[ai][bj][m][n], 0, 0, 0); __builtin_amdgcn_s_setprio(0); } while (0)
#define PG8_WAIT_V(n) asm volatile("s_waitcnt vmcnt(" #n ")" ::: "memory")
#define PG8_WAIT_L(n) asm volatile("s_waitcnt lgkmcnt(" #n ")" ::: "memory")
#define PG8_BAR __builtin_amdgcn_s_barrier()
#define PG8_SCHED __builtin_amdgcn_sched_barrier(0)
#define PG8_GOFF(u, o0, o1) do { _Pragma("unroll") for (int _i = 0; _i < 2; ++_i) { int R_, C_; stage_rc(tid * 16 + _i * 8192, R_, C_); \
        o0[_i] = AA.row_off(u, R_) + (unsigned)C_ * 2u; o1[_i] = AA.row_off(u, R_ + HALF) + (unsigned)C_ * 2u; } } while (0)
    Unit cur, nxt; int ui = 0;
    if (!S.next(0, cur)) return;
    f32x4 acc[2][2][4][2];
#pragma unroll
    for (int a = 0; a < 2; ++a)
#pragma unroll
        for (int b = 0; b < 2; ++b)
#pragma unroll
            for (int m = 0; m < 4; ++m)
#pragma unroll
                for (int n = 0; n < 2; ++n) acc[a][b][m][n] = (f32x4){0.f, 0.f, 0.f, 0.f};
    bf16x8 At[4][2], B0[2][2], B1[2][2];
    const char* const baseA = GA ? (const char*)AA.base : nullptr;
    const char* cA = GA ? nullptr : (const char*)AA.unit_ptr(cur);
    unsigned cof0[2] = {0u, 0u}, cof1[2] = {0u, 0u}, nof0[2] = {0u, 0u}, nof1[2] = {0u, 0u};
    if constexpr (GA) PG8_GOFF(cur, cof0, cof1);
    const char* cB = (const char*)BA.ptr(cur);
    PG8_STAGE(PG8_SB(0, 0), cB, voffB); PG8_STA_CUR(PG8_SA(0, 0), 0, 0); PG8_STAGE(PG8_SB(0, 1), cB + hstepB, voffB); PG8_STA_CUR(PG8_SA(0, 1), 1, 0);
    if (wr == 1) PG8_BAR;
    PG8_WAIT_V(4); PG8_BAR;
    PG8_STAGE(PG8_SB(1, 0), cB + kstepB, voffB); PG8_STA_CUR(PG8_SA(1, 0), 0, kstepA); PG8_STAGE(PG8_SB(1, 1), cB + hstepB + kstepB, voffB);
    PG8_WAIT_V(6); PG8_BAR;
    for (;;) {
        const bool has_next = S.next(ui + 1, nxt);
        const char* nB = cB; const char* nA = cA;
        if (has_next) { nB = (const char*)BA.ptr(nxt); if constexpr (GA) PG8_GOFF(nxt, nof0, nof1); else nA = (const char*)AA.unit_ptr(nxt); }
        else { if constexpr (GA) {
#pragma unroll
            for (int i = 0; i < 2; ++i) { nof0[i] = cof0[i]; nof1[i] = cof1[i]; } } }
#pragma nounroll
        for (int t = 0; t < nt; t += 2) {
            const bool last = (t == nt - 2);
            const size_t k1 = (size_t)(t + 1) * kstepA, k2 = last ? 0 : (size_t)(t + 2) * kstepA, k3 = k2 + kstepA;
            const char* b2 = last ? nB : cB + (size_t)(t + 2) * kstepB; const char* b3 = b2 + kstepB;
            const char* sA = last ? nA : cA;
            unsigned sof0[2], sof1[2];
#pragma unroll
            for (int i = 0; i < 2; ++i) { sof0[i] = last ? nof0[i] : cof0[i]; sof1[i] = last ? nof1[i] : cof1[i]; }
            PG8_LDB(B0, 0, 0); PG8_SCHED; PG8_LDA(At, 0, 0); PG8_STA_CUR(PG8_SA(1, 1), 1, k1);
            PG8_WAIT_L(8); PG8_BAR; PG8_WAIT_L(0); PG8_MMA(0, 0, At, B0); PG8_BAR; PG8_SCHED;
            PG8_LDB(B1, 0, 1); PG8_STAGE(PG8_SB(0, 0), b2, voffB);
            PG8_BAR; PG8_WAIT_L(0); PG8_MMA(0, 1, At, B1); PG8_BAR;
            PG8_LDA(At, 0, 1); PG8_STA_SEL(PG8_SA(0, 0), 0, k2);
            PG8_BAR; PG8_WAIT_L(0); PG8_MMA(1, 0, At, B0); PG8_BAR; PG8_SCHED;
            PG8_STAGE(PG8_SB(0, 1), b2 + hstepB, voffB);
            PG8_WAIT_V(6); PG8_BAR; PG8_MMA(1, 1, At, B1); PG8_BAR;
            PG8_LDB(B0, 1, 0); PG8_SCHED; PG8_LDA(At, 1, 0); PG8_STA_SEL(PG8_SA(0, 1), 1, k2);
            PG8_WAIT_L(8); PG8_BAR; PG8_WAIT_L(0); PG8_MMA(0, 0, At, B0); PG8_BAR; PG8_SCHED;
            PG8_LDB(B1, 1, 1); PG8_STAGE(PG8_SB(1, 0), b3, voffB);
            PG8_BAR; PG8_WAIT_L(0); PG8_MMA(0, 1, At, B1); PG8_BAR;
            PG8_LDA(At, 1, 1); PG8_STA_SEL(PG8_SA(1, 0), 0, k3);
            PG8_BAR; PG8_WAIT_L(0); PG8_MMA(1, 0, At, B0); PG8_BAR; PG8_SCHED;
            PG8_STAGE(PG8_SB(1, 1), b3 + hstepB, voffB);
            PG8_WAIT_V(6); PG8_BAR; PG8_MMA(1, 1, At, B1); PG8_BAR;
        }
        E(acc, cur, wr, wc, fr, fq);
        if (!has_next) break;
#pragma unroll
        for (int a = 0; a < 2; ++a)
#pragma unroll
            for (int b = 0; b < 2; ++b)
#pragma unroll
                for (int m = 0; m < 4; ++m)
#pragma unroll
                    for (int n = 0; n < 2; ++n) acc[a][b][m][n] = (f32x4){0.f, 0.f, 0.f, 0.f};
        cur = nxt; cB = nB; cA = nA; ++ui;
        if constexpr (GA) {
#pragma unroll
            for (int i = 0; i < 2; ++i) { cof0[i] = nof0[i]; cof1[i] = nof1[i]; } }
    }
    PG8_WAIT_V(0);
    if (wr == 0) PG8_BAR;
    PG8_BAR;
#undef PG8_SA
#undef PG8_SB
#undef PG8_STAGE
#undef PG8_STA_CUR
#undef PG8_STA_SEL
#undef PG8_GOFF
#undef PG8_LDA
#undef PG8_LDB
#undef PG8_MMA
#undef PG8_WAIT_V
#undef PG8_WAIT_L
#undef PG8_BAR
#undef PG8_SCHED
}
}

constexpr int NWAVES = 8, NTHR = 512;
struct Args { const float* in[26]; float* out; unsigned char* ws; int ph_lo, ph_hi; unsigned repmask; int pad; };
struct Frame {
    LAS unsigned char* lds;
    int tid, lane, wave, G, bx;
    unsigned char* ws;
};

struct APlain { const void* base; unsigned kstep; unsigned ld2;
    static constexpr bool GATHER = false;
    __device__ __forceinline__ const void* unit_ptr(const pg8::Unit& u) const { return (const char*)base + (size_t)u.pm * 256 * ld2; }
    __device__ __forceinline__ unsigned lane_off(int R, int C) const { return (unsigned)R * ld2 + (unsigned)C * 2u; }
    __device__ __forceinline__ size_t hstep() const { return (size_t)128 * ld2; }
    __device__ __forceinline__ unsigned row_off(const pg8::Unit&, int) const { return 0u; } };
struct BPlain { const bf16* Bt; int K;
    __device__ __forceinline__ const void* ptr(const pg8::Unit& u) const { return Bt + (size_t)u.pn * 256 * K; } };

struct EpiZ {
    static constexpr bool PERM = true;
    bf16* ZA; bf16* ZG;
    __device__ __forceinline__ void operator()(const f32x4 (&acc)[2][2][4][2], const pg8::Unit& u, int wr, int wc, int fr, int fq) const {
        const bool gate = u.pn >= 11;
        bf16* base = gate ? ZG : ZA; const int ld = gate ? ZG_LD : ZA_LD; const int colt = gate ? (u.pn - 11) * 256 : u.pn * 256;
        const int row0 = u.pm * 256 + wr * 64 + fr, col0 = colt + wc * 32 + 8 * fq;
#pragma unroll
        for (int ai = 0; ai < 2; ++ai)
#pragma unroll
            for (int m = 0; m < 4; ++m) { bf16* rowp = base + (size_t)(row0 + ai * 128 + m * 16) * ld + col0;
#pragma unroll
                for (int bj = 0; bj < 2; ++bj) { f32x4 v0 = acc[ai][bj][m][0], v1 = acc[ai][bj][m][1];
                    if (gate) {
#pragma unroll
                        for (int j = 0; j < 4; ++j) { v0[j] = sigmoidf_(v0[j]); v1[j] = sigmoidf_(v1[j]); } }
                    u32x4 w; w.x = pk2(v0[0], v0[1]); w.y = pk2(v0[2], v0[3]); w.z = pk2(v1[0], v1[1]); w.w = pk2(v1[2], v1[3]);
                    *(u32x4*)(rowp + bj * 128) = w; } }
    }
};
template <int MODE> struct EpiGate {
    static constexpr bool PERM = true;
    const bf16* ZG; const bf16* T1; bf16* O;
    __device__ __forceinline__ void operator()(const f32x4 (&acc)[2][2][4][2], const pg8::Unit& u, int wr, int wc, int fr, int fq) const {
        const int row0 = u.pm * 256 + wr * 64 + fr, col0 = u.pn * 256 + wc * 32 + 8 * fq;
#pragma unroll
        for (int ai = 0; ai < 2; ++ai) {
            u32x4 gv[4][2], tv[4][2];
#pragma unroll
            for (int m = 0; m < 4; ++m)
#pragma unroll
                for (int bj = 0; bj < 2; ++bj) { const size_t r = (size_t)(row0 + ai * 128 + m * 16); const int c = col0 + bj * 128;
                    gv[m][bj] = *(const u32x4*)(ZG + r * ZG_LD + MODE * 1024 + c); if (MODE == 1) tv[m][bj] = *(const u32x4*)(T1 + r * 1024 + c); }
#pragma unroll
            for (int m = 0; m < 4; ++m)
#pragma unroll
                for (int bj = 0; bj < 2; ++bj) { asm volatile("" : "+v"(gv[m][bj])); if (MODE == 1) asm volatile("" : "+v"(tv[m][bj])); }
#pragma unroll
            for (int m = 0; m < 4; ++m) { const size_t r = (size_t)(row0 + ai * 128 + m * 16);
#pragma unroll
                for (int bj = 0; bj < 2; ++bj) { const int c = col0 + bj * 128; const u32x4 g = gv[m][bj];
                    const f32x4 v0 = acc[ai][bj][m][0], v1 = acc[ai][bj][m][1];
                    float o[8] = { v0[0] * bflo(g.x), v0[1] * bfhi(g.x), v0[2] * bflo(g.y), v0[3] * bfhi(g.y), v1[0] * bflo(g.z), v1[1] * bfhi(g.z), v1[2] * bflo(g.w), v1[3] * bfhi(g.w) };
                    if (MODE == 1) { const u32x4 t = tv[m][bj];
                        o[0] += bflo(t.x); o[1] += bfhi(t.x); o[2] += bflo(t.y); o[3] += bfhi(t.y); o[4] += bflo(t.z); o[5] += bfhi(t.z); o[6] += bflo(t.w); o[7] += bfhi(t.w); }
                    u32x4 w; w.x = pk2(o[0], o[1]); w.y = pk2(o[2], o[3]); w.z = pk2(o[4], o[5]); w.w = pk2(o[6], o[7]);
                    *(u32x4*)(O + r * 1024 + c) = w; } }
        }
    }
};
struct EpiRes {
    static constexpr bool PERM = true;
    const float* X; bf16* O;
    __device__ __forceinline__ void operator()(const f32x4 (&acc)[2][2][4][2], const pg8::Unit& u, int wr, int wc, int fr, int fq) const {
        const int row0 = u.pm * 256 + wr * 64 + fr, col0 = u.pn * 256 + wc * 32 + 8 * fq;
#pragma unroll
        for (int ai = 0; ai < 2; ++ai) {
            f32x4 xv[4][2][2];
#pragma unroll
            for (int m = 0; m < 4; ++m)
#pragma unroll
                for (int bj = 0; bj < 2; ++bj) { const size_t off = (size_t)(row0 + ai * 128 + m * 16) * D + col0 + bj * 128; xv[m][bj][0] = *(const f32x4*)(X + off); xv[m][bj][1] = *(const f32x4*)(X + off + 4); }
#pragma unroll
            for (int m = 0; m < 4; ++m)
#pragma unroll
                for (int bj = 0; bj < 2; ++bj) { asm volatile("" : "+v"(xv[m][bj][0])); asm volatile("" : "+v"(xv[m][bj][1])); }
#pragma unroll
            for (int m = 0; m < 4; ++m)
#pragma unroll
                for (int bj = 0; bj < 2; ++bj) { const size_t off = (size_t)(row0 + ai * 128 + m * 16) * D + col0 + bj * 128;
                    const f32x4 v0 = xv[m][bj][0] * ALPHA + acc[ai][bj][m][0], v1 = xv[m][bj][1] * ALPHA + acc[ai][bj][m][1];
                    u32x4 w; w.x = pk2(v0[0], v0[1]); w.y = pk2(v0[2], v0[3]); w.z = pk2(v1[0], v1[1]); w.w = pk2(v1[2], v1[3]);
                    *(u32x4*)(O + off) = w; }
        }
    }
};

template <class F>
__device__ __forceinline__ void p0_tile(const F& f, bf16* WT, int ldk, int k0, int n0, LAS float* scr, int lane) {
    if constexpr (F::FOLD) {
        float bc[64];
#pragma unroll
        for (int d = 0; d < 64; ++d) bc[d] = f.bval(k0, d, n0 + (lane & 31));
#pragma unroll 4
        for (int i = 0; i < 32; ++i) { const int kk = 2 * i + (lane >> 5); const f32x4* ar = (const f32x4*)f.arow(k0 + kk, n0); f32x4 a4 = {0.f, 0.f, 0.f, 0.f};
#pragma unroll
            for (int q = 0; q < 16; ++q) { const f32x4 av = ar[q]; a4[0] += av[0] * bc[4 * q]; a4[1] += av[1] * bc[4 * q + 1]; a4[2] += av[2] * bc[4 * q + 2]; a4[3] += av[3] * bc[4 * q + 3]; }
            scr[kk * 33 + (lane & 31)] = (a4[0] + a4[1]) + (a4[2] + a4[3]); }
    } else {
        float v[32];
#pragma unroll
        for (int i = 0; i < 32; ++i) { const int kk = 2 * i + (lane >> 5); v[i] = f(k0 + kk, n0 + (lane & 31)); }
#pragma unroll
        for (int i = 0; i < 32; ++i) { const int kk = 2 * i + (lane >> 5); scr[kk * 33 + (lane & 31)] = v[i]; }
    }
    LDS_WAIT(); asm volatile("" ::: "memory");
    const int c = lane & 7;
#pragma unroll
    for (int j = 0; j < 4; ++j) { const int n = (lane >> 3) + 8 * j; const LAS float* s = scr + (8 * c) * 33 + n;
        u32x4 o; o.x = pk2(s[0 * 33], s[1 * 33]); o.y = pk2(s[2 * 33], s[3 * 33]); o.z = pk2(s[4 * 33], s[5 * 33]); o.w = pk2(s[6 * 33], s[7 * 33]);
        *(u32x4*)(WT + (size_t)(n0 + n) * ldk + k0 + 8 * c) = o; }
    LDS_WAIT(); asm volatile("" ::: "memory");
}
struct P0Item { const float* src; int N, noff; bf16* dst; int ldk, k0, n0; };
__device__ __forceinline__ void p0_item_load(const P0Item& it, float (&v)[32], int lane) {
#pragma unroll
    for (int i = 0; i < 32; ++i) { const int kk = 2 * i + (lane >> 5); v[i] = it.src[(size_t)(it.k0 + kk) * it.N + it.n0 + (lane & 31) + it.noff]; }
}
__device__ __forceinline__ void p0_item_finish(const P0Item& it, const float (&v)[32], LAS float* scr, int lane) {
#pragma unroll
    for (int i = 0; i < 32; ++i) { const int kk = 2 * i + (lane >> 5); scr[kk * 33 + (lane & 31)] = v[i]; }
    LDS_WAIT(); asm volatile("" ::: "memory");
    const int c = lane & 7;
#pragma unroll
    for (int j = 0; j < 4; ++j) { const int n = (lane >> 3) + 8 * j; const LAS float* s = scr + (8 * c) * 33 + n;
        u32x4 o; o.x = pk2(s[0 * 33], s[1 * 33]); o.y = pk2(s[2 * 33], s[3 * 33]); o.z = pk2(s[4 * 33], s[5 * 33]); o.w = pk2(s[6 * 33], s[7 * 33]);
        *(u32x4*)(it.dst + (size_t)(it.n0 + n) * it.ldk + it.k0 + 8 * c) = o; }
    LDS_WAIT(); asm volatile("" ::: "memory");
}
__device__ __forceinline__ int zsrc_col(int n) {
    if (n < 1280) return n;
    if (n < 2304) return -2;
    if (n < 2432) return 1816 + (n - 2304);
    if (n < 2688) return 1944 + (n - 2432);
    if (n < 2752) return 2200 + (n - 2688);
    if (n < 2776) return 1280 + (n - 2752);
    if (n < 2780) return 2264 + (n - 2776);
    if (n < 2816) return -1;
    if (n < 3840) return 2268 + (n - 2816);
    return 3292 + (n - 3840);
}
struct FWin { const float* w_in; static constexpr bool FOLD = false;
    __device__ __forceinline__ float operator()(int k, int n) const { const int s = zsrc_col(n); return s >= 0 ? w_in[(size_t)k * D_IN + s] : 0.f; } };
struct FWinQ { const float* w_in; const float* w_uk; static constexpr bool FOLD = true;
    __device__ __forceinline__ const float* arow(int k, int n0) const { return w_in + (size_t)k * D_IN + 1304 + ((n0 - 1280) >> 7) * 64; }
    __device__ __forceinline__ float bval(int, int d, int n) const { return w_uk[(size_t)((n - 1280) >> 7) * 64 * 128 + d * 128 + ((n - 1280) & 127)]; }
    __device__ __forceinline__ float operator()(int, int) const { return 0.f; } };
struct FWb { const float* w_uv; const float* w_bb; static constexpr bool FOLD = true;
    __device__ __forceinline__ const float* arow(int k, int) const { return w_uv + (size_t)k * 64; }
    __device__ __forceinline__ float bval(int k0, int d, int n) const { return w_bb[(size_t)((k0 >> 7) * 64 + d) * D + n]; }
    __device__ __forceinline__ float operator()(int, int) const { return 0.f; } };
struct FPlain { const float* W; int N; static constexpr bool FOLD = false; __device__ __forceinline__ float operator()(int k, int n) const { return W[(size_t)k * N + n]; } };
struct FOff { const float* W; int N; int noff; static constexpr bool FOLD = false;
    __device__ __forceinline__ float operator()(int k, int n) const { return W[(size_t)k * N + n + noff]; } };

__device__ __forceinline__ float rel_bucket_bias(const float* rel_bias, int dist, int head) {
    int b;
    if (dist < 16) b = dist;
    else { const float t = (__log2f((float)dist) - 4.0f) * 2.66666675f; b = 16 + (int)t; if (b > 31) b = 31; }
    return rel_bias[b * 16 + head];
}

constexpr int P0_EXP_ITEMS = NEXP * ((1024 / 64) * (512 / 32) + (256 / 64) * (1024 / 32)), P0_EXP_SPLIT = (P0_EXP_ITEMS * 2) / 3;
__device__ __forceinline__ void p0_experts(const Frame& F, const Args& a, int wv, int nwv, int ibeg, int iend) {
    LAS float* scr = (LAS float*)(F.lds + F.wave * 16384);
    unsigned char* ws = F.ws;
    constexpr int I_GU = (1024 / 64) * (512 / 32), I_DN = (256 / 64) * (1024 / 32);
    const int gw = wv, NGW = nwv;
    {
        constexpr int NEI = NEXP * (I_GU + I_DN);
        auto mk = [&](int idx) { P0Item it; const int e = idx / (I_GU + I_DN); int r = idx - e * (I_GU + I_DN);
            if (r < I_GU) {
                const int n0 = (r % 16) * 32; const uintptr_t pg = (uintptr_t)a.in[21], pu = (uintptr_t)a.in[22];
                it.src = (const float*)(pg + (uintptr_t)((n0 >> 7) & 1) * (pu - pg)) + (size_t)e * D * DEXP; it.N = DEXP; it.noff = ((n0 >> 8) * 128 + (n0 & 127)) - n0;
                it.dst = (bf16*)(ws + WS_WGU) + (size_t)e * 512 * 1024; it.ldk = 1024; it.k0 = (r / 16) * 64; it.n0 = n0; }
            else { r -= I_GU; it.src = a.in[23] + (size_t)e * DEXP * D; it.N = D; it.noff = 0; it.dst = (bf16*)(ws + WS_WDT) + (size_t)e * 1024 * 256; it.ldk = 256; it.k0 = (r / 32) * 64; it.n0 = (r % 32) * 32; }
            return it; };
        float va[32], vb[32];
        {
        (void)NEI;
        int idx = ibeg + gw;
        if (idx < iend) { P0Item cur = mk(idx); p0_item_load(cur, va, F.lane);
            for (;;) {
                const int nidx = idx + NGW; const bool more = nidx < iend; P0Item nxt = cur;
                if (more) { nxt = mk(nidx); p0_item_load(nxt, vb, F.lane); }
                p0_item_finish(cur, va, scr, F.lane);
                if (!more) break;
#pragma unroll
                for (int i = 0; i < 32; ++i) va[i] = vb[i];
                cur = nxt; idx = nidx; } }
        }
    }
}
__device__ __forceinline__ void phase0(const Frame& F, const Args& a) {
    LAS float* scr = (LAS float*)(F.lds + F.wave * 16384);
    const int gw = F.bx * NWAVES + F.wave, NGW = F.G * NWAVES;
    unsigned char* ws = F.ws;
    constexpr int I_WIN = (D / 64) * (NZ / 32);
    constexpr int I_WB = (1024 / 64) * (1024 / 32);
    constexpr int I_WA = (512 / 64) * (1024 / 32);
    constexpr int I_WO = I_WB;
    constexpr int I_W1 = (2048 / 64) * (256 / 32);
    constexpr int I_W2 = (256 / 64) * (64 / 32);
    constexpr int I_GU = (1024 / 64) * (512 / 32);
    constexpr int I_DN = (256 / 64) * (1024 / 32);
    constexpr int NITEMS = I_WIN + I_WB + I_WA + I_WO + 2 * I_W1 + 2 * I_W2;
    (void)NITEMS;
    constexpr int I_WINP = (D / 64) * ((NZ - 1024) / 32);
    for (int it = gw; it < 1024; it += NGW) {
        if (it < 512) { const int k0 = (it >> 5) * 64, n0 = 1280 + (it & 31) * 32; const FWinQ f{a.in[1], a.in[9]}; p0_tile(f, (bf16*)(ws + WS_WINT), D, k0, n0, scr, F.lane); }
        else { const int r = it - 512; const FWb f{a.in[10], a.in[13]}; p0_tile(f, (bf16*)(ws + WS_WBT), 1024, (r / 32) * 64, (r % 32) * 32, scr, F.lane); }
    }
    { constexpr int NPL = I_WINP + I_WA + I_WO + 2 * I_W1 + 2 * I_W2;
      const int pw0 = NGW > 1024 ? (gw >= 1024 ? gw - 1024 : -1) : gw, pws = NGW > 1024 ? NGW - 1024 : NGW;
      if (pw0 >= 0) for (int it = pw0; it < NPL; it += pws) {
        int r = it;
        if (r < I_WINP) { const int k0 = (r / 120) * 64; int nb = r % 120; nb = nb < 40 ? nb : nb + 32; const FWin f{a.in[1]}; p0_tile(f, (bf16*)(ws + WS_WINT), D, k0, nb * 32, scr, F.lane); continue; } r -= I_WINP;
        if (r < I_WA) { const FPlain f{a.in[12], D}; p0_tile(f, (bf16*)(ws + WS_WAT), 512, (r / 32) * 64, (r % 32) * 32, scr, F.lane); continue; } r -= I_WA;
        if (r < I_WO) { const FPlain f{a.in[14], D}; p0_tile(f, (bf16*)(ws + WS_WOT), 1024, (r / 32) * 64, (r % 32) * 32, scr, F.lane); continue; } r -= I_WO;
        if (r < I_W1) { const FPlain f{a.in[4], 256}; p0_tile(f, (bf16*)(ws + WS_W1K), 2048, (r / 8) * 64, (r % 8) * 32, scr, F.lane); continue; } r -= I_W1;
        if (r < I_W1) { const FPlain f{a.in[6], 256}; p0_tile(f, (bf16*)(ws + WS_W1V), 2048, (r / 8) * 64, (r % 8) * 32, scr, F.lane); continue; } r -= I_W1;
        if (r < I_W2) { const FPlain f{a.in[5], 64}; p0_tile(f, (bf16*)(ws + WS_W2K), 256, (r / 2) * 64, (r % 2) * 32, scr, F.lane); continue; } r -= I_W2;
        { const FPlain f{a.in[7], 64}; p0_tile(f, (bf16*)(ws + WS_W2V), 256, (r / 2) * 64, (r % 2) * 32, scr, F.lane); }
      } }
    { const int nu = (NTOK / 256) * (NZ / 256); if ((nu % F.G) == 0) p0_experts(F, a, gw, NGW, 0, P0_EXP_ITEMS); }
    { const f32x4* x4 = (const f32x4*)a.in[0]; u32x2* o = (u32x2*)(ws + WS_XB);
      const size_t total = (size_t)NTOK * D / 4, stride = (size_t)F.G * NTHR;
      for (size_t i0 = (size_t)F.bx * NTHR + F.tid; i0 < total; i0 += 8 * stride) { f32x4 v[8];
#pragma unroll
          for (int j = 0; j < 8; ++j) { const size_t i = i0 + j * stride; v[j] = i < total ? x4[i] : (f32x4){0.f, 0.f, 0.f, 0.f}; }
#pragma unroll
          for (int j = 0; j < 8; ++j) { const size_t i = i0 + j * stride; if (i < total) { u32x2 w; w.x = pk2(v[j][0], v[j][1]); w.y = pk2(v[j][2], v[j][3]); o[i] = w; } } } }
    if (F.bx < 64 && F.tid < 256) {
        const int kv = F.bx >> 5, j = F.bx & 31;
        const float* pe = (kv ? a.in[3] : a.in[2]) + 64 * j; const float* w1 = (kv ? a.in[6] : a.in[4]) + (size_t)(64 * j) * 256 + F.tid; float acc = 0.f;
#pragma unroll 16
        for (int k = 0; k < 64; ++k) acc += pe[k] * w1[(size_t)k * 256];
        ((float*)(ws + WS_BIASK))[(kv * 32 + j) * 256 + F.tid] = acc;
    }
    if (F.bx >= 64 && F.bx < 96) { const int idx = (F.bx - 64) * NTHR + F.tid;
        const int tab = idx >> 13, head = (idx >> 10) & 7, dist = idx & 1023;
        ((float*)(ws + (tab ? WS_TBB : WS_TBA)))[head * 1024 + dist] = rel_bucket_bias(a.in[11], dist, tab * 8 + head) * LOG2E; }
}

constexpr int NRT = 36;
constexpr int P6_WR = 0;
constexpr int P6_CNT = 147456;
constexpr int P6_ENT = 147456 + 512;
__device__ __forceinline__ float row16_sum(float v) {
    v += __builtin_bit_cast(float, __builtin_amdgcn_update_dpp(0, __builtin_bit_cast(int, v), 0xB1, 0xf, 0xf, true));
    v += __builtin_bit_cast(float, __builtin_amdgcn_update_dpp(0, __builtin_bit_cast(int, v), 0x4E, 0xf, 0xf, true));
    v += __builtin_bit_cast(float, __builtin_amdgcn_update_dpp(0, __builtin_bit_cast(int, v), 0x141, 0xf, 0xf, true));
    v += __builtin_bit_cast(float, __builtin_amdgcn_update_dpp(0, __builtin_bit_cast(int, v), 0x140, 0xf, 0xf, true));
    return v;
}
__device__ __forceinline__ float wave_sum_dpp(float v) { v = row16_sum(v); v += __shfl_xor(v, 16); v += __shfl_xor(v, 32); return v; }
__device__ __forceinline__ void phase6(const Frame& F, const Args& a) {
    unsigned char* ws = F.ws;
    LAS float* WR = (LAS float*)(F.lds + P6_WR);
    LAS int* cntL = (LAS int*)(F.lds + P6_CNT); LAS int* baseL = cntL + 32;
    LAS int* ent = (LAS int*)(F.lds + P6_ENT);
    const float* w_grp = a.in[17]; const float* b_grp = a.in[18]; const float* w_rtr = a.in[19]; const float* b_rtr = a.in[20];
    {
        f32x4 wv[16], gv2[2];
#pragma unroll
        for (int i = 0; i < 16; ++i) wv[i] = *(const f32x4*)(w_rtr + 4 * (F.tid + NTHR * i));
#pragma unroll
        for (int i = 0; i < 2; ++i) gv2[i] = *(const f32x4*)(w_grp + 4 * (F.tid + NTHR * i));
#pragma unroll
        for (int i = 0; i < 16; ++i) { const int e = 4 * (F.tid + NTHR * i), k = e >> 5, o = e & 31;
#pragma unroll
            for (int c = 0; c < 4; ++c) WR[(4 + o + c) * 1024 + k] = wv[i][c]; }
#pragma unroll
        for (int i = 0; i < 2; ++i) { const int k = F.tid + NTHR * i;
#pragma unroll
            for (int c = 0; c < 4; ++c) WR[c * 1024 + k] = gv2[i][c]; }
    }
    if (F.tid < 65) cntL[F.tid] = 0;
    __syncthreads();
    const bf16* HP = (const bf16*)(ws + WS_H1); bf16* H1B = (bf16*)(ws + WS_H1B);
    const float* lg = a.in[15]; const float* lb = a.in[16];
    f32x2 gam[8], bet[8];
#pragma unroll
    for (int j = 0; j < 2; ++j)
#pragma unroll
        for (int q = 0; q < 4; ++q) { gam[4 * j + q] = *(const f32x2*)(lg + 512 * j + 8 * F.lane + 2 * q); bet[4 * j + q] = *(const f32x2*)(lb + 512 * j + 8 * F.lane + 2 * q); }
    unsigned* gcnt = (unsigned*)(ws + WS_CTL) + CW_CNT;
    int* list = (int*)(ws + WS_LIST); float* tokinfo = (float*)(ws + WS_TOKINFO);
    const int gw = F.bx * NWAVES + F.wave, NGW = F.G * NWAVES;
    u32x4 nx0, nx1;
    const int rpb = (NTOK + F.G - 1) / F.G, rbeg = F.bx * rpb, rend = (rbeg + rpb < NTOK) ? rbeg + rpb : NTOK;
    (void)gw; (void)NGW;
    if (rbeg + F.wave < rend) { const u32x4* hr = (const u32x4*)(HP + (size_t)(rbeg + F.wave) * D) + F.lane; nx0 = hr[0]; nx1 = hr[64]; }
    for (int row = rbeg + F.wave; row < rend; row += NWAVES) {
        const u32x4 r0 = nx0, r1 = nx1;
        if (row + NWAVES < rend) { const u32x4* hr = (const u32x4*)(HP + (size_t)(row + NWAVES) * D) + F.lane; nx0 = hr[0]; nx1 = hr[64]; }
        f32x2 v[8];
        v[0] = (f32x2){bflo(r0.x), bfhi(r0.x)}; v[1] = (f32x2){bflo(r0.y), bfhi(r0.y)}; v[2] = (f32x2){bflo(r0.z), bfhi(r0.z)}; v[3] = (f32x2){bflo(r0.w), bfhi(r0.w)};
        v[4] = (f32x2){bflo(r1.x), bfhi(r1.x)}; v[5] = (f32x2){bflo(r1.y), bfhi(r1.y)}; v[6] = (f32x2){bflo(r1.z), bfhi(r1.z)}; v[7] = (f32x2){bflo(r1.w), bfhi(r1.w)};
        f32x2 s2 = v[0];
#pragma unroll
        for (int q = 1; q < 8; ++q) s2 += v[q];
        const float mean = wave_sum_dpp(s2[0] + s2[1]) * (1.f / D);
        f32x2 q2 = {0.f, 0.f};
#pragma unroll
        for (int q = 0; q < 8; ++q) { v[q] = v[q] - mean; q2 += v[q] * v[q]; }
        const float rstd = 1.0f / sqrtf(wave_sum_dpp(q2[0] + q2[1]) * (1.f / D) + 1e-5f);
#pragma unroll
        for (int q = 0; q < 8; ++q) v[q] = v[q] * rstd * gam[q] + bet[q];
        { u32x4 w0, w1; w0.x = pk2(v[0][0], v[0][1]); w0.y = pk2(v[1][0], v[1][1]); w0.z = pk2(v[2][0], v[2][1]); w0.w = pk2(v[3][0], v[3][1]);
          w1.x = pk2(v[4][0], v[4][1]); w1.y = pk2(v[5][0], v[5][1]); w1.z = pk2(v[6][0], v[6][1]); w1.w = pk2(v[7][0], v[7][1]);
          u32x4* ob = (u32x4*)(H1B + (size_t)row * D) + F.lane; ob[0] = w0; ob[64] = w1; }
        auto rdot = [&](int o) { f32x2 p2 = {0.f, 0.f};
#pragma unroll
            for (int j = 0; j < 2; ++j) { const f32x4 wa = *(const LAS f32x4*)(WR + o * 1024 + 512 * j + 8 * F.lane), wb = *(const LAS f32x4*)(WR + o * 1024 + 512 * j + 8 * F.lane + 4);
                p2 += v[4 * j] * (f32x2){wa[0], wa[1]}; p2 += v[4 * j + 1] * (f32x2){wa[2], wa[3]}; p2 += v[4 * j + 2] * (f32x2){wb[0], wb[1]}; p2 += v[4 * j + 3] * (f32x2){wb[2], wb[3]}; }
            return row16_sum(p2[0] + p2[1]); };
        float g[4];
#pragma unroll
        for (int i = 0; i < 4; ++i) g[i] = rdot(i);
#pragma unroll
        for (int i = 0; i < 4; ++i) { float t = g[i]; t += __shfl_xor(t, 16); t += __shfl_xor(t, 32); g[i] = t + b_grp[i]; }
        int gs = 0; float gm = g[0];
#pragma unroll
        for (int i = 1; i < 4; ++i) if (g[i] > gm) { gm = g[i]; gs = i; }
        gs = __builtin_amdgcn_readfirstlane(gs);
        float gsum = 0.f;
#pragma unroll
        for (int i = 0; i < 4; ++i) gsum += __expf(g[i] - gm);
        const float pgrp = 1.0f / gsum;
        float el[8];
#pragma unroll
        for (int i = 0; i < 8; ++i) el[i] = rdot(4 + gs * 8 + i);
#pragma unroll
        for (int i = 0; i < 8; ++i) { float t = el[i]; t += __shfl_xor(t, 16); t += __shfl_xor(t, 32); el[i] = t + b_rtr[gs * 8 + i]; }
        int i1 = 0; float l1 = el[0];
#pragma unroll
        for (int i = 1; i < 8; ++i) if (el[i] > l1) { l1 = el[i]; i1 = i; }
        int i2 = -1; float l2 = -3.0e38f;
#pragma unroll
        for (int i = 0; i < 8; ++i) if (i != i1 && el[i] > l2) { l2 = el[i]; i2 = i; }
        const float e2 = __expf(l2 - l1), inv = 1.0f / (1.0f + e2);
        const float w0 = pgrp * inv, w1 = pgrp * e2 * inv;
        const int e0 = gs * 8 + i1, e1 = gs * 8 + i2;
        if (F.lane == 0) {
            const int p0 = atomicAdd((int*)&cntL[e0], 1), p1 = atomicAdd((int*)&cntL[e1], 1);
            const int n0 = atomicAdd((int*)&cntL[64], 2);
            ent[2 * n0] = (e0 << 16) | p0; ent[2 * n0 + 1] = row * 2;
            ent[2 * n0 + 2] = (e1 << 16) | p1; ent[2 * n0 + 3] = row * 2 + 1;
            tokinfo[row * 2] = w0; tokinfo[row * 2 + 1] = w1;
        }
    }
    __syncthreads();
    if (F.tid < 32) { const int c = cntL[F.tid]; baseL[F.tid] = c > 0 ? (int)__hip_atomic_fetch_add(gcnt + 64 * F.tid, (unsigned)c, __ATOMIC_RELAXED, __HIP_MEMORY_SCOPE_AGENT) : 0; }
    __syncthreads();
    const int nent = cntL[64];
    for (int i = F.tid; i < nent; i += NTHR) { const int ep = ent[2 * i], tk = ent[2 * i + 1]; const int e = ep >> 16, p = ep & 0xffff; list[(size_t)e * NTOK + baseL[e] + p] = tk; }
    __syncthreads();
}

constexpr int MOE_CUM = 131072;
struct MoeOrder {
    int G, c, NP; const LAS int* cum; const LAS int* cnt;
    __device__ bool next(int i, pg8::Unit& u) const {
        const int L = i * G + c, t = L / NP; if (t >= cum[32]) return false;
        const int e = cum[80 + t];
        const int j = t - cum[e]; u.pm = t; u.pn = L % NP; u.e = e | (j << 8); const int rem = cnt[e] - j * 256; u.nrows = rem < 256 ? rem : 256; return true;
    }
};
__device__ __forceinline__ void moe_setup(const Frame& F) {
    LAS int* cum = (LAS int*)(F.lds + MOE_CUM); LAS int* cnt = cum + 40;
    const unsigned* gcnt = (const unsigned*)(F.ws + WS_CTL) + CW_CNT;
    if (F.tid < 32) cnt[F.tid] = (int)__hip_atomic_load(gcnt + 64 * F.tid, __ATOMIC_RELAXED, __HIP_MEMORY_SCOPE_AGENT);
    __syncthreads();
    if (F.tid == 0) { int s = 0; for (int e = 0; e < 32; ++e) { cum[e] = s; s += (cnt[e] + 255) >> 8; } cum[32] = s; }
    __syncthreads();
    for (int t = F.tid; t < cum[32]; t += NTHR) { int e = 0; for (int k = 1; k < 32; ++k) if (t >= cum[k]) e = k; cum[80 + t] = e; }
    __syncthreads();
}
struct AGather { const void* base; unsigned kstep; const int* list;
    static constexpr bool GATHER = true;
    __device__ __forceinline__ const void* unit_ptr(const pg8::Unit&) const { return base; }
    __device__ __forceinline__ unsigned lane_off(int, int) const { return 0u; }
    __device__ __forceinline__ size_t hstep() const { return 0; }
    __device__ __forceinline__ unsigned row_off(const pg8::Unit& u, int r) const { const int e = u.e & 255, j = u.e >> 8; const int rr = r < u.nrows ? r : 0;
        const int tk = list[(size_t)e * NTOK + j * 256 + rr]; return (unsigned)(tk >> 1) * (unsigned)(D * 2); } };
struct BGu { const bf16* W; __device__ __forceinline__ const void* ptr(const pg8::Unit& u) const { return W + (size_t)(u.e & 255) * 512 * 1024 + (size_t)u.pn * 256 * 1024; } };
struct BDn { const bf16* W; __device__ __forceinline__ const void* ptr(const pg8::Unit& u) const { return W + (size_t)(u.e & 255) * 1024 * 256 + (size_t)u.pn * 256 * 256; } };
struct EpiAct {
    static constexpr bool PERM = true; bf16* ACT;
    __device__ __forceinline__ void operator()(const f32x4 (&acc)[2][2][4][2], const pg8::Unit& u, int wr, int wc, int fr, int fq) const {
        const int row0 = u.pm * 256 + wr * 64 + fr, col0 = u.pn * 128 + wc * 32 + 8 * fq;
#pragma unroll
        for (int ai = 0; ai < 2; ++ai)
#pragma unroll
            for (int m = 0; m < 4; ++m) { float o[8];
#pragma unroll
                for (int n = 0; n < 2; ++n)
#pragma unroll
                    for (int j = 0; j < 4; ++j) { const float gt = acc[ai][0][m][n][j], up = acc[ai][1][m][n][j]; o[4 * n + j] = gt * sigmoidf_(gt) * up; }
                u32x4 w; w.x = pk2(o[0], o[1]); w.y = pk2(o[2], o[3]); w.z = pk2(o[4], o[5]); w.w = pk2(o[6], o[7]);
                *(u32x4*)(ACT + (size_t)(row0 + ai * 128 + m * 16) * DEXP + col0) = w; }
    }
};
struct EpiDown {
    static constexpr bool PERM = true; bf16* Y; const int* list;
    __device__ __forceinline__ void operator()(const f32x4 (&acc)[2][2][4][2], const pg8::Unit& u, int wr, int wc, int fr, int fq) const {
        const int e = u.e & 255, j = u.e >> 8; const int col0 = u.pn * 256 + wc * 32 + 8 * fq;
        int tks[2][4];
#pragma unroll
        for (int ai = 0; ai < 2; ++ai)
#pragma unroll
            for (int m = 0; m < 4; ++m) { const int r = ai * 128 + wr * 64 + m * 16 + fr; tks[ai][m] = r < u.nrows ? list[(size_t)e * NTOK + j * 256 + r] : -1; }
#pragma unroll
        for (int ai = 0; ai < 2; ++ai)
#pragma unroll
            for (int m = 0; m < 4; ++m) { const int tk = tks[ai][m];
                if (tk >= 0) { bf16* rowp = Y + (size_t)tk * D + col0;
#pragma unroll
                    for (int bj = 0; bj < 2; ++bj) { const f32x4 v0 = acc[ai][bj][m][0], v1 = acc[ai][bj][m][1];
                        u32x4 w; w.x = pk2(v0[0], v0[1]); w.y = pk2(v0[2], v0[3]); w.z = pk2(v1[0], v1[1]); w.w = pk2(v1[2], v1[3]);
                        *(u32x4*)(rowp + bj * 128) = w; } } }
    }
};

__device__ __forceinline__ void phase9(const Frame& F, const Args& a) {
    unsigned char* ws = F.ws;
    const bf16* H1B = (const bf16*)(ws + WS_H1B); const bf16* Y = (const bf16*)(ws + WS_YBUF); const float* tokinfo = (const float*)(ws + WS_TOKINFO);
    const float* lg = a.in[24]; const float* lb = a.in[25];
    f32x4 gam[4], bet[4];
#pragma unroll
    for (int j = 0; j < 2; ++j) { gam[2 * j] = *(const f32x4*)(lg + 512 * j + 8 * F.lane); gam[2 * j + 1] = *(const f32x4*)(lg + 512 * j + 8 * F.lane + 4); bet[2 * j] = *(const f32x4*)(lb + 512 * j + 8 * F.lane); bet[2 * j + 1] = *(const f32x4*)(lb + 512 * j + 8 * F.lane + 4); }
    const int gw = F.bx * NWAVES + F.wave, NGW = F.G * NWAVES;
    u32x4 nh[2], ny0[2], ny1[2]; float nw0 = 0.f, nw1 = 0.f;
#define P9_LOAD(row_) do { const u32x4* hp_ = (const u32x4*)(H1B + (size_t)(row_) * D) + F.lane; const u32x4* y0_ = (const u32x4*)(Y + (size_t)((row_) * 2) * D) + F.lane; const u32x4* y1_ = (const u32x4*)(Y + (size_t)((row_) * 2 + 1) * D) + F.lane; \
        nh[0] = hp_[0]; nh[1] = hp_[64]; ny0[0] = y0_[0]; ny0[1] = y0_[64]; ny1[0] = y1_[0]; ny1[1] = y1_[64]; nw0 = tokinfo[(row_) * 2]; nw1 = tokinfo[(row_) * 2 + 1]; } while (0)
    if (gw < NTOK) P9_LOAD(gw);
    for (int row = gw; row < NTOK; row += NGW) {
        u32x4 h[2] = {nh[0], nh[1]}, p[2] = {ny0[0], ny0[1]}, q[2] = {ny1[0], ny1[1]}; const float w0 = nw0, w1 = nw1;
        if (row + NGW < NTOK) P9_LOAD(row + NGW);
        f32x4 v[4]; float s = 0.f;
#pragma unroll
        for (int j = 0; j < 2; ++j) {
            v[2 * j][0] = ALPHA * bflo(h[j].x) + w0 * bflo(p[j].x) + w1 * bflo(q[j].x); v[2 * j][1] = ALPHA * bfhi(h[j].x) + w0 * bfhi(p[j].x) + w1 * bfhi(q[j].x);
            v[2 * j][2] = ALPHA * bflo(h[j].y) + w0 * bflo(p[j].y) + w1 * bflo(q[j].y); v[2 * j][3] = ALPHA * bfhi(h[j].y) + w0 * bfhi(p[j].y) + w1 * bfhi(q[j].y);
            v[2 * j + 1][0] = ALPHA * bflo(h[j].z) + w0 * bflo(p[j].z) + w1 * bflo(q[j].z); v[2 * j + 1][1] = ALPHA * bfhi(h[j].z) + w0 * bfhi(p[j].z) + w1 * bfhi(q[j].z);
            v[2 * j + 1][2] = ALPHA * bflo(h[j].w) + w0 * bflo(p[j].w) + w1 * bflo(q[j].w); v[2 * j + 1][3] = ALPHA * bfhi(h[j].w) + w0 * bfhi(p[j].w) + w1 * bfhi(q[j].w); }
#pragma unroll
        for (int j = 0; j < 4; ++j) s += (v[j][0] + v[j][1]) + (v[j][2] + v[j][3]);
        const float mean = wave_sum_dpp(s) * (1.f / D); float s2 = 0.f;
#pragma unroll
        for (int j = 0; j < 4; ++j) { v[j] = v[j] - mean; s2 += (v[j][0] * v[j][0] + v[j][1] * v[j][1]) + (v[j][2] * v[j][2] + v[j][3] * v[j][3]); }
        const float rstd = 1.0f / sqrtf(wave_sum_dpp(s2) * (1.f / D) + 1e-5f);
        float* orow = a.out + (size_t)row * D + 8 * F.lane;
#pragma unroll
        for (int j = 0; j < 2; ++j) { *(f32x4*)(orow + 512 * j) = v[2 * j] * rstd * gam[2 * j] + bet[2 * j]; *(f32x4*)(orow + 512 * j + 4) = v[2 * j + 1] * rstd * gam[2 * j + 1] + bet[2 * j + 1]; }
    }
#undef P9_LOAD
}
#define MFMA32(a, b, c) __builtin_amdgcn_mfma_f32_32x32x16_bf16((a), (b), (c), 0, 0, 0)
__device__ __forceinline__ int crow(int r, int hi) { return (r & 3) + 8 * (r >> 2) + 4 * hi; }
__device__ __forceinline__ float gelu_tanh(float x) { const float u = 0.7978845608028654f * (x + 0.044715f * x * x * x); const float e = __builtin_amdgcn_exp2f(2.885390081777927f * u); return 0.5f * x * (2.0f - 2.0f * __builtin_amdgcn_rcpf(e + 1.0f)); }
constexpr int P2_AROW = 4096 + 16;
constexpr int P2_HID = 32 * P2_AROW;
constexpr int P2_HROW = 512 + 16;
__device__ __forceinline__ void phase2(const Frame& F, const Args& a) {
    unsigned char* ws = F.ws;
    const bf16* ZA = (const bf16*)(ws + WS_ZA);
    { const float* gn = a.in[8]; bf16* CK = (bf16*)(ws + WS_CKVN);
      const int sub = F.lane >> 4, l16 = F.lane & 15;
      float gv[8];
#pragma unroll
      for (int j = 0; j < 8; ++j) gv[j] = gn[l16 * 8 + j];
      const int r4b = F.bx * NWAVES + F.wave, r4s = F.G * NWAVES;
      for (int r4 = r4b; r4 < NTOK / 4; r4 += 4 * r4s) { u32x4 wv[4];
#pragma unroll
          for (int t = 0; t < 4; ++t) { const int rr = r4 + t * r4s; const int row = (rr < NTOK / 4 ? rr : r4) * 4 + sub; wv[t] = *(const u32x4*)(ZA + (size_t)row * ZA_LD + ZC_CKV + l16 * 8); }
#pragma unroll
          for (int t = 0; t < 4; ++t) { const int rr = r4 + t * r4s; if (rr < NTOK / 4) { const int row = rr * 4 + sub; const u32x4 w = wv[t];
              float v[8] = { bflo(w.x), bfhi(w.x), bflo(w.y), bfhi(w.y), bflo(w.z), bfhi(w.z), bflo(w.w), bfhi(w.w) };
              float s2 = 0.f;
#pragma unroll
              for (int j = 0; j < 8; ++j) s2 += v[j] * v[j];
              s2 += __shfl_xor(s2, 1); s2 += __shfl_xor(s2, 2); s2 += __shfl_xor(s2, 4); s2 += __shfl_xor(s2, 8);
              const float rs = 1.0f / sqrtf(s2 * (1.0f / 128.0f) + 1e-6f);
              u32x4 o; o.x = pk2(v[0] * rs * gv[0], v[1] * rs * gv[1]); o.y = pk2(v[2] * rs * gv[2], v[3] * rs * gv[3]); o.z = pk2(v[4] * rs * gv[4], v[5] * rs * gv[5]); o.w = pk2(v[6] * rs * gv[6], v[7] * rs * gv[7]);
              *(u32x4*)(CK + (size_t)row * 128 + l16 * 8) = o; } } } }
    const int r32 = F.lane & 31, hi = F.lane >> 5;
    for (int u = F.bx; u < 256; u += F.G) {
        const int kv = u >> 7, rt = u & 127, R0 = rt * 32;
        const int zc = kv ? ZC_VC : ZC_KC;
        const bf16* W1T = (const bf16*)(ws + (kv ? WS_W1V : WS_W1K)); const bf16* W2T = (const bf16*)(ws + (kv ? WS_W2V : WS_W2K));
        const float* bias = (const float*)(ws + WS_BIASK) + (size_t)kv * 32 * 256;
        bf16* OUT = (bf16*)(ws + (kv ? WS_VCMP : WS_KCMP));
        __syncthreads();
        { u32x4 av[16];
#pragma unroll
          for (int i = 0; i < 16; ++i) { const int q = F.tid + NTHR * i; const int row = q >> 8, cq = q & 255, l = cq >> 3, dch = cq & 7;
              const int R = R0 + row, b = R >> 9, c = (R >> 1) & 255, g = R & 1; const int cc = c < NCMP ? c : NCMP - 1;
              av[i] = *(const u32x4*)(ZA + (size_t)(b * SEQ + 16 * cc + l) * ZA_LD + zc + g * 64 + dch * 8); }
#pragma unroll
          for (int i = 0; i < 16; ++i) { const int q = F.tid + NTHR * i; const int row = q >> 8, cq = q & 255; *(LAS u32x4*)(F.lds + row * P2_AROW + cq * 16) = av[i]; } }
        __syncthreads();
        f32x16 acc = {};
        { const bf16* bp = W1T + (size_t)(32 * F.wave + r32) * 2048 + 8 * hi; const LAS unsigned char* ap = F.lds + r32 * P2_AROW + 16 * hi;
          f32x16 acc1 = {};
#pragma unroll 1
          for (int s0 = 0; s0 < 128; s0 += 32) { bf16x8 bfr[32];
#pragma unroll
              for (int j = 0; j < 32; ++j) bfr[j] = *(const bf16x8*)(bp + (s0 + j) * 16);
#pragma unroll
              for (int j = 0; j < 32; j += 2) { const bf16x8 a0 = *(const LAS bf16x8*)(ap + (s0 + j) * 32), a1 = *(const LAS bf16x8*)(ap + (s0 + j + 1) * 32); acc = MFMA32(a0, bfr[j], acc); acc1 = MFMA32(a1, bfr[j + 1], acc1); } }
#pragma unroll
          for (int i = 0; i < 16; ++i) acc[i] += acc1[i]; }
        { float bs = 0.f;
#pragma unroll 8
          for (int j = 0; j < 32; ++j) bs += bias[j * 256 + 32 * F.wave + r32];
#pragma unroll
          for (int i = 0; i < 16; ++i) { const float h = gelu_tanh(acc[i] + bs); *(LAS unsigned short*)(F.lds + P2_HID + crow(i, hi) * P2_HROW + (32 * F.wave + r32) * 2) = (unsigned short)f2bf(h); } }
        __syncthreads();
        if (F.wave < 2) {
            f32x16 o2 = {};
            const bf16* bp = W2T + (size_t)(32 * F.wave + r32) * 256 + 8 * hi; const LAS unsigned char* ap = F.lds + P2_HID + r32 * P2_HROW + 16 * hi;
#pragma unroll
            for (int s = 0; s < 16; ++s) { const bf16x8 af = *(const LAS bf16x8*)(ap + s * 32); const bf16x8 bfr = *(const bf16x8*)(bp + s * 16); o2 = MFMA32(af, bfr, o2); }
#pragma unroll
            for (int i = 0; i < 16; ++i) OUT[(size_t)(R0 + crow(i, hi)) * 64 + 32 * F.wave + r32] = (bf16)f2bf(o2[i]);
        }
    }
    __syncthreads();
}

typedef short v4i16_t __attribute__((ext_vector_type(4)));
__device__ __forceinline__ s16x4 vtr(const LAS unsigned char* p) { return __builtin_bit_cast(s16x4, __builtin_amdgcn_ds_read_tr16_b64_v4i16((LAS v4i16_t*)p)); }
constexpr int NSA_K = 0;
constexpr int NSA_V = 16384;
constexpr int NSA_TB = 49152;
constexpr int NSA_SC = 65536;
constexpr int NSA_MSK = 81920;
constexpr int NSA_OF = 83968;
constexpr float C2 = 0.125f * LOG2E;

__device__ __forceinline__ float halfmax(float v) { return fmaxf(v, __shfl_xor(v, 32)); }
__device__ __forceinline__ void nsa_tile(const bool nc4, const LAS unsigned char* Kb, const LAS unsigned char* Vb, const LAS float* tbh, const bf16x8 (&qr)[4], f32x16 (&o)[4], float& m, float& l,
                                         int kt, int tq, int kmul, int kadd, int dmax, bool selbit, int mode, float b31, int r32, int hi, int lane) {
    const int tqa = tq - kadd, qk = kmul == 16 ? (tqa >> 4) : tqa, rem = kmul == 16 ? (tqa & 15) : 0;
    const int ebase = qk - (kt * 64 + 4 * hi);
    const LAS unsigned char* vp0 = Vb + ((lane >> 4) & 1) * 32 + (lane & 3) * 8 + (4 * hi + ((lane & 15) >> 2)) * 64;
#pragma unroll
    for (int hf = 0; hf < 2; ++hf) {
        f32x16 s0 = {};
#pragma unroll
        for (int d0 = 0; d0 < 4; ++d0) { const bf16x8 k0 = *(const LAS bf16x8*)(Kb + (2 * d0 + hi) * 1024 + (r32 + 32 * hf) * 16); s0 = MFMA32(k0, qr[d0], s0); }
        float tmax, mn, ps = 0.f;
        if (mode == 2) {
            float a0 = fmaxf(fmaxf(s0[0], s0[1]), s0[2]), a1 = fmaxf(fmaxf(s0[3], s0[4]), s0[5]);
            a0 = fmaxf(fmaxf(a0, s0[6]), s0[7]); a1 = fmaxf(fmaxf(a1, s0[8]), s0[9]); a0 = fmaxf(fmaxf(a0, s0[10]), s0[11]); a1 = fmaxf(fmaxf(a1, s0[12]), s0[13]); a0 = fmaxf(fmaxf(a0, s0[14]), s0[15]);
            const float cb = selbit ? b31 : NEGBIG;
            tmax = fmaxf(a0, a1) * C2 + cb;
            tmax = halfmax(tmax);
            mn = fmaxf(m, tmax);
            const float cc = cb - mn;
#pragma unroll
            for (int r = 0; r < 16; ++r) { const float p0 = __builtin_amdgcn_exp2f(s0[r] * C2 + cc); s0[r] = p0; ps += p0; }
        } else if (mode == 1) {
            int eb1 = ebase; asm volatile("" : "+v"(eb1));
            const LAS float* tb1 = tbh + (eb1 - 96);
            float bv[16];
#pragma unroll
            for (int r = 0; r < 16; ++r) bv[r] = tb1[96 - ((r & 3) + 8 * (r >> 2) + 32 * hf)];
#pragma unroll
            for (int r = 0; r < 16; ++r) asm volatile("" : "+v"(bv[r]));
            tmax = NEGBIG;
#pragma unroll
            for (int r = 0; r < 16; ++r) { const float x = s0[r] * C2 + bv[r]; s0[r] = x; tmax = fmaxf(tmax, x); }
            tmax = selbit ? tmax : NEGBIG;
            tmax = halfmax(tmax);
            mn = fmaxf(m, tmax);
            const float mne = selbit ? mn : 1e30f;
#pragma unroll
            for (int r = 0; r < 16; ++r) { const float p0 = __builtin_amdgcn_exp2f(s0[r] - mne); s0[r] = p0; ps += p0; }
        } else {
            tmax = NEGBIG;
            float bv[16];
            int eb0 = ebase; asm volatile("" : "+v"(eb0));
#pragma unroll
            for (int r = 0; r < 16; ++r) { const int dist = __mul24(eb0 - ((r & 3) + 8 * (r >> 2) + 32 * hf), kmul) + rem; int dc = dist < 0 ? 0 : dist; dc = dc > 1023 ? 1023 : dc; bv[r] = tbh[dc]; }
#pragma unroll
            for (int r = 0; r < 16; ++r) asm volatile("" : "+v"(bv[r]));
#pragma unroll
            for (int r = 0; r < 16; ++r) { const int dist = __mul24(eb0 - ((r & 3) + 8 * (r >> 2) + 32 * hf), kmul) + rem;
                const bool valid = selbit && dist >= 0 && dist < dmax;
                const float x = valid ? s0[r] * C2 + bv[r] : NEGBIG;
                s0[r] = x; tmax = fmaxf(tmax, x); }
            tmax = halfmax(tmax);
            mn = fmaxf(m, tmax);
#pragma unroll
            for (int r = 0; r < 16; ++r) { const float p0 = s0[r] > -1e29f ? __builtin_amdgcn_exp2f(s0[r] - mn) : 0.f; s0[r] = p0; ps += p0; }
        }
        if (__any(mn != m)) {
            const float alpha = __builtin_amdgcn_exp2f(m - mn);
            l *= alpha;
#pragma unroll
            for (int c = 0; c < 4; ++c) if (c < 2 || nc4) {
#pragma unroll
                for (int r = 0; r < 16; ++r) o[c][r] *= alpha; }
        }
        m = mn;
        l += ps;
        u32x4 pw[2];
#pragma unroll
        for (int q = 0; q < 4; ++q) { pw[0][q] = pk2(s0[2 * q], s0[2 * q + 1]); pw[1][q] = pk2(s0[8 + 2 * q], s0[8 + 2 * q + 1]); }
#pragma unroll
        for (int c = 0; c < 4; ++c) if (c < 2 || nc4)
#pragma unroll
            for (int s2 = 0; s2 < 2; ++s2) { const int s = 2 * hf + s2; const s16x4 vl = vtr(vp0 + c * 4096 + s * 1024), vh = vtr(vp0 + c * 4096 + s * 1024 + 512);
                const bf16x8 vf = {vl[0], vl[1], vl[2], vl[3], vh[0], vh[1], vh[2], vh[3]};
                o[c] = MFMA32(vf, __builtin_bit_cast(bf16x8, pw[s2]), o[c]); }
    }
}

__device__ __forceinline__ void nsa_unit(const Frame& F, int b, int g, int qt) {
    unsigned char* ws = F.ws;
    const bf16* ZA = (const bf16*)(ws + WS_ZA);
    const int r32 = F.lane & 31, hi = F.lane >> 5, qi = r32 >> 2, hh = r32 & 3, head = g * 4 + hh;
    const int q0 = qt * 64, tq = q0 + 8 * F.wave + qi;
    const size_t zrow = (size_t)(b * SEQ + tq) * ZA_LD;
    const int srow = F.tid >> 3, sch = F.tid & 7;
    const f32x4* TBA4 = (const f32x4*)((const float*)(ws + WS_TBA) + (size_t)g * 4 * 1024);
    const f32x4 tbv0 = TBA4[F.tid], tbv1 = TBA4[F.tid + NTHR];
    const LAS float* tbh = (const LAS float*)(F.lds + NSA_TB) + hh * 1024;
    const int wq0 = q0 + 8 * F.wave;
    const float b31 = ((const float*)(ws + WS_TBA))[(size_t)head * 1024 + 1023];
    bf16x8 qr[4];
#pragma unroll
    for (int d0 = 0; d0 < 4; ++d0) qr[d0] = *(const bf16x8*)(ZA + zrow + ZC_QA + head * 64 + d0 * 16 + hi * 8);
    unsigned short graw[3];
#pragma unroll
    for (int i = 0; i < 3; ++i) graw[i] = ZA[zrow + ZC_GNSA + head * 3 + i];
    { LAS f32x4* tb4 = (LAS f32x4*)(F.lds + NSA_TB); tb4[F.tid] = tbv0; tb4[F.tid + NTHR] = tbv1; }
    float gate[3];
#pragma unroll
    for (int i = 0; i < 3; ++i) gate[i] = sigmoidf_(bf2f(graw[i]));
    LAS float* ofw = (LAS float*)(F.lds + NSA_OF) + F.wave * 2048 + F.lane;
    unsigned mlo = 0u, mhi = 0u;
    u32x4 kreg, vreg = {0u, 0u, 0u, 0u};
    const bf16* kgp; size_t vdel, tstep;
#define NSA_SETUP(br_) do { const int b_ = (br_); const bf16* Kg_; size_t pitch_; int tl_; \
        if (b_ == 0) { Kg_ = (const bf16*)(ws + WS_KCMP) + (size_t)(b * 256) * 128 + g * 64; vdel = (size_t)((const bf16*)(ws + WS_VCMP) - (const bf16*)(ws + WS_KCMP)); pitch_ = 128; tl_ = 0; } \
        else { Kg_ = ZA + (size_t)(b * SEQ) * ZA_LD + (b_ == 1 ? ZC_KS : ZC_KW) + g * 64; vdel = 128; pitch_ = ZA_LD; tl_ = (b_ == 2 && qt > 8) ? qt - 8 : 0; } \
        kgp = Kg_ + (size_t)(tl_ * 64 + srow) * pitch_ + sch * 8; tstep = (size_t)64 * pitch_; } while (0)
#define NSA_GLOAD(kt_) do { kreg = *(const u32x4*)kgp; vreg = *(const u32x4*)(kgp + vdel); kgp += tstep; } while (0)
    NSA_SETUP(0); NSA_GLOAD(0);
#pragma nounroll
    for (int br = 0; br < 3; ++br) {
        const bool iscmp = br == 0;
        const int t_lo = iscmp ? 0 : ((br == 2 && qt > 8) ? qt - 8 : 0), t_hi = iscmp ? ((q0 + 32) >> 10) : qt;
        const int kmul = iscmp ? 16 : 1, kadd = iscmp ? 31 : 0, dmax = br == 2 ? 512 : 0x40000000;
        f32x16 o[4]; o[0] = f32x16{}; o[1] = f32x16{}; o[2] = f32x16{}; o[3] = f32x16{};
        float m = NEGBIG, l = 0.f;
#define NSA_LSTORE(kt_, buf_) do { \
        *(LAS u32x4*)(F.lds + NSA_K + (buf_) * 8192 + sch * 1024 + srow * 16) = kreg; \
        *(LAS u32x4*)(F.lds + NSA_V + (buf_) * 16384 + (sch >> 2) * 4096 + srow * 64 + (sch & 3) * 16) = vreg; \
        if (iscmp) { const int c_ = (kt_) * 64 + srow, jj_ = c_ >> 2, mm_ = c_ & 3; u32x4 mv_; \
            _Pragma("unroll") for (int i_ = 0; i_ < 4; ++i_) { const int j0_ = sch * 8 + 2 * i_, j1_ = j0_ + 1; \
                const unsigned e0_ = (c_ < NCMP) ? (mm_ < 3 ? (j0_ == jj_ ? 0x4000u : 0u) : ((j0_ == jj_ || j0_ == jj_ + 1) ? 0x3F80u : 0u)) : 0u; \
                const unsigned e1_ = (c_ < NCMP) ? (mm_ < 3 ? (j1_ == jj_ ? 0x4000u : 0u) : ((j1_ == jj_ || j1_ == jj_ + 1) ? 0x3F80u : 0u)) : 0u; \
                mv_[i_] = e0_ | (e1_ << 16); } \
            *(LAS u32x4*)(F.lds + NSA_V + (buf_) * 16384 + (2 + (sch >> 2)) * 4096 + srow * 64 + (sch & 3) * 16) = mv_; } } while (0)
        NSA_LSTORE(t_lo, 0);
        __syncthreads();
        int buf = 0;
#pragma nounroll
        for (int kt = t_lo; kt <= t_hi; ++kt) {
            const int ktn = kt + 1; const bool more = kt < t_hi;
            if (more) NSA_GLOAD(ktn);
            const bool selbit = br == 1 ? (((kt < 32 ? (mlo >> kt) : (mhi >> (kt - 32))) & 1u) != 0u) : true;
            int mode = 0;
            { const int dmin = wq0 - (64 * kt + 63), dmx = wq0 + 7 - 64 * kt;
              if (br == 1) mode = dmin >= 790 ? 2 : (dmin >= 0 ? 1 : 0);
              if (br == 0) mode = 16 * (((wq0 - 31) >> 4) - (64 * kt + 63)) >= 790 ? 2 : 0;
              if (br == 2) mode = (dmin >= 0 && dmx <= 511) ? 1 : 0; }
            if (__any(selbit))
                nsa_tile(iscmp, F.lds + NSA_K + buf * 8192, F.lds + NSA_V + buf * 16384, tbh, qr, o, m, l, kt, tq, kmul, kadd, dmax, selbit, mode, b31, r32, hi, F.lane);
            if (more) NSA_LSTORE(ktn, buf ^ 1);
            __syncthreads();
            buf ^= 1;
        }
#undef NSA_LSTORE
        if (br < 2) { NSA_SETUP(br + 1); NSA_GLOAD(0); }
        l += __shfl_xor(l, 32);
        const float inv = l > 0.f ? 1.0f / l : 0.f;
        { const float sc = inv * (br == 0 ? gate[0] : br == 1 ? gate[1] : gate[2]);
#pragma unroll
            for (int c = 0; c < 2; ++c)
#pragma unroll
                for (int r = 0; r < 16; ++r) { const float prev = br == 0 ? 0.f : ofw[(c * 16 + r) * 64]; ofw[(c * 16 + r) * 64] = prev + o[c][r] * sc; } }
        if (iscmp) {
            LAS float* scw = (LAS float*)(F.lds + NSA_SC) + F.wave * 512;
#pragma unroll
            for (int c = 0; c < 2; ++c)
#pragma unroll
                for (int r = 0; r < 16; ++r) { float v = o[2 + c][r] * inv;
                    v += __builtin_bit_cast(float, __builtin_amdgcn_update_dpp(0, __builtin_bit_cast(int, v), 0xB1, 0xf, 0xf, true));
                    v += __builtin_bit_cast(float, __builtin_amdgcn_update_dpp(0, __builtin_bit_cast(int, v), 0x4E, 0xf, 0xf, true));
                    if (hh == 0) scw[qi * 64 + 32 * c + crow(r, hi)] = v; }
            LDS_WAIT();
            LAS unsigned* mskw = (LAS unsigned*)(F.lds + NSA_MSK) + F.wave * 16;
#pragma nounroll
            for (int q = 0; q < 8; ++q) {
                const int curq = (q0 + 8 * F.wave + q) >> 6, j = F.lane;
                const bool avail = j <= curq, forced = (j == 0) || (j == curq) || (j == curq - 1);
                const float sj = avail ? scw[q * 64 + j] + (forced ? 1e4f : 0.f) : NEGBIG;
                int rank = 0; const int sjb = __builtin_bit_cast(int, sj);
#pragma unroll
                for (int j2 = 0; j2 < 64; ++j2) { const float s2 = __builtin_bit_cast(float, __builtin_amdgcn_readlane(sjb, j2)); rank += (s2 > sj || (s2 == sj && j2 < j)) ? 1 : 0; }
                const bool sel = rank < 16 && avail;
                const unsigned long long bm = __ballot(sel);
                if (F.lane == 0) { mskw[2 * q] = (unsigned)bm; mskw[2 * q + 1] = (unsigned)(bm >> 32); } }
            LDS_WAIT();
            mlo = mskw[2 * qi]; mhi = mskw[2 * qi + 1];
        }
    }
#undef NSA_GLOAD
#undef NSA_SETUP
    bf16* OA = (bf16*)(ws + WS_OA) + (size_t)(b * SEQ + tq) * 512 + head * 64;
#pragma unroll
    for (int c = 0; c < 2; ++c)
#pragma unroll
        for (int r4 = 0; r4 < 4; ++r4) { u32x2 w; w.x = pk2(ofw[(c * 16 + 4 * r4) * 64], ofw[(c * 16 + 4 * r4 + 1) * 64]); w.y = pk2(ofw[(c * 16 + 4 * r4 + 2) * 64], ofw[(c * 16 + 4 * r4 + 3) * 64]);
            *(u32x2*)(OA + 32 * c + 8 * r4 + 4 * hi) = w; }
}
__device__ __forceinline__ void phase3(const Frame& F) {
    const bool xcd = (F.G == 256);
    const int pstart = xcd ? (F.bx >> 3) : F.bx, pstep = xcd ? 32 : F.G, pend = xcd ? 64 : 512;
#pragma nounroll
    for (int p2 = 2 * pstart; p2 < 2 * pend; p2 += (p2 & 1) ? 2 * pstep - 1 : 1) { const int p = p2 >> 1;
        const int b = xcd ? (F.bx & 7) : (p >> 6), g = (p >> 5) & 1, qt = p & 31;
        nsa_unit(F, b, g, (p2 & 1) ? qt : 63 - qt); }
    __syncthreads();
}

#define MFMA16(a, b, c) __builtin_amdgcn_mfma_f32_16x16x32_bf16((a), (b), (c), 0, 0, 0)
constexpr int DSA_SCP = 8200;
constexpr int DSA_SC = 0;
constexpr int DSA_LIST = 16 * DSA_SCP;
constexpr int DSA_NSEL = DSA_LIST + 8192;
constexpr int DSA_BIAS = DSA_NSEL + 64;
constexpr int DSA_HIST = DSA_BIAS + 1088;
constexpr int DSA_BKI = DSA_HIST + 8192;
constexpr int KSEL = 256;
__device__ __forceinline__ unsigned dsa_offb(unsigned row, unsigned ch) { return 256u * row + 16u * (ch ^ (((row & 3u) << 2) | ((row >> 2) & 3u))); }
__device__ __forceinline__ unsigned sortkey16(float x) { x = x + 0.0f; const unsigned short h = __builtin_bit_cast(unsigned short, (_Float16)x); return (h & 0x8000u) ? (unsigned)(unsigned short)~h : (unsigned)(h | 0x8000u); }
__device__ __forceinline__ int prefix_cnt(unsigned long long b) { return (int)__builtin_amdgcn_mbcnt_hi((unsigned)(b >> 32), __builtin_amdgcn_mbcnt_lo((unsigned)b, 0u)); }

__device__ __forceinline__ void dsa_unit(const Frame& F, const Args& a, int b, int qt16) {
    unsigned char* ws = F.ws;
    const bf16* ZA = (const bf16*)(ws + WS_ZA);
    const int lane = F.lane, l16 = lane & 15, quad = lane >> 4, q0 = qt16 * 16;
    __syncthreads();
#ifndef PROBE_DSA
#define PROBE_DSA 0
#endif
    for (int rep1_ = 0; rep1_ < (PROBE_DSA == 1 ? 2 : 1); ++rep1_) {
        const size_t qrow = (size_t)(b * SEQ + q0 + l16) * ZA_LD;
        bf16x8 qf[4][2];
#pragma unroll
        for (int i = 0; i < 4; ++i)
#pragma unroll
            for (int ks = 0; ks < 2; ++ks) qf[i][ks] = *(const bf16x8*)(ZA + qrow + ZC_QIDX + i * 64 + 32 * ks + 8 * quad);
        float wq[4];
#pragma unroll
        for (int i = 0; i < 4; ++i) wq[i] = bf2f(ZA[qrow + ZC_WIDX + i]) * 0.0625f;
        const int tq = q0 + l16, nkt = qt16 + 1;
        const bf16* kbase = ZA + (size_t)(b * SEQ + l16) * ZA_LD + ZC_KIDX + 8 * quad;
        bf16x8 ka[4][2], kn[4][2];
#define DSA_KLOAD(dst, kt0_) do { _Pragma("unroll") for (int t_ = 0; t_ < 4; ++t_) { const int k_ = (kt0_) + 8 * t_; const int kc_ = k_ < nkt ? k_ : nkt - 1; \
            dst[t_][0] = *(const bf16x8*)(kbase + (size_t)(kc_ * 16) * ZA_LD); dst[t_][1] = *(const bf16x8*)(kbase + (size_t)(kc_ * 16) * ZA_LD + 32); } } while (0)
        if (F.wave < nkt) DSA_KLOAD(ka, F.wave);
#pragma nounroll
        for (int kt0 = F.wave; kt0 < nkt; kt0 += 32) {
            if (kt0 + 32 < nkt) DSA_KLOAD(kn, kt0 + 32);
#pragma unroll
            for (int t = 0; t < 4; ++t) { const int kt = kt0 + 8 * t;
                if (kt < nkt) {
                    float idx[4] = {0.f, 0.f, 0.f, 0.f};
#pragma unroll
                    for (int i = 0; i < 4; ++i) { f32x4 acc = {0.f, 0.f, 0.f, 0.f}; acc = MFMA16(ka[t][0], qf[i][0], acc); acc = MFMA16(ka[t][1], qf[i][1], acc);
#pragma unroll
                        for (int r = 0; r < 4; ++r) idx[r] += fmaxf(acc[r], 0.f) * wq[i]; }
                    unsigned k16[4];
#pragma unroll
                    for (int r = 0; r < 4; ++r) { const int key = kt * 16 + 4 * quad + r; k16[r] = key <= tq ? sortkey16(idx[r]) : 0u; }
                    u32x2 w; w.x = k16[0] | (k16[1] << 16); w.y = k16[2] | (k16[3] << 16);
                    *(LAS u32x2*)(F.lds + DSA_SC + l16 * DSA_SCP + (kt * 16 + 4 * quad) * 2) = w; } }
#pragma unroll
            for (int t = 0; t < 4; ++t) { ka[t][0] = kn[t][0]; ka[t][1] = kn[t][1]; }
        }
#undef DSA_KLOAD
    }
    if (F.tid < 264) { const float* rb = a.in[11]; ((LAS float*)(F.lds + DSA_BIAS))[F.tid] = F.tid < 256 ? rb[(F.tid >> 3) * 16 + 8 + (F.tid & 7)] * LOG2E : NEGBIG; }
    __syncthreads();
#pragma nounroll
    for (int qq = 0; qq < (PROBE_DSA == 2 ? 4 : 2); ++qq) {
        const int n = 2 * F.wave + (qq & 1), tq = q0 + n, N = tq + 1;
        LAS unsigned char* scq = F.lds + DSA_SC + n * DSA_SCP;
        LAS unsigned short* lst = (LAS unsigned short*)(F.lds + DSA_LIST) + n * 256;
        LAS unsigned short* bki = (LAS unsigned short*)(F.lds + DSA_BKI) + n * 256;
        if (N <= KSEL) {
            for (int s = lane; s < KSEL; s += 64) lst[s] = (unsigned short)(s < N ? s : 0);
            if (lane == 0) ((LAS int*)(F.lds + DSA_NSEL))[n] = N;
        } else {
            const int nit = (N + 255) >> 8;
            { const int it = nit - 1; const int s0 = 4 * (lane + 64 * it); u32x2 w = *(LAS u32x2*)(scq + s0 * 2);
              if (s0 + 0 > tq) w.x &= 0xffff0000u; if (s0 + 1 > tq) w.x &= 0x0000ffffu; if (s0 + 2 > tq) w.y &= 0xffff0000u; if (s0 + 3 > tq) w.y &= 0x0000ffffu;
              *(LAS u32x2*)(scq + s0 * 2) = w; }
            LDS_WAIT();
            LAS unsigned* hist = (LAS unsigned*)(F.lds + DSA_HIST) + F.wave * 256;
            unsigned T = 0u; int cgt = 0; int need = KSEL;
#pragma nounroll
            for (int lvl = 0; lvl < 2; ++lvl) {
                *(LAS u32x4*)(hist + 4 * lane) = (u32x4){0u, 0u, 0u, 0u};
                LDS_WAIT();
#pragma nounroll
                for (int it = 0; it < nit; ++it) { const u32x2 w = *(LAS u32x2*)(scq + (lane + 64 * it) * 8);
                    const unsigned k[4] = {w.x & 0xffffu, w.x >> 16, w.y & 0xffffu, w.y >> 16};
#pragma unroll
                    for (int e = 0; e < 4; ++e) { const bool in = lvl == 0 ? true : (k[e] >> 8) == (T >> 8); const unsigned bin = lvl == 0 ? (k[e] >> 8) : (k[e] & 255u);
                        if (in) __hip_atomic_fetch_add(hist + bin, 1u, __ATOMIC_RELAXED, __HIP_MEMORY_SCOPE_WORKGROUP); } }
                LDS_WAIT();
                const u32x4 h = *(LAS u32x4*)(hist + 4 * lane);
                const int sl = (int)(h.x + h.y + h.z + h.w); int suf = sl;
#pragma unroll
                for (int d = 1; d < 64; d <<= 1) { const int o = __shfl_down(suf, d); suf += (lane + d < 64) ? o : 0; }
                const int above = suf - sl;
                const bool here = above < need && above + sl >= need;
                int bsel = 4 * lane + 3, ca = above;
                if (ca + (int)h.w < need) { ca += (int)h.w; bsel = 4 * lane + 2; if (ca + (int)h.z < need) { ca += (int)h.z; bsel = 4 * lane + 1; if (ca + (int)h.y < need) { ca += (int)h.y; bsel = 4 * lane; } } }
                const unsigned long long bm = __ballot(here);
                const int src = bm ? (int)__builtin_ctzll(bm) : 0;
                const int B = __shfl(bsel, src), CA = __shfl(ca, src);
                if (lvl == 0) T = (unsigned)B << 8; else T |= (unsigned)B;
                cgt += CA; need -= CA;
                LDS_WAIT();
            }
            const int rties = KSEL - cgt;
            int tiebase = 0, outbase = 0;
#define DSA_PUT(pos_, idx_) do { const int p_ = (pos_); if (p_ >= 0 && p_ < KSEL) lst[p_] = (unsigned short)(idx_); } while (0)
#pragma nounroll
            for (int it = 0; it < nit; ++it) { const u32x2 w = *(LAS u32x2*)(scq + (lane + 64 * it) * 8);
                const unsigned k0 = w.x & 0xffffu, k1 = w.x >> 16, k2 = w.y & 0xffffu, k3 = w.y >> 16;
                const int sidx = 4 * (lane + 64 * it);
                const bool g0 = k0 > T, g1 = k1 > T, g2 = k2 > T, g3 = k3 > T;
                const unsigned long long bg0 = __ballot(g0), bg1 = __ballot(g1), bg2 = __ballot(g2), bg3 = __ballot(g3);
                if (bg0 | bg1 | bg2 | bg3) {
                    int pos = outbase + prefix_cnt(bg0) + prefix_cnt(bg1) + prefix_cnt(bg2) + prefix_cnt(bg3);
                    if (g0) { DSA_PUT(pos, sidx + 0); ++pos; }
                    if (g1) { DSA_PUT(pos, sidx + 1); ++pos; }
                    if (g2) { DSA_PUT(pos, sidx + 2); ++pos; }
                    if (g3) { DSA_PUT(pos, sidx + 3); ++pos; }
                    outbase += __popcll(bg0) + __popcll(bg1) + __popcll(bg2) + __popcll(bg3); }
                const bool e0 = k0 == T, e1 = k1 == T, e2 = k2 == T, e3 = k3 == T;
                const unsigned long long be0 = __ballot(e0), be1 = __ballot(e1), be2 = __ballot(e2), be3 = __ballot(e3);
                if ((be0 | be1 | be2 | be3) && tiebase < rties) {
                    const int t0 = tiebase + prefix_cnt(be0) + prefix_cnt(be1) + prefix_cnt(be2) + prefix_cnt(be3), t1 = t0 + (e0 ? 1 : 0), t2 = t1 + (e1 ? 1 : 0), t3 = t2 + (e2 ? 1 : 0);
                    if (e0 && t0 < rties) DSA_PUT(KSEL - 1 - t0, sidx + 0);
                    if (e1 && t1 < rties) DSA_PUT(KSEL - 1 - t1, sidx + 1);
                    if (e2 && t2 < rties) DSA_PUT(KSEL - 1 - t2, sidx + 2);
                    if (e3 && t3 < rties) DSA_PUT(KSEL - 1 - t3, sidx + 3);
                    tiebase += __popcll(be0) + __popcll(be1) + __popcll(be2) + __popcll(be3); } }
#undef DSA_PUT
            outbase = KSEL;
            if (lane == 0) ((LAS int*)(F.lds + DSA_NSEL))[n] = outbase < KSEL ? outbase : KSEL;
        }
        LDS_WAIT();
        { const int nsl = N < KSEL ? N : KSEL;
#pragma unroll
          for (int i = 0; i < 4; ++i) { const int e = lane + 64 * i; const int dist = tq - (int)lst[e];
              const int dpos = dist < 1 ? 1 : dist; int bl = 16 + (int)((__log2f((float)dpos) - 4.0f) * 2.66666675f); bl = bl > 31 ? 31 : bl;
              const int bk = dist < 1 ? 0 : (dpos < 16 ? dpos : bl);
              bki[e] = (unsigned short)(e < nsl ? bk * 32 : 1024); } }
    }
    LDS_WAIT();
    const bf16* CK = (const bf16*)(ws + WS_CKVN) + (size_t)(b * SEQ) * 128;
    LAS unsigned char* gb0 = F.lds + DSA_SC + (2 * F.wave) * DSA_SCP;
    const LAS unsigned char* biasb = F.lds + DSA_BIAS + (l16 & 7) * 4;
#define DSA_GATHER(chunk_, buf_) do { const unsigned key_ = lst[(chunk_) * 32 + (lane >> 1)]; const char* src_ = (const char*)CK + (key_ * 256u + (unsigned)(lane & 1) * 16u); \
        _Pragma("unroll") for (int c_ = 0; c_ < 8; ++c_) __builtin_amdgcn_global_load_lds((const unsigned*)(src_ + c_ * 32), (LAS unsigned*)(gb0 + (buf_) * 8192 + c_ * 1024), 16, 0, 0); } while (0)
    int tqs[2], nsels[2]; const LAS unsigned short* lsts[2]; const LAS unsigned short* bkis[2]; bf16x8 ql[2][4]; f32x4 o[2][8]; float ms[2], ls[2];
#pragma unroll
    for (int qq = 0; qq < 2; ++qq) { const int n = 2 * F.wave + qq; tqs[qq] = q0 + n; nsels[qq] = ((const LAS int*)(F.lds + DSA_NSEL))[n]; lsts[qq] = (const LAS unsigned short*)(F.lds + DSA_LIST) + n * 256; bkis[qq] = (const LAS unsigned short*)(F.lds + DSA_BKI) + n * 256;
#pragma unroll
        for (int s2 = 0; s2 < 4; ++s2) { const bf16x8 v = *(const bf16x8*)(ZA + (size_t)(b * SEQ + tqs[qq]) * ZA_LD + ZC_QLAT + (l16 & 7) * 128 + 32 * s2 + 8 * quad); ql[qq][s2] = l16 < 8 ? v : (bf16x8){0, 0, 0, 0, 0, 0, 0, 0}; }
#pragma unroll
        for (int c = 0; c < 8; ++c) o[qq][c] = (f32x4){0.f, 0.f, 0.f, 0.f};
        ms[qq] = NEGBIG; ls[qq] = 0.f; }
#pragma unroll
    for (int qq = 0; qq < 2; ++qq)
#pragma unroll
        for (int s2 = 0; s2 < 4; ++s2) asm volatile("" : "+v"(ql[qq][s2]));
    const int nch1 = (nsels[1] + 31) >> 5, nch = PROBE_DSA == 3 ? 2 * nch1 : nch1;
    LDS_WAIT();
    { const LAS unsigned short* lst = lsts[0]; DSA_GATHER(0, 0); }
    { const LAS unsigned short* lst = lsts[1]; DSA_GATHER(0, 1); }
    const unsigned offA = (unsigned)((quad >> 1) * 1024 + l16 * 32 + (quad & 1) * 16);
    const unsigned offT = (unsigned)((4 * quad + (l16 >> 2)) * 32 + 8 * (lane & 3));
#pragma nounroll
    for (int ch = 0; ch < nch; ++ch) {
#pragma unroll
        for (int qq = 0; qq < 2; ++qq) {
            const int chd = ch >= nch1 ? ch - nch1 : ch;
            const LAS unsigned short* lst = lsts[qq];
            const LAS unsigned char* gb = gb0 + qq * 8192;
            if (qq == 0 || ch + 1 < nch) asm volatile("s_waitcnt vmcnt(8)" ::: "memory"); else asm volatile("s_waitcnt vmcnt(0)" ::: "memory");
            f32x4 acc2[2]; float bvs[2][4];
#pragma unroll
            for (int rb = 0; rb < 2; ++rb) { f32x4 acc = {0.f, 0.f, 0.f, 0.f};
#pragma unroll
                for (int s2 = 0; s2 < 4; ++s2) { const bf16x8 af = *(const LAS bf16x8*)(gb + offA + rb * 512 + s2 * 2048); acc = MFMA16(af, ql[qq][s2], acc); }
                acc2[rb] = acc;
                const u32x2 kb = *(const LAS u32x2*)((const LAS unsigned char*)bkis[qq] + (chd * 32 + rb * 16 + 4 * quad) * 2);
                bvs[rb][0] = *(const LAS float*)(biasb + (kb.x & 0xffffu)); bvs[rb][1] = *(const LAS float*)(biasb + (kb.x >> 16));
                bvs[rb][2] = *(const LAS float*)(biasb + (kb.y & 0xffffu)); bvs[rb][3] = *(const LAS float*)(biasb + (kb.y >> 16)); }
#pragma unroll
            for (int rb = 0; rb < 2; ++rb)
#pragma unroll
                for (int r = 0; r < 4; ++r) asm volatile("" : "+v"(bvs[rb][r]));
            float x[2][4]; float tmax = NEGBIG;
#pragma unroll
            for (int rb = 0; rb < 2; ++rb)
#pragma unroll
                for (int r = 0; r < 4; ++r) { const float xv = acc2[rb][r] * C2 + bvs[rb][r]; x[rb][r] = xv; tmax = fmaxf(tmax, xv); }
            tmax = fmaxf(tmax, __shfl_xor(tmax, 16)); tmax = fmaxf(tmax, __shfl_xor(tmax, 32));
            const float mn = fmaxf(ms[qq], tmax); const bool resc = __any(mn != ms[qq]); const float alpha = __builtin_amdgcn_exp2f(ms[qq] - mn); ms[qq] = mn;
            float ps = 0.f;
#pragma unroll
            for (int rb = 0; rb < 2; ++rb)
#pragma unroll
                for (int r = 0; r < 4; ++r) { const float pv = __builtin_amdgcn_exp2f(x[rb][r] - mn); x[rb][r] = pv; ps += pv; }
            ls[qq] = ls[qq] * alpha + ps;
            if (resc) {
#pragma unroll
                for (int c = 0; c < 8; ++c) o[qq][c] = o[qq][c] * alpha; }
            u32x4 pw; pw.x = pk2(x[0][0], x[0][1]); pw.y = pk2(x[0][2], x[0][3]); pw.z = pk2(x[1][0], x[1][1]); pw.w = pk2(x[1][2], x[1][3]);
            const unsigned gba = (unsigned)(unsigned long long)gb + offT;
#pragma unroll
            for (int cb = 0; cb < 2; ++cb) {
                s16x4 v[8];
                if (cb == 0) asm volatile("ds_read_b64_tr_b16 %0, %8\n\tds_read_b64_tr_b16 %1, %8 offset:512\n\tds_read_b64_tr_b16 %2, %8 offset:1024\n\tds_read_b64_tr_b16 %3, %8 offset:1536\n\t"
                             "ds_read_b64_tr_b16 %4, %8 offset:2048\n\tds_read_b64_tr_b16 %5, %8 offset:2560\n\tds_read_b64_tr_b16 %6, %8 offset:3072\n\tds_read_b64_tr_b16 %7, %8 offset:3584\n\ts_waitcnt lgkmcnt(0)"
                             : "=&v"(v[0]), "=&v"(v[1]), "=&v"(v[2]), "=&v"(v[3]), "=&v"(v[4]), "=&v"(v[5]), "=&v"(v[6]), "=&v"(v[7]) : "v"(gba) : "memory");
                else asm volatile("ds_read_b64_tr_b16 %0, %8 offset:4096\n\tds_read_b64_tr_b16 %1, %8 offset:4608\n\tds_read_b64_tr_b16 %2, %8 offset:5120\n\tds_read_b64_tr_b16 %3, %8 offset:5632\n\t"
                             "ds_read_b64_tr_b16 %4, %8 offset:6144\n\tds_read_b64_tr_b16 %5, %8 offset:6656\n\tds_read_b64_tr_b16 %6, %8 offset:7168\n\tds_read_b64_tr_b16 %7, %8 offset:7680\n\ts_waitcnt lgkmcnt(0)"
                             : "=&v"(v[0]), "=&v"(v[1]), "=&v"(v[2]), "=&v"(v[3]), "=&v"(v[4]), "=&v"(v[5]), "=&v"(v[6]), "=&v"(v[7]) : "v"(gba) : "memory");
#pragma unroll
                for (int c4 = 0; c4 < 4; ++c4) { const int c = 4 * cb + c4; const s16x4 v0 = v[2 * c4], v1 = v[2 * c4 + 1];
                    const bf16x8 vf = {v0[0], v0[1], v0[2], v0[3], v1[0], v1[1], v1[2], v1[3]};
                    o[qq][c] = MFMA16(vf, __builtin_bit_cast(bf16x8, pw), o[qq][c]); }
            }
            LDS_WAIT();
            if (ch + 1 < nch) DSA_GATHER((ch + 1 >= nch1 ? ch + 1 - nch1 : ch + 1), qq);
        }
    }
#pragma unroll
    for (int qq = 0; qq < 2; ++qq) {
        float l = ls[qq]; const int tq = tqs[qq];
        l += __shfl_xor(l, 16); l += __shfl_xor(l, 32);
        const float inv = l > 0.f ? 1.0f / l : 0.f;
        if (l16 < 8) { bf16* op = (bf16*)(ws + WS_OLAT) + (size_t)(b * SEQ + tq) * 1024 + l16 * 128 + 4 * quad;
#pragma unroll
            for (int c = 0; c < 8; ++c) { u32x2 w; w.x = pk2(o[qq][c][0] * inv, o[qq][c][1] * inv); w.y = pk2(o[qq][c][2] * inv, o[qq][c][3] * inv); *(u32x2*)(op + 16 * c) = w; } }
    }
}
#undef DSA_GATHER
__device__ __forceinline__ void phase4(const Frame& F, const Args& a) {
    const bool xcd = (F.G == 256);
    const int pstart = xcd ? (F.bx >> 3) : F.bx, pstep = xcd ? 32 : F.G, pend = xcd ? 128 : 1024;
#pragma nounroll
    for (int p2 = 2 * pstart; p2 < 2 * pend; p2 += (p2 & 1) ? 2 * pstep - 1 : 1) { const int p = p2 >> 1;
        const int b = xcd ? (F.bx & 7) : (p >> 7), j = p & 127;
        dsa_unit(F, a, b, (p2 & 1) ? j : 255 - j); }
    __syncthreads();
}

constexpr int NPHASE = 11;
__global__ void __launch_bounds__(NTHR, 2) fwd_kernel(Args args) {
    extern __shared__ __attribute__((aligned(16))) unsigned char lds_raw[];
    Frame F;
    F.lds = (LAS unsigned char*)lds_raw;
    F.tid = threadIdx.x; F.lane = F.tid & 63; F.wave = __builtin_amdgcn_readfirstlane(F.tid >> 6);
    F.G = gridDim.x; F.bx = blockIdx.x; F.ws = args.ws;
    unsigned char* ws = args.ws;
    volatile LAS unsigned* MISC = (volatile LAS unsigned*)(F.lds + MISC_OFF);
    if (F.tid < 64) MISC[F.tid] = 0u;
    __syncthreads();
    const int lo = args.ph_lo, hi = args.ph_hi;
    XcdBarrier bar; bar.bar = (unsigned*)(ws + WS_CTL) + CW_BAR; bar.x = 0; bar.st = nullptr;
    if (hi - lo > 1) bar = xcd_barrier_post((unsigned*)(ws + WS_CTL) + CW_BAR, MISC + 8);
#ifndef PH_MASK
#define PH_MASK 0xFFFF
#endif
#define IN(k) ((((PH_MASK) >> (k)) & 1) && lo <= (k) && (k) < hi)
#define SEAM(k) do { if (IN(k) && IN((k) + 1)) xcd_barrier(bar); } while (0)
#ifndef PROBE_PHASE
#define PROBE_PHASE -1
#endif
#define REPEAT(k) for (int rep_ = 0; rep_ < ((PROBE_PHASE) == (k) ? 2 : 1); ++rep_, ((PROBE_PHASE) == (k) && rep_ < 2 ? xcd_barrier(bar) : (void)0))

    if (IN(0)) REPEAT(0) { phase0(F, args); }
    SEAM(0);
    if (IN(1)) REPEAT(1) {
#ifndef PROBE_GEMM
#define PROBE_GEMM 0
#endif
        pg8::StaticOrder S; S.init(NTOK / 256, NZ / 256, F.G, F.bx, PROBE_GEMM == 1 ? 2 : 1);
        const APlain AA{ws + WS_XB, 128u, (unsigned)(D * 2)}; const BPlain BA{(const bf16*)(ws + WS_WINT), D};
        const EpiZ E{(bf16*)(ws + WS_ZA), (bf16*)(ws + WS_ZG)};
        pg8::gemm_phase(F.lds, D, S, AA, BA, E);
        { const int nu = (NTOK / 256) * (NZ / 256), rem = nu % F.G;
          if (rem != 0 && F.bx >= rem) p0_experts(F, args, (F.bx - rem) * NWAVES + F.wave, (F.G - rem) * NWAVES, 0, P0_EXP_ITEMS); }
    }
    SEAM(1);
    if (IN(2)) REPEAT(2) { phase2(F, args); }
    SEAM(2);
    if (IN(3)) REPEAT(3) { phase3(F); }
    if (IN(4)) REPEAT(4) { phase4(F, args); }
    SEAM(4);
    if (IN(5)) REPEAT(5) {
        pg8::StaticOrder S; S.init(NTOK / 256, D / 256, F.G, F.bx);
        { const APlain AA{ws + WS_OA, 128u, 1024u}; const BPlain BA{(const bf16*)(ws + WS_WAT), 512};
          const EpiGate<0> E{(const bf16*)(ws + WS_ZG), nullptr, (bf16*)(ws + WS_T1)};
          pg8::gemm_phase(F.lds, 512, S, AA, BA, E); }
        { const APlain AA{ws + WS_OLAT, 128u, 2048u}; const BPlain BA{(const bf16*)(ws + WS_WBT), 1024};
          const EpiGate<1> E{(const bf16*)(ws + WS_ZG), (const bf16*)(ws + WS_T1), (bf16*)(ws + WS_MERGED)};
          pg8::gemm_phase(F.lds, 1024, S, AA, BA, E); }
    }
    SEAM(5);
    if (IN(6)) REPEAT(6) {
        pg8::StaticOrder S; S.init(NTOK / 256, D / 256, F.G, F.bx, PROBE_GEMM == 6 ? 2 : 1);
        const APlain AA{ws + WS_MERGED, 128u, 2048u}; const BPlain BA{(const bf16*)(ws + WS_WOT), 1024};
        const EpiRes E{args.in[0], (bf16*)(ws + WS_H1)};
        pg8::gemm_phase(F.lds, 1024, S, AA, BA, E);
    }
    SEAM(6);
    if (IN(7)) { phase6(F, args); }
    SEAM(7);
    if (IN(8)) REPEAT(8) {
        moe_setup(F);
        const MoeOrder S{F.G, F.bx, 2, (const LAS int*)(F.lds + MOE_CUM), (const LAS int*)(F.lds + MOE_CUM) + 40};
        const AGather AA{ws + WS_H1B, 128u, (const int*)(ws + WS_LIST)}; const BGu BA{(const bf16*)(ws + WS_WGU)};
        const EpiAct E{(bf16*)(ws + WS_ACT)};
        pg8::gemm_phase(F.lds, 1024, S, AA, BA, E);
    }
    SEAM(8);
    if (IN(9)) REPEAT(9) {
        moe_setup(F);
        const MoeOrder S{F.G, F.bx, 4, (const LAS int*)(F.lds + MOE_CUM), (const LAS int*)(F.lds + MOE_CUM) + 40};
        const APlain AA{ws + WS_ACT, 128u, 512u}; const BDn BA{(const bf16*)(ws + WS_WDT)};
        const EpiDown E{(bf16*)(ws + WS_YBUF), (const int*)(ws + WS_LIST)};
        pg8::gemm_phase(F.lds, 256, S, AA, BA, E);
    }
    SEAM(9);
    if (IN(10)) REPEAT(10) { phase9(F, args); }
#undef IN
#undef SEAM
#undef REPEAT
}

extern "C" void kernel_launch(void* const* d_in, const int* in_sizes, int n_in, void* d_out, int out_size, void* d_ws, size_t ws_size, hipStream_t stream) {
    static int grid = 0;
    if (grid == 0) {
        if (n_in != 26 || in_sizes[0] != NTOK * D || out_size != NTOK * D || ws_size < WS_END) {
            fprintf(stderr, "kernel_launch: unexpected problem: n_in %d in0 %d out %d ws %zu (need %zu)\n", n_in, n_in > 0 ? in_sizes[0] : -1, out_size, ws_size, (size_t)WS_END); grid = -1; return; }
        int dev = 0, cus = 0, per_cu = 0;
        if (hipGetDevice(&dev) != hipSuccess || hipDeviceGetAttribute(&cus, hipDeviceAttributeMultiprocessorCount, dev) != hipSuccess) { grid = -1; return; }
        if (hipFuncSetAttribute((const void*)fwd_kernel, hipFuncAttributeMaxDynamicSharedMemorySize, LDS_BYTES) != hipSuccess) { fprintf(stderr, "kernel_launch: hipFuncSetAttribute failed\n"); grid = -1; return; }
        if (hipOccupancyMaxActiveBlocksPerMultiprocessor(&per_cu, (const void*)fwd_kernel, NTHR, LDS_BYTES) != hipSuccess || per_cu < 1)
            fprintf(stderr, "kernel_launch: occupancy query reports %d\n", per_cu);
        (void)hipGetLastError();
        grid = cus;
    }
    if (grid < 0) return;
    if (hipMemsetAsync((char*)d_ws + WS_CTL, 0, CTL_ZERO_BYTES, stream) != hipSuccess) return;
    Args a{};
    for (int i = 0; i < 26; ++i) a.in[i] = (const float*)d_in[i];
    a.out = (float*)d_out; a.ws = (unsigned char*)d_ws;
#if MK_PER_PHASE
    for (int p = 0; p < NPHASE; ++p) { a.ph_lo = p; a.ph_hi = p + 1; hipLaunchKernelGGL(fwd_kernel, dim3(grid), dim3(NTHR), LDS_BYTES, stream, a); }
#else
    a.ph_lo = 0; a.ph_hi = NPHASE;
    hipLaunchKernelGGL(fwd_kernel, dim3(grid), dim3(NTHR), LDS_BYTES, stream, a);
#endif
}
```

```cpp
#include <hip/hip_runtime.h>
#include <cstdio>
#include <cstdint>

#ifndef MK_PER_PHASE
#define MK_PER_PHASE 0
#endif

#define GAS __attribute__((address_space(1)))
#define LAS __attribute__((address_space(3)))
typedef unsigned short bf16;
typedef short bf16x8 __attribute__((ext_vector_type(8)));
typedef short s16x4 __attribute__((ext_vector_type(4)));
typedef float f32x4 __attribute__((ext_vector_type(4)));
typedef float f32x16 __attribute__((ext_vector_type(16)));
typedef float f32x2 __attribute__((ext_vector_type(2)));
typedef unsigned u32x4 __attribute__((ext_vector_type(4)));
typedef unsigned u32x2 __attribute__((ext_vector_type(2)));

constexpr int D = 1024, BATCH = 8, SEQ = 4096, NTOK = BATCH * SEQ;
constexpr int D_IN = 4316;
constexpr int NCMP = 255;
constexpr float ALPHA = 1.189207115002721f;
constexpr float LOG2E = 1.4426950408889634f;
constexpr float NEGBIG = -1e30f;
constexpr int ZA_LD = 2816;
constexpr int ZC_QA = 0, ZC_KC = 512, ZC_VC = 640, ZC_KS = 768, ZC_VS = 896, ZC_KW = 1024, ZC_VW = 1152, ZC_QLAT = 1280, ZC_CKV = 2304,
              ZC_QIDX = 2432, ZC_KIDX = 2688, ZC_GNSA = 2752, ZC_WIDX = 2776;
constexpr int ZG_LD = 2048;
constexpr int NZ = ZA_LD + ZG_LD;
constexpr int NEXP = 32, DEXP = 256;
constexpr int MAXTILES = (2 * NTOK) / 256 + NEXP;

constexpr size_t MiB = 1u << 20;
constexpr size_t WS_CTL = 0, CTL_ZERO_BYTES = 1 * MiB;
constexpr size_t WS_WAT = 1 * MiB;
constexpr size_t WS_WBT = 2 * MiB;
constexpr size_t WS_WOT = 4 * MiB;
constexpr size_t WS_W1K = 6 * MiB;
constexpr size_t WS_W1V = 7 * MiB;
constexpr size_t WS_W2K = 8 * MiB;
constexpr size_t WS_W2V = 8 * MiB + 64 * 1024;
constexpr size_t WS_BIASK = 8 * MiB + 128 * 1024;
constexpr size_t WS_TBA = 8 * MiB + 256 * 1024;
constexpr size_t WS_TBB = 8 * MiB + 320 * 1024;
constexpr size_t WS_KCMP = 9 * MiB;
constexpr size_t WS_VCMP = 9 * MiB + 512 * 1024;
constexpr size_t WS_TOKINFO = 10 * MiB;
constexpr size_t WS_LIST = 11 * MiB;
constexpr size_t WS_WINT = 16 * MiB;
constexpr size_t WS_WGU = 32 * MiB;
constexpr size_t WS_WDT = 64 * MiB;
constexpr size_t WS_CKVN = 80 * MiB;
constexpr size_t WS_XB = 96 * MiB;
constexpr size_t WS_OLAT = 96 * MiB;
constexpr size_t WS_H1B = 96 * MiB;
constexpr size_t WS_ZA = 160 * MiB;
constexpr size_t WS_T1 = 160 * MiB;
constexpr size_t WS_ACT = 160 * MiB;
constexpr size_t WS_YBUF = 196 * MiB;
constexpr size_t WS_MERGED = 224 * MiB;
constexpr size_t WS_ZG = 336 * MiB;
constexpr size_t WS_H1 = 336 * MiB;
constexpr size_t WS_OA = 464 * MiB;
constexpr size_t WS_END = 496 * MiB;

constexpr int CW_BAR = 4096;
constexpr int CW_CNT = 16384;

constexpr int LDS_BYTES = 163840;
constexpr int MISC_OFF = 160 * 1024 - 256;

__device__ __forceinline__ unsigned f2bf(float f) { unsigned u = __builtin_bit_cast(unsigned, f); return (u + 0x7fffu + ((u >> 16) & 1u)) >> 16; }
__device__ __forceinline__ unsigned pk2(float lo, float hi) { unsigned r; asm volatile("v_cvt_pk_bf16_f32 %0, %1, %2" : "=v"(r) : "v"(lo), "v"(hi)); return r; }
__device__ __forceinline__ float bf2f(unsigned short b) { return __builtin_bit_cast(float, ((unsigned)b) << 16); }
__device__ __forceinline__ float bflo(unsigned w) { return __builtin_bit_cast(float, w << 16); }
__device__ __forceinline__ float bfhi(unsigned w) { return __builtin_bit_cast(float, w & 0xffff0000u); }
__device__ __forceinline__ float wave_sum(float v) {
#pragma unroll
    for (int o = 1; o < 64; o <<= 1) v += __shfl_xor(v, o);
    return v;
}
__device__ __forceinline__ float sigmoidf_(float x) { return __builtin_amdgcn_rcpf(1.0f + __builtin_amdgcn_exp2f(-1.4426950408889634f * x)); }
#define LDS_WAIT() asm volatile("s_waitcnt lgkmcnt(0)" ::: "memory")
#define VM_WAIT() asm volatile("s_waitcnt vmcnt(0)" ::: "memory")

#define XB_TMO      128
#define XB_XCNT(j)  (256  + 64 * (j))
#define XB_XSUB(j)  (1280 + 64 * (j))
#define XB_XGEN(j)  (2304 + 64 * (j))
#define XB_TOP      3328
#define XB_TOPGEN   3392
#define XCD_BAR_WORDS 3456
#define XB_SPIN_CAP (1u << 18)
__device__ __forceinline__ unsigned xb_ld(unsigned* p)              { return __hip_atomic_load(p, __ATOMIC_RELAXED, __HIP_MEMORY_SCOPE_AGENT); }
__device__ __forceinline__ unsigned xb_add(unsigned* p, unsigned v) { return __hip_atomic_fetch_add(p, v, __ATOMIC_RELAXED, __HIP_MEMORY_SCOPE_AGENT); }
__device__ __forceinline__ unsigned xb_xcc_id() { return (unsigned)__builtin_amdgcn_s_getreg((3 << 11) | 20) & 0xFu; }
#define XB_SPIN(cond, bar) do { unsigned _sp = 0; while (cond) { __builtin_amdgcn_s_sleep(1); \
    if ((++_sp & 255u) == 0u) { if (xb_ld(&(bar)[XB_TMO])) break; if (_sp > XB_SPIN_CAP) { atomicAdd(&(bar)[XB_TMO], 1u); break; } } } } while (0)
struct XcdBarrier { unsigned* bar; unsigned x; volatile LAS unsigned* st; };
__device__ __forceinline__ XcdBarrier xcd_barrier_post(unsigned* bar, volatile LAS unsigned* st) {
    XcdBarrier b; b.bar = bar; b.x = xb_xcc_id(); b.st = st;
    if (threadIdx.x == 0) (void)xb_add(&bar[XB_XCNT(b.x)], 1u);
    return b;
}
__device__ __forceinline__ void xcd_barrier_complete(unsigned* bar, unsigned x, unsigned& nloc, unsigned& nx) {
    const unsigned G = gridDim.x * gridDim.y * gridDim.z;
    unsigned sum, cnt, mine, sp = 0u;
    for (;;) {
        sum = 0u; cnt = 0u; mine = 0u;
#pragma unroll
        for (unsigned j = 0; j < 16; ++j) { const unsigned c = xb_ld(&bar[XB_XCNT(j)]); sum += c; cnt += (c > 0u) ? 1u : 0u; mine = (j == x) ? c : mine; }
        if (sum == G) break;
        __builtin_amdgcn_s_sleep(1);
        if ((++sp & 255u) == 0u) { if (xb_ld(&bar[XB_TMO])) break; if (sp > XB_SPIN_CAP) { atomicAdd(&bar[XB_TMO], 1u); break; } }
    }
    nloc = mine > 0u ? mine : 1u; nx = cnt > 0u ? cnt : 1u;
}
__device__ __forceinline__ void xcd_barrier(const XcdBarrier& b) {
    asm volatile("s_waitcnt vmcnt(0)" ::: "memory");
    __syncthreads();
    if (threadIdx.x == 0) {
        unsigned* bar = b.bar;
        __builtin_amdgcn_s_waitcnt(0);
        unsigned nloc = b.st[0], nx = b.st[1];
        if (nloc == 0u) { xcd_barrier_complete(bar, b.x, nloc, nx); b.st[0] = nloc; b.st[1] = nx; }
        const unsigned old = xb_add(&bar[XB_XSUB(b.x)], 1u);
        const unsigned gen = old / nloc;
        if (old + 1u == (gen + 1u) * nloc) {
            __builtin_amdgcn_fence(__ATOMIC_RELEASE, "agent");
            asm volatile("s_waitcnt vmcnt(0)" ::: "memory");
            const unsigned og = xb_add(&bar[XB_TOP], 1u);
            const unsigned tg = og / nx;
            if (og + 1u == (tg + 1u) * nx) xb_add(&bar[XB_TOPGEN], 1u);
            else XB_SPIN(xb_ld(&bar[XB_TOPGEN]) == tg, bar);
            __builtin_amdgcn_fence(__ATOMIC_ACQUIRE, "agent");
            xb_add(&bar[XB_XGEN(b.x)], 1u);
            asm volatile("s_waitcnt vmcnt(0)" ::: "memory");
        } else {
            XB_SPIN(xb_ld(&bar[XB_XGEN(b.x)]) == gen, bar);
            __builtin_amdgcn_fence(__ATOMIC_ACQUIRE, "agent");
            asm volatile("s_waitcnt vmcnt(0)" ::: "memory");
        }
    }
    __syncthreads();
}

namespace pg8 {
constexpr int BM = 256, BK = 64, HALF = 128, HTB = HALF * BK * 2, STAGE_BYTES = 8 * HTB, NXCD = 8, WGM = 8;
__host__ __device__ __forceinline__ int lds_byte(int r, int c) { const int st = (r >> 4) * 2 + (c >> 5), rr = r & 15, cc = c & 31, ob = rr * 64 + cc * 2; return st * 1024 + (ob ^ (((ob >> 9) & 1) << 5)); }
__host__ __device__ __forceinline__ void stage_rc(int b, int& R, int& C) { const int st = b / 1024, sb = b % 1024, swz = sb ^ (((sb >> 9) & 1) << 5); R = (st >> 1) * 16 + swz / 64; C = (st & 1) * 32 + (swz % 64) / 2; }
__host__ __device__ __forceinline__ int perm32(int rho) { const int n = rho >> 4, i = rho & 15; return 8 * (i >> 2) + 4 * n + (i & 3); }
struct Unit { int pm, pn, e, nrows; };
struct StaticOrder {
    int nM, nN, nwg, G, c, dup;
    __device__ void init(int nM_, int nN_, int G_, int c_, int dup_ = 1) { nM = nM_; nN = nN_; nwg = nM * nN; G = G_; c = c_; dup = dup_; }
    __device__ bool next(int i, Unit& u) const {
        const long L0 = (long)i * G + c; if (L0 >= (long)nwg * dup) return false;
        const long L = L0 % nwg;
        int wgid = (int)L; { const int q = nwg / NXCD, r = nwg % NXCD, xcd = wgid % NXCD, off = wgid / NXCD; wgid = (xcd < r ? xcd * (q + 1) : r * (q + 1) + (xcd - r) * q) + off; }
        const int nig = WGM * nN, gid = wgid / nig, fm = gid * WGM, gsz = (nM - fm) < WGM ? (nM - fm) : WGM;
        u.pm = fm + ((wgid % nig) % gsz); u.pn = (wgid % nig) / gsz; u.e = 0; u.nrows = 256; return true;
    }
};

template <class Epi, class Sched, class AAddr, class BAddr>
__device__ __forceinline__ void gemm_phase(LAS unsigned char* lds, const int K, const Sched& S, const AAddr& AA, const BAddr& BA, const Epi& E) {
    constexpr bool GA = AAddr::GATHER;
    const int tid = threadIdx.x, wid = __builtin_amdgcn_readfirstlane(tid >> 6), lane = tid & 63, wr = wid >> 2, wc = wid & 3, fr = lane & 15, fq = lane >> 4;
    const int nt = K / BK;
    unsigned voffA[2], voffB[2];
#pragma unroll
    for (int i = 0; i < 2; ++i) { int R, C; stage_rc(tid * 16 + i * 8192, R, C); const int Rb = Epi::PERM ? ((R & ~31) + perm32(R & 31)) : R;
        voffA[i] = GA ? 0u : AA.lane_off(R, C); voffB[i] = (unsigned)(Rb * K + C) * 2u; }
    const size_t kstepA = (size_t)AA.kstep, kstepB = (size_t)(BK * 2);
    const size_t hstepB = (size_t)HALF * K * 2, hstepA = GA ? 0 : AA.hstep();
    const unsigned ldsw = (unsigned)wid * 1024u;
    const int aoff = lds_byte(wr * 64 + fr, fq * 8), boff = lds_byte(wc * 32 + fr, fq * 8);
#define PG8_SA(b, h) (((b) * 2 + (h)) * HTB)
#define PG8_SB(b, h) ((4 + (b) * 2 + (h)) * HTB)
#define PG8_STAGE(bufoff, gbase, voff) do { _Pragma("unroll") for (int _i = 0; _i < 2; ++_i) \
        __builtin_amdgcn_global_load_lds((const unsigned*)((const char*)(gbase) + (voff)[_i]), (LAS unsigned*)(lds + (bufoff) + ldsw + _i * 8192), 16, 0, 0); } while (0)
#define PG8_STA_CUR(bufoff, h, kb) do { if constexpr (GA) { if (h) PG8_STAGE(bufoff, baseA + (kb), cof1); else PG8_STAGE(bufoff, baseA + (kb), cof0); } \
        else PG8_STAGE(bufoff, cA + (h) * hstepA + (kb), voffA); } while (0)
#define PG8_STA_SEL(bufoff, h, kb) do { if constexpr (GA) { if (h) PG8_STAGE(bufoff, baseA + (kb), sof1); else PG8_STAGE(bufoff, baseA + (kb), sof0); } \
        else PG8_STAGE(bufoff, sA + (h) * hstepA + (kb), voffA); } while (0)
#define PG8_LDA(dst, b, h) do { _Pragma("unroll") for (int m = 0; m < 4; ++m) _Pragma("unroll") for (int k = 0; k < 2; ++k) dst[m][k] = *(const LAS bf16x8*)(lds + PG8_SA(b, h) + aoff + m * 2048 + k * 1024); } while (0)
#define PG8_LDB(dst, b, h) do { _Pragma("unroll") for (int n = 0; n < 2; ++n) _Pragma("unroll") for (int k = 0; k < 2; ++k) dst[n][k] = *(const LAS bf16x8*)(lds + PG8_SB(b, h) + boff + n * 2048 + k * 1024); } while (0)
#define PG8_MMA(ai, bj, At, Bt) do { __builtin_amdgcn_s_setprio(1); _Pragma("unroll") for (int m = 0; m < 4; ++m) _Pragma("unroll") for (int n = 0; n < 2; ++n) _Pragma("unroll") for (int k = 0; k < 2; ++k) \
        acc[ai][bj][m][n] = __builtin_amdgcn_mfma_f32_16x16x32_bf16(Bt[n][k], At[m][k], acc[ai][bj][m][n], 0, 0, 0); __builtin_amdgcn_s_setprio(0); } while (0)
#define PG8_WAIT_V(n) asm volatile("s_waitcnt vmcnt(" #n ")" ::: "memory")
#define PG8_WAIT_L(n) asm volatile("s_waitcnt lgkmcnt(" #n ")" ::: "memory")
#define PG8_BAR __builtin_amdgcn_s_barrier()
#define PG8_SCHED __builtin_amdgcn_sched_barrier(0)
#define PG8_GOFF(u, o0, o1) do { _Pragma("unroll") for (int _i = 0; _i < 2; ++_i) { int R_, C_; stage_rc(tid * 16 + _i * 8192, R_, C_); \
        o0[_i] = AA.row_off(u, R_) + (unsigned)C_ * 2u; o1[_i] = AA.row_off(u, R_ + HALF) + (unsigned)C_ * 2u; } } while (0)
    Unit cur, nxt; int ui = 0;
    if (!S.next(0, cur)) return;
    f32x4 acc[2][2][4][2];
#pragma unroll
    for (int a = 0; a < 2; ++a)
#pragma unroll
        for (int b = 0; b < 2; ++b)
#pragma unroll
            for (int m = 0; m < 4; ++m)
#pragma unroll
                for (int n = 0; n < 2; ++n) acc[a][b][m][n] = (f32x4){0.f, 0.f, 0.f, 0.f};
    bf16x8 At[4][2], B0[2][2], B1[2][2];
    const char* const baseA = GA ? (const char*)AA.base : nullptr;
    const char* cA = GA ? nullptr : (const char*)AA.unit_ptr(cur);
    unsigned cof0[2] = {0u, 0u}, cof1[2] = {0u, 0u}, nof0[2] = {0u, 0u}, nof1[2] = {0u, 0u};
    if constexpr (GA) PG8_GOFF(cur, cof0, cof1);
    const char* cB = (const char*)BA.ptr(cur);
    PG8_STAGE(PG8_SB(0, 0), cB, voffB); PG8_STA_CUR(PG8_SA(0, 0), 0, 0); PG8_STAGE(PG8_SB(0, 1), cB + hstepB, voffB); PG8_STA_CUR(PG8_SA(0, 1), 1, 0);
    if (wr == 1) PG8_BAR;
    PG8_WAIT_V(4); PG8_BAR;
    PG8_STAGE(PG8_SB(1, 0), cB + kstepB, voffB); PG8_STA_CUR(PG8_SA(1, 0), 0, kstepA); PG8_STAGE(PG8_SB(1, 1), cB + hstepB + kstepB, voffB);
    PG8_WAIT_V(6); PG8_BAR;
    for (;;) {
        const bool has_next = S.next(ui + 1, nxt);
        const char* nB = cB; const char* nA = cA;
        if (has_next) { nB = (const char*)BA.ptr(nxt); if constexpr (GA) PG8_GOFF(nxt, nof0, nof1); else nA = (const char*)AA.unit_ptr(nxt); }
        else { if constexpr (GA) {
#pragma unroll
            for (int i = 0; i < 2; ++i) { nof0[i] = cof0[i]; nof1[i] = cof1[i]; } } }
#pragma nounroll
        for (int t = 0; t < nt; t += 2) {
            const bool last = (t == nt - 2);
            const size_t k1 = (size_t)(t + 1) * kstepA, k2 = last ? 0 : (size_t)(t + 2) * kstepA, k3 = k2 + kstepA;
            const char* b2 = last ? nB : cB + (size_t)(t + 2) * kstepB; const char* b3 = b2 + kstepB;
            const char* sA = last ? nA : cA;
            unsigned sof0[2], sof1[2];
#pragma unroll
            for (int i = 0; i < 2; ++i) { sof0[i] = last ? nof0[i] : cof0[i]; sof1[i] = last ? nof1[i] : cof1[i]; }
            PG8_LDB(B0, 0, 0); PG8_SCHED; PG8_LDA(At, 0, 0); PG8_STA_CUR(PG8_SA(1, 1), 1, k1);
            PG8_WAIT_L(8); PG8_BAR; PG8_WAIT_L(0); PG8_MMA(0, 0, At, B0); PG8_BAR; PG8_SCHED;
            PG8_LDB(B1, 0, 1); PG8_STAGE(PG8_SB(0, 0), b2, voffB);
            PG8_BAR; PG8_WAIT_L(0); PG8_MMA(0, 1, At, B1); PG8_BAR;
            PG8_LDA(At, 0, 1); PG8_STA_SEL(PG8_SA(0, 0), 0, k2);
            PG8_BAR; PG8_WAIT_L(0); PG8_MMA(1, 0, At, B0); PG8_BAR; PG8_SCHED;
            PG8_STAGE(PG8_SB(0, 1), b2 + hstepB, voffB);
            PG8_WAIT_V(6); PG8_BAR; PG8_MMA(1, 1, At, B1); PG8_BAR;
            PG8_LDB(B0, 1, 0); PG8_SCHED; PG8_LDA(At, 1, 0); PG8_STA_SEL(PG8_SA(0, 1), 1, k2);
            PG8_WAIT_L(8); PG8_BAR; PG8_WAIT_L(0); PG8_MMA(0, 0, At, B0); PG8_BAR; PG8_SCHED;
            PG8_LDB(B1, 1, 1); PG8_STAGE(PG8_SB(1, 0), b3, voffB);
            PG8_BAR; PG8_WAIT_L(0); PG8_MMA(0, 1, At, B1); PG8_BAR;
            PG8_LDA(At, 1, 1); PG8_STA_SEL(PG8_SA(1, 0), 0, k3);
            PG8_BAR; PG8_WAIT_L(0); PG8_MMA(1, 0, At, B0); PG8_BAR; PG8_SCHED;
            PG8_STAGE(PG8_SB(1, 1), b3 + hstepB, voffB);
            PG8_WAIT_V(6); PG8_BAR; PG8_MMA(1, 1, At, B1); PG8_BAR;
        }
        E(acc, cur, wr, wc, fr, fq);
        if (!has_next) break;
#pragma unroll
        for (int a = 0; a < 2; ++a)
#pragma unroll
            for (int b = 0; b < 2; ++b)
#pragma unroll
                for (int m = 0; m < 4; ++m)
#pragma unroll
                    for (int n = 0; n < 2; ++n) acc[a][b][m][n] = (f32x4){0.f, 0.f, 0.f, 0.f};
        cur = nxt; cB = nB; cA = nA; ++ui;
        if constexpr (GA) {
#pragma unroll
            for (int i = 0; i < 2; ++i) { cof0[i] = nof0[i]; cof1[i] = nof1[i]; } }
    }
    PG8_WAIT_V(0);
    if (wr == 0) PG8_BAR;
    PG8_BAR;
#undef PG8_SA
#undef PG8_SB
#undef PG8_STAGE
#undef PG8_STA_CUR
#undef PG8_STA_SEL
#undef PG8_GOFF
#undef PG8_LDA
#undef PG8_LDB
#undef PG8_MMA
#undef PG8_WAIT_V
#undef PG8_WAIT_L
#undef PG8_BAR
#undef PG8_SCHED
}
}

constexpr int NWAVES = 8, NTHR = 512;
struct Args { const float* in[26]; float* out; unsigned char* ws; int ph_lo, ph_hi; unsigned repmask; int pad; };
struct Frame {
    LAS unsigned char* lds;
    int tid, lane, wave, G, bx;
    unsigned char* ws;
};

struct APlain { const void* base; unsigned kstep; unsigned ld2;
    static constexpr bool GATHER = false;
    __device__ __forceinline__ const void* unit_ptr(const pg8::Unit& u) const { return (const char*)base + (size_t)u.pm * 256 * ld2; }
    __device__ __forceinline__ unsigned lane_off(int R, int C) const { return (unsigned)R * ld2 + (unsigned)C * 2u; }
    __device__ __forceinline__ size_t hstep() const { return (size_t)128 * ld2; }
    __device__ __forceinline__ unsigned row_off(const pg8::Unit&, int) const { return 0u; } };
struct BPlain { const bf16* Bt; int K;
    __device__ __forceinline__ const void* ptr(const pg8::Unit& u) const { return Bt + (size_t)u.pn * 256 * K; } };

struct EpiZ {
    static constexpr bool PERM = true;
    bf16* ZA; bf16* ZG;
    __device__ __forceinline__ void operator()(const f32x4 (&acc)[2][2][4][2], const pg8::Unit& u, int wr, int wc, int fr, int fq) const {
        const bool gate = u.pn >= 11;
        bf16* base = gate ? ZG : ZA; const int ld = gate ? ZG_LD : ZA_LD; const int colt = gate ? (u.pn - 11) * 256 : u.pn * 256;
        const int row0 = u.pm * 256 + wr * 64 + fr, col0 = colt + wc * 32 + 8 * fq;
#pragma unroll
        for (int ai = 0; ai < 2; ++ai)
#pragma unroll
            for (int m = 0; m < 4; ++m) { bf16* rowp = base + (size_t)(row0 + ai * 128 + m * 16) * ld + col0;
#pragma unroll
                for (int bj = 0; bj < 2; ++bj) { f32x4 v0 = acc[ai][bj][m][0], v1 = acc[ai][bj][m][1];
                    if (gate) {
#pragma unroll
                        for (int j = 0; j < 4; ++j) { v0[j] = sigmoidf_(v0[j]); v1[j] = sigmoidf_(v1[j]); } }
                    u32x4 w; w.x = pk2(v0[0], v0[1]); w.y = pk2(v0[2], v0[3]); w.z = pk2(v1[0], v1[1]); w.w = pk2(v1[2], v1[3]);
                    *(u32x4*)(rowp + bj * 128) = w; } }
    }
};
template <int MODE> struct EpiGate {
    static constexpr bool PERM = true;
    const bf16* ZG; const bf16* T1; bf16* O;
    __device__ __forceinline__ void operator()(const f32x4 (&acc)[2][2][4][2], const pg8::Unit& u, int wr, int wc, int fr, int fq) const {
        const int row0 = u.pm * 256 + wr * 64 + fr, col0 = u.pn * 256 + wc * 32 + 8 * fq;
#pragma unroll
        for (int ai = 0; ai < 2; ++ai) {
            u32x4 gv[4][2], tv[4][2];
#pragma unroll
            for (int m = 0; m < 4; ++m)
#pragma unroll
                for (int bj = 0; bj < 2; ++bj) { const size_t r = (size_t)(row0 + ai * 128 + m * 16); const int c = col0 + bj * 128;
                    gv[m][bj] = *(const u32x4*)(ZG + r * ZG_LD + MODE * 1024 + c); if (MODE == 1) tv[m][bj] = *(const u32x4*)(T1 + r * 1024 + c); }
#pragma unroll
            for (int m = 0; m < 4; ++m)
#pragma unroll
                for (int bj = 0; bj < 2; ++bj) { asm volatile("" : "+v"(gv[m][bj])); if (MODE == 1) asm volatile("" : "+v"(tv[m][bj])); }
#pragma unroll
            for (int m = 0; m < 4; ++m) { const size_t r = (size_t)(row0 + ai * 128 + m * 16);
#pragma unroll
                for (int bj = 0; bj < 2; ++bj) { const int c = col0 + bj * 128; const u32x4 g = gv[m][bj];
                    const f32x4 v0 = acc[ai][bj][m][0], v1 = acc[ai][bj][m][1];
                    float o[8] = { v0[0] * bflo(g.x), v0[1] * bfhi(g.x), v0[2] * bflo(g.y), v0[3] * bfhi(g.y), v1[0] * bflo(g.z), v1[1] * bfhi(g.z), v1[2] * bflo(g.w), v1[3] * bfhi(g.w) };
                    if (MODE == 1) { const u32x4 t = tv[m][bj];
                        o[0] += bflo(t.x); o[1] += bfhi(t.x); o[2] += bflo(t.y); o[3] += bfhi(t.y); o[4] += bflo(t.z); o[5] += bfhi(t.z); o[6] += bflo(t.w); o[7] += bfhi(t.w); }
                    u32x4 w; w.x = pk2(o[0], o[1]); w.y = pk2(o[2], o[3]); w.z = pk2(o[4], o[5]); w.w = pk2(o[6], o[7]);
                    *(u32x4*)(O + r * 1024 + c) = w; } }
        }
    }
};
struct EpiRes {
    static constexpr bool PERM = true;
    const float* X; bf16* O;
    __device__ __forceinline__ void operator()(const f32x4 (&acc)[2][2][4][2], const pg8::Unit& u, int wr, int wc, int fr, int fq) const {
        const int row0 = u.pm * 256 + wr * 64 + fr, col0 = u.pn * 256 + wc * 32 + 8 * fq;
#pragma unroll
        for (int ai = 0; ai < 2; ++ai) {
            f32x4 xv[4][2][2];
#pragma unroll
            for (int m = 0; m < 4; ++m)
#pragma unroll
                for (int bj = 0; bj < 2; ++bj) { const size_t off = (size_t)(row0 + ai * 128 + m * 16) * D + col0 + bj * 128; xv[m][bj][0] = *(const f32x4*)(X + off); xv[m][bj][1] = *(const f32x4*)(X + off + 4); }
#pragma unroll
            for (int m = 0; m < 4; ++m)
#pragma unroll
                for (int bj = 0; bj < 2; ++bj) { asm volatile("" : "+v"(xv[m][bj][0])); asm volatile("" : "+v"(xv[m][bj][1])); }
#pragma unroll
            for (int m = 0; m < 4; ++m)
#pragma unroll
                for (int bj = 0; bj < 2; ++bj) { const size_t off = (size_t)(row0 + ai * 128 + m * 16) * D + col0 + bj * 128;
                    const f32x4 v0 = xv[m][bj][0] * ALPHA + acc[ai][bj][m][0], v1 = xv[m][bj][1] * ALPHA + acc[ai][bj][m][1];
                    u32x4 w; w.x = pk2(v0[0], v0[1]); w.y = pk2(v0[2], v0[3]); w.z = pk2(v1[0], v1[1]); w.w = pk2(v1[2], v1[3]);
                    *(u32x4*)(O + off) = w; }
        }
    }
};

template <class F>
__device__ __forceinline__ void p0_tile(const F& f, bf16* WT, int ldk, int k0, int n0, LAS float* scr, int lane) {
    if constexpr (F::FOLD) {
        float bc[64];
#pragma unroll
        for (int d = 0; d < 64; ++d) bc[d] = f.bval(k0, d, n0 + (lane & 31));
#pragma unroll 4
        for (int i = 0; i < 32; ++i) { const int kk = 2 * i + (lane >> 5); const f32x4* ar = (const f32x4*)f.arow(k0 + kk, n0); f32x4 a4 = {0.f, 0.f, 0.f, 0.f};
#pragma unroll
            for (int q = 0; q < 16; ++q) { const f32x4 av = ar[q]; a4[0] += av[0] * bc[4 * q]; a4[1] += av[1] * bc[4 * q + 1]; a4[2] += av[2] * bc[4 * q + 2]; a4[3] += av[3] * bc[4 * q + 3]; }
            scr[kk * 33 + (lane & 31)] = (a4[0] + a4[1]) + (a4[2] + a4[3]); }
    } else {
        float v[32];
#pragma unroll
        for (int i = 0; i < 32; ++i) { const int kk = 2 * i + (lane >> 5); v[i] = f(k0 + kk, n0 + (lane & 31)); }
#pragma unroll
        for (int i = 0; i < 32; ++i) { const int kk = 2 * i + (lane >> 5); scr[kk * 33 + (lane & 31)] = v[i]; }
    }
    LDS_WAIT(); asm volatile("" ::: "memory");
    const int c = lane & 7;
#pragma unroll
    for (int j = 0; j < 4; ++j) { const int n = (lane >> 3) + 8 * j; const LAS float* s = scr + (8 * c) * 33 + n;
        u32x4 o; o.x = pk2(s[0 * 33], s[1 * 33]); o.y = pk2(s[2 * 33], s[3 * 33]); o.z = pk2(s[4 * 33], s[5 * 33]); o.w = pk2(s[6 * 33], s[7 * 33]);
        *(u32x4*)(WT + (size_t)(n0 + n) * ldk + k0 + 8 * c) = o; }
    LDS_WAIT(); asm volatile("" ::: "memory");
}
struct P0Item { const float* src; int N, noff; bf16* dst; int ldk, k0, n0; };
__device__ __forceinline__ void p0_item_load(const P0Item& it, float (&v)[32], int lane) {
#pragma unroll
    for (int i = 0; i < 32; ++i) { const int kk = 2 * i + (lane >> 5); v[i] = it.src[(size_t)(it.k0 + kk) * it.N + it.n0 + (lane & 31) + it.noff]; }
}
__device__ __forceinline__ void p0_item_finish(const P0Item& it, const float (&v)[32], LAS float* scr, int lane) {
#pragma unroll
    for (int i = 0; i < 32; ++i) { const int kk = 2 * i + (lane >> 5); scr[kk * 33 + (lane & 31)] = v[i]; }
    LDS_WAIT(); asm volatile("" ::: "memory");
    const int c = lane & 7;
#pragma unroll
    for (int j = 0; j < 4; ++j) { const int n = (lane >> 3) + 8 * j; const LAS float* s = scr + (8 * c) * 33 + n;
        u32x4 o; o.x = pk2(s[0 * 33], s[1 * 33]); o.y = pk2(s[2 * 33], s[3 * 33]); o.z = pk2(s[4 * 33], s[5 * 33]); o.w = pk2(s[6 * 33], s[7 * 33]);
        *(u32x4*)(it.dst + (size_t)(it.n0 + n) * it.ldk + it.k0 + 8 * c) = o; }
    LDS_WAIT(); asm volatile("" ::: "memory");
}
__device__ __forceinline__ int zsrc_col(int n) {
    if (n < 1280) return n;
    if (n < 2304) return -2;
    if (n < 2432) return 1816 + (n - 2304);
    if (n < 2688) return 1944 + (n - 2432);
    if (n < 2752) return 2200 + (n - 2688);
    if (n < 2776) return 1280 + (n - 2752);
    if (n < 2780) return 2264 + (n - 2776);
    if (n < 2816) return -1;
    if (n < 3840) return 2268 + (n - 2816);
    return 3292 + (n - 3840);
}
struct FWin { const float* w_in; static constexpr bool FOLD = false;
    __device__ __forceinline__ float operator()(int k, int n) const { const int s = zsrc_col(n); return s >= 0 ? w_in[(size_t)k * D_IN + s] : 0.f; } };
struct FWinQ { const float* w_in; const float* w_uk; static constexpr bool FOLD = true;
    __device__ __forceinline__ const float* arow(int k, int n0) const { return w_in + (size_t)k * D_IN + 1304 + ((n0 - 1280) >> 7) * 64; }
    __device__ __forceinline__ float bval(int, int d, int n) const { return w_uk[(size_t)((n - 1280) >> 7) * 64 * 128 + d * 128 + ((n - 1280) & 127)]; }
    __device__ __forceinline__ float operator()(int, int) const { return 0.f; } };
struct FWb { const float* w_uv; const float* w_bb; static constexpr bool FOLD = true;
    __device__ __forceinline__ const float* arow(int k, int) const { return w_uv + (size_t)k * 64; }
    __device__ __forceinline__ float bval(int k0, int d, int n) const { return w_bb[(size_t)((k0 >> 7) * 64 + d) * D + n]; }
    __device__ __forceinline__ float operator()(int, int) const { return 0.f; } };
struct FPlain { const float* W; int N; static constexpr bool FOLD = false; __device__ __forceinline__ float operator()(int k, int n) const { return W[(size_t)k * N + n]; } };
struct FOff { const float* W; int N; int noff; static constexpr bool FOLD = false;
    __device__ __forceinline__ float operator()(int k, int n) const { return W[(size_t)k * N + n + noff]; } };

__device__ __forceinline__ float rel_bucket_bias(const float* rel_bias, int dist, int head) {
    int b;
    if (dist < 16) b = dist;
    else { const float t = (__log2f((float)dist) - 4.0f) * 2.66666675f; b = 16 + (int)t; if (b > 31) b = 31; }
    return rel_bias[b * 16 + head];
}

constexpr int P0_EXP_ITEMS = NEXP * ((1024 / 64) * (512 / 32) + (256 / 64) * (1024 / 32)), P0_EXP_SPLIT = (P0_EXP_ITEMS * 2) / 3;
__device__ __forceinline__ void p0_experts(const Frame& F, const Args& a, int wv, int nwv, int ibeg, int iend) {
    LAS float* scr = (LAS float*)(F.lds + F.wave * 16384);
    unsigned char* ws = F.ws;
    constexpr int I_GU = (1024 / 64) * (512 / 32), I_DN = (256 / 64) * (1024 / 32);
    const int gw = wv, NGW = nwv;
    {
        constexpr int NEI = NEXP * (I_GU + I_DN);
        auto mk = [&](int idx) { P0Item it; const int e = idx / (I_GU + I_DN); int r = idx - e * (I_GU + I_DN);
            if (r < I_GU) {
                const int n0 = (r % 16) * 32; const uintptr_t pg = (uintptr_t)a.in[21], pu = (uintptr_t)a.in[22];
                it.src = (const float*)(pg + (uintptr_t)((n0 >> 7) & 1) * (pu - pg)) + (size_t)e * D * DEXP; it.N = DEXP; it.noff = ((n0 >> 8) * 128 + (n0 & 127)) - n0;
                it.dst = (bf16*)(ws + WS_WGU) + (size_t)e * 512 * 1024; it.ldk = 1024; it.k0 = (r / 16) * 64; it.n0 = n0; }
            else { r -= I_GU; it.src = a.in[23] + (size_t)e * DEXP * D; it.N = D; it.noff = 0; it.dst = (bf16*)(ws + WS_WDT) + (size_t)e * 1024 * 256; it.ldk = 256; it.k0 = (r / 32) * 64; it.n0 = (r % 32) * 32; }
            return it; };
        float va[32], vb[32];
        {
        (void)NEI;
        int idx = ibeg + gw;
        if (idx < iend) { P0Item cur = mk(idx); p0_item_load(cur, va, F.lane);
            for (;;) {
                const int nidx = idx + NGW; const bool more = nidx < iend; P0Item nxt = cur;
                if (more) { nxt = mk(nidx); p0_item_load(nxt, vb, F.lane); }
                p0_item_finish(cur, va, scr, F.lane);
                if (!more) break;
#pragma unroll
                for (int i = 0; i < 32; ++i) va[i] = vb[i];
                cur = nxt; idx = nidx; } }
        }
    }
}
__device__ __forceinline__ void phase0(const Frame& F, const Args& a) {
    LAS float* scr = (LAS float*)(F.lds + F.wave * 16384);
    const int gw = F.bx * NWAVES + F.wave, NGW = F.G * NWAVES;
    unsigned char* ws = F.ws;
    constexpr int I_WIN = (D / 64) * (NZ / 32);
    constexpr int I_WB = (1024 / 64) * (1024 / 32);
    constexpr int I_WA = (512 / 64) * (1024 / 32);
    constexpr int I_WO = I_WB;
    constexpr int I_W1 = (2048 / 64) * (256 / 32);
    constexpr int I_W2 = (256 / 64) * (64 / 32);
    constexpr int I_GU = (1024 / 64) * (512 / 32);
    constexpr int I_DN = (256 / 64) * (1024 / 32);
    constexpr int NITEMS = I_WIN + I_WB + I_WA + I_WO + 2 * I_W1 + 2 * I_W2;
    (void)NITEMS;
    constexpr int I_WINP = (D / 64) * ((NZ - 1024) / 32);
    for (int it = gw; it < 1024; it += NGW) {
        if (it < 512) { const int k0 = (it >> 5) * 64, n0 = 1280 + (it & 31) * 32; const FWinQ f{a.in[1], a.in[9]}; p0_tile(f, (bf16*)(ws + WS_WINT), D, k0, n0, scr, F.lane); }
        else { const int r = it - 512; const FWb f{a.in[10], a.in[13]}; p0_tile(f, (bf16*)(ws + WS_WBT), 1024, (r / 32) * 64, (r % 32) * 32, scr, F.lane); }
    }
    { constexpr int NPL = I_WINP + I_WA + I_WO + 2 * I_W1 + 2 * I_W2;
      const int pw0 = NGW > 1024 ? (gw >= 1024 ? gw - 1024 : -1) : gw, pws = NGW > 1024 ? NGW - 1024 : NGW;
      if (pw0 >= 0) for (int it = pw0; it < NPL; it += pws) {
        int r = it;
        if (r < I_WINP) { const int k0 = (r / 120) * 64; int nb = r % 120; nb = nb < 40 ? nb : nb + 32; const FWin f{a.in[1]}; p0_tile(f, (bf16*)(ws + WS_WINT), D, k0, nb * 32, scr, F.lane); continue; } r -= I_WINP;
        if (r < I_WA) { const FPlain f{a.in[12], D}; p0_tile(f, (bf16*)(ws + WS_WAT), 512, (r / 32) * 64, (r % 32) * 32, scr, F.lane); continue; } r -= I_WA;
        if (r < I_WO) { const FPlain f{a.in[14], D}; p0_tile(f, (bf16*)(ws + WS_WOT), 1024, (r / 32) * 64, (r % 32) * 32, scr, F.lane); continue; } r -= I_WO;
        if (r < I_W1) { const FPlain f{a.in[4], 256}; p0_tile(f, (bf16*)(ws + WS_W1K), 2048, (r / 8) * 64, (r % 8) * 32, scr, F.lane); continue; } r -= I_W1;
        if (r < I_W1) { const FPlain f{a.in[6], 256}; p0_tile(f, (bf16*)(ws + WS_W1V), 2048, (r / 8) * 64, (r % 8) * 32, scr, F.lane); continue; } r -= I_W1;
        if (r < I_W2) { const FPlain f{a.in[5], 64}; p0_tile(f, (bf16*)(ws + WS_W2K), 256, (r / 2) * 64, (r % 2) * 32, scr, F.lane); continue; } r -= I_W2;
        { const FPlain f{a.in[7], 64}; p0_tile(f, (bf16*)(ws + WS_W2V), 256, (r / 2) * 64, (r % 2) * 32, scr, F.lane); }
      } }
    { const int nu = (NTOK / 256) * (NZ / 256); if ((nu % F.G) == 0) p0_experts(F, a, gw, NGW, 0, P0_EXP_ITEMS); }
    { const f32x4* x4 = (const f32x4*)a.in[0]; u32x2* o = (u32x2*)(ws + WS_XB);
      const size_t total = (size_t)NTOK * D / 4, stride = (size_t)F.G * NTHR;
      for (size_t i0 = (size_t)F.bx * NTHR + F.tid; i0 < total; i0 += 8 * stride) { f32x4 v[8];
#pragma unroll
          for (int j = 0; j < 8; ++j) { const size_t i = i0 + j * stride; v[j] = i < total ? x4[i] : (f32x4){0.f, 0.f, 0.f, 0.f}; }
#pragma unroll
          for (int j = 0; j < 8; ++j) { const size_t i = i0 + j * stride; if (i < total) { u32x2 w; w.x = pk2(v[j][0], v[j][1]); w.y = pk2(v[j][2], v[j][3]); o[i] = w; } } } }
    if (F.bx < 64 && F.tid < 256) {
        const int kv = F.bx >> 5, j = F.bx & 31;
        const float* pe = (kv ? a.in[3] : a.in[2]) + 64 * j; const float* w1 = (kv ? a.in[6] : a.in[4]) + (size_t)(64 * j) * 256 + F.tid; float acc = 0.f;
#pragma unroll 16
        for (int k = 0; k < 64; ++k) acc += pe[k] * w1[(size_t)k * 256];
        ((float*)(ws + WS_BIASK))[(kv * 32 + j) * 256 + F.tid] = acc;
    }
    if (F.bx >= 64 && F.bx < 96) { const int idx = (F.bx - 64) * NTHR + F.tid;
        const int tab = idx >> 13, head = (idx >> 10) & 7, dist = idx & 1023;
        ((float*)(ws + (tab ? WS_TBB : WS_TBA)))[head * 1024 + dist] = rel_bucket_bias(a.in[11], dist, tab * 8 + head) * LOG2E; }
}

constexpr int NRT = 36;
constexpr int P6_WR = 0;
constexpr int P6_CNT = 147456;
constexpr int P6_ENT = 147456 + 512;
__device__ __forceinline__ float row16_sum(float v) {
    v += __builtin_bit_cast(float, __builtin_amdgcn_update_dpp(0, __builtin_bit_cast(int, v), 0xB1, 0xf, 0xf, true));
    v += __builtin_bit_cast(float, __builtin_amdgcn_update_dpp(0, __builtin_bit_cast(int, v), 0x4E, 0xf, 0xf, true));
    v += __builtin_bit_cast(float, __builtin_amdgcn_update_dpp(0, __builtin_bit_cast(int, v), 0x141, 0xf, 0xf, true));
    v += __builtin_bit_cast(float, __builtin_amdgcn_update_dpp(0, __builtin_bit_cast(int, v), 0x140, 0xf, 0xf, true));
    return v;
}
__device__ __forceinline__ float wave_sum_dpp(float v) { v = row16_sum(v); v += __shfl_xor(v, 16); v += __shfl_xor(v, 32); return v; }
__device__ __forceinline__ void phase6(const Frame& F, const Args& a) {
    unsigned char* ws = F.ws;
    LAS float* WR = (LAS float*)(F.lds + P6_WR);
    LAS int* cntL = (LAS int*)(F.lds + P6_CNT); LAS int* baseL = cntL + 32;
    LAS int* ent = (LAS int*)(F.lds + P6_ENT);
    const float* w_grp = a.in[17]; const float* b_grp = a.in[18]; const float* w_rtr = a.in[19]; const float* b_rtr = a.in[20];
    {
        f32x4 wv[16], gv2[2];
#pragma unroll
        for (int i = 0; i < 16; ++i) wv[i] = *(const f32x4*)(w_rtr + 4 * (F.tid + NTHR * i));
#pragma unroll
        for (int i = 0; i < 2; ++i) gv2[i] = *(const f32x4*)(w_grp + 4 * (F.tid + NTHR * i));
#pragma unroll
        for (int i = 0; i < 16; ++i) { const int e = 4 * (F.tid + NTHR * i), k = e >> 5, o = e & 31;
#pragma unroll
            for (int c = 0; c < 4; ++c) WR[(4 + o + c) * 1024 + k] = wv[i][c]; }
#pragma unroll
        for (int i = 0; i < 2; ++i) { const int k = F.tid + NTHR * i;
#pragma unroll
            for (int c = 0; c < 4; ++c) WR[c * 1024 + k] = gv2[i][c]; }
    }
    if (F.tid < 65) cntL[F.tid] = 0;
    __syncthreads();
    const bf16* HP = (const bf16*)(ws + WS_H1); bf16* H1B = (bf16*)(ws + WS_H1B);
    const float* lg = a.in[15]; const float* lb = a.in[16];
    f32x2 gam[8], bet[8];
#pragma unroll
    for (int j = 0; j < 2; ++j)
#pragma unroll
        for (int q = 0; q < 4; ++q) { gam[4 * j + q] = *(const f32x2*)(lg + 512 * j + 8 * F.lane + 2 * q); bet[4 * j + q] = *(const f32x2*)(lb + 512 * j + 8 * F.lane + 2 * q); }
    unsigned* gcnt = (unsigned*)(ws + WS_CTL) + CW_CNT;
    int* list = (int*)(ws + WS_LIST); float* tokinfo = (float*)(ws + WS_TOKINFO);
    const int gw = F.bx * NWAVES + F.wave, NGW = F.G * NWAVES;
    u32x4 nx0, nx1;
    const int rpb = (NTOK + F.G - 1) / F.G, rbeg = F.bx * rpb, rend = (rbeg + rpb < NTOK) ? rbeg + rpb : NTOK;
    (void)gw; (void)NGW;
    if (rbeg + F.wave < rend) { const u32x4* hr = (const u32x4*)(HP + (size_t)(rbeg + F.wave) * D) + F.lane; nx0 = hr[0]; nx1 = hr[64]; }
    for (int row = rbeg + F.wave; row < rend; row += NWAVES) {
        const u32x4 r0 = nx0, r1 = nx1;
        if (row + NWAVES < rend) { const u32x4* hr = (const u32x4*)(HP + (size_t)(row + NWAVES) * D) + F.lane; nx0 = hr[0]; nx1 = hr[64]; }
        f32x2 v[8];
        v[0] = (f32x2){bflo(r0.x), bfhi(r0.x)}; v[1] = (f32x2){bflo(r0.y), bfhi(r0.y)}; v[2] = (f32x2){bflo(r0.z), bfhi(r0.z)}; v[3] = (f32x2){bflo(r0.w), bfhi(r0.w)};
        v[4] = (f32x2){bflo(r1.x), bfhi(r1.x)}; v[5] = (f32x2){bflo(r1.y), bfhi(r1.y)}; v[6] = (f32x2){bflo(r1.z), bfhi(r1.z)}; v[7] = (f32x2){bflo(r1.w), bfhi(r1.w)};
        f32x2 s2 = v[0];
#pragma unroll
        for (int q = 1; q < 8; ++q) s2 += v[q];
        const float mean = wave_sum_dpp(s2[0] + s2[1]) * (1.f / D);
        f32x2 q2 = {0.f, 0.f};
#pragma unroll
        for (int q = 0; q < 8; ++q) { v[q] = v[q] - mean; q2 += v[q] * v[q]; }
        const float rstd = 1.0f / sqrtf(wave_sum_dpp(q2[0] + q2[1]) * (1.f / D) + 1e-5f);
#pragma unroll
        for (int q = 0; q < 8; ++q) v[q] = v[q] * rstd * gam[q] + bet[q];
        { u32x4 w0, w1; w0.x = pk2(v[0][0], v[0][1]); w0.y = pk2(v[1][0], v[1][1]); w0.z = pk2(v[2][0], v[2][1]); w0.w = pk2(v[3][0], v[3][1]);
          w1.x = pk2(v[4][0], v[4][1]); w1.y = pk2(v[5][0], v[5][1]); w1.z = pk2(v[6][0], v[6][1]); w1.w = pk2(v[7][0], v[7][1]);
          u32x4* ob = (u32x4*)(H1B + (size_t)row * D) + F.lane; ob[0] = w0; ob[64] = w1; }
        auto rdot = [&](int o) { f32x2 p2 = {0.f, 0.f};
#pragma unroll
            for (int j = 0; j < 2; ++j) { const f32x4 wa = *(const LAS f32x4*)(WR + o * 1024 + 512 * j + 8 * F.lane), wb = *(const LAS f32x4*)(WR + o * 1024 + 512 * j + 8 * F.lane + 4);
                p2 += v[4 * j] * (f32x2){wa[0], wa[1]}; p2 += v[4 * j + 1] * (f32x2){wa[2], wa[3]}; p2 += v[4 * j + 2] * (f32x2){wb[0], wb[1]}; p2 += v[4 * j + 3] * (f32x2){wb[2], wb[3]}; }
            return row16_sum(p2[0] + p2[1]); };
        float g[4];
#pragma unroll
        for (int i = 0; i < 4; ++i) g[i] = rdot(i);
#pragma unroll
        for (int i = 0; i < 4; ++i) { float t = g[i]; t += __shfl_xor(t, 16); t += __shfl_xor(t, 32); g[i] = t + b_grp[i]; }
        int gs = 0; float gm = g[0];
#pragma unroll
        for (int i = 1; i < 4; ++i) if (g[i] > gm) { gm = g[i]; gs = i; }
        gs = __builtin_amdgcn_readfirstlane(gs);
        float gsum = 0.f;
#pragma unroll
        for (int i = 0; i < 4; ++i) gsum += __expf(g[i] - gm);
        const float pgrp = 1.0f / gsum;
        float el[8];
#pragma unroll
        for (int i = 0; i < 8; ++i) el[i] = rdot(4 + gs * 8 + i);
#pragma unroll
        for (int i = 0; i < 8; ++i) { float t = el[i]; t += __shfl_xor(t, 16); t += __shfl_xor(t, 32); el[i] = t + b_rtr[gs * 8 + i]; }
        int i1 = 0; float l1 = el[0];
#pragma unroll
        for (int i = 1; i < 8; ++i) if (el[i] > l1) { l1 = el[i]; i1 = i; }
        int i2 = -1; float l2 = -3.0e38f;
#pragma unroll
        for (int i = 0; i < 8; ++i) if (i != i1 && el[i] > l2) { l2 = el[i]; i2 = i; }
        const float e2 = __expf(l2 - l1), inv = 1.0f / (1.0f + e2);
        const float w0 = pgrp * inv, w1 = pgrp * e2 * inv;
        const int e0 = gs * 8 + i1, e1 = gs * 8 + i2;
        if (F.lane == 0) {
            const int p0 = atomicAdd((int*)&cntL[e0], 1), p1 = atomicAdd((int*)&cntL[e1], 1);
            const int n0 = atomicAdd((int*)&cntL[64], 2);
            ent[2 * n0] = (e0 << 16) | p0; ent[2 * n0 + 1] = row * 2;
            ent[2 * n0 + 2] = (e1 << 16) | p1; ent[2 * n0 + 3] = row * 2 + 1;
            tokinfo[row * 2] = w0; tokinfo[row * 2 + 1] = w1;
        }
    }
    __syncthreads();
    if (F.tid < 32) { const int c = cntL[F.tid]; baseL[F.tid] = c > 0 ? (int)__hip_atomic_fetch_add(gcnt + 64 * F.tid, (unsigned)c, __ATOMIC_RELAXED, __HIP_MEMORY_SCOPE_AGENT) : 0; }
    __syncthreads();
    const int nent = cntL[64];
    for (int i = F.tid; i < nent; i += NTHR) { const int ep = ent[2 * i], tk = ent[2 * i + 1]; const int e = ep >> 16, p = ep & 0xffff; list[(size_t)e * NTOK + baseL[e] + p] = tk; }
    __syncthreads();
}

constexpr int MOE_CUM = 131072;
struct MoeOrder {
    int G, c, NP; const LAS int* cum; const LAS int* cnt;
    __device__ bool next(int i, pg8::Unit& u) const {
        const int L = i * G + c, t = L / NP; if (t >= cum[32]) return false;
        const int e = cum[80 + t];
        const int j = t - cum[e]; u.pm = t; u.pn = L % NP; u.e = e | (j << 8); const int rem = cnt[e] - j * 256; u.nrows = rem < 256 ? rem : 256; return true;
    }
};
__device__ __forceinline__ void moe_setup(const Frame& F) {
    LAS int* cum = (LAS int*)(F.lds + MOE_CUM); LAS int* cnt = cum + 40;
    const unsigned* gcnt = (const unsigned*)(F.ws + WS_CTL) + CW_CNT;
    if (F.tid < 32) cnt[F.tid] = (int)__hip_atomic_load(gcnt + 64 * F.tid, __ATOMIC_RELAXED, __HIP_MEMORY_SCOPE_AGENT);
    __syncthreads();
    if (F.tid == 0) { int s = 0; for (int e = 0; e < 32; ++e) { cum[e] = s; s += (cnt[e] + 255) >> 8; } cum[32] = s; }
    __syncthreads();
    for (int t = F.tid; t < cum[32]; t += NTHR) { int e = 0; for (int k = 1; k < 32; ++k) if (t >= cum[k]) e = k; cum[80 + t] = e; }
    __syncthreads();
}
struct AGather { const void* base; unsigned kstep; const int* list;
    static constexpr bool GATHER = true;
    __device__ __forceinline__ const void* unit_ptr(const pg8::Unit&) const { return base; }
    __device__ __forceinline__ unsigned lane_off(int, int) const { return 0u; }
    __device__ __forceinline__ size_t hstep() const { return 0; }
    __device__ __forceinline__ unsigned row_off(const pg8::Unit& u, int r) const { const int e = u.e & 255, j = u.e >> 8; const int rr = r < u.nrows ? r : 0;
        const int tk = list[(size_t)e * NTOK + j * 256 + rr]; return (unsigned)(tk >> 1) * (unsigned)(D * 2); } };
struct BGu { const bf16* W; __device__ __forceinline__ const void* ptr(const pg8::Unit& u) const { return W + (size_t)(u.e & 255) * 512 * 1024 + (size_t)u.pn * 256 * 1024; } };
struct BDn { const bf16* W; __device__ __forceinline__ const void* ptr(const pg8::Unit& u) const { return W + (size_t)(u.e & 255) * 1024 * 256 + (size_t)u.pn * 256 * 256; } };
struct EpiAct {
    static constexpr bool PERM = true; bf16* ACT;
    __device__ __forceinline__ void operator()(const f32x4 (&acc)[2][2][4][2], const pg8::Unit& u, int wr, int wc, int fr, int fq) const {
        const int row0 = u.pm * 256 + wr * 64 + fr, col0 = u.pn * 128 + wc * 32 + 8 * fq;
#pragma unroll
        for (int ai = 0; ai < 2; ++ai)
#pragma unroll
            for (int m = 0; m < 4; ++m) { float o[8];
#pragma unroll
                for (int n = 0; n < 2; ++n)
#pragma unroll
                    for (int j = 0; j < 4; ++j) { const float gt = acc[ai][0][m][n][j], up = acc[ai][1][m][n][j]; o[4 * n + j] = gt * sigmoidf_(gt) * up; }
                u32x4 w; w.x = pk2(o[0], o[1]); w.y = pk2(o[2], o[3]); w.z = pk2(o[4], o[5]); w.w = pk2(o[6], o[7]);
                *(u32x4*)(ACT + (size_t)(row0 + ai * 128 + m * 16) * DEXP + col0) = w; }
    }
};
struct EpiDown {
    static constexpr bool PERM = true; bf16* Y; const int* list;
    __device__ __forceinline__ void operator()(const f32x4 (&acc)[2][2][4][2], const pg8::Unit& u, int wr, int wc, int fr, int fq) const {
        const int e = u.e & 255, j = u.e >> 8; const int col0 = u.pn * 256 + wc * 32 + 8 * fq;
        int tks[2][4];
#pragma unroll
        for (int ai = 0; ai < 2; ++ai)
#pragma unroll
            for (int m = 0; m < 4; ++m) { const int r = ai * 128 + wr * 64 + m * 16 + fr; tks[ai][m] = r < u.nrows ? list[(size_t)e * NTOK + j * 256 + r] : -1; }
#pragma unroll
        for (int ai = 0; ai < 2; ++ai)
#pragma unroll
            for (int m = 0; m < 4; ++m) { const int tk = tks[ai][m];
                if (tk >= 0) { bf16* rowp = Y + (size_t)tk * D + col0;
#pragma unroll
                    for (int bj = 0; bj < 2; ++bj) { const f32x4 v0 = acc[ai][bj][m][0], v1 = acc[ai][bj][m][1];
                        u32x4 w; w.x = pk2(v0[0], v0[1]); w.y = pk2(v0[2], v0[3]); w.z = pk2(v1[0], v1[1]); w.w = pk2(v1[2], v1[3]);
                        *(u32x4*)(rowp + bj * 128) = w; } } }
    }
};

__device__ __forceinline__ void phase9(const Frame& F, const Args& a) {
    unsigned char* ws = F.ws;
    const bf16* H1B = (const bf16*)(ws + WS_H1B); const bf16* Y = (const bf16*)(ws + WS_YBUF); const float* tokinfo = (const float*)(ws + WS_TOKINFO);
    const float* lg = a.in[24]; const float* lb = a.in[25];
    f32x4 gam[4], bet[4];
#pragma unroll
    for (int j = 0; j < 2; ++j) { gam[2 * j] = *(const f32x4*)(lg + 512 * j + 8 * F.lane); gam[2 * j + 1] = *(const f32x4*)(lg + 512 * j + 8 * F.lane + 4); bet[2 * j] = *(const f32x4*)(lb + 512 * j + 8 * F.lane); bet[2 * j + 1] = *(const f32x4*)(lb + 512 * j + 8 * F.lane + 4); }
    const int gw = F.bx * NWAVES + F.wave, NGW = F.G * NWAVES;
    u32x4 nh[2], ny0[2], ny1[2]; float nw0 = 0.f, nw1 = 0.f;
#define P9_LOAD(row_) do { const u32x4* hp_ = (const u32x4*)(H1B + (size_t)(row_) * D) + F.lane; const u32x4* y0_ = (const u32x4*)(Y + (size_t)((row_) * 2) * D) + F.lane; const u32x4* y1_ = (const u32x4*)(Y + (size_t)((row_) * 2 + 1) * D) + F.lane; \
        nh[0] = hp_[0]; nh[1] = hp_[64]; ny0[0] = y0_[0]; ny0[1] = y0_[64]; ny1[0] = y1_[0]; ny1[1] = y1_[64]; nw0 = tokinfo[(row_) * 2]; nw1 = tokinfo[(row_) * 2 + 1]; } while (0)
    if (gw < NTOK) P9_LOAD(gw);
    for (int row = gw; row < NTOK; row += NGW) {
        u32x4 h[2] = {nh[0], nh[1]}, p[2] = {ny0[0], ny0[1]}, q[2] = {ny1[0], ny1[1]}; const float w0 = nw0, w1 = nw1;
        if (row + NGW < NTOK) P9_LOAD(row + NGW);
        f32x4 v[4]; float s = 0.f;
#pragma unroll
        for (int j = 0; j < 2; ++j) {
            v[2 * j][0] = ALPHA * bflo(h[j].x) + w0 * bflo(p[j].x) + w1 * bflo(q[j].x); v[2 * j][1] = ALPHA * bfhi(h[j].x) + w0 * bfhi(p[j].x) + w1 * bfhi(q[j].x);
            v[2 * j][2] = ALPHA * bflo(h[j].y) + w0 * bflo(p[j].y) + w1 * bflo(q[j].y); v[2 * j][3] = ALPHA * bfhi(h[j].y) + w0 * bfhi(p[j].y) + w1 * bfhi(q[j].y);
            v[2 * j + 1][0] = ALPHA * bflo(h[j].z) + w0 * bflo(p[j].z) + w1 * bflo(q[j].z); v[2 * j + 1][1] = ALPHA * bfhi(h[j].z) + w0 * bfhi(p[j].z) + w1 * bfhi(q[j].z);
            v[2 * j + 1][2] = ALPHA * bflo(h[j].w) + w0 * bflo(p[j].w) + w1 * bflo(q[j].w); v[2 * j + 1][3] = ALPHA * bfhi(h[j].w) + w0 * bfhi(p[j].w) + w1 * bfhi(q[j].w); }
#pragma unroll
        for (int j = 0; j < 4; ++j) s += (v[j][0] + v[j][1]) + (v[j][2] + v[j][3]);
        const float mean = wave_sum_dpp(s) * (1.f / D); float s2 = 0.f;
#pragma unroll
        for (int j = 0; j < 4; ++j) { v[j] = v[j] - mean; s2 += (v[j][0] * v[j][0] + v[j][1] * v[j][1]) + (v[j][2] * v[j][2] + v[j][3] * v[j][3]); }
        const float rstd = 1.0f / sqrtf(wave_sum_dpp(s2) * (1.f / D) + 1e-5f);
        float* orow = a.out + (size_t)row * D + 8 * F.lane;
#pragma unroll
        for (int j = 0; j < 2; ++j) { *(f32x4*)(orow + 512 * j) = v[2 * j] * rstd * gam[2 * j] + bet[2 * j]; *(f32x4*)(orow + 512 * j + 4) = v[2 * j + 1] * rstd * gam[2 * j + 1] + bet[2 * j + 1]; }
    }
#undef P9_LOAD
}
#define MFMA32(a, b, c) __builtin_amdgcn_mfma_f32_32x32x16_bf16((a), (b), (c), 0, 0, 0)
__device__ __forceinline__ int crow(int r, int hi) { return (r & 3) + 8 * (r >> 2) + 4 * hi; }
__device__ __forceinline__ float gelu_tanh(float x) { const float u = 0.7978845608028654f * (x + 0.044715f * x * x * x); const float e = __builtin_amdgcn_exp2f(2.885390081777927f * u); return 0.5f * x * (2.0f - 2.0f * __builtin_amdgcn_rcpf(e + 1.0f)); }
constexpr int P2_AROW = 4096 + 16;
constexpr int P2_HID = 32 * P2_AROW;
constexpr int P2_HROW = 512 + 16;
__device__ __forceinline__ void phase2(const Frame& F, const Args& a) {
    unsigned char* ws = F.ws;
    const bf16* ZA = (const bf16*)(ws + WS_ZA);
    { const float* gn = a.in[8]; bf16* CK = (bf16*)(ws + WS_CKVN);
      const int sub = F.lane >> 4, l16 = F.lane & 15;
      float gv[8];
#pragma unroll
      for (int j = 0; j < 8; ++j) gv[j] = gn[l16 * 8 + j];
      const int r4b = F.bx * NWAVES + F.wave, r4s = F.G * NWAVES;
      for (int r4 = r4b; r4 < NTOK / 4; r4 += 4 * r4s) { u32x4 wv[4];
#pragma unroll
          for (int t = 0; t < 4; ++t) { const int rr = r4 + t * r4s; const int row = (rr < NTOK / 4 ? rr : r4) * 4 + sub; wv[t] = *(const u32x4*)(ZA + (size_t)row * ZA_LD + ZC_CKV + l16 * 8); }
#pragma unroll
          for (int t = 0; t < 4; ++t) { const int rr = r4 + t * r4s; if (rr < NTOK / 4) { const int row = rr * 4 + sub; const u32x4 w = wv[t];
              float v[8] = { bflo(w.x), bfhi(w.x), bflo(w.y), bfhi(w.y), bflo(w.z), bfhi(w.z), bflo(w.w), bfhi(w.w) };
              float s2 = 0.f;
#pragma unroll
              for (int j = 0; j < 8; ++j) s2 += v[j] * v[j];
              s2 += __shfl_xor(s2, 1); s2 += __shfl_xor(s2, 2); s2 += __shfl_xor(s2, 4); s2 += __shfl_xor(s2, 8);
              const float rs = 1.0f / sqrtf(s2 * (1.0f / 128.0f) + 1e-6f);
              u32x4 o; o.x = pk2(v[0] * rs * gv[0], v[1] * rs * gv[1]); o.y = pk2(v[2] * rs * gv[2], v[3] * rs * gv[3]); o.z = pk2(v[4] * rs * gv[4], v[5] * rs * gv[5]); o.w = pk2(v[6] * rs * gv[6], v[7] * rs * gv[7]);
              *(u32x4*)(CK + (size_t)row * 128 + l16 * 8) = o; } } } }
    const int r32 = F.lane & 31, hi = F.lane >> 5;
    for (int u = F.bx; u < 256; u += F.G) {
        const int kv = u >> 7, rt = u & 127, R0 = rt * 32;
        const int zc = kv ? ZC_VC : ZC_KC;
        const bf16* W1T = (const bf16*)(ws + (kv ? WS_W1V : WS_W1K)); const bf16* W2T = (const bf16*)(ws + (kv ? WS_W2V : WS_W2K));
        const float* bias = (const float*)(ws + WS_BIASK) + (size_t)kv * 32 * 256;
        bf16* OUT = (bf16*)(ws + (kv ? WS_VCMP : WS_KCMP));
        __syncthreads();
        { u32x4 av[16];
#pragma unroll
          for (int i = 0; i < 16; ++i) { const int q = F.tid + NTHR * i; const int row = q >> 8, cq = q & 255, l = cq >> 3, dch = cq & 7;
              const int R = R0 + row, b = R >> 9, c = (R >> 1) & 255, g = R & 1; const int cc = c < NCMP ? c : NCMP - 1;
              av[i] = *(const u32x4*)(ZA + (size_t)(b * SEQ + 16 * cc + l) * ZA_LD + zc + g * 64 + dch * 8); }
#pragma unroll
          for (int i = 0; i < 16; ++i) { const int q = F.tid + NTHR * i; const int row = q >> 8, cq = q & 255; *(LAS u32x4*)(F.lds + row * P2_AROW + cq * 16) = av[i]; } }
        __syncthreads();
        f32x16 acc = {};
        { const bf16* bp = W1T + (size_t)(32 * F.wave + r32) * 2048 + 8 * hi; const LAS unsigned char* ap = F.lds + r32 * P2_AROW + 16 * hi;
          f32x16 acc1 = {};
#pragma unroll 1
          for (int s0 = 0; s0 < 128; s0 += 32) { bf16x8 bfr[32];
#pragma unroll
              for (int j = 0; j < 32; ++j) bfr[j] = *(const bf16x8*)(bp + (s0 + j) * 16);
#pragma unroll
              for (int j = 0; j < 32; j += 2) { const bf16x8 a0 = *(const LAS bf16x8*)(ap + (s0 + j) * 32), a1 = *(const LAS bf16x8*)(ap + (s0 + j + 1) * 32); acc = MFMA32(a0, bfr[j], acc); acc1 = MFMA32(a1, bfr[j + 1], acc1); } }
#pragma unroll
          for (int i = 0; i < 16; ++i) acc[i] += acc1[i]; }
        { float bs = 0.f;
#pragma unroll 8
          for (int j = 0; j < 32; ++j) bs += bias[j * 256 + 32 * F.wave + r32];
#pragma unroll
          for (int i = 0; i < 16; ++i) { const float h = gelu_tanh(acc[i] + bs); *(LAS unsigned short*)(F.lds + P2_HID + crow(i, hi) * P2_HROW + (32 * F.wave + r32) * 2) = (unsigned short)f2bf(h); } }
        __syncthreads();
        if (F.wave < 2) {
            f32x16 o2 = {};
            const bf16* bp = W2T + (size_t)(32 * F.wave + r32) * 256 + 8 * hi; const LAS unsigned char* ap = F.lds + P2_HID + r32 * P2_HROW + 16 * hi;
#pragma unroll
            for (int s = 0; s < 16; ++s) { const bf16x8 af = *(const LAS bf16x8*)(ap + s * 32); const bf16x8 bfr = *(const bf16x8*)(bp + s * 16); o2 = MFMA32(af, bfr, o2); }
#pragma unroll
            for (int i = 0; i < 16; ++i) OUT[(size_t)(R0 + crow(i, hi)) * 64 + 32 * F.wave + r32] = (bf16)f2bf(o2[i]);
        }
    }
    __syncthreads();
}

typedef short v4i16_t __attribute__((ext_vector_type(4)));
__device__ __forceinline__ s16x4 vtr(const LAS unsigned char* p) { return __builtin_bit_cast(s16x4, __builtin_amdgcn_ds_read_tr16_b64_v4i16((LAS v4i16_t*)p)); }
constexpr int NSA_K = 0;
constexpr int NSA_V = 16384;
constexpr int NSA_TB = 49152;
constexpr int NSA_SC = 65536;
constexpr int NSA_MSK = 81920;
constexpr int NSA_OF = 83968;
constexpr float C2 = 0.125f * LOG2E;

__device__ __forceinline__ float halfmax(float v) { return fmaxf(v, __shfl_xor(v, 32)); }
__device__ __forceinline__ void nsa_tile(const bool nc4, const LAS unsigned char* Kb, const LAS unsigned char* Vb, const LAS float* tbh, const bf16x8 (&qr)[4], f32x16 (&o)[4], float& m, float& l,
                                         int kt, int tq, int kmul, int kadd, int dmax, bool selbit, int mode, float b31, int r32, int hi, int lane) {
    const int tqa = tq - kadd, qk = kmul == 16 ? (tqa >> 4) : tqa, rem = kmul == 16 ? (tqa & 15) : 0;
    const int ebase = qk - (kt * 64 + 4 * hi);
    const LAS unsigned char* vp0 = Vb + ((lane >> 4) & 1) * 32 + (lane & 3) * 8 + (4 * hi + ((lane & 15) >> 2)) * 64;
#pragma unroll
    for (int hf = 0; hf < 2; ++hf) {
        f32x16 s0 = {};
#pragma unroll
        for (int d0 = 0; d0 < 4; ++d0) { const bf16x8 k0 = *(const LAS bf16x8*)(Kb + (2 * d0 + hi) * 1024 + (r32 + 32 * hf) * 16); s0 = MFMA32(k0, qr[d0], s0); }
        float tmax, mn, ps = 0.f;
        if (mode == 2) {
            float a0 = fmaxf(fmaxf(s0[0], s0[1]), s0[2]), a1 = fmaxf(fmaxf(s0[3], s0[4]), s0[5]);
            a0 = fmaxf(fmaxf(a0, s0[6]), s0[7]); a1 = fmaxf(fmaxf(a1, s0[8]), s0[9]); a0 = fmaxf(fmaxf(a0, s0[10]), s0[11]); a1 = fmaxf(fmaxf(a1, s0[12]), s0[13]); a0 = fmaxf(fmaxf(a0, s0[14]), s0[15]);
            const float cb = selbit ? b31 : NEGBIG;
            tmax = fmaxf(a0, a1) * C2 + cb;
            tmax = halfmax(tmax);
            mn = fmaxf(m, tmax);
            const float cc = cb - mn;
#pragma unroll
            for (int r = 0; r < 16; ++r) { const float p0 = __builtin_amdgcn_exp2f(s0[r] * C2 + cc); s0[r] = p0; ps += p0; }
        } else if (mode == 1) {
            int eb1 = ebase; asm volatile("" : "+v"(eb1));
            const LAS float* tb1 = tbh + (eb1 - 96);
            float bv[16];
#pragma unroll
            for (int r = 0; r < 16; ++r) bv[r] = tb1[96 - ((r & 3) + 8 * (r >> 2) + 32 * hf)];
#pragma unroll
            for (int r = 0; r < 16; ++r) asm volatile("" : "+v"(bv[r]));
            tmax = NEGBIG;
#pragma unroll
            for (int r = 0; r < 16; ++r) { const float x = s0[r] * C2 + bv[r]; s0[r] = x; tmax = fmaxf(tmax, x); }
            tmax = selbit ? tmax : NEGBIG;
            tmax = halfmax(tmax);
            mn = fmaxf(m, tmax);
            const float mne = selbit ? mn : 1e30f;
#pragma unroll
            for (int r = 0; r < 16; ++r) { const float p0 = __builtin_amdgcn_exp2f(s0[r] - mne); s0[r] = p0; ps += p0; }
        } else {
            tmax = NEGBIG;
            float bv[16];
            int eb0 = ebase; asm volatile("" : "+v"(eb0));
#pragma unroll
            for (int r = 0; r < 16; ++r) { const int dist = __mul24(eb0 - ((r & 3) + 8 * (r >> 2) + 32 * hf), kmul) + rem; int dc = dist < 0 ? 0 : dist; dc = dc > 1023 ? 1023 : dc; bv[r] = tbh[dc]; }
#pragma unroll
            for (int r = 0; r < 16; ++r) asm volatile("" : "+v"(bv[r]));
#pragma unroll
            for (int r = 0; r < 16; ++r) { const int dist = __mul24(eb0 - ((r & 3) + 8 * (r >> 2) + 32 * hf), kmul) + rem;
                const bool valid = selbit && dist >= 0 && dist < dmax;
                const float x = valid ? s0[r] * C2 + bv[r] : NEGBIG;
                s0[r] = x; tmax = fmaxf(tmax, x); }
            tmax = halfmax(tmax);
            mn = fmaxf(m, tmax);
#pragma unroll
            for (int r = 0; r < 16; ++r) { const float p0 = s0[r] > -1e29f ? __builtin_amdgcn_exp2f(s0[r] - mn) : 0.f; s0[r] = p0; ps += p0; }
        }
        if (__any(mn != m)) {
            const float alpha = __builtin_amdgcn_exp2f(m - mn);
            l *= alpha;
#pragma unroll
            for (int c = 0; c < 4; ++c) if (c < 2 || nc4) {
#pragma unroll
                for (int r = 0; r < 16; ++r) o[c][r] *= alpha; }
        }
        m = mn;
        l += ps;
        u32x4 pw[2];
#pragma unroll
        for (int q = 0; q < 4; ++q) { pw[0][q] = pk2(s0[2 * q], s0[2 * q + 1]); pw[1][q] = pk2(s0[8 + 2 * q], s0[8 + 2 * q + 1]); }
#pragma unroll
        for (int c = 0; c < 4; ++c) if (c < 2 || nc4)
#pragma unroll
            for (int s2 = 0; s2 < 2; ++s2) { const int s = 2 * hf + s2; const s16x4 vl = vtr(vp0 + c * 4096 + s * 1024), vh = vtr(vp0 + c * 4096 + s * 1024 + 512);
                const bf16x8 vf = {vl[0], vl[1], vl[2], vl[3], vh[0], vh[1], vh[2], vh[3]};
                o[c] = MFMA32(vf, __builtin_bit_cast(bf16x8, pw[s2]), o[c]); }
    }
}

__device__ __forceinline__ void nsa_unit(const Frame& F, int b, int g, int qt) {
    unsigned char* ws = F.ws;
    const bf16* ZA = (const bf16*)(ws + WS_ZA);
    const int r32 = F.lane & 31, hi = F.lane >> 5, qi = r32 >> 2, hh = r32 & 3, head = g * 4 + hh;
    const int q0 = qt * 64, tq = q0 + 8 * F.wave + qi;
    const size_t zrow = (size_t)(b * SEQ + tq) * ZA_LD;
    const int srow = F.tid >> 3, sch = F.tid & 7;
    const f32x4* TBA4 = (const f32x4*)((const float*)(ws + WS_TBA) + (size_t)g * 4 * 1024);
    const f32x4 tbv0 = TBA4[F.tid], tbv1 = TBA4[F.tid + NTHR];
    const LAS float* tbh = (const LAS float*)(F.lds + NSA_TB) + hh * 1024;
    const int wq0 = q0 + 8 * F.wave;
    const float b31 = ((const float*)(ws + WS_TBA))[(size_t)head * 1024 + 1023];
    bf16x8 qr[4];
#pragma unroll
    for (int d0 = 0; d0 < 4; ++d0) qr[d0] = *(const bf16x8*)(ZA + zrow + ZC_QA + head * 64 + d0 * 16 + hi * 8);
    unsigned short graw[3];
#pragma unroll
    for (int i = 0; i < 3; ++i) graw[i] = ZA[zrow + ZC_GNSA + head * 3 + i];
    { LAS f32x4* tb4 = (LAS f32x4*)(F.lds + NSA_TB); tb4[F.tid] = tbv0; tb4[F.tid + NTHR] = tbv1; }
    float gate[3];
#pragma unroll
    for (int i = 0; i < 3; ++i) gate[i] = sigmoidf_(bf2f(graw[i]));
    LAS float* ofw = (LAS float*)(F.lds + NSA_OF) + F.wave * 2048 + F.lane;
    unsigned mlo = 0u, mhi = 0u;
    u32x4 kreg, vreg = {0u, 0u, 0u, 0u};
    const bf16* kgp; size_t vdel, tstep;
#define NSA_SETUP(br_) do { const int b_ = (br_); const bf16* Kg_; size_t pitch_; int tl_; \
        if (b_ == 0) { Kg_ = (const bf16*)(ws + WS_KCMP) + (size_t)(b * 256) * 128 + g * 64; vdel = (size_t)((const bf16*)(ws + WS_VCMP) - (const bf16*)(ws + WS_KCMP)); pitch_ = 128; tl_ = 0; } \
        else { Kg_ = ZA + (size_t)(b * SEQ) * ZA_LD + (b_ == 1 ? ZC_KS : ZC_KW) + g * 64; vdel = 128; pitch_ = ZA_LD; tl_ = (b_ == 2 && qt > 8) ? qt - 8 : 0; } \
        kgp = Kg_ + (size_t)(tl_ * 64 + srow) * pitch_ + sch * 8; tstep = (size_t)64 * pitch_; } while (0)
#define NSA_GLOAD(kt_) do { kreg = *(const u32x4*)kgp; vreg = *(const u32x4*)(kgp + vdel); kgp += tstep; } while (0)
    NSA_SETUP(0); NSA_GLOAD(0);
#pragma nounroll
    for (int br = 0; br < 3; ++br) {
        const bool iscmp = br == 0;
        const int t_lo = iscmp ? 0 : ((br == 2 && qt > 8) ? qt - 8 : 0), t_hi = iscmp ? ((q0 + 32) >> 10) : qt;
        const int kmul = iscmp ? 16 : 1, kadd = iscmp ? 31 : 0, dmax = br == 2 ? 512 : 0x40000000;
        f32x16 o[4]; o[0] = f32x16{}; o[1] = f32x16{}; o[2] = f32x16{}; o[3] = f32x16{};
        float m = NEGBIG, l = 0.f;
#define NSA_LSTORE(kt_, buf_) do { \
        *(LAS u32x4*)(F.lds + NSA_K + (buf_) * 8192 + sch * 1024 + srow * 16) = kreg; \
        *(LAS u32x4*)(F.lds + NSA_V + (buf_) * 16384 + (sch >> 2) * 4096 + srow * 64 + (sch & 3) * 16) = vreg; \
        if (iscmp) { const int c_ = (kt_) * 64 + srow, jj_ = c_ >> 2, mm_ = c_ & 3; u32x4 mv_; \
            _Pragma("unroll") for (int i_ = 0; i_ < 4; ++i_) { const int j0_ = sch * 8 + 2 * i_, j1_ = j0_ + 1; \
                const unsigned e0_ = (c_ < NCMP) ? (mm_ < 3 ? (j0_ == jj_ ? 0x4000u : 0u) : ((j0_ == jj_ || j0_ == jj_ + 1) ? 0x3F80u : 0u)) : 0u; \
                const unsigned e1_ = (c_ < NCMP) ? (mm_ < 3 ? (j1_ == jj_ ? 0x4000u : 0u) : ((j1_ == jj_ || j1_ == jj_ + 1) ? 0x3F80u : 0u)) : 0u; \
                mv_[i_] = e0_ | (e1_ << 16); } \
            *(LAS u32x4*)(F.lds + NSA_V + (buf_) * 16384 + (2 + (sch >> 2)) * 4096 + srow * 64 + (sch & 3) * 16) = mv_; } } while (0)
        NSA_LSTORE(t_lo, 0);
        __syncthreads();
        int buf = 0;
#pragma nounroll
        for (int kt = t_lo; kt <= t_hi; ++kt) {
            const int ktn = kt + 1; const bool more = kt < t_hi;
            if (more) NSA_GLOAD(ktn);
            const bool selbit = br == 1 ? (((kt < 32 ? (mlo >> kt) : (mhi >> (kt - 32))) & 1u) != 0u) : true;
            int mode = 0;
            { const int dmin = wq0 - (64 * kt + 63), dmx = wq0 + 7 - 64 * kt;
              if (br == 1) mode = dmin >= 790 ? 2 : (dmin >= 0 ? 1 : 0);
              if (br == 0) mode = 16 * (((wq0 - 31) >> 4) - (64 * kt + 63)) >= 790 ? 2 : 0;
              if (br == 2) mode = (dmin >= 0 && dmx <= 511) ? 1 : 0; }
            if (__any(selbit))
                nsa_tile(iscmp, F.lds + NSA_K + buf * 8192, F.lds + NSA_V + buf * 16384, tbh, qr, o, m, l, kt, tq, kmul, kadd, dmax, selbit, mode, b31, r32, hi, F.lane);
            if (more) NSA_LSTORE(ktn, buf ^ 1);
            __syncthreads();
            buf ^= 1;
        }
#undef NSA_LSTORE
        if (br < 2) { NSA_SETUP(br + 1); NSA_GLOAD(0); }
        l += __shfl_xor(l, 32);
        const float inv = l > 0.f ? 1.0f / l : 0.f;
        { const float sc = inv * (br == 0 ? gate[0] : br == 1 ? gate[1] : gate[2]);
#pragma unroll
            for (int c = 0; c < 2; ++c)
#pragma unroll
                for (int r = 0; r < 16; ++r) { const float prev = br == 0 ? 0.f : ofw[(c * 16 + r) * 64]; ofw[(c * 16 + r) * 64] = prev + o[c][r] * sc; } }
        if (iscmp) {
            LAS float* scw = (LAS float*)(F.lds + NSA_SC) + F.wave * 512;
#pragma unroll
            for (int c = 0; c < 2; ++c)
#pragma unroll
                for (int r = 0; r < 16; ++r) { float v = o[2 + c][r] * inv;
                    v += __builtin_bit_cast(float, __builtin_amdgcn_update_dpp(0, __builtin_bit_cast(int, v), 0xB1, 0xf, 0xf, true));
                    v += __builtin_bit_cast(float, __builtin_amdgcn_update_dpp(0, __builtin_bit_cast(int, v), 0x4E, 0xf, 0xf, true));
                    if (hh == 0) scw[qi * 64 + 32 * c + crow(r, hi)] = v; }
            LDS_WAIT();
            LAS unsigned* mskw = (LAS unsigned*)(F.lds + NSA_MSK) + F.wave * 16;
#pragma nounroll
            for (int q = 0; q < 8; ++q) {
                const int curq = (q0 + 8 * F.wave + q) >> 6, j = F.lane;
                const bool avail = j <= curq, forced = (j == 0) || (j == curq) || (j == curq - 1);
                const float sj = avail ? scw[q * 64 + j] + (forced ? 1e4f : 0.f) : NEGBIG;
                int rank = 0; const int sjb = __builtin_bit_cast(int, sj);
#pragma unroll
                for (int j2 = 0; j2 < 64; ++j2) { const float s2 = __builtin_bit_cast(float, __builtin_amdgcn_readlane(sjb, j2)); rank += (s2 > sj || (s2 == sj && j2 < j)) ? 1 : 0; }
                const bool sel = rank < 16 && avail;
                const unsigned long long bm = __ballot(sel);
                if (F.lane == 0) { mskw[2 * q] = (unsigned)bm; mskw[2 * q + 1] = (unsigned)(bm >> 32); } }
            LDS_WAIT();
            mlo = mskw[2 * qi]; mhi = mskw[2 * qi + 1];
        }
    }
#undef NSA_GLOAD
#undef NSA_SETUP
    bf16* OA = (bf16*)(ws + WS_OA) + (size_t)(b * SEQ + tq) * 512 + head * 64;
#pragma unroll
    for (int c = 0; c < 2; ++c)
#pragma unroll
        for (int r4 = 0; r4 < 4; ++r4) { u32x2 w; w.x = pk2(ofw[(c * 16 + 4 * r4) * 64], ofw[(c * 16 + 4 * r4 + 1) * 64]); w.y = pk2(ofw[(c * 16 + 4 * r4 + 2) * 64], ofw[(c * 16 + 4 * r4 + 3) * 64]);
            *(u32x2*)(OA + 32 * c + 8 * r4 + 4 * hi) = w; }
}
__device__ __forceinline__ void phase3(const Frame& F) {
    const bool xcd = (F.G == 256);
    const int pstart = xcd ? (F.bx >> 3) : F.bx, pstep = xcd ? 32 : F.G, pend = xcd ? 64 : 512;
#pragma nounroll
    for (int p2 = 2 * pstart; p2 < 2 * pend; p2 += (p2 & 1) ? 2 * pstep - 1 : 1) { const int p = p2 >> 1;
        const int b = xcd ? (F.bx & 7) : (p >> 6), g = (p >> 5) & 1, qt = p & 31;
        nsa_unit(F, b, g, (p2 & 1) ? qt : 63 - qt); }
    __syncthreads();
}

#define MFMA16(a, b, c) __builtin_amdgcn_mfma_f32_16x16x32_bf16((a), (b), (c), 0, 0, 0)
constexpr int DSA_SCP = 8200;
constexpr int DSA_SC = 0;
constexpr int DSA_LIST = 16 * DSA_SCP;
constexpr int DSA_NSEL = DSA_LIST + 8192;
constexpr int DSA_BIAS = DSA_NSEL + 64;
constexpr int DSA_HIST = DSA_BIAS + 1088;
constexpr int DSA_BKI = DSA_HIST + 8192;
constexpr int KSEL = 256;
__device__ __forceinline__ unsigned dsa_offb(unsigned row, unsigned ch) { return 256u * row + 16u * (ch ^ (((row & 3u) << 2) | ((row >> 2) & 3u))); }
__device__ __forceinline__ unsigned sortkey16(float x) { x = x + 0.0f; const unsigned short h = __builtin_bit_cast(unsigned short, (_Float16)x); return (h & 0x8000u) ? (unsigned)(unsigned short)~h : (unsigned)(h | 0x8000u); }
__device__ __forceinline__ int prefix_cnt(unsigned long long b) { return (int)__builtin_amdgcn_mbcnt_hi((unsigned)(b >> 32), __builtin_amdgcn_mbcnt_lo((unsigned)b, 0u)); }

__device__ __forceinline__ void dsa_unit(const Frame& F, const Args& a, int b, int qt16) {
    unsigned char* ws = F.ws;
    const bf16* ZA = (const bf16*)(ws + WS_ZA);
    const int lane = F.lane, l16 = lane & 15, quad = lane >> 4, q0 = qt16 * 16;
    __syncthreads();
#ifndef PROBE_DSA
#define PROBE_DSA 0
#endif
    for (int rep1_ = 0; rep1_ < (PROBE_DSA == 1 ? 2 : 1); ++rep1_) {
        const size_t qrow = (size_t)(b * SEQ + q0 + l16) * ZA_LD;
        bf16x8 qf[4][2];
#pragma unroll
        for (int i = 0; i < 4; ++i)
#pragma unroll
            for (int ks = 0; ks < 2; ++ks) qf[i][ks] = *(const bf16x8*)(ZA + qrow + ZC_QIDX + i * 64 + 32 * ks + 8 * quad);
        float wq[4];
#pragma unroll
        for (int i = 0; i < 4; ++i) wq[i] = bf2f(ZA[qrow + ZC_WIDX + i]) * 0.0625f;
        const int tq = q0 + l16, nkt = qt16 + 1;
        const bf16* kbase = ZA + (size_t)(b * SEQ + l16) * ZA_LD + ZC_KIDX + 8 * quad;
        bf16x8 ka[4][2], kn[4][2];
#define DSA_KLOAD(dst, kt0_) do { _Pragma("unroll") for (int t_ = 0; t_ < 4; ++t_) { const int k_ = (kt0_) + 8 * t_; const int kc_ = k_ < nkt ? k_ : nkt - 1; \
            dst[t_][0] = *(const bf16x8*)(kbase + (size_t)(kc_ * 16) * ZA_LD); dst[t_][1] = *(const bf16x8*)(kbase + (size_t)(kc_ * 16) * ZA_LD + 32); } } while (0)
        if (F.wave < nkt) DSA_KLOAD(ka, F.wave);
#pragma nounroll
        for (int kt0 = F.wave; kt0 < nkt; kt0 += 32) {
            if (kt0 + 32 < nkt) DSA_KLOAD(kn, kt0 + 32);
#pragma unroll
            for (int t = 0; t < 4; ++t) { const int kt = kt0 + 8 * t;
                if (kt < nkt) {
                    float idx[4] = {0.f, 0.f, 0.f, 0.f};
#pragma unroll
                    for (int i = 0; i < 4; ++i) { f32x4 acc = {0.f, 0.f, 0.f, 0.f}; acc = MFMA16(ka[t][0], qf[i][0], acc); acc = MFMA16(ka[t][1], qf[i][1], acc);
#pragma unroll
                        for (int r = 0; r < 4; ++r) idx[r] += fmaxf(acc[r], 0.f) * wq[i]; }
                    unsigned k16[4];
#pragma unroll
                    for (int r = 0; r < 4; ++r) { const int key = kt * 16 + 4 * quad + r; k16[r] = key <= tq ? sortkey16(idx[r]) : 0u; }
                    u32x2 w; w.x = k16[0] | (k16[1] << 16); w.y = k16[2] | (k16[3] << 16);
                    *(LAS u32x2*)(F.lds + DSA_SC + l16 * DSA_SCP + (kt * 16 + 4 * quad) * 2) = w; } }
#pragma unroll
            for (int t = 0; t < 4; ++t) { ka[t][0] = kn[t][0]; ka[t][1] = kn[t][1]; }
        }
#undef DSA_KLOAD
    }
    if (F.tid < 264) { const float* rb = a.in[11]; ((LAS float*)(F.lds + DSA_BIAS))[F.tid] = F.tid < 256 ? rb[(F.tid >> 3) * 16 + 8 + (F.tid & 7)] * LOG2E : NEGBIG; }
    __syncthreads();
    bf16x8 ql[2][4];
#pragma unroll
    for (int qq = 0; qq < 2; ++qq)
#pragma unroll
        for (int s2 = 0; s2 < 4; ++s2) { const bf16x8 v = *(const bf16x8*)(ZA + (size_t)(b * SEQ + q0 + 2 * F.wave + qq) * ZA_LD + ZC_QLAT + (l16 & 7) * 128 + 32 * s2 + 8 * quad); ql[qq][s2] = l16 < 8 ? v : (bf16x8){0, 0, 0, 0, 0, 0, 0, 0}; }
#pragma nounroll
    for (int qq = 0; qq < (PROBE_DSA == 2 ? 4 : 2); ++qq) {
        const int n = 2 * F.wave + (qq & 1), tq = q0 + n, N = tq + 1;
        LAS unsigned char* scq = F.lds + DSA_SC + n * DSA_SCP;
        LAS unsigned short* lst = (LAS unsigned short*)(F.lds + DSA_LIST) + n * 256;
        LAS unsigned short* bki = (LAS unsigned short*)(F.lds + DSA_BKI) + n * 256;
        if (N <= KSEL) {
            for (int s = lane; s < KSEL; s += 64) lst[s] = (unsigned short)(s < N ? s : 0);
            if (lane == 0) ((LAS int*)(F.lds + DSA_NSEL))[n] = N;
        } else {
            const int nit = (N + 255) >> 8;
            { const int it = nit - 1; const int s0 = 4 * (lane + 64 * it); u32x2 w = *(LAS u32x2*)(scq + s0 * 2);
              if (s0 + 0 > tq) w.x &= 0xffff0000u; if (s0 + 1 > tq) w.x &= 0x0000ffffu; if (s0 + 2 > tq) w.y &= 0xffff0000u; if (s0 + 3 > tq) w.y &= 0x0000ffffu;
              *(LAS u32x2*)(scq + s0 * 2) = w; }
            LDS_WAIT();
            LAS unsigned* hist = (LAS unsigned*)(F.lds + DSA_HIST) + F.wave * 256;
            unsigned T = 0u; int cgt = 0; int need = KSEL;
#pragma nounroll
            for (int lvl = 0; lvl < 2; ++lvl) {
                *(LAS u32x4*)(hist + 4 * lane) = (u32x4){0u, 0u, 0u, 0u};
                LDS_WAIT();
#pragma nounroll
                for (int it = 0; it < nit; ++it) { const u32x2 w = *(LAS u32x2*)(scq + (lane + 64 * it) * 8);
                    const unsigned k[4] = {w.x & 0xffffu, w.x >> 16, w.y & 0xffffu, w.y >> 16};
#pragma unroll
                    for (int e = 0; e < 4; ++e) { const bool in = lvl == 0 ? true : (k[e] >> 8) == (T >> 8); const unsigned bin = lvl == 0 ? (k[e] >> 8) : (k[e] & 255u);
                        if (in) __hip_atomic_fetch_add(hist + bin, 1u, __ATOMIC_RELAXED, __HIP_MEMORY_SCOPE_WORKGROUP); } }
                LDS_WAIT();
                const u32x4 h = *(LAS u32x4*)(hist + 4 * lane);
                const int sl = (int)(h.x + h.y + h.z + h.w); int suf = sl;
#pragma unroll
                for (int d = 1; d < 64; d <<= 1) { const int o = __shfl_down(suf, d); suf += (lane + d < 64) ? o : 0; }
                const int above = suf - sl;
                const bool here = above < need && above + sl >= need;
                int bsel = 4 * lane + 3, ca = above;
                if (ca + (int)h.w < need) { ca += (int)h.w; bsel = 4 * lane + 2; if (ca + (int)h.z < need) { ca += (int)h.z; bsel = 4 * lane + 1; if (ca + (int)h.y < need) { ca += (int)h.y; bsel = 4 * lane; } } }
                const unsigned long long bm = __ballot(here);
                const int src = bm ? (int)__builtin_ctzll(bm) : 0;
                const int B = __shfl(bsel, src), CA = __shfl(ca, src);
                if (lvl == 0) T = (unsigned)B << 8; else T |= (unsigned)B;
                cgt += CA; need -= CA;
                LDS_WAIT();
            }
            const int rties = KSEL - cgt;
            int tiebase = 0, outbase = 0;
#define DSA_PUT(pos_, idx_) do { const int p_ = (pos_); if (p_ >= 0 && p_ < KSEL) lst[p_] = (unsigned short)(idx_); } while (0)
#pragma nounroll
            for (int it = 0; it < nit; ++it) { const u32x2 w = *(LAS u32x2*)(scq + (lane + 64 * it) * 8);
                const unsigned k0 = w.x & 0xffffu, k1 = w.x >> 16, k2 = w.y & 0xffffu, k3 = w.y >> 16;
                const int sidx = 4 * (lane + 64 * it);
                const bool g0 = k0 > T, g1 = k1 > T, g2 = k2 > T, g3 = k3 > T;
                const unsigned long long bg0 = __ballot(g0), bg1 = __ballot(g1), bg2 = __ballot(g2), bg3 = __ballot(g3);
                if (bg0 | bg1 | bg2 | bg3) {
                    int pos = outbase + prefix_cnt(bg0) + prefix_cnt(bg1) + prefix_cnt(bg2) + prefix_cnt(bg3);
                    if (g0) { DSA_PUT(pos, sidx + 0); ++pos; }
                    if (g1) { DSA_PUT(pos, sidx + 1); ++pos; }
                    if (g2) { DSA_PUT(pos, sidx + 2); ++pos; }
                    if (g3) { DSA_PUT(pos, sidx + 3); ++pos; }
                    outbase += __popcll(bg0) + __popcll(bg1) + __popcll(bg2) + __popcll(bg3); }
                const bool e0 = k0 == T, e1 = k1 == T, e2 = k2 == T, e3 = k3 == T;
                const unsigned long long be0 = __ballot(e0), be1 = __ballot(e1), be2 = __ballot(e2), be3 = __ballot(e3);
                if ((be0 | be1 | be2 | be3) && tiebase < rties) {
                    const int t0 = tiebase + prefix_cnt(be0) + prefix_cnt(be1) + prefix_cnt(be2) + prefix_cnt(be3), t1 = t0 + (e0 ? 1 : 0), t2 = t1 + (e1 ? 1 : 0), t3 = t2 + (e2 ? 1 : 0);
                    if (e0 && t0 < rties) DSA_PUT(KSEL - 1 - t0, sidx + 0);
                    if (e1 && t1 < rties) DSA_PUT(KSEL - 1 - t1, sidx + 1);
                    if (e2 && t2 < rties) DSA_PUT(KSEL - 1 - t2, sidx + 2);
                    if (e3 && t3 < rties) DSA_PUT(KSEL - 1 - t3, sidx + 3);
                    tiebase += __popcll(be0) + __popcll(be1) + __popcll(be2) + __popcll(be3); } }
#undef DSA_PUT
            outbase = KSEL;
            if (lane == 0) ((LAS int*)(F.lds + DSA_NSEL))[n] = outbase < KSEL ? outbase : KSEL;
        }
        LDS_WAIT();
        { const int nsl = N < KSEL ? N : KSEL;
#pragma unroll
          for (int i = 0; i < 4; ++i) { const int e = lane + 64 * i; const int dist = tq - (int)lst[e];
              const int dpos = dist < 1 ? 1 : dist; int bl = 16 + (int)((__log2f((float)dpos) - 4.0f) * 2.66666675f); bl = bl > 31 ? 31 : bl;
              const int bk = dist < 1 ? 0 : (dpos < 16 ? dpos : bl);
              bki[e] = (unsigned short)(e < nsl ? bk * 32 : 1024); } }
    }
    LDS_WAIT();
    const bf16* CK = (const bf16*)(ws + WS_CKVN) + (size_t)(b * SEQ) * 128;
    LAS unsigned char* gb0 = F.lds + DSA_SC + (2 * F.wave) * DSA_SCP;
    const LAS unsigned char* biasb = F.lds + DSA_BIAS + (l16 & 7) * 4;
#define DSA_GATHER(chunk_, buf_) do { const unsigned key_ = lst[(chunk_) * 32 + (lane >> 1)]; const char* src_ = (const char*)CK + (key_ * 256u + (unsigned)(lane & 1) * 16u); \
        _Pragma("unroll") for (int c_ = 0; c_ < 8; ++c_) __builtin_amdgcn_global_load_lds((const unsigned*)(src_ + c_ * 32), (LAS unsigned*)(gb0 + (buf_) * 8192 + c_ * 1024), 16, 0, 0); } while (0)
    int tqs[2], nsels[2]; const LAS unsigned short* lsts[2]; const LAS unsigned short* bkis[2]; f32x4 o[2][8]; float ms[2], ls[2];
#pragma unroll
    for (int qq = 0; qq < 2; ++qq) { const int n = 2 * F.wave + qq; tqs[qq] = q0 + n; nsels[qq] = ((const LAS int*)(F.lds + DSA_NSEL))[n]; lsts[qq] = (const LAS unsigned short*)(F.lds + DSA_LIST) + n * 256; bkis[qq] = (const LAS unsigned short*)(F.lds + DSA_BKI) + n * 256;
#pragma unroll
        for (int c = 0; c < 8; ++c) o[qq][c] = (f32x4){0.f, 0.f, 0.f, 0.f};
        ms[qq] = NEGBIG; ls[qq] = 0.f; }
#pragma unroll
    for (int qq = 0; qq < 2; ++qq)
#pragma unroll
        for (int s2 = 0; s2 < 4; ++s2) asm volatile("" : "+v"(ql[qq][s2]));
    const int nch1 = (nsels[1] + 31) >> 5, nch = PROBE_DSA == 3 ? 2 * nch1 : nch1;
    LDS_WAIT();
    { const LAS unsigned short* lst = lsts[0]; DSA_GATHER(0, 0); }
    { const LAS unsigned short* lst = lsts[1]; DSA_GATHER(0, 1); }
    const unsigned offA = (unsigned)((quad >> 1) * 1024 + l16 * 32 + (quad & 1) * 16);
    const unsigned offT = (unsigned)((4 * quad + (l16 >> 2)) * 32 + 8 * (lane & 3));
#pragma nounroll
    for (int ch = 0; ch < nch; ++ch) {
#pragma unroll
        for (int qq = 0; qq < 2; ++qq) {
            const int chd = ch >= nch1 ? ch - nch1 : ch;
            const LAS unsigned short* lst = lsts[qq];
            const LAS unsigned char* gb = gb0 + qq * 8192;
            if (qq == 0 || ch + 1 < nch) asm volatile("s_waitcnt vmcnt(8)" ::: "memory"); else asm volatile("s_waitcnt vmcnt(0)" ::: "memory");
            f32x4 acc2[2]; float bvs[2][4];
#pragma unroll
            for (int rb = 0; rb < 2; ++rb) { f32x4 acc = {0.f, 0.f, 0.f, 0.f};
#pragma unroll
                for (int s2 = 0; s2 < 4; ++s2) { const bf16x8 af = *(const LAS bf16x8*)(gb + offA + rb * 512 + s2 * 2048); acc = MFMA16(af, ql[qq][s2], acc); }
                acc2[rb] = acc;
                const u32x2 kb = *(const LAS u32x2*)((const LAS unsigned char*)bkis[qq] + (chd * 32 + rb * 16 + 4 * quad) * 2);
                bvs[rb][0] = *(const LAS float*)(biasb + (kb.x & 0xffffu)); bvs[rb][1] = *(const LAS float*)(biasb + (kb.x >> 16));
                bvs[rb][2] = *(const LAS float*)(biasb + (kb.y & 0xffffu)); bvs[rb][3] = *(const LAS float*)(biasb + (kb.y >> 16)); }
#pragma unroll
            for (int rb = 0; rb < 2; ++rb)
#pragma unroll
                for (int r = 0; r < 4; ++r) asm volatile("" : "+v"(bvs[rb][r]));
            float x[2][4]; float tmax = NEGBIG;
#pragma unroll
            for (int rb = 0; rb < 2; ++rb)
#pragma unroll
                for (int r = 0; r < 4; ++r) { const float xv = acc2[rb][r] * C2 + bvs[rb][r]; x[rb][r] = xv; tmax = fmaxf(tmax, xv); }
            tmax = fmaxf(tmax, __shfl_xor(tmax, 16)); tmax = fmaxf(tmax, __shfl_xor(tmax, 32));
            const float mn = fmaxf(ms[qq], tmax); const bool resc = __any(mn != ms[qq]); const float alpha = __builtin_amdgcn_exp2f(ms[qq] - mn); ms[qq] = mn;
            float ps = 0.f;
#pragma unroll
            for (int rb = 0; rb < 2; ++rb)
#pragma unroll
                for (int r = 0; r < 4; ++r) { const float pv = __builtin_amdgcn_exp2f(x[rb][r] - mn); x[rb][r] = pv; ps += pv; }
            ls[qq] = ls[qq] * alpha + ps;
            if (resc) {
#pragma unroll
                for (int c = 0; c < 8; ++c) o[qq][c] = o[qq][c] * alpha; }
            u32x4 pw; pw.x = pk2(x[0][0], x[0][1]); pw.y = pk2(x[0][2], x[0][3]); pw.z = pk2(x[1][0], x[1][1]); pw.w = pk2(x[1][2], x[1][3]);
            const unsigned gba = (unsigned)(unsigned long long)gb + offT;
#pragma unroll
            for (int cb = 0; cb < 2; ++cb) {
                s16x4 v[8];
                if (cb == 0) asm volatile("ds_read_b64_tr_b16 %0, %8\n\tds_read_b64_tr_b16 %1, %8 offset:512\n\tds_read_b64_tr_b16 %2, %8 offset:1024\n\tds_read_b64_tr_b16 %3, %8 offset:1536\n\t"
                             "ds_read_b64_tr_b16 %4, %8 offset:2048\n\tds_read_b64_tr_b16 %5, %8 offset:2560\n\tds_read_b64_tr_b16 %6, %8 offset:3072\n\tds_read_b64_tr_b16 %7, %8 offset:3584\n\ts_waitcnt lgkmcnt(0)"
                             : "=&v"(v[0]), "=&v"(v[1]), "=&v"(v[2]), "=&v"(v[3]), "=&v"(v[4]), "=&v"(v[5]), "=&v"(v[6]), "=&v"(v[7]) : "v"(gba) : "memory");
                else asm volatile("ds_read_b64_tr_b16 %0, %8 offset:4096\n\tds_read_b64_tr_b16 %1, %8 offset:4608\n\tds_read_b64_tr_b16 %2, %8 offset:5120\n\tds_read_b64_tr_b16 %3, %8 offset:5632\n\t"
                             "ds_read_b64_tr_b16 %4, %8 offset:6144\n\tds_read_b64_tr_b16 %5, %8 offset:6656\n\tds_read_b64_tr_b16 %6, %8 offset:7168\n\tds_read_b64_tr_b16 %7, %8 offset:7680\n\ts_waitcnt lgkmcnt(0)"
                             : "=&v"(v[0]), "=&v"(v[1]), "=&v"(v[2]), "=&v"(v[3]), "=&v"(v[4]), "=&v"(v[5]), "=&v"(v[6]), "=&v"(v[7]) : "v"(gba) : "memory");
#pragma unroll
                for (int c4 = 0; c4 < 4; ++c4) { const int c = 4 * cb + c4; const s16x4 v0 = v[2 * c4], v1 = v[2 * c4 + 1];
                    const bf16x8 vf = {v0[0], v0[1], v0[2], v0[3], v1[0], v1[1], v1[2], v1[3]};
                    o[qq][c] = MFMA16(vf, __builtin_bit_cast(bf16x8, pw), o[qq][c]); }
            }
            LDS_WAIT();
            if (ch + 1 < nch) DSA_GATHER((ch + 1 >= nch1 ? ch + 1 - nch1 : ch + 1), qq);
        }
    }
#pragma unroll
    for (int qq = 0; qq < 2; ++qq) {
        float l = ls[qq]; const int tq = tqs[qq];
        l += __shfl_xor(l, 16); l += __shfl_xor(l, 32);
        const float inv = l > 0.f ? 1.0f / l : 0.f;
        if (l16 < 8) { bf16* op = (bf16*)(ws + WS_OLAT) + (size_t)(b * SEQ + tq) * 1024 + l16 * 128 + 4 * quad;
#pragma unroll
            for (int c = 0; c < 8; ++c) { u32x2 w; w.x = pk2(o[qq][c][0] * inv, o[qq][c][1] * inv); w.y = pk2(o[qq][c][2] * inv, o[qq][c][3] * inv); *(u32x2*)(op + 16 * c) = w; } }
    }
}
#undef DSA_GATHER
__device__ __forceinline__ void phase4(const Frame& F, const Args& a) {
    const bool xcd = (F.G == 256);
    const int pstart = xcd ? (F.bx >> 3) : F.bx, pstep = xcd ? 32 : F.G, pend = xcd ? 128 : 1024;
#pragma nounroll
    for (int p2 = 2 * pstart; p2 < 2 * pend; p2 += (p2 & 1) ? 2 * pstep - 1 : 1) { const int p = p2 >> 1;
        const int b = xcd ? (F.bx & 7) : (p >> 7), j = p & 127;
        dsa_unit(F, a, b, (p2 & 1) ? j : 255 - j); }
    __syncthreads();
}

constexpr int NPHASE = 11;
__global__ void __launch_bounds__(NTHR, 2) fwd_kernel(Args args) {
    extern __shared__ __attribute__((aligned(16))) unsigned char lds_raw[];
    Frame F;
    F.lds = (LAS unsigned char*)lds_raw;
    F.tid = threadIdx.x; F.lane = F.tid & 63; F.wave = __builtin_amdgcn_readfirstlane(F.tid >> 6);
    F.G = gridDim.x; F.bx = blockIdx.x; F.ws = args.ws;
    unsigned char* ws = args.ws;
    volatile LAS unsigned* MISC = (volatile LAS unsigned*)(F.lds + MISC_OFF);
    if (F.tid < 64) MISC[F.tid] = 0u;
    __syncthreads();
    const int lo = args.ph_lo, hi = args.ph_hi;
    XcdBarrier bar; bar.bar = (unsigned*)(ws + WS_CTL) + CW_BAR; bar.x = 0; bar.st = nullptr;
    if (hi - lo > 1) bar = xcd_barrier_post((unsigned*)(ws + WS_CTL) + CW_BAR, MISC + 8);
#ifndef PH_MASK
#define PH_MASK 0xFFFF
#endif
#define IN(k) ((((PH_MASK) >> (k)) & 1) && lo <= (k) && (k) < hi)
#define SEAM(k) do { if (IN(k) && IN((k) + 1)) xcd_barrier(bar); } while (0)
#ifndef PROBE_PHASE
#define PROBE_PHASE -1
#endif
#define REPEAT(k) for (int rep_ = 0; rep_ < ((PROBE_PHASE) == (k) ? 2 : 1); ++rep_, ((PROBE_PHASE) == (k) && rep_ < 2 ? xcd_barrier(bar) : (void)0))

    if (IN(0)) REPEAT(0) { phase0(F, args); }
    SEAM(0);
    if (IN(1)) REPEAT(1) {
#ifndef PROBE_GEMM
#define PROBE_GEMM 0
#endif
        pg8::StaticOrder S; S.init(NTOK / 256, NZ / 256, F.G, F.bx, PROBE_GEMM == 1 ? 2 : 1);
        const APlain AA{ws + WS_XB, 128u, (unsigned)(D * 2)}; const BPlain BA{(const bf16*)(ws + WS_WINT), D};
        const EpiZ E{(bf16*)(ws + WS_ZA), (bf16*)(ws + WS_ZG)};
        pg8::gemm_phase(F.lds, D, S, AA, BA, E);
        { const int nu = (NTOK / 256) * (NZ / 256), rem = nu % F.G;
          if (rem != 0 && F.bx >= rem) p0_experts(F, args, (F.bx - rem) * NWAVES + F.wave, (F.G - rem) * NWAVES, 0, P0_EXP_ITEMS); }
    }
    SEAM(1);
    if (IN(2)) REPEAT(2) { phase2(F, args); }
    SEAM(2);
    if (IN(3)) REPEAT(3) { phase3(F); }
    if (IN(4)) REPEAT(4) { phase4(F, args); }
    SEAM(4);
    if (IN(5)) REPEAT(5) {
        pg8::StaticOrder S; S.init(NTOK / 256, D / 256, F.G, F.bx);
        { const APlain AA{ws + WS_OA, 128u, 1024u}; const BPlain BA{(const bf16*)(ws + WS_WAT), 512};
          const EpiGate<0> E{(const bf16*)(ws + WS_ZG), nullptr, (bf16*)(ws + WS_T1)};
          pg8::gemm_phase(F.lds, 512, S, AA, BA, E); }
        { const APlain AA{ws + WS_OLAT, 128u, 2048u}; const BPlain BA{(const bf16*)(ws + WS_WBT), 1024};
          const EpiGate<1> E{(const bf16*)(ws + WS_ZG), (const bf16*)(ws + WS_T1), (bf16*)(ws + WS_MERGED)};
          pg8::gemm_phase(F.lds, 1024, S, AA, BA, E); }
    }
    SEAM(5);
    if (IN(6)) REPEAT(6) {
        pg8::StaticOrder S; S.init(NTOK / 256, D / 256, F.G, F.bx, PROBE_GEMM == 6 ? 2 : 1);
        const APlain AA{ws + WS_MERGED, 128u, 2048u}; const BPlain BA{(const bf16*)(ws + WS_WOT), 1024};
        const EpiRes E{args.in[0], (bf16*)(ws + WS_H1)};
        pg8::gemm_phase(F.lds, 1024, S, AA, BA, E);
    }
    SEAM(6);
    if (IN(7)) { phase6(F, args); }
    SEAM(7);
    if (IN(8)) REPEAT(8) {
        moe_setup(F);
        const int vcu = (F.G % 8 == 0) ? (F.bx % 8) * (F.G / 8) + F.bx / 8 : F.bx;
        const MoeOrder S{F.G, vcu, 2, (const LAS int*)(F.lds + MOE_CUM), (const LAS int*)(F.lds + MOE_CUM) + 40};
        const AGather AA{ws + WS_H1B, 128u, (const int*)(ws + WS_LIST)}; const BGu BA{(const bf16*)(ws + WS_WGU)};
        const EpiAct E{(bf16*)(ws + WS_ACT)};
        pg8::gemm_phase(F.lds, 1024, S, AA, BA, E);
    }
    SEAM(8);
    if (IN(9)) REPEAT(9) {
        moe_setup(F);
        const int vcu = (F.G % 8 == 0) ? (F.bx % 8) * (F.G / 8) + F.bx / 8 : F.bx;
        const MoeOrder S{F.G, vcu, 4, (const LAS int*)(F.lds + MOE_CUM), (const LAS int*)(F.lds + MOE_CUM) + 40};
        const APlain AA{ws + WS_ACT, 128u, 512u}; const BDn BA{(const bf16*)(ws + WS_WDT)};
        const EpiDown E{(bf16*)(ws + WS_YBUF), (const int*)(ws + WS_LIST)};
        pg8::gemm_phase(F.lds, 256, S, AA, BA, E);
    }
    SEAM(9);
    if (IN(10)) REPEAT(10) { phase9(F, args); }
#undef IN
#undef SEAM
#undef REPEAT
}

extern "C" void kernel_launch(void* const* d_in, const int* in_sizes, int n_in, void* d_out, int out_size, void* d_ws, size_t ws_size, hipStream_t stream) {
    static int grid = 0;
    if (grid == 0) {
        if (n_in != 26 || in_sizes[0] != NTOK * D || out_size != NTOK * D || ws_size < WS_END) {
            fprintf(stderr, "kernel_launch: unexpected problem: n_in %d in0 %d out %d ws %zu (need %zu)\n", n_in, n_in > 0 ? in_sizes[0] : -1, out_size, ws_size, (size_t)WS_END); grid = -1; return; }
        int dev = 0, cus = 0, per_cu = 0;
        if (hipGetDevice(&dev) != hipSuccess || hipDeviceGetAttribute(&cus, hipDeviceAttributeMultiprocessorCount, dev) != hipSuccess) { grid = -1; return; }
        if (hipFuncSetAttribute((const void*)fwd_kernel, hipFuncAttributeMaxDynamicSharedMemorySize, LDS_BYTES) != hipSuccess) { fprintf(stderr, "kernel_launch: hipFuncSetAttribute failed\n"); grid = -1; return; }
        if (hipOccupancyMaxActiveBlocksPerMultiprocessor(&per_cu, (const void*)fwd_kernel, NTHR, LDS_BYTES) != hipSuccess || per_cu < 1)
            fprintf(stderr, "kernel_launch: occupancy query reports %d\n", per_cu);
        (void)hipGetLastError();
        grid = cus;
    }
    if (grid < 0) return;
    if (hipMemsetAsync((char*)d_ws + WS_CTL, 0, CTL_ZERO_BYTES, stream) != hipSuccess) return;
    Args a{};
    for (int i = 0; i < 26; ++i) a.in[i] = (const float*)d_in[i];
    a.out = (float*)d_out; a.ws = (unsigned char*)d_ws;
#if MK_PER_PHASE
    for (int p = 0; p < NPHASE; ++p) { a.ph_lo = p; a.ph_hi = p + 1; hipLaunchKernelGGL(fwd_kernel, dim3(grid), dim3(NTHR), LDS_BYTES, stream, a); }
#else
    a.ph_lo = 0; a.ph_hi = NPHASE;
    hipLaunchKernelGGL(fwd_kernel, dim3(grid), dim3(NTHR), LDS_BYTES, stream, a);
#endif
}
```

```cpp
#include <hip/hip_runtime.h>
#include <cstdio>
#include <cstdint>

#ifndef MK_PER_PHASE
#define MK_PER_PHASE 0
#endif

#define GAS __attribute__((address_space(1)))
#define LAS __attribute__((address_space(3)))
typedef unsigned short bf16;
typedef short bf16x8 __attribute__((ext_vector_type(8)));
typedef short s16x4 __attribute__((ext_vector_type(4)));
typedef float f32x4 __attribute__((ext_vector_type(4)));
typedef float f32x16 __attribute__((ext_vector_type(16)));
typedef float f32x2 __attribute__((ext_vector_type(2)));
typedef unsigned u32x4 __attribute__((ext_vector_type(4)));
typedef unsigned u32x2 __attribute__((ext_vector_type(2)));

constexpr int D = 1024, BATCH = 8, SEQ = 4096, NTOK = BATCH * SEQ;
constexpr int D_IN = 4316;
constexpr int NCMP = 255;
constexpr float ALPHA = 1.189207115002721f;
constexpr float LOG2E = 1.4426950408889634f;
constexpr float NEGBIG = -1e30f;
constexpr int ZA_LD = 2816;
constexpr int ZC_QA = 0, ZC_KC = 512, ZC_VC = 640, ZC_KS = 768, ZC_VS = 896, ZC_KW = 1024, ZC_VW = 1152, ZC_QLAT = 1280, ZC_CKV = 2304,
              ZC_QIDX = 2432, ZC_KIDX = 2688, ZC_GNSA = 2752, ZC_WIDX = 2776;
constexpr int ZG_LD = 2048;
constexpr int NZ = ZA_LD + ZG_LD;
constexpr int NEXP = 32, DEXP = 256;
constexpr int MAXTILES = (2 * NTOK) / 256 + NEXP;

constexpr size_t MiB = 1u << 20;
constexpr size_t WS_CTL = 0, CTL_ZERO_BYTES = 1 * MiB;
constexpr size_t WS_WAT = 1 * MiB;
constexpr size_t WS_WBT = 2 * MiB;
constexpr size_t WS_WOT = 4 * MiB;
constexpr size_t WS_W1K = 6 * MiB;
constexpr size_t WS_W1V = 7 * MiB;
constexpr size_t WS_W2K = 8 * MiB;
constexpr size_t WS_W2V = 8 * MiB + 64 * 1024;
constexpr size_t WS_BIASK = 8 * MiB + 128 * 1024;
constexpr size_t WS_TBA = 8 * MiB + 256 * 1024;
constexpr size_t WS_TBB = 8 * MiB + 320 * 1024;
constexpr size_t WS_KCMP = 9 * MiB;
constexpr size_t WS_VCMP = 9 * MiB + 512 * 1024;
constexpr size_t WS_TOKINFO = 10 * MiB;
constexpr size_t WS_LIST = 11 * MiB;
constexpr size_t WS_WINT = 16 * MiB;
constexpr size_t WS_WGU = 32 * MiB;
constexpr size_t WS_WDT = 64 * MiB;
constexpr size_t WS_CKVN = 80 * MiB;
constexpr size_t WS_XB = 96 * MiB;
constexpr size_t WS_OLAT = 96 * MiB;
constexpr size_t WS_H1B = 96 * MiB;
constexpr size_t WS_ZA = 160 * MiB;
constexpr size_t WS_T1 = 160 * MiB;
constexpr size_t WS_ACT = 160 * MiB;
constexpr size_t WS_YBUF = 196 * MiB;
constexpr size_t WS_MERGED = 224 * MiB;
constexpr size_t WS_ZG = 336 * MiB;
constexpr size_t WS_H1 = 336 * MiB;
constexpr size_t WS_OA = 464 * MiB;
constexpr size_t WS_END = 496 * MiB;

constexpr int CW_BAR = 4096;
constexpr int CW_CNT = 16384;

constexpr int LDS_BYTES = 163840;
constexpr int MISC_OFF = 160 * 1024 - 256;

__device__ __forceinline__ unsigned f2bf(float f) { unsigned u = __builtin_bit_cast(unsigned, f); return (u + 0x7fffu + ((u >> 16) & 1u)) >> 16; }
__device__ __forceinline__ unsigned pk2(float lo, float hi) { unsigned r; asm volatile("v_cvt_pk_bf16_f32 %0, %1, %2" : "=v"(r) : "v"(lo), "v"(hi)); return r; }
__device__ __forceinline__ float bf2f(unsigned short b) { return __builtin_bit_cast(float, ((unsigned)b) << 16); }
__device__ __forceinline__ float bflo(unsigned w) { return __builtin_bit_cast(float, w << 16); }
__device__ __forceinline__ float bfhi(unsigned w) { return __builtin_bit_cast(float, w & 0xffff0000u); }
__device__ __forceinline__ float wave_sum(float v) {
#pragma unroll
    for (int o = 1; o < 64; o <<= 1) v += __shfl_xor(v, o);
    return v;
}
__device__ __forceinline__ float sigmoidf_(float x) { return __builtin_amdgcn_rcpf(1.0f + __builtin_amdgcn_exp2f(-1.4426950408889634f * x)); }
#define LDS_WAIT() asm volatile("s_waitcnt lgkmcnt(0)" ::: "memory")
#define VM_WAIT() asm volatile("s_waitcnt vmcnt(0)" ::: "memory")

#define XB_TMO      128
#define XB_XCNT(j)  (256  + 64 * (j))
#define XB_XSUB(j)  (1280 + 64 * (j))
#define XB_XGEN(j)  (2304 + 64 * (j))
#define XB_TOP      3328
#define XB_TOPGEN   3392
#define XCD_BAR_WORDS 3456
#define XB_SPIN_CAP (1u << 18)
__device__ __forceinline__ unsigned xb_ld(unsigned* p)              { return __hip_atomic_load(p, __ATOMIC_RELAXED, __HIP_MEMORY_SCOPE_AGENT); }
__device__ __forceinline__ unsigned xb_add(unsigned* p, unsigned v) { return __hip_atomic_fetch_add(p, v, __ATOMIC_RELAXED, __HIP_MEMORY_SCOPE_AGENT); }
__device__ __forceinline__ unsigned xb_xcc_id() { return (unsigned)__builtin_amdgcn_s_getreg((3 << 11) | 20) & 0xFu; }
#define XB_SPIN(cond, bar) do { unsigned _sp = 0; while (cond) { __builtin_amdgcn_s_sleep(1); \
    if ((++_sp & 255u) == 0u) { if (xb_ld(&(bar)[XB_TMO])) break; if (_sp > XB_SPIN_CAP) { atomicAdd(&(bar)[XB_TMO], 1u); break; } } } } while (0)
struct XcdBarrier { unsigned* bar; unsigned x; volatile LAS unsigned* st; };
__device__ __forceinline__ XcdBarrier xcd_barrier_post(unsigned* bar, volatile LAS unsigned* st) {
    XcdBarrier b; b.bar = bar; b.x = xb_xcc_id(); b.st = st;
    if (threadIdx.x == 0) (void)xb_add(&bar[XB_XCNT(b.x)], 1u);
    return b;
}
__device__ __forceinline__ void xcd_barrier_complete(unsigned* bar, unsigned x, unsigned& nloc, unsigned& nx) {
    const unsigned G = gridDim.x * gridDim.y * gridDim.z;
    unsigned sum, cnt, mine, sp = 0u;
    for (;;) {
        sum = 0u; cnt = 0u; mine = 0u;
#pragma unroll
        for (unsigned j = 0; j < 16; ++j) { const unsigned c = xb_ld(&bar[XB_XCNT(j)]); sum += c; cnt += (c > 0u) ? 1u : 0u; mine = (j == x) ? c : mine; }
        if (sum == G) break;
        __builtin_amdgcn_s_sleep(1);
        if ((++sp & 255u) == 0u) { if (xb_ld(&bar[XB_TMO])) break; if (sp > XB_SPIN_CAP) { atomicAdd(&bar[XB_TMO], 1u); break; } }
    }
    nloc = mine > 0u ? mine : 1u; nx = cnt > 0u ? cnt : 1u;
}
__device__ __forceinline__ void xcd_barrier(const XcdBarrier& b) {
    asm volatile("s_waitcnt vmcnt(0)" ::: "memory");
    __syncthreads();
    if (threadIdx.x == 0) {
        unsigned* bar = b.bar;
        __builtin_amdgcn_s_waitcnt(0);
        unsigned nloc = b.st[0], nx = b.st[1];
        if (nloc == 0u) { xcd_barrier_complete(bar, b.x, nloc, nx); b.st[0] = nloc; b.st[1] = nx; }
        const unsigned old = xb_add(&bar[XB_XSUB(b.x)], 1u);
        const unsigned gen = old / nloc;
        if (old + 1u == (gen + 1u) * nloc) {
            __builtin_amdgcn_fence(__ATOMIC_RELEASE, "agent");
            asm volatile("s_waitcnt vmcnt(0)" ::: "memory");
            const unsigned og = xb_add(&bar[XB_TOP], 1u);
            const unsigned tg = og / nx;
            if (og + 1u == (tg + 1u) * nx) xb_add(&bar[XB_TOPGEN], 1u);
            else XB_SPIN(xb_ld(&bar[XB_TOPGEN]) == tg, bar);
            __builtin_amdgcn_fence(__ATOMIC_ACQUIRE, "agent");
            xb_add(&bar[XB_XGEN(b.x)], 1u);
            asm volatile("s_waitcnt vmcnt(0)" ::: "memory");
        } else {
            XB_SPIN(xb_ld(&bar[XB_XGEN(b.x)]) == gen, bar);
            __builtin_amdgcn_fence(__ATOMIC_ACQUIRE, "agent");
            asm volatile("s_waitcnt vmcnt(0)" ::: "memory");
        }
    }
    __syncthreads();
}

namespace pg8 {
constexpr int BM = 256, BK = 64, HALF = 128, HTB = HALF * BK * 2, STAGE_BYTES = 8 * HTB, NXCD = 8, WGM = 8;
__host__ __device__ __forceinline__ int lds_byte(int r, int c) { const int st = (r >> 4) * 2 + (c >> 5), rr = r & 15, cc = c & 31, ob = rr * 64 + cc * 2; return st * 1024 + (ob ^ (((ob >> 9) & 1) << 5)); }
__host__ __device__ __forceinline__ void stage_rc(int b, int& R, int& C) { const int st = b / 1024, sb = b % 1024, swz = sb ^ (((sb >> 9) & 1) << 5); R = (st >> 1) * 16 + swz / 64; C = (st & 1) * 32 + (swz % 64) / 2; }
__host__ __device__ __forceinline__ int perm32(int rho) { const int n = rho >> 4, i = rho & 15; return 8 * (i >> 2) + 4 * n + (i & 3); }
struct Unit { int pm, pn, e, nrows; };
struct StaticOrder {
    int nM, nN, nwg, G, c, dup;
    __device__ void init(int nM_, int nN_, int G_, int c_, int dup_ = 1) { nM = nM_; nN = nN_; nwg = nM * nN; G = G_; c = c_; dup = dup_; }
    __device__ bool next(int i, Unit& u) const {
        const long L0 = (long)i * G + c; if (L0 >= (long)nwg * dup) return false;
        const long L = L0 % nwg;
        int wgid = (int)L; { const int q = nwg / NXCD, r = nwg % NXCD, xcd = wgid % NXCD, off = wgid / NXCD; wgid = (xcd < r ? xcd * (q + 1) : r * (q + 1) + (xcd - r) * q) + off; }
        const int nig = WGM * nN, gid = wgid / nig, fm = gid * WGM, gsz = (nM - fm) < WGM ? (nM - fm) : WGM;
        u.pm = fm + ((wgid % nig) % gsz); u.pn = (wgid % nig) / gsz; u.e = 0; u.nrows = 256; return true;
    }
};

template <class Epi, class Sched, class AAddr, class BAddr>
__device__ __forceinline__ void gemm_phase(LAS unsigned char* lds, const int K, const Sched& S, const AAddr& AA, const BAddr& BA, const Epi& E) {
    constexpr bool GA = AAddr::GATHER;
    const int tid = threadIdx.x, wid = __builtin_amdgcn_readfirstlane(tid >> 6), lane = tid & 63, wr = wid >> 2, wc = wid & 3, fr = lane & 15, fq = lane >> 4;
    const int nt = K / BK;
    unsigned voffA[2], voffB[2];
#pragma unroll
    for (int i = 0; i < 2; ++i) { int R, C; stage_rc(tid * 16 + i * 8192, R, C); const int Rb = Epi::PERM ? ((R & ~31) + perm32(R & 31)) : R;
        voffA[i] = GA ? 0u : AA.lane_off(R, C); voffB[i] = (unsigned)(Rb * K + C) * 2u; }
    const size_t kstepA = (size_t)AA.kstep, kstepB = (size_t)(BK * 2);
    const size_t hstepB = (size_t)HALF * K * 2, hstepA = GA ? 0 : AA.hstep();
    const unsigned ldsw = (unsigned)wid * 1024u;
    const int aoff = lds_byte(wr * 64 + fr, fq * 8), boff = lds_byte(wc * 32 + fr, fq * 8);
#define PG8_SA(b, h) (((b) * 2 + (h)) * HTB)
#define PG8_SB(b, h) ((4 + (b) * 2 + (h)) * HTB)
#define PG8_STAGE(bufoff, gbase, voff) do { _Pragma("unroll") for (int _i = 0; _i < 2; ++_i) \
        __builtin_amdgcn_global_load_lds((const unsigned*)((const char*)(gbase) + (voff)[_i]), (LAS unsigned*)(lds + (bufoff) + ldsw + _i * 8192), 16, 0, 0); } while (0)
#define PG8_STA_CUR(bufoff, h, kb) do { if constexpr (GA) { if (h) PG8_STAGE(bufoff, baseA + (kb), cof1); else PG8_STAGE(bufoff, baseA + (kb), cof0); } \
        else PG8_STAGE(bufoff, cA + (h) * hstepA + (kb), voffA); } while (0)
#define PG8_STA_SEL(bufoff, h, kb) do { if constexpr (GA) { if (h) PG8_STAGE(bufoff, baseA + (kb), sof1); else PG8_STAGE(bufoff, baseA + (kb), sof0); } \
        else PG8_STAGE(bufoff, sA + (h) * hstepA + (kb), voffA); } while (0)
#define PG8_LDA(dst, b, h) do { _Pragma("unroll") for (int m = 0; m < 4; ++m) _Pragma("unroll") for (int k = 0; k < 2; ++k) dst[m][k] = *(const LAS bf16x8*)(lds + PG8_SA(b, h) + aoff + m * 2048 + k * 1024); } while (0)
#define PG8_LDB(dst, b, h) do { _Pragma("unroll") for (int n = 0; n < 2; ++n) _Pragma("unroll") for (int k = 0; k < 2; ++k) dst[n][k] = *(const LAS bf16x8*)(lds + PG8_SB(b, h) + boff + n * 2048 + k * 1024); } while (0)
#define PG8_MMA(ai, bj, At, Bt) do { __builtin_amdgcn_s_setprio(1); _Pragma("unroll") for (int m = 0; m < 4; ++m) _Pragma("unroll") for (int n = 0; n < 2; ++n) _Pragma("unroll") for (int k = 0; k < 2; ++k) \
        acc[ai][bj][m][n] = __builtin_amdgcn_mfma_f32_16x16x32_bf16(Bt[n][k], At[m][k], acc[ai][bj][m][n], 0, 0, 0); __builtin_amdgcn_s_setprio(0); } while (0)
#define PG8_WAIT_V(n) asm volatile("s_waitcnt vmcnt(" #n ")" ::: "memory")
#define PG8_WAIT_L(n) asm volatile("s_waitcnt lgkmcnt(" #n ")" ::: "memory")
#define PG8_BAR __builtin_amdgcn_s_barrier()
#define PG8_SCHED __builtin_amdgcn_sched_barrier(0)
#define PG8_GOFF(u, o0, o1) do { _Pragma("unroll") for (int _i = 0; _i < 2; ++_i) { int R_, C_; stage_rc(tid * 16 + _i * 8192, R_, C_); \
        o0[_i] = AA.row_off(u, R_) + (unsigned)C_ * 2u; o1[_i] = AA.row_off(u, R_ + HALF) + (unsigned)C_ * 2u; } } while (0)
    Unit cur, nxt; int ui = 0;
    if (!S.next(0, cur)) return;
    f32x4 acc[2][2][4][2];
#pragma unroll
    for (int a = 0; a < 2; ++a)
#pragma unroll
        for (int b = 0; b < 2; ++b)
#pragma unroll
            for (int m = 0; m < 4; ++m)
#pragma unroll
                for (int n = 0; n < 2; ++n) acc[a][b][m][n] = (f32x4){0.f, 0.f, 0.f, 0.f};
    bf16x8 At[4][2], B0[2][2], B1[2][2];
    const char* const baseA = GA ? (const char*)AA.base : nullptr;
    const char* cA = GA ? nullptr : (const char*)AA.unit_ptr(cur);
    unsigned cof0[2] = {0u, 0u}, cof1[2] = {0u, 0u}, nof0[2] = {0u, 0u}, nof1[2] = {0u, 0u};
    if constexpr (GA) PG8_GOFF(cur, cof0, cof1);
    const char* cB = (const char*)BA.ptr(cur);
    PG8_STAGE(PG8_SB(0, 0), cB, voffB); PG8_STA_CUR(PG8_SA(0, 0), 0, 0); PG8_STAGE(PG8_SB(0, 1), cB + hstepB, voffB); PG8_STA_CUR(PG8_SA(0, 1), 1, 0);
    if (wr == 1) PG8_BAR;
    PG8_WAIT_V(4); PG8_BAR;
    PG8_STAGE(PG8_SB(1, 0), cB + kstepB, voffB); PG8_STA_CUR(PG8_SA(1, 0), 0, kstepA); PG8_STAGE(PG8_SB(1, 1), cB + hstepB + kstepB, voffB);
    PG8_WAIT_V(6); PG8_BAR;
    for (;;) {
        const bool has_next = S.next(ui + 1, nxt);
        const char* nB = cB; const char* nA = cA;
        if (has_next) { nB = (const char*)BA.ptr(nxt); if constexpr (GA) PG8_GOFF(nxt, nof0, nof1); else nA = (const char*)AA.unit_ptr(nxt); }
        else { if constexpr (GA) {
#pragma unroll
            for (int i = 0; i < 2; ++i) { nof0[i] = cof0[i]; nof1[i] = cof1[i]; } } }
#pragma nounroll
        for (int t = 0; t < nt; t += 2) {
            const bool last = (t == nt - 2);
            const size_t k1 = (size_t)(t + 1) * kstepA, k2 = last ? 0 : (size_t)(t + 2) * kstepA, k3 = k2 + kstepA;
            const char* b2 = last ? nB : cB + (size_t)(t + 2) * kstepB; const char* b3 = b2 + kstepB;
            const char* sA = last ? nA : cA;
            unsigned sof0[2], sof1[2];
#pragma unroll
            for (int i = 0; i < 2; ++i) { sof0[i] = last ? nof0[i] : cof0[i]; sof1[i] = last ? nof1[i] : cof1[i]; }
            PG8_LDB(B0, 0, 0); PG8_SCHED; PG8_LDA(At, 0, 0); PG8_STA_CUR(PG8_SA(1, 1), 1, k1);
            PG8_WAIT_L(8); PG8_BAR; PG8_WAIT_L(0); PG8_MMA(0, 0, At, B0); PG8_BAR; PG8_SCHED;
            PG8_LDB(B1, 0, 1); PG8_STAGE(PG8_SB(0, 0), b2, voffB);
            PG8_BAR; PG8_WAIT_L(0); PG8_MMA(0, 1, At, B1); PG8_BAR;
            PG8_LDA(At, 0, 1); PG8_STA_SEL(PG8_SA(0, 0), 0, k2);
            PG8_BAR; PG8_WAIT_L(0); PG8_MMA(1, 0, At, B0); PG8_BAR; PG8_SCHED;
            PG8_STAGE(PG8_SB(0, 1), b2 + hstepB, voffB);
            PG8_WAIT_V(6); PG8_BAR; PG8_MMA(1, 1, At, B1); PG8_BAR;
            PG8_LDB(B0, 1, 0); PG8_SCHED; PG8_LDA(At, 1, 0); PG8_STA_SEL(PG8_SA(0, 1), 1, k2);
            PG8_WAIT_L(8); PG8_BAR; PG8_WAIT_L(0); PG8_MMA(0, 0, At, B0); PG8_BAR; PG8_SCHED;
            PG8_LDB(B1, 1, 1); PG8_STAGE(PG8_SB(1, 0), b3, voffB);
            PG8_BAR; PG8_WAIT_L(0); PG8_MMA(0, 1, At, B1); PG8_BAR;
            PG8_LDA(At, 1, 1); PG8_STA_SEL(PG8_SA(1, 0), 0, k3);
            PG8_BAR; PG8_WAIT_L(0); PG8_MMA(1, 0, At, B0); PG8_BAR; PG8_SCHED;
            PG8_STAGE(PG8_SB(1, 1), b3 + hstepB, voffB);
            PG8_WAIT_V(6); PG8_BAR; PG8_MMA(1, 1, At, B1); PG8_BAR;
        }
        E(acc, cur, wr, wc, fr, fq);
        if (!has_next) break;
#pragma unroll
        for (int a = 0; a < 2; ++a)
#pragma unroll
            for (int b = 0; b < 2; ++b)
#pragma unroll
                for (int m = 0; m < 4; ++m)
#pragma unroll
                    for (int n = 0; n < 2; ++n) acc[a][b][m][n] = (f32x4){0.f, 0.f, 0.f, 0.f};
        cur = nxt; cB = nB; cA = nA; ++ui;
        if constexpr (GA) {
#pragma unroll
            for (int i = 0; i < 2; ++i) { cof0[i] = nof0[i]; cof1[i] = nof1[i]; } }
    }
    PG8_WAIT_V(0);
    if (wr == 0) PG8_BAR;
    PG8_BAR;
#undef PG8_SA
#undef PG8_SB
#undef PG8_STAGE
#undef PG8_STA_CUR
#undef PG8_STA_SEL
#undef PG8_GOFF
#undef PG8_LDA
#undef PG8_LDB
#undef PG8_MMA
#undef PG8_WAIT_V
#undef PG8_WAIT_L
#undef PG8_BAR
#undef PG8_SCHED
}
}

constexpr int NWAVES = 8, NTHR = 512;
struct Args { const float* in[26]; float* out; unsigned char* ws; int ph_lo, ph_hi; unsigned repmask; int pad; };
struct Frame {
    LAS unsigned char* lds;
    int tid, lane, wave, G, bx;
    unsigned char* ws;
};

struct APlain { const void* base; unsigned kstep; unsigned ld2;
    static constexpr bool GATHER = false;
    __device__ __forceinline__ const void* unit_ptr(const pg8::Unit& u) const { return (const char*)base + (size_t)u.pm * 256 * ld2; }
    __device__ __forceinline__ unsigned lane_off(int R, int C) const { return (unsigned)R * ld2 + (unsigned)C * 2u; }
    __device__ __forceinline__ size_t hstep() const { return (size_t)128 * ld2; }
    __device__ __forceinline__ unsigned row_off(const pg8::Unit&, int) const { return 0u; } };
struct BPlain { const bf16* Bt; int K;
    __device__ __forceinline__ const void* ptr(const pg8::Unit& u) const { return Bt + (size_t)u.pn * 256 * K; } };

struct EpiZ {
    static constexpr bool PERM = true;
    bf16* ZA; bf16* ZG;
    __device__ __forceinline__ void operator()(const f32x4 (&acc)[2][2][4][2], const pg8::Unit& u, int wr, int wc, int fr, int fq) const {
        const bool gate = u.pn >= 11;
        bf16* base = gate ? ZG : ZA; const int ld = gate ? ZG_LD : ZA_LD; const int colt = gate ? (u.pn - 11) * 256 : u.pn * 256;
        const int row0 = u.pm * 256 + wr * 64 + fr, col0 = colt + wc * 32 + 8 * fq;
#pragma unroll
        for (int ai = 0; ai < 2; ++ai)
#pragma unroll
            for (int m = 0; m < 4; ++m) { bf16* rowp = base + (size_t)(row0 + ai * 128 + m * 16) * ld + col0;
#pragma unroll
                for (int bj = 0; bj < 2; ++bj) { f32x4 v0 = acc[ai][bj][m][0], v1 = acc[ai][bj][m][1];
                    if (gate) {
#pragma unroll
                        for (int j = 0; j < 4; ++j) { v0[j] = sigmoidf_(v0[j]); v1[j] = sigmoidf_(v1[j]); } }
                    u32x4 w; w.x = pk2(v0[0], v0[1]); w.y = pk2(v0[2], v0[3]); w.z = pk2(v1[0], v1[1]); w.w = pk2(v1[2], v1[3]);
                    *(u32x4*)(rowp + bj * 128) = w; } }
    }
};
template <int MODE> struct EpiGate {
    static constexpr bool PERM = true;
    const bf16* ZG; const bf16* T1; bf16* O;
    __device__ __forceinline__ void operator()(const f32x4 (&acc)[2][2][4][2], const pg8::Unit& u, int wr, int wc, int fr, int fq) const {
        const int row0 = u.pm * 256 + wr * 64 + fr, col0 = u.pn * 256 + wc * 32 + 8 * fq;
#pragma unroll
        for (int ai = 0; ai < 2; ++ai) {
            u32x4 gv[4][2], tv[4][2];
#pragma unroll
            for (int m = 0; m < 4; ++m)
#pragma unroll
                for (int bj = 0; bj < 2; ++bj) { const size_t r = (size_t)(row0 + ai * 128 + m * 16); const int c = col0 + bj * 128;
                    gv[m][bj] = *(const u32x4*)(ZG + r * ZG_LD + MODE * 1024 + c); if (MODE == 1) tv[m][bj] = *(const u32x4*)(T1 + r * 1024 + c); }
#pragma unroll
            for (int m = 0; m < 4; ++m)
#pragma unroll
                for (int bj = 0; bj < 2; ++bj) { asm volatile("" : "+v"(gv[m][bj])); if (MODE == 1) asm volatile("" : "+v"(tv[m][bj])); }
#pragma unroll
            for (int m = 0; m < 4; ++m) { const size_t r = (size_t)(row0 + ai * 128 + m * 16);
#pragma unroll
                for (int bj = 0; bj < 2; ++bj) { const int c = col0 + bj * 128; const u32x4 g = gv[m][bj];
                    const f32x4 v0 = acc[ai][bj][m][0], v1 = acc[ai][bj][m][1];
                    float o[8] = { v0[0] * bflo(g.x), v0[1] * bfhi(g.x), v0[2] * bflo(g.y), v0[3] * bfhi(g.y), v1[0] * bflo(g.z), v1[1] * bfhi(g.z), v1[2] * bflo(g.w), v1[3] * bfhi(g.w) };
                    if (MODE == 1) { const u32x4 t = tv[m][bj];
                        o[0] += bflo(t.x); o[1] += bfhi(t.x); o[2] += bflo(t.y); o[3] += bfhi(t.y); o[4] += bflo(t.z); o[5] += bfhi(t.z); o[6] += bflo(t.w); o[7] += bfhi(t.w); }
                    u32x4 w; w.x = pk2(o[0], o[1]); w.y = pk2(o[2], o[3]); w.z = pk2(o[4], o[5]); w.w = pk2(o[6], o[7]);
                    *(u32x4*)(O + r * 1024 + c) = w; } }
        }
    }
};
struct EpiRes {
    static constexpr bool PERM = true;
    const float* X; bf16* O;
    __device__ __forceinline__ void operator()(const f32x4 (&acc)[2][2][4][2], const pg8::Unit& u, int wr, int wc, int fr, int fq) const {
        const int row0 = u.pm * 256 + wr * 64 + fr, col0 = u.pn * 256 + wc * 32 + 8 * fq;
#pragma unroll
        for (int ai = 0; ai < 2; ++ai) {
            f32x4 xv[4][2][2];
#pragma unroll
            for (int m = 0; m < 4; ++m)
#pragma unroll
                for (int bj = 0; bj < 2; ++bj) { const size_t off = (size_t)(row0 + ai * 128 + m * 16) * D + col0 + bj * 128; xv[m][bj][0] = *(const f32x4*)(X + off); xv[m][bj][1] = *(const f32x4*)(X + off + 4); }
#pragma unroll
            for (int m = 0; m < 4; ++m)
#pragma unroll
                for (int bj = 0; bj < 2; ++bj) { asm volatile("" : "+v"(xv[m][bj][0])); asm volatile("" : "+v"(xv[m][bj][1])); }
#pragma unroll
            for (int m = 0; m < 4; ++m)
#pragma unroll
                for (int bj = 0; bj < 2; ++bj) { const size_t off = (size_t)(row0 + ai * 128 + m * 16) * D + col0 + bj * 128;
                    const f32x4 v0 = xv[m][bj][0] * ALPHA + acc[ai][bj][m][0], v1 = xv[m][bj][1] * ALPHA + acc[ai][bj][m][1];
                    u32x4 w; w.x = pk2(v0[0], v0[1]); w.y = pk2(v0[2], v0[3]); w.z = pk2(v1[0], v1[1]); w.w = pk2(v1[2], v1[3]);
                    *(u32x4*)(O + off) = w; }
        }
    }
};

template <class F>
__device__ __forceinline__ void p0_tile(const F& f, bf16* WT, int ldk, int k0, int n0, LAS float* scr, int lane) {
    if constexpr (F::FOLD) {
        float bc[64];
#pragma unroll
        for (int d = 0; d < 64; ++d) bc[d] = f.bval(k0, d, n0 + (lane & 31));
#pragma unroll 4
        for (int i = 0; i < 32; ++i) { const int kk = 2 * i + (lane >> 5); const f32x4* ar = (const f32x4*)f.arow(k0 + kk, n0); f32x4 a4 = {0.f, 0.f, 0.f, 0.f};
#pragma unroll
            for (int q = 0; q < 16; ++q) { const f32x4 av = ar[q]; a4[0] += av[0] * bc[4 * q]; a4[1] += av[1] * bc[4 * q + 1]; a4[2] += av[2] * bc[4 * q + 2]; a4[3] += av[3] * bc[4 * q + 3]; }
            scr[kk * 33 + (lane & 31)] = (a4[0] + a4[1]) + (a4[2] + a4[3]); }
    } else {
        float v[32];
#pragma unroll
        for (int i = 0; i < 32; ++i) { const int kk = 2 * i + (lane >> 5); v[i] = f(k0 + kk, n0 + (lane & 31)); }
#pragma unroll
        for (int i = 0; i < 32; ++i) { const int kk = 2 * i + (lane >> 5); scr[kk * 33 + (lane & 31)] = v[i]; }
    }
    LDS_WAIT(); asm volatile("" ::: "memory");
    const int c = lane & 7;
#pragma unroll
    for (int j = 0; j < 4; ++j) { const int n = (lane >> 3) + 8 * j; const LAS float* s = scr + (8 * c) * 33 + n;
        u32x4 o; o.x = pk2(s[0 * 33], s[1 * 33]); o.y = pk2(s[2 * 33], s[3 * 33]); o.z = pk2(s[4 * 33], s[5 * 33]); o.w = pk2(s[6 * 33], s[7 * 33]);
        *(u32x4*)(WT + (size_t)(n0 + n) * ldk + k0 + 8 * c) = o; }
    LDS_WAIT(); asm volatile("" ::: "memory");
}
struct P0Item { const float* src; int N, noff; bf16* dst; int ldk, k0, n0; };
__device__ __forceinline__ void p0_item_load(const P0Item& it, float (&v)[32], int lane) {
#pragma unroll
    for (int i = 0; i < 32; ++i) { const int kk = 2 * i + (lane >> 5); v[i] = it.src[(size_t)(it.k0 + kk) * it.N + it.n0 + (lane & 31) + it.noff]; }
}
__device__ __forceinline__ void p0_item_finish(const P0Item& it, const float (&v)[32], LAS float* scr, int lane) {
#pragma unroll
    for (int i = 0; i < 32; ++i) { const int kk = 2 * i + (lane >> 5); scr[kk * 33 + (lane & 31)] = v[i]; }
    LDS_WAIT(); asm volatile("" ::: "memory");
    const int c = lane & 7;
#pragma unroll
    for (int j = 0; j < 4; ++j) { const int n = (lane >> 3) + 8 * j; const LAS float* s = scr + (8 * c) * 33 + n;
        u32x4 o; o.x = pk2(s[0 * 33], s[1 * 33]); o.y = pk2(s[2 * 33], s[3 * 33]); o.z = pk2(s[4 * 33], s[5 * 33]); o.w = pk2(s[6 * 33], s[7 * 33]);
        *(u32x4*)(it.dst + (size_t)(it.n0 + n) * it.ldk + it.k0 + 8 * c) = o; }
    LDS_WAIT(); asm volatile("" ::: "memory");
}
__device__ __forceinline__ int zsrc_col(int n) {
    if (n < 1280) return n;
    if (n < 2304) return -2;
    if (n < 2432) return 1816 + (n - 2304);
    if (n < 2688) return 1944 + (n - 2432);
    if (n < 2752) return 2200 + (n - 2688);
    if (n < 2776) return 1280 + (n - 2752);
    if (n < 2780) return 2264 + (n - 2776);
    if (n < 2816) return -1;
    if (n < 3840) return 2268 + (n - 2816);
    return 3292 + (n - 3840);
}
struct FWin { const float* w_in; static constexpr bool FOLD = false;
    __device__ __forceinline__ float operator()(int k, int n) const { const int s = zsrc_col(n); return s >= 0 ? w_in[(size_t)k * D_IN + s] : 0.f; } };
struct FWinQ { const float* w_in; const float* w_uk; static constexpr bool FOLD = true;
    __device__ __forceinline__ const float* arow(int k, int n0) const { return w_in + (size_t)k * D_IN + 1304 + ((n0 - 1280) >> 7) * 64; }
    __device__ __forceinline__ float bval(int, int d, int n) const { return w_uk[(size_t)((n - 1280) >> 7) * 64 * 128 + d * 128 + ((n - 1280) & 127)]; }
    __device__ __forceinline__ float operator()(int, int) const { return 0.f; } };
struct FWb { const float* w_uv; const float* w_bb; static constexpr bool FOLD = true;
    __device__ __forceinline__ const float* arow(int k, int) const { return w_uv + (size_t)k * 64; }
    __device__ __forceinline__ float bval(int k0, int d, int n) const { return w_bb[(size_t)((k0 >> 7) * 64 + d) * D + n]; }
    __device__ __forceinline__ float operator()(int, int) const { return 0.f; } };
struct FPlain { const float* W; int N; static constexpr bool FOLD = false; __device__ __forceinline__ float operator()(int k, int n) const { return W[(size_t)k * N + n]; } };
struct FOff { const float* W; int N; int noff; static constexpr bool FOLD = false;
    __device__ __forceinline__ float operator()(int k, int n) const { return W[(size_t)k * N + n + noff]; } };

__device__ __forceinline__ float rel_bucket_bias(const float* rel_bias, int dist, int head) {
    int b;
    if (dist < 16) b = dist;
    else { const float t = (__log2f((float)dist) - 4.0f) * 2.66666675f; b = 16 + (int)t; if (b > 31) b = 31; }
    return rel_bias[b * 16 + head];
}

constexpr int P0_EXP_ITEMS = NEXP * ((1024 / 64) * (512 / 32) + (256 / 64) * (1024 / 32)), P0_EXP_SPLIT = (P0_EXP_ITEMS * 2) / 3;
__device__ __forceinline__ void p0_experts(const Frame& F, const Args& a, int wv, int nwv, int ibeg, int iend) {
    LAS float* scr = (LAS float*)(F.lds + F.wave * 16384);
    unsigned char* ws = F.ws;
    constexpr int I_GU = (1024 / 64) * (512 / 32), I_DN = (256 / 64) * (1024 / 32);
    const int gw = wv, NGW = nwv;
    {
        constexpr int NEI = NEXP * (I_GU + I_DN);
        auto mk = [&](int idx) { P0Item it; const int e = idx / (I_GU + I_DN); int r = idx - e * (I_GU + I_DN);
            if (r < I_GU) {
                const int n0 = (r % 16) * 32; const uintptr_t pg = (uintptr_t)a.in[21], pu = (uintptr_t)a.in[22];
                it.src = (const float*)(pg + (uintptr_t)((n0 >> 7) & 1) * (pu - pg)) + (size_t)e * D * DEXP; it.N = DEXP; it.noff = ((n0 >> 8) * 128 + (n0 & 127)) - n0;
                it.dst = (bf16*)(ws + WS_WGU) + (size_t)e * 512 * 1024; it.ldk = 1024; it.k0 = (r / 16) * 64; it.n0 = n0; }
            else { r -= I_GU; it.src = a.in[23] + (size_t)e * DEXP * D; it.N = D; it.noff = 0; it.dst = (bf16*)(ws + WS_WDT) + (size_t)e * 1024 * 256; it.ldk = 256; it.k0 = (r / 32) * 64; it.n0 = (r % 32) * 32; }
            return it; };
        float va[32], vb[32];
        {
        (void)NEI;
        int idx = ibeg + gw;
        if (idx < iend) { P0Item cur = mk(idx); p0_item_load(cur, va, F.lane);
            for (;;) {
                const int nidx = idx + NGW; const bool more = nidx < iend; P0Item nxt = cur;
                if (more) { nxt = mk(nidx); p0_item_load(nxt, vb, F.lane); }
                p0_item_finish(cur, va, scr, F.lane);
                if (!more) break;
#pragma unroll
                for (int i = 0; i < 32; ++i) va[i] = vb[i];
                cur = nxt; idx = nidx; } }
        }
    }
}
__device__ __forceinline__ void phase0(const Frame& F, const Args& a) {
    LAS float* scr = (LAS float*)(F.lds + F.wave * 16384);
    const int gw = F.bx * NWAVES + F.wave, NGW = F.G * NWAVES;
    unsigned char* ws = F.ws;
    constexpr int I_WIN = (D / 64) * (NZ / 32);
    constexpr int I_WB = (1024 / 64) * (1024 / 32);
    constexpr int I_WA = (512 / 64) * (1024 / 32);
    constexpr int I_WO = I_WB;
    constexpr int I_W1 = (2048 / 64) * (256 / 32);
    constexpr int I_W2 = (256 / 64) * (64 / 32);
    constexpr int I_GU = (1024 / 64) * (512 / 32);
    constexpr int I_DN = (256 / 64) * (1024 / 32);
    constexpr int NITEMS = I_WIN + I_WB + I_WA + I_WO + 2 * I_W1 + 2 * I_W2;
    (void)NITEMS;
    constexpr int I_WINP = (D / 64) * ((NZ - 1024) / 32);
    for (int it = gw; it < 1024; it += NGW) {
        if (it < 512) { const int k0 = (it >> 5) * 64, n0 = 1280 + (it & 31) * 32; const FWinQ f{a.in[1], a.in[9]}; p0_tile(f, (bf16*)(ws + WS_WINT), D, k0, n0, scr, F.lane); }
        else { const int r = it - 512; const FWb f{a.in[10], a.in[13]}; p0_tile(f, (bf16*)(ws + WS_WBT), 1024, (r / 32) * 64, (r % 32) * 32, scr, F.lane); }
    }
    { constexpr int NPL = I_WINP + I_WA + I_WO + 2 * I_W1 + 2 * I_W2;
      const int pw0 = NGW > 1024 ? (gw >= 1024 ? gw - 1024 : -1) : gw, pws = NGW > 1024 ? NGW - 1024 : NGW;
      if (pw0 >= 0) for (int it = pw0; it < NPL; it += pws) {
        int r = it;
        if (r < I_WINP) { const int k0 = (r / 120) * 64; int nb = r % 120; nb = nb < 40 ? nb : nb + 32; const FWin f{a.in[1]}; p0_tile(f, (bf16*)(ws + WS_WINT), D, k0, nb * 32, scr, F.lane); continue; } r -= I_WINP;
        if (r < I_WA) { const FPlain f{a.in[12], D}; p0_tile(f, (bf16*)(ws + WS_WAT), 512, (r / 32) * 64, (r % 32) * 32, scr, F.lane); continue; } r -= I_WA;
        if (r < I_WO) { const FPlain f{a.in[14], D}; p0_tile(f, (bf16*)(ws + WS_WOT), 1024, (r / 32) * 64, (r % 32) * 32, scr, F.lane); continue; } r -= I_WO;
        if (r < I_W1) { const FPlain f{a.in[4], 256}; p0_tile(f, (bf16*)(ws + WS_W1K), 2048, (r / 8) * 64, (r % 8) * 32, scr, F.lane); continue; } r -= I_W1;
        if (r < I_W1) { const FPlain f{a.in[6], 256}; p0_tile(f, (bf16*)(ws + WS_W1V), 2048, (r / 8) * 64, (r % 8) * 32, scr, F.lane); continue; } r -= I_W1;
        if (r < I_W2) { const FPlain f{a.in[5], 64}; p0_tile(f, (bf16*)(ws + WS_W2K), 256, (r / 2) * 64, (r % 2) * 32, scr, F.lane); continue; } r -= I_W2;
        { const FPlain f{a.in[7], 64}; p0_tile(f, (bf16*)(ws + WS_W2V), 256, (r / 2) * 64, (r % 2) * 32, scr, F.lane); }
      } }
    { const int nu = (NTOK / 256) * (NZ / 256); if ((nu % F.G) == 0) p0_experts(F, a, gw, NGW, 0, P0_EXP_ITEMS); }
    { const f32x4* x4 = (const f32x4*)a.in[0]; u32x2* o = (u32x2*)(ws + WS_XB);
      const size_t total = (size_t)NTOK * D / 4, stride = (size_t)F.G * NTHR;
      for (size_t i0 = (size_t)F.bx * NTHR + F.tid; i0 < total; i0 += 8 * stride) { f32x4 v[8];
#pragma unroll
          for (int j = 0; j < 8; ++j) { const size_t i = i0 + j * stride; v[j] = i < total ? x4[i] : (f32x4){0.f, 0.f, 0.f, 0.f}; }
#pragma unroll
          for (int j = 0; j < 8; ++j) { const size_t i = i0 + j * stride; if (i < total) { u32x2 w; w.x = pk2(v[j][0], v[j][1]); w.y = pk2(v[j][2], v[j][3]); o[i] = w; } } } }
    if (F.bx < 64 && F.tid < 256) {
        const int kv = F.bx >> 5, j = F.bx & 31;
        const float* pe = (kv ? a.in[3] : a.in[2]) + 64 * j; const float* w1 = (kv ? a.in[6] : a.in[4]) + (size_t)(64 * j) * 256 + F.tid; float acc = 0.f;
#pragma unroll 16
        for (int k = 0; k < 64; ++k) acc += pe[k] * w1[(size_t)k * 256];
        ((float*)(ws + WS_BIASK))[(kv * 32 + j) * 256 + F.tid] = acc;
    }
    if (F.bx >= 64 && F.bx < 96) { const int idx = (F.bx - 64) * NTHR + F.tid;
        const int tab = idx >> 13, head = (idx >> 10) & 7, dist = idx & 1023;
        ((float*)(ws + (tab ? WS_TBB : WS_TBA)))[head * 1024 + dist] = rel_bucket_bias(a.in[11], dist, tab * 8 + head) * LOG2E; }
}

constexpr int NRT = 36;
constexpr int P6_WR = 0;
constexpr int P6_CNT = 147456;
constexpr int P6_ENT = 147456 + 512;
__device__ __forceinline__ float row16_sum(float v) {
    v += __builtin_bit_cast(float, __builtin_amdgcn_update_dpp(0, __builtin_bit_cast(int, v), 0xB1, 0xf, 0xf, true));
    v += __builtin_bit_cast(float, __builtin_amdgcn_update_dpp(0, __builtin_bit_cast(int, v), 0x4E, 0xf, 0xf, true));
    v += __builtin_bit_cast(float, __builtin_amdgcn_update_dpp(0, __builtin_bit_cast(int, v), 0x141, 0xf, 0xf, true));
    v += __builtin_bit_cast(float, __builtin_amdgcn_update_dpp(0, __builtin_bit_cast(int, v), 0x140, 0xf, 0xf, true));
    return v;
}
__device__ __forceinline__ float wave_sum_dpp(float v) { v = row16_sum(v); v += __shfl_xor(v, 16); v += __shfl_xor(v, 32); return v; }
__device__ __forceinline__ void phase6(const Frame& F, const Args& a) {
    unsigned char* ws = F.ws;
    LAS float* WR = (LAS float*)(F.lds + P6_WR);
    LAS int* cntL = (LAS int*)(F.lds + P6_CNT); LAS int* baseL = cntL + 32;
    LAS int* ent = (LAS int*)(F.lds + P6_ENT);
    const float* w_grp = a.in[17]; const float* b_grp = a.in[18]; const float* w_rtr = a.in[19]; const float* b_rtr = a.in[20];
    {
        f32x4 wv[16], gv2[2];
#pragma unroll
        for (int i = 0; i < 16; ++i) wv[i] = *(const f32x4*)(w_rtr + 4 * (F.tid + NTHR * i));
#pragma unroll
        for (int i = 0; i < 2; ++i) gv2[i] = *(const f32x4*)(w_grp + 4 * (F.tid + NTHR * i));
#pragma unroll
        for (int i = 0; i < 16; ++i) { const int e = 4 * (F.tid + NTHR * i), k = e >> 5, o = e & 31;
#pragma unroll
            for (int c = 0; c < 4; ++c) WR[(4 + o + c) * 1024 + k] = wv[i][c]; }
#pragma unroll
        for (int i = 0; i < 2; ++i) { const int k = F.tid + NTHR * i;
#pragma unroll
            for (int c = 0; c < 4; ++c) WR[c * 1024 + k] = gv2[i][c]; }
    }
    if (F.tid < 65) cntL[F.tid] = 0;
    __syncthreads();
    const bf16* HP = (const bf16*)(ws + WS_H1); bf16* H1B = (bf16*)(ws + WS_H1B);
    const float* lg = a.in[15]; const float* lb = a.in[16];
    f32x2 gam[8], bet[8];
#pragma unroll
    for (int j = 0; j < 2; ++j)
#pragma unroll
        for (int q = 0; q < 4; ++q) { gam[4 * j + q] = *(const f32x2*)(lg + 512 * j + 8 * F.lane + 2 * q); bet[4 * j + q] = *(const f32x2*)(lb + 512 * j + 8 * F.lane + 2 * q); }
    unsigned* gcnt = (unsigned*)(ws + WS_CTL) + CW_CNT;
    int* list = (int*)(ws + WS_LIST); float* tokinfo = (float*)(ws + WS_TOKINFO);
    const int gw = F.bx * NWAVES + F.wave, NGW = F.G * NWAVES;
    u32x4 nx0, nx1;
    const int rpb = (NTOK + F.G - 1) / F.G, rbeg = F.bx * rpb, rend = (rbeg + rpb < NTOK) ? rbeg + rpb : NTOK;
    (void)gw; (void)NGW;
    if (rbeg + F.wave < rend) { const u32x4* hr = (const u32x4*)(HP + (size_t)(rbeg + F.wave) * D) + F.lane; nx0 = hr[0]; nx1 = hr[64]; }
    for (int row = rbeg + F.wave; row < rend; row += NWAVES) {
        const u32x4 r0 = nx0, r1 = nx1;
        if (row + NWAVES < rend) { const u32x4* hr = (const u32x4*)(HP + (size_t)(row + NWAVES) * D) + F.lane; nx0 = hr[0]; nx1 = hr[64]; }
        f32x2 v[8];
        v[0] = (f32x2){bflo(r0.x), bfhi(r0.x)}; v[1] = (f32x2){bflo(r0.y), bfhi(r0.y)}; v[2] = (f32x2){bflo(r0.z), bfhi(r0.z)}; v[3] = (f32x2){bflo(r0.w), bfhi(r0.w)};
        v[4] = (f32x2){bflo(r1.x), bfhi(r1.x)}; v[5] = (f32x2){bflo(r1.y), bfhi(r1.y)}; v[6] = (f32x2){bflo(r1.z), bfhi(r1.z)}; v[7] = (f32x2){bflo(r1.w), bfhi(r1.w)};
        f32x2 s2 = v[0];
#pragma unroll
        for (int q = 1; q < 8; ++q) s2 += v[q];
        const float mean = wave_sum_dpp(s2[0] + s2[1]) * (1.f / D);
        f32x2 q2 = {0.f, 0.f};
#pragma unroll
        for (int q = 0; q < 8; ++q) { v[q] = v[q] - mean; q2 += v[q] * v[q]; }
        const float rstd = 1.0f / sqrtf(wave_sum_dpp(q2[0] + q2[1]) * (1.f / D) + 1e-5f);
#pragma unroll
        for (int q = 0; q < 8; ++q) v[q] = v[q] * rstd * gam[q] + bet[q];
        { u32x4 w0, w1; w0.x = pk2(v[0][0], v[0][1]); w0.y = pk2(v[1][0], v[1][1]); w0.z = pk2(v[2][0], v[2][1]); w0.w = pk2(v[3][0], v[3][1]);
          w1.x = pk2(v[4][0], v[4][1]); w1.y = pk2(v[5][0], v[5][1]); w1.z = pk2(v[6][0], v[6][1]); w1.w = pk2(v[7][0], v[7][1]);
          u32x4* ob = (u32x4*)(H1B + (size_t)row * D) + F.lane; ob[0] = w0; ob[64] = w1; }
        auto rdot = [&](int o) { f32x2 p2 = {0.f, 0.f};
#pragma unroll
            for (int j = 0; j < 2; ++j) { const f32x4 wa = *(const LAS f32x4*)(WR + o * 1024 + 512 * j + 8 * F.lane), wb = *(const LAS f32x4*)(WR + o * 1024 + 512 * j + 8 * F.lane + 4);
                p2 += v[4 * j] * (f32x2){wa[0], wa[1]}; p2 += v[4 * j + 1] * (f32x2){wa[2], wa[3]}; p2 += v[4 * j + 2] * (f32x2){wb[0], wb[1]}; p2 += v[4 * j + 3] * (f32x2){wb[2], wb[3]}; }
            return row16_sum(p2[0] + p2[1]); };
        float g[4];
#pragma unroll
        for (int i = 0; i < 4; ++i) g[i] = rdot(i);
#pragma unroll
        for (int i = 0; i < 4; ++i) { float t = g[i]; t += __shfl_xor(t, 16); t += __shfl_xor(t, 32); g[i] = t + b_grp[i]; }
        int gs = 0; float gm = g[0];
#pragma unroll
        for (int i = 1; i < 4; ++i) if (g[i] > gm) { gm = g[i]; gs = i; }
        gs = __builtin_amdgcn_readfirstlane(gs);
        float gsum = 0.f;
#pragma unroll
        for (int i = 0; i < 4; ++i) gsum += __expf(g[i] - gm);
        const float pgrp = 1.0f / gsum;
        float el[8];
#pragma unroll
        for (int i = 0; i < 8; ++i) el[i] = rdot(4 + gs * 8 + i);
#pragma unroll
        for (int i = 0; i < 8; ++i) { float t = el[i]; t += __shfl_xor(t, 16); t += __shfl_xor(t, 32); el[i] = t + b_rtr[gs * 8 + i]; }
        int i1 = 0; float l1 = el[0];
#pragma unroll
        for (int i = 1; i < 8; ++i) if (el[i] > l1) { l1 = el[i]; i1 = i; }
        int i2 = -1; float l2 = -3.0e38f;
#pragma unroll
        for (int i = 0; i < 8; ++i) if (i != i1 && el[i] > l2) { l2 = el[i]; i2 = i; }
        const float e2 = __expf(l2 - l1), inv = 1.0f / (1.0f + e2);
        const float w0 = pgrp * inv, w1 = pgrp * e2 * inv;
        const int e0 = gs * 8 + i1, e1 = gs * 8 + i2;
        if (F.lane == 0) {
            const int p0 = atomicAdd((int*)&cntL[e0], 1), p1 = atomicAdd((int*)&cntL[e1], 1);
            const int n0 = atomicAdd((int*)&cntL[64], 2);
            ent[2 * n0] = (e0 << 16) | p0; ent[2 * n0 + 1] = row * 2;
            ent[2 * n0 + 2] = (e1 << 16) | p1; ent[2 * n0 + 3] = row * 2 + 1;
            tokinfo[row * 2] = w0; tokinfo[row * 2 + 1] = w1;
        }
    }
    __syncthreads();
    if (F.tid < 32) { const int c = cntL[F.tid]; baseL[F.tid] = c > 0 ? (int)__hip_atomic_fetch_add(gcnt + 64 * F.tid, (unsigned)c, __ATOMIC_RELAXED, __HIP_MEMORY_SCOPE_AGENT) : 0; }
    __syncthreads();
    const int nent = cntL[64];
    for (int i = F.tid; i < nent; i += NTHR) { const int ep = ent[2 * i], tk = ent[2 * i + 1]; const int e = ep >> 16, p = ep & 0xffff; list[(size_t)e * NTOK + baseL[e] + p] = tk; }
    __syncthreads();
}

constexpr int MOE_CUM = 131072;
struct MoeOrder {
    int G, c, NP; const LAS int* cum; const LAS int* cnt;
    __device__ bool next(int i, pg8::Unit& u) const {
        const int L = i * G + c, t = L / NP; if (t >= cum[32]) return false;
        const int e = cum[80 + t];
        const int j = t - cum[e]; u.pm = t; u.pn = L % NP; u.e = e | (j << 8); const int rem = cnt[e] - j * 256; u.nrows = rem < 256 ? rem : 256; return true;
    }
};
__device__ __forceinline__ void moe_setup(const Frame& F) {
    LAS int* cum = (LAS int*)(F.lds + MOE_CUM); LAS int* cnt = cum + 40;
    const unsigned* gcnt = (const unsigned*)(F.ws + WS_CTL) + CW_CNT;
    if (F.tid < 32) cnt[F.tid] = (int)__hip_atomic_load(gcnt + 64 * F.tid, __ATOMIC_RELAXED, __HIP_MEMORY_SCOPE_AGENT);
    __syncthreads();
    if (F.tid == 0) { int s = 0; for (int e = 0; e < 32; ++e) { cum[e] = s; s += (cnt[e] + 255) >> 8; } cum[32] = s; }
    __syncthreads();
    for (int t = F.tid; t < cum[32]; t += NTHR) { int e = 0; for (int k = 1; k < 32; ++k) if (t >= cum[k]) e = k; cum[80 + t] = e; }
    __syncthreads();
}
struct AGather { const void* base; unsigned kstep; const int* list;
    static constexpr bool GATHER = true;
    __device__ __forceinline__ const void* unit_ptr(const pg8::Unit&) const { return base; }
    __device__ __forceinline__ unsigned lane_off(int, int) const { return 0u; }
    __device__ __forceinline__ size_t hstep() const { return 0; }
    __device__ __forceinline__ unsigned row_off(const pg8::Unit& u, int r) const { const int e = u.e & 255, j = u.e >> 8; const int rr = r < u.nrows ? r : 0;
        const int tk = list[(size_t)e * NTOK + j * 256 + rr]; return (unsigned)(tk >> 1) * (unsigned)(D * 2); } };
struct BGu { const bf16* W; __device__ __forceinline__ const void* ptr(const pg8::Unit& u) const { return W + (size_t)(u.e & 255) * 512 * 1024 + (size_t)u.pn * 256 * 1024; } };
struct BDn { const bf16* W; __device__ __forceinline__ const void* ptr(const pg8::Unit& u) const { return W + (size_t)(u.e & 255) * 1024 * 256 + (size_t)u.pn * 256 * 256; } };
struct EpiAct {
    static constexpr bool PERM = true; bf16* ACT;
    __device__ __forceinline__ void operator()(const f32x4 (&acc)[2][2][4][2], const pg8::Unit& u, int wr, int wc, int fr, int fq) const {
        const int row0 = u.pm * 256 + wr * 64 + fr, col0 = u.pn * 128 + wc * 32 + 8 * fq;
#pragma unroll
        for (int ai = 0; ai < 2; ++ai)
#pragma unroll
            for (int m = 0; m < 4; ++m) { float o[8];
#pragma unroll
                for (int n = 0; n < 2; ++n)
#pragma unroll
                    for (int j = 0; j < 4; ++j) { const float gt = acc[ai][0][m][n][j], up = acc[ai][1][m][n][j]; o[4 * n + j] = gt * sigmoidf_(gt) * up; }
                u32x4 w; w.x = pk2(o[0], o[1]); w.y = pk2(o[2], o[3]); w.z = pk2(o[4], o[5]); w.w = pk2(o[6], o[7]);
                *(u32x4*)(ACT + (size_t)(row0 + ai * 128 + m * 16) * DEXP + col0) = w; }
    }
};
struct EpiDown {
    static constexpr bool PERM = true; bf16* Y; const int* list;
    __device__ __forceinline__ void operator()(const f32x4 (&acc)[2][2][4][2], const pg8::Unit& u, int wr, int wc, int fr, int fq) const {
        const int e = u.e & 255, j = u.e >> 8; const int col0 = u.pn * 256 + wc * 32 + 8 * fq;
        int tks[2][4];
#pragma unroll
        for (int ai = 0; ai < 2; ++ai)
#pragma unroll
            for (int m = 0; m < 4; ++m) { const int r = ai * 128 + wr * 64 + m * 16 + fr; tks[ai][m] = r < u.nrows ? list[(size_t)e * NTOK + j * 256 + r] : -1; }
#pragma unroll
        for (int ai = 0; ai < 2; ++ai)
#pragma unroll
            for (int m = 0; m < 4; ++m) { const int tk = tks[ai][m];
                if (tk >= 0) { bf16* rowp = Y + (size_t)tk * D + col0;
#pragma unroll
                    for (int bj = 0; bj < 2; ++bj) { const f32x4 v0 = acc[ai][bj][m][0], v1 = acc[ai][bj][m][1];
                        u32x4 w; w.x = pk2(v0[0], v0[1]); w.y = pk2(v0[2], v0[3]); w.z = pk2(v1[0], v1[1]); w.w = pk2(v1[2], v1[3]);
                        *(u32x4*)(rowp + bj * 128) = w; } } }
    }
};

__device__ __forceinline__ void phase9(const Frame& F, const Args& a) {
    unsigned char* ws = F.ws;
    const bf16* H1B = (const bf16*)(ws + WS_H1B); const bf16* Y = (const bf16*)(ws + WS_YBUF); const float* tokinfo = (const float*)(ws + WS_TOKINFO);
    const float* lg = a.in[24]; const float* lb = a.in[25];
    f32x4 gam[4], bet[4];
#pragma unroll
    for (int j = 0; j < 2; ++j) { gam[2 * j] = *(const f32x4*)(lg + 512 * j + 8 * F.lane); gam[2 * j + 1] = *(const f32x4*)(lg + 512 * j + 8 * F.lane + 4); bet[2 * j] = *(const f32x4*)(lb + 512 * j + 8 * F.lane); bet[2 * j + 1] = *(const f32x4*)(lb + 512 * j + 8 * F.lane + 4); }
    const int gw = F.bx * NWAVES + F.wave, NGW = F.G * NWAVES;
    u32x4 nh[2], ny0[2], ny1[2]; float nw0 = 0.f, nw1 = 0.f;
#define P9_LOAD(row_) do { const u32x4* hp_ = (const u32x4*)(H1B + (size_t)(row_) * D) + F.lane; const u32x4* y0_ = (const u32x4*)(Y + (size_t)((row_) * 2) * D) + F.lane; const u32x4* y1_ = (const u32x4*)(Y + (size_t)((row_) * 2 + 1) * D) + F.lane; \
        nh[0] = hp_[0]; nh[1] = hp_[64]; ny0[0] = y0_[0]; ny0[1] = y0_[64]; ny1[0] = y1_[0]; ny1[1] = y1_[64]; nw0 = tokinfo[(row_) * 2]; nw1 = tokinfo[(row_) * 2 + 1]; } while (0)
    if (gw < NTOK) P9_LOAD(gw);
    for (int row = gw; row < NTOK; row += NGW) {
        u32x4 h[2] = {nh[0], nh[1]}, p[2] = {ny0[0], ny0[1]}, q[2] = {ny1[0], ny1[1]}; const float w0 = nw0, w1 = nw1;
        if (row + NGW < NTOK) P9_LOAD(row + NGW);
        f32x4 v[4]; float s = 0.f;
#pragma unroll
        for (int j = 0; j < 2; ++j) {
            v[2 * j][0] = ALPHA * bflo(h[j].x) + w0 * bflo(p[j].x) + w1 * bflo(q[j].x); v[2 * j][1] = ALPHA * bfhi(h[j].x) + w0 * bfhi(p[j].x) + w1 * bfhi(q[j].x);
            v[2 * j][2] = ALPHA * bflo(h[j].y) + w0 * bflo(p[j].y) + w1 * bflo(q[j].y); v[2 * j][3] = ALPHA * bfhi(h[j].y) + w0 * bfhi(p[j].y) + w1 * bfhi(q[j].y);
            v[2 * j + 1][0] = ALPHA * bflo(h[j].z) + w0 * bflo(p[j].z) + w1 * bflo(q[j].z); v[2 * j + 1][1] = ALPHA * bfhi(h[j].z) + w0 * bfhi(p[j].z) + w1 * bfhi(q[j].z);
            v[2 * j + 1][2] = ALPHA * bflo(h[j].w) + w0 * bflo(p[j].w) + w1 * bflo(q[j].w); v[2 * j + 1][3] = ALPHA * bfhi(h[j].w) + w0 * bfhi(p[j].w) + w1 * bfhi(q[j].w); }
#pragma unroll
        for (int j = 0; j < 4; ++j) s += (v[j][0] + v[j][1]) + (v[j][2] + v[j][3]);
        const float mean = wave_sum_dpp(s) * (1.f / D); float s2 = 0.f;
#pragma unroll
        for (int j = 0; j < 4; ++j) { v[j] = v[j] - mean; s2 += (v[j][0] * v[j][0] + v[j][1] * v[j][1]) + (v[j][2] * v[j][2] + v[j][3] * v[j][3]); }
        const float rstd = 1.0f / sqrtf(wave_sum_dpp(s2) * (1.f / D) + 1e-5f);
        float* orow = a.out + (size_t)row * D + 8 * F.lane;
#pragma unroll
        for (int j = 0; j < 2; ++j) { *(f32x4*)(orow + 512 * j) = v[2 * j] * rstd * gam[2 * j] + bet[2 * j]; *(f32x4*)(orow + 512 * j + 4) = v[2 * j + 1] * rstd * gam[2 * j + 1] + bet[2 * j + 1]; }
    }
#undef P9_LOAD
}
#define MFMA32(a, b, c) __builtin_amdgcn_mfma_f32_32x32x16_bf16((a), (b), (c), 0, 0, 0)
__device__ __forceinline__ int crow(int r, int hi) { return (r & 3) + 8 * (r >> 2) + 4 * hi; }
__device__ __forceinline__ float gelu_tanh(float x) { const float u = 0.7978845608028654f * (x + 0.044715f * x * x * x); const float e = __builtin_amdgcn_exp2f(2.885390081777927f * u); return 0.5f * x * (2.0f - 2.0f * __builtin_amdgcn_rcpf(e + 1.0f)); }
constexpr int P2_AROW = 4096 + 16;
constexpr int P2_HID = 32 * P2_AROW;
constexpr int P2_HROW = 512 + 16;
__device__ __forceinline__ void phase2(const Frame& F, const Args& a) {
    unsigned char* ws = F.ws;
    const bf16* ZA = (const bf16*)(ws + WS_ZA);
    { const float* gn = a.in[8]; bf16* CK = (bf16*)(ws + WS_CKVN);
      const int sub = F.lane >> 4, l16 = F.lane & 15;
      float gv[8];
#pragma unroll
      for (int j = 0; j < 8; ++j) gv[j] = gn[l16 * 8 + j];
      const int r4b = F.bx * NWAVES + F.wave, r4s = F.G * NWAVES;
      for (int r4 = r4b; r4 < NTOK / 4; r4 += 4 * r4s) { u32x4 wv[4];
#pragma unroll
          for (int t = 0; t < 4; ++t) { const int rr = r4 + t * r4s; const int row = (rr < NTOK / 4 ? rr : r4) * 4 + sub; wv[t] = *(const u32x4*)(ZA + (size_t)row * ZA_LD + ZC_CKV + l16 * 8); }
#pragma unroll
          for (int t = 0; t < 4; ++t) { const int rr = r4 + t * r4s; if (rr < NTOK / 4) { const int row = rr * 4 + sub; const u32x4 w = wv[t];
              float v[8] = { bflo(w.x), bfhi(w.x), bflo(w.y), bfhi(w.y), bflo(w.z), bfhi(w.z), bflo(w.w), bfhi(w.w) };
              float s2 = 0.f;
#pragma unroll
              for (int j = 0; j < 8; ++j) s2 += v[j] * v[j];
              s2 += __shfl_xor(s2, 1); s2 += __shfl_xor(s2, 2); s2 += __shfl_xor(s2, 4); s2 += __shfl_xor(s2, 8);
              const float rs = 1.0f / sqrtf(s2 * (1.0f / 128.0f) + 1e-6f);
              u32x4 o; o.x = pk2(v[0] * rs * gv[0], v[1] * rs * gv[1]); o.y = pk2(v[2] * rs * gv[2], v[3] * rs * gv[3]); o.z = pk2(v[4] * rs * gv[4], v[5] * rs * gv[5]); o.w = pk2(v[6] * rs * gv[6], v[7] * rs * gv[7]);
              *(u32x4*)(CK + (size_t)row * 128 + l16 * 8) = o; } } } }
    const int r32 = F.lane & 31, hi = F.lane >> 5;
    for (int u = F.bx; u < 256; u += F.G) {
        const int kv = u >> 7, rt = u & 127, R0 = rt * 32;
        const int zc = kv ? ZC_VC : ZC_KC;
        const bf16* W1T = (const bf16*)(ws + (kv ? WS_W1V : WS_W1K)); const bf16* W2T = (const bf16*)(ws + (kv ? WS_W2V : WS_W2K));
        const float* bias = (const float*)(ws + WS_BIASK) + (size_t)kv * 32 * 256;
        bf16* OUT = (bf16*)(ws + (kv ? WS_VCMP : WS_KCMP));
        __syncthreads();
        { u32x4 av[16];
#pragma unroll
          for (int i = 0; i < 16; ++i) { const int q = F.tid + NTHR * i; const int row = q >> 8, cq = q & 255, l = cq >> 3, dch = cq & 7;
              const int R = R0 + row, b = R >> 9, c = (R >> 1) & 255, g = R & 1; const int cc = c < NCMP ? c : NCMP - 1;
              av[i] = *(const u32x4*)(ZA + (size_t)(b * SEQ + 16 * cc + l) * ZA_LD + zc + g * 64 + dch * 8); }
#pragma unroll
          for (int i = 0; i < 16; ++i) { const int q = F.tid + NTHR * i; const int row = q >> 8, cq = q & 255; *(LAS u32x4*)(F.lds + row * P2_AROW + cq * 16) = av[i]; } }
        __syncthreads();
        f32x16 acc = {};
        { const bf16* bp = W1T + (size_t)(32 * F.wave + r32) * 2048 + 8 * hi; const LAS unsigned char* ap = F.lds + r32 * P2_AROW + 16 * hi;
          f32x16 acc1 = {};
#pragma unroll 1
          for (int s0 = 0; s0 < 128; s0 += 32) { bf16x8 bfr[32];
#pragma unroll
              for (int j = 0; j < 32; ++j) bfr[j] = *(const bf16x8*)(bp + (s0 + j) * 16);
#pragma unroll
              for (int j = 0; j < 32; j += 2) { const bf16x8 a0 = *(const LAS bf16x8*)(ap + (s0 + j) * 32), a1 = *(const LAS bf16x8*)(ap + (s0 + j + 1) * 32); acc = MFMA32(a0, bfr[j], acc); acc1 = MFMA32(a1, bfr[j + 1], acc1); } }
#pragma unroll
          for (int i = 0; i < 16; ++i) acc[i] += acc1[i]; }
        { float bs = 0.f;
#pragma unroll 8
          for (int j = 0; j < 32; ++j) bs += bias[j * 256 + 32 * F.wave + r32];
#pragma unroll
          for (int i = 0; i < 16; ++i) { const float h = gelu_tanh(acc[i] + bs); *(LAS unsigned short*)(F.lds + P2_HID + crow(i, hi) * P2_HROW + (32 * F.wave + r32) * 2) = (unsigned short)f2bf(h); } }
        __syncthreads();
        if (F.wave < 2) {
            f32x16 o2 = {};
            const bf16* bp = W2T + (size_t)(32 * F.wave + r32) * 256 + 8 * hi; const LAS unsigned char* ap = F.lds + P2_HID + r32 * P2_HROW + 16 * hi;
#pragma unroll
            for (int s = 0; s < 16; ++s) { const bf16x8 af = *(const LAS bf16x8*)(ap + s * 32); const bf16x8 bfr = *(const bf16x8*)(bp + s * 16); o2 = MFMA32(af, bfr, o2); }
#pragma unroll
            for (int i = 0; i < 16; ++i) OUT[(size_t)(R0 + crow(i, hi)) * 64 + 32 * F.wave + r32] = (bf16)f2bf(o2[i]);
        }
    }
    __syncthreads();
}

typedef short v4i16_t __attribute__((ext_vector_type(4)));
__device__ __forceinline__ s16x4 vtr(const LAS unsigned char* p) { return __builtin_bit_cast(s16x4, __builtin_amdgcn_ds_read_tr16_b64_v4i16((LAS v4i16_t*)p)); }
constexpr int NSA_K = 0;
constexpr int NSA_V = 16384;
constexpr int NSA_TB = 49152;
constexpr int NSA_SC = 65536;
constexpr int NSA_MSK = 81920;
constexpr int NSA_OF = 83968;
constexpr float C2 = 0.125f * LOG2E;

__device__ __forceinline__ float halfmax(float v) { return fmaxf(v, __shfl_xor(v, 32)); }
__device__ __forceinline__ void nsa_tile(const bool nc4, const LAS unsigned char* Kb, const LAS unsigned char* Vb, const LAS float* tbh, const bf16x8 (&qr)[4], f32x16 (&o)[4], float& m, float& l,
                                         int kt, int tq, int kmul, int kadd, int dmax, bool selbit, int mode, float b31, int r32, int hi, int lane) {
    const int tqa = tq - kadd, qk = kmul == 16 ? (tqa >> 4) : tqa, rem = kmul == 16 ? (tqa & 15) : 0;
    const int ebase = qk - (kt * 64 + 4 * hi);
    const LAS unsigned char* vp0 = Vb + ((lane >> 4) & 1) * 32 + (lane & 3) * 8 + (4 * hi + ((lane & 15) >> 2)) * 64;
    bf16x8 kf[2][4];
#pragma unroll
    for (int hf = 0; hf < 2; ++hf)
#pragma unroll
        for (int d0 = 0; d0 < 4; ++d0) kf[hf][d0] = *(const LAS bf16x8*)(Kb + (2 * d0 + hi) * 1024 + (r32 + 32 * hf) * 16);
#pragma unroll
    for (int hf = 0; hf < 2; ++hf) {
        f32x16 s0 = {};
#pragma unroll
        for (int d0 = 0; d0 < 4; ++d0) asm volatile("" : "+v"(kf[hf][d0]));
#pragma unroll
        for (int d0 = 0; d0 < 4; ++d0) s0 = MFMA32(kf[hf][d0], qr[d0], s0);
        s16x4 vfl[4][2], vfh[4][2];
#pragma unroll
        for (int c = 0; c < 4; ++c) if (c < 2 || nc4)
#pragma unroll
            for (int s2 = 0; s2 < 2; ++s2) { const int s = 2 * hf + s2; vfl[c][s2] = vtr(vp0 + c * 4096 + s * 1024); vfh[c][s2] = vtr(vp0 + c * 4096 + s * 1024 + 512); }
        float tmax, mn, ps = 0.f;
        if (mode == 2) {
            float a0 = fmaxf(fmaxf(s0[0], s0[1]), s0[2]), a1 = fmaxf(fmaxf(s0[3], s0[4]), s0[5]);
            a0 = fmaxf(fmaxf(a0, s0[6]), s0[7]); a1 = fmaxf(fmaxf(a1, s0[8]), s0[9]); a0 = fmaxf(fmaxf(a0, s0[10]), s0[11]); a1 = fmaxf(fmaxf(a1, s0[12]), s0[13]); a0 = fmaxf(fmaxf(a0, s0[14]), s0[15]);
            const float cb = selbit ? b31 : NEGBIG;
            tmax = fmaxf(a0, a1) * C2 + cb;
            tmax = halfmax(tmax);
            mn = fmaxf(m, tmax);
            const float cc = cb - mn;
#pragma unroll
            for (int r = 0; r < 16; ++r) { const float p0 = __builtin_amdgcn_exp2f(s0[r] * C2 + cc); s0[r] = p0; ps += p0; }
        } else if (mode == 1) {
            int eb1 = ebase; asm volatile("" : "+v"(eb1));
            const LAS float* tb1 = tbh + (eb1 - 96);
            float bv[16];
#pragma unroll
            for (int r = 0; r < 16; ++r) bv[r] = tb1[96 - ((r & 3) + 8 * (r >> 2) + 32 * hf)];
#pragma unroll
            for (int r = 0; r < 16; ++r) asm volatile("" : "+v"(bv[r]));
            tmax = NEGBIG;
#pragma unroll
            for (int r = 0; r < 16; ++r) { const float x = s0[r] * C2 + bv[r]; s0[r] = x; tmax = fmaxf(tmax, x); }
            tmax = selbit ? tmax : NEGBIG;
            tmax = halfmax(tmax);
            mn = fmaxf(m, tmax);
            const float mne = selbit ? mn : 1e30f;
#pragma unroll
            for (int r = 0; r < 16; ++r) { const float p0 = __builtin_amdgcn_exp2f(s0[r] - mne); s0[r] = p0; ps += p0; }
        } else {
            tmax = NEGBIG;
            float bv[16];
            int eb0 = ebase; asm volatile("" : "+v"(eb0));
#pragma unroll
            for (int r = 0; r < 16; ++r) { const int dist = __mul24(eb0 - ((r & 3) + 8 * (r >> 2) + 32 * hf), kmul) + rem; int dc = dist < 0 ? 0 : dist; dc = dc > 1023 ? 1023 : dc; bv[r] = tbh[dc]; }
#pragma unroll
            for (int r = 0; r < 16; ++r) asm volatile("" : "+v"(bv[r]));
#pragma unroll
            for (int r = 0; r < 16; ++r) { const int dist = __mul24(eb0 - ((r & 3) + 8 * (r >> 2) + 32 * hf), kmul) + rem;
                const bool valid = selbit && dist >= 0 && dist < dmax;
                const float x = valid ? s0[r] * C2 + bv[r] : NEGBIG;
                s0[r] = x; tmax = fmaxf(tmax, x); }
            tmax = halfmax(tmax);
            mn = fmaxf(m, tmax);
#pragma unroll
            for (int r = 0; r < 16; ++r) { const float p0 = s0[r] > -1e29f ? __builtin_amdgcn_exp2f(s0[r] - mn) : 0.f; s0[r] = p0; ps += p0; }
        }
        if (__any(mn != m)) {
            const float alpha = __builtin_amdgcn_exp2f(m - mn);
            l *= alpha;
#pragma unroll
            for (int c = 0; c < 4; ++c) if (c < 2 || nc4) {
#pragma unroll
                for (int r = 0; r < 16; ++r) o[c][r] *= alpha; }
        }
        m = mn;
        l += ps;
        u32x4 pw[2];
#pragma unroll
        for (int q = 0; q < 4; ++q) { pw[0][q] = pk2(s0[2 * q], s0[2 * q + 1]); pw[1][q] = pk2(s0[8 + 2 * q], s0[8 + 2 * q + 1]); }
#pragma unroll
        for (int c = 0; c < 4; ++c) if (c < 2 || nc4)
#pragma unroll
            for (int s2 = 0; s2 < 2; ++s2) { const s16x4 vl = vfl[c][s2], vh = vfh[c][s2];
                const bf16x8 vf = {vl[0], vl[1], vl[2], vl[3], vh[0], vh[1], vh[2], vh[3]};
                o[c] = MFMA32(vf, __builtin_bit_cast(bf16x8, pw[s2]), o[c]); }
    }
}

__device__ __forceinline__ void nsa_unit(const Frame& F, int b, int g, int qt) {
    unsigned char* ws = F.ws;
    const bf16* ZA = (const bf16*)(ws + WS_ZA);
    const int r32 = F.lane & 31, hi = F.lane >> 5, qi = r32 >> 2, hh = r32 & 3, head = g * 4 + hh;
    const int q0 = qt * 64, tq = q0 + 8 * F.wave + qi;
    const size_t zrow = (size_t)(b * SEQ + tq) * ZA_LD;
    const int srow = F.tid >> 3, sch = F.tid & 7;
    const f32x4* TBA4 = (const f32x4*)((const float*)(ws + WS_TBA) + (size_t)g * 4 * 1024);
    const f32x4 tbv0 = TBA4[F.tid], tbv1 = TBA4[F.tid + NTHR];
    const LAS float* tbh = (const LAS float*)(F.lds + NSA_TB) + hh * 1024;
    const int wq0 = q0 + 8 * F.wave;
    const float b31 = ((const float*)(ws + WS_TBA))[(size_t)head * 1024 + 1023];
    bf16x8 qr[4];
#pragma unroll
    for (int d0 = 0; d0 < 4; ++d0) qr[d0] = *(const bf16x8*)(ZA + zrow + ZC_QA + head * 64 + d0 * 16 + hi * 8);
    unsigned short graw[3];
#pragma unroll
    for (int i = 0; i < 3; ++i) graw[i] = ZA[zrow + ZC_GNSA + head * 3 + i];
    { LAS f32x4* tb4 = (LAS f32x4*)(F.lds + NSA_TB); tb4[F.tid] = tbv0; tb4[F.tid + NTHR] = tbv1; }
    float gate[3];
#pragma unroll
    for (int i = 0; i < 3; ++i) gate[i] = sigmoidf_(bf2f(graw[i]));
    LAS float* ofw = (LAS float*)(F.lds + NSA_OF) + F.wave * 2048 + F.lane;
    unsigned mlo = 0u, mhi = 0u;
    u32x4 kreg, vreg = {0u, 0u, 0u, 0u};
    const bf16* kgp; size_t vdel, tstep;
#define NSA_SETUP(br_) do { const int b_ = (br_); const bf16* Kg_; size_t pitch_; int tl_; \
        if (b_ == 0) { Kg_ = (const bf16*)(ws + WS_KCMP) + (size_t)(b * 256) * 128 + g * 64; vdel = (size_t)((const bf16*)(ws + WS_VCMP) - (const bf16*)(ws + WS_KCMP)); pitch_ = 128; tl_ = 0; } \
        else { Kg_ = ZA + (size_t)(b * SEQ) * ZA_LD + (b_ == 1 ? ZC_KS : ZC_KW) + g * 64; vdel = 128; pitch_ = ZA_LD; tl_ = (b_ == 2 && qt > 8) ? qt - 8 : 0; } \
        kgp = Kg_ + (size_t)(tl_ * 64 + srow) * pitch_ + sch * 8; tstep = (size_t)64 * pitch_; } while (0)
#define NSA_GLOAD(kt_) do { kreg = *(const u32x4*)kgp; vreg = *(const u32x4*)(kgp + vdel); kgp += tstep; } while (0)
    NSA_SETUP(0); NSA_GLOAD(0);
#pragma nounroll
    for (int br = 0; br < 3; ++br) {
        const bool iscmp = br == 0;
        const int t_lo = iscmp ? 0 : ((br == 2 && qt > 8) ? qt - 8 : 0), t_hi = iscmp ? ((q0 + 32) >> 10) : qt;
        const int kmul = iscmp ? 16 : 1, kadd = iscmp ? 31 : 0, dmax = br == 2 ? 512 : 0x40000000;
        f32x16 o[4]; o[0] = f32x16{}; o[1] = f32x16{}; o[2] = f32x16{}; o[3] = f32x16{};
        float m = NEGBIG, l = 0.f;
#define NSA_LSTORE(kt_, buf_) do { \
        *(LAS u32x4*)(F.lds + NSA_K + (buf_) * 8192 + sch * 1024 + srow * 16) = kreg; \
        *(LAS u32x4*)(F.lds + NSA_V + (buf_) * 16384 + (sch >> 2) * 4096 + srow * 64 + (sch & 3) * 16) = vreg; \
        if (iscmp) { const int c_ = (kt_) * 64 + srow, jj_ = c_ >> 2, mm_ = c_ & 3; u32x4 mv_; \
            _Pragma("unroll") for (int i_ = 0; i_ < 4; ++i_) { const int j0_ = sch * 8 + 2 * i_, j1_ = j0_ + 1; \
                const unsigned e0_ = (c_ < NCMP) ? (mm_ < 3 ? (j0_ == jj_ ? 0x4000u : 0u) : ((j0_ == jj_ || j0_ == jj_ + 1) ? 0x3F80u : 0u)) : 0u; \
                const unsigned e1_ = (c_ < NCMP) ? (mm_ < 3 ? (j1_ == jj_ ? 0x4000u : 0u) : ((j1_ == jj_ || j1_ == jj_ + 1) ? 0x3F80u : 0u)) : 0u; \
                mv_[i_] = e0_ | (e1_ << 16); } \
            *(LAS u32x4*)(F.lds + NSA_V + (buf_) * 16384 + (2 + (sch >> 2)) * 4096 + srow * 64 + (sch & 3) * 16) = mv_; } } while (0)
        NSA_LSTORE(t_lo, 0);
        __syncthreads();
        int buf = 0;
#pragma nounroll
        for (int kt = t_lo; kt <= t_hi; ++kt) {
            const int ktn = kt + 1; const bool more = kt < t_hi;
            if (more) NSA_GLOAD(ktn);
            const bool selbit = br == 1 ? (((kt < 32 ? (mlo >> kt) : (mhi >> (kt - 32))) & 1u) != 0u) : true;
            int mode = 0;
            { const int dmin = wq0 - (64 * kt + 63), dmx = wq0 + 7 - 64 * kt;
              if (br == 1) mode = dmin >= 790 ? 2 : (dmin >= 0 ? 1 : 0);
              if (br == 0) mode = 16 * (((wq0 - 31) >> 4) - (64 * kt + 63)) >= 790 ? 2 : 0;
              if (br == 2) mode = (dmin >= 0 && dmx <= 511) ? 1 : 0; }
            if (__any(selbit))
                nsa_tile(iscmp, F.lds + NSA_K + buf * 8192, F.lds + NSA_V + buf * 16384, tbh, qr, o, m, l, kt, tq, kmul, kadd, dmax, selbit, mode, b31, r32, hi, F.lane);
            if (more) NSA_LSTORE(ktn, buf ^ 1);
            __syncthreads();
            buf ^= 1;
        }
#undef NSA_LSTORE
        if (br < 2) { NSA_SETUP(br + 1); NSA_GLOAD(0); }
        l += __shfl_xor(l, 32);
        const float inv = l > 0.f ? 1.0f / l : 0.f;
        { const float sc = inv * (br == 0 ? gate[0] : br == 1 ? gate[1] : gate[2]);
#pragma unroll
            for (int c = 0; c < 2; ++c)
#pragma unroll
                for (int r = 0; r < 16; ++r) { const float prev = br == 0 ? 0.f : ofw[(c * 16 + r) * 64]; ofw[(c * 16 + r) * 64] = prev + o[c][r] * sc; } }
        if (iscmp) {
            LAS float* scw = (LAS float*)(F.lds + NSA_SC) + F.wave * 512;
#pragma unroll
            for (int c = 0; c < 2; ++c)
#pragma unroll
                for (int r = 0; r < 16; ++r) { float v = o[2 + c][r] * inv;
                    v += __builtin_bit_cast(float, __builtin_amdgcn_update_dpp(0, __builtin_bit_cast(int, v), 0xB1, 0xf, 0xf, true));
                    v += __builtin_bit_cast(float, __builtin_amdgcn_update_dpp(0, __builtin_bit_cast(int, v), 0x4E, 0xf, 0xf, true));
                    if (hh == 0) scw[qi * 64 + 32 * c + crow(r, hi)] = v; }
            LDS_WAIT();
            LAS unsigned* mskw = (LAS unsigned*)(F.lds + NSA_MSK) + F.wave * 16;
#pragma nounroll
            for (int q = 0; q < 8; ++q) {
                const int curq = (q0 + 8 * F.wave + q) >> 6, j = F.lane;
                const bool avail = j <= curq, forced = (j == 0) || (j == curq) || (j == curq - 1);
                const float sj = avail ? scw[q * 64 + j] + (forced ? 1e4f : 0.f) : NEGBIG;
                int rank = 0; const int sjb = __builtin_bit_cast(int, sj);
#pragma unroll
                for (int j2 = 0; j2 < 64; ++j2) { const float s2 = __builtin_bit_cast(float, __builtin_amdgcn_readlane(sjb, j2)); rank += (s2 > sj || (s2 == sj && j2 < j)) ? 1 : 0; }
                const bool sel = rank < 16 && avail;
                const unsigned long long bm = __ballot(sel);
                if (F.lane == 0) { mskw[2 * q] = (unsigned)bm; mskw[2 * q + 1] = (unsigned)(bm >> 32); } }
            LDS_WAIT();
            mlo = mskw[2 * qi]; mhi = mskw[2 * qi + 1];
        }
    }
#undef NSA_GLOAD
#undef NSA_SETUP
    bf16* OA = (bf16*)(ws + WS_OA) + (size_t)(b * SEQ + tq) * 512 + head * 64;
#pragma unroll
    for (int c = 0; c < 2; ++c)
#pragma unroll
        for (int r4 = 0; r4 < 4; ++r4) { u32x2 w; w.x = pk2(ofw[(c * 16 + 4 * r4) * 64], ofw[(c * 16 + 4 * r4 + 1) * 64]); w.y = pk2(ofw[(c * 16 + 4 * r4 + 2) * 64], ofw[(c * 16 + 4 * r4 + 3) * 64]);
            *(u32x2*)(OA + 32 * c + 8 * r4 + 4 * hi) = w; }
}
__device__ __forceinline__ void phase3(const Frame& F) {
    const bool xcd = (F.G == 256);
    const int pstart = xcd ? (F.bx >> 3) : F.bx, pstep = xcd ? 32 : F.G, pend = xcd ? 64 : 512;
#pragma nounroll
    for (int p2 = 2 * pstart; p2 < 2 * pend; p2 += (p2 & 1) ? 2 * pstep - 1 : 1) { const int p = p2 >> 1;
        const int b = xcd ? (F.bx & 7) : (p >> 6), g = (p >> 5) & 1, qt = p & 31;
        nsa_unit(F, b, g, (p2 & 1) ? qt : 63 - qt); }
    __syncthreads();
}

#define MFMA16(a, b, c) __builtin_amdgcn_mfma_f32_16x16x32_bf16((a), (b), (c), 0, 0, 0)
constexpr int DSA_SCP = 8200;
constexpr int DSA_SC = 0;
constexpr int DSA_LIST = 16 * DSA_SCP;
constexpr int DSA_NSEL = DSA_LIST + 8192;
constexpr int DSA_BIAS = DSA_NSEL + 64;
constexpr int DSA_HIST = DSA_BIAS + 1088;
constexpr int DSA_BKI = DSA_HIST + 8192;
constexpr int KSEL = 256;
__device__ __forceinline__ unsigned dsa_offb(unsigned row, unsigned ch) { return 256u * row + 16u * (ch ^ (((row & 3u) << 2) | ((row >> 2) & 3u))); }
__device__ __forceinline__ unsigned sortkey16(float x) { x = x + 0.0f; const unsigned short h = __builtin_bit_cast(unsigned short, (_Float16)x); return (h & 0x8000u) ? (unsigned)(unsigned short)~h : (unsigned)(h | 0x8000u); }
__device__ __forceinline__ int prefix_cnt(unsigned long long b) { return (int)__builtin_amdgcn_mbcnt_hi((unsigned)(b >> 32), __builtin_amdgcn_mbcnt_lo((unsigned)b, 0u)); }

__device__ __forceinline__ void dsa_unit(const Frame& F, const Args& a, int b, int qt16) {
    unsigned char* ws = F.ws;
    const bf16* ZA = (const bf16*)(ws + WS_ZA);
    const int lane = F.lane, l16 = lane & 15, quad = lane >> 4, q0 = qt16 * 16;
    __syncthreads();
#ifndef PROBE_DSA
#define PROBE_DSA 0
#endif
    for (int rep1_ = 0; rep1_ < (PROBE_DSA == 1 ? 2 : 1); ++rep1_) {
        const size_t qrow = (size_t)(b * SEQ + q0 + l16) * ZA_LD;
        bf16x8 qf[4][2];
#pragma unroll
        for (int i = 0; i < 4; ++i)
#pragma unroll
            for (int ks = 0; ks < 2; ++ks) qf[i][ks] = *(const bf16x8*)(ZA + qrow + ZC_QIDX + i * 64 + 32 * ks + 8 * quad);
        float wq[4];
#pragma unroll
        for (int i = 0; i < 4; ++i) wq[i] = bf2f(ZA[qrow + ZC_WIDX + i]) * 0.0625f;
        const int tq = q0 + l16, nkt = qt16 + 1;
        const bf16* kbase = ZA + (size_t)(b * SEQ + l16) * ZA_LD + ZC_KIDX + 8 * quad;
        bf16x8 ka[4][2], kn[4][2];
#define DSA_KLOAD(dst, kt0_) do { _Pragma("unroll") for (int t_ = 0; t_ < 4; ++t_) { const int k_ = (kt0_) + 8 * t_; const int kc_ = k_ < nkt ? k_ : nkt - 1; \
            dst[t_][0] = *(const bf16x8*)(kbase + (size_t)(kc_ * 16) * ZA_LD); dst[t_][1] = *(const bf16x8*)(kbase + (size_t)(kc_ * 16) * ZA_LD + 32); } } while (0)
        if (F.wave < nkt) DSA_KLOAD(ka, F.wave);
#pragma nounroll
        for (int kt0 = F.wave; kt0 < nkt; kt0 += 32) {
            if (kt0 + 32 < nkt) DSA_KLOAD(kn, kt0 + 32);
#pragma unroll
            for (int t = 0; t < 4; ++t) { const int kt = kt0 + 8 * t;
                if (kt < nkt) {
                    float idx[4] = {0.f, 0.f, 0.f, 0.f};
#pragma unroll
                    for (int i = 0; i < 4; ++i) { f32x4 acc = {0.f, 0.f, 0.f, 0.f}; acc = MFMA16(ka[t][0], qf[i][0], acc); acc = MFMA16(ka[t][1], qf[i][1], acc);
#pragma unroll
                        for (int r = 0; r < 4; ++r) idx[r] += fmaxf(acc[r], 0.f) * wq[i]; }
                    unsigned k16[4];
#pragma unroll
                    for (int r = 0; r < 4; ++r) { const int key = kt * 16 + 4 * quad + r; k16[r] = key <= tq ? sortkey16(idx[r]) : 0u; }
                    u32x2 w; w.x = k16[0] | (k16[1] << 16); w.y = k16[2] | (k16[3] << 16);
                    *(LAS u32x2*)(F.lds + DSA_SC + l16 * DSA_SCP + (kt * 16 + 4 * quad) * 2) = w; } }
#pragma unroll
            for (int t = 0; t < 4; ++t) { ka[t][0] = kn[t][0]; ka[t][1] = kn[t][1]; }
        }
#undef DSA_KLOAD
    }
    if (F.tid < 264) { const float* rb = a.in[11]; ((LAS float*)(F.lds + DSA_BIAS))[F.tid] = F.tid < 256 ? rb[(F.tid >> 3) * 16 + 8 + (F.tid & 7)] * LOG2E : NEGBIG; }
    __syncthreads();
    bf16x8 ql[2][4];
#pragma unroll
    for (int qq = 0; qq < 2; ++qq)
#pragma unroll
        for (int s2 = 0; s2 < 4; ++s2) { const bf16x8 v = *(const bf16x8*)(ZA + (size_t)(b * SEQ + q0 + 2 * F.wave + qq) * ZA_LD + ZC_QLAT + (l16 & 7) * 128 + 32 * s2 + 8 * quad); ql[qq][s2] = l16 < 8 ? v : (bf16x8){0, 0, 0, 0, 0, 0, 0, 0}; }
#pragma nounroll
    for (int qq = 0; qq < (PROBE_DSA == 2 ? 4 : 2); ++qq) {
        const int n = 2 * F.wave + (qq & 1), tq = q0 + n, N = tq + 1;
        LAS unsigned char* scq = F.lds + DSA_SC + n * DSA_SCP;
        LAS unsigned short* lst = (LAS unsigned short*)(F.lds + DSA_LIST) + n * 256;
        LAS unsigned short* bki = (LAS unsigned short*)(F.lds + DSA_BKI) + n * 256;
        if (N <= KSEL) {
            for (int s = lane; s < KSEL; s += 64) lst[s] = (unsigned short)(s < N ? s : 0);
            if (lane == 0) ((LAS int*)(F.lds + DSA_NSEL))[n] = N;
        } else {
            const int nit = (N + 255) >> 8;
            { const int it = nit - 1; const int s0 = 4 * (lane + 64 * it); u32x2 w = *(LAS u32x2*)(scq + s0 * 2);
              if (s0 + 0 > tq) w.x &= 0xffff0000u; if (s0 + 1 > tq) w.x &= 0x0000ffffu; if (s0 + 2 > tq) w.y &= 0xffff0000u; if (s0 + 3 > tq) w.y &= 0x0000ffffu;
              *(LAS u32x2*)(scq + s0 * 2) = w; }
            LDS_WAIT();
            LAS unsigned* hist = (LAS unsigned*)(F.lds + DSA_HIST) + F.wave * 256;
            unsigned T = 0u; int cgt = 0; int need = KSEL;
#pragma nounroll
            for (int lvl = 0; lvl < 2; ++lvl) {
                *(LAS u32x4*)(hist + 4 * lane) = (u32x4){0u, 0u, 0u, 0u};
                LDS_WAIT();
#pragma nounroll
                for (int it = 0; it < nit; ++it) { const u32x2 w = *(LAS u32x2*)(scq + (lane + 64 * it) * 8);
                    const unsigned k[4] = {w.x & 0xffffu, w.x >> 16, w.y & 0xffffu, w.y >> 16};
#pragma unroll
                    for (int e = 0; e < 4; ++e) { const bool in = lvl == 0 ? true : (k[e] >> 8) == (T >> 8); const unsigned bin = lvl == 0 ? (k[e] >> 8) : (k[e] & 255u);
                        if (in) __hip_atomic_fetch_add(hist + bin, 1u, __ATOMIC_RELAXED, __HIP_MEMORY_SCOPE_WORKGROUP); } }
                LDS_WAIT();
                const u32x4 h = *(LAS u32x4*)(hist + 4 * lane);
                const int sl = (int)(h.x + h.y + h.z + h.w); int suf = sl;
#pragma unroll
                for (int d = 1; d < 64; d <<= 1) { const int o = __shfl_down(suf, d); suf += (lane + d < 64) ? o : 0; }
                const int above = suf - sl;
                const bool here = above < need && above + sl >= need;
                int bsel = 4 * lane + 3, ca = above;
                if (ca + (int)h.w < need) { ca += (int)h.w; bsel = 4 * lane + 2; if (ca + (int)h.z < need) { ca += (int)h.z; bsel = 4 * lane + 1; if (ca + (int)h.y < need) { ca += (int)h.y; bsel = 4 * lane; } } }
                const unsigned long long bm = __ballot(here);
                const int src = bm ? (int)__builtin_ctzll(bm) : 0;
                const int B = __shfl(bsel, src), CA = __shfl(ca, src);
                if (lvl == 0) T = (unsigned)B << 8; else T |= (unsigned)B;
                cgt += CA; need -= CA;
                LDS_WAIT();
            }
            const int rties = KSEL - cgt;
            int tiebase = 0, outbase = 0;
#define DSA_PUT(pos_, idx_) do { const int p_ = (pos_); if (p_ >= 0 && p_ < KSEL) lst[p_] = (unsigned short)(idx_); } while (0)
#pragma nounroll
            for (int it = 0; it < nit; ++it) { const u32x2 w = *(LAS u32x2*)(scq + (lane + 64 * it) * 8);
                const unsigned k0 = w.x & 0xffffu, k1 = w.x >> 16, k2 = w.y & 0xffffu, k3 = w.y >> 16;
                const int sidx = 4 * (lane + 64 * it);
                const bool g0 = k0 > T, g1 = k1 > T, g2 = k2 > T, g3 = k3 > T;
                const unsigned long long bg0 = __ballot(g0), bg1 = __ballot(g1), bg2 = __ballot(g2), bg3 = __ballot(g3);
                if (bg0 | bg1 | bg2 | bg3) {
                    int pos = outbase + prefix_cnt(bg0) + prefix_cnt(bg1) + prefix_cnt(bg2) + prefix_cnt(bg3);
                    if (g0) { DSA_PUT(pos, sidx + 0); ++pos; }
                    if (g1) { DSA_PUT(pos, sidx + 1); ++pos; }
                    if (g2) { DSA_PUT(pos, sidx + 2); ++pos; }
                    if (g3) { DSA_PUT(pos, sidx + 3); ++pos; }
                    outbase += __popcll(bg0) + __popcll(bg1) + __popcll(bg2) + __popcll(bg3); }
                const bool e0 = k0 == T, e1 = k1 == T, e2 = k2 == T, e3 = k3 == T;
                const unsigned long long be0 = __ballot(e0), be1 = __ballot(e1), be2 = __ballot(e2), be3 = __ballot(e3);
                if ((be0 | be1 | be2 | be3) && tiebase < rties) {
                    const int t0 = tiebase + prefix_cnt(be0) + prefix_cnt(be1) + prefix_cnt(be2) + prefix_cnt(be3), t1 = t0 + (e0 ? 1 : 0), t2 = t1 + (e1 ? 1 : 0), t3 = t2 + (e2 ? 1 : 0);
                    if (e0 && t0 < rties) DSA_PUT(KSEL - 1 - t0, sidx + 0);
                    if (e1 && t1 < rties) DSA_PUT(KSEL - 1 - t1, sidx + 1);
                    if (e2 && t2 < rties) DSA_PUT(KSEL - 1 - t2, sidx + 2);
                    if (e3 && t3 < rties) DSA_PUT(KSEL - 1 - t3, sidx + 3);
                    tiebase += __popcll(be0) + __popcll(be1) + __popcll(be2) + __popcll(be3); } }
#undef DSA_PUT
            outbase = KSEL;
            if (lane == 0) ((LAS int*)(F.lds + DSA_NSEL))[n] = outbase < KSEL ? outbase : KSEL;
        }
        LDS_WAIT();
        { const int nsl = N < KSEL ? N : KSEL;
#pragma unroll
          for (int i = 0; i < 4; ++i) { const int e = lane + 64 * i; const int dist = tq - (int)lst[e];
              const int dpos = dist < 1 ? 1 : dist; int bl = 16 + (int)((__log2f((float)dpos) - 4.0f) * 2.66666675f); bl = bl > 31 ? 31 : bl;
              const int bk = dist < 1 ? 0 : (dpos < 16 ? dpos : bl);
              bki[e] = (unsigned short)(e < nsl ? bk * 32 : 1024); } }
    }
    LDS_WAIT();
    const bf16* CK = (const bf16*)(ws + WS_CKVN) + (size_t)(b * SEQ) * 128;
    LAS unsigned char* gb0 = F.lds + DSA_SC + (2 * F.wave) * DSA_SCP;
    const LAS unsigned char* biasb = F.lds + DSA_BIAS + (l16 & 7) * 4;
#define DSA_GATHER(chunk_, buf_) do { const unsigned key_ = lst[(chunk_) * 32 + (lane >> 1)]; const char* src_ = (const char*)CK + (key_ * 256u + (unsigned)(lane & 1) * 16u); \
        _Pragma("unroll") for (int c_ = 0; c_ < 8; ++c_) __builtin_amdgcn_global_load_lds((const unsigned*)(src_ + c_ * 32), (LAS unsigned*)(gb0 + (buf_) * 8192 + c_ * 1024), 16, 0, 0); } while (0)
    int tqs[2], nsels[2]; const LAS unsigned short* lsts[2]; const LAS unsigned short* bkis[2]; f32x4 o[2][8]; float ms[2], ls[2];
#pragma unroll
    for (int qq = 0; qq < 2; ++qq) { const int n = 2 * F.wave + qq; tqs[qq] = q0 + n; nsels[qq] = ((const LAS int*)(F.lds + DSA_NSEL))[n]; lsts[qq] = (const LAS unsigned short*)(F.lds + DSA_LIST) + n * 256; bkis[qq] = (const LAS unsigned short*)(F.lds + DSA_BKI) + n * 256;
#pragma unroll
        for (int c = 0; c < 8; ++c) o[qq][c] = (f32x4){0.f, 0.f, 0.f, 0.f};
        ms[qq] = NEGBIG; ls[qq] = 0.f; }
#pragma unroll
    for (int qq = 0; qq < 2; ++qq)
#pragma unroll
        for (int s2 = 0; s2 < 4; ++s2) asm volatile("" : "+v"(ql[qq][s2]));
    const int nch1 = (nsels[1] + 31) >> 5, nch = PROBE_DSA == 3 ? 2 * nch1 : nch1;
    LDS_WAIT();
    { const LAS unsigned short* lst = lsts[0]; DSA_GATHER(0, 0); }
    { const LAS unsigned short* lst = lsts[1]; DSA_GATHER(0, 1); }
    const unsigned offA = (unsigned)((quad >> 1) * 1024 + l16 * 32 + (quad & 1) * 16);
    const unsigned offT = (unsigned)((4 * quad + (l16 >> 2)) * 32 + 8 * (lane & 3));
#pragma nounroll
    for (int ch = 0; ch < nch; ++ch) {
#pragma unroll
        for (int qq = 0; qq < 2; ++qq) {
            const int chd = ch >= nch1 ? ch - nch1 : ch;
            const LAS unsigned short* lst = lsts[qq];
            const LAS unsigned char* gb = gb0 + qq * 8192;
            if (qq == 0 || ch + 1 < nch) asm volatile("s_waitcnt vmcnt(8)" ::: "memory"); else asm volatile("s_waitcnt vmcnt(0)" ::: "memory");
            f32x4 acc2[2]; float bvs[2][4];
#pragma unroll
            for (int rb = 0; rb < 2; ++rb) { f32x4 acc = {0.f, 0.f, 0.f, 0.f};
#pragma unroll
                for (int s2 = 0; s2 < 4; ++s2) { const bf16x8 af = *(const LAS bf16x8*)(gb + offA + rb * 512 + s2 * 2048); acc = MFMA16(af, ql[qq][s2], acc); }
                acc2[rb] = acc;
                const u32x2 kb = *(const LAS u32x2*)((const LAS unsigned char*)bkis[qq] + (chd * 32 + rb * 16 + 4 * quad) * 2);
                bvs[rb][0] = *(const LAS float*)(biasb + (kb.x & 0xffffu)); bvs[rb][1] = *(const LAS float*)(biasb + (kb.x >> 16));
                bvs[rb][2] = *(const LAS float*)(biasb + (kb.y & 0xffffu)); bvs[rb][3] = *(const LAS float*)(biasb + (kb.y >> 16)); }
#pragma unroll
            for (int rb = 0; rb < 2; ++rb)
#pragma unroll
                for (int r = 0; r < 4; ++r) asm volatile("" : "+v"(bvs[rb][r]));
            float x[2][4]; float tmax = NEGBIG;
#pragma unroll
            for (int rb = 0; rb < 2; ++rb)
#pragma unroll
                for (int r = 0; r < 4; ++r) { const float xv = acc2[rb][r] * C2 + bvs[rb][r]; x[rb][r] = xv; tmax = fmaxf(tmax, xv); }
            tmax = fmaxf(tmax, __shfl_xor(tmax, 16)); tmax = fmaxf(tmax, __shfl_xor(tmax, 32));
            const float mn = fmaxf(ms[qq], tmax); const bool resc = __any(mn != ms[qq]); const float alpha = __builtin_amdgcn_exp2f(ms[qq] - mn); ms[qq] = mn;
            float ps = 0.f;
#pragma unroll
            for (int rb = 0; rb < 2; ++rb)
#pragma unroll
                for (int r = 0; r < 4; ++r) { const float pv = __builtin_amdgcn_exp2f(x[rb][r] - mn); x[rb][r] = pv; ps += pv; }
            ls[qq] = ls[qq] * alpha + ps;
            if (resc) {
#pragma unroll
                for (int c = 0; c < 8; ++c) o[qq][c] = o[qq][c] * alpha; }
            u32x4 pw; pw.x = pk2(x[0][0], x[0][1]); pw.y = pk2(x[0][2], x[0][3]); pw.z = pk2(x[1][0], x[1][1]); pw.w = pk2(x[1][2], x[1][3]);
            const unsigned gba = (unsigned)(unsigned long long)gb + offT;
#pragma unroll
            for (int cb = 0; cb < 2; ++cb) {
                s16x4 v[8];
                if (cb == 0) asm volatile("ds_read_b64_tr_b16 %0, %8\n\tds_read_b64_tr_b16 %1, %8 offset:512\n\tds_read_b64_tr_b16 %2, %8 offset:1024\n\tds_read_b64_tr_b16 %3, %8 offset:1536\n\t"
                             "ds_read_b64_tr_b16 %4, %8 offset:2048\n\tds_read_b64_tr_b16 %5, %8 offset:2560\n\tds_read_b64_tr_b16 %6, %8 offset:3072\n\tds_read_b64_tr_b16 %7, %8 offset:3584\n\ts_waitcnt lgkmcnt(0)"
                             : "=&v"(v[0]), "=&v"(v[1]), "=&v"(v[2]), "=&v"(v[3]), "=&v"(v[4]), "=&v"(v[5]), "=&v"(v[6]), "=&v"(v[7]) : "v"(gba) : "memory");
                else asm volatile("ds_read_b64_tr_b16 %0, %8 offset:4096\n\tds_read_b64_tr_b16 %1, %8 offset:4608\n\tds_read_b64_tr_b16 %2, %8 offset:5120\n\tds_read_b64_tr_b16 %3, %8 offset:5632\n\t"
                             "ds_read_b64_tr_b16 %4, %8 offset:6144\n\tds_read_b64_tr_b16 %5, %8 offset:6656\n\tds_read_b64_tr_b16 %6, %8 offset:7168\n\tds_read_b64_tr_b16 %7, %8 offset:7680\n\ts_waitcnt lgkmcnt(0)"
                             : "=&v"(v[0]), "=&v"(v[1]), "=&v"(v[2]), "=&v"(v[3]), "=&v"(v[4]), "=&v"(v[5]), "=&v"(v[6]), "=&v"(v[7]) : "v"(gba) : "memory");
#pragma unroll
                for (int c4 = 0; c4 < 4; ++c4) { const int c = 4 * cb + c4; const s16x4 v0 = v[2 * c4], v1 = v[2 * c4 + 1];
                    const bf16x8 vf = {v0[0], v0[1], v0[2], v0[3], v1[0], v1[1], v1[2], v1[3]};
                    o[qq][c] = MFMA16(vf, __builtin_bit_cast(bf16x8, pw), o[qq][c]); }
            }
            LDS_WAIT();
            if (ch + 1 < nch) DSA_GATHER((ch + 1 >= nch1 ? ch + 1 - nch1 : ch + 1), qq);
        }
    }
#pragma unroll
    for (int qq = 0; qq < 2; ++qq) {
        float l = ls[qq]; const int tq = tqs[qq];
        l += __shfl_xor(l, 16); l += __shfl_xor(l, 32);
        const float inv = l > 0.f ? 1.0f / l : 0.f;
        if (l16 < 8) { bf16* op = (bf16*)(ws + WS_OLAT) + (size_t)(b * SEQ + tq) * 1024 + l16 * 128 + 4 * quad;
#pragma unroll
            for (int c = 0; c < 8; ++c) { u32x2 w; w.x = pk2(o[qq][c][0] * inv, o[qq][c][1] * inv); w.y = pk2(o[qq][c][2] * inv, o[qq][c][3] * inv); *(u32x2*)(op + 16 * c) = w; } }
    }
}
#undef DSA_GATHER
__device__ __forceinline__ void phase4(const Frame& F, const Args& a) {
    const bool xcd = (F.G == 256);
    const int pstart = xcd ? (F.bx >> 3) : F.bx, pstep = xcd ? 32 : F.G, pend = xcd ? 128 : 1024;
#pragma nounroll
    for (int p2 = 2 * pstart; p2 < 2 * pend; p2 += (p2 & 1) ? 2 * pstep - 1 : 1) { const int p = p2 >> 1;
        const int b = xcd ? (F.bx & 7) : (p >> 7), j = p & 127;
        dsa_unit(F, a, b, (p2 & 1) ? j : 255 - j); }
    __syncthreads();
}

constexpr int NPHASE = 11;
__global__ void __launch_bounds__(NTHR, 2) fwd_kernel(Args args) {
    extern __shared__ __attribute__((aligned(16))) unsigned char lds_raw[];
    Frame F;
    F.lds = (LAS unsigned char*)lds_raw;
    F.tid = threadIdx.x; F.lane = F.tid & 63; F.wave = __builtin_amdgcn_readfirstlane(F.tid >> 6);
    F.G = gridDim.x; F.bx = blockIdx.x; F.ws = args.ws;
    unsigned char* ws = args.ws;
    volatile LAS unsigned* MISC = (volatile LAS unsigned*)(F.lds + MISC_OFF);
    if (F.tid < 64) MISC[F.tid] = 0u;
    __syncthreads();
    const int lo = args.ph_lo, hi = args.ph_hi;
    XcdBarrier bar; bar.bar = (unsigned*)(ws + WS_CTL) + CW_BAR; bar.x = 0; bar.st = nullptr;
    if (hi - lo > 1) bar = xcd_barrier_post((unsigned*)(ws + WS_CTL) + CW_BAR, MISC + 8);
#ifndef PH_MASK
#define PH_MASK 0xFFFF
#endif
#define IN(k) ((((PH_MASK) >> (k)) & 1) && lo <= (k) && (k) < hi)
#define SEAM(k) do { if (IN(k) && IN((k) + 1)) xcd_barrier(bar); } while (0)
#ifndef PROBE_PHASE
#define PROBE_PHASE -1
#endif
#define REPEAT(k) for (int rep_ = 0; rep_ < ((PROBE_PHASE) == (k) ? 2 : 1); ++rep_, ((PROBE_PHASE) == (k) && rep_ < 2 ? xcd_barrier(bar) : (void)0))

    if (IN(0)) REPEAT(0) { phase0(F, args); }
    SEAM(0);
    if (IN(1)) REPEAT(1) {
#ifndef PROBE_GEMM
#define PROBE_GEMM 0
#endif
        pg8::StaticOrder S; S.init(NTOK / 256, NZ / 256, F.G, F.bx, PROBE_GEMM == 1 ? 2 : 1);
        const APlain AA{ws + WS_XB, 128u, (unsigned)(D * 2)}; const BPlain BA{(const bf16*)(ws + WS_WINT), D};
        const EpiZ E{(bf16*)(ws + WS_ZA), (bf16*)(ws + WS_ZG)};
        pg8::gemm_phase(F.lds, D, S, AA, BA, E);
        { const int nu = (NTOK / 256) * (NZ / 256), rem = nu % F.G;
          if (rem != 0 && F.bx >= rem) p0_experts(F, args, (F.bx - rem) * NWAVES + F.wave, (F.G - rem) * NWAVES, 0, P0_EXP_ITEMS); }
    }
    SEAM(1);
    if (IN(2)) REPEAT(2) { phase2(F, args); }
    SEAM(2);
    if (IN(3)) REPEAT(3) { phase3(F); }
    if (IN(4)) REPEAT(4) { phase4(F, args); }
    SEAM(4);
    if (IN(5)) REPEAT(5) {
        pg8::StaticOrder S; S.init(NTOK / 256, D / 256, F.G, F.bx);
        { const APlain AA{ws + WS_OA, 128u, 1024u}; const BPlain BA{(const bf16*)(ws + WS_WAT), 512};
          const EpiGate<0> E{(const bf16*)(ws + WS_ZG), nullptr, (bf16*)(ws + WS_T1)};
          pg8::gemm_phase(F.lds, 512, S, AA, BA, E); }
        { const APlain AA{ws + WS_OLAT, 128u, 2048u}; const BPlain BA{(const bf16*)(ws + WS_WBT), 1024};
          const EpiGate<1> E{(const bf16*)(ws + WS_ZG), (const bf16*)(ws + WS_T1), (bf16*)(ws + WS_MERGED)};
          pg8::gemm_phase(F.lds, 1024, S, AA, BA, E); }
    }
    SEAM(5);
    if (IN(6)) REPEAT(6) {
        pg8::StaticOrder S; S.init(NTOK / 256, D / 256, F.G, F.bx, PROBE_GEMM == 6 ? 2 : 1);
        const APlain AA{ws + WS_MERGED, 128u, 2048u}; const BPlain BA{(const bf16*)(ws + WS_WOT), 1024};
        const EpiRes E{args.in[0], (bf16*)(ws + WS_H1)};
        pg8::gemm_phase(F.lds, 1024, S, AA, BA, E);
    }
    SEAM(6);
    if (IN(7)) { phase6(F, args); }
    SEAM(7);
    if (IN(8)) REPEAT(8) {
        moe_setup(F);
        const int vcu = (F.G % 8 == 0) ? (F.bx % 8) * (F.G / 8) + F.bx / 8 : F.bx;
        const MoeOrder S{F.G, vcu, 2, (const LAS int*)(F.lds + MOE_CUM), (const LAS int*)(F.lds + MOE_CUM) + 40};
        const AGather AA{ws + WS_H1B, 128u, (const int*)(ws + WS_LIST)}; const BGu BA{(const bf16*)(ws + WS_WGU)};
        const EpiAct E{(bf16*)(ws + WS_ACT)};
        pg8::gemm_phase(F.lds, 1024, S, AA, BA, E);
    }
    SEAM(8);
    if (IN(9)) REPEAT(9) {
        moe_setup(F);
        const int vcu = (F.G % 8 == 0) ? (F.bx % 8) * (F.G / 8) + F.bx / 8 : F.bx;
        const MoeOrder S{F.G, vcu, 4, (const LAS int*)(F.lds + MOE_CUM), (const LAS int*)(F.lds + MOE_CUM) + 40};
        const APlain AA{ws + WS_ACT, 128u, 512u}; const BDn BA{(const bf16*)(ws + WS_WDT)};
        const EpiDown E{(bf16*)(ws + WS_YBUF), (const int*)(ws + WS_LIST)};
        pg8::gemm_phase(F.lds, 256, S, AA, BA, E);
    }
    SEAM(9);
    if (IN(10)) REPEAT(10) { phase9(F, args); }
#undef IN
#undef SEAM
#undef REPEAT
}

extern "C" void kernel_launch(void* const* d_in, const int* in_sizes, int n_in, void* d_out, int out_size, void* d_ws, size_t ws_size, hipStream_t stream) {
    static int grid = 0;
    if (grid == 0) {
        if (n_in != 26 || in_sizes[0] != NTOK * D || out_size != NTOK * D || ws_size < WS_END) {
            fprintf(stderr, "kernel_launch: unexpected problem: n_in %d in0 %d out %d ws %zu (need %zu)\n", n_in, n_in > 0 ? in_sizes[0] : -1, out_size, ws_size, (size_t)WS_END); grid = -1; return; }
        int dev = 0, cus = 0, per_cu = 0;
        if (hipGetDevice(&dev) != hipSuccess || hipDeviceGetAttribute(&cus, hipDeviceAttributeMultiprocessorCount, dev) != hipSuccess) { grid = -1; return; }
        if (hipFuncSetAttribute((const void*)fwd_kernel, hipFuncAttributeMaxDynamicSharedMemorySize, LDS_BYTES) != hipSuccess) { fprintf(stderr, "kernel_launch: hipFuncSetAttribute failed\n"); grid = -1; return; }
        if (hipOccupancyMaxActiveBlocksPerMultiprocessor(&per_cu, (const void*)fwd_kernel, NTHR, LDS_BYTES) != hipSuccess || per_cu < 1)
            fprintf(stderr, "kernel_launch: occupancy query reports %d\n", per_cu);
        (void)hipGetLastError();
        grid = cus;
    }
    if (grid < 0) return;
    if (hipMemsetAsync((char*)d_ws + WS_CTL, 0, CTL_ZERO_BYTES, stream) != hipSuccess) return;
    Args a{};
    for (int i = 0; i < 26; ++i) a.in[i] = (const float*)d_in[i];
    a.out = (float*)d_out; a.ws = (unsigned char*)d_ws;
#if MK_PER_PHASE
    for (int p = 0; p < NPHASE; ++p) { a.ph_lo = p; a.ph_hi = p + 1; hipLaunchKernelGGL(fwd_kernel, dim3(grid), dim3(NTHR), LDS_BYTES, stream, a); }
#else
    a.ph_lo = 0; a.ph_hi = NPHASE;
    hipLaunchKernelGGL(fwd_kernel, dim3(grid), dim3(NTHR), LDS_BYTES, stream, a);
#endif
}
```

```cpp
#include <hip/hip_runtime.h>
#include <cstdio>
#include <cstdint>

#ifndef MK_PER_PHASE
#define MK_PER_PHASE 0
#endif

#define GAS __attribute__((address_space(1)))
#define LAS __attribute__((address_space(3)))
typedef unsigned short bf16;
typedef short bf16x8 __attribute__((ext_vector_type(8)));
typedef short s16x4 __attribute__((ext_vector_type(4)));
typedef float f32x4 __attribute__((ext_vector_type(4)));
typedef float f32x16 __attribute__((ext_vector_type(16)));
typedef float f32x2 __attribute__((ext_vector_type(2)));
typedef unsigned u32x4 __attribute__((ext_vector_type(4)));
typedef unsigned u32x2 __attribute__((ext_vector_type(2)));

constexpr int D = 1024, BATCH = 8, SEQ = 4096, NTOK = BATCH * SEQ;
constexpr int D_IN = 4316;
constexpr int NCMP = 255;
constexpr float ALPHA = 1.189207115002721f;
constexpr float LOG2E = 1.4426950408889634f;
constexpr float NEGBIG = -1e30f;
constexpr int ZA_LD = 2816;
constexpr int ZC_QA = 0, ZC_KC = 512, ZC_VC = 640, ZC_KS = 768, ZC_VS = 896, ZC_KW = 1024, ZC_VW = 1152, ZC_QLAT = 1280, ZC_CKV = 2304,
              ZC_QIDX = 2432, ZC_KIDX = 2688, ZC_GNSA = 2752, ZC_WIDX = 2776;
constexpr int ZG_LD = 2048;
constexpr int NZ = ZA_LD + ZG_LD;
constexpr int NEXP = 32, DEXP = 256;
constexpr int MAXTILES = (2 * NTOK) / 256 + NEXP;

constexpr size_t MiB = 1u << 20;
constexpr size_t WS_CTL = 0, CTL_ZERO_BYTES = 1 * MiB;
constexpr size_t WS_WAT = 1 * MiB;
constexpr size_t WS_WBT = 2 * MiB;
constexpr size_t WS_WOT = 4 * MiB;
constexpr size_t WS_W1K = 6 * MiB;
constexpr size_t WS_W1V = 7 * MiB;
constexpr size_t WS_W2K = 8 * MiB;
constexpr size_t WS_W2V = 8 * MiB + 64 * 1024;
constexpr size_t WS_BIASK = 8 * MiB + 128 * 1024;
constexpr size_t WS_TBA = 8 * MiB + 256 * 1024;
constexpr size_t WS_TBB = 8 * MiB + 320 * 1024;
constexpr size_t WS_KCMP = 9 * MiB;
constexpr size_t WS_VCMP = 9 * MiB + 512 * 1024;
constexpr size_t WS_TOKINFO = 10 * MiB;
constexpr size_t WS_LIST = 11 * MiB;
constexpr size_t WS_WINT = 16 * MiB;
constexpr size_t WS_WGU = 32 * MiB;
constexpr size_t WS_WDT = 64 * MiB;
constexpr size_t WS_CKVN = 80 * MiB;
constexpr size_t WS_XB = 96 * MiB;
constexpr size_t WS_OLAT = 96 * MiB;
constexpr size_t WS_H1B = 96 * MiB;
constexpr size_t WS_ZA = 160 * MiB;
constexpr size_t WS_T1 = 160 * MiB;
constexpr size_t WS_ACT = 160 * MiB;
constexpr size_t WS_YBUF = 196 * MiB;
constexpr size_t WS_MERGED = 224 * MiB;
constexpr size_t WS_ZG = 336 * MiB;
constexpr size_t WS_H1 = 336 * MiB;
constexpr size_t WS_OA = 464 * MiB;
constexpr size_t WS_END = 496 * MiB;

constexpr int CW_BAR = 4096;
constexpr int CW_CNT = 16384;

constexpr int LDS_BYTES = 163840;
constexpr int MISC_OFF = 160 * 1024 - 256;

__device__ __forceinline__ unsigned f2bf(float f) { unsigned u = __builtin_bit_cast(unsigned, f); return (u + 0x7fffu + ((u >> 16) & 1u)) >> 16; }
__device__ __forceinline__ unsigned pk2(float lo, float hi) { unsigned r; asm volatile("v_cvt_pk_bf16_f32 %0, %1, %2" : "=v"(r) : "v"(lo), "v"(hi)); return r; }
__device__ __forceinline__ float bf2f(unsigned short b) { return __builtin_bit_cast(float, ((unsigned)b) << 16); }
__device__ __forceinline__ float bflo(unsigned w) { return __builtin_bit_cast(float, w << 16); }
__device__ __forceinline__ float bfhi(unsigned w) { return __builtin_bit_cast(float, w & 0xffff0000u); }
__device__ __forceinline__ float wave_sum(float v) {
#pragma unroll
    for (int o = 1; o < 64; o <<= 1) v += __shfl_xor(v, o);
    return v;
}
__device__ __forceinline__ float sigmoidf_(float x) { return __builtin_amdgcn_rcpf(1.0f + __builtin_amdgcn_exp2f(-1.4426950408889634f * x)); }
#define LDS_WAIT() asm volatile("s_waitcnt lgkmcnt(0)" ::: "memory")
#define VM_WAIT() asm volatile("s_waitcnt vmcnt(0)" ::: "memory")

#define XB_TMO      128
#define XB_XCNT(j)  (256  + 64 * (j))
#define XB_XSUB(j)  (1280 + 64 * (j))
#define XB_XGEN(j)  (2304 + 64 * (j))
#define XB_TOP      3328
#define XB_TOPGEN   3392
#define XCD_BAR_WORDS 3456
#define XB_SPIN_CAP (1u << 18)
__device__ __forceinline__ unsigned xb_ld(unsigned* p)              { return __hip_atomic_load(p, __ATOMIC_RELAXED, __HIP_MEMORY_SCOPE_AGENT); }
__device__ __forceinline__ unsigned xb_add(unsigned* p, unsigned v) { return __hip_atomic_fetch_add(p, v, __ATOMIC_RELAXED, __HIP_MEMORY_SCOPE_AGENT); }
__device__ __forceinline__ unsigned xb_xcc_id() { return (unsigned)__builtin_amdgcn_s_getreg((3 << 11) | 20) & 0xFu; }
#define XB_SPIN(cond, bar) do { unsigned _sp = 0; while (cond) { __builtin_amdgcn_s_sleep(1); \
    if ((++_sp & 255u) == 0u) { if (xb_ld(&(bar)[XB_TMO])) break; if (_sp > XB_SPIN_CAP) { atomicAdd(&(bar)[XB_TMO], 1u); break; } } } } while (0)
struct XcdBarrier { unsigned* bar; unsigned x; volatile LAS unsigned* st; };
__device__ __forceinline__ XcdBarrier xcd_barrier_post(unsigned* bar, volatile LAS unsigned* st) {
    XcdBarrier b; b.bar = bar; b.x = xb_xcc_id(); b.st = st;
    if (threadIdx.x == 0) (void)xb_add(&bar[XB_XCNT(b.x)], 1u);
    return b;
}
__device__ __forceinline__ void xcd_barrier_complete(unsigned* bar, unsigned x, unsigned& nloc, unsigned& nx) {
    const unsigned G = gridDim.x * gridDim.y * gridDim.z;
    unsigned sum, cnt, mine, sp = 0u;
    for (;;) {
        sum = 0u; cnt = 0u; mine = 0u;
#pragma unroll
        for (unsigned j = 0; j < 16; ++j) { const unsigned c = xb_ld(&bar[XB_XCNT(j)]); sum += c; cnt += (c > 0u) ? 1u : 0u; mine = (j == x) ? c : mine; }
        if (sum == G) break;
        __builtin_amdgcn_s_sleep(1);
        if ((++sp & 255u) == 0u) { if (xb_ld(&bar[XB_TMO])) break; if (sp > XB_SPIN_CAP) { atomicAdd(&bar[XB_TMO], 1u); break; } }
    }
    nloc = mine > 0u ? mine : 1u; nx = cnt > 0u ? cnt : 1u;
}
__device__ __forceinline__ void xcd_barrier(const XcdBarrier& b) {
    asm volatile("s_waitcnt vmcnt(0)" ::: "memory");
    __syncthreads();
    if (threadIdx.x == 0) {
        unsigned* bar = b.bar;
        __builtin_amdgcn_s_waitcnt(0);
        unsigned nloc = b.st[0], nx = b.st[1];
        if (nloc == 0u) { xcd_barrier_complete(bar, b.x, nloc, nx); b.st[0] = nloc; b.st[1] = nx; }
        const unsigned old = xb_add(&bar[XB_XSUB(b.x)], 1u);
        const unsigned gen = old / nloc;
        if (old + 1u == (gen + 1u) * nloc) {
            __builtin_amdgcn_fence(__ATOMIC_RELEASE, "agent");
            asm volatile("s_waitcnt vmcnt(0)" ::: "memory");
            const unsigned og = xb_add(&bar[XB_TOP], 1u);
            const unsigned tg = og / nx;
            if (og + 1u == (tg + 1u) * nx) xb_add(&bar[XB_TOPGEN], 1u);
            else XB_SPIN(xb_ld(&bar[XB_TOPGEN]) == tg, bar);
            __builtin_amdgcn_fence(__ATOMIC_ACQUIRE, "agent");
            xb_add(&bar[XB_XGEN(b.x)], 1u);
            asm volatile("s_waitcnt vmcnt(0)" ::: "memory");
        } else {
            XB_SPIN(xb_ld(&bar[XB_XGEN(b.x)]) == gen, bar);
            __builtin_amdgcn_fence(__ATOMIC_ACQUIRE, "agent");
            asm volatile("s_waitcnt vmcnt(0)" ::: "memory");
        }
    }
    __syncthreads();
}

namespace pg8 {
constexpr int BM = 256, BK = 64, HALF = 128, HTB = HALF * BK * 2, STAGE_BYTES = 8 * HTB, NXCD = 8, WGM = 8;
__host__ __device__ __forceinline__ int lds_byte(int r, int c) { const int st = (r >> 4) * 2 + (c >> 5), rr = r & 15, cc = c & 31, ob = rr * 64 + cc * 2; return st * 1024 + (ob ^ (((ob >> 9) & 1) << 5)); }
__host__ __device__ __forceinline__ void stage_rc(int b, int& R, int& C) { const int st = b / 1024, sb = b % 1024, swz = sb ^ (((sb >> 9) & 1) << 5); R = (st >> 1) * 16 + swz / 64; C = (st & 1) * 32 + (swz % 64) / 2; }
__host__ __device__ __forceinline__ int perm32(int rho) { const int n = rho >> 4, i = rho & 15; return 8 * (i >> 2) + 4 * n + (i & 3); }
struct Unit { int pm, pn, e, nrows; };
struct StaticOrder {
    int nM, nN, nwg, G, c, dup;
    __device__ void init(int nM_, int nN_, int G_, int c_, int dup_ = 1) { nM = nM_; nN = nN_; nwg = nM * nN; G = G_; c = c_; dup = dup_; }
    __device__ bool next(int i, Unit& u) const {
        const long L0 = (long)i * G + c; if (L0 >= (long)nwg * dup) return false;
        const long L = L0 % nwg;
        int wgid = (int)L; { const int q = nwg / NXCD, r = nwg % NXCD, xcd = wgid % NXCD, off = wgid / NXCD; wgid = (xcd < r ? xcd * (q + 1) : r * (q + 1) + (xcd - r) * q) + off; }
        const int nig = WGM * nN, gid = wgid / nig, fm = gid * WGM, gsz = (nM - fm) < WGM ? (nM - fm) : WGM;
        u.pm = fm + ((wgid % nig) % gsz); u.pn = (wgid % nig) / gsz; u.e = 0; u.nrows = 256; return true;
    }
};

template <class Epi, class Sched, class AAddr, class BAddr>
__device__ __forceinline__ void gemm_phase(LAS unsigned char* lds, const int K, const Sched& S, const AAddr& AA, const BAddr& BA, const Epi& E) {
    constexpr bool GA = AAddr::GATHER;
    const int tid = threadIdx.x, wid = __builtin_amdgcn_readfirstlane(tid >> 6), lane = tid & 63, wr = wid >> 2, wc = wid & 3, fr = lane & 15, fq = lane >> 4;
    const int nt = K / BK;
    unsigned voffA[2], voffB[2];
#pragma unroll
    for (int i = 0; i < 2; ++i) { int R, C; stage_rc(tid * 16 + i * 8192, R, C); const int Rb = Epi::PERM ? ((R & ~31) + perm32(R & 31)) : R;
        voffA[i] = GA ? 0u : AA.lane_off(R, C); voffB[i] = (unsigned)(Rb * K + C) * 2u; }
    const size_t kstepA = (size_t)AA.kstep, kstepB = (size_t)(BK * 2);
    const size_t hstepB = (size_t)HALF * K * 2, hstepA = GA ? 0 : AA.hstep();
    const unsigned ldsw = (unsigned)wid * 1024u;
    const int aoff = lds_byte(wr * 64 + fr, fq * 8), boff = lds_byte(wc * 32 + fr, fq * 8);
#define PG8_SA(b, h) (((b) * 2 + (h)) * HTB)
#define PG8_SB(b, h) ((4 + (b) * 2 + (h)) * HTB)
#define PG8_STAGE(bufoff, gbase, voff) do { _Pragma("unroll") for (int _i = 0; _i < 2; ++_i) \
        __builtin_amdgcn_global_load_lds((const unsigned*)((const char*)(gbase) + (voff)[_i]), (LAS unsigned*)(lds + (bufoff) + ldsw + _i * 8192), 16, 0, 0); } while (0)
#define PG8_STA_CUR(bufoff, h, kb) do { if constexpr (GA) { if (h) PG8_STAGE(bufoff, baseA + (kb), cof1); else PG8_STAGE(bufoff, baseA + (kb), cof0); } \
        else PG8_STAGE(bufoff, cA + (h) * hstepA + (kb), voffA); } while (0)
#define PG8_STA_SEL(bufoff, h, kb) do { if constexpr (GA) { if (h) PG8_STAGE(bufoff, baseA + (kb), sof1); else PG8_STAGE(bufoff, baseA + (kb), sof0); } \
        else PG8_STAGE(bufoff, sA + (h) * hstepA + (kb), voffA); } while (0)
#define PG8_LDA(dst, b, h) do { _Pragma("unroll") for (int m = 0; m < 4; ++m) _Pragma("unroll") for (int k = 0; k < 2; ++k) dst[m][k] = *(const LAS bf16x8*)(lds + PG8_SA(b, h) + aoff + m * 2048 + k * 1024); } while (0)
#define PG8_LDB(dst, b, h) do { _Pragma("unroll") for (int n = 0; n < 2; ++n) _Pragma("unroll") for (int k = 0; k < 2; ++k) dst[n][k] = *(const LAS bf16x8*)(lds + PG8_SB(b, h) + boff + n * 2048 + k * 1024); } while (0)
#define PG8_MMA(ai, bj, At, Bt) do { __builtin_amdgcn_s_setprio(1); _Pragma("unroll") for (int m = 0; m < 4; ++m) _Pragma("unroll") for (int n = 0; n < 2; ++n) _Pragma("unroll") for (int k = 0; k < 2; ++k) \
        acc[ai][bj][m][n] = __builtin_amdgcn_mfma_f32_16x16x32_bf16(Bt[n][k], At[m][k], acc[ai][bj][m][n], 0, 0, 0); __builtin_amdgcn_s_setprio(0); } while (0)
#define PG8_WAIT_V(n) asm volatile("s_waitcnt vmcnt(" #n ")" ::: "memory")
#define PG8_WAIT_L(n) asm volatile("s_waitcnt lgkmcnt(" #n ")" ::: "memory")
#define PG8_BAR __builtin_amdgcn_s_barrier()
#define PG8_SCHED __builtin_amdgcn_sched_barrier(0)
#define PG8_GOFF(u, o0, o1) do { _Pragma("unroll") for (int _i = 0; _i < 2; ++_i) { int R_, C_; stage_rc(tid * 16 + _i * 8192, R_, C_); \
        o0[_i] = AA.row_off(u, R_) + (unsigned)C_ * 2u; o1[_i] = AA.row_off(u, R_ + HALF) + (unsigned)C_ * 2u; } } while (0)
    Unit cur, nxt; int ui = 0;
    if (!S.next(0, cur)) return;
    f32x4 acc[2][2][4][2];
#pragma unroll
    for (int a = 0; a < 2; ++a)
#pragma unroll
        for (int b = 0; b < 2; ++b)
#pragma unroll
            for (int m = 0; m < 4; ++m)
#pragma unroll
                for (int n = 0; n < 2; ++n) acc[a][b][m][n] = (f32x4){0.f, 0.f, 0.f, 0.f};
    bf16x8 At[4][2], B0[2][2], B1[2][2];
    const char* const baseA = GA ? (const char*)AA.base : nullptr;
    const char* cA = GA ? nullptr : (const char*)AA.unit_ptr(cur);
    unsigned cof0[2] = {0u, 0u}, cof1[2] = {0u, 0u}, nof0[2] = {0u, 0u}, nof1[2] = {0u, 0u};
    if constexpr (GA) PG8_GOFF(cur, cof0, cof1);
    const char* cB = (const char*)BA.ptr(cur);
    PG8_STAGE(PG8_SB(0, 0), cB, voffB); PG8_STA_CUR(PG8_SA(0, 0), 0, 0); PG8_STAGE(PG8_SB(0, 1), cB + hstepB, voffB); PG8_STA_CUR(PG8_SA(0, 1), 1, 0);
    if (wr == 1) PG8_BAR;
    PG8_WAIT_V(4); PG8_BAR;
    PG8_STAGE(PG8_SB(1, 0), cB + kstepB, voffB); PG8_STA_CUR(PG8_SA(1, 0), 0, kstepA); PG8_STAGE(PG8_SB(1, 1), cB + hstepB + kstepB, voffB);
    PG8_WAIT_V(6); PG8_BAR;
    for (;;) {
        const bool has_next = S.next(ui + 1, nxt);
        const char* nB = cB; const char* nA = cA;
        if (has_next) { nB = (const char*)BA.ptr(nxt); if constexpr (GA) PG8_GOFF(nxt, nof0, nof1); else nA = (const char*)AA.unit_ptr(nxt); }
        else { if constexpr (GA) {
#pragma unroll
            for (int i = 0; i < 2; ++i) { nof0[i] = cof0[i]; nof1[i] = cof1[i]; } } }
#pragma nounroll
        for (int t = 0; t < nt; t += 2) {
            const bool last = (t == nt - 2);
            const size_t k1 = (size_t)(t + 1) * kstepA, k2 = last ? 0 : (size_t)(t + 2) * kstepA, k3 = k2 + kstepA;
            const char* b2 = last ? nB : cB + (size_t)(t + 2) * kstepB; const char* b3 = b2 + kstepB;
            const char* sA = last ? nA : cA;
            unsigned sof0[2], sof1[2];
#pragma unroll
            for (int i = 0; i < 2; ++i) { sof0[i] = last ? nof0[i] : cof0[i]; sof1[i] = last ? nof1[i] : cof1[i]; }
            PG8_LDB(B0, 0, 0); PG8_SCHED; PG8_LDA(At, 0, 0); PG8_STA_CUR(PG8_SA(1, 1), 1, k1);
            PG8_WAIT_L(8); PG8_BAR; PG8_WAIT_L(0); PG8_MMA(0, 0, At, B0); PG8_BAR; PG8_SCHED;
            PG8_LDB(B1, 0, 1); PG8_STAGE(PG8_SB(0, 0), b2, voffB);
            PG8_BAR; PG8_WAIT_L(0); PG8_MMA(0, 1, At, B1); PG8_BAR;
            PG8_LDA(At, 0, 1); PG8_STA_SEL(PG8_SA(0, 0), 0, k2);
            PG8_BAR; PG8_WAIT_L(0); PG8_MMA(1, 0, At, B0); PG8_BAR; PG8_SCHED;
            PG8_STAGE(PG8_SB(0, 1), b2 + hstepB, voffB);
            PG8_WAIT_V(6); PG8_BAR; PG8_MMA(1, 1, At, B1); PG8_BAR;
            PG8_LDB(B0, 1, 0); PG8_SCHED; PG8_LDA(At, 1, 0); PG8_STA_SEL(PG8_SA(0, 1), 1, k2);
            PG8_WAIT_L(8); PG8_BAR; PG8_WAIT_L(0); PG8_MMA(0, 0, At, B0); PG8_BAR; PG8_SCHED;
            PG8_LDB(B1, 1, 1); PG8_STAGE(PG8_SB(1, 0), b3, voffB);
            PG8_BAR; PG8_WAIT_L(0); PG8_MMA(0, 1, At, B1); PG8_BAR;
            PG8_LDA(At, 1, 1); PG8_STA_SEL(PG8_SA(1, 0), 0, k3);
            PG8_BAR; PG8_WAIT_L(0); PG8_MMA(1, 0, At, B0); PG8_BAR; PG8_SCHED;
            PG8_STAGE(PG8_SB(1, 1), b3 + hstepB, voffB);
            PG8_WAIT_V(6); PG8_BAR; PG8_MMA(1, 1, At, B1); PG8_BAR;
        }
        E(acc, cur, wr, wc, fr, fq);
        if (!has_next) break;
#pragma unroll
        for (int a = 0; a < 2; ++a)
#pragma unroll
            for (int b = 0; b < 2; ++b)
#pragma unroll
                for (int m = 0; m < 4; ++m)
#pragma unroll
                    for (int n = 0; n < 2; ++n) acc[a][b][m][n] = (f32x4){0.f, 0.f, 0.f, 0.f};
        cur = nxt; cB = nB; cA = nA; ++ui;
        if constexpr (GA) {
#pragma unroll
            for (int i = 0; i < 2; ++i) { cof0[i] = nof0[i]; cof1[i] = nof1[i]; } }
    }
    PG8_WAIT_V(0);
    if (wr == 0) PG8_BAR;
    PG8_BAR;
#undef PG8_SA
#undef PG8_SB
#undef PG8_STAGE
#undef PG8_STA_CUR
#undef PG8_STA_SEL
#undef PG8_GOFF
#undef PG8_LDA
#undef PG8_LDB
#undef PG8_MMA
#undef PG8_WAIT_V
#undef PG8_WAIT_L
#undef PG8_BAR
#undef PG8_SCHED
}
}

constexpr int NWAVES = 8, NTHR = 512;
struct Args { const float* in[26]; float* out; unsigned char* ws; int ph_lo, ph_hi; unsigned repmask; int pad; };
struct Frame {
    LAS unsigned char* lds;
    int tid, lane, wave, G, bx;
    unsigned char* ws;
};

struct APlain { const void* base; unsigned kstep; unsigned ld2;
    static constexpr bool GATHER = false;
    __device__ __forceinline__ const void* unit_ptr(const pg8::Unit& u) const { return (const char*)base + (size_t)u.pm * 256 * ld2; }
    __device__ __forceinline__ unsigned lane_off(int R, int C) const { return (unsigned)R * ld2 + (unsigned)C * 2u; }
    __device__ __forceinline__ size_t hstep() const { return (size_t)128 * ld2; }
    __device__ __forceinline__ unsigned row_off(const pg8::Unit&, int) const { return 0u; } };
struct BPlain { const bf16* Bt; int K;
    __device__ __forceinline__ const void* ptr(const pg8::Unit& u) const { return Bt + (size_t)u.pn * 256 * K; } };

struct EpiZ {
    static constexpr bool PERM = true;
    bf16* ZA; bf16* ZG;
    __device__ __forceinline__ void operator()(const f32x4 (&acc)[2][2][4][2], const pg8::Unit& u, int wr, int wc, int fr, int fq) const {
        const bool gate = u.pn >= 11;
        bf16* base = gate ? ZG : ZA; const int ld = gate ? ZG_LD : ZA_LD; const int colt = gate ? (u.pn - 11) * 256 : u.pn * 256;
        const int row0 = u.pm * 256 + wr * 64 + fr, col0 = colt + wc * 32 + 8 * fq;
#pragma unroll
        for (int ai = 0; ai < 2; ++ai)
#pragma unroll
            for (int m = 0; m < 4; ++m) { bf16* rowp = base + (size_t)(row0 + ai * 128 + m * 16) * ld + col0;
#pragma unroll
                for (int bj = 0; bj < 2; ++bj) { f32x4 v0 = acc[ai][bj][m][0], v1 = acc[ai][bj][m][1];
                    if (gate) {
#pragma unroll
                        for (int j = 0; j < 4; ++j) { v0[j] = sigmoidf_(v0[j]); v1[j] = sigmoidf_(v1[j]); } }
                    u32x4 w; w.x = pk2(v0[0], v0[1]); w.y = pk2(v0[2], v0[3]); w.z = pk2(v1[0], v1[1]); w.w = pk2(v1[2], v1[3]);
                    *(u32x4*)(rowp + bj * 128) = w; } }
    }
};
template <int MODE> struct EpiGate {
    static constexpr bool PERM = true;
    const bf16* ZG; const bf16* T1; bf16* O;
    __device__ __forceinline__ void operator()(const f32x4 (&acc)[2][2][4][2], const pg8::Unit& u, int wr, int wc, int fr, int fq) const {
        const int row0 = u.pm * 256 + wr * 64 + fr, col0 = u.pn * 256 + wc * 32 + 8 * fq;
#pragma unroll
        for (int ai = 0; ai < 2; ++ai) {
            u32x4 gv[4][2], tv[4][2];
#pragma unroll
            for (int m = 0; m < 4; ++m)
#pragma unroll
                for (int bj = 0; bj < 2; ++bj) { const size_t r = (size_t)(row0 + ai * 128 + m * 16); const int c = col0 + bj * 128;
                    gv[m][bj] = *(const u32x4*)(ZG + r * ZG_LD + MODE * 1024 + c); if (MODE == 1) tv[m][bj] = *(const u32x4*)(T1 + r * 1024 + c); }
#pragma unroll
            for (int m = 0; m < 4; ++m)
#pragma unroll
                for (int bj = 0; bj < 2; ++bj) { asm volatile("" : "+v"(gv[m][bj])); if (MODE == 1) asm volatile("" : "+v"(tv[m][bj])); }
#pragma unroll
            for (int m = 0; m < 4; ++m) { const size_t r = (size_t)(row0 + ai * 128 + m * 16);
#pragma unroll
                for (int bj = 0; bj < 2; ++bj) { const int c = col0 + bj * 128; const u32x4 g = gv[m][bj];
                    const f32x4 v0 = acc[ai][bj][m][0], v1 = acc[ai][bj][m][1];
                    float o[8] = { v0[0] * bflo(g.x), v0[1] * bfhi(g.x), v0[2] * bflo(g.y), v0[3] * bfhi(g.y), v1[0] * bflo(g.z), v1[1] * bfhi(g.z), v1[2] * bflo(g.w), v1[3] * bfhi(g.w) };
                    if (MODE == 1) { const u32x4 t = tv[m][bj];
                        o[0] += bflo(t.x); o[1] += bfhi(t.x); o[2] += bflo(t.y); o[3] += bfhi(t.y); o[4] += bflo(t.z); o[5] += bfhi(t.z); o[6] += bflo(t.w); o[7] += bfhi(t.w); }
                    u32x4 w; w.x = pk2(o[0], o[1]); w.y = pk2(o[2], o[3]); w.z = pk2(o[4], o[5]); w.w = pk2(o[6], o[7]);
                    *(u32x4*)(O + r * 1024 + c) = w; } }
        }
    }
};
struct EpiRes {
    static constexpr bool PERM = true;
    const float* X; bf16* O;
    __device__ __forceinline__ void operator()(const f32x4 (&acc)[2][2][4][2], const pg8::Unit& u, int wr, int wc, int fr, int fq) const {
        const int row0 = u.pm * 256 + wr * 64 + fr, col0 = u.pn * 256 + wc * 32 + 8 * fq;
#pragma unroll
        for (int ai = 0; ai < 2; ++ai) {
            f32x4 xv[4][2][2];
#pragma unroll
            for (int m = 0; m < 4; ++m)
#pragma unroll
                for (int bj = 0; bj < 2; ++bj) { const size_t off = (size_t)(row0 + ai * 128 + m * 16) * D + col0 + bj * 128; xv[m][bj][0] = *(const f32x4*)(X + off); xv[m][bj][1] = *(const f32x4*)(X + off + 4); }
#pragma unroll
            for (int m = 0; m < 4; ++m)
#pragma unroll
                for (int bj = 0; bj < 2; ++bj) { asm volatile("" : "+v"(xv[m][bj][0])); asm volatile("" : "+v"(xv[m][bj][1])); }
#pragma unroll
            for (int m = 0; m < 4; ++m)
#pragma unroll
                for (int bj = 0; bj < 2; ++bj) { const size_t off = (size_t)(row0 + ai * 128 + m * 16) * D + col0 + bj * 128;
                    const f32x4 v0 = xv[m][bj][0] * ALPHA + acc[ai][bj][m][0], v1 = xv[m][bj][1] * ALPHA + acc[ai][bj][m][1];
                    u32x4 w; w.x = pk2(v0[0], v0[1]); w.y = pk2(v0[2], v0[3]); w.z = pk2(v1[0], v1[1]); w.w = pk2(v1[2], v1[3]);
                    *(u32x4*)(O + off) = w; }
        }
    }
};

template <class F>
__device__ __forceinline__ void p0_tile(const F& f, bf16* WT, int ldk, int k0, int n0, LAS float* scr, int lane) {
    if constexpr (F::FOLD) {
        float bc[64];
#pragma unroll
        for (int d = 0; d < 64; ++d) bc[d] = f.bval(k0, d, n0 + (lane & 31));
#pragma unroll 4
        for (int i = 0; i < 32; ++i) { const int kk = 2 * i + (lane >> 5); const f32x4* ar = (const f32x4*)f.arow(k0 + kk, n0); f32x4 a4 = {0.f, 0.f, 0.f, 0.f};
#pragma unroll
            for (int q = 0; q < 16; ++q) { const f32x4 av = ar[q]; a4[0] += av[0] * bc[4 * q]; a4[1] += av[1] * bc[4 * q + 1]; a4[2] += av[2] * bc[4 * q + 2]; a4[3] += av[3] * bc[4 * q + 3]; }
            scr[kk * 33 + (lane & 31)] = (a4[0] + a4[1]) + (a4[2] + a4[3]); }
    } else {
        float v[32];
#pragma unroll
        for (int i = 0; i < 32; ++i) { const int kk = 2 * i + (lane >> 5); v[i] = f(k0 + kk, n0 + (lane & 31)); }
#pragma unroll
        for (int i = 0; i < 32; ++i) { const int kk = 2 * i + (lane >> 5); scr[kk * 33 + (lane & 31)] = v[i]; }
    }
    LDS_WAIT(); asm volatile("" ::: "memory");
    const int c = lane & 7;
#pragma unroll
    for (int j = 0; j < 4; ++j) { const int n = (lane >> 3) + 8 * j; const LAS float* s = scr + (8 * c) * 33 + n;
        u32x4 o; o.x = pk2(s[0 * 33], s[1 * 33]); o.y = pk2(s[2 * 33], s[3 * 33]); o.z = pk2(s[4 * 33], s[5 * 33]); o.w = pk2(s[6 * 33], s[7 * 33]);
        *(u32x4*)(WT + (size_t)(n0 + n) * ldk + k0 + 8 * c) = o; }
    LDS_WAIT(); asm volatile("" ::: "memory");
}
struct P0Item { const float* src; int N, noff; bf16* dst; int ldk, k0, n0; };
__device__ __forceinline__ void p0_item_load(const P0Item& it, float (&v)[32], int lane) {
#pragma unroll
    for (int i = 0; i < 32; ++i) { const int kk = 2 * i + (lane >> 5); v[i] = it.src[(size_t)(it.k0 + kk) * it.N + it.n0 + (lane & 31) + it.noff]; }
}
__device__ __forceinline__ void p0_item_finish(const P0Item& it, const float (&v)[32], LAS float* scr, int lane) {
#pragma unroll
    for (int i = 0; i < 32; ++i) { const int kk = 2 * i + (lane >> 5); scr[kk * 33 + (lane & 31)] = v[i]; }
    LDS_WAIT(); asm volatile("" ::: "memory");
    const int c = lane & 7;
#pragma unroll
    for (int j = 0; j < 4; ++j) { const int n = (lane >> 3) + 8 * j; const LAS float* s = scr + (8 * c) * 33 + n;
        u32x4 o; o.x = pk2(s[0 * 33], s[1 * 33]); o.y = pk2(s[2 * 33], s[3 * 33]); o.z = pk2(s[4 * 33], s[5 * 33]); o.w = pk2(s[6 * 33], s[7 * 33]);
        *(u32x4*)(it.dst + (size_t)(it.n0 + n) * it.ldk + it.k0 + 8 * c) = o; }
    LDS_WAIT(); asm volatile("" ::: "memory");
}
__device__ __forceinline__ int zsrc_col(int n) {
    if (n < 1280) return n;
    if (n < 2304) return -2;
    if (n < 2432) return 1816 + (n - 2304);
    if (n < 2688) return 1944 + (n - 2432);
    if (n < 2752) return 2200 + (n - 2688);
    if (n < 2776) return 1280 + (n - 2752);
    if (n < 2780) return 2264 + (n - 2776);
    if (n < 2816) return -1;
    if (n < 3840) return 2268 + (n - 2816);
    return 3292 + (n - 3840);
}
struct FWin { const float* w_in; static constexpr bool FOLD = false;
    __device__ __forceinline__ float operator()(int k, int n) const { const int s = zsrc_col(n); return s >= 0 ? w_in[(size_t)k * D_IN + s] : 0.f; } };
struct FWinQ { const float* w_in; const float* w_uk; static constexpr bool FOLD = true;
    __device__ __forceinline__ const float* arow(int k, int n0) const { return w_in + (size_t)k * D_IN + 1304 + ((n0 - 1280) >> 7) * 64; }
    __device__ __forceinline__ float bval(int, int d, int n) const { return w_uk[(size_t)((n - 1280) >> 7) * 64 * 128 + d * 128 + ((n - 1280) & 127)]; }
    __device__ __forceinline__ float operator()(int, int) const { return 0.f; } };
struct FWb { const float* w_uv; const float* w_bb; static constexpr bool FOLD = true;
    __device__ __forceinline__ const float* arow(int k, int) const { return w_uv + (size_t)k * 64; }
    __device__ __forceinline__ float bval(int k0, int d, int n) const { return w_bb[(size_t)((k0 >> 7) * 64 + d) * D + n]; }
    __device__ __forceinline__ float operator()(int, int) const { return 0.f; } };
struct FPlain { const float* W; int N; static constexpr bool FOLD = false; __device__ __forceinline__ float operator()(int k, int n) const { return W[(size_t)k * N + n]; } };
struct FOff { const float* W; int N; int noff; static constexpr bool FOLD = false;
    __device__ __forceinline__ float operator()(int k, int n) const { return W[(size_t)k * N + n + noff]; } };

__device__ __forceinline__ float rel_bucket_bias(const float* rel_bias, int dist, int head) {
    int b;
    if (dist < 16) b = dist;
    else { const float t = (__log2f((float)dist) - 4.0f) * 2.66666675f; b = 16 + (int)t; if (b > 31) b = 31; }
    return rel_bias[b * 16 + head];
}

constexpr int P0_EXP_ITEMS = NEXP * ((1024 / 64) * (512 / 32) + (256 / 64) * (1024 / 32)), P0_EXP_SPLIT = (P0_EXP_ITEMS * 2) / 3;
__device__ __forceinline__ void p0_experts(const Frame& F, const Args& a, int wv, int nwv, int ibeg, int iend) {
    LAS float* scr = (LAS float*)(F.lds + F.wave * 16384);
    unsigned char* ws = F.ws;
    constexpr int I_GU = (1024 / 64) * (512 / 32), I_DN = (256 / 64) * (1024 / 32);
    const int gw = wv, NGW = nwv;
    {
        constexpr int NEI = NEXP * (I_GU + I_DN);
        auto mk = [&](int idx) { P0Item it; const int e = idx / (I_GU + I_DN); int r = idx - e * (I_GU + I_DN);
            if (r < I_GU) {
                const int n0 = (r % 16) * 32; const uintptr_t pg = (uintptr_t)a.in[21], pu = (uintptr_t)a.in[22];
                it.src = (const float*)(pg + (uintptr_t)((n0 >> 7) & 1) * (pu - pg)) + (size_t)e * D * DEXP; it.N = DEXP; it.noff = ((n0 >> 8) * 128 + (n0 & 127)) - n0;
                it.dst = (bf16*)(ws + WS_WGU) + (size_t)e * 512 * 1024; it.ldk = 1024; it.k0 = (r / 16) * 64; it.n0 = n0; }
            else { r -= I_GU; it.src = a.in[23] + (size_t)e * DEXP * D; it.N = D; it.noff = 0; it.dst = (bf16*)(ws + WS_WDT) + (size_t)e * 1024 * 256; it.ldk = 256; it.k0 = (r / 32) * 64; it.n0 = (r % 32) * 32; }
            return it; };
        float va[32], vb[32];
        {
        (void)NEI;
        int idx = ibeg + gw;
        if (idx < iend) { P0Item cur = mk(idx); p0_item_load(cur, va, F.lane);
            for (;;) {
                const int nidx = idx + NGW; const bool more = nidx < iend; P0Item nxt = cur;
                if (more) { nxt = mk(nidx); p0_item_load(nxt, vb, F.lane); }
                p0_item_finish(cur, va, scr, F.lane);
                if (!more) break;
#pragma unroll
                for (int i = 0; i < 32; ++i) va[i] = vb[i];
                cur = nxt; idx = nidx; } }
        }
    }
}
__device__ __forceinline__ void phase0(const Frame& F, const Args& a) {
    LAS float* scr = (LAS float*)(F.lds + F.wave * 16384);
    const int gw = F.bx * NWAVES + F.wave, NGW = F.G * NWAVES;
    unsigned char* ws = F.ws;
    constexpr int I_WIN = (D / 64) * (NZ / 32);
    constexpr int I_WB = (1024 / 64) * (1024 / 32);
    constexpr int I_WA = (512 / 64) * (1024 / 32);
    constexpr int I_WO = I_WB;
    constexpr int I_W1 = (2048 / 64) * (256 / 32);
    constexpr int I_W2 = (256 / 64) * (64 / 32);
    constexpr int I_GU = (1024 / 64) * (512 / 32);
    constexpr int I_DN = (256 / 64) * (1024 / 32);
    constexpr int NITEMS = I_WIN + I_WB + I_WA + I_WO + 2 * I_W1 + 2 * I_W2;
    (void)NITEMS;
    constexpr int I_WINP = (D / 64) * ((NZ - 1024) / 32);
    for (int it = gw; it < 1024; it += NGW) {
        if (it < 512) { const int k0 = (it >> 5) * 64, n0 = 1280 + (it & 31) * 32; const FWinQ f{a.in[1], a.in[9]}; p0_tile(f, (bf16*)(ws + WS_WINT), D, k0, n0, scr, F.lane); }
        else { const int r = it - 512; const FWb f{a.in[10], a.in[13]}; p0_tile(f, (bf16*)(ws + WS_WBT), 1024, (r / 32) * 64, (r % 32) * 32, scr, F.lane); }
    }
    { constexpr int NPL = I_WINP + I_WA + I_WO + 2 * I_W1 + 2 * I_W2;
      const int pw0 = NGW > 1024 ? (gw >= 1024 ? gw - 1024 : -1) : gw, pws = NGW > 1024 ? NGW - 1024 : NGW;
      if (pw0 >= 0) for (int it = pw0; it < NPL; it += pws) {
        int r = it;
        if (r < I_WINP) { const int k0 = (r / 120) * 64; int nb = r % 120; nb = nb < 40 ? nb : nb + 32; const FWin f{a.in[1]}; p0_tile(f, (bf16*)(ws + WS_WINT), D, k0, nb * 32, scr, F.lane); continue; } r -= I_WINP;
        if (r < I_WA) { const FPlain f{a.in[12], D}; p0_tile(f, (bf16*)(ws + WS_WAT), 512, (r / 32) * 64, (r % 32) * 32, scr, F.lane); continue; } r -= I_WA;
        if (r < I_WO) { const FPlain f{a.in[14], D}; p0_tile(f, (bf16*)(ws + WS_WOT), 1024, (r / 32) * 64, (r % 32) * 32, scr, F.lane); continue; } r -= I_WO;
        if (r < I_W1) { const FPlain f{a.in[4], 256}; p0_tile(f, (bf16*)(ws + WS_W1K), 2048, (r / 8) * 64, (r % 8) * 32, scr, F.lane); continue; } r -= I_W1;
        if (r < I_W1) { const FPlain f{a.in[6], 256}; p0_tile(f, (bf16*)(ws + WS_W1V), 2048, (r / 8) * 64, (r % 8) * 32, scr, F.lane); continue; } r -= I_W1;
        if (r < I_W2) { const FPlain f{a.in[5], 64}; p0_tile(f, (bf16*)(ws + WS_W2K), 256, (r / 2) * 64, (r % 2) * 32, scr, F.lane); continue; } r -= I_W2;
        { const FPlain f{a.in[7], 64}; p0_tile(f, (bf16*)(ws + WS_W2V), 256, (r / 2) * 64, (r % 2) * 32, scr, F.lane); }
      } }
    { const int nu = (NTOK / 256) * (NZ / 256); if ((nu % F.G) == 0) p0_experts(F, a, gw, NGW, 0, P0_EXP_ITEMS); }
    { const f32x4* x4 = (const f32x4*)a.in[0]; u32x2* o = (u32x2*)(ws + WS_XB);
      const size_t total = (size_t)NTOK * D / 4, stride = (size_t)F.G * NTHR;
      for (size_t i0 = (size_t)F.bx * NTHR + F.tid; i0 < total; i0 += 8 * stride) { f32x4 v[8];
#pragma unroll
          for (int j = 0; j < 8; ++j) { const size_t i = i0 + j * stride; v[j] = i < total ? x4[i] : (f32x4){0.f, 0.f, 0.f, 0.f}; }
#pragma unroll
          for (int j = 0; j < 8; ++j) { const size_t i = i0 + j * stride; if (i < total) { u32x2 w; w.x = pk2(v[j][0], v[j][1]); w.y = pk2(v[j][2], v[j][3]); o[i] = w; } } } }
    if (F.bx < 64 && F.tid < 256) {
        const int kv = F.bx >> 5, j = F.bx & 31;
        const float* pe = (kv ? a.in[3] : a.in[2]) + 64 * j; const float* w1 = (kv ? a.in[6] : a.in[4]) + (size_t)(64 * j) * 256 + F.tid; float acc = 0.f;
#pragma unroll 16
        for (int k = 0; k < 64; ++k) acc += pe[k] * w1[(size_t)k * 256];
        ((float*)(ws + WS_BIASK))[(kv * 32 + j) * 256 + F.tid] = acc;
    }
    if (F.bx >= 64 && F.bx < 96) { const int idx = (F.bx - 64) * NTHR + F.tid;
        const int tab = idx >> 13, head = (idx >> 10) & 7, dist = idx & 1023;
        ((float*)(ws + (tab ? WS_TBB : WS_TBA)))[head * 1024 + dist] = rel_bucket_bias(a.in[11], dist, tab * 8 + head) * LOG2E; }
}

constexpr int NRT = 36;
constexpr int P6_WR = 0;
constexpr int P6_CNT = 147456;
constexpr int P6_ENT = 147456 + 512;
__device__ __forceinline__ float row16_sum(float v) {
    v += __builtin_bit_cast(float, __builtin_amdgcn_update_dpp(0, __builtin_bit_cast(int, v), 0xB1, 0xf, 0xf, true));
    v += __builtin_bit_cast(float, __builtin_amdgcn_update_dpp(0, __builtin_bit_cast(int, v), 0x4E, 0xf, 0xf, true));
    v += __builtin_bit_cast(float, __builtin_amdgcn_update_dpp(0, __builtin_bit_cast(int, v), 0x141, 0xf, 0xf, true));
    v += __builtin_bit_cast(float, __builtin_amdgcn_update_dpp(0, __builtin_bit_cast(int, v), 0x140, 0xf, 0xf, true));
    return v;
}
__device__ __forceinline__ float wave_sum_dpp(float v) { v = row16_sum(v); v += __shfl_xor(v, 16); v += __shfl_xor(v, 32); return v; }
__device__ __forceinline__ void phase6(const Frame& F, const Args& a) {
    unsigned char* ws = F.ws;
    LAS float* WR = (LAS float*)(F.lds + P6_WR);
    LAS int* cntL = (LAS int*)(F.lds + P6_CNT); LAS int* baseL = cntL + 32;
    LAS int* ent = (LAS int*)(F.lds + P6_ENT);
    const float* w_grp = a.in[17]; const float* b_grp = a.in[18]; const float* w_rtr = a.in[19]; const float* b_rtr = a.in[20];
    {
        f32x4 wv[16], gv2[2];
#pragma unroll
        for (int i = 0; i < 16; ++i) wv[i] = *(const f32x4*)(w_rtr + 4 * (F.tid + NTHR * i));
#pragma unroll
        for (int i = 0; i < 2; ++i) gv2[i] = *(const f32x4*)(w_grp + 4 * (F.tid + NTHR * i));
#pragma unroll
        for (int i = 0; i < 16; ++i) { const int e = 4 * (F.tid + NTHR * i), k = e >> 5, o = e & 31;
#pragma unroll
            for (int c = 0; c < 4; ++c) WR[(4 + o + c) * 1024 + k] = wv[i][c]; }
#pragma unroll
        for (int i = 0; i < 2; ++i) { const int k = F.tid + NTHR * i;
#pragma unroll
            for (int c = 0; c < 4; ++c) WR[c * 1024 + k] = gv2[i][c]; }
    }
    if (F.tid < 65) cntL[F.tid] = 0;
    __syncthreads();
    const bf16* HP = (const bf16*)(ws + WS_H1); bf16* H1B = (bf16*)(ws + WS_H1B);
    const float* lg = a.in[15]; const float* lb = a.in[16];
    f32x2 gam[8], bet[8];
#pragma unroll
    for (int j = 0; j < 2; ++j)
#pragma unroll
        for (int q = 0; q < 4; ++q) { gam[4 * j + q] = *(const f32x2*)(lg + 512 * j + 8 * F.lane + 2 * q); bet[4 * j + q] = *(const f32x2*)(lb + 512 * j + 8 * F.lane + 2 * q); }
    unsigned* gcnt = (unsigned*)(ws + WS_CTL) + CW_CNT;
    int* list = (int*)(ws + WS_LIST); float* tokinfo = (float*)(ws + WS_TOKINFO);
    const int gw = F.bx * NWAVES + F.wave, NGW = F.G * NWAVES;
    u32x4 nx0, nx1;
    const int rpb = (NTOK + F.G - 1) / F.G, rbeg = F.bx * rpb, rend = (rbeg + rpb < NTOK) ? rbeg + rpb : NTOK;
    (void)gw; (void)NGW;
    if (rbeg + F.wave < rend) { const u32x4* hr = (const u32x4*)(HP + (size_t)(rbeg + F.wave) * D) + F.lane; nx0 = hr[0]; nx1 = hr[64]; }
    for (int row = rbeg + F.wave; row < rend; row += NWAVES) {
        const u32x4 r0 = nx0, r1 = nx1;
        if (row + NWAVES < rend) { const u32x4* hr = (const u32x4*)(HP + (size_t)(row + NWAVES) * D) + F.lane; nx0 = hr[0]; nx1 = hr[64]; }
        f32x2 v[8];
        v[0] = (f32x2){bflo(r0.x), bfhi(r0.x)}; v[1] = (f32x2){bflo(r0.y), bfhi(r0.y)}; v[2] = (f32x2){bflo(r0.z), bfhi(r0.z)}; v[3] = (f32x2){bflo(r0.w), bfhi(r0.w)};
        v[4] = (f32x2){bflo(r1.x), bfhi(r1.x)}; v[5] = (f32x2){bflo(r1.y), bfhi(r1.y)}; v[6] = (f32x2){bflo(r1.z), bfhi(r1.z)}; v[7] = (f32x2){bflo(r1.w), bfhi(r1.w)};
        f32x2 s2 = v[0];
#pragma unroll
        for (int q = 1; q < 8; ++q) s2 += v[q];
        const float mean = wave_sum_dpp(s2[0] + s2[1]) * (1.f / D);
        f32x2 q2 = {0.f, 0.f};
#pragma unroll
        for (int q = 0; q < 8; ++q) { v[q] = v[q] - mean; q2 += v[q] * v[q]; }
        const float rstd = 1.0f / sqrtf(wave_sum_dpp(q2[0] + q2[1]) * (1.f / D) + 1e-5f);
#pragma unroll
        for (int q = 0; q < 8; ++q) v[q] = v[q] * rstd * gam[q] + bet[q];
        { u32x4 w0, w1; w0.x = pk2(v[0][0], v[0][1]); w0.y = pk2(v[1][0], v[1][1]); w0.z = pk2(v[2][0], v[2][1]); w0.w = pk2(v[3][0], v[3][1]);
          w1.x = pk2(v[4][0], v[4][1]); w1.y = pk2(v[5][0], v[5][1]); w1.z = pk2(v[6][0], v[6][1]); w1.w = pk2(v[7][0], v[7][1]);
          u32x4* ob = (u32x4*)(H1B + (size_t)row * D) + F.lane; ob[0] = w0; ob[64] = w1; }
        auto rdot = [&](int o) { f32x2 p2 = {0.f, 0.f};
#pragma unroll
            for (int j = 0; j < 2; ++j) { const f32x4 wa = *(const LAS f32x4*)(WR + o * 1024 + 512 * j + 8 * F.lane), wb = *(const LAS f32x4*)(WR + o * 1024 + 512 * j + 8 * F.lane + 4);
                p2 += v[4 * j] * (f32x2){wa[0], wa[1]}; p2 += v[4 * j + 1] * (f32x2){wa[2], wa[3]}; p2 += v[4 * j + 2] * (f32x2){wb[0], wb[1]}; p2 += v[4 * j + 3] * (f32x2){wb[2], wb[3]}; }
            return row16_sum(p2[0] + p2[1]); };
        float g[4];
#pragma unroll
        for (int i = 0; i < 4; ++i) g[i] = rdot(i);
#pragma unroll
        for (int i = 0; i < 4; ++i) { float t = g[i]; t += __shfl_xor(t, 16); t += __shfl_xor(t, 32); g[i] = t + b_grp[i]; }
        int gs = 0; float gm = g[0];
#pragma unroll
        for (int i = 1; i < 4; ++i) if (g[i] > gm) { gm = g[i]; gs = i; }
        gs = __builtin_amdgcn_readfirstlane(gs);
        float gsum = 0.f;
#pragma unroll
        for (int i = 0; i < 4; ++i) gsum += __expf(g[i] - gm);
        const float pgrp = 1.0f / gsum;
        float el[8];
#pragma unroll
        for (int i = 0; i < 8; ++i) el[i] = rdot(4 + gs * 8 + i);
#pragma unroll
        for (int i = 0; i < 8; ++i) { float t = el[i]; t += __shfl_xor(t, 16); t += __shfl_xor(t, 32); el[i] = t + b_rtr[gs * 8 + i]; }
        int i1 = 0; float l1 = el[0];
#pragma unroll
        for (int i = 1; i < 8; ++i) if (el[i] > l1) { l1 = el[i]; i1 = i; }
        int i2 = -1; float l2 = -3.0e38f;
#pragma unroll
        for (int i = 0; i < 8; ++i) if (i != i1 && el[i] > l2) { l2 = el[i]; i2 = i; }
        const float e2 = __expf(l2 - l1), inv = 1.0f / (1.0f + e2);
        const float w0 = pgrp * inv, w1 = pgrp * e2 * inv;
        const int e0 = gs * 8 + i1, e1 = gs * 8 + i2;
        if (F.lane == 0) {
            const int p0 = atomicAdd((int*)&cntL[e0], 1), p1 = atomicAdd((int*)&cntL[e1], 1);
            const int n0 = atomicAdd((int*)&cntL[64], 2);
            ent[2 * n0] = (e0 << 16) | p0; ent[2 * n0 + 1] = row * 2;
            ent[2 * n0 + 2] = (e1 << 16) | p1; ent[2 * n0 + 3] = row * 2 + 1;
            tokinfo[row * 2] = w0; tokinfo[row * 2 + 1] = w1;
        }
    }
    __syncthreads();
    if (F.tid < 32) { const int c = cntL[F.tid]; baseL[F.tid] = c > 0 ? (int)__hip_atomic_fetch_add(gcnt + 64 * F.tid, (unsigned)c, __ATOMIC_RELAXED, __HIP_MEMORY_SCOPE_AGENT) : 0; }
    __syncthreads();
    const int nent = cntL[64];
    for (int i = F.tid; i < nent; i += NTHR) { const int ep = ent[2 * i], tk = ent[2 * i + 1]; const int e = ep >> 16, p = ep & 0xffff; list[(size_t)e * NTOK + baseL[e] + p] = tk; }
    __syncthreads();
}

constexpr int MOE_CUM = 131072;
struct MoeOrder {
    int G, c, NP; const LAS int* cum; const LAS int* cnt;
    __device__ bool next(int i, pg8::Unit& u) const {
        const int L = i * G + c, t = L / NP; if (t >= cum[32]) return false;
        const int e = cum[80 + t];
        const int j = t - cum[e]; u.pm = t; u.pn = L % NP; u.e = e | (j << 8); const int rem = cnt[e] - j * 256; u.nrows = rem < 256 ? rem : 256; return true;
    }
};
__device__ __forceinline__ void moe_setup(const Frame& F) {
    LAS int* cum = (LAS int*)(F.lds + MOE_CUM); LAS int* cnt = cum + 40;
    const unsigned* gcnt = (const unsigned*)(F.ws + WS_CTL) + CW_CNT;
    if (F.tid < 32) cnt[F.tid] = (int)__hip_atomic_load(gcnt + 64 * F.tid, __ATOMIC_RELAXED, __HIP_MEMORY_SCOPE_AGENT);
    __syncthreads();
    if (F.tid == 0) { int s = 0; for (int e = 0; e < 32; ++e) { cum[e] = s; s += (cnt[e] + 255) >> 8; } cum[32] = s; }
    __syncthreads();
    for (int t = F.tid; t < cum[32]; t += NTHR) { int e = 0; for (int k = 1; k < 32; ++k) if (t >= cum[k]) e = k; cum[80 + t] = e; }
    __syncthreads();
}
struct AGather { const void* base; unsigned kstep; const int* list;
    static constexpr bool GATHER = true;
    __device__ __forceinline__ const void* unit_ptr(const pg8::Unit&) const { return base; }
    __device__ __forceinline__ unsigned lane_off(int, int) const { return 0u; }
    __device__ __forceinline__ size_t hstep() const { return 0; }
    __device__ __forceinline__ unsigned row_off(const pg8::Unit& u, int r) const { const int e = u.e & 255, j = u.e >> 8; const int rr = r < u.nrows ? r : 0;
        const int tk = list[(size_t)e * NTOK + j * 256 + rr]; return (unsigned)(tk >> 1) * (unsigned)(D * 2); } };
struct BGu { const bf16* W; __device__ __forceinline__ const void* ptr(const pg8::Unit& u) const { return W + (size_t)(u.e & 255) * 512 * 1024 + (size_t)u.pn * 256 * 1024; } };
struct BDn { const bf16* W; __device__ __forceinline__ const void* ptr(const pg8::Unit& u) const { return W + (size_t)(u.e & 255) * 1024 * 256 + (size_t)u.pn * 256 * 256; } };
struct EpiAct {
    static constexpr bool PERM = true; bf16* ACT;
    __device__ __forceinline__ void operator()(const f32x4 (&acc)[2][2][4][2], const pg8::Unit& u, int wr, int wc, int fr, int fq) const {
        const int row0 = u.pm * 256 + wr * 64 + fr, col0 = u.pn * 128 + wc * 32 + 8 * fq;
#pragma unroll
        for (int ai = 0; ai < 2; ++ai)
#pragma unroll
            for (int m = 0; m < 4; ++m) { float o[8];
#pragma unroll
                for (int n = 0; n < 2; ++n)
#pragma unroll
                    for (int j = 0; j < 4; ++j) { const float gt = acc[ai][0][m][n][j], up = acc[ai][1][m][n][j]; o[4 * n + j] = gt * sigmoidf_(gt) * up; }
                u32x4 w; w.x = pk2(o[0], o[1]); w.y = pk2(o[2], o[3]); w.z = pk2(o[4], o[5]); w.w = pk2(o[6], o[7]);
                *(u32x4*)(ACT + (size_t)(row0 + ai * 128 + m * 16) * DEXP + col0) = w; }
    }
};
struct EpiDown {
    static constexpr bool PERM = true; bf16* Y; const int* list;
    __device__ __forceinline__ void operator()(const f32x4 (&acc)[2][2][4][2], const pg8::Unit& u, int wr, int wc, int fr, int fq) const {
        const int e = u.e & 255, j = u.e >> 8; const int col0 = u.pn * 256 + wc * 32 + 8 * fq;
        int tks[2][4];
#pragma unroll
        for (int ai = 0; ai < 2; ++ai)
#pragma unroll
            for (int m = 0; m < 4; ++m) { const int r = ai * 128 + wr * 64 + m * 16 + fr; tks[ai][m] = r < u.nrows ? list[(size_t)e * NTOK + j * 256 + r] : -1; }
#pragma unroll
        for (int ai = 0; ai < 2; ++ai)
#pragma unroll
            for (int m = 0; m < 4; ++m) { const int tk = tks[ai][m];
                if (tk >= 0) { bf16* rowp = Y + (size_t)tk * D + col0;
#pragma unroll
                    for (int bj = 0; bj < 2; ++bj) { const f32x4 v0 = acc[ai][bj][m][0], v1 = acc[ai][bj][m][1];
                        u32x4 w; w.x = pk2(v0[0], v0[1]); w.y = pk2(v0[2], v0[3]); w.z = pk2(v1[0], v1[1]); w.w = pk2(v1[2], v1[3]);
                        *(u32x4*)(rowp + bj * 128) = w; } } }
    }
};

__device__ __forceinline__ void phase9(const Frame& F, const Args& a) {
    unsigned char* ws = F.ws;
    const bf16* H1B = (const bf16*)(ws + WS_H1B); const bf16* Y = (const bf16*)(ws + WS_YBUF); const float* tokinfo = (const float*)(ws + WS_TOKINFO);
    const float* lg = a.in[24]; const float* lb = a.in[25];
    f32x4 gam[4], bet[4];
#pragma unroll
    for (int j = 0; j < 2; ++j) { gam[2 * j] = *(const f32x4*)(lg + 512 * j + 8 * F.lane); gam[2 * j + 1] = *(const f32x4*)(lg + 512 * j + 8 * F.lane + 4); bet[2 * j] = *(const f32x4*)(lb + 512 * j + 8 * F.lane); bet[2 * j + 1] = *(const f32x4*)(lb + 512 * j + 8 * F.lane + 4); }
    const int gw = F.bx * NWAVES + F.wave, NGW = F.G * NWAVES;
    u32x4 nh[2], ny0[2], ny1[2]; float nw0 = 0.f, nw1 = 0.f;
#define P9_LOAD(row_) do { const u32x4* hp_ = (const u32x4*)(H1B + (size_t)(row_) * D) + F.lane; const u32x4* y0_ = (const u32x4*)(Y + (size_t)((row_) * 2) * D) + F.lane; const u32x4* y1_ = (const u32x4*)(Y + (size_t)((row_) * 2 + 1) * D) + F.lane; \
        nh[0] = hp_[0]; nh[1] = hp_[64]; ny0[0] = y0_[0]; ny0[1] = y0_[64]; ny1[0] = y1_[0]; ny1[1] = y1_[64]; nw0 = tokinfo[(row_) * 2]; nw1 = tokinfo[(row_) * 2 + 1]; } while (0)
    if (gw < NTOK) P9_LOAD(gw);
    for (int row = gw; row < NTOK; row += NGW) {
        u32x4 h[2] = {nh[0], nh[1]}, p[2] = {ny0[0], ny0[1]}, q[2] = {ny1[0], ny1[1]}; const float w0 = nw0, w1 = nw1;
        if (row + NGW < NTOK) P9_LOAD(row + NGW);
        f32x4 v[4]; float s = 0.f;
#pragma unroll
        for (int j = 0; j < 2; ++j) {
            v[2 * j][0] = ALPHA * bflo(h[j].x) + w0 * bflo(p[j].x) + w1 * bflo(q[j].x); v[2 * j][1] = ALPHA * bfhi(h[j].x) + w0 * bfhi(p[j].x) + w1 * bfhi(q[j].x);
            v[2 * j][2] = ALPHA * bflo(h[j].y) + w0 * bflo(p[j].y) + w1 * bflo(q[j].y); v[2 * j][3] = ALPHA * bfhi(h[j].y) + w0 * bfhi(p[j].y) + w1 * bfhi(q[j].y);
            v[2 * j + 1][0] = ALPHA * bflo(h[j].z) + w0 * bflo(p[j].z) + w1 * bflo(q[j].z); v[2 * j + 1][1] = ALPHA * bfhi(h[j].z) + w0 * bfhi(p[j].z) + w1 * bfhi(q[j].z);
            v[2 * j + 1][2] = ALPHA * bflo(h[j].w) + w0 * bflo(p[j].w) + w1 * bflo(q[j].w); v[2 * j + 1][3] = ALPHA * bfhi(h[j].w) + w0 * bfhi(p[j].w) + w1 * bfhi(q[j].w); }
#pragma unroll
        for (int j = 0; j < 4; ++j) s += (v[j][0] + v[j][1]) + (v[j][2] + v[j][3]);
        const float mean = wave_sum_dpp(s) * (1.f / D); float s2 = 0.f;
#pragma unroll
        for (int j = 0; j < 4; ++j) { v[j] = v[j] - mean; s2 += (v[j][0] * v[j][0] + v[j][1] * v[j][1]) + (v[j][2] * v[j][2] + v[j][3] * v[j][3]); }
        const float rstd = 1.0f / sqrtf(wave_sum_dpp(s2) * (1.f / D) + 1e-5f);
        float* orow = a.out + (size_t)row * D + 8 * F.lane;
#pragma unroll
        for (int j = 0; j < 2; ++j) { *(f32x4*)(orow + 512 * j) = v[2 * j] * rstd * gam[2 * j] + bet[2 * j]; *(f32x4*)(orow + 512 * j + 4) = v[2 * j + 1] * rstd * gam[2 * j + 1] + bet[2 * j + 1]; }
    }
#undef P9_LOAD
}
#define MFMA32(a, b, c) __builtin_amdgcn_mfma_f32_32x32x16_bf16((a), (b), (c), 0, 0, 0)
__device__ __forceinline__ int crow(int r, int hi) { return (r & 3) + 8 * (r >> 2) + 4 * hi; }
__device__ __forceinline__ float gelu_tanh(float x) { const float u = 0.7978845608028654f * (x + 0.044715f * x * x * x); const float e = __builtin_amdgcn_exp2f(2.885390081777927f * u); return 0.5f * x * (2.0f - 2.0f * __builtin_amdgcn_rcpf(e + 1.0f)); }
constexpr int P2_AROW = 4096 + 16;
constexpr int P2_HID = 32 * P2_AROW;
constexpr int P2_HROW = 512 + 16;
__device__ __forceinline__ void phase2(const Frame& F, const Args& a) {
    unsigned char* ws = F.ws;
    const bf16* ZA = (const bf16*)(ws + WS_ZA);
    { const float* gn = a.in[8]; bf16* CK = (bf16*)(ws + WS_CKVN);
      const int sub = F.lane >> 4, l16 = F.lane & 15;
      float gv[8];
#pragma unroll
      for (int j = 0; j < 8; ++j) gv[j] = gn[l16 * 8 + j];
      const int r4b = F.bx * NWAVES + F.wave, r4s = F.G * NWAVES;
      for (int r4 = r4b; r4 < NTOK / 4; r4 += 4 * r4s) { u32x4 wv[4];
#pragma unroll
          for (int t = 0; t < 4; ++t) { const int rr = r4 + t * r4s; const int row = (rr < NTOK / 4 ? rr : r4) * 4 + sub; wv[t] = *(const u32x4*)(ZA + (size_t)row * ZA_LD + ZC_CKV + l16 * 8); }
#pragma unroll
          for (int t = 0; t < 4; ++t) { const int rr = r4 + t * r4s; if (rr < NTOK / 4) { const int row = rr * 4 + sub; const u32x4 w = wv[t];
              float v[8] = { bflo(w.x), bfhi(w.x), bflo(w.y), bfhi(w.y), bflo(w.z), bfhi(w.z), bflo(w.w), bfhi(w.w) };
              float s2 = 0.f;
#pragma unroll
              for (int j = 0; j < 8; ++j) s2 += v[j] * v[j];
              s2 += __shfl_xor(s2, 1); s2 += __shfl_xor(s2, 2); s2 += __shfl_xor(s2, 4); s2 += __shfl_xor(s2, 8);
              const float rs = 1.0f / sqrtf(s2 * (1.0f / 128.0f) + 1e-6f);
              u32x4 o; o.x = pk2(v[0] * rs * gv[0], v[1] * rs * gv[1]); o.y = pk2(v[2] * rs * gv[2], v[3] * rs * gv[3]); o.z = pk2(v[4] * rs * gv[4], v[5] * rs * gv[5]); o.w = pk2(v[6] * rs * gv[6], v[7] * rs * gv[7]);
              *(u32x4*)(CK + (size_t)row * 128 + l16 * 8) = o; } } } }
    const int r32 = F.lane & 31, hi = F.lane >> 5;
    for (int u = F.bx; u < 256; u += F.G) {
        const int kv = u >> 7, rt = u & 127, R0 = rt * 32;
        const int zc = kv ? ZC_VC : ZC_KC;
        const bf16* W1T = (const bf16*)(ws + (kv ? WS_W1V : WS_W1K)); const bf16* W2T = (const bf16*)(ws + (kv ? WS_W2V : WS_W2K));
        const float* bias = (const float*)(ws + WS_BIASK) + (size_t)kv * 32 * 256;
        bf16* OUT = (bf16*)(ws + (kv ? WS_VCMP : WS_KCMP));
        __syncthreads();
        { u32x4 av[16];
#pragma unroll
          for (int i = 0; i < 16; ++i) { const int q = F.tid + NTHR * i; const int row = q >> 8, cq = q & 255, l = cq >> 3, dch = cq & 7;
              const int R = R0 + row, b = R >> 9, c = (R >> 1) & 255, g = R & 1; const int cc = c < NCMP ? c : NCMP - 1;
              av[i] = *(const u32x4*)(ZA + (size_t)(b * SEQ + 16 * cc + l) * ZA_LD + zc + g * 64 + dch * 8); }
#pragma unroll
          for (int i = 0; i < 16; ++i) { const int q = F.tid + NTHR * i; const int row = q >> 8, cq = q & 255; *(LAS u32x4*)(F.lds + row * P2_AROW + cq * 16) = av[i]; } }
        __syncthreads();
        f32x16 acc = {};
        { const bf16* bp = W1T + (size_t)(32 * F.wave + r32) * 2048 + 8 * hi; const LAS unsigned char* ap = F.lds + r32 * P2_AROW + 16 * hi;
          f32x16 acc1 = {};
#pragma unroll 1
          for (int s0 = 0; s0 < 128; s0 += 32) { bf16x8 bfr[32];
#pragma unroll
              for (int j = 0; j < 32; ++j) bfr[j] = *(const bf16x8*)(bp + (s0 + j) * 16);
#pragma unroll
              for (int j = 0; j < 32; j += 2) { const bf16x8 a0 = *(const LAS bf16x8*)(ap + (s0 + j) * 32), a1 = *(const LAS bf16x8*)(ap + (s0 + j + 1) * 32); acc = MFMA32(a0, bfr[j], acc); acc1 = MFMA32(a1, bfr[j + 1], acc1); } }
#pragma unroll
          for (int i = 0; i < 16; ++i) acc[i] += acc1[i]; }
        { float bs = 0.f;
#pragma unroll 8
          for (int j = 0; j < 32; ++j) bs += bias[j * 256 + 32 * F.wave + r32];
#pragma unroll
          for (int i = 0; i < 16; ++i) { const float h = gelu_tanh(acc[i] + bs); *(LAS unsigned short*)(F.lds + P2_HID + crow(i, hi) * P2_HROW + (32 * F.wave + r32) * 2) = (unsigned short)f2bf(h); } }
        __syncthreads();
        if (F.wave < 2) {
            f32x16 o2 = {};
            const bf16* bp = W2T + (size_t)(32 * F.wave + r32) * 256 + 8 * hi; const LAS unsigned char* ap = F.lds + P2_HID + r32 * P2_HROW + 16 * hi;
#pragma unroll
            for (int s = 0; s < 16; ++s) { const bf16x8 af = *(const LAS bf16x8*)(ap + s * 32); const bf16x8 bfr = *(const bf16x8*)(bp + s * 16); o2 = MFMA32(af, bfr, o2); }
#pragma unroll
            for (int i = 0; i < 16; ++i) OUT[(size_t)(R0 + crow(i, hi)) * 64 + 32 * F.wave + r32] = (bf16)f2bf(o2[i]);
        }
    }
    __syncthreads();
}

typedef short v4i16_t __attribute__((ext_vector_type(4)));
__device__ __forceinline__ s16x4 vtr(const LAS unsigned char* p) { return __builtin_bit_cast(s16x4, __builtin_amdgcn_ds_read_tr16_b64_v4i16((LAS v4i16_t*)p)); }
constexpr int NSA_K = 0;
constexpr int NSA_V = 16384;
constexpr int NSA_TB = 49152;
constexpr int NSA_TBP = 1032;
constexpr int NSA_SC = 65792;
constexpr int NSA_MSK = 82176;
constexpr int NSA_OF = 84224;
constexpr float C2 = 0.125f * LOG2E;

__device__ __forceinline__ int prefix_cnt(unsigned long long b) { return (int)__builtin_amdgcn_mbcnt_hi((unsigned)(b >> 32), __builtin_amdgcn_mbcnt_lo((unsigned)b, 0u)); }
__device__ __forceinline__ int sbcnt64(unsigned long long m) { int n; asm("s_bcnt1_i32_b64 %0, %1" : "=s"(n) : "s"(m) : "scc"); return n; }
__device__ __forceinline__ float halfmax(float v) { return fmaxf(v, __shfl_xor(v, 32)); }
__device__ __forceinline__ void nsa_tile(const bool nc4, const LAS unsigned char* Kb, const LAS unsigned char* Vb, const LAS float* tbh, const bf16x8 (&qr)[4], f32x16 (&o)[4], float& m, float& l,
                                         int kt, int tq, int kmul, int kadd, int dmax, bool selbit, int mode, float b31, int r32, int hi, int lane) {
    const int tqa = tq - kadd, qk = kmul == 16 ? (tqa >> 4) : tqa, rem = kmul == 16 ? (tqa & 15) : 0;
    const int ebase = qk - (kt * 64 + 4 * hi);
    const LAS unsigned char* vp0 = Vb + ((lane >> 4) & 1) * 32 + (lane & 3) * 8 + (4 * hi + ((lane & 15) >> 2)) * 64;
    bf16x8 kf[2][4];
#pragma unroll
    for (int hf = 0; hf < 2; ++hf)
#pragma unroll
        for (int d0 = 0; d0 < 4; ++d0) kf[hf][d0] = *(const LAS bf16x8*)(Kb + (2 * d0 + hi) * 1024 + (r32 + 32 * hf) * 16);
#pragma unroll
    for (int hf = 0; hf < 2; ++hf) {
        f32x16 s0 = {};
#pragma unroll
        for (int d0 = 0; d0 < 4; ++d0) asm volatile("" : "+v"(kf[hf][d0]));
#pragma unroll
        for (int d0 = 0; d0 < 4; ++d0) s0 = MFMA32(kf[hf][d0], qr[d0], s0);
        s16x4 vfl[4][2], vfh[4][2];
#pragma unroll
        for (int c = 0; c < 4; ++c) if (c < 2 || nc4)
#pragma unroll
            for (int s2 = 0; s2 < 2; ++s2) { const int s = 2 * hf + s2; vfl[c][s2] = vtr(vp0 + c * 4096 + s * 1024); vfh[c][s2] = vtr(vp0 + c * 4096 + s * 1024 + 512); }
        float tmax, mn, ps = 0.f;
        if (mode == 2) {
            float a0 = fmaxf(fmaxf(s0[0], s0[1]), s0[2]), a1 = fmaxf(fmaxf(s0[3], s0[4]), s0[5]);
            a0 = fmaxf(fmaxf(a0, s0[6]), s0[7]); a1 = fmaxf(fmaxf(a1, s0[8]), s0[9]); a0 = fmaxf(fmaxf(a0, s0[10]), s0[11]); a1 = fmaxf(fmaxf(a1, s0[12]), s0[13]); a0 = fmaxf(fmaxf(a0, s0[14]), s0[15]);
            const float cb = selbit ? b31 : NEGBIG;
            tmax = fmaxf(a0, a1) * C2 + cb;
            tmax = halfmax(tmax);
            mn = fmaxf(m, tmax);
            const float cc = cb - mn;
#pragma unroll
            for (int r = 0; r < 16; ++r) { const float p0 = __builtin_amdgcn_exp2f(s0[r] * C2 + cc); s0[r] = p0; ps += p0; }
        } else if (mode == 1) {
            int eb1 = ebase; asm volatile("" : "+v"(eb1));
            const LAS float* tb1 = tbh + (eb1 - 96);
            float bv[16];
#pragma unroll
            for (int r = 0; r < 16; ++r) bv[r] = tb1[96 - ((r & 3) + 8 * (r >> 2) + 32 * hf)];
#pragma unroll
            for (int r = 0; r < 16; ++r) asm volatile("" : "+v"(bv[r]));
            tmax = NEGBIG;
#pragma unroll
            for (int r = 0; r < 16; ++r) { const float x = s0[r] * C2 + bv[r]; s0[r] = x; tmax = fmaxf(tmax, x); }
            tmax = selbit ? tmax : NEGBIG;
            tmax = halfmax(tmax);
            mn = fmaxf(m, tmax);
            const float mne = selbit ? mn : 1e30f;
#pragma unroll
            for (int r = 0; r < 16; ++r) { const float p0 = __builtin_amdgcn_exp2f(s0[r] - mne); s0[r] = p0; ps += p0; }
        } else {
            tmax = NEGBIG;
            float bv[16];
            int eb0 = ebase; asm volatile("" : "+v"(eb0));
#pragma unroll
            for (int r = 0; r < 16; ++r) { const int dist = __mul24(eb0 - ((r & 3) + 8 * (r >> 2) + 32 * hf), kmul) + rem; int dc = dist < 0 ? 0 : dist; dc = dc > 1023 ? 1023 : dc; bv[r] = tbh[dc]; }
#pragma unroll
            for (int r = 0; r < 16; ++r) asm volatile("" : "+v"(bv[r]));
#pragma unroll
            for (int r = 0; r < 16; ++r) { const int dist = __mul24(eb0 - ((r & 3) + 8 * (r >> 2) + 32 * hf), kmul) + rem;
                const bool valid = selbit && dist >= 0 && dist < dmax;
                const float x = valid ? s0[r] * C2 + bv[r] : NEGBIG;
                s0[r] = x; tmax = fmaxf(tmax, x); }
            tmax = halfmax(tmax);
            mn = fmaxf(m, tmax);
#pragma unroll
            for (int r = 0; r < 16; ++r) { const float p0 = s0[r] > -1e29f ? __builtin_amdgcn_exp2f(s0[r] - mn) : 0.f; s0[r] = p0; ps += p0; }
        }
        if (__any(mn != m)) {
            const float alpha = __builtin_amdgcn_exp2f(m - mn);
            l *= alpha;
#pragma unroll
            for (int c = 0; c < 4; ++c) if (c < 2 || nc4) {
#pragma unroll
                for (int r = 0; r < 16; ++r) o[c][r] *= alpha; }
        }
        m = mn;
        l += ps;
        u32x4 pw[2];
#pragma unroll
        for (int q = 0; q < 4; ++q) { pw[0][q] = pk2(s0[2 * q], s0[2 * q + 1]); pw[1][q] = pk2(s0[8 + 2 * q], s0[8 + 2 * q + 1]); }
#pragma unroll
        for (int c = 0; c < 4; ++c) if (c < 2 || nc4)
#pragma unroll
            for (int s2 = 0; s2 < 2; ++s2) { const s16x4 vl = vfl[c][s2], vh = vfh[c][s2];
                const bf16x8 vf = {vl[0], vl[1], vl[2], vl[3], vh[0], vh[1], vh[2], vh[3]};
                o[c] = MFMA32(vf, __builtin_bit_cast(bf16x8, pw[s2]), o[c]); }
    }
}

__device__ __forceinline__ void nsa_unit(const Frame& F, int b, int g, int qt) {
    unsigned char* ws = F.ws;
    const bf16* ZA = (const bf16*)(ws + WS_ZA);
    const int r32 = F.lane & 31, hi = F.lane >> 5, qi = r32 >> 2, hh = r32 & 3, head = g * 4 + hh;
    const int q0 = qt * 64, tq = q0 + 8 * F.wave + qi;
    const size_t zrow = (size_t)(b * SEQ + tq) * ZA_LD;
    const int srow = F.tid >> 3, sch = F.tid & 7;
    const f32x4* TBA4 = (const f32x4*)((const float*)(ws + WS_TBA) + (size_t)g * 4 * 1024);
    const f32x4 tbv0 = TBA4[F.tid], tbv1 = TBA4[F.tid + NTHR];
    const LAS float* tbh = (const LAS float*)(F.lds + NSA_TB) + hh * NSA_TBP;
    const int wq0 = q0 + 8 * F.wave;
    const float b31 = ((const float*)(ws + WS_TBA))[(size_t)head * 1024 + 1023];
    bf16x8 qr[4];
#pragma unroll
    for (int d0 = 0; d0 < 4; ++d0) qr[d0] = *(const bf16x8*)(ZA + zrow + ZC_QA + head * 64 + d0 * 16 + hi * 8);
    unsigned short graw[3];
#pragma unroll
    for (int i = 0; i < 3; ++i) graw[i] = ZA[zrow + ZC_GNSA + head * 3 + i];
    { LAS f32x4* tb4 = (LAS f32x4*)(F.lds + NSA_TB) + (F.tid >> 8) * (NSA_TBP / 4) + (F.tid & 255); tb4[0] = tbv0; tb4[2 * (NSA_TBP / 4)] = tbv1; }
    float gate[3];
#pragma unroll
    for (int i = 0; i < 3; ++i) gate[i] = sigmoidf_(bf2f(graw[i]));
    LAS float* ofw = (LAS float*)(F.lds + NSA_OF) + F.wave * 2048 + F.lane;
    unsigned mlo = 0u, mhi = 0u;
    u32x4 kreg, vreg = {0u, 0u, 0u, 0u};
    const bf16* kgp; size_t vdel, tstep;
#define NSA_SETUP(br_) do { const int b_ = (br_); const bf16* Kg_; size_t pitch_; int tl_; \
        if (b_ == 0) { Kg_ = (const bf16*)(ws + WS_KCMP) + (size_t)(b * 256) * 128 + g * 64; vdel = (size_t)((const bf16*)(ws + WS_VCMP) - (const bf16*)(ws + WS_KCMP)); pitch_ = 128; tl_ = 0; } \
        else { Kg_ = ZA + (size_t)(b * SEQ) * ZA_LD + (b_ == 1 ? ZC_KS : ZC_KW) + g * 64; vdel = 128; pitch_ = ZA_LD; tl_ = (b_ == 2 && qt > 8) ? qt - 8 : 0; } \
        kgp = Kg_ + (size_t)(tl_ * 64 + srow) * pitch_ + sch * 8; tstep = (size_t)64 * pitch_; } while (0)
#define NSA_GLOAD(kt_) do { kreg = *(const u32x4*)kgp; vreg = *(const u32x4*)(kgp + vdel); kgp += tstep; } while (0)
    NSA_SETUP(0); NSA_GLOAD(0);
#pragma nounroll
    for (int br = 0; br < 3; ++br) {
        const bool iscmp = br == 0;
        const int t_lo = iscmp ? 0 : ((br == 2 && qt > 8) ? qt - 8 : 0), t_hi = iscmp ? ((q0 + 32) >> 10) : qt;
        const int kmul = iscmp ? 16 : 1, kadd = iscmp ? 31 : 0, dmax = br == 2 ? 512 : 0x40000000;
        f32x16 o[4]; o[0] = f32x16{}; o[1] = f32x16{}; o[2] = f32x16{}; o[3] = f32x16{};
        float m = NEGBIG, l = 0.f;
#define NSA_LSTORE(kt_, buf_) do { \
        *(LAS u32x4*)(F.lds + NSA_K + (buf_) * 8192 + sch * 1024 + srow * 16) = kreg; \
        *(LAS u32x4*)(F.lds + NSA_V + (buf_) * 16384 + (sch >> 2) * 4096 + srow * 64 + (sch & 3) * 16) = vreg; \
        if (iscmp) { const int c_ = (kt_) * 64 + srow, jj_ = c_ >> 2, mm_ = c_ & 3; u32x4 mv_; \
            _Pragma("unroll") for (int i_ = 0; i_ < 4; ++i_) { const int j0_ = sch * 8 + 2 * i_, j1_ = j0_ + 1; \
                const unsigned e0_ = (c_ < NCMP) ? (mm_ < 3 ? (j0_ == jj_ ? 0x4000u : 0u) : ((j0_ == jj_ || j0_ == jj_ + 1) ? 0x3F80u : 0u)) : 0u; \
                const unsigned e1_ = (c_ < NCMP) ? (mm_ < 3 ? (j1_ == jj_ ? 0x4000u : 0u) : ((j1_ == jj_ || j1_ == jj_ + 1) ? 0x3F80u : 0u)) : 0u; \
                mv_[i_] = e0_ | (e1_ << 16); } \
            *(LAS u32x4*)(F.lds + NSA_V + (buf_) * 16384 + (2 + (sch >> 2)) * 4096 + srow * 64 + (sch & 3) * 16) = mv_; } } while (0)
        NSA_LSTORE(t_lo, 0);
        __syncthreads();
        int buf = 0;
#pragma nounroll
        for (int kt = t_lo; kt <= t_hi; ++kt) {
            const int ktn = kt + 1; const bool more = kt < t_hi;
            if (more) NSA_GLOAD(ktn);
            const bool selbit = br == 1 ? (((kt < 32 ? (mlo >> kt) : (mhi >> (kt - 32))) & 1u) != 0u) : true;
            int mode = 0;
            { const int dmin = wq0 - (64 * kt + 63), dmx = wq0 + 7 - 64 * kt;
              if (br == 1) mode = dmin >= 790 ? 2 : (dmin >= 0 ? 1 : 0);
              if (br == 0) mode = 16 * (((wq0 - 31) >> 4) - (64 * kt + 63)) >= 790 ? 2 : 0;
              if (br == 2) mode = (dmin >= 0 && dmx <= 511) ? 1 : 0; }
            if (__any(selbit))
                nsa_tile(iscmp, F.lds + NSA_K + buf * 8192, F.lds + NSA_V + buf * 16384, tbh, qr, o, m, l, kt, tq, kmul, kadd, dmax, selbit, mode, b31, r32, hi, F.lane);
            if (more) NSA_LSTORE(ktn, buf ^ 1);
            __syncthreads();
            buf ^= 1;
        }
#undef NSA_LSTORE
        if (br < 2) { NSA_SETUP(br + 1); NSA_GLOAD(0); }
        l += __shfl_xor(l, 32);
        const float inv = l > 0.f ? 1.0f / l : 0.f;
        { const float sc = inv * (br == 0 ? gate[0] : br == 1 ? gate[1] : gate[2]);
#pragma unroll
            for (int c = 0; c < 2; ++c)
#pragma unroll
                for (int r = 0; r < 16; ++r) { const float prev = br == 0 ? 0.f : ofw[(c * 16 + r) * 64]; ofw[(c * 16 + r) * 64] = prev + o[c][r] * sc; } }
        if (iscmp) {
            LAS float* scw = (LAS float*)(F.lds + NSA_SC) + F.wave * 512;
#pragma unroll
            for (int c = 0; c < 2; ++c)
#pragma unroll
                for (int r = 0; r < 16; ++r) { float v = o[2 + c][r] * inv;
                    v += __builtin_bit_cast(float, __builtin_amdgcn_update_dpp(0, __builtin_bit_cast(int, v), 0xB1, 0xf, 0xf, true));
                    v += __builtin_bit_cast(float, __builtin_amdgcn_update_dpp(0, __builtin_bit_cast(int, v), 0x4E, 0xf, 0xf, true));
                    if (hh == 0) scw[qi * 64 + 32 * c + crow(r, hi)] = v; }
            LDS_WAIT();
            LAS unsigned* mskw = (LAS unsigned*)(F.lds + NSA_MSK) + F.wave * 16;
#pragma nounroll
            for (int q = 0; q < 8; q += 2) {
                unsigned key[2]; bool av[2];
#pragma unroll
                for (int u = 0; u < 2; ++u) { const int curq = (q0 + 8 * F.wave + q + u) >> 6, j = F.lane;
                    av[u] = j <= curq; const bool forced = (j == 0) || (j == curq) || (j == curq - 1);
                    const float sj = scw[(q + u) * 64 + j] + (forced ? 1e4f : 0.f);
                    key[u] = av[u] ? __builtin_bit_cast(unsigned, sj + 0.0f) + 1u : 0u; }
                unsigned T0 = 0u, T1 = 0u;
#pragma unroll
                for (int bit = 30; bit >= 0; --bit) { const unsigned c0 = T0 | (1u << bit), c1 = T1 | (1u << bit);
                    const int n0 = sbcnt64(__ballot(key[0] >= c0)), n1 = sbcnt64(__ballot(key[1] >= c1));
                    T0 = n0 >= 16 ? c0 : T0; T1 = n1 >= 16 ? c1 : T1; }
#pragma unroll
                for (int u = 0; u < 2; ++u) { const unsigned T = u ? T1 : T0;
                    const bool gt = key[u] > T, eq = key[u] == T;
                    const int need = 16 - sbcnt64(__ballot(gt));
                    const bool sel = (gt || (eq && prefix_cnt(__ballot(eq)) < need)) && av[u];
                    const unsigned long long bm = __ballot(sel);
                    if (F.lane == 0) { mskw[2 * (q + u)] = (unsigned)bm; mskw[2 * (q + u) + 1] = (unsigned)(bm >> 32); } } }
            LDS_WAIT();
            mlo = mskw[2 * qi]; mhi = mskw[2 * qi + 1];
        }
    }
#undef NSA_GLOAD
#undef NSA_SETUP
    bf16* OA = (bf16*)(ws + WS_OA) + (size_t)(b * SEQ + tq) * 512 + head * 64;
#pragma unroll
    for (int c = 0; c < 2; ++c)
#pragma unroll
        for (int r4 = 0; r4 < 4; ++r4) { u32x2 w; w.x = pk2(ofw[(c * 16 + 4 * r4) * 64], ofw[(c * 16 + 4 * r4 + 1) * 64]); w.y = pk2(ofw[(c * 16 + 4 * r4 + 2) * 64], ofw[(c * 16 + 4 * r4 + 3) * 64]);
            *(u32x2*)(OA + 32 * c + 8 * r4 + 4 * hi) = w; }
}
__device__ __forceinline__ void phase3(const Frame& F) {
    const bool xcd = (F.G == 256);
    const int pstart = xcd ? (F.bx >> 3) : F.bx, pstep = xcd ? 32 : F.G, pend = xcd ? 64 : 512;
#pragma nounroll
    for (int p2 = 2 * pstart; p2 < 2 * pend; p2 += (p2 & 1) ? 2 * pstep - 1 : 1) { const int p = p2 >> 1;
        const int b = xcd ? (F.bx & 7) : (p >> 6), g = (p >> 5) & 1, qt = p & 31;
        nsa_unit(F, b, g, (p2 & 1) ? qt : 63 - qt); }
    __syncthreads();
}

#define MFMA16(a, b, c) __builtin_amdgcn_mfma_f32_16x16x32_bf16((a), (b), (c), 0, 0, 0)
constexpr int DSA_SCP = 8200;
constexpr int DSA_SC = 0;
constexpr int DSA_LIST = 16 * DSA_SCP;
constexpr int DSA_NSEL = DSA_LIST + 8192;
constexpr int DSA_BIAS = DSA_NSEL + 64;
constexpr int DSA_HIST = DSA_BIAS + 1088;
constexpr int DSA_BKI = DSA_HIST + 8192;
constexpr int KSEL = 256;
__device__ __forceinline__ unsigned dsa_offb(unsigned row, unsigned ch) { return 256u * row + 16u * (ch ^ (((row & 3u) << 2) | ((row >> 2) & 3u))); }
__device__ __forceinline__ unsigned sortkey16(float x) { x = x + 0.0f; const unsigned short h = __builtin_bit_cast(unsigned short, (_Float16)x); return (h & 0x8000u) ? (unsigned)(unsigned short)~h : (unsigned)(h | 0x8000u); }

__device__ __forceinline__ void dsa_unit(const Frame& F, const Args& a, int b, int qt16) {
    unsigned char* ws = F.ws;
    const bf16* ZA = (const bf16*)(ws + WS_ZA);
    const int lane = F.lane, l16 = lane & 15, quad = lane >> 4, q0 = qt16 * 16;
    __syncthreads();
#ifndef PROBE_DSA
#define PROBE_DSA 0
#endif
    for (int rep1_ = 0; rep1_ < (PROBE_DSA == 1 ? 2 : 1); ++rep1_) {
        const size_t qrow = (size_t)(b * SEQ + q0 + l16) * ZA_LD;
        bf16x8 qf[4][2];
#pragma unroll
        for (int i = 0; i < 4; ++i)
#pragma unroll
            for (int ks = 0; ks < 2; ++ks) qf[i][ks] = *(const bf16x8*)(ZA + qrow + ZC_QIDX + i * 64 + 32 * ks + 8 * quad);
        float wq[4];
#pragma unroll
        for (int i = 0; i < 4; ++i) wq[i] = bf2f(ZA[qrow + ZC_WIDX + i]) * 0.0625f;
        const int tq = q0 + l16, nkt = qt16 + 1;
        const bf16* kbase = ZA + (size_t)(b * SEQ + l16) * ZA_LD + ZC_KIDX + 8 * quad;
        bf16x8 ka[4][2], kn[4][2];
#define DSA_KLOAD(dst, kt0_) do { _Pragma("unroll") for (int t_ = 0; t_ < 4; ++t_) { const int k_ = (kt0_) + 8 * t_; const int kc_ = k_ < nkt ? k_ : nkt - 1; \
            dst[t_][0] = *(const bf16x8*)(kbase + (size_t)(kc_ * 16) * ZA_LD); dst[t_][1] = *(const bf16x8*)(kbase + (size_t)(kc_ * 16) * ZA_LD + 32); } } while (0)
        if (F.wave < nkt) DSA_KLOAD(ka, F.wave);
#pragma nounroll
        for (int kt0 = F.wave; kt0 < nkt; kt0 += 32) {
            if (kt0 + 32 < nkt) DSA_KLOAD(kn, kt0 + 32);
#pragma unroll
            for (int t = 0; t < 4; ++t) { const int kt = kt0 + 8 * t;
                if (kt < nkt) {
                    float idx[4] = {0.f, 0.f, 0.f, 0.f};
#pragma unroll
                    for (int i = 0; i < 4; ++i) { f32x4 acc = {0.f, 0.f, 0.f, 0.f}; acc = MFMA16(ka[t][0], qf[i][0], acc); acc = MFMA16(ka[t][1], qf[i][1], acc);
#pragma unroll
                        for (int r = 0; r < 4; ++r) idx[r] += fmaxf(acc[r], 0.f) * wq[i]; }
                    unsigned k16[4];
#pragma unroll
                    for (int r = 0; r < 4; ++r) { const int key = kt * 16 + 4 * quad + r; k16[r] = key <= tq ? sortkey16(idx[r]) : 0u; }
                    u32x2 w; w.x = k16[0] | (k16[1] << 16); w.y = k16[2] | (k16[3] << 16);
                    *(LAS u32x2*)(F.lds + DSA_SC + l16 * DSA_SCP + (kt * 16 + 4 * quad) * 2) = w; } }
#pragma unroll
            for (int t = 0; t < 4; ++t) { ka[t][0] = kn[t][0]; ka[t][1] = kn[t][1]; }
        }
#undef DSA_KLOAD
    }
    if (F.tid < 264) { const float* rb = a.in[11]; ((LAS float*)(F.lds + DSA_BIAS))[F.tid] = F.tid < 256 ? rb[(F.tid >> 3) * 16 + 8 + (F.tid & 7)] * LOG2E : NEGBIG; }
    __syncthreads();
    bf16x8 ql[2][4];
#pragma unroll
    for (int qq = 0; qq < 2; ++qq)
#pragma unroll
        for (int s2 = 0; s2 < 4; ++s2) { const bf16x8 v = *(const bf16x8*)(ZA + (size_t)(b * SEQ + q0 + 2 * F.wave + qq) * ZA_LD + ZC_QLAT + (l16 & 7) * 128 + 32 * s2 + 8 * quad); ql[qq][s2] = l16 < 8 ? v : (bf16x8){0, 0, 0, 0, 0, 0, 0, 0}; }
#pragma nounroll
    for (int qq = 0; qq < (PROBE_DSA == 2 ? 4 : 2); ++qq) {
        const int n = 2 * F.wave + (qq & 1), tq = q0 + n, N = tq + 1;
        LAS unsigned char* scq = F.lds + DSA_SC + n * DSA_SCP;
        LAS unsigned short* lst = (LAS unsigned short*)(F.lds + DSA_LIST) + n * 256;
        LAS unsigned short* bki = (LAS unsigned short*)(F.lds + DSA_BKI) + n * 256;
        if (N <= KSEL) {
            for (int s = lane; s < KSEL; s += 64) lst[s] = (unsigned short)(s < N ? s : 0);
            if (lane == 0) ((LAS int*)(F.lds + DSA_NSEL))[n] = N;
        } else {
            const int nit = (N + 255) >> 8;
            { const int it = nit - 1; const int s0 = 4 * (lane + 64 * it); u32x2 w = *(LAS u32x2*)(scq + s0 * 2);
              if (s0 + 0 > tq) w.x &= 0xffff0000u; if (s0 + 1 > tq) w.x &= 0x0000ffffu; if (s0 + 2 > tq) w.y &= 0xffff0000u; if (s0 + 3 > tq) w.y &= 0x0000ffffu;
              *(LAS u32x2*)(scq + s0 * 2) = w; }
            LDS_WAIT();
            LAS unsigned* hist = (LAS unsigned*)(F.lds + DSA_HIST) + F.wave * 256;
            unsigned T = 0u; int cgt = 0; int need = KSEL;
#pragma nounroll
            for (int lvl = 0; lvl < 2; ++lvl) {
                *(LAS u32x4*)(hist + 4 * lane) = (u32x4){0u, 0u, 0u, 0u};
                LDS_WAIT();
#pragma nounroll
                for (int it = 0; it < nit; ++it) { const u32x2 w = *(LAS u32x2*)(scq + (lane + 64 * it) * 8);
                    const unsigned k[4] = {w.x & 0xffffu, w.x >> 16, w.y & 0xffffu, w.y >> 16};
#pragma unroll
                    for (int e = 0; e < 4; ++e) { const bool in = lvl == 0 ? true : (k[e] >> 8) == (T >> 8); const unsigned bin = lvl == 0 ? (k[e] >> 8) : (k[e] & 255u);
                        if (in) __hip_atomic_fetch_add(hist + bin, 1u, __ATOMIC_RELAXED, __HIP_MEMORY_SCOPE_WORKGROUP); } }
                LDS_WAIT();
                const u32x4 h = *(LAS u32x4*)(hist + 4 * lane);
                const int sl = (int)(h.x + h.y + h.z + h.w); int suf = sl;
#pragma unroll
                for (int d = 1; d < 64; d <<= 1) { const int o = __shfl_down(suf, d); suf += (lane + d < 64) ? o : 0; }
                const int above = suf - sl;
                const bool here = above < need && above + sl >= need;
                int bsel = 4 * lane + 3, ca = above;
                if (ca + (int)h.w < need) { ca += (int)h.w; bsel = 4 * lane + 2; if (ca + (int)h.z < need) { ca += (int)h.z; bsel = 4 * lane + 1; if (ca + (int)h.y < need) { ca += (int)h.y; bsel = 4 * lane; } } }
                const unsigned long long bm = __ballot(here);
                const int src = bm ? (int)__builtin_ctzll(bm) : 0;
                const int B = __shfl(bsel, src), CA = __shfl(ca, src);
                if (lvl == 0) T = (unsigned)B << 8; else T |= (unsigned)B;
                cgt += CA; need -= CA;
                LDS_WAIT();
            }
            const int rties = KSEL - cgt;
            int tiebase = 0, outbase = 0;
#define DSA_PUT(pos_, idx_) do { const int p_ = (pos_); if (p_ >= 0 && p_ < KSEL) lst[p_] = (unsigned short)(idx_); } while (0)
#pragma nounroll
            for (int it = 0; it < nit; ++it) { const u32x2 w = *(LAS u32x2*)(scq + (lane + 64 * it) * 8);
                const unsigned k0 = w.x & 0xffffu, k1 = w.x >> 16, k2 = w.y & 0xffffu, k3 = w.y >> 16;
                const int sidx = 4 * (lane + 64 * it);
                const bool g0 = k0 > T, g1 = k1 > T, g2 = k2 > T, g3 = k3 > T;
                const unsigned long long bg0 = __ballot(g0), bg1 = __ballot(g1), bg2 = __ballot(g2), bg3 = __ballot(g3);
                if (bg0 | bg1 | bg2 | bg3) {
                    int pos = outbase + prefix_cnt(bg0) + prefix_cnt(bg1) + prefix_cnt(bg2) + prefix_cnt(bg3);
                    if (g0) { DSA_PUT(pos, sidx + 0); ++pos; }
                    if (g1) { DSA_PUT(pos, sidx + 1); ++pos; }
                    if (g2) { DSA_PUT(pos, sidx + 2); ++pos; }
                    if (g3) { DSA_PUT(pos, sidx + 3); ++pos; }
                    outbase += __popcll(bg0) + __popcll(bg1) + __popcll(bg2) + __popcll(bg3); }
                const bool e0 = k0 == T, e1 = k1 == T, e2 = k2 == T, e3 = k3 == T;
                const unsigned long long be0 = __ballot(e0), be1 = __ballot(e1), be2 = __ballot(e2), be3 = __ballot(e3);
                if ((be0 | be1 | be2 | be3) && tiebase < rties) {
                    const int t0 = tiebase + prefix_cnt(be0) + prefix_cnt(be1) + prefix_cnt(be2) + prefix_cnt(be3), t1 = t0 + (e0 ? 1 : 0), t2 = t1 + (e1 ? 1 : 0), t3 = t2 + (e2 ? 1 : 0);
                    if (e0 && t0 < rties) DSA_PUT(KSEL - 1 - t0, sidx + 0);
                    if (e1 && t1 < rties) DSA_PUT(KSEL - 1 - t1, sidx + 1);
                    if (e2 && t2 < rties) DSA_PUT(KSEL - 1 - t2, sidx + 2);
                    if (e3 && t3 < rties) DSA_PUT(KSEL - 1 - t3, sidx + 3);
                    tiebase += __popcll(be0) + __popcll(be1) + __popcll(be2) + __popcll(be3); } }
#undef DSA_PUT
            outbase = KSEL;
            if (lane == 0) ((LAS int*)(F.lds + DSA_NSEL))[n] = outbase < KSEL ? outbase : KSEL;
        }
        LDS_WAIT();
        { const int nsl = N < KSEL ? N : KSEL;
#pragma unroll
          for (int i = 0; i < 4; ++i) { const int e = lane + 64 * i; const int dist = tq - (int)lst[e];
              const int dpos = dist < 1 ? 1 : dist; int bl = 16 + (int)((__log2f((float)dpos) - 4.0f) * 2.66666675f); bl = bl > 31 ? 31 : bl;
              const int bk = dist < 1 ? 0 : (dpos < 16 ? dpos : bl);
              bki[e] = (unsigned short)(e < nsl ? bk * 32 : 1024); } }
    }
    LDS_WAIT();
    const bf16* CK = (const bf16*)(ws + WS_CKVN) + (size_t)(b * SEQ) * 128;
    LAS unsigned char* gb0 = F.lds + DSA_SC + (2 * F.wave) * DSA_SCP;
    const LAS unsigned char* biasb = F.lds + DSA_BIAS + (l16 & 7) * 4;
#define DSA_GATHER(chunk_, buf_) do { const unsigned key_ = lst[(chunk_) * 32 + (lane >> 1)]; const char* src_ = (const char*)CK + (key_ * 256u + (unsigned)(lane & 1) * 16u); \
        _Pragma("unroll") for (int c_ = 0; c_ < 8; ++c_) __builtin_amdgcn_global_load_lds((const unsigned*)(src_ + c_ * 32), (LAS unsigned*)(gb0 + (buf_) * 8192 + c_ * 1024), 16, 0, 0); } while (0)
    int tqs[2], nsels[2]; const LAS unsigned short* lsts[2]; const LAS unsigned short* bkis[2]; f32x4 o[2][8]; float ms[2], ls[2];
#pragma unroll
    for (int qq = 0; qq < 2; ++qq) { const int n = 2 * F.wave + qq; tqs[qq] = q0 + n; nsels[qq] = ((const LAS int*)(F.lds + DSA_NSEL))[n]; lsts[qq] = (const LAS unsigned short*)(F.lds + DSA_LIST) + n * 256; bkis[qq] = (const LAS unsigned short*)(F.lds + DSA_BKI) + n * 256;
#pragma unroll
        for (int c = 0; c < 8; ++c) o[qq][c] = (f32x4){0.f, 0.f, 0.f, 0.f};
        ms[qq] = NEGBIG; ls[qq] = 0.f; }
#pragma unroll
    for (int qq = 0; qq < 2; ++qq)
#pragma unroll
        for (int s2 = 0; s2 < 4; ++s2) asm volatile("" : "+v"(ql[qq][s2]));
    const int nch1 = (nsels[1] + 31) >> 5, nch = PROBE_DSA == 3 ? 2 * nch1 : nch1;
    LDS_WAIT();
    { const LAS unsigned short* lst = lsts[0]; DSA_GATHER(0, 0); }
    { const LAS unsigned short* lst = lsts[1]; DSA_GATHER(0, 1); }
    const unsigned offA = (unsigned)((quad >> 1) * 1024 + l16 * 32 + (quad & 1) * 16);
    const unsigned offT = (unsigned)((4 * quad + (l16 >> 2)) * 32 + 8 * (lane & 3));
#pragma nounroll
    for (int ch = 0; ch < nch; ++ch) {
#pragma unroll
        for (int qq = 0; qq < 2; ++qq) {
            const int chd = ch >= nch1 ? ch - nch1 : ch;
            const LAS unsigned short* lst = lsts[qq];
            const LAS unsigned char* gb = gb0 + qq * 8192;
            if (qq == 0 || ch + 1 < nch) asm volatile("s_waitcnt vmcnt(8)" ::: "memory"); else asm volatile("s_waitcnt vmcnt(0)" ::: "memory");
            f32x4 acc2[2]; float bvs[2][4];
#pragma unroll
            for (int rb = 0; rb < 2; ++rb) { f32x4 acc = {0.f, 0.f, 0.f, 0.f};
#pragma unroll
                for (int s2 = 0; s2 < 4; ++s2) { const bf16x8 af = *(const LAS bf16x8*)(gb + offA + rb * 512 + s2 * 2048); acc = MFMA16(af, ql[qq][s2], acc); }
                acc2[rb] = acc;
                const u32x2 kb = *(const LAS u32x2*)((const LAS unsigned char*)bkis[qq] + (chd * 32 + rb * 16 + 4 * quad) * 2);
                bvs[rb][0] = *(const LAS float*)(biasb + (kb.x & 0xffffu)); bvs[rb][1] = *(const LAS float*)(biasb + (kb.x >> 16));
                bvs[rb][2] = *(const LAS float*)(biasb + (kb.y & 0xffffu)); bvs[rb][3] = *(const LAS float*)(biasb + (kb.y >> 16)); }
#pragma unroll
            for (int rb = 0; rb < 2; ++rb)
#pragma unroll
                for (int r = 0; r < 4; ++r) asm volatile("" : "+v"(bvs[rb][r]));
            float x[2][4]; float tmax = NEGBIG;
#pragma unroll
            for (int rb = 0; rb < 2; ++rb)
#pragma unroll
                for (int r = 0; r < 4; ++r) { const float xv = acc2[rb][r] * C2 + bvs[rb][r]; x[rb][r] = xv; tmax = fmaxf(tmax, xv); }
            tmax = fmaxf(tmax, __shfl_xor(tmax, 16)); tmax = fmaxf(tmax, __shfl_xor(tmax, 32));
            const float mn = fmaxf(ms[qq], tmax); const bool resc = __any(mn != ms[qq]); const float alpha = __builtin_amdgcn_exp2f(ms[qq] - mn); ms[qq] = mn;
            float ps = 0.f;
#pragma unroll
            for (int rb = 0; rb < 2; ++rb)
#pragma unroll
                for (int r = 0; r < 4; ++r) { const float pv = __builtin_amdgcn_exp2f(x[rb][r] - mn); x[rb][r] = pv; ps += pv; }
            ls[qq] = ls[qq] * alpha + ps;
            if (resc) {
#pragma unroll
                for (int c = 0; c < 8; ++c) o[qq][c] = o[qq][c] * alpha; }
            u32x4 pw; pw.x = pk2(x[0][0], x[0][1]); pw.y = pk2(x[0][2], x[0][3]); pw.z = pk2(x[1][0], x[1][1]); pw.w = pk2(x[1][2], x[1][3]);
            const unsigned gba = (unsigned)(unsigned long long)gb + offT;
#pragma unroll
            for (int cb = 0; cb < 2; ++cb) {
                s16x4 v[8];
                if (cb == 0) asm volatile("ds_read_b64_tr_b16 %0, %8\n\tds_read_b64_tr_b16 %1, %8 offset:512\n\tds_read_b64_tr_b16 %2, %8 offset:1024\n\tds_read_b64_tr_b16 %3, %8 offset:1536\n\t"
                             "ds_read_b64_tr_b16 %4, %8 offset:2048\n\tds_read_b64_tr_b16 %5, %8 offset:2560\n\tds_read_b64_tr_b16 %6, %8 offset:3072\n\tds_read_b64_tr_b16 %7, %8 offset:3584\n\ts_waitcnt lgkmcnt(0)"
                             : "=&v"(v[0]), "=&v"(v[1]), "=&v"(v[2]), "=&v"(v[3]), "=&v"(v[4]), "=&v"(v[5]), "=&v"(v[6]), "=&v"(v[7]) : "v"(gba) : "memory");
                else asm volatile("ds_read_b64_tr_b16 %0, %8 offset:4096\n\tds_read_b64_tr_b16 %1, %8 offset:4608\n\tds_read_b64_tr_b16 %2, %8 offset:5120\n\tds_read_b64_tr_b16 %3, %8 offset:5632\n\t"
                             "ds_read_b64_tr_b16 %4, %8 offset:6144\n\tds_read_b64_tr_b16 %5, %8 offset:6656\n\tds_read_b64_tr_b16 %6, %8 offset:7168\n\tds_read_b64_tr_b16 %7, %8 offset:7680\n\ts_waitcnt lgkmcnt(0)"
                             : "=&v"(v[0]), "=&v"(v[1]), "=&v"(v[2]), "=&v"(v[3]), "=&v"(v[4]), "=&v"(v[5]), "=&v"(v[6]), "=&v"(v[7]) : "v"(gba) : "memory");
#pragma unroll
                for (int c4 = 0; c4 < 4; ++c4) { const int c = 4 * cb + c4; const s16x4 v0 = v[2 * c4], v1 = v[2 * c4 + 1];
                    const bf16x8 vf = {v0[0], v0[1], v0[2], v0[3], v1[0], v1[1], v1[2], v1[3]};
                    o[qq][c] = MFMA16(vf, __builtin_bit_cast(bf16x8, pw), o[qq][c]); }
            }
            LDS_WAIT();
            if (ch + 1 < nch) DSA_GATHER((ch + 1 >= nch1 ? ch + 1 - nch1 : ch + 1), qq);
        }
    }
#pragma unroll
    for (int qq = 0; qq < 2; ++qq) {
        float l = ls[qq]; const int tq = tqs[qq];
        l += __shfl_xor(l, 16); l += __shfl_xor(l, 32);
        const float inv = l > 0.f ? 1.0f / l : 0.f;
        if (l16 < 8) { bf16* op = (bf16*)(ws + WS_OLAT) + (size_t)(b * SEQ + tq) * 1024 + l16 * 128 + 4 * quad;
#pragma unroll
            for (int c = 0; c < 8; ++c) { u32x2 w; w.x = pk2(o[qq][c][0] * inv, o[qq][c][1] * inv); w.y = pk2(o[qq][c][2] * inv, o[qq][c][3] * inv); *(u32x2*)(op + 16 * c) = w; } }
    }
}
#undef DSA_GATHER
__device__ __forceinline__ void phase4(const Frame& F, const Args& a) {
    const bool xcd = (F.G == 256);
    const int pstart = xcd ? (F.bx >> 3) : F.bx, pstep = xcd ? 32 : F.G, pend = xcd ? 128 : 1024;
#pragma nounroll
    for (int p2 = 2 * pstart; p2 < 2 * pend; p2 += (p2 & 1) ? 2 * pstep - 1 : 1) { const int p = p2 >> 1;
        const int b = xcd ? (F.bx & 7) : (p >> 7), j = p & 127;
        dsa_unit(F, a, b, (p2 & 1) ? j : 255 - j); }
    __syncthreads();
}

constexpr int NPHASE = 11;
__global__ void __launch_bounds__(NTHR, 2) fwd_kernel(Args args) {
    extern __shared__ __attribute__((aligned(16))) unsigned char lds_raw[];
    Frame F;
    F.lds = (LAS unsigned char*)lds_raw;
    F.tid = threadIdx.x; F.lane = F.tid & 63; F.wave = __builtin_amdgcn_readfirstlane(F.tid >> 6);
    F.G = gridDim.x; F.bx = blockIdx.x; F.ws = args.ws;
    unsigned char* ws = args.ws;
    volatile LAS unsigned* MISC = (volatile LAS unsigned*)(F.lds + MISC_OFF);
    if (F.tid < 64) MISC[F.tid] = 0u;
    __syncthreads();
    const int lo = args.ph_lo, hi = args.ph_hi;
    XcdBarrier bar; bar.bar = (unsigned*)(ws + WS_CTL) + CW_BAR; bar.x = 0; bar.st = nullptr;
    if (hi - lo > 1) bar = xcd_barrier_post((unsigned*)(ws + WS_CTL) + CW_BAR, MISC + 8);
#ifndef PH_MASK
#define PH_MASK 0xFFFF
#endif
#define IN(k) ((((PH_MASK) >> (k)) & 1) && lo <= (k) && (k) < hi)
#define SEAM(k) do { if (IN(k) && IN((k) + 1)) xcd_barrier(bar); } while (0)
#ifndef PROBE_PHASE
#define PROBE_PHASE -1
#endif
#define REPEAT(k) for (int rep_ = 0; rep_ < ((PROBE_PHASE) == (k) ? 2 : 1); ++rep_, ((PROBE_PHASE) == (k) && rep_ < 2 ? xcd_barrier(bar) : (void)0))

    if (IN(0)) REPEAT(0) { phase0(F, args); }
    SEAM(0);
    if (IN(1)) REPEAT(1) {
#ifndef PROBE_GEMM
#define PROBE_GEMM 0
#endif
        pg8::StaticOrder S; S.init(NTOK / 256, NZ / 256, F.G, F.bx, PROBE_GEMM == 1 ? 2 : 1);
        const APlain AA{ws + WS_XB, 128u, (unsigned)(D * 2)}; const BPlain BA{(const bf16*)(ws + WS_WINT), D};
        const EpiZ E{(bf16*)(ws + WS_ZA), (bf16*)(ws + WS_ZG)};
        pg8::gemm_phase(F.lds, D, S, AA, BA, E);
        { const int nu = (NTOK / 256) * (NZ / 256), rem = nu % F.G;
          if (rem != 0 && F.bx >= rem) p0_experts(F, args, (F.bx - rem) * NWAVES + F.wave, (F.G - rem) * NWAVES, 0, P0_EXP_ITEMS); }
    }
    SEAM(1);
    if (IN(2)) REPEAT(2) { phase2(F, args); }
    SEAM(2);
    if (IN(3)) REPEAT(3) { phase3(F); }
    if (IN(4)) REPEAT(4) { phase4(F, args); }
    SEAM(4);
    if (IN(5)) REPEAT(5) {
        pg8::StaticOrder S; S.init(NTOK / 256, D / 256, F.G, F.bx);
        { const APlain AA{ws + WS_OA, 128u, 1024u}; const BPlain BA{(const bf16*)(ws + WS_WAT), 512};
          const EpiGate<0> E{(const bf16*)(ws + WS_ZG), nullptr, (bf16*)(ws + WS_T1)};
          pg8::gemm_phase(F.lds, 512, S, AA, BA, E); }
        { const APlain AA{ws + WS_OLAT, 128u, 2048u}; const BPlain BA{(const bf16*)(ws + WS_WBT), 1024};
          const EpiGate<1> E{(const bf16*)(ws + WS_ZG), (const bf16*)(ws + WS_T1), (bf16*)(ws + WS_MERGED)};
          pg8::gemm_phase(F.lds, 1024, S, AA, BA, E); }
    }
    SEAM(5);
    if (IN(6)) REPEAT(6) {
        pg8::StaticOrder S; S.init(NTOK / 256, D / 256, F.G, F.bx, PROBE_GEMM == 6 ? 2 : 1);
        const APlain AA{ws + WS_MERGED, 128u, 2048u}; const BPlain BA{(const bf16*)(ws + WS_WOT), 1024};
        const EpiRes E{args.in[0], (bf16*)(ws + WS_H1)};
        pg8::gemm_phase(F.lds, 1024, S, AA, BA, E);
    }
    SEAM(6);
    if (IN(7)) { phase6(F, args); }
    SEAM(7);
    if (IN(8)) REPEAT(8) {
        moe_setup(F);
        const int vcu = (F.G % 8 == 0) ? (F.bx % 8) * (F.G / 8) + F.bx / 8 : F.bx;
        const MoeOrder S{F.G, vcu, 2, (const LAS int*)(F.lds + MOE_CUM), (const LAS int*)(F.lds + MOE_CUM) + 40};
        const AGather AA{ws + WS_H1B, 128u, (const int*)(ws + WS_LIST)}; const BGu BA{(const bf16*)(ws + WS_WGU)};
        const EpiAct E{(bf16*)(ws + WS_ACT)};
        pg8::gemm_phase(F.lds, 1024, S, AA, BA, E);
    }
    SEAM(8);
    if (IN(9)) REPEAT(9) {
        moe_setup(F);
        const int vcu = (F.G % 8 == 0) ? (F.bx % 8) * (F.G / 8) + F.bx / 8 : F.bx;
        const MoeOrder S{F.G, vcu, 4, (const LAS int*)(F.lds + MOE_CUM), (const LAS int*)(F.lds + MOE_CUM) + 40};
        const APlain AA{ws + WS_ACT, 128u, 512u}; const BDn BA{(const bf16*)(ws + WS_WDT)};
        const EpiDown E{(bf16*)(ws + WS_YBUF), (const int*)(ws + WS_LIST)};
        pg8::gemm_phase(F.lds, 256, S, AA, BA, E);
    }
    SEAM(9);
    if (IN(10)) REPEAT(10) { phase9(F, args); }
#undef IN
#undef SEAM
#undef REPEAT
}

extern "C" void kernel_launch(void* const* d_in, const int* in_sizes, int n_in, void* d_out, int out_size, void* d_ws, size_t ws_size, hipStream_t stream) {
    static int grid = 0;
    if (grid == 0) {
        if (n_in != 26 || in_sizes[0] != NTOK * D || out_size != NTOK * D || ws_size < WS_END) {
            fprintf(stderr, "kernel_launch: unexpected problem: n_in %d in0 %d out %d ws %zu (need %zu)\n", n_in, n_in > 0 ? in_sizes[0] : -1, out_size, ws_size, (size_t)WS_END); grid = -1; return; }
        int dev = 0, cus = 0, per_cu = 0;
        if (hipGetDevice(&dev) != hipSuccess || hipDeviceGetAttribute(&cus, hipDeviceAttributeMultiprocessorCount, dev) != hipSuccess) { grid = -1; return; }
        if (hipFuncSetAttribute((const void*)fwd_kernel, hipFuncAttributeMaxDynamicSharedMemorySize, LDS_BYTES) != hipSuccess) { fprintf(stderr, "kernel_launch: hipFuncSetAttribute failed\n"); grid = -1; return; }
        if (hipOccupancyMaxActiveBlocksPerMultiprocessor(&per_cu, (const void*)fwd_kernel, NTHR, LDS_BYTES) != hipSuccess || per_cu < 1)
            fprintf(stderr, "kernel_launch: occupancy query reports %d\n", per_cu);
        (void)hipGetLastError();
        grid = cus;
    }
    if (grid < 0) return;
    if (hipMemsetAsync((char*)d_ws + WS_CTL, 0, CTL_ZERO_BYTES, stream) != hipSuccess) return;
    Args a{};
    for (int i = 0; i < 26; ++i) a.in[i] = (const float*)d_in[i];
    a.out = (float*)d_out; a.ws = (unsigned char*)d_ws;
#if MK_PER_PHASE
    for (int p = 0; p < NPHASE; ++p) { a.ph_lo = p; a.ph_hi = p + 1; hipLaunchKernelGGL(fwd_kernel, dim3(grid), dim3(NTHR), LDS_BYTES, stream, a); }
#else
    a.ph_lo = 0; a.ph_hi = NPHASE;
    hipLaunchKernelGGL(fwd_kernel, dim3(grid), dim3(NTHR), LDS_BYTES, stream, a);
#endif
}
```

```cpp
#include <hip/hip_runtime.h>
#include <cstdio>
#include <cstdint>

#ifndef MK_PER_PHASE
#define MK_PER_PHASE 0
#endif

#define GAS __attribute__((address_space(1)))
#define LAS __attribute__((address_space(3)))
typedef unsigned short bf16;
typedef short bf16x8 __attribute__((ext_vector_type(8)));
typedef short s16x4 __attribute__((ext_vector_type(4)));
typedef float f32x4 __attribute__((ext_vector_type(4)));
typedef float f32x16 __attribute__((ext_vector_type(16)));
typedef float f32x2 __attribute__((ext_vector_type(2)));
typedef unsigned u32x4 __attribute__((ext_vector_type(4)));
typedef unsigned u32x2 __attribute__((ext_vector_type(2)));

constexpr int D = 1024, BATCH = 8, SEQ = 4096, NTOK = BATCH * SEQ;
constexpr int D_IN = 4316;
constexpr int NCMP = 255;
constexpr float ALPHA = 1.189207115002721f;
constexpr float LOG2E = 1.4426950408889634f;
constexpr float NEGBIG = -1e30f;
constexpr int ZA_LD = 2816;
constexpr int ZC_QA = 0, ZC_KC = 512, ZC_VC = 640, ZC_KS = 768, ZC_VS = 896, ZC_KW = 1024, ZC_VW = 1152, ZC_QLAT = 1280, ZC_CKV = 2304,
              ZC_QIDX = 2432, ZC_KIDX = 2688, ZC_GNSA = 2752, ZC_WIDX = 2776;
constexpr int ZG_LD = 2048;
constexpr int NZ = ZA_LD + ZG_LD;
constexpr int NEXP = 32, DEXP = 256;
constexpr int MAXTILES = (2 * NTOK) / 256 + NEXP;

constexpr size_t MiB = 1u << 20;
constexpr size_t WS_CTL = 0, CTL_ZERO_BYTES = 1 * MiB;
constexpr size_t WS_WAT = 1 * MiB;
constexpr size_t WS_WBT = 2 * MiB;
constexpr size_t WS_WOT = 4 * MiB;
constexpr size_t WS_W1K = 6 * MiB;
constexpr size_t WS_W1V = 7 * MiB;
constexpr size_t WS_W2K = 8 * MiB;
constexpr size_t WS_W2V = 8 * MiB + 64 * 1024;
constexpr size_t WS_BIASK = 8 * MiB + 128 * 1024;
constexpr size_t WS_TBA = 8 * MiB + 256 * 1024;
constexpr size_t WS_TBB = 8 * MiB + 320 * 1024;
constexpr size_t WS_KCMP = 9 * MiB;
constexpr size_t WS_VCMP = 9 * MiB + 512 * 1024;
constexpr size_t WS_TOKINFO = 10 * MiB;
constexpr size_t WS_LIST = 11 * MiB;
constexpr size_t WS_WINT = 16 * MiB;
constexpr size_t WS_WGU = 32 * MiB;
constexpr size_t WS_WDT = 64 * MiB;
constexpr size_t WS_CKVN = 80 * MiB;
constexpr size_t WS_XB = 96 * MiB;
constexpr size_t WS_OLAT = 96 * MiB;
constexpr size_t WS_H1B = 96 * MiB;
constexpr size_t WS_ZA = 160 * MiB;
constexpr size_t WS_T1 = 160 * MiB;
constexpr size_t WS_ACT = 160 * MiB;
constexpr size_t WS_YBUF = 196 * MiB;
constexpr size_t WS_MERGED = 224 * MiB;
constexpr size_t WS_ZG = 336 * MiB;
constexpr size_t WS_H1 = 336 * MiB;
constexpr size_t WS_OA = 464 * MiB;
constexpr size_t WS_END = 496 * MiB;

constexpr int CW_BAR = 4096;
constexpr int CW_CNT = 16384;
constexpr int CW_P8R = 20480;

constexpr int LDS_BYTES = 163840;
constexpr int MISC_OFF = 160 * 1024 - 256;

__device__ __forceinline__ unsigned f2bf(float f) { unsigned u = __builtin_bit_cast(unsigned, f); return (u + 0x7fffu + ((u >> 16) & 1u)) >> 16; }
__device__ __forceinline__ unsigned pk2(float lo, float hi) { unsigned r; asm volatile("v_cvt_pk_bf16_f32 %0, %1, %2" : "=v"(r) : "v"(lo), "v"(hi)); return r; }
__device__ __forceinline__ float bf2f(unsigned short b) { return __builtin_bit_cast(float, ((unsigned)b) << 16); }
__device__ __forceinline__ float bflo(unsigned w) { return __builtin_bit_cast(float, w << 16); }
__device__ __forceinline__ float bfhi(unsigned w) { return __builtin_bit_cast(float, w & 0xffff0000u); }
__device__ __forceinline__ float wave_sum(float v) {
#pragma unroll
    for (int o = 1; o < 64; o <<= 1) v += __shfl_xor(v, o);
    return v;
}
__device__ __forceinline__ float sigmoidf_(float x) { return __builtin_amdgcn_rcpf(1.0f + __builtin_amdgcn_exp2f(-1.4426950408889634f * x)); }
#define LDS_WAIT() asm volatile("s_waitcnt lgkmcnt(0)" ::: "memory")
#define VM_WAIT() asm volatile("s_waitcnt vmcnt(0)" ::: "memory")

#define XB_TMO      128
#define XB_XCNT(j)  (256  + 64 * (j))
#define XB_XSUB(j)  (1280 + 64 * (j))
#define XB_XGEN(j)  (2304 + 64 * (j))
#define XB_TOP      3328
#define XB_TOPGEN   3392
#define XCD_BAR_WORDS 3456
#define XB_SPIN_CAP (1u << 18)
__device__ __forceinline__ unsigned xb_ld(unsigned* p)              { return __hip_atomic_load(p, __ATOMIC_RELAXED, __HIP_MEMORY_SCOPE_AGENT); }
__device__ __forceinline__ unsigned xb_add(unsigned* p, unsigned v) { return __hip_atomic_fetch_add(p, v, __ATOMIC_RELAXED, __HIP_MEMORY_SCOPE_AGENT); }
__device__ __forceinline__ unsigned xb_xcc_id() { return (unsigned)__builtin_amdgcn_s_getreg((3 << 11) | 20) & 0xFu; }
#define XB_SPIN(cond, bar) do { unsigned _sp = 0; while (cond) { __builtin_amdgcn_s_sleep(1); \
    if ((++_sp & 255u) == 0u) { if (xb_ld(&(bar)[XB_TMO])) break; if (_sp > XB_SPIN_CAP) { atomicAdd(&(bar)[XB_TMO], 1u); break; } } } } while (0)
struct XcdBarrier { unsigned* bar; unsigned x; volatile LAS unsigned* st; };
__device__ __forceinline__ XcdBarrier xcd_barrier_post(unsigned* bar, volatile LAS unsigned* st) {
    XcdBarrier b; b.bar = bar; b.x = xb_xcc_id(); b.st = st;
    if (threadIdx.x == 0) (void)xb_add(&bar[XB_XCNT(b.x)], 1u);
    return b;
}
__device__ __forceinline__ void xcd_barrier_complete(unsigned* bar, unsigned x, unsigned& nloc, unsigned& nx) {
    const unsigned G = gridDim.x * gridDim.y * gridDim.z;
    unsigned sum, cnt, mine, sp = 0u;
    for (;;) {
        sum = 0u; cnt = 0u; mine = 0u;
#pragma unroll
        for (unsigned j = 0; j < 16; ++j) { const unsigned c = xb_ld(&bar[XB_XCNT(j)]); sum += c; cnt += (c > 0u) ? 1u : 0u; mine = (j == x) ? c : mine; }
        if (sum == G) break;
        __builtin_amdgcn_s_sleep(1);
        if ((++sp & 255u) == 0u) { if (xb_ld(&bar[XB_TMO])) break; if (sp > XB_SPIN_CAP) { atomicAdd(&bar[XB_TMO], 1u); break; } }
    }
    nloc = mine > 0u ? mine : 1u; nx = cnt > 0u ? cnt : 1u;
}
__device__ __forceinline__ void xcd_barrier(const XcdBarrier& b) {
    asm volatile("s_waitcnt vmcnt(0)" ::: "memory");
    __syncthreads();
    if (threadIdx.x == 0) {
        unsigned* bar = b.bar;
        __builtin_amdgcn_s_waitcnt(0);
        unsigned nloc = b.st[0], nx = b.st[1];
        if (nloc == 0u) { xcd_barrier_complete(bar, b.x, nloc, nx); b.st[0] = nloc; b.st[1] = nx; }
        const unsigned old = xb_add(&bar[XB_XSUB(b.x)], 1u);
        const unsigned gen = old / nloc;
        if (old + 1u == (gen + 1u) * nloc) {
            __builtin_amdgcn_fence(__ATOMIC_RELEASE, "agent");
            asm volatile("s_waitcnt vmcnt(0)" ::: "memory");
            const unsigned og = xb_add(&bar[XB_TOP], 1u);
            const unsigned tg = og / nx;
            if (og + 1u == (tg + 1u) * nx) xb_add(&bar[XB_TOPGEN], 1u);
            else XB_SPIN(xb_ld(&bar[XB_TOPGEN]) == tg, bar);
            __builtin_amdgcn_fence(__ATOMIC_ACQUIRE, "agent");
            xb_add(&bar[XB_XGEN(b.x)], 1u);
            asm volatile("s_waitcnt vmcnt(0)" ::: "memory");
        } else {
            XB_SPIN(xb_ld(&bar[XB_XGEN(b.x)]) == gen, bar);
            __builtin_amdgcn_fence(__ATOMIC_ACQUIRE, "agent");
            asm volatile("s_waitcnt vmcnt(0)" ::: "memory");
        }
    }
    __syncthreads();
}

namespace pg8 {
constexpr int BM = 256, BK = 64, HALF = 128, HTB = HALF * BK * 2, STAGE_BYTES = 8 * HTB, NXCD = 8, WGM = 8;
__host__ __device__ __forceinline__ int lds_byte(int r, int c) { const int st = (r >> 4) * 2 + (c >> 5), rr = r & 15, cc = c & 31, ob = rr * 64 + cc * 2; return st * 1024 + (ob ^ (((ob >> 9) & 1) << 5)); }
__host__ __device__ __forceinline__ void stage_rc(int b, int& R, int& C) { const int st = b / 1024, sb = b % 1024, swz = sb ^ (((sb >> 9) & 1) << 5); R = (st >> 1) * 16 + swz / 64; C = (st & 1) * 32 + (swz % 64) / 2; }
__host__ __device__ __forceinline__ int perm32(int rho) { const int n = rho >> 4, i = rho & 15; return 8 * (i >> 2) + 4 * n + (i & 3); }
struct Unit { int pm, pn, e, nrows; };
struct StaticOrder {
    int nM, nN, nwg, G, c, dup;
    __device__ void init(int nM_, int nN_, int G_, int c_, int dup_ = 1) { nM = nM_; nN = nN_; nwg = nM * nN; G = G_; c = c_; dup = dup_; }
    __device__ bool next(int i, Unit& u) const {
        const long L0 = (long)i * G + c; if (L0 >= (long)nwg * dup) return false;
        const long L = L0 % nwg;
        int wgid = (int)L; { const int q = nwg / NXCD, r = nwg % NXCD, xcd = wgid % NXCD, off = wgid / NXCD; wgid = (xcd < r ? xcd * (q + 1) : r * (q + 1) + (xcd - r) * q) + off; }
        const int nig = WGM * nN, gid = wgid / nig, fm = gid * WGM, gsz = (nM - fm) < WGM ? (nM - fm) : WGM;
        u.pm = fm + ((wgid % nig) % gsz); u.pn = (wgid % nig) / gsz; u.e = 0; u.nrows = 256; return true;
    }
    __device__ __forceinline__ void done(int) const {}
};

template <class Epi, class Sched, class AAddr, class BAddr>
__device__ __forceinline__ void gemm_phase(LAS unsigned char* lds, const int K, const Sched& S, const AAddr& AA, const BAddr& BA, const Epi& E) {
    constexpr bool GA = AAddr::GATHER;
    const int tid = threadIdx.x, wid = __builtin_amdgcn_readfirstlane(tid >> 6), lane = tid & 63, wr = wid >> 2, wc = wid & 3, fr = lane & 15, fq = lane >> 4;
    const int nt = K / BK;
    unsigned voffA[2], voffB[2];
#pragma unroll
    for (int i = 0; i < 2; ++i) { int R, C; stage_rc(tid * 16 + i * 8192, R, C); const int Rb = Epi::PERM ? ((R & ~31) + perm32(R & 31)) : R;
        voffA[i] = GA ? 0u : AA.lane_off(R, C); voffB[i] = (unsigned)(Rb * K + C) * 2u; }
    const size_t kstepA = (size_t)AA.kstep, kstepB = (size_t)(BK * 2);
    const size_t hstepB = (size_t)HALF * K * 2, hstepA = GA ? 0 : AA.hstep();
    const unsigned ldsw = (unsigned)wid * 1024u;
    const int aoff = lds_byte(wr * 64 + fr, fq * 8), boff = lds_byte(wc * 32 + fr, fq * 8);
#define PG8_SA(b, h) (((b) * 2 + (h)) * HTB)
#define PG8_SB(b, h) ((4 + (b) * 2 + (h)) * HTB)
#define PG8_STAGE(bufoff, gbase, voff) do { _Pragma("unroll") for (int _i = 0; _i < 2; ++_i) \
        __builtin_amdgcn_global_load_lds((const unsigned*)((const char*)(gbase) + (voff)[_i]), (LAS unsigned*)(lds + (bufoff) + ldsw + _i * 8192), 16, 0, 0); } while (0)
#define PG8_STA_CUR(bufoff, h, kb) do { if constexpr (GA) { if (h) PG8_STAGE(bufoff, baseA + (kb), cof1); else PG8_STAGE(bufoff, baseA + (kb), cof0); } \
        else PG8_STAGE(bufoff, cA + (h) * hstepA + (kb), voffA); } while (0)
#define PG8_STA_SEL(bufoff, h, kb) do { if constexpr (GA) { if (h) PG8_STAGE(bufoff, baseA + (kb), sof1); else PG8_STAGE(bufoff, baseA + (kb), sof0); } \
        else PG8_STAGE(bufoff, sA + (h) * hstepA + (kb), voffA); } while (0)
#define PG8_LDA(dst, b, h) do { _Pragma("unroll") for (int m = 0; m < 4; ++m) _Pragma("unroll") for (int k = 0; k < 2; ++k) dst[m][k] = *(const LAS bf16x8*)(lds + PG8_SA(b, h) + aoff + m * 2048 + k * 1024); } while (0)
#define PG8_LDB(dst, b, h) do { _Pragma("unroll") for (int n = 0; n < 2; ++n) _Pragma("unroll") for (int k = 0; k < 2; ++k) dst[n][k] = *(const LAS bf16x8*)(lds + PG8_SB(b, h) + boff + n * 2048 + k * 1024); } while (0)
#define PG8_MMA(ai, bj, At, Bt) do { __builtin_amdgcn_s_setprio(1); _Pragma("unroll") for (int m = 0; m < 4; ++m) _Pragma("unroll") for (int n = 0; n < 2; ++n) _Pragma("unroll") for (int k = 0; k < 2; ++k) \
        acc[ai][bj][m][n] = __builtin_amdgcn_mfma_f32_16x16x32_bf16(Bt[n][k], At[m][k], acc[ai][bj][m][n], 0, 0, 0); __builtin_amdgcn_s_setprio(0); } while (0)
#define PG8_WAIT_V(n) asm volatile("s_waitcnt vmcnt(" #n ")" ::: "memory")
#define PG8_WAIT_L(n) asm volatile("s_waitcnt lgkmcnt(" #n ")" ::: "memory")
#define PG8_BAR __builtin_amdgcn_s_barrier()
#define PG8_SCHED __builtin_amdgcn_sched_barrier(0)
#define PG8_GOFF(u, o0, o1) do { _Pragma("unroll") for (int _i = 0; _i < 2; ++_i) { int R_, C_; stage_rc(tid * 16 + _i * 8192, R_, C_); \
        o0[_i] = AA.row_off(u, R_) + (unsigned)C_ * 2u; o1[_i] = AA.row_off(u, R_ + HALF) + (unsigned)C_ * 2u; } } while (0)
    Unit cur, nxt; int ui = 0;
    if (!S.next(0, cur)) return;
    f32x4 acc[2][2][4][2];
#pragma unroll
    for (int a = 0; a < 2; ++a)
#pragma unroll
        for (int b = 0; b < 2; ++b)
#pragma unroll
            for (int m = 0; m < 4; ++m)
#pragma unroll
                for (int n = 0; n < 2; ++n) acc[a][b][m][n] = (f32x4){0.f, 0.f, 0.f, 0.f};
    bf16x8 At[4][2], B0[2][2], B1[2][2];
    const char* const baseA = GA ? (const char*)AA.base : nullptr;
    const char* cA = GA ? nullptr : (const char*)AA.unit_ptr(cur);
    unsigned cof0[2] = {0u, 0u}, cof1[2] = {0u, 0u}, nof0[2] = {0u, 0u}, nof1[2] = {0u, 0u};
    if constexpr (GA) PG8_GOFF(cur, cof0, cof1);
    const char* cB = (const char*)BA.ptr(cur);
    PG8_STAGE(PG8_SB(0, 0), cB, voffB); PG8_STA_CUR(PG8_SA(0, 0), 0, 0); PG8_STAGE(PG8_SB(0, 1), cB + hstepB, voffB); PG8_STA_CUR(PG8_SA(0, 1), 1, 0);
    if (wr == 1) PG8_BAR;
    PG8_WAIT_V(4); PG8_BAR;
    PG8_STAGE(PG8_SB(1, 0), cB + kstepB, voffB); PG8_STA_CUR(PG8_SA(1, 0), 0, kstepA); PG8_STAGE(PG8_SB(1, 1), cB + hstepB + kstepB, voffB);
    PG8_WAIT_V(6); PG8_BAR;
    for (;;) {
        const bool has_next = S.next(ui + 1, nxt);
        const char* nB = cB; const char* nA = cA;
        if (has_next) { nB = (const char*)BA.ptr(nxt); if constexpr (GA) PG8_GOFF(nxt, nof0, nof1); else nA = (const char*)AA.unit_ptr(nxt); }
        else { if constexpr (GA) {
#pragma unroll
            for (int i = 0; i < 2; ++i) { nof0[i] = cof0[i]; nof1[i] = cof1[i]; } } }
#pragma nounroll
        for (int t = 0; t < nt; t += 2) {
            const bool last = (t == nt - 2);
            const size_t k1 = (size_t)(t + 1) * kstepA, k2 = last ? 0 : (size_t)(t + 2) * kstepA, k3 = k2 + kstepA;
            const char* b2 = last ? nB : cB + (size_t)(t + 2) * kstepB; const char* b3 = b2 + kstepB;
            const char* sA = last ? nA : cA;
            unsigned sof0[2], sof1[2];
#pragma unroll
            for (int i = 0; i < 2; ++i) { sof0[i] = last ? nof0[i] : cof0[i]; sof1[i] = last ? nof1[i] : cof1[i]; }
            PG8_LDB(B0, 0, 0); PG8_SCHED; PG8_LDA(At, 0, 0); PG8_STA_CUR(PG8_SA(1, 1), 1, k1);
            PG8_WAIT_L(8); PG8_BAR; PG8_WAIT_L(0); PG8_MMA(0, 0, At, B0); PG8_BAR; PG8_SCHED;
            PG8_LDB(B1, 0, 1); PG8_STAGE(PG8_SB(0, 0), b2, voffB);
            PG8_BAR; PG8_WAIT_L(0); PG8_MMA(0, 1, At, B1); PG8_BAR;
            PG8_LDA(At, 0, 1); PG8_STA_SEL(PG8_SA(0, 0), 0, k2);
            PG8_BAR; PG8_WAIT_L(0); PG8_MMA(1, 0, At, B0); PG8_BAR; PG8_SCHED;
            PG8_STAGE(PG8_SB(0, 1), b2 + hstepB, voffB);
            PG8_WAIT_V(6); PG8_BAR; PG8_MMA(1, 1, At, B1); PG8_BAR;
            PG8_LDB(B0, 1, 0); PG8_SCHED; PG8_LDA(At, 1, 0); PG8_STA_SEL(PG8_SA(0, 1), 1, k2);
            PG8_WAIT_L(8); PG8_BAR; PG8_WAIT_L(0); PG8_MMA(0, 0, At, B0); PG8_BAR; PG8_SCHED;
            PG8_LDB(B1, 1, 1); PG8_STAGE(PG8_SB(1, 0), b3, voffB);
            PG8_BAR; PG8_WAIT_L(0); PG8_MMA(0, 1, At, B1); PG8_BAR;
            PG8_LDA(At, 1, 1); PG8_STA_SEL(PG8_SA(1, 0), 0, k3);
            PG8_BAR; PG8_WAIT_L(0); PG8_MMA(1, 0, At, B0); PG8_BAR; PG8_SCHED;
            PG8_STAGE(PG8_SB(1, 1), b3 + hstepB, voffB);
            PG8_WAIT_V(6); PG8_BAR; PG8_MMA(1, 1, At, B1); PG8_BAR;
        }
        E(acc, cur, wr, wc, fr, fq);
        S.done(ui);
        if (!has_next) break;
#pragma unroll
        for (int a = 0; a < 2; ++a)
#pragma unroll
            for (int b = 0; b < 2; ++b)
#pragma unroll
                for (int m = 0; m < 4; ++m)
#pragma unroll
                    for (int n = 0; n < 2; ++n) acc[a][b][m][n] = (f32x4){0.f, 0.f, 0.f, 0.f};
        cur = nxt; cB = nB; cA = nA; ++ui;
        if constexpr (GA) {
#pragma unroll
            for (int i = 0; i < 2; ++i) { cof0[i] = nof0[i]; cof1[i] = nof1[i]; } }
    }
    PG8_WAIT_V(0);
    if (wr == 0) PG8_BAR;
    PG8_BAR;
#undef PG8_SA
#undef PG8_SB
#undef PG8_STAGE
#undef PG8_STA_CUR
#undef PG8_STA_SEL
#undef PG8_GOFF
#undef PG8_LDA
#undef PG8_LDB
#undef PG8_MMA
#undef PG8_WAIT_V
#undef PG8_WAIT_L
#undef PG8_BAR
#undef PG8_SCHED
}
}

constexpr int NWAVES = 8, NTHR = 512;
struct Args { const float* in[26]; float* out; unsigned char* ws; int ph_lo, ph_hi; unsigned repmask; int pad; };
struct Frame {
    LAS unsigned char* lds;
    int tid, lane, wave, G, bx;
    unsigned char* ws;
};

struct APlain { const void* base; unsigned kstep; unsigned ld2;
    static constexpr bool GATHER = false;
    __device__ __forceinline__ const void* unit_ptr(const pg8::Unit& u) const { return (const char*)base + (size_t)u.pm * 256 * ld2; }
    __device__ __forceinline__ unsigned lane_off(int R, int C) const { return (unsigned)R * ld2 + (unsigned)C * 2u; }
    __device__ __forceinline__ size_t hstep() const { return (size_t)128 * ld2; }
    __device__ __forceinline__ unsigned row_off(const pg8::Unit&, int) const { return 0u; } };
struct BPlain { const bf16* Bt; int K;
    __device__ __forceinline__ const void* ptr(const pg8::Unit& u) const { return Bt + (size_t)u.pn * 256 * K; } };

struct EpiZ {
    static constexpr bool PERM = true;
    bf16* ZA; bf16* ZG;
    __device__ __forceinline__ void operator()(const f32x4 (&acc)[2][2][4][2], const pg8::Unit& u, int wr, int wc, int fr, int fq) const {
        const bool gate = u.pn >= 11;
        bf16* base = gate ? ZG : ZA; const int ld = gate ? ZG_LD : ZA_LD; const int colt = gate ? (u.pn - 11) * 256 : u.pn * 256;
        const int row0 = u.pm * 256 + wr * 64 + fr, col0 = colt + wc * 32 + 8 * fq;
#pragma unroll
        for (int ai = 0; ai < 2; ++ai)
#pragma unroll
            for (int m = 0; m < 4; ++m) { bf16* rowp = base + (size_t)(row0 + ai * 128 + m * 16) * ld + col0;
#pragma unroll
                for (int bj = 0; bj < 2; ++bj) { f32x4 v0 = acc[ai][bj][m][0], v1 = acc[ai][bj][m][1];
                    if (gate) {
#pragma unroll
                        for (int j = 0; j < 4; ++j) { v0[j] = sigmoidf_(v0[j]); v1[j] = sigmoidf_(v1[j]); } }
                    u32x4 w; w.x = pk2(v0[0], v0[1]); w.y = pk2(v0[2], v0[3]); w.z = pk2(v1[0], v1[1]); w.w = pk2(v1[2], v1[3]);
                    *(u32x4*)(rowp + bj * 128) = w; } }
    }
};
template <int MODE> struct EpiGate {
    static constexpr bool PERM = true;
    const bf16* ZG; const bf16* T1; bf16* O;
    __device__ __forceinline__ void operator()(const f32x4 (&acc)[2][2][4][2], const pg8::Unit& u, int wr, int wc, int fr, int fq) const {
        const int row0 = u.pm * 256 + wr * 64 + fr, col0 = u.pn * 256 + wc * 32 + 8 * fq;
#pragma unroll
        for (int ai = 0; ai < 2; ++ai) {
            u32x4 gv[4][2], tv[4][2];
#pragma unroll
            for (int m = 0; m < 4; ++m)
#pragma unroll
                for (int bj = 0; bj < 2; ++bj) { const size_t r = (size_t)(row0 + ai * 128 + m * 16); const int c = col0 + bj * 128;
                    gv[m][bj] = *(const u32x4*)(ZG + r * ZG_LD + MODE * 1024 + c); if (MODE == 1) tv[m][bj] = *(const u32x4*)(T1 + r * 1024 + c); }
#pragma unroll
            for (int m = 0; m < 4; ++m)
#pragma unroll
                for (int bj = 0; bj < 2; ++bj) { asm volatile("" : "+v"(gv[m][bj])); if (MODE == 1) asm volatile("" : "+v"(tv[m][bj])); }
#pragma unroll
            for (int m = 0; m < 4; ++m) { const size_t r = (size_t)(row0 + ai * 128 + m * 16);
#pragma unroll
                for (int bj = 0; bj < 2; ++bj) { const int c = col0 + bj * 128; const u32x4 g = gv[m][bj];
                    const f32x4 v0 = acc[ai][bj][m][0], v1 = acc[ai][bj][m][1];
                    float o[8] = { v0[0] * bflo(g.x), v0[1] * bfhi(g.x), v0[2] * bflo(g.y), v0[3] * bfhi(g.y), v1[0] * bflo(g.z), v1[1] * bfhi(g.z), v1[2] * bflo(g.w), v1[3] * bfhi(g.w) };
                    if (MODE == 1) { const u32x4 t = tv[m][bj];
                        o[0] += bflo(t.x); o[1] += bfhi(t.x); o[2] += bflo(t.y); o[3] += bfhi(t.y); o[4] += bflo(t.z); o[5] += bfhi(t.z); o[6] += bflo(t.w); o[7] += bfhi(t.w); }
                    u32x4 w; w.x = pk2(o[0], o[1]); w.y = pk2(o[2], o[3]); w.z = pk2(o[4], o[5]); w.w = pk2(o[6], o[7]);
                    *(u32x4*)(O + r * 1024 + c) = w; } }
        }
    }
};
struct EpiRes {
    static constexpr bool PERM = true;
    const float* X; bf16* O;
    __device__ __forceinline__ void operator()(const f32x4 (&acc)[2][2][4][2], const pg8::Unit& u, int wr, int wc, int fr, int fq) const {
        const int row0 = u.pm * 256 + wr * 64 + fr, col0 = u.pn * 256 + wc * 32 + 8 * fq;
#pragma unroll
        for (int ai = 0; ai < 2; ++ai) {
            f32x4 xv[4][2][2];
#pragma unroll
            for (int m = 0; m < 4; ++m)
#pragma unroll
                for (int bj = 0; bj < 2; ++bj) { const size_t off = (size_t)(row0 + ai * 128 + m * 16) * D + col0 + bj * 128; xv[m][bj][0] = *(const f32x4*)(X + off); xv[m][bj][1] = *(const f32x4*)(X + off + 4); }
#pragma unroll
            for (int m = 0; m < 4; ++m)
#pragma unroll
                for (int bj = 0; bj < 2; ++bj) { asm volatile("" : "+v"(xv[m][bj][0])); asm volatile("" : "+v"(xv[m][bj][1])); }
#pragma unroll
            for (int m = 0; m < 4; ++m)
#pragma unroll
                for (int bj = 0; bj < 2; ++bj) { const size_t off = (size_t)(row0 + ai * 128 + m * 16) * D + col0 + bj * 128;
                    const f32x4 v0 = xv[m][bj][0] * ALPHA + acc[ai][bj][m][0], v1 = xv[m][bj][1] * ALPHA + acc[ai][bj][m][1];
                    u32x4 w; w.x = pk2(v0[0], v0[1]); w.y = pk2(v0[2], v0[3]); w.z = pk2(v1[0], v1[1]); w.w = pk2(v1[2], v1[3]);
                    *(u32x4*)(O + off) = w; }
        }
    }
};

template <class F>
__device__ __forceinline__ void p0_tile(const F& f, bf16* WT, int ldk, int k0, int n0, LAS float* scr, int lane) {
    if constexpr (F::FOLD) {
        float bc[64];
#pragma unroll
        for (int d = 0; d < 64; ++d) bc[d] = f.bval(k0, d, n0 + (lane & 31));
#pragma unroll 4
        for (int i = 0; i < 32; ++i) { const int kk = 2 * i + (lane >> 5); const f32x4* ar = (const f32x4*)f.arow(k0 + kk, n0); f32x4 a4 = {0.f, 0.f, 0.f, 0.f};
#pragma unroll
            for (int q = 0; q < 16; ++q) { const f32x4 av = ar[q]; a4[0] += av[0] * bc[4 * q]; a4[1] += av[1] * bc[4 * q + 1]; a4[2] += av[2] * bc[4 * q + 2]; a4[3] += av[3] * bc[4 * q + 3]; }
            scr[kk * 33 + (lane & 31)] = (a4[0] + a4[1]) + (a4[2] + a4[3]); }
    } else {
        float v[32];
#pragma unroll
        for (int i = 0; i < 32; ++i) { const int kk = 2 * i + (lane >> 5); v[i] = f(k0 + kk, n0 + (lane & 31)); }
#pragma unroll
        for (int i = 0; i < 32; ++i) { const int kk = 2 * i + (lane >> 5); scr[kk * 33 + (lane & 31)] = v[i]; }
    }
    LDS_WAIT(); asm volatile("" ::: "memory");
    const int c = lane & 7;
#pragma unroll
    for (int j = 0; j < 4; ++j) { const int n = (lane >> 3) + 8 * j; const LAS float* s = scr + (8 * c) * 33 + n;
        u32x4 o; o.x = pk2(s[0 * 33], s[1 * 33]); o.y = pk2(s[2 * 33], s[3 * 33]); o.z = pk2(s[4 * 33], s[5 * 33]); o.w = pk2(s[6 * 33], s[7 * 33]);
        *(u32x4*)(WT + (size_t)(n0 + n) * ldk + k0 + 8 * c) = o; }
    LDS_WAIT(); asm volatile("" ::: "memory");
}
struct P0Item { const float* src; int N, noff; bf16* dst; int ldk, k0, n0; };
__device__ __forceinline__ void p0_item_load(const P0Item& it, float (&v)[32], int lane) {
#pragma unroll
    for (int i = 0; i < 32; ++i) { const int kk = 2 * i + (lane >> 5); v[i] = it.src[(size_t)(it.k0 + kk) * it.N + it.n0 + (lane & 31) + it.noff]; }
}
__device__ __forceinline__ void p0_item_finish(const P0Item& it, const float (&v)[32], LAS float* scr, int lane) {
#pragma unroll
    for (int i = 0; i < 32; ++i) { const int kk = 2 * i + (lane >> 5); scr[kk * 33 + (lane & 31)] = v[i]; }
    LDS_WAIT(); asm volatile("" ::: "memory");
    const int c = lane & 7;
#pragma unroll
    for (int j = 0; j < 4; ++j) { const int n = (lane >> 3) + 8 * j; const LAS float* s = scr + (8 * c) * 33 + n;
        u32x4 o; o.x = pk2(s[0 * 33], s[1 * 33]); o.y = pk2(s[2 * 33], s[3 * 33]); o.z = pk2(s[4 * 33], s[5 * 33]); o.w = pk2(s[6 * 33], s[7 * 33]);
        *(u32x4*)(it.dst + (size_t)(it.n0 + n) * it.ldk + it.k0 + 8 * c) = o; }
    LDS_WAIT(); asm volatile("" ::: "memory");
}
__device__ __forceinline__ int zsrc_col(int n) {
    if (n < 1280) return n;
    if (n < 2304) return -2;
    if (n < 2432) return 1816 + (n - 2304);
    if (n < 2688) return 1944 + (n - 2432);
    if (n < 2752) return 2200 + (n - 2688);
    if (n < 2776) return 1280 + (n - 2752);
    if (n < 2780) return 2264 + (n - 2776);
    if (n < 2816) return -1;
    if (n < 3840) return 2268 + (n - 2816);
    return 3292 + (n - 3840);
}
struct FWin { const float* w_in; static constexpr bool FOLD = false;
    __device__ __forceinline__ float operator()(int k, int n) const { const int s = zsrc_col(n); return s >= 0 ? w_in[(size_t)k * D_IN + s] : 0.f; } };
struct FWinQ { const float* w_in; const float* w_uk; static constexpr bool FOLD = true;
    __device__ __forceinline__ const float* arow(int k, int n0) const { return w_in + (size_t)k * D_IN + 1304 + ((n0 - 1280) >> 7) * 64; }
    __device__ __forceinline__ float bval(int, int d, int n) const { return w_uk[(size_t)((n - 1280) >> 7) * 64 * 128 + d * 128 + ((n - 1280) & 127)]; }
    __device__ __forceinline__ float operator()(int, int) const { return 0.f; } };
struct FWb { const float* w_uv; const float* w_bb; static constexpr bool FOLD = true;
    __device__ __forceinline__ const float* arow(int k, int) const { return w_uv + (size_t)k * 64; }
    __device__ __forceinline__ float bval(int k0, int d, int n) const { return w_bb[(size_t)((k0 >> 7) * 64 + d) * D + n]; }
    __device__ __forceinline__ float operator()(int, int) const { return 0.f; } };
struct FPlain { const float* W; int N; static constexpr bool FOLD = false; __device__ __forceinline__ float operator()(int k, int n) const { return W[(size_t)k * N + n]; } };
struct FOff { const float* W; int N; int noff; static constexpr bool FOLD = false;
    __device__ __forceinline__ float operator()(int k, int n) const { return W[(size_t)k * N + n + noff]; } };

__device__ __forceinline__ float rel_bucket_bias(const float* rel_bias, int dist, int head) {
    int b;
    if (dist < 16) b = dist;
    else { const float t = (__log2f((float)dist) - 4.0f) * 2.66666675f; b = 16 + (int)t; if (b > 31) b = 31; }
    return rel_bias[b * 16 + head];
}

constexpr int P0_EXP_ITEMS = NEXP * ((1024 / 64) * (512 / 32) + (256 / 64) * (1024 / 32)), P0_EXP_SPLIT = (P0_EXP_ITEMS * 2) / 3;
__device__ __forceinline__ void p0_experts(const Frame& F, const Args& a, int wv, int nwv, int ibeg, int iend) {
    LAS float* scr = (LAS float*)(F.lds + F.wave * 16384);
    unsigned char* ws = F.ws;
    constexpr int I_GU = (1024 / 64) * (512 / 32), I_DN = (256 / 64) * (1024 / 32);
    const int gw = wv, NGW = nwv;
    {
        constexpr int NEI = NEXP * (I_GU + I_DN);
        auto mk = [&](int idx) { P0Item it; const int e = idx / (I_GU + I_DN); int r = idx - e * (I_GU + I_DN);
            if (r < I_GU) {
                const int n0 = (r % 16) * 32; const uintptr_t pg = (uintptr_t)a.in[21], pu = (uintptr_t)a.in[22];
                it.src = (const float*)(pg + (uintptr_t)((n0 >> 7) & 1) * (pu - pg)) + (size_t)e * D * DEXP; it.N = DEXP; it.noff = ((n0 >> 8) * 128 + (n0 & 127)) - n0;
                it.dst = (bf16*)(ws + WS_WGU) + (size_t)e * 512 * 1024; it.ldk = 1024; it.k0 = (r / 16) * 64; it.n0 = n0; }
            else { r -= I_GU; it.src = a.in[23] + (size_t)e * DEXP * D; it.N = D; it.noff = 0; it.dst = (bf16*)(ws + WS_WDT) + (size_t)e * 1024 * 256; it.ldk = 256; it.k0 = (r / 32) * 64; it.n0 = (r % 32) * 32; }
            return it; };
        float va[32], vb[32];
        {
        (void)NEI;
        int idx = ibeg + gw;
        if (idx < iend) { P0Item cur = mk(idx); p0_item_load(cur, va, F.lane);
            for (;;) {
                const int nidx = idx + NGW; const bool more = nidx < iend; P0Item nxt = cur;
                if (more) { nxt = mk(nidx); p0_item_load(nxt, vb, F.lane); }
                p0_item_finish(cur, va, scr, F.lane);
                if (!more) break;
#pragma unroll
                for (int i = 0; i < 32; ++i) va[i] = vb[i];
                cur = nxt; idx = nidx; } }
        }
    }
}
__device__ __forceinline__ void phase0(const Frame& F, const Args& a) {
    LAS float* scr = (LAS float*)(F.lds + F.wave * 16384);
    const int gw = F.bx * NWAVES + F.wave, NGW = F.G * NWAVES;
    unsigned char* ws = F.ws;
    constexpr int I_WIN = (D / 64) * (NZ / 32);
    constexpr int I_WB = (1024 / 64) * (1024 / 32);
    constexpr int I_WA = (512 / 64) * (1024 / 32);
    constexpr int I_WO = I_WB;
    constexpr int I_W1 = (2048 / 64) * (256 / 32);
    constexpr int I_W2 = (256 / 64) * (64 / 32);
    constexpr int I_GU = (1024 / 64) * (512 / 32);
    constexpr int I_DN = (256 / 64) * (1024 / 32);
    constexpr int NITEMS = I_WIN + I_WB + I_WA + I_WO + 2 * I_W1 + 2 * I_W2;
    (void)NITEMS;
    constexpr int I_WINP = (D / 64) * ((NZ - 1024) / 32);
    for (int it = gw; it < 1024; it += NGW) {
        if (it < 512) { const int k0 = (it >> 5) * 64, n0 = 1280 + (it & 31) * 32; const FWinQ f{a.in[1], a.in[9]}; p0_tile(f, (bf16*)(ws + WS_WINT), D, k0, n0, scr, F.lane); }
        else { const int r = it - 512; const FWb f{a.in[10], a.in[13]}; p0_tile(f, (bf16*)(ws + WS_WBT), 1024, (r / 32) * 64, (r % 32) * 32, scr, F.lane); }
    }
    { constexpr int NPL = I_WINP + I_WA + I_WO + 2 * I_W1 + 2 * I_W2;
      const int pw0 = NGW > 1024 ? (gw >= 1024 ? gw - 1024 : -1) : gw, pws = NGW > 1024 ? NGW - 1024 : NGW;
      if (pw0 >= 0) for (int it = pw0; it < NPL; it += pws) {
        int r = it;
        if (r < I_WINP) { const int k0 = (r / 120) * 64; int nb = r % 120; nb = nb < 40 ? nb : nb + 32; const FWin f{a.in[1]}; p0_tile(f, (bf16*)(ws + WS_WINT), D, k0, nb * 32, scr, F.lane); continue; } r -= I_WINP;
        if (r < I_WA) { const FPlain f{a.in[12], D}; p0_tile(f, (bf16*)(ws + WS_WAT), 512, (r / 32) * 64, (r % 32) * 32, scr, F.lane); continue; } r -= I_WA;
        if (r < I_WO) { const FPlain f{a.in[14], D}; p0_tile(f, (bf16*)(ws + WS_WOT), 1024, (r / 32) * 64, (r % 32) * 32, scr, F.lane); continue; } r -= I_WO;
        if (r < I_W1) { const FPlain f{a.in[4], 256}; p0_tile(f, (bf16*)(ws + WS_W1K), 2048, (r / 8) * 64, (r % 8) * 32, scr, F.lane); continue; } r -= I_W1;
        if (r < I_W1) { const FPlain f{a.in[6], 256}; p0_tile(f, (bf16*)(ws + WS_W1V), 2048, (r / 8) * 64, (r % 8) * 32, scr, F.lane); continue; } r -= I_W1;
        if (r < I_W2) { const FPlain f{a.in[5], 64}; p0_tile(f, (bf16*)(ws + WS_W2K), 256, (r / 2) * 64, (r % 2) * 32, scr, F.lane); continue; } r -= I_W2;
        { const FPlain f{a.in[7], 64}; p0_tile(f, (bf16*)(ws + WS_W2V), 256, (r / 2) * 64, (r % 2) * 32, scr, F.lane); }
      } }
    { const int nu = (NTOK / 256) * (NZ / 256); if ((nu % F.G) == 0) p0_experts(F, a, gw, NGW, 0, P0_EXP_ITEMS); }
    { const f32x4* x4 = (const f32x4*)a.in[0]; u32x2* o = (u32x2*)(ws + WS_XB);
      const size_t total = (size_t)NTOK * D / 4, stride = (size_t)F.G * NTHR;
      for (size_t i0 = (size_t)F.bx * NTHR + F.tid; i0 < total; i0 += 8 * stride) { f32x4 v[8];
#pragma unroll
          for (int j = 0; j < 8; ++j) { const size_t i = i0 + j * stride; v[j] = i < total ? x4[i] : (f32x4){0.f, 0.f, 0.f, 0.f}; }
#pragma unroll
          for (int j = 0; j < 8; ++j) { const size_t i = i0 + j * stride; if (i < total) { u32x2 w; w.x = pk2(v[j][0], v[j][1]); w.y = pk2(v[j][2], v[j][3]); o[i] = w; } } } }
    if (F.bx < 64 && F.tid < 256) {
        const int kv = F.bx >> 5, j = F.bx & 31;
        const float* pe = (kv ? a.in[3] : a.in[2]) + 64 * j; const float* w1 = (kv ? a.in[6] : a.in[4]) + (size_t)(64 * j) * 256 + F.tid; float acc = 0.f;
#pragma unroll 16
        for (int k = 0; k < 64; ++k) acc += pe[k] * w1[(size_t)k * 256];
        ((float*)(ws + WS_BIASK))[(kv * 32 + j) * 256 + F.tid] = acc;
    }
    if (F.bx >= 64 && F.bx < 96) { const int idx = (F.bx - 64) * NTHR + F.tid;
        const int tab = idx >> 13, head = (idx >> 10) & 7, dist = idx & 1023;
        ((float*)(ws + (tab ? WS_TBB : WS_TBA)))[head * 1024 + dist] = rel_bucket_bias(a.in[11], dist, tab * 8 + head) * LOG2E; }
}

constexpr int NRT = 36;
constexpr int P6_WR = 0;
constexpr int P6_CNT = 147456;
constexpr int P6_ENT = 147456 + 512;
__device__ __forceinline__ float row16_sum(float v) {
    v += __builtin_bit_cast(float, __builtin_amdgcn_update_dpp(0, __builtin_bit_cast(int, v), 0xB1, 0xf, 0xf, true));
    v += __builtin_bit_cast(float, __builtin_amdgcn_update_dpp(0, __builtin_bit_cast(int, v), 0x4E, 0xf, 0xf, true));
    v += __builtin_bit_cast(float, __builtin_amdgcn_update_dpp(0, __builtin_bit_cast(int, v), 0x141, 0xf, 0xf, true));
    v += __builtin_bit_cast(float, __builtin_amdgcn_update_dpp(0, __builtin_bit_cast(int, v), 0x140, 0xf, 0xf, true));
    return v;
}
__device__ __forceinline__ float wave_sum_dpp(float v) { v = row16_sum(v); v += __shfl_xor(v, 16); v += __shfl_xor(v, 32); return v; }
__device__ __forceinline__ void phase6(const Frame& F, const Args& a) {
    unsigned char* ws = F.ws;
    LAS float* WR = (LAS float*)(F.lds + P6_WR);
    LAS int* cntL = (LAS int*)(F.lds + P6_CNT); LAS int* baseL = cntL + 32;
    LAS int* ent = (LAS int*)(F.lds + P6_ENT);
    const float* w_grp = a.in[17]; const float* b_grp = a.in[18]; const float* w_rtr = a.in[19]; const float* b_rtr = a.in[20];
    {
        f32x4 wv[16], gv2[2];
#pragma unroll
        for (int i = 0; i < 16; ++i) wv[i] = *(const f32x4*)(w_rtr + 4 * (F.tid + NTHR * i));
#pragma unroll
        for (int i = 0; i < 2; ++i) gv2[i] = *(const f32x4*)(w_grp + 4 * (F.tid + NTHR * i));
#pragma unroll
        for (int i = 0; i < 16; ++i) { const int e = 4 * (F.tid + NTHR * i), k = e >> 5, o = e & 31;
#pragma unroll
            for (int c = 0; c < 4; ++c) WR[(4 + o + c) * 1024 + k] = wv[i][c]; }
#pragma unroll
        for (int i = 0; i < 2; ++i) { const int k = F.tid + NTHR * i;
#pragma unroll
            for (int c = 0; c < 4; ++c) WR[c * 1024 + k] = gv2[i][c]; }
    }
    if (F.tid < 65) cntL[F.tid] = 0;
    __syncthreads();
    const bf16* HP = (const bf16*)(ws + WS_H1); bf16* H1B = (bf16*)(ws + WS_H1B);
    const float* lg = a.in[15]; const float* lb = a.in[16];
    f32x2 gam[8], bet[8];
#pragma unroll
    for (int j = 0; j < 2; ++j)
#pragma unroll
        for (int q = 0; q < 4; ++q) { gam[4 * j + q] = *(const f32x2*)(lg + 512 * j + 8 * F.lane + 2 * q); bet[4 * j + q] = *(const f32x2*)(lb + 512 * j + 8 * F.lane + 2 * q); }
    unsigned* gcnt = (unsigned*)(ws + WS_CTL) + CW_CNT;
    int* list = (int*)(ws + WS_LIST); float* tokinfo = (float*)(ws + WS_TOKINFO);
    const int gw = F.bx * NWAVES + F.wave, NGW = F.G * NWAVES;
    u32x4 nx0, nx1;
    const int rpb = (NTOK + F.G - 1) / F.G, rbeg = F.bx * rpb, rend = (rbeg + rpb < NTOK) ? rbeg + rpb : NTOK;
    (void)gw; (void)NGW;
    if (rbeg + F.wave < rend) { const u32x4* hr = (const u32x4*)(HP + (size_t)(rbeg + F.wave) * D) + F.lane; nx0 = hr[0]; nx1 = hr[64]; }
    for (int row = rbeg + F.wave; row < rend; row += NWAVES) {
        const u32x4 r0 = nx0, r1 = nx1;
        if (row + NWAVES < rend) { const u32x4* hr = (const u32x4*)(HP + (size_t)(row + NWAVES) * D) + F.lane; nx0 = hr[0]; nx1 = hr[64]; }
        f32x2 v[8];
        v[0] = (f32x2){bflo(r0.x), bfhi(r0.x)}; v[1] = (f32x2){bflo(r0.y), bfhi(r0.y)}; v[2] = (f32x2){bflo(r0.z), bfhi(r0.z)}; v[3] = (f32x2){bflo(r0.w), bfhi(r0.w)};
        v[4] = (f32x2){bflo(r1.x), bfhi(r1.x)}; v[5] = (f32x2){bflo(r1.y), bfhi(r1.y)}; v[6] = (f32x2){bflo(r1.z), bfhi(r1.z)}; v[7] = (f32x2){bflo(r1.w), bfhi(r1.w)};
        f32x2 s2 = v[0];
#pragma unroll
        for (int q = 1; q < 8; ++q) s2 += v[q];
        const float mean = wave_sum_dpp(s2[0] + s2[1]) * (1.f / D);
        f32x2 q2 = {0.f, 0.f};
#pragma unroll
        for (int q = 0; q < 8; ++q) { v[q] = v[q] - mean; q2 += v[q] * v[q]; }
        const float rstd = 1.0f / sqrtf(wave_sum_dpp(q2[0] + q2[1]) * (1.f / D) + 1e-5f);
#pragma unroll
        for (int q = 0; q < 8; ++q) v[q] = v[q] * rstd * gam[q] + bet[q];
        { u32x4 w0, w1; w0.x = pk2(v[0][0], v[0][1]); w0.y = pk2(v[1][0], v[1][1]); w0.z = pk2(v[2][0], v[2][1]); w0.w = pk2(v[3][0], v[3][1]);
          w1.x = pk2(v[4][0], v[4][1]); w1.y = pk2(v[5][0], v[5][1]); w1.z = pk2(v[6][0], v[6][1]); w1.w = pk2(v[7][0], v[7][1]);
          u32x4* ob = (u32x4*)(H1B + (size_t)row * D) + F.lane; ob[0] = w0; ob[64] = w1; }
        auto rdot = [&](int o) { f32x2 p2 = {0.f, 0.f};
#pragma unroll
            for (int j = 0; j < 2; ++j) { const f32x4 wa = *(const LAS f32x4*)(WR + o * 1024 + 512 * j + 8 * F.lane), wb = *(const LAS f32x4*)(WR + o * 1024 + 512 * j + 8 * F.lane + 4);
                p2 += v[4 * j] * (f32x2){wa[0], wa[1]}; p2 += v[4 * j + 1] * (f32x2){wa[2], wa[3]}; p2 += v[4 * j + 2] * (f32x2){wb[0], wb[1]}; p2 += v[4 * j + 3] * (f32x2){wb[2], wb[3]}; }
            return row16_sum(p2[0] + p2[1]); };
        float g[4];
#pragma unroll
        for (int i = 0; i < 4; ++i) g[i] = rdot(i);
#pragma unroll
        for (int i = 0; i < 4; ++i) { float t = g[i]; t += __shfl_xor(t, 16); t += __shfl_xor(t, 32); g[i] = t + b_grp[i]; }
        int gs = 0; float gm = g[0];
#pragma unroll
        for (int i = 1; i < 4; ++i) if (g[i] > gm) { gm = g[i]; gs = i; }
        gs = __builtin_amdgcn_readfirstlane(gs);
        float gsum = 0.f;
#pragma unroll
        for (int i = 0; i < 4; ++i) gsum += __expf(g[i] - gm);
        const float pgrp = 1.0f / gsum;
        float el[8];
#pragma unroll
        for (int i = 0; i < 8; ++i) el[i] = rdot(4 + gs * 8 + i);
#pragma unroll
        for (int i = 0; i < 8; ++i) { float t = el[i]; t += __shfl_xor(t, 16); t += __shfl_xor(t, 32); el[i] = t + b_rtr[gs * 8 + i]; }
        int i1 = 0; float l1 = el[0];
#pragma unroll
        for (int i = 1; i < 8; ++i) if (el[i] > l1) { l1 = el[i]; i1 = i; }
        int i2 = -1; float l2 = -3.0e38f;
#pragma unroll
        for (int i = 0; i < 8; ++i) if (i != i1 && el[i] > l2) { l2 = el[i]; i2 = i; }
        const float e2 = __expf(l2 - l1), inv = 1.0f / (1.0f + e2);
        const float w0 = pgrp * inv, w1 = pgrp * e2 * inv;
        const int e0 = gs * 8 + i1, e1 = gs * 8 + i2;
        if (F.lane == 0) {
            const int p0 = atomicAdd((int*)&cntL[e0], 1), p1 = atomicAdd((int*)&cntL[e1], 1);
            const int n0 = atomicAdd((int*)&cntL[64], 2);
            ent[2 * n0] = (e0 << 16) | p0; ent[2 * n0 + 1] = row * 2;
            ent[2 * n0 + 2] = (e1 << 16) | p1; ent[2 * n0 + 3] = row * 2 + 1;
            tokinfo[row * 2] = w0; tokinfo[row * 2 + 1] = w1;
        }
    }
    __syncthreads();
    if (F.tid < 32) { const int c = cntL[F.tid]; baseL[F.tid] = c > 0 ? (int)__hip_atomic_fetch_add(gcnt + 64 * F.tid, (unsigned)c, __ATOMIC_RELAXED, __HIP_MEMORY_SCOPE_AGENT) : 0; }
    __syncthreads();
    const int nent = cntL[64];
    for (int i = F.tid; i < nent; i += NTHR) { const int ep = ent[2 * i], tk = ent[2 * i + 1]; const int e = ep >> 16, p = ep & 0xffff; list[(size_t)e * NTOK + baseL[e] + p] = tk; }
    __syncthreads();
}

constexpr int MOE_CUM = 131072;
struct MoeOrder {
    int G, c, NPs, mode; const LAS int* cum; unsigned* dep;
    __device__ __forceinline__ bool unit_of(int L, pg8::Unit& u) const {
        const int t = L >> NPs; if (t >= cum[32]) return false;
        const int e = cum[80 + t];
        const int j = t - cum[e]; u.pm = t; u.pn = L & ((1 << NPs) - 1); u.e = e | (j << 8); const int rem = cum[40 + e] - j * 256; u.nrows = rem < 256 ? rem : 256; return true; }
    static __device__ __forceinline__ void wait_for(const unsigned* w, unsigned need) {
        unsigned sp = 0;
        while (__hip_atomic_load(w, __ATOMIC_RELAXED, __HIP_MEMORY_SCOPE_AGENT) < need && ++sp < (1u << 22)) __builtin_amdgcn_s_sleep(2);
        __builtin_amdgcn_fence(__ATOMIC_ACQUIRE, "agent"); asm volatile("s_waitcnt vmcnt(0)" ::: "memory"); }
    __device__ bool next(int i, pg8::Unit& u) const {
        if (mode != 3) return unit_of(i * G + c, u);
        const int U8 = 2 * cum[32], R8 = U8 >> 8, nr = U8 & 255;
        const int na = R8 << 9, nb = 2 * U8 - na, S = (nr > 0 && R8 >= 2) ? 2 : 0, Jc = c < na ? (na - c + 255) >> 8 : 0;
        int L;
        if (c < nr) { L = c + 256 * (i + S); if (L >= na) return false; }
        else if (i < Jc) L = c + 256 * i;
        else { const int x = (c - nr) + (i - Jc) * (256 - nr); if (x >= S * nr + nb) return false;
            if (x < S * nr) L = x < nr ? x : x - nr + 256;
            else { L = na + (x - S * nr);
                if (__builtin_amdgcn_readfirstlane(threadIdx.x >> 6) == 0) wait_for(dep + 64, (unsigned)nr);
                asm volatile("" ::: "memory"); __builtin_amdgcn_s_barrier(); asm volatile("" ::: "memory"); } }
        return unit_of(L, u);
    }
    __device__ __forceinline__ void done(int ui) const {
        if (mode != 1) return;
        const int R8 = (2 * cum[32]) >> 8;
        if (ui == R8 - 1 || ui == R8) {
            asm volatile("s_waitcnt vmcnt(0)" ::: "memory");
            LAS unsigned* lcnt = (LAS unsigned*)((LAS unsigned char*)cum - MOE_CUM + MISC_OFF + 128);
            unsigned old = 0u;
            if ((threadIdx.x & 63) == 0) old = __hip_atomic_fetch_add(lcnt, 1u, __ATOMIC_RELAXED, __HIP_MEMORY_SCOPE_WORKGROUP);
            old = (unsigned)__builtin_amdgcn_readfirstlane((int)old);
            if ((old & 7u) == 7u) {
                __builtin_amdgcn_fence(__ATOMIC_RELEASE, "agent"); asm volatile("s_waitcnt vmcnt(0)" ::: "memory");
                if ((threadIdx.x & 63) == 0) __hip_atomic_fetch_add(dep + (ui == R8 ? 64 : 0), 1u, __ATOMIC_RELAXED, __HIP_MEMORY_SCOPE_AGENT); } }
    }
};
__device__ __forceinline__ void moe_setup(const Frame& F) {
    LAS int* cum = (LAS int*)(F.lds + MOE_CUM); LAS int* cnt = cum + 40;
    const unsigned* gcnt = (const unsigned*)(F.ws + WS_CTL) + CW_CNT;
    if (F.tid < 32) cnt[F.tid] = (int)__hip_atomic_load(gcnt + 64 * F.tid, __ATOMIC_RELAXED, __HIP_MEMORY_SCOPE_AGENT);
    __syncthreads();
    if (F.tid == 0) { int s = 0; for (int e = 0; e < 32; ++e) { cum[e] = s; s += (cnt[e] + 255) >> 8; } cum[32] = s; }
    __syncthreads();
    for (int t = F.tid; t < cum[32]; t += NTHR) { int e = 0; for (int k = 1; k < 32; ++k) if (t >= cum[k]) e = k; cum[80 + t] = e; }
    __syncthreads();
}
struct AGather { const void* base; unsigned kstep; const int* list;
    static constexpr bool GATHER = true;
    __device__ __forceinline__ const void* unit_ptr(const pg8::Unit&) const { return base; }
    __device__ __forceinline__ unsigned lane_off(int, int) const { return 0u; }
    __device__ __forceinline__ size_t hstep() const { return 0; }
    __device__ __forceinline__ unsigned row_off(const pg8::Unit& u, int r) const { const int e = u.e & 255, j = u.e >> 8; const int rr = r < u.nrows ? r : 0;
        const int tk = list[(size_t)e * NTOK + j * 256 + rr]; return (unsigned)(tk >> 1) * (unsigned)(D * 2); } };
struct BGu { const bf16* W; __device__ __forceinline__ const void* ptr(const pg8::Unit& u) const { return W + (size_t)(u.e & 255) * 512 * 1024 + (size_t)u.pn * 256 * 1024; } };
struct BDn { const bf16* W; __device__ __forceinline__ const void* ptr(const pg8::Unit& u) const { return W + (size_t)(u.e & 255) * 1024 * 256 + (size_t)u.pn * 256 * 256; } };
struct EpiAct {
    static constexpr bool PERM = true; bf16* ACT;
    __device__ __forceinline__ void operator()(const f32x4 (&acc)[2][2][4][2], const pg8::Unit& u, int wr, int wc, int fr, int fq) const {
        const int row0 = u.pm * 256 + wr * 64 + fr, col0 = u.pn * 128 + wc * 32 + 8 * fq;
#pragma unroll
        for (int ai = 0; ai < 2; ++ai)
#pragma unroll
            for (int m = 0; m < 4; ++m) { float o[8];
#pragma unroll
                for (int n = 0; n < 2; ++n)
#pragma unroll
                    for (int j = 0; j < 4; ++j) { const float gt = acc[ai][0][m][n][j], up = acc[ai][1][m][n][j]; o[4 * n + j] = gt * sigmoidf_(gt) * up; }
                u32x4 w; w.x = pk2(o[0], o[1]); w.y = pk2(o[2], o[3]); w.z = pk2(o[4], o[5]); w.w = pk2(o[6], o[7]);
                *(u32x4*)(ACT + (size_t)(row0 + ai * 128 + m * 16) * DEXP + col0) = w; }
    }
};
struct EpiDown {
    static constexpr bool PERM = true; bf16* Y; const int* list;
    __device__ __forceinline__ void operator()(const f32x4 (&acc)[2][2][4][2], const pg8::Unit& u, int wr, int wc, int fr, int fq) const {
        const int e = u.e & 255, j = u.e >> 8; const int col0 = u.pn * 256 + wc * 32 + 8 * fq;
        int tks[2][4];
#pragma unroll
        for (int ai = 0; ai < 2; ++ai)
#pragma unroll
            for (int m = 0; m < 4; ++m) { const int r = ai * 128 + wr * 64 + m * 16 + fr; tks[ai][m] = r < u.nrows ? list[(size_t)e * NTOK + j * 256 + r] : -1; }
#pragma unroll
        for (int ai = 0; ai < 2; ++ai)
#pragma unroll
            for (int m = 0; m < 4; ++m) { const int tk = tks[ai][m];
                if (tk >= 0) { bf16* rowp = Y + (size_t)tk * D + col0;
#pragma unroll
                    for (int bj = 0; bj < 2; ++bj) { const f32x4 v0 = acc[ai][bj][m][0], v1 = acc[ai][bj][m][1];
                        u32x4 w; w.x = pk2(v0[0], v0[1]); w.y = pk2(v0[2], v0[3]); w.z = pk2(v1[0], v1[1]); w.w = pk2(v1[2], v1[3]);
                        *(u32x4*)(rowp + bj * 128) = w; } } }
    }
};

__device__ __forceinline__ void phase9(const Frame& F, const Args& a) {
    unsigned char* ws = F.ws;
    const bf16* H1B = (const bf16*)(ws + WS_H1B); const bf16* Y = (const bf16*)(ws + WS_YBUF); const float* tokinfo = (const float*)(ws + WS_TOKINFO);
    const float* lg = a.in[24]; const float* lb = a.in[25];
    f32x4 gam[4], bet[4];
#pragma unroll
    for (int j = 0; j < 2; ++j) { gam[2 * j] = *(const f32x4*)(lg + 512 * j + 8 * F.lane); gam[2 * j + 1] = *(const f32x4*)(lg + 512 * j + 8 * F.lane + 4); bet[2 * j] = *(const f32x4*)(lb + 512 * j + 8 * F.lane); bet[2 * j + 1] = *(const f32x4*)(lb + 512 * j + 8 * F.lane + 4); }
    const int gw = F.bx * NWAVES + F.wave, NGW = F.G * NWAVES;
    u32x4 nh[2], ny0[2], ny1[2]; float nw0 = 0.f, nw1 = 0.f;
#define P9_LOAD(row_) do { const u32x4* hp_ = (const u32x4*)(H1B + (size_t)(row_) * D) + F.lane; const u32x4* y0_ = (const u32x4*)(Y + (size_t)((row_) * 2) * D) + F.lane; const u32x4* y1_ = (const u32x4*)(Y + (size_t)((row_) * 2 + 1) * D) + F.lane; \
        nh[0] = hp_[0]; nh[1] = hp_[64]; ny0[0] = y0_[0]; ny0[1] = y0_[64]; ny1[0] = y1_[0]; ny1[1] = y1_[64]; nw0 = tokinfo[(row_) * 2]; nw1 = tokinfo[(row_) * 2 + 1]; } while (0)
    if (gw < NTOK) P9_LOAD(gw);
    for (int row = gw; row < NTOK; row += NGW) {
        u32x4 h[2] = {nh[0], nh[1]}, p[2] = {ny0[0], ny0[1]}, q[2] = {ny1[0], ny1[1]}; const float w0 = nw0, w1 = nw1;
        if (row + NGW < NTOK) P9_LOAD(row + NGW);
        f32x4 v[4]; float s = 0.f;
#pragma unroll
        for (int j = 0; j < 2; ++j) {
            v[2 * j][0] = ALPHA * bflo(h[j].x) + w0 * bflo(p[j].x) + w1 * bflo(q[j].x); v[2 * j][1] = ALPHA * bfhi(h[j].x) + w0 * bfhi(p[j].x) + w1 * bfhi(q[j].x);
            v[2 * j][2] = ALPHA * bflo(h[j].y) + w0 * bflo(p[j].y) + w1 * bflo(q[j].y); v[2 * j][3] = ALPHA * bfhi(h[j].y) + w0 * bfhi(p[j].y) + w1 * bfhi(q[j].y);
            v[2 * j + 1][0] = ALPHA * bflo(h[j].z) + w0 * bflo(p[j].z) + w1 * bflo(q[j].z); v[2 * j + 1][1] = ALPHA * bfhi(h[j].z) + w0 * bfhi(p[j].z) + w1 * bfhi(q[j].z);
            v[2 * j + 1][2] = ALPHA * bflo(h[j].w) + w0 * bflo(p[j].w) + w1 * bflo(q[j].w); v[2 * j + 1][3] = ALPHA * bfhi(h[j].w) + w0 * bfhi(p[j].w) + w1 * bfhi(q[j].w); }
#pragma unroll
        for (int j = 0; j < 4; ++j) s += (v[j][0] + v[j][1]) + (v[j][2] + v[j][3]);
        const float mean = wave_sum_dpp(s) * (1.f / D); float s2 = 0.f;
#pragma unroll
        for (int j = 0; j < 4; ++j) { v[j] = v[j] - mean; s2 += (v[j][0] * v[j][0] + v[j][1] * v[j][1]) + (v[j][2] * v[j][2] + v[j][3] * v[j][3]); }
        const float rstd = 1.0f / sqrtf(wave_sum_dpp(s2) * (1.f / D) + 1e-5f);
        float* orow = a.out + (size_t)row * D + 8 * F.lane;
#pragma unroll
        for (int j = 0; j < 2; ++j) { *(f32x4*)(orow + 512 * j) = v[2 * j] * rstd * gam[2 * j] + bet[2 * j]; *(f32x4*)(orow + 512 * j + 4) = v[2 * j + 1] * rstd * gam[2 * j + 1] + bet[2 * j + 1]; }
    }
#undef P9_LOAD
}
#define MFMA32(a, b, c) __builtin_amdgcn_mfma_f32_32x32x16_bf16((a), (b), (c), 0, 0, 0)
__device__ __forceinline__ int crow(int r, int hi) { return (r & 3) + 8 * (r >> 2) + 4 * hi; }
__device__ __forceinline__ float gelu_tanh(float x) { const float u = 0.7978845608028654f * (x + 0.044715f * x * x * x); const float e = __builtin_amdgcn_exp2f(2.885390081777927f * u); return 0.5f * x * (2.0f - 2.0f * __builtin_amdgcn_rcpf(e + 1.0f)); }
constexpr int P2_AROW = 4096 + 16;
constexpr int P2_HID = 32 * P2_AROW;
constexpr int P2_HROW = 512 + 16;
__device__ __forceinline__ void phase2(const Frame& F, const Args& a) {
    unsigned char* ws = F.ws;
    const bf16* ZA = (const bf16*)(ws + WS_ZA);
    { const float* gn = a.in[8]; bf16* CK = (bf16*)(ws + WS_CKVN);
      const int sub = F.lane >> 4, l16 = F.lane & 15;
      float gv[8];
#pragma unroll
      for (int j = 0; j < 8; ++j) gv[j] = gn[l16 * 8 + j];
      const int r4b = F.bx * NWAVES + F.wave, r4s = F.G * NWAVES;
      for (int r4 = r4b; r4 < NTOK / 4; r4 += 4 * r4s) { u32x4 wv[4];
#pragma unroll
          for (int t = 0; t < 4; ++t) { const int rr = r4 + t * r4s; const int row = (rr < NTOK / 4 ? rr : r4) * 4 + sub; wv[t] = *(const u32x4*)(ZA + (size_t)row * ZA_LD + ZC_CKV + l16 * 8); }
#pragma unroll
          for (int t = 0; t < 4; ++t) { const int rr = r4 + t * r4s; if (rr < NTOK / 4) { const int row = rr * 4 + sub; const u32x4 w = wv[t];
              float v[8] = { bflo(w.x), bfhi(w.x), bflo(w.y), bfhi(w.y), bflo(w.z), bfhi(w.z), bflo(w.w), bfhi(w.w) };
              float s2 = 0.f;
#pragma unroll
              for (int j = 0; j < 8; ++j) s2 += v[j] * v[j];
              s2 += __shfl_xor(s2, 1); s2 += __shfl_xor(s2, 2); s2 += __shfl_xor(s2, 4); s2 += __shfl_xor(s2, 8);
              const float rs = 1.0f / sqrtf(s2 * (1.0f / 128.0f) + 1e-6f);
              u32x4 o; o.x = pk2(v[0] * rs * gv[0], v[1] * rs * gv[1]); o.y = pk2(v[2] * rs * gv[2], v[3] * rs * gv[3]); o.z = pk2(v[4] * rs * gv[4], v[5] * rs * gv[5]); o.w = pk2(v[6] * rs * gv[6], v[7] * rs * gv[7]);
              *(u32x4*)(CK + (size_t)row * 128 + l16 * 8) = o; } } } }
    const int r32 = F.lane & 31, hi = F.lane >> 5;
    for (int u = F.bx; u < 256; u += F.G) {
        const int kv = u >> 7, rt = u & 127, R0 = rt * 32;
        const int zc = kv ? ZC_VC : ZC_KC;
        const bf16* W1T = (const bf16*)(ws + (kv ? WS_W1V : WS_W1K)); const bf16* W2T = (const bf16*)(ws + (kv ? WS_W2V : WS_W2K));
        const float* bias = (const float*)(ws + WS_BIASK) + (size_t)kv * 32 * 256;
        bf16* OUT = (bf16*)(ws + (kv ? WS_VCMP : WS_KCMP));
        __syncthreads();
        { u32x4 av[16];
#pragma unroll
          for (int i = 0; i < 16; ++i) { const int q = F.tid + NTHR * i; const int row = q >> 8, cq = q & 255, l = cq >> 3, dch = cq & 7;
              const int R = R0 + row, b = R >> 9, c = (R >> 1) & 255, g = R & 1; const int cc = c < NCMP ? c : NCMP - 1;
              av[i] = *(const u32x4*)(ZA + (size_t)(b * SEQ + 16 * cc + l) * ZA_LD + zc + g * 64 + dch * 8); }
#pragma unroll
          for (int i = 0; i < 16; ++i) { const int q = F.tid + NTHR * i; const int row = q >> 8, cq = q & 255; *(LAS u32x4*)(F.lds + row * P2_AROW + cq * 16) = av[i]; } }
        __syncthreads();
        f32x16 acc = {};
        { const bf16* bp = W1T + (size_t)(32 * F.wave + r32) * 2048 + 8 * hi; const LAS unsigned char* ap = F.lds + r32 * P2_AROW + 16 * hi;
          f32x16 acc1 = {};
#pragma unroll 1
          for (int s0 = 0; s0 < 128; s0 += 32) { bf16x8 bfr[32];
#pragma unroll
              for (int j = 0; j < 32; ++j) bfr[j] = *(const bf16x8*)(bp + (s0 + j) * 16);
#pragma unroll
              for (int j = 0; j < 32; j += 2) { const bf16x8 a0 = *(const LAS bf16x8*)(ap + (s0 + j) * 32), a1 = *(const LAS bf16x8*)(ap + (s0 + j + 1) * 32); acc = MFMA32(a0, bfr[j], acc); acc1 = MFMA32(a1, bfr[j + 1], acc1); } }
#pragma unroll
          for (int i = 0; i < 16; ++i) acc[i] += acc1[i]; }
        { float bs = 0.f;
#pragma unroll 8
          for (int j = 0; j < 32; ++j) bs += bias[j * 256 + 32 * F.wave + r32];
#pragma unroll
          for (int i = 0; i < 16; ++i) { const float h = gelu_tanh(acc[i] + bs); *(LAS unsigned short*)(F.lds + P2_HID + crow(i, hi) * P2_HROW + (32 * F.wave + r32) * 2) = (unsigned short)f2bf(h); } }
        __syncthreads();
        if (F.wave < 2) {
            f32x16 o2 = {};
            const bf16* bp = W2T + (size_t)(32 * F.wave + r32) * 256 + 8 * hi; const LAS unsigned char* ap = F.lds + P2_HID + r32 * P2_HROW + 16 * hi;
#pragma unroll
            for (int s = 0; s < 16; ++s) { const bf16x8 af = *(const LAS bf16x8*)(ap + s * 32); const bf16x8 bfr = *(const bf16x8*)(bp + s * 16); o2 = MFMA32(af, bfr, o2); }
#pragma unroll
            for (int i = 0; i < 16; ++i) OUT[(size_t)(R0 + crow(i, hi)) * 64 + 32 * F.wave + r32] = (bf16)f2bf(o2[i]);
        }
    }
    __syncthreads();
}

typedef short v4i16_t __attribute__((ext_vector_type(4)));
__device__ __forceinline__ s16x4 vtr(const LAS unsigned char* p) { return __builtin_bit_cast(s16x4, __builtin_amdgcn_ds_read_tr16_b64_v4i16((LAS v4i16_t*)p)); }
constexpr int NSA_K = 0;
constexpr int NSA_V = 16384;
constexpr int NSA_TB = 49152;
constexpr int NSA_TBP = 1032;
constexpr int NSA_SC = 65792;
constexpr int NSA_MSK = 82176;
constexpr int NSA_OF = 84224;
constexpr float C2 = 0.125f * LOG2E;

__device__ __forceinline__ int prefix_cnt(unsigned long long b) { return (int)__builtin_amdgcn_mbcnt_hi((unsigned)(b >> 32), __builtin_amdgcn_mbcnt_lo((unsigned)b, 0u)); }
__device__ __forceinline__ int sbcnt64(unsigned long long m) { int n; asm("s_bcnt1_i32_b64 %0, %1" : "=s"(n) : "s"(m) : "scc"); return n; }
__device__ __forceinline__ float halfmax(float v, int xaddr) { return fmaxf(v, __builtin_bit_cast(float, __builtin_amdgcn_ds_bpermute(xaddr, __builtin_bit_cast(int, v)))); }
__device__ __forceinline__ void nsa_tile(const bool nc4, const LAS unsigned char* Kb, const LAS unsigned char* Vb, const LAS float* tbh, const bf16x8 (&qr)[4], f32x16 (&o)[4], float& m, float& l,
                                         int kt, int tq, int kmul, int kadd, int dmax, bool selbit, int mode, float b31, int r32, int hi, int lane, int xaddr) {
    const int tqa = tq - kadd, qk = kmul == 16 ? (tqa >> 4) : tqa, rem = kmul == 16 ? (tqa & 15) : 0;
    const int ebase = qk - (kt * 64 + 4 * hi);
    const LAS unsigned char* vp0 = Vb + ((lane >> 4) & 1) * 32 + (lane & 3) * 8 + (4 * hi + ((lane & 15) >> 2)) * 64;
    bf16x8 kf[2][4];
#pragma unroll
    for (int hf = 0; hf < 2; ++hf)
#pragma unroll
        for (int d0 = 0; d0 < 4; ++d0) kf[hf][d0] = *(const LAS bf16x8*)(Kb + (2 * d0 + hi) * 1024 + (r32 + 32 * hf) * 16);
#pragma unroll
    for (int hf = 0; hf < 2; ++hf) {
        f32x16 s0 = {};
#pragma unroll
        for (int d0 = 0; d0 < 4; ++d0) asm volatile("" : "+v"(kf[hf][d0]));
#pragma unroll
        for (int d0 = 0; d0 < 4; ++d0) s0 = MFMA32(kf[hf][d0], qr[d0], s0);
        s16x4 vfl[4][2], vfh[4][2];
#pragma unroll
        for (int c = 0; c < 4; ++c) if (c < 2 || nc4)
#pragma unroll
            for (int s2 = 0; s2 < 2; ++s2) { const int s = 2 * hf + s2; vfl[c][s2] = vtr(vp0 + c * 4096 + s * 1024); vfh[c][s2] = vtr(vp0 + c * 4096 + s * 1024 + 512); }
        float tmax, mn, ps = 0.f;
        if (mode == 2) {
            float a0 = fmaxf(fmaxf(s0[0], s0[1]), s0[2]), a1 = fmaxf(fmaxf(s0[3], s0[4]), s0[5]);
            a0 = fmaxf(fmaxf(a0, s0[6]), s0[7]); a1 = fmaxf(fmaxf(a1, s0[8]), s0[9]); a0 = fmaxf(fmaxf(a0, s0[10]), s0[11]); a1 = fmaxf(fmaxf(a1, s0[12]), s0[13]); a0 = fmaxf(fmaxf(a0, s0[14]), s0[15]);
            const float cb = selbit ? b31 : NEGBIG;
            tmax = fmaxf(a0, a1) * C2 + cb;
            tmax = halfmax(tmax, xaddr);
            mn = fmaxf(m, tmax);
            const float cc = cb - mn;
#pragma unroll
            for (int r = 0; r < 16; ++r) { const float p0 = __builtin_amdgcn_exp2f(s0[r] * C2 + cc); s0[r] = p0; ps += p0; }
        } else if (mode == 1) {
            int eb1 = ebase; asm volatile("" : "+v"(eb1));
            const LAS float* tb1 = tbh + (eb1 - 96);
            float bv[16];
#pragma unroll
            for (int r = 0; r < 16; ++r) bv[r] = tb1[96 - ((r & 3) + 8 * (r >> 2) + 32 * hf)];
#pragma unroll
            for (int r = 0; r < 16; ++r) asm volatile("" : "+v"(bv[r]));
            tmax = NEGBIG;
#pragma unroll
            for (int r = 0; r < 16; ++r) { const float x = s0[r] * C2 + bv[r]; s0[r] = x; tmax = fmaxf(tmax, x); }
            tmax = selbit ? tmax : NEGBIG;
            tmax = halfmax(tmax, xaddr);
            mn = fmaxf(m, tmax);
            const float mne = selbit ? mn : 1e30f;
#pragma unroll
            for (int r = 0; r < 16; ++r) { const float p0 = __builtin_amdgcn_exp2f(s0[r] - mne); s0[r] = p0; ps += p0; }
        } else if (mode == 3) {
            int eb1 = ebase; asm volatile("" : "+v"(eb1));
            const LAS float* tb1 = tbh + (eb1 - 96);
            float bv[16];
#pragma unroll
            for (int r = 0; r < 16; ++r) bv[r] = tb1[96 - ((r & 3) + 8 * (r >> 2) + 32 * hf)];
#pragma unroll
            for (int r = 0; r < 16; ++r) asm volatile("" : "+v"(bv[r]));
            tmax = NEGBIG;
#pragma unroll
            for (int r = 0; r < 16; ++r) { const bool valid = (unsigned)(eb1 - ((r & 3) + 8 * (r >> 2) + 32 * hf)) < (unsigned)dmax;
                const float x = valid ? s0[r] * C2 + bv[r] : NEGBIG; s0[r] = x; tmax = fmaxf(tmax, x); }
            tmax = selbit ? tmax : NEGBIG;
            tmax = halfmax(tmax, xaddr);
            mn = fmaxf(m, tmax);
            const float mne = (selbit && mn > -1e29f) ? mn : 1e30f;
#pragma unroll
            for (int r = 0; r < 16; ++r) { const float p0 = __builtin_amdgcn_exp2f(s0[r] - mne); s0[r] = p0; ps += p0; }
        } else {
            tmax = NEGBIG;
            float bv[16];
            int eb0 = ebase; asm volatile("" : "+v"(eb0));
#pragma unroll
            for (int r = 0; r < 16; ++r) { const int dist = __mul24(eb0 - ((r & 3) + 8 * (r >> 2) + 32 * hf), kmul) + rem; int dc = dist < 0 ? 0 : dist; dc = dc > 1023 ? 1023 : dc; bv[r] = tbh[dc]; }
#pragma unroll
            for (int r = 0; r < 16; ++r) asm volatile("" : "+v"(bv[r]));
#pragma unroll
            for (int r = 0; r < 16; ++r) { const int dist = __mul24(eb0 - ((r & 3) + 8 * (r >> 2) + 32 * hf), kmul) + rem;
                const bool valid = selbit && dist >= 0 && dist < dmax;
                const float x = valid ? s0[r] * C2 + bv[r] : NEGBIG;
                s0[r] = x; tmax = fmaxf(tmax, x); }
            tmax = halfmax(tmax, xaddr);
            mn = fmaxf(m, tmax);
#pragma unroll
            for (int r = 0; r < 16; ++r) { const float p0 = s0[r] > -1e29f ? __builtin_amdgcn_exp2f(s0[r] - mn) : 0.f; s0[r] = p0; ps += p0; }
        }
        if (__any(mn != m)) {
            const float alpha = __builtin_amdgcn_exp2f(m - mn);
            l *= alpha;
#pragma unroll
            for (int c = 0; c < 4; ++c) if (c < 2 || nc4) {
#pragma unroll
                for (int r = 0; r < 16; ++r) o[c][r] *= alpha; }
        }
        m = mn;
        l += ps;
        u32x4 pw[2];
#pragma unroll
        for (int q = 0; q < 4; ++q) { pw[0][q] = pk2(s0[2 * q], s0[2 * q + 1]); pw[1][q] = pk2(s0[8 + 2 * q], s0[8 + 2 * q + 1]); }
#pragma unroll
        for (int c = 0; c < 4; ++c) if (c < 2 || nc4)
#pragma unroll
            for (int s2 = 0; s2 < 2; ++s2) { const s16x4 vl = vfl[c][s2], vh = vfh[c][s2];
                const bf16x8 vf = {vl[0], vl[1], vl[2], vl[3], vh[0], vh[1], vh[2], vh[3]};
                o[c] = MFMA32(vf, __builtin_bit_cast(bf16x8, pw[s2]), o[c]); }
    }
}

__device__ __forceinline__ void nsa_unit(const Frame& F, int b, int g, int qt) {
    unsigned char* ws = F.ws;
    const bf16* ZA = (const bf16*)(ws + WS_ZA);
    const int r32 = F.lane & 31, hi = F.lane >> 5, qi = r32 >> 2, hh = r32 & 3, head = g * 4 + hh;
    const int q0 = qt * 64, tq = q0 + 8 * F.wave + qi;
    const size_t zrow = (size_t)(b * SEQ + tq) * ZA_LD;
    const int srow = F.tid >> 3, sch = F.tid & 7;
    const f32x4* TBA4 = (const f32x4*)((const float*)(ws + WS_TBA) + (size_t)g * 4 * 1024);
    const f32x4 tbv0 = TBA4[F.tid], tbv1 = TBA4[F.tid + NTHR];
    const LAS float* tbh = (const LAS float*)(F.lds + NSA_TB) + hh * NSA_TBP;
    const int wq0 = q0 + 8 * F.wave;
    const float b31 = ((const float*)(ws + WS_TBA))[(size_t)head * 1024 + 1023];
    bf16x8 qr[4];
#pragma unroll
    for (int d0 = 0; d0 < 4; ++d0) qr[d0] = *(const bf16x8*)(ZA + zrow + ZC_QA + head * 64 + d0 * 16 + hi * 8);
    unsigned short graw[3];
#pragma unroll
    for (int i = 0; i < 3; ++i) graw[i] = ZA[zrow + ZC_GNSA + head * 3 + i];
    { LAS f32x4* tb4 = (LAS f32x4*)(F.lds + NSA_TB) + (F.tid >> 8) * (NSA_TBP / 4) + (F.tid & 255); tb4[0] = tbv0; tb4[2 * (NSA_TBP / 4)] = tbv1; }
    float gate[3];
#pragma unroll
    for (int i = 0; i < 3; ++i) gate[i] = sigmoidf_(bf2f(graw[i]));
    LAS float* ofw = (LAS float*)(F.lds + NSA_OF) + F.wave * 2048 + F.lane;
    unsigned mlo = 0u, mhi = 0u;
    const int xaddr = (F.lane ^ 32) << 2;
    u32x4 kreg, vreg = {0u, 0u, 0u, 0u};
    const bf16* kgp; size_t vdel, tstep;
#define NSA_SETUP(br_) do { const int b_ = (br_); const bf16* Kg_; size_t pitch_; int tl_; \
        if (b_ == 0) { Kg_ = (const bf16*)(ws + WS_KCMP) + (size_t)(b * 256) * 128 + g * 64; vdel = (size_t)((const bf16*)(ws + WS_VCMP) - (const bf16*)(ws + WS_KCMP)); pitch_ = 128; tl_ = 0; } \
        else { Kg_ = ZA + (size_t)(b * SEQ) * ZA_LD + (b_ == 1 ? ZC_KS : ZC_KW) + g * 64; vdel = 128; pitch_ = ZA_LD; tl_ = (b_ == 2 && qt > 8) ? qt - 8 : 0; } \
        kgp = Kg_ + (size_t)(tl_ * 64 + srow) * pitch_ + sch * 8; tstep = (size_t)64 * pitch_; } while (0)
#define NSA_GLOAD(kt_) do { kreg = *(const u32x4*)kgp; vreg = *(const u32x4*)(kgp + vdel); kgp += tstep; } while (0)
    NSA_SETUP(0); NSA_GLOAD(0);
#pragma nounroll
    for (int br = 0; br < 3; ++br) {
        const bool iscmp = br == 0;
        const int t_lo = iscmp ? 0 : ((br == 2 && qt > 8) ? qt - 8 : 0), t_hi = iscmp ? ((q0 + 32) >> 10) : qt;
        const int kmul = iscmp ? 16 : 1, kadd = iscmp ? 31 : 0, dmax = br == 2 ? 512 : 0x40000000;
        f32x16 o[4]; o[0] = f32x16{}; o[1] = f32x16{}; o[2] = f32x16{}; o[3] = f32x16{};
        float m = NEGBIG, l = 0.f;
#define NSA_LSTORE(kt_, buf_) do { \
        *(LAS u32x4*)(F.lds + NSA_K + (buf_) * 8192 + sch * 1024 + srow * 16) = kreg; \
        *(LAS u32x4*)(F.lds + NSA_V + (buf_) * 16384 + (sch >> 2) * 4096 + srow * 64 + (sch & 3) * 16) = vreg; \
        if (iscmp) { const int c_ = (kt_) * 64 + srow, jj_ = c_ >> 2, mm_ = c_ & 3; u32x4 mv_; \
            _Pragma("unroll") for (int i_ = 0; i_ < 4; ++i_) { const int j0_ = sch * 8 + 2 * i_, j1_ = j0_ + 1; \
                const unsigned e0_ = (c_ < NCMP) ? (mm_ < 3 ? (j0_ == jj_ ? 0x4000u : 0u) : ((j0_ == jj_ || j0_ == jj_ + 1) ? 0x3F80u : 0u)) : 0u; \
                const unsigned e1_ = (c_ < NCMP) ? (mm_ < 3 ? (j1_ == jj_ ? 0x4000u : 0u) : ((j1_ == jj_ || j1_ == jj_ + 1) ? 0x3F80u : 0u)) : 0u; \
                mv_[i_] = e0_ | (e1_ << 16); } \
            *(LAS u32x4*)(F.lds + NSA_V + (buf_) * 16384 + (2 + (sch >> 2)) * 4096 + srow * 64 + (sch & 3) * 16) = mv_; } } while (0)
        NSA_LSTORE(t_lo, 0);
        __syncthreads();
        int buf = 0;
#pragma nounroll
        for (int kt = t_lo; kt <= t_hi; ++kt) {
            const int ktn = kt + 1; const bool more = kt < t_hi;
            if (more) NSA_GLOAD(ktn);
            const bool selbit = br == 1 ? (((kt < 32 ? (mlo >> kt) : (mhi >> (kt - 32))) & 1u) != 0u) : true;
            int mode = 0;
            { const int dmin = wq0 - (64 * kt + 63), dmx = wq0 + 7 - 64 * kt;
              if (br == 1) mode = dmin >= 790 ? 2 : (dmin >= 0 ? 1 : 3);
              if (br == 0) mode = 16 * (((wq0 - 31) >> 4) - (64 * kt + 63)) >= 790 ? 2 : 0;
              if (br == 2) mode = (dmin >= 0 && dmx <= 511) ? 1 : 3; }
            if (__any(selbit))
                nsa_tile(iscmp, F.lds + NSA_K + buf * 8192, F.lds + NSA_V + buf * 16384, tbh, qr, o, m, l, kt, tq, kmul, kadd, dmax, selbit, mode, b31, r32, hi, F.lane, xaddr);
            if (more) NSA_LSTORE(ktn, buf ^ 1);
            __syncthreads();
            buf ^= 1;
        }
#undef NSA_LSTORE
        if (br < 2) { NSA_SETUP(br + 1); NSA_GLOAD(0); }
        l += __shfl_xor(l, 32);
        const float inv = l > 0.f ? 1.0f / l : 0.f;
        { const float sc = inv * (br == 0 ? gate[0] : br == 1 ? gate[1] : gate[2]);
#pragma unroll
            for (int c = 0; c < 2; ++c)
#pragma unroll
                for (int r = 0; r < 16; ++r) { const float prev = br == 0 ? 0.f : ofw[(c * 16 + r) * 64]; ofw[(c * 16 + r) * 64] = prev + o[c][r] * sc; } }
        if (iscmp) {
            LAS float* scw = (LAS float*)(F.lds + NSA_SC) + F.wave * 512;
#pragma unroll
            for (int c = 0; c < 2; ++c)
#pragma unroll
                for (int r = 0; r < 16; ++r) { float v = o[2 + c][r] * inv;
                    v += __builtin_bit_cast(float, __builtin_amdgcn_update_dpp(0, __builtin_bit_cast(int, v), 0xB1, 0xf, 0xf, true));
                    v += __builtin_bit_cast(float, __builtin_amdgcn_update_dpp(0, __builtin_bit_cast(int, v), 0x4E, 0xf, 0xf, true));
                    if (hh == 0) scw[qi * 64 + 32 * c + crow(r, hi)] = v; }
            LDS_WAIT();
            LAS unsigned* mskw = (LAS unsigned*)(F.lds + NSA_MSK) + F.wave * 16;
#pragma nounroll
            for (int q = 0; q < 8; q += 2) {
                unsigned key[2]; bool av[2];
#pragma unroll
                for (int u = 0; u < 2; ++u) { const int curq = (q0 + 8 * F.wave + q + u) >> 6, j = F.lane;
                    av[u] = j <= curq; const bool forced = (j == 0) || (j == curq) || (j == curq - 1);
                    const float sj = scw[(q + u) * 64 + j] + (forced ? 1e4f : 0.f);
                    key[u] = av[u] ? __builtin_bit_cast(unsigned, sj + 0.0f) + 1u : 0u; }
                unsigned T0 = 0u, T1 = 0u;
#pragma unroll
                for (int bit = 30; bit >= 0; --bit) { const unsigned c0 = T0 | (1u << bit), c1 = T1 | (1u << bit);
                    const int n0 = sbcnt64(__ballot(key[0] >= c0)), n1 = sbcnt64(__ballot(key[1] >= c1));
                    T0 = n0 >= 16 ? c0 : T0; T1 = n1 >= 16 ? c1 : T1; }
#pragma unroll
                for (int u = 0; u < 2; ++u) { const unsigned T = u ? T1 : T0;
                    const bool gt = key[u] > T, eq = key[u] == T;
                    const int need = 16 - sbcnt64(__ballot(gt));
                    const bool sel = (gt || (eq && prefix_cnt(__ballot(eq)) < need)) && av[u];
                    const unsigned long long bm = __ballot(sel);
                    if (F.lane == 0) { mskw[2 * (q + u)] = (unsigned)bm; mskw[2 * (q + u) + 1] = (unsigned)(bm >> 32); } } }
            LDS_WAIT();
            mlo = mskw[2 * qi]; mhi = mskw[2 * qi + 1];
        }
    }
#undef NSA_GLOAD
#undef NSA_SETUP
    bf16* OA = (bf16*)(ws + WS_OA) + (size_t)(b * SEQ + tq) * 512 + head * 64;
#pragma unroll
    for (int c = 0; c < 2; ++c)
#pragma unroll
        for (int r4 = 0; r4 < 4; ++r4) { u32x2 w; w.x = pk2(ofw[(c * 16 + 4 * r4) * 64], ofw[(c * 16 + 4 * r4 + 1) * 64]); w.y = pk2(ofw[(c * 16 + 4 * r4 + 2) * 64], ofw[(c * 16 + 4 * r4 + 3) * 64]);
            *(u32x2*)(OA + 32 * c + 8 * r4 + 4 * hi) = w; }
}
__device__ __forceinline__ void phase3(const Frame& F) {
    const bool xcd = (F.G == 256);
    const int pstart = xcd ? (F.bx >> 3) : F.bx, pstep = xcd ? 32 : F.G, pend = xcd ? 64 : 512;
#pragma nounroll
    for (int p2 = 2 * pstart; p2 < 2 * pend; p2 += (p2 & 1) ? 2 * pstep - 1 : 1) { const int p = p2 >> 1;
        const int b = xcd ? (F.bx & 7) : (p >> 6), g = (p >> 5) & 1, qt = p & 31;
        nsa_unit(F, b, g, (p2 & 1) ? qt : 63 - qt); }
    __syncthreads();
}

#define MFMA16(a, b, c) __builtin_amdgcn_mfma_f32_16x16x32_bf16((a), (b), (c), 0, 0, 0)
constexpr int DSA_SCP = 8200;
constexpr int DSA_SC = 0;
constexpr int DSA_LIST = 16 * DSA_SCP;
constexpr int DSA_NSEL = DSA_LIST + 8192;
constexpr int DSA_BIAS = DSA_NSEL + 64;
constexpr int DSA_HIST = DSA_BIAS + 1088;
constexpr int DSA_BKI = DSA_HIST + 8192;
constexpr int KSEL = 256;
__device__ __forceinline__ unsigned dsa_offb(unsigned row, unsigned ch) { return 256u * row + 16u * (ch ^ (((row & 3u) << 2) | ((row >> 2) & 3u))); }
__device__ __forceinline__ unsigned sortkey16(float x) { x = x + 0.0f; const unsigned short h = __builtin_bit_cast(unsigned short, (_Float16)x); return (h & 0x8000u) ? (unsigned)(unsigned short)~h : (unsigned)(h | 0x8000u); }

__device__ __forceinline__ void dsa_unit(const Frame& F, const Args& a, int b, int qt16) {
    unsigned char* ws = F.ws;
    const bf16* ZA = (const bf16*)(ws + WS_ZA);
    const int lane = F.lane, l16 = lane & 15, quad = lane >> 4, q0 = qt16 * 16;
    __syncthreads();
#ifndef PROBE_DSA
#define PROBE_DSA 0
#endif
    for (int rep1_ = 0; rep1_ < (PROBE_DSA == 1 ? 2 : 1); ++rep1_) {
        const size_t qrow = (size_t)(b * SEQ + q0 + l16) * ZA_LD;
        bf16x8 qf[4][2];
#pragma unroll
        for (int i = 0; i < 4; ++i)
#pragma unroll
            for (int ks = 0; ks < 2; ++ks) qf[i][ks] = *(const bf16x8*)(ZA + qrow + ZC_QIDX + i * 64 + 32 * ks + 8 * quad);
        float wq[4];
#pragma unroll
        for (int i = 0; i < 4; ++i) wq[i] = bf2f(ZA[qrow + ZC_WIDX + i]) * 0.0625f;
        const int tq = q0 + l16, nkt = qt16 + 1;
        const bf16* kbase = ZA + (size_t)(b * SEQ + l16) * ZA_LD + ZC_KIDX + 8 * quad;
        bf16x8 ka[4][2], kn[4][2];
#define DSA_KLOAD(dst, kt0_) do { _Pragma("unroll") for (int t_ = 0; t_ < 4; ++t_) { const int k_ = (kt0_) + 8 * t_; const int kc_ = k_ < nkt ? k_ : nkt - 1; \
            dst[t_][0] = *(const bf16x8*)(kbase + (size_t)(kc_ * 16) * ZA_LD); dst[t_][1] = *(const bf16x8*)(kbase + (size_t)(kc_ * 16) * ZA_LD + 32); } } while (0)
        if (F.wave < nkt) DSA_KLOAD(ka, F.wave);
#pragma nounroll
        for (int kt0 = F.wave; kt0 < nkt; kt0 += 32) {
            if (kt0 + 32 < nkt) DSA_KLOAD(kn, kt0 + 32);
#pragma unroll
            for (int t = 0; t < 4; ++t) { const int kt = kt0 + 8 * t;
                if (kt < nkt) {
                    float idx[4] = {0.f, 0.f, 0.f, 0.f};
#pragma unroll
                    for (int i = 0; i < 4; ++i) { f32x4 acc = {0.f, 0.f, 0.f, 0.f}; acc = MFMA16(ka[t][0], qf[i][0], acc); acc = MFMA16(ka[t][1], qf[i][1], acc);
#pragma unroll
                        for (int r = 0; r < 4; ++r) idx[r] += fmaxf(acc[r], 0.f) * wq[i]; }
                    unsigned k16[4];
#pragma unroll
                    for (int r = 0; r < 4; ++r) { const int key = kt * 16 + 4 * quad + r; k16[r] = key <= tq ? sortkey16(idx[r]) : 0u; }
                    u32x2 w; w.x = k16[0] | (k16[1] << 16); w.y = k16[2] | (k16[3] << 16);
                    *(LAS u32x2*)(F.lds + DSA_SC + l16 * DSA_SCP + (kt * 16 + 4 * quad) * 2) = w; } }
#pragma unroll
            for (int t = 0; t < 4; ++t) { ka[t][0] = kn[t][0]; ka[t][1] = kn[t][1]; }
        }
#undef DSA_KLOAD
    }
    if (F.tid < 264) { const float* rb = a.in[11]; ((LAS float*)(F.lds + DSA_BIAS))[F.tid] = F.tid < 256 ? rb[(F.tid >> 3) * 16 + 8 + (F.tid & 7)] * LOG2E : NEGBIG; }
    __syncthreads();
    bf16x8 ql[2][4];
#pragma unroll
    for (int qq = 0; qq < 2; ++qq)
#pragma unroll
        for (int s2 = 0; s2 < 4; ++s2) { const bf16x8 v = *(const bf16x8*)(ZA + (size_t)(b * SEQ + q0 + 2 * F.wave + qq) * ZA_LD + ZC_QLAT + (l16 & 7) * 128 + 32 * s2 + 8 * quad); ql[qq][s2] = l16 < 8 ? v : (bf16x8){0, 0, 0, 0, 0, 0, 0, 0}; }
#pragma nounroll
    for (int qq = 0; qq < (PROBE_DSA == 2 ? 4 : 2); ++qq) {
        const int n = 2 * F.wave + (qq & 1), tq = q0 + n, N = tq + 1;
        LAS unsigned char* scq = F.lds + DSA_SC + n * DSA_SCP;
        LAS unsigned short* lst = (LAS unsigned short*)(F.lds + DSA_LIST) + n * 256;
        LAS unsigned short* bki = (LAS unsigned short*)(F.lds + DSA_BKI) + n * 256;
        if (N <= KSEL) {
            for (int s = lane; s < KSEL; s += 64) lst[s] = (unsigned short)(s < N ? s : 0);
            if (lane == 0) ((LAS int*)(F.lds + DSA_NSEL))[n] = N;
        } else {
            const int nit = (N + 255) >> 8;
            { const int it = nit - 1; const int s0 = 4 * (lane + 64 * it); u32x2 w = *(LAS u32x2*)(scq + s0 * 2);
              if (s0 + 0 > tq) w.x &= 0xffff0000u; if (s0 + 1 > tq) w.x &= 0x0000ffffu; if (s0 + 2 > tq) w.y &= 0xffff0000u; if (s0 + 3 > tq) w.y &= 0x0000ffffu;
              *(LAS u32x2*)(scq + s0 * 2) = w; }
            LDS_WAIT();
            LAS unsigned* hist = (LAS unsigned*)(F.lds + DSA_HIST) + F.wave * 256;
            unsigned T = 0u; int cgt = 0; int need = KSEL;
#pragma nounroll
            for (int lvl = 0; lvl < 2; ++lvl) {
                *(LAS u32x4*)(hist + 4 * lane) = (u32x4){0u, 0u, 0u, 0u};
                LDS_WAIT();
#pragma nounroll
                for (int it = 0; it < nit; ++it) { const u32x2 w = *(LAS u32x2*)(scq + (lane + 64 * it) * 8);
                    const unsigned k[4] = {w.x & 0xffffu, w.x >> 16, w.y & 0xffffu, w.y >> 16};
#pragma unroll
                    for (int e = 0; e < 4; ++e) { const bool in = lvl == 0 ? true : (k[e] >> 8) == (T >> 8); const unsigned bin = lvl == 0 ? (k[e] >> 8) : (k[e] & 255u);
                        if (in) __hip_atomic_fetch_add(hist + bin, 1u, __ATOMIC_RELAXED, __HIP_MEMORY_SCOPE_WORKGROUP); } }
                LDS_WAIT();
                const u32x4 h = *(LAS u32x4*)(hist + 4 * lane);
                const int sl = (int)(h.x + h.y + h.z + h.w); int suf = sl;
#pragma unroll
                for (int d = 1; d < 64; d <<= 1) { const int o = __shfl_down(suf, d); suf += (lane + d < 64) ? o : 0; }
                const int above = suf - sl;
                const bool here = above < need && above + sl >= need;
                int bsel = 4 * lane + 3, ca = above;
                if (ca + (int)h.w < need) { ca += (int)h.w; bsel = 4 * lane + 2; if (ca + (int)h.z < need) { ca += (int)h.z; bsel = 4 * lane + 1; if (ca + (int)h.y < need) { ca += (int)h.y; bsel = 4 * lane; } } }
                const unsigned long long bm = __ballot(here);
                const int src = bm ? (int)__builtin_ctzll(bm) : 0;
                const int B = __shfl(bsel, src), CA = __shfl(ca, src);
                if (lvl == 0) T = (unsigned)B << 8; else T |= (unsigned)B;
                cgt += CA; need -= CA;
                LDS_WAIT();
            }
            const int rties = KSEL - cgt;
            int tiebase = 0, outbase = 0;
#define DSA_PUT(pos_, idx_) do { const int p_ = (pos_); if (p_ >= 0 && p_ < KSEL) lst[p_] = (unsigned short)(idx_); } while (0)
#pragma nounroll
            for (int it = 0; it < nit; ++it) { const u32x2 w = *(LAS u32x2*)(scq + (lane + 64 * it) * 8);
                const unsigned k0 = w.x & 0xffffu, k1 = w.x >> 16, k2 = w.y & 0xffffu, k3 = w.y >> 16;
                const int sidx = 4 * (lane + 64 * it);
                const bool g0 = k0 > T, g1 = k1 > T, g2 = k2 > T, g3 = k3 > T;
                const unsigned long long bg0 = __ballot(g0), bg1 = __ballot(g1), bg2 = __ballot(g2), bg3 = __ballot(g3);
                if (bg0 | bg1 | bg2 | bg3) {
                    int pos = outbase + prefix_cnt(bg0) + prefix_cnt(bg1) + prefix_cnt(bg2) + prefix_cnt(bg3);
                    if (g0) { DSA_PUT(pos, sidx + 0); ++pos; }
                    if (g1) { DSA_PUT(pos, sidx + 1); ++pos; }
                    if (g2) { DSA_PUT(pos, sidx + 2); ++pos; }
                    if (g3) { DSA_PUT(pos, sidx + 3); ++pos; }
                    outbase += __popcll(bg0) + __popcll(bg1) + __popcll(bg2) + __popcll(bg3); }
                const bool e0 = k0 == T, e1 = k1 == T, e2 = k2 == T, e3 = k3 == T;
                const unsigned long long be0 = __ballot(e0), be1 = __ballot(e1), be2 = __ballot(e2), be3 = __ballot(e3);
                if ((be0 | be1 | be2 | be3) && tiebase < rties) {
                    const int t0 = tiebase + prefix_cnt(be0) + prefix_cnt(be1) + prefix_cnt(be2) + prefix_cnt(be3), t1 = t0 + (e0 ? 1 : 0), t2 = t1 + (e1 ? 1 : 0), t3 = t2 + (e2 ? 1 : 0);
                    if (e0 && t0 < rties) DSA_PUT(KSEL - 1 - t0, sidx + 0);
                    if (e1 && t1 < rties) DSA_PUT(KSEL - 1 - t1, sidx + 1);
                    if (e2 && t2 < rties) DSA_PUT(KSEL - 1 - t2, sidx + 2);
                    if (e3 && t3 < rties) DSA_PUT(KSEL - 1 - t3, sidx + 3);
                    tiebase += __popcll(be0) + __popcll(be1) + __popcll(be2) + __popcll(be3); } }
#undef DSA_PUT
            outbase = KSEL;
            if (lane == 0) ((LAS int*)(F.lds + DSA_NSEL))[n] = outbase < KSEL ? outbase : KSEL;
        }
        LDS_WAIT();
        { const int nsl = N < KSEL ? N : KSEL;
#pragma unroll
          for (int i = 0; i < 4; ++i) { const int e = lane + 64 * i; const int dist = tq - (int)lst[e];
              const int dpos = dist < 1 ? 1 : dist; int bl = 16 + (int)((__log2f((float)dpos) - 4.0f) * 2.66666675f); bl = bl > 31 ? 31 : bl;
              const int bk = dist < 1 ? 0 : (dpos < 16 ? dpos : bl);
              bki[e] = (unsigned short)(e < nsl ? bk * 32 : 1024); } }
    }
    LDS_WAIT();
    const bf16* CK = (const bf16*)(ws + WS_CKVN) + (size_t)(b * SEQ) * 128;
    LAS unsigned char* gb0 = F.lds + DSA_SC + (2 * F.wave) * DSA_SCP;
    const LAS unsigned char* biasb = F.lds + DSA_BIAS + (l16 & 7) * 4;
#define DSA_GATHER(chunk_, buf_) do { const unsigned key_ = lst[(chunk_) * 32 + (lane >> 1)]; const char* src_ = (const char*)CK + (key_ * 256u + (unsigned)(lane & 1) * 16u); \
        _Pragma("unroll") for (int c_ = 0; c_ < 8; ++c_) __builtin_amdgcn_global_load_lds((const unsigned*)(src_ + c_ * 32), (LAS unsigned*)(gb0 + (buf_) * 8192 + c_ * 1024), 16, 0, 0); } while (0)
    int tqs[2], nsels[2]; const LAS unsigned short* lsts[2]; const LAS unsigned short* bkis[2]; f32x4 o[2][8]; float ms[2], ls[2];
#pragma unroll
    for (int qq = 0; qq < 2; ++qq) { const int n = 2 * F.wave + qq; tqs[qq] = q0 + n; nsels[qq] = ((const LAS int*)(F.lds + DSA_NSEL))[n]; lsts[qq] = (const LAS unsigned short*)(F.lds + DSA_LIST) + n * 256; bkis[qq] = (const LAS unsigned short*)(F.lds + DSA_BKI) + n * 256;
#pragma unroll
        for (int c = 0; c < 8; ++c) o[qq][c] = (f32x4){0.f, 0.f, 0.f, 0.f};
        ms[qq] = NEGBIG; ls[qq] = 0.f; }
#pragma unroll
    for (int qq = 0; qq < 2; ++qq)
#pragma unroll
        for (int s2 = 0; s2 < 4; ++s2) asm volatile("" : "+v"(ql[qq][s2]));
    const int nch1 = (nsels[1] + 31) >> 5, nch = PROBE_DSA == 3 ? 2 * nch1 : nch1;
    LDS_WAIT();
    { const LAS unsigned short* lst = lsts[0]; DSA_GATHER(0, 0); }
    { const LAS unsigned short* lst = lsts[1]; DSA_GATHER(0, 1); }
    const unsigned offA = (unsigned)((quad >> 1) * 1024 + l16 * 32 + (quad & 1) * 16);
    const unsigned offT = (unsigned)((4 * quad + (l16 >> 2)) * 32 + 8 * (lane & 3));
#pragma nounroll
    for (int ch = 0; ch < nch; ++ch) {
#pragma unroll
        for (int qq = 0; qq < 2; ++qq) {
            const int chd = ch >= nch1 ? ch - nch1 : ch;
            const LAS unsigned short* lst = lsts[qq];
            const LAS unsigned char* gb = gb0 + qq * 8192;
            if (qq == 0 || ch + 1 < nch) asm volatile("s_waitcnt vmcnt(8)" ::: "memory"); else asm volatile("s_waitcnt vmcnt(0)" ::: "memory");
            f32x4 acc2[2]; float bvs[2][4];
#pragma unroll
            for (int rb = 0; rb < 2; ++rb) { f32x4 acc = {0.f, 0.f, 0.f, 0.f};
#pragma unroll
                for (int s2 = 0; s2 < 4; ++s2) { const bf16x8 af = *(const LAS bf16x8*)(gb + offA + rb * 512 + s2 * 2048); acc = MFMA16(af, ql[qq][s2], acc); }
                acc2[rb] = acc;
                const u32x2 kb = *(const LAS u32x2*)((const LAS unsigned char*)bkis[qq] + (chd * 32 + rb * 16 + 4 * quad) * 2);
                bvs[rb][0] = *(const LAS float*)(biasb + (kb.x & 0xffffu)); bvs[rb][1] = *(const LAS float*)(biasb + (kb.x >> 16));
                bvs[rb][2] = *(const LAS float*)(biasb + (kb.y & 0xffffu)); bvs[rb][3] = *(const LAS float*)(biasb + (kb.y >> 16)); }
#pragma unroll
            for (int rb = 0; rb < 2; ++rb)
#pragma unroll
                for (int r = 0; r < 4; ++r) asm volatile("" : "+v"(bvs[rb][r]));
            float x[2][4]; float tmax = NEGBIG;
#pragma unroll
            for (int rb = 0; rb < 2; ++rb)
#pragma unroll
                for (int r = 0; r < 4; ++r) { const float xv = acc2[rb][r] * C2 + bvs[rb][r]; x[rb][r] = xv; tmax = fmaxf(tmax, xv); }
            tmax = fmaxf(tmax, __shfl_xor(tmax, 16)); tmax = fmaxf(tmax, __shfl_xor(tmax, 32));
            const float mn = fmaxf(ms[qq], tmax); const bool resc = __any(mn != ms[qq]); const float alpha = __builtin_amdgcn_exp2f(ms[qq] - mn); ms[qq] = mn;
            float ps = 0.f;
#pragma unroll
            for (int rb = 0; rb < 2; ++rb)
#pragma unroll
                for (int r = 0; r < 4; ++r) { const float pv = __builtin_amdgcn_exp2f(x[rb][r] - mn); x[rb][r] = pv; ps += pv; }
            ls[qq] = ls[qq] * alpha + ps;
            if (resc) {
#pragma unroll
                for (int c = 0; c < 8; ++c) o[qq][c] = o[qq][c] * alpha; }
            u32x4 pw; pw.x = pk2(x[0][0], x[0][1]); pw.y = pk2(x[0][2], x[0][3]); pw.z = pk2(x[1][0], x[1][1]); pw.w = pk2(x[1][2], x[1][3]);
            const unsigned gba = (unsigned)(unsigned long long)gb + offT;
#pragma unroll
            for (int cb = 0; cb < 2; ++cb) {
                s16x4 v[8];
                if (cb == 0) asm volatile("ds_read_b64_tr_b16 %0, %8\n\tds_read_b64_tr_b16 %1, %8 offset:512\n\tds_read_b64_tr_b16 %2, %8 offset:1024\n\tds_read_b64_tr_b16 %3, %8 offset:1536\n\t"
                             "ds_read_b64_tr_b16 %4, %8 offset:2048\n\tds_read_b64_tr_b16 %5, %8 offset:2560\n\tds_read_b64_tr_b16 %6, %8 offset:3072\n\tds_read_b64_tr_b16 %7, %8 offset:3584\n\ts_waitcnt lgkmcnt(0)"
                             : "=&v"(v[0]), "=&v"(v[1]), "=&v"(v[2]), "=&v"(v[3]), "=&v"(v[4]), "=&v"(v[5]), "=&v"(v[6]), "=&v"(v[7]) : "v"(gba) : "memory");
                else asm volatile("ds_read_b64_tr_b16 %0, %8 offset:4096\n\tds_read_b64_tr_b16 %1, %8 offset:4608\n\tds_read_b64_tr_b16 %2, %8 offset:5120\n\tds_read_b64_tr_b16 %3, %8 offset:5632\n\t"
                             "ds_read_b64_tr_b16 %4, %8 offset:6144\n\tds_read_b64_tr_b16 %5, %8 offset:6656\n\tds_read_b64_tr_b16 %6, %8 offset:7168\n\tds_read_b64_tr_b16 %7, %8 offset:7680\n\ts_waitcnt lgkmcnt(0)"
                             : "=&v"(v[0]), "=&v"(v[1]), "=&v"(v[2]), "=&v"(v[3]), "=&v"(v[4]), "=&v"(v[5]), "=&v"(v[6]), "=&v"(v[7]) : "v"(gba) : "memory");
#pragma unroll
                for (int c4 = 0; c4 < 4; ++c4) { const int c = 4 * cb + c4; const s16x4 v0 = v[2 * c4], v1 = v[2 * c4 + 1];
                    const bf16x8 vf = {v0[0], v0[1], v0[2], v0[3], v1[0], v1[1], v1[2], v1[3]};
                    o[qq][c] = MFMA16(vf, __builtin_bit_cast(bf16x8, pw), o[qq][c]); }
            }
            LDS_WAIT();
            if (ch + 1 < nch) DSA_GATHER((ch + 1 >= nch1 ? ch + 1 - nch1 : ch + 1), qq);
        }
    }
#pragma unroll
    for (int qq = 0; qq < 2; ++qq) {
        float l = ls[qq]; const int tq = tqs[qq];
        l += __shfl_xor(l, 16); l += __shfl_xor(l, 32);
        const float inv = l > 0.f ? 1.0f / l : 0.f;
        if (l16 < 8) { bf16* op = (bf16*)(ws + WS_OLAT) + (size_t)(b * SEQ + tq) * 1024 + l16 * 128 + 4 * quad;
#pragma unroll
            for (int c = 0; c < 8; ++c) { u32x2 w; w.x = pk2(o[qq][c][0] * inv, o[qq][c][1] * inv); w.y = pk2(o[qq][c][2] * inv, o[qq][c][3] * inv); *(u32x2*)(op + 16 * c) = w; } }
    }
}
#undef DSA_GATHER
__device__ __forceinline__ void phase4(const Frame& F, const Args& a) {
    const bool xcd = (F.G == 256);
    const int pstart = xcd ? (F.bx >> 3) : F.bx, pstep = xcd ? 32 : F.G, pend = xcd ? 128 : 1024;
#pragma nounroll
    for (int p2 = 2 * pstart; p2 < 2 * pend; p2 += (p2 & 1) ? 2 * pstep - 1 : 1) { const int p = p2 >> 1;
        const int b = xcd ? (F.bx & 7) : (p >> 7), j = p & 127;
        dsa_unit(F, a, b, (p2 & 1) ? j : 255 - j); }
    __syncthreads();
}

constexpr int NPHASE = 11;
__global__ void __launch_bounds__(NTHR, 2) fwd_kernel(Args args) {
    extern __shared__ __attribute__((aligned(16))) unsigned char lds_raw[];
    Frame F;
    F.lds = (LAS unsigned char*)lds_raw;
    F.tid = threadIdx.x; F.lane = F.tid & 63; F.wave = __builtin_amdgcn_readfirstlane(F.tid >> 6);
    F.G = gridDim.x; F.bx = blockIdx.x; F.ws = args.ws;
    unsigned char* ws = args.ws;
    volatile LAS unsigned* MISC = (volatile LAS unsigned*)(F.lds + MISC_OFF);
    if (F.tid < 64) MISC[F.tid] = 0u;
    __syncthreads();
    const int lo = args.ph_lo, hi = args.ph_hi;
    XcdBarrier bar; bar.bar = (unsigned*)(ws + WS_CTL) + CW_BAR; bar.x = 0; bar.st = nullptr;
    if (hi - lo > 1) bar = xcd_barrier_post((unsigned*)(ws + WS_CTL) + CW_BAR, MISC + 8);
#ifndef PH_MASK
#define PH_MASK 0xFFFF
#endif
#define IN(k) ((((PH_MASK) >> (k)) & 1) && lo <= (k) && (k) < hi)
#define SEAM(k) do { if (IN(k) && IN((k) + 1)) xcd_barrier(bar); } while (0)
#ifndef PROBE_PHASE
#define PROBE_PHASE -1
#endif
#define REPEAT(k) for (int rep_ = 0; rep_ < ((PROBE_PHASE) == (k) ? 2 : 1); ++rep_, ((PROBE_PHASE) == (k) && rep_ < 2 ? xcd_barrier(bar) : (void)0))

    if (IN(0)) REPEAT(0) { phase0(F, args); }
    SEAM(0);
    if (IN(1)) REPEAT(1) {
#ifndef PROBE_GEMM
#define PROBE_GEMM 0
#endif
        pg8::StaticOrder S; S.init(NTOK / 256, NZ / 256, F.G, F.bx, PROBE_GEMM == 1 ? 2 : 1);
        const APlain AA{ws + WS_XB, 128u, (unsigned)(D * 2)}; const BPlain BA{(const bf16*)(ws + WS_WINT), D};
        const EpiZ E{(bf16*)(ws + WS_ZA), (bf16*)(ws + WS_ZG)};
        pg8::gemm_phase(F.lds, D, S, AA, BA, E);
        { const int nu = (NTOK / 256) * (NZ / 256), rem = nu % F.G;
          if (rem != 0 && F.bx >= rem) p0_experts(F, args, (F.bx - rem) * NWAVES + F.wave, (F.G - rem) * NWAVES, 0, P0_EXP_ITEMS); }
    }
    SEAM(1);
    if (IN(2)) REPEAT(2) { phase2(F, args); }
    SEAM(2);
    if (IN(3)) REPEAT(3) { phase3(F); }
    if (IN(4)) REPEAT(4) { phase4(F, args); }
    SEAM(4);
    if (IN(5)) REPEAT(5) {
        pg8::StaticOrder S; S.init(NTOK / 256, D / 256, F.G, F.bx);
        { const APlain AA{ws + WS_OA, 128u, 1024u}; const BPlain BA{(const bf16*)(ws + WS_WAT), 512};
          const EpiGate<0> E{(const bf16*)(ws + WS_ZG), nullptr, (bf16*)(ws + WS_T1)};
          pg8::gemm_phase(F.lds, 512, S, AA, BA, E); }
        { const APlain AA{ws + WS_OLAT, 128u, 2048u}; const BPlain BA{(const bf16*)(ws + WS_WBT), 1024};
          const EpiGate<1> E{(const bf16*)(ws + WS_ZG), (const bf16*)(ws + WS_T1), (bf16*)(ws + WS_MERGED)};
          pg8::gemm_phase(F.lds, 1024, S, AA, BA, E); }
    }
    SEAM(5);
    if (IN(6)) REPEAT(6) {
        pg8::StaticOrder S; S.init(NTOK / 256, D / 256, F.G, F.bx, PROBE_GEMM == 6 ? 2 : 1);
        const APlain AA{ws + WS_MERGED, 128u, 2048u}; const BPlain BA{(const bf16*)(ws + WS_WOT), 1024};
        const EpiRes E{args.in[0], (bf16*)(ws + WS_H1)};
        pg8::gemm_phase(F.lds, 1024, S, AA, BA, E);
    }
    SEAM(6);
    if (IN(7)) { phase6(F, args); }
    SEAM(7);
    if (IN(8)) {
        moe_setup(F);
        const int vcu = (F.G % 8 == 0) ? (F.bx % 8) * (F.G / 8) + F.bx / 8 : F.bx;
        const MoeOrder S{F.G, vcu, 1, F.G == 256 ? 1 : 0, (const LAS int*)(F.lds + MOE_CUM), (unsigned*)(ws + WS_CTL) + CW_P8R};
        const AGather AA{ws + WS_H1B, 128u, (const int*)(ws + WS_LIST)}; const BGu BA{(const bf16*)(ws + WS_WGU)};
        const EpiAct E{(bf16*)(ws + WS_ACT)};
        pg8::gemm_phase(F.lds, 1024, S, AA, BA, E);
    }
    if (F.G != 256) SEAM(8);
    if (IN(9)) {
        moe_setup(F);
        const int vcu = (F.G % 8 == 0) ? (F.bx % 8) * (F.G / 8) + F.bx / 8 : F.bx;
        const MoeOrder S{F.G, vcu, 2, F.G == 256 ? 3 : 0, (const LAS int*)(F.lds + MOE_CUM), (unsigned*)(ws + WS_CTL) + CW_P8R};
        if (F.G == 256) { if (F.wave == 0) MoeOrder::wait_for(S.dep, 256u); __syncthreads(); }
        const APlain AA{ws + WS_ACT, 128u, 512u}; const BDn BA{(const bf16*)(ws + WS_WDT)};
        const EpiDown E{(bf16*)(ws + WS_YBUF), (const int*)(ws + WS_LIST)};
        pg8::gemm_phase(F.lds, 256, S, AA, BA, E);
    }
    SEAM(9);
    if (IN(10)) REPEAT(10) { phase9(F, args); }
#undef IN
#undef SEAM
#undef REPEAT
}

extern "C" void kernel_launch(void* const* d_in, const int* in_sizes, int n_in, void* d_out, int out_size, void* d_ws, size_t ws_size, hipStream_t stream) {
    static int grid = 0;
    if (grid == 0) {
        if (n_in != 26 || in_sizes[0] != NTOK * D || out_size != NTOK * D || ws_size < WS_END) {
            fprintf(stderr, "kernel_launch: unexpected problem: n_in %d in0 %d out %d ws %zu (need %zu)\n", n_in, n_in > 0 ? in_sizes[0] : -1, out_size, ws_size, (size_t)WS_END); grid = -1; return; }
        int dev = 0, cus = 0, per_cu = 0;
        if (hipGetDevice(&dev) != hipSuccess || hipDeviceGetAttribute(&cus, hipDeviceAttributeMultiprocessorCount, dev) != hipSuccess) { grid = -1; return; }
        if (hipFuncSetAttribute((const void*)fwd_kernel, hipFuncAttributeMaxDynamicSharedMemorySize, LDS_BYTES) != hipSuccess) { fprintf(stderr, "kernel_launch: hipFuncSetAttribute failed\n"); grid = -1; return; }
        if (hipOccupancyMaxActiveBlocksPerMultiprocessor(&per_cu, (const void*)fwd_kernel, NTHR, LDS_BYTES) != hipSuccess || per_cu < 1)
            fprintf(stderr, "kernel_launch: occupancy query reports %d\n", per_cu);
        (void)hipGetLastError();
        grid = cus;
    }
    if (grid < 0) return;
    if (hipMemsetAsync((char*)d_ws + WS_CTL, 0, CTL_ZERO_BYTES, stream) != hipSuccess) return;
    Args a{};
    for (int i = 0; i < 26; ++i) a.in[i] = (const float*)d_in[i];
    a.out = (float*)d_out; a.ws = (unsigned char*)d_ws;
#if MK_PER_PHASE
    for (int p = 0; p < NPHASE; ++p) { a.ph_lo = p; a.ph_hi = p + 1; hipLaunchKernelGGL(fwd_kernel, dim3(grid), dim3(NTHR), LDS_BYTES, stream, a); }
#else
    a.ph_lo = 0; a.ph_hi = NPHASE;
    hipLaunchKernelGGL(fwd_kernel, dim3(grid), dim3(NTHR), LDS_BYTES, stream, a);
#endif
}
```

```cpp
#include <hip/hip_runtime.h>
#include <cstdio>
#include <cstdint>

#ifndef MK_PER_PHASE
#define MK_PER_PHASE 0
#endif

#define GAS __attribute__((address_space(1)))
#define LAS __attribute__((address_space(3)))
typedef unsigned short bf16;
typedef short bf16x8 __attribute__((ext_vector_type(8)));
typedef short s16x4 __attribute__((ext_vector_type(4)));
typedef float f32x4 __attribute__((ext_vector_type(4)));
typedef float f32x16 __attribute__((ext_vector_type(16)));
typedef float f32x2 __attribute__((ext_vector_type(2)));
typedef unsigned u32x4 __attribute__((ext_vector_type(4)));
typedef unsigned u32x2 __attribute__((ext_vector_type(2)));

constexpr int D = 1024, BATCH = 8, SEQ = 4096, NTOK = BATCH * SEQ;
constexpr int D_IN = 4316;
constexpr int NCMP = 255;
constexpr float ALPHA = 1.189207115002721f;
constexpr float LOG2E = 1.4426950408889634f;
constexpr float NEGBIG = -1e30f;
constexpr int ZA_LD = 2816;
constexpr int ZC_QA = 0, ZC_KC = 512, ZC_VC = 640, ZC_KS = 768, ZC_VS = 896, ZC_KW = 1024, ZC_VW = 1152, ZC_QLAT = 1280, ZC_CKV = 2304,
              ZC_QIDX = 2432, ZC_KIDX = 2688, ZC_GNSA = 2752, ZC_WIDX = 2776;
constexpr int ZG_LD = 2048;
constexpr int NZ = ZA_LD + ZG_LD;
constexpr int NEXP = 32, DEXP = 256;
constexpr int MAXTILES = (2 * NTOK) / 256 + NEXP;

constexpr size_t MiB = 1u << 20;
constexpr size_t WS_CTL = 0, CTL_ZERO_BYTES = 1 * MiB;
constexpr size_t WS_WAT = 1 * MiB;
constexpr size_t WS_WBT = 2 * MiB;
constexpr size_t WS_WOT = 4 * MiB;
constexpr size_t WS_W1K = 6 * MiB;
constexpr size_t WS_W1V = 7 * MiB;
constexpr size_t WS_W2K = 8 * MiB;
constexpr size_t WS_W2V = 8 * MiB + 64 * 1024;
constexpr size_t WS_BIASK = 8 * MiB + 128 * 1024;
constexpr size_t WS_TBA = 8 * MiB + 256 * 1024;
constexpr size_t WS_TBB = 8 * MiB + 320 * 1024;
constexpr size_t WS_KCMP = 9 * MiB;
constexpr size_t WS_VCMP = 9 * MiB + 512 * 1024;
constexpr size_t WS_TOKINFO = 10 * MiB;
constexpr size_t WS_LIST = 11 * MiB;
constexpr size_t WS_WINT = 16 * MiB;
constexpr size_t WS_WGU = 32 * MiB;
constexpr size_t WS_WDT = 64 * MiB;
constexpr size_t WS_CKVN = 80 * MiB;
constexpr size_t WS_XB = 96 * MiB;
constexpr size_t WS_OLAT = 96 * MiB;
constexpr size_t WS_H1B = 96 * MiB;
constexpr size_t WS_ZA = 160 * MiB;
constexpr size_t WS_T1 = 160 * MiB;
constexpr size_t WS_ACT = 160 * MiB;
constexpr size_t WS_YBUF = 196 * MiB;
constexpr size_t WS_MERGED = 224 * MiB;
constexpr size_t WS_ZG = 336 * MiB;
constexpr size_t WS_H1 = 336 * MiB;
constexpr size_t WS_OA = 464 * MiB;
constexpr size_t WS_END = 496 * MiB;

constexpr int CW_BAR = 4096;
constexpr int CW_CNT = 16384;
constexpr int CW_P8R = 20480;

constexpr int LDS_BYTES = 163840;
constexpr int MISC_OFF = 160 * 1024 - 256;

__device__ __forceinline__ unsigned f2bf(float f) { unsigned u = __builtin_bit_cast(unsigned, f); return (u + 0x7fffu + ((u >> 16) & 1u)) >> 16; }
__device__ __forceinline__ unsigned pk2(float lo, float hi) { unsigned r; asm volatile("v_cvt_pk_bf16_f32 %0, %1, %2" : "=v"(r) : "v"(lo), "v"(hi)); return r; }
__device__ __forceinline__ float bf2f(unsigned short b) { return __builtin_bit_cast(float, ((unsigned)b) << 16); }
__device__ __forceinline__ float bflo(unsigned w) { return __builtin_bit_cast(float, w << 16); }
__device__ __forceinline__ float bfhi(unsigned w) { return __builtin_bit_cast(float, w & 0xffff0000u); }
__device__ __forceinline__ float wave_sum(float v) {
#pragma unroll
    for (int o = 1; o < 64; o <<= 1) v += __shfl_xor(v, o);
    return v;
}
__device__ __forceinline__ float sigmoidf_(float x) { return __builtin_amdgcn_rcpf(1.0f + __builtin_amdgcn_exp2f(-1.4426950408889634f * x)); }
#define LDS_WAIT() asm volatile("s_waitcnt lgkmcnt(0)" ::: "memory")
#define VM_WAIT() asm volatile("s_waitcnt vmcnt(0)" ::: "memory")

#define XB_TMO      128
#define XB_XCNT(j)  (256  + 64 * (j))
#define XB_XSUB(j)  (1280 + 64 * (j))
#define XB_XGEN(j)  (2304 + 64 * (j))
#define XB_TOP      3328
#define XB_TOPGEN   3392
#define XCD_BAR_WORDS 3456
#define XB_SPIN_CAP (1u << 18)
__device__ __forceinline__ unsigned xb_ld(unsigned* p)              { return __hip_atomic_load(p, __ATOMIC_RELAXED, __HIP_MEMORY_SCOPE_AGENT); }
__device__ __forceinline__ unsigned xb_add(unsigned* p, unsigned v) { return __hip_atomic_fetch_add(p, v, __ATOMIC_RELAXED, __HIP_MEMORY_SCOPE_AGENT); }
__device__ __forceinline__ unsigned xb_xcc_id() { return (unsigned)__builtin_amdgcn_s_getreg((3 << 11) | 20) & 0xFu; }
#define XB_SPIN(cond, bar) do { unsigned _sp = 0; while (cond) { __builtin_amdgcn_s_sleep(1); \
    if ((++_sp & 255u) == 0u) { if (xb_ld(&(bar)[XB_TMO])) break; if (_sp > XB_SPIN_CAP) { atomicAdd(&(bar)[XB_TMO], 1u); break; } } } } while (0)
struct XcdBarrier { unsigned* bar; unsigned x; volatile LAS unsigned* st; };
__device__ __forceinline__ XcdBarrier xcd_barrier_post(unsigned* bar, volatile LAS unsigned* st) {
    XcdBarrier b; b.bar = bar; b.x = xb_xcc_id(); b.st = st;
    if (threadIdx.x == 0) (void)xb_add(&bar[XB_XCNT(b.x)], 1u);
    return b;
}
__device__ __forceinline__ void xcd_barrier_complete(unsigned* bar, unsigned x, unsigned& nloc, unsigned& nx) {
    const unsigned G = gridDim.x * gridDim.y * gridDim.z;
    unsigned sum, cnt, mine, sp = 0u;
    for (;;) {
        sum = 0u; cnt = 0u; mine = 0u;
#pragma unroll
        for (unsigned j = 0; j < 16; ++j) { const unsigned c = xb_ld(&bar[XB_XCNT(j)]); sum += c; cnt += (c > 0u) ? 1u : 0u; mine = (j == x) ? c : mine; }
        if (sum == G) break;
        __builtin_amdgcn_s_sleep(1);
        if ((++sp & 255u) == 0u) { if (xb_ld(&bar[XB_TMO])) break; if (sp > XB_SPIN_CAP) { atomicAdd(&bar[XB_TMO], 1u); break; } }
    }
    nloc = mine > 0u ? mine : 1u; nx = cnt > 0u ? cnt : 1u;
}
__device__ __forceinline__ void xcd_barrier(const XcdBarrier& b) {
    asm volatile("s_waitcnt vmcnt(0)" ::: "memory");
    __syncthreads();
    if (threadIdx.x == 0) {
        unsigned* bar = b.bar;
        __builtin_amdgcn_s_waitcnt(0);
        unsigned nloc = b.st[0], nx = b.st[1];
        if (nloc == 0u) { xcd_barrier_complete(bar, b.x, nloc, nx); b.st[0] = nloc; b.st[1] = nx; }
        const unsigned old = xb_add(&bar[XB_XSUB(b.x)], 1u);
        const unsigned gen = old / nloc;
        if (old + 1u == (gen + 1u) * nloc) {
            __builtin_amdgcn_fence(__ATOMIC_RELEASE, "agent");
            asm volatile("s_waitcnt vmcnt(0)" ::: "memory");
            const unsigned og = xb_add(&bar[XB_TOP], 1u);
            const unsigned tg = og / nx;
            if (og + 1u == (tg + 1u) * nx) xb_add(&bar[XB_TOPGEN], 1u);
            else XB_SPIN(xb_ld(&bar[XB_TOPGEN]) == tg, bar);
            __builtin_amdgcn_fence(__ATOMIC_ACQUIRE, "agent");
            xb_add(&bar[XB_XGEN(b.x)], 1u);
            asm volatile("s_waitcnt vmcnt(0)" ::: "memory");
        } else {
            XB_SPIN(xb_ld(&bar[XB_XGEN(b.x)]) == gen, bar);
            __builtin_amdgcn_fence(__ATOMIC_ACQUIRE, "agent");
            asm volatile("s_waitcnt vmcnt(0)" ::: "memory");
        }
    }
    __syncthreads();
}

namespace pg8 {
constexpr int BM = 256, BK = 64, HALF = 128, HTB = HALF * BK * 2, STAGE_BYTES = 8 * HTB, NXCD = 8, WGM = 8;
__host__ __device__ __forceinline__ int lds_byte(int r, int c) { const int st = (r >> 4) * 2 + (c >> 5), rr = r & 15, cc = c & 31, ob = rr * 64 + cc * 2; return st * 1024 + (ob ^ (((ob >> 9) & 1) << 5)); }
__host__ __device__ __forceinline__ void stage_rc(int b, int& R, int& C) { const int st = b / 1024, sb = b % 1024, swz = sb ^ (((sb >> 9) & 1) << 5); R = (st >> 1) * 16 + swz / 64; C = (st & 1) * 32 + (swz % 64) / 2; }
__host__ __device__ __forceinline__ int perm32(int rho) { const int n = rho >> 4, i = rho & 15; return 8 * (i >> 2) + 4 * n + (i & 3); }
struct Unit { int pm, pn, e, nrows; };
struct StaticOrder {
    int nM, nN, nwg, G, c, dup;
    __device__ void init(int nM_, int nN_, int G_, int c_, int dup_ = 1) { nM = nM_; nN = nN_; nwg = nM * nN; G = G_; c = c_; dup = dup_; }
    __device__ bool next(int i, Unit& u) const {
        const long L0 = (long)i * G + c; if (L0 >= (long)nwg * dup) return false;
        const long L = L0 % nwg;
        int wgid = (int)L; { const int q = nwg / NXCD, r = nwg % NXCD, xcd = wgid % NXCD, off = wgid / NXCD; wgid = (xcd < r ? xcd * (q + 1) : r * (q + 1) + (xcd - r) * q) + off; }
        const int nig = WGM * nN, gid = wgid / nig, fm = gid * WGM, gsz = (nM - fm) < WGM ? (nM - fm) : WGM;
        u.pm = fm + ((wgid % nig) % gsz); u.pn = (wgid % nig) / gsz; u.e = 0; u.nrows = 256; return true;
    }
    __device__ __forceinline__ void done(int) const {}
};

template <class Epi, class Sched, class AAddr, class BAddr>
__device__ __forceinline__ void gemm_phase(LAS unsigned char* lds, const int K, const Sched& S, const AAddr& AA, const BAddr& BA, const Epi& E) {
    constexpr bool GA = AAddr::GATHER;
    const int tid = threadIdx.x, wid = __builtin_amdgcn_readfirstlane(tid >> 6), lane = tid & 63, wr = wid >> 2, wc = wid & 3, fr = lane & 15, fq = lane >> 4;
    const int nt = K / BK;
    unsigned voffA[2], voffB[2];
#pragma unroll
    for (int i = 0; i < 2; ++i) { int R, C; stage_rc(tid * 16 + i * 8192, R, C); const int Rb = Epi::PERM ? ((R & ~31) + perm32(R & 31)) : R;
        voffA[i] = GA ? 0u : AA.lane_off(R, C); voffB[i] = (unsigned)(Rb * K + C) * 2u; }
    const size_t kstepA = (size_t)AA.kstep, kstepB = (size_t)(BK * 2);
    const size_t hstepB = (size_t)HALF * K * 2, hstepA = GA ? 0 : AA.hstep();
    const unsigned ldsw = (unsigned)wid * 1024u;
    const int aoff = lds_byte(wr * 64 + fr, fq * 8), boff = lds_byte(wc * 32 + fr, fq * 8);
#define PG8_SA(b, h) (((b) * 2 + (h)) * HTB)
#define PG8_SB(b, h) ((4 + (b) * 2 + (h)) * HTB)
#define PG8_STAGE(bufoff, gbase, voff) do { _Pragma("unroll") for (int _i = 0; _i < 2; ++_i) \
        __builtin_amdgcn_global_load_lds((const unsigned*)((const char*)(gbase) + (voff)[_i]), (LAS unsigned*)(lds + (bufoff) + ldsw + _i * 8192), 16, 0, 0); } while (0)
#define PG8_STA_CUR(bufoff, h, kb) do { if constexpr (GA) { if (h) PG8_STAGE(bufoff, baseA + (kb), cof1); else PG8_STAGE(bufoff, baseA + (kb), cof0); } \
        else PG8_STAGE(bufoff, cA + (h) * hstepA + (kb), voffA); } while (0)
#define PG8_STA_SEL(bufoff, h, kb) do { if constexpr (GA) { if (h) PG8_STAGE(bufoff, baseA + (kb), sof1); else PG8_STAGE(bufoff, baseA + (kb), sof0); } \
        else PG8_STAGE(bufoff, sA + (h) * hstepA + (kb), voffA); } while (0)
#define PG8_LDA(dst, b, h) do { _Pragma("unroll") for (int m = 0; m < 4; ++m) _Pragma("unroll") for (int k = 0; k < 2; ++k) dst[m][k] = *(const LAS bf16x8*)(lds + PG8_SA(b, h) + aoff + m * 2048 + k * 1024); } while (0)
#define PG8_LDB(dst, b, h) do { _Pragma("unroll") for (int n = 0; n < 2; ++n) _Pragma("unroll") for (int k = 0; k < 2; ++k) dst[n][k] = *(const LAS bf16x8*)(lds + PG8_SB(b, h) + boff + n * 2048 + k * 1024); } while (0)
#define PG8_MMA(ai, bj, At, Bt) do { __builtin_amdgcn_s_setprio(1); _Pragma("unroll") for (int m = 0; m < 4; ++m) _Pragma("unroll") for (int n = 0; n < 2; ++n) _Pragma("unroll") for (int k = 0; k < 2; ++k) \
        acc[ai][bj][m][n] = __builtin_amdgcn_mfma_f32_16x16x32_bf16(Bt[n][k], At[m][k], acc[ai][bj][m][n], 0, 0, 0); __builtin_amdgcn_s_setprio(0); } while (0)
#define PG8_WAIT_V(n) asm volatile("s_waitcnt vmcnt(" #n ")" ::: "memory")
#define PG8_WAIT_L(n) asm volatile("s_waitcnt lgkmcnt(" #n ")" ::: "memory")
#define PG8_BAR __builtin_amdgcn_s_barrier()
#define PG8_SCHED __builtin_amdgcn_sched_barrier(0)
#define PG8_GOFF(u, o0, o1) do { _Pragma("unroll") for (int _i = 0; _i < 2; ++_i) { int R_, C_; stage_rc(tid * 16 + _i * 8192, R_, C_); \
        o0[_i] = AA.row_off(u, R_) + (unsigned)C_ * 2u; o1[_i] = AA.row_off(u, R_ + HALF) + (unsigned)C_ * 2u; } } while (0)
    Unit cur, nxt; int ui = 0;
    if (!S.next(0, cur)) return;
    f32x4 acc[2][2][4][2];
#pragma unroll
    for (int a = 0; a < 2; ++a)
#pragma unroll
        for (int b = 0; b < 2; ++b)
#pragma unroll
            for (int m = 0; m < 4; ++m)
#pragma unroll
                for (int n = 0; n < 2; ++n) acc[a][b][m][n] = (f32x4){0.f, 0.f, 0.f, 0.f};
    bf16x8 At[4][2], B0[2][2], B1[2][2];
    const char* const baseA = GA ? (const char*)AA.base : nullptr;
    const char* cA = GA ? nullptr : (const char*)AA.unit_ptr(cur);
    unsigned cof0[2] = {0u, 0u}, cof1[2] = {0u, 0u}, nof0[2] = {0u, 0u}, nof1[2] = {0u, 0u};
    if constexpr (GA) PG8_GOFF(cur, cof0, cof1);
    const char* cB = (const char*)BA.ptr(cur);
    PG8_STAGE(PG8_SB(0, 0), cB, voffB); PG8_STA_CUR(PG8_SA(0, 0), 0, 0); PG8_STAGE(PG8_SB(0, 1), cB + hstepB, voffB); PG8_STA_CUR(PG8_SA(0, 1), 1, 0);
    if (wr == 1) PG8_BAR;
    PG8_WAIT_V(4); PG8_BAR;
    PG8_STAGE(PG8_SB(1, 0), cB + kstepB, voffB); PG8_STA_CUR(PG8_SA(1, 0), 0, kstepA); PG8_STAGE(PG8_SB(1, 1), cB + hstepB + kstepB, voffB);
    PG8_WAIT_V(6); PG8_BAR;
    for (;;) {
        const bool has_next = S.next(ui + 1, nxt);
        const char* nB = cB; const char* nA = cA;
        if (has_next) { nB = (const char*)BA.ptr(nxt); if constexpr (GA) PG8_GOFF(nxt, nof0, nof1); else nA = (const char*)AA.unit_ptr(nxt); }
        else { if constexpr (GA) {
#pragma unroll
            for (int i = 0; i < 2; ++i) { nof0[i] = cof0[i]; nof1[i] = cof1[i]; } } }
#pragma nounroll
        for (int t = 0; t < nt; t += 2) {
            const bool last = (t == nt - 2);
            const size_t k1 = (size_t)(t + 1) * kstepA, k2 = last ? 0 : (size_t)(t + 2) * kstepA, k3 = k2 + kstepA;
            const char* b2 = last ? nB : cB + (size_t)(t + 2) * kstepB; const char* b3 = b2 + kstepB;
            const char* sA = last ? nA : cA;
            unsigned sof0[2], sof1[2];
#pragma unroll
            for (int i = 0; i < 2; ++i) { sof0[i] = last ? nof0[i] : cof0[i]; sof1[i] = last ? nof1[i] : cof1[i]; }
            PG8_LDB(B0, 0, 0); PG8_SCHED; PG8_LDA(At, 0, 0); PG8_STA_CUR(PG8_SA(1, 1), 1, k1);
            PG8_WAIT_L(8); PG8_BAR; PG8_WAIT_L(0); PG8_MMA(0, 0, At, B0); PG8_BAR; PG8_SCHED;
            PG8_LDB(B1, 0, 1); PG8_STAGE(PG8_SB(0, 0), b2, voffB);
            PG8_BAR; PG8_WAIT_L(0); PG8_MMA(0, 1, At, B1); PG8_BAR;
            PG8_LDA(At, 0, 1); PG8_STA_SEL(PG8_SA(0, 0), 0, k2);
            PG8_BAR; PG8_WAIT_L(0); PG8_MMA(1, 0, At, B0); PG8_BAR; PG8_SCHED;
            PG8_STAGE(PG8_SB(0, 1), b2 + hstepB, voffB);
            PG8_WAIT_V(6); PG8_BAR; PG8_MMA(1, 1, At, B1); PG8_BAR;
            PG8_LDB(B0, 1, 0); PG8_SCHED; PG8_LDA(At, 1, 0); PG8_STA_SEL(PG8_SA(0, 1), 1, k2);
            PG8_WAIT_L(8); PG8_BAR; PG8_WAIT_L(0); PG8_MMA(0, 0, At, B0); PG8_BAR; PG8_SCHED;
            PG8_LDB(B1, 1, 1); PG8_STAGE(PG8_SB(1, 0), b3, voffB);
            PG8_BAR; PG8_WAIT_L(0); PG8_MMA(0, 1, At, B1); PG8_BAR;
            PG8_LDA(At, 1, 1); PG8_STA_SEL(PG8_SA(1, 0), 0, k3);
            PG8_BAR; PG8_WAIT_L(0); PG8_MMA(1, 0, At, B0); PG8_BAR; PG8_SCHED;
            PG8_STAGE(PG8_SB(1, 1), b3 + hstepB, voffB);
            PG8_WAIT_V(6); PG8_BAR; PG8_MMA(1, 1, At, B1); PG8_BAR;
        }
        E(acc, cur, wr, wc, fr, fq);
        S.done(ui);
        if (!has_next) break;
#pragma unroll
        for (int a = 0; a < 2; ++a)
#pragma unroll
            for (int b = 0; b < 2; ++b)
#pragma unroll
                for (int m = 0; m < 4; ++m)
#pragma unroll
                    for (int n = 0; n < 2; ++n) acc[a][b][m][n] = (f32x4){0.f, 0.f, 0.f, 0.f};
        cur = nxt; cB = nB; cA = nA; ++ui;
        if constexpr (GA) {
#pragma unroll
            for (int i = 0; i < 2; ++i) { cof0[i] = nof0[i]; cof1[i] = nof1[i]; } }
    }
    PG8_WAIT_V(0);
    if (wr == 0) PG8_BAR;
    PG8_BAR;
#undef PG8_SA
#undef PG8_SB
#undef PG8_STAGE
#undef PG8_STA_CUR
#undef PG8_STA_SEL
#undef PG8_GOFF
#undef PG8_LDA
#undef PG8_LDB
#undef PG8_MMA
#undef PG8_WAIT_V
#undef PG8_WAIT_L
#undef PG8_BAR
#undef PG8_SCHED
}
}

constexpr int NWAVES = 8, NTHR = 512;
struct Args { const float* in[26]; float* out; unsigned char* ws; int ph_lo, ph_hi; unsigned repmask; int pad; };
typedef const __attribute__((address_space(4))) Args& ArgsR;
struct Frame {
    LAS unsigned char* lds;
    int tid, lane, wave, G, bx;
    unsigned char* ws;
};

struct APlain { const void* base; unsigned kstep; unsigned ld2;
    static constexpr bool GATHER = false;
    __device__ __forceinline__ const void* unit_ptr(const pg8::Unit& u) const { return (const char*)base + (size_t)u.pm * 256 * ld2; }
    __device__ __forceinline__ unsigned lane_off(int R, int C) const { return (unsigned)R * ld2 + (unsigned)C * 2u; }
    __device__ __forceinline__ size_t hstep() const { return (size_t)128 * ld2; }
    __device__ __forceinline__ unsigned row_off(const pg8::Unit&, int) const { return 0u; } };
struct BPlain { const bf16* Bt; int K;
    __device__ __forceinline__ const void* ptr(const pg8::Unit& u) const { return Bt + (size_t)u.pn * 256 * K; } };

struct EpiZ {
    static constexpr bool PERM = true;
    bf16* ZA; bf16* ZG;
    __device__ __forceinline__ void operator()(const f32x4 (&acc)[2][2][4][2], const pg8::Unit& u, int wr, int wc, int fr, int fq) const {
        const bool gate = u.pn >= 11;
        bf16* base = gate ? ZG : ZA; const int ld = gate ? ZG_LD : ZA_LD; const int colt = gate ? (u.pn - 11) * 256 : u.pn * 256;
        const int row0 = u.pm * 256 + wr * 64 + fr, col0 = colt + wc * 32 + 8 * fq;
#pragma unroll
        for (int ai = 0; ai < 2; ++ai)
#pragma unroll
            for (int m = 0; m < 4; ++m) { bf16* rowp = base + (size_t)(row0 + ai * 128 + m * 16) * ld + col0;
#pragma unroll
                for (int bj = 0; bj < 2; ++bj) { f32x4 v0 = acc[ai][bj][m][0], v1 = acc[ai][bj][m][1];
                    if (gate) {
#pragma unroll
                        for (int j = 0; j < 4; ++j) { v0[j] = sigmoidf_(v0[j]); v1[j] = sigmoidf_(v1[j]); } }
                    u32x4 w; w.x = pk2(v0[0], v0[1]); w.y = pk2(v0[2], v0[3]); w.z = pk2(v1[0], v1[1]); w.w = pk2(v1[2], v1[3]);
                    *(u32x4*)(rowp + bj * 128) = w; } }
    }
};
template <int MODE> struct EpiGate {
    static constexpr bool PERM = true;
    const bf16* ZG; const bf16* T1; bf16* O;
    __device__ __forceinline__ void operator()(const f32x4 (&acc)[2][2][4][2], const pg8::Unit& u, int wr, int wc, int fr, int fq) const {
        const int row0 = u.pm * 256 + wr * 64 + fr, col0 = u.pn * 256 + wc * 32 + 8 * fq;
#pragma unroll
        for (int ai = 0; ai < 2; ++ai) {
            u32x4 gv[4][2], tv[4][2];
#pragma unroll
            for (int m = 0; m < 4; ++m)
#pragma unroll
                for (int bj = 0; bj < 2; ++bj) { const size_t r = (size_t)(row0 + ai * 128 + m * 16); const int c = col0 + bj * 128;
                    gv[m][bj] = *(const u32x4*)(ZG + r * ZG_LD + MODE * 1024 + c); if (MODE == 1) tv[m][bj] = *(const u32x4*)(T1 + r * 1024 + c); }
#pragma unroll
            for (int m = 0; m < 4; ++m)
#pragma unroll
                for (int bj = 0; bj < 2; ++bj) { asm volatile("" : "+v"(gv[m][bj])); if (MODE == 1) asm volatile("" : "+v"(tv[m][bj])); }
#pragma unroll
            for (int m = 0; m < 4; ++m) { const size_t r = (size_t)(row0 + ai * 128 + m * 16);
#pragma unroll
                for (int bj = 0; bj < 2; ++bj) { const int c = col0 + bj * 128; const u32x4 g = gv[m][bj];
                    const f32x4 v0 = acc[ai][bj][m][0], v1 = acc[ai][bj][m][1];
                    float o[8] = { v0[0] * bflo(g.x), v0[1] * bfhi(g.x), v0[2] * bflo(g.y), v0[3] * bfhi(g.y), v1[0] * bflo(g.z), v1[1] * bfhi(g.z), v1[2] * bflo(g.w), v1[3] * bfhi(g.w) };
                    if (MODE == 1) { const u32x4 t = tv[m][bj];
                        o[0] += bflo(t.x); o[1] += bfhi(t.x); o[2] += bflo(t.y); o[3] += bfhi(t.y); o[4] += bflo(t.z); o[5] += bfhi(t.z); o[6] += bflo(t.w); o[7] += bfhi(t.w); }
                    u32x4 w; w.x = pk2(o[0], o[1]); w.y = pk2(o[2], o[3]); w.z = pk2(o[4], o[5]); w.w = pk2(o[6], o[7]);
                    *(u32x4*)(O + r * 1024 + c) = w; } }
        }
    }
};
struct EpiRes {
    static constexpr bool PERM = true;
    const float* X; bf16* O;
    __device__ __forceinline__ void operator()(const f32x4 (&acc)[2][2][4][2], const pg8::Unit& u, int wr, int wc, int fr, int fq) const {
        const int row0 = u.pm * 256 + wr * 64 + fr, col0 = u.pn * 256 + wc * 32 + 8 * fq;
#pragma unroll
        for (int ai = 0; ai < 2; ++ai) {
            f32x4 xv[4][2][2];
#pragma unroll
            for (int m = 0; m < 4; ++m)
#pragma unroll
                for (int bj = 0; bj < 2; ++bj) { const size_t off = (size_t)(row0 + ai * 128 + m * 16) * D + col0 + bj * 128; xv[m][bj][0] = *(const f32x4*)(X + off); xv[m][bj][1] = *(const f32x4*)(X + off + 4); }
#pragma unroll
            for (int m = 0; m < 4; ++m)
#pragma unroll
                for (int bj = 0; bj < 2; ++bj) { asm volatile("" : "+v"(xv[m][bj][0])); asm volatile("" : "+v"(xv[m][bj][1])); }
#pragma unroll
            for (int m = 0; m < 4; ++m)
#pragma unroll
                for (int bj = 0; bj < 2; ++bj) { const size_t off = (size_t)(row0 + ai * 128 + m * 16) * D + col0 + bj * 128;
                    const f32x4 v0 = xv[m][bj][0] * ALPHA + acc[ai][bj][m][0], v1 = xv[m][bj][1] * ALPHA + acc[ai][bj][m][1];
                    u32x4 w; w.x = pk2(v0[0], v0[1]); w.y = pk2(v0[2], v0[3]); w.z = pk2(v1[0], v1[1]); w.w = pk2(v1[2], v1[3]);
                    *(u32x4*)(O + off) = w; }
        }
    }
};

template <class F>
__device__ __forceinline__ void p0_tile(const F& f, bf16* WT, int ldk, int k0, int n0, LAS float* scr, int lane) {
    if constexpr (F::FOLD) {
        float bc[64];
#pragma unroll
        for (int d = 0; d < 64; ++d) bc[d] = f.bval(k0, d, n0 + (lane & 31));
#pragma unroll 4
        for (int i = 0; i < 32; ++i) { const int kk = 2 * i + (lane >> 5); const f32x4* ar = (const f32x4*)f.arow(k0 + kk, n0); f32x4 a4 = {0.f, 0.f, 0.f, 0.f};
#pragma unroll
            for (int q = 0; q < 16; ++q) { const f32x4 av = ar[q]; a4[0] += av[0] * bc[4 * q]; a4[1] += av[1] * bc[4 * q + 1]; a4[2] += av[2] * bc[4 * q + 2]; a4[3] += av[3] * bc[4 * q + 3]; }
            scr[kk * 33 + (lane & 31)] = (a4[0] + a4[1]) + (a4[2] + a4[3]); }
    } else {
        float v[32];
#pragma unroll
        for (int i = 0; i < 32; ++i) { const int kk = 2 * i + (lane >> 5); v[i] = f(k0 + kk, n0 + (lane & 31)); }
#pragma unroll
        for (int i = 0; i < 32; ++i) { const int kk = 2 * i + (lane >> 5); scr[kk * 33 + (lane & 31)] = v[i]; }
    }
    LDS_WAIT(); asm volatile("" ::: "memory");
    const int c = lane & 7;
#pragma unroll
    for (int j = 0; j < 4; ++j) { const int n = (lane >> 3) + 8 * j; const LAS float* s = scr + (8 * c) * 33 + n;
        u32x4 o; o.x = pk2(s[0 * 33], s[1 * 33]); o.y = pk2(s[2 * 33], s[3 * 33]); o.z = pk2(s[4 * 33], s[5 * 33]); o.w = pk2(s[6 * 33], s[7 * 33]);
        *(u32x4*)(WT + (size_t)(n0 + n) * ldk + k0 + 8 * c) = o; }
    LDS_WAIT(); asm volatile("" ::: "memory");
}
struct P0Item { const float* src; int N, noff; bf16* dst; int ldk, k0, n0; };
__device__ __forceinline__ void p0_item_load(const P0Item& it, float (&v)[32], int lane) {
#pragma unroll
    for (int i = 0; i < 32; ++i) { const int kk = 2 * i + (lane >> 5); v[i] = it.src[(size_t)(it.k0 + kk) * it.N + it.n0 + (lane & 31) + it.noff]; }
}
__device__ __forceinline__ void p0_item_finish(const P0Item& it, const float (&v)[32], LAS float* scr, int lane) {
#pragma unroll
    for (int i = 0; i < 32; ++i) { const int kk = 2 * i + (lane >> 5); scr[kk * 33 + (lane & 31)] = v[i]; }
    LDS_WAIT(); asm volatile("" ::: "memory");
    const int c = lane & 7;
#pragma unroll
    for (int j = 0; j < 4; ++j) { const int n = (lane >> 3) + 8 * j; const LAS float* s = scr + (8 * c) * 33 + n;
        u32x4 o; o.x = pk2(s[0 * 33], s[1 * 33]); o.y = pk2(s[2 * 33], s[3 * 33]); o.z = pk2(s[4 * 33], s[5 * 33]); o.w = pk2(s[6 * 33], s[7 * 33]);
        *(u32x4*)(it.dst + (size_t)(it.n0 + n) * it.ldk + it.k0 + 8 * c) = o; }
    LDS_WAIT(); asm volatile("" ::: "memory");
}
__device__ __forceinline__ int zsrc_col(int n) {
    if (n < 1280) return n;
    if (n < 2304) return -2;
    if (n < 2432) return 1816 + (n - 2304);
    if (n < 2688) return 1944 + (n - 2432);
    if (n < 2752) return 2200 + (n - 2688);
    if (n < 2776) return 1280 + (n - 2752);
    if (n < 2780) return 2264 + (n - 2776);
    if (n < 2816) return -1;
    if (n < 3840) return 2268 + (n - 2816);
    return 3292 + (n - 3840);
}
struct FWin { const float* w_in; static constexpr bool FOLD = false;
    __device__ __forceinline__ float operator()(int k, int n) const { const int s = zsrc_col(n); return s >= 0 ? w_in[(size_t)k * D_IN + s] : 0.f; } };
struct FWinQ { const float* w_in; const float* w_uk; static constexpr bool FOLD = true;
    __device__ __forceinline__ const float* arow(int k, int n0) const { return w_in + (size_t)k * D_IN + 1304 + ((n0 - 1280) >> 7) * 64; }
    __device__ __forceinline__ float bval(int, int d, int n) const { return w_uk[(size_t)((n - 1280) >> 7) * 64 * 128 + d * 128 + ((n - 1280) & 127)]; }
    __device__ __forceinline__ float operator()(int, int) const { return 0.f; } };
struct FWb { const float* w_uv; const float* w_bb; static constexpr bool FOLD = true;
    __device__ __forceinline__ const float* arow(int k, int) const { return w_uv + (size_t)k * 64; }
    __device__ __forceinline__ float bval(int k0, int d, int n) const { return w_bb[(size_t)((k0 >> 7) * 64 + d) * D + n]; }
    __device__ __forceinline__ float operator()(int, int) const { return 0.f; } };
struct FPlain { const float* W; int N; static constexpr bool FOLD = false; __device__ __forceinline__ float operator()(int k, int n) const { return W[(size_t)k * N + n]; } };
struct FOff { const float* W; int N; int noff; static constexpr bool FOLD = false;
    __device__ __forceinline__ float operator()(int k, int n) const { return W[(size_t)k * N + n + noff]; } };

__device__ __forceinline__ float rel_bucket_bias(const float* rel_bias, int dist, int head) {
    int b;
    if (dist < 16) b = dist;
    else { const float t = (__log2f((float)dist) - 4.0f) * 2.66666675f; b = 16 + (int)t; if (b > 31) b = 31; }
    return rel_bias[b * 16 + head];
}

constexpr int P0_EXP_ITEMS = NEXP * ((1024 / 64) * (512 / 32) + (256 / 64) * (1024 / 32)), P0_EXP_SPLIT = (P0_EXP_ITEMS * 2) / 3;
__device__ __forceinline__ void p0_experts(const Frame& F, ArgsR a, int wv, int nwv, int ibeg, int iend) {
    LAS float* scr = (LAS float*)(F.lds + F.wave * 16384);
    unsigned char* ws = F.ws;
    constexpr int I_GU = (1024 / 64) * (512 / 32), I_DN = (256 / 64) * (1024 / 32);
    const int gw = wv, NGW = nwv;
    {
        constexpr int NEI = NEXP * (I_GU + I_DN);
        auto mk = [&](int idx) { P0Item it; const int e = idx / (I_GU + I_DN); int r = idx - e * (I_GU + I_DN);
            if (r < I_GU) {
                const int n0 = (r % 16) * 32; const uintptr_t pg = (uintptr_t)a.in[21], pu = (uintptr_t)a.in[22];
                it.src = (const float*)(pg + (uintptr_t)((n0 >> 7) & 1) * (pu - pg)) + (size_t)e * D * DEXP; it.N = DEXP; it.noff = ((n0 >> 8) * 128 + (n0 & 127)) - n0;
                it.dst = (bf16*)(ws + WS_WGU) + (size_t)e * 512 * 1024; it.ldk = 1024; it.k0 = (r / 16) * 64; it.n0 = n0; }
            else { r -= I_GU; it.src = a.in[23] + (size_t)e * DEXP * D; it.N = D; it.noff = 0; it.dst = (bf16*)(ws + WS_WDT) + (size_t)e * 1024 * 256; it.ldk = 256; it.k0 = (r / 32) * 64; it.n0 = (r % 32) * 32; }
            return it; };
        float va[32], vb[32];
        {
        (void)NEI;
        int idx = ibeg + gw;
        if (idx < iend) { P0Item cur = mk(idx); p0_item_load(cur, va, F.lane);
            for (;;) {
                const int nidx = idx + NGW; const bool more = nidx < iend; P0Item nxt = cur;
                if (more) { nxt = mk(nidx); p0_item_load(nxt, vb, F.lane); }
                p0_item_finish(cur, va, scr, F.lane);
                if (!more) break;
#pragma unroll
                for (int i = 0; i < 32; ++i) va[i] = vb[i];
                cur = nxt; idx = nidx; } }
        }
    }
}
__device__ __forceinline__ void phase0(const Frame& F, ArgsR a) {
    LAS float* scr = (LAS float*)(F.lds + F.wave * 16384);
    const int gw = F.bx * NWAVES + F.wave, NGW = F.G * NWAVES;
    unsigned char* ws = F.ws;
    constexpr int I_WIN = (D / 64) * (NZ / 32);
    constexpr int I_WB = (1024 / 64) * (1024 / 32);
    constexpr int I_WA = (512 / 64) * (1024 / 32);
    constexpr int I_WO = I_WB;
    constexpr int I_W1 = (2048 / 64) * (256 / 32);
    constexpr int I_W2 = (256 / 64) * (64 / 32);
    constexpr int I_GU = (1024 / 64) * (512 / 32);
    constexpr int I_DN = (256 / 64) * (1024 / 32);
    constexpr int NITEMS = I_WIN + I_WB + I_WA + I_WO + 2 * I_W1 + 2 * I_W2;
    (void)NITEMS;
    constexpr int I_WINP = (D / 64) * ((NZ - 1024) / 32);
    for (int it = gw; it < 1024; it += NGW) {
        if (it < 512) { const int k0 = (it >> 5) * 64, n0 = 1280 + (it & 31) * 32; const FWinQ f{a.in[1], a.in[9]}; p0_tile(f, (bf16*)(ws + WS_WINT), D, k0, n0, scr, F.lane); }
        else { const int r = it - 512; const FWb f{a.in[10], a.in[13]}; p0_tile(f, (bf16*)(ws + WS_WBT), 1024, (r / 32) * 64, (r % 32) * 32, scr, F.lane); }
    }
    { constexpr int NPL = I_WINP + I_WA + I_WO + 2 * I_W1 + 2 * I_W2;
      const int pw0 = NGW > 1024 ? (gw >= 1024 ? gw - 1024 : -1) : gw, pws = NGW > 1024 ? NGW - 1024 : NGW;
      if (pw0 >= 0) for (int it = pw0; it < NPL; it += pws) {
        int r = it;
        if (r < I_WINP) { const int k0 = (r / 120) * 64; int nb = r % 120; nb = nb < 40 ? nb : nb + 32; const FWin f{a.in[1]}; p0_tile(f, (bf16*)(ws + WS_WINT), D, k0, nb * 32, scr, F.lane); continue; } r -= I_WINP;
        if (r < I_WA) { const FPlain f{a.in[12], D}; p0_tile(f, (bf16*)(ws + WS_WAT), 512, (r / 32) * 64, (r % 32) * 32, scr, F.lane); continue; } r -= I_WA;
        if (r < I_WO) { const FPlain f{a.in[14], D}; p0_tile(f, (bf16*)(ws + WS_WOT), 1024, (r / 32) * 64, (r % 32) * 32, scr, F.lane); continue; } r -= I_WO;
        if (r < I_W1) { const FPlain f{a.in[4], 256}; p0_tile(f, (bf16*)(ws + WS_W1K), 2048, (r / 8) * 64, (r % 8) * 32, scr, F.lane); continue; } r -= I_W1;
        if (r < I_W1) { const FPlain f{a.in[6], 256}; p0_tile(f, (bf16*)(ws + WS_W1V), 2048, (r / 8) * 64, (r % 8) * 32, scr, F.lane); continue; } r -= I_W1;
        if (r < I_W2) { const FPlain f{a.in[5], 64}; p0_tile(f, (bf16*)(ws + WS_W2K), 256, (r / 2) * 64, (r % 2) * 32, scr, F.lane); continue; } r -= I_W2;
        { const FPlain f{a.in[7], 64}; p0_tile(f, (bf16*)(ws + WS_W2V), 256, (r / 2) * 64, (r % 2) * 32, scr, F.lane); }
      } }
    { const int nu = (NTOK / 256) * (NZ / 256); if ((nu % F.G) == 0) p0_experts(F, a, gw, NGW, 0, P0_EXP_ITEMS); }
    { const f32x4* x4 = (const f32x4*)a.in[0]; u32x2* o = (u32x2*)(ws + WS_XB);
      const size_t total = (size_t)NTOK * D / 4, stride = (size_t)F.G * NTHR;
      for (size_t i0 = (size_t)F.bx * NTHR + F.tid; i0 < total; i0 += 8 * stride) { f32x4 v[8];
#pragma unroll
          for (int j = 0; j < 8; ++j) { const size_t i = i0 + j * stride; v[j] = i < total ? x4[i] : (f32x4){0.f, 0.f, 0.f, 0.f}; }
#pragma unroll
          for (int j = 0; j < 8; ++j) { const size_t i = i0 + j * stride; if (i < total) { u32x2 w; w.x = pk2(v[j][0], v[j][1]); w.y = pk2(v[j][2], v[j][3]); o[i] = w; } } } }
    if (F.bx < 64 && F.tid < 256) {
        const int kv = F.bx >> 5, j = F.bx & 31;
        const float* pe = (kv ? a.in[3] : a.in[2]) + 64 * j; const float* w1 = (kv ? a.in[6] : a.in[4]) + (size_t)(64 * j) * 256 + F.tid; float acc = 0.f;
#pragma unroll 16
        for (int k = 0; k < 64; ++k) acc += pe[k] * w1[(size_t)k * 256];
        ((float*)(ws + WS_BIASK))[(kv * 32 + j) * 256 + F.tid] = acc;
    }
    if (F.bx >= 64 && F.bx < 96) { const int idx = (F.bx - 64) * NTHR + F.tid;
        const int tab = idx >> 13, head = (idx >> 10) & 7, dist = idx & 1023;
        ((float*)(ws + (tab ? WS_TBB : WS_TBA)))[head * 1024 + dist] = rel_bucket_bias(a.in[11], dist, tab * 8 + head) * LOG2E; }
}

constexpr int NRT = 36;
constexpr int P6_WR = 0;
constexpr int P6_CNT = 147456;
constexpr int P6_ENT = 147456 + 512;
__device__ __forceinline__ float row16_sum(float v) {
    v += __builtin_bit_cast(float, __builtin_amdgcn_update_dpp(0, __builtin_bit_cast(int, v), 0xB1, 0xf, 0xf, true));
    v += __builtin_bit_cast(float, __builtin_amdgcn_update_dpp(0, __builtin_bit_cast(int, v), 0x4E, 0xf, 0xf, true));
    v += __builtin_bit_cast(float, __builtin_amdgcn_update_dpp(0, __builtin_bit_cast(int, v), 0x141, 0xf, 0xf, true));
    v += __builtin_bit_cast(float, __builtin_amdgcn_update_dpp(0, __builtin_bit_cast(int, v), 0x140, 0xf, 0xf, true));
    return v;
}
__device__ __forceinline__ float wave_sum_dpp(float v) { v = row16_sum(v); v += __shfl_xor(v, 16); v += __shfl_xor(v, 32); return v; }
__device__ __forceinline__ void phase6(const Frame& F, ArgsR a) {
    unsigned char* ws = F.ws;
    LAS float* WR = (LAS float*)(F.lds + P6_WR);
    LAS int* cntL = (LAS int*)(F.lds + P6_CNT); LAS int* baseL = cntL + 32;
    LAS int* ent = (LAS int*)(F.lds + P6_ENT);
    const float* w_grp = a.in[17]; const float* b_grp = a.in[18]; const float* w_rtr = a.in[19]; const float* b_rtr = a.in[20];
    {
        f32x4 wv[16], gv2[2];
#pragma unroll
        for (int i = 0; i < 16; ++i) wv[i] = *(const f32x4*)(w_rtr + 4 * (F.tid + NTHR * i));
#pragma unroll
        for (int i = 0; i < 2; ++i) gv2[i] = *(const f32x4*)(w_grp + 4 * (F.tid + NTHR * i));
#pragma unroll
        for (int i = 0; i < 16; ++i) { const int e = 4 * (F.tid + NTHR * i), k = e >> 5, o = e & 31;
#pragma unroll
            for (int c = 0; c < 4; ++c) WR[(4 + o + c) * 1024 + k] = wv[i][c]; }
#pragma unroll
        for (int i = 0; i < 2; ++i) { const int k = F.tid + NTHR * i;
#pragma unroll
            for (int c = 0; c < 4; ++c) WR[c * 1024 + k] = gv2[i][c]; }
    }
    if (F.tid < 65) cntL[F.tid] = 0;
    __syncthreads();
    const bf16* HP = (const bf16*)(ws + WS_H1); bf16* H1B = (bf16*)(ws + WS_H1B);
    const float* lg = a.in[15]; const float* lb = a.in[16];
    f32x2 gam[8], bet[8];
#pragma unroll
    for (int j = 0; j < 2; ++j)
#pragma unroll
        for (int q = 0; q < 4; ++q) { gam[4 * j + q] = *(const f32x2*)(lg + 512 * j + 8 * F.lane + 2 * q); bet[4 * j + q] = *(const f32x2*)(lb + 512 * j + 8 * F.lane + 2 * q); }
    unsigned* gcnt = (unsigned*)(ws + WS_CTL) + CW_CNT;
    int* list = (int*)(ws + WS_LIST); float* tokinfo = (float*)(ws + WS_TOKINFO);
    const int gw = F.bx * NWAVES + F.wave, NGW = F.G * NWAVES;
    u32x4 nx0, nx1;
    const int rpb = (NTOK + F.G - 1) / F.G, rbeg = F.bx * rpb, rend = (rbeg + rpb < NTOK) ? rbeg + rpb : NTOK;
    (void)gw; (void)NGW;
    if (rbeg + F.wave < rend) { const u32x4* hr = (const u32x4*)(HP + (size_t)(rbeg + F.wave) * D) + F.lane; nx0 = hr[0]; nx1 = hr[64]; }
    for (int row = rbeg + F.wave; row < rend; row += NWAVES) {
        const u32x4 r0 = nx0, r1 = nx1;
        if (row + NWAVES < rend) { const u32x4* hr = (const u32x4*)(HP + (size_t)(row + NWAVES) * D) + F.lane; nx0 = hr[0]; nx1 = hr[64]; }
        f32x2 v[8];
        v[0] = (f32x2){bflo(r0.x), bfhi(r0.x)}; v[1] = (f32x2){bflo(r0.y), bfhi(r0.y)}; v[2] = (f32x2){bflo(r0.z), bfhi(r0.z)}; v[3] = (f32x2){bflo(r0.w), bfhi(r0.w)};
        v[4] = (f32x2){bflo(r1.x), bfhi(r1.x)}; v[5] = (f32x2){bflo(r1.y), bfhi(r1.y)}; v[6] = (f32x2){bflo(r1.z), bfhi(r1.z)}; v[7] = (f32x2){bflo(r1.w), bfhi(r1.w)};
        f32x2 s2 = v[0];
#pragma unroll
        for (int q = 1; q < 8; ++q) s2 += v[q];
        const float mean = wave_sum_dpp(s2[0] + s2[1]) * (1.f / D);
        f32x2 q2 = {0.f, 0.f};
#pragma unroll
        for (int q = 0; q < 8; ++q) { v[q] = v[q] - mean; q2 += v[q] * v[q]; }
        const float rstd = 1.0f / sqrtf(wave_sum_dpp(q2[0] + q2[1]) * (1.f / D) + 1e-5f);
#pragma unroll
        for (int q = 0; q < 8; ++q) v[q] = v[q] * rstd * gam[q] + bet[q];
        { u32x4 w0, w1; w0.x = pk2(v[0][0], v[0][1]); w0.y = pk2(v[1][0], v[1][1]); w0.z = pk2(v[2][0], v[2][1]); w0.w = pk2(v[3][0], v[3][1]);
          w1.x = pk2(v[4][0], v[4][1]); w1.y = pk2(v[5][0], v[5][1]); w1.z = pk2(v[6][0], v[6][1]); w1.w = pk2(v[7][0], v[7][1]);
          u32x4* ob = (u32x4*)(H1B + (size_t)row * D) + F.lane; ob[0] = w0; ob[64] = w1; }
        auto rdot = [&](int o) { f32x2 p2 = {0.f, 0.f};
#pragma unroll
            for (int j = 0; j < 2; ++j) { const f32x4 wa = *(const LAS f32x4*)(WR + o * 1024 + 512 * j + 8 * F.lane), wb = *(const LAS f32x4*)(WR + o * 1024 + 512 * j + 8 * F.lane + 4);
                p2 += v[4 * j] * (f32x2){wa[0], wa[1]}; p2 += v[4 * j + 1] * (f32x2){wa[2], wa[3]}; p2 += v[4 * j + 2] * (f32x2){wb[0], wb[1]}; p2 += v[4 * j + 3] * (f32x2){wb[2], wb[3]}; }
            return row16_sum(p2[0] + p2[1]); };
        float g[4];
#pragma unroll
        for (int i = 0; i < 4; ++i) g[i] = rdot(i);
#pragma unroll
        for (int i = 0; i < 4; ++i) { float t = g[i]; t += __shfl_xor(t, 16); t += __shfl_xor(t, 32); g[i] = t + b_grp[i]; }
        int gs = 0; float gm = g[0];
#pragma unroll
        for (int i = 1; i < 4; ++i) if (g[i] > gm) { gm = g[i]; gs = i; }
        gs = __builtin_amdgcn_readfirstlane(gs);
        float gsum = 0.f;
#pragma unroll
        for (int i = 0; i < 4; ++i) gsum += __expf(g[i] - gm);
        const float pgrp = 1.0f / gsum;
        float el[8];
#pragma unroll
        for (int i = 0; i < 8; ++i) el[i] = rdot(4 + gs * 8 + i);
#pragma unroll
        for (int i = 0; i < 8; ++i) { float t = el[i]; t += __shfl_xor(t, 16); t += __shfl_xor(t, 32); el[i] = t + b_rtr[gs * 8 + i]; }
        int i1 = 0; float l1 = el[0];
#pragma unroll
        for (int i = 1; i < 8; ++i) if (el[i] > l1) { l1 = el[i]; i1 = i; }
        int i2 = -1; float l2 = -3.0e38f;
#pragma unroll
        for (int i = 0; i < 8; ++i) if (i != i1 && el[i] > l2) { l2 = el[i]; i2 = i; }
        const float e2 = __expf(l2 - l1), inv = 1.0f / (1.0f + e2);
        const float w0 = pgrp * inv, w1 = pgrp * e2 * inv;
        const int e0 = gs * 8 + i1, e1 = gs * 8 + i2;
        if (F.lane == 0) {
            const int p0 = atomicAdd((int*)&cntL[e0], 1), p1 = atomicAdd((int*)&cntL[e1], 1);
            const int n0 = atomicAdd((int*)&cntL[64], 2);
            ent[2 * n0] = (e0 << 16) | p0; ent[2 * n0 + 1] = row * 2;
            ent[2 * n0 + 2] = (e1 << 16) | p1; ent[2 * n0 + 3] = row * 2 + 1;
            tokinfo[row * 2] = w0; tokinfo[row * 2 + 1] = w1;
        }
    }
    __syncthreads();
    if (F.tid < 32) { const int c = cntL[F.tid]; baseL[F.tid] = c > 0 ? (int)__hip_atomic_fetch_add(gcnt + 64 * F.tid, (unsigned)c, __ATOMIC_RELAXED, __HIP_MEMORY_SCOPE_AGENT) : 0; }
    __syncthreads();
    const int nent = cntL[64];
    for (int i = F.tid; i < nent; i += NTHR) { const int ep = ent[2 * i], tk = ent[2 * i + 1]; const int e = ep >> 16, p = ep & 0xffff; list[(size_t)e * NTOK + baseL[e] + p] = tk; }
    __syncthreads();
}

constexpr int MOE_CUM = 131072;
struct MoeOrder {
    int G, c, NPs, mode; const LAS int* cum; unsigned* dep;
    __device__ __forceinline__ bool unit_of(int L, pg8::Unit& u) const {
        const int t = L >> NPs; if (t >= cum[32]) return false;
        const int e = cum[80 + t];
        const int j = t - cum[e]; u.pm = t; u.pn = L & ((1 << NPs) - 1); u.e = e | (j << 8); const int rem = cum[40 + e] - j * 256; u.nrows = rem < 256 ? rem : 256; return true; }
    static __device__ __forceinline__ void wait_for(const unsigned* w, unsigned need) {
        unsigned sp = 0;
        while (__hip_atomic_load(w, __ATOMIC_RELAXED, __HIP_MEMORY_SCOPE_AGENT) < need && ++sp < (1u << 22)) __builtin_amdgcn_s_sleep(2);
        __builtin_amdgcn_fence(__ATOMIC_ACQUIRE, "agent"); asm volatile("s_waitcnt vmcnt(0)" ::: "memory"); }
    __device__ bool next(int i, pg8::Unit& u) const {
        if (mode != 3) return unit_of(i * G + c, u);
        const int U8 = 2 * cum[32], R8 = U8 >> 8, nr = U8 & 255;
        const int na = R8 << 9, nb = 2 * U8 - na, S = (nr > 0 && R8 >= 2) ? 2 : 0, Jc = c < na ? (na - c + 255) >> 8 : 0;
        int L;
        if (c < nr) { L = c + 256 * (i + S); if (L >= na) return false; }
        else if (i < Jc) L = c + 256 * i;
        else { const int x = (c - nr) + (i - Jc) * (256 - nr); if (x >= S * nr + nb) return false;
            if (x < S * nr) L = x < nr ? x : x - nr + 256;
            else { L = na + (x - S * nr);
                if (__builtin_amdgcn_readfirstlane(threadIdx.x >> 6) == 0) wait_for(dep + 64, (unsigned)nr);
                asm volatile("" ::: "memory"); __builtin_amdgcn_s_barrier(); asm volatile("" ::: "memory"); } }
        return unit_of(L, u);
    }
    __device__ __forceinline__ void done(int ui) const {
        if (mode != 1) return;
        const int R8 = (2 * cum[32]) >> 8;
        if (ui == R8 - 1 || ui == R8) {
            asm volatile("s_waitcnt vmcnt(0)" ::: "memory");
            LAS unsigned* lcnt = (LAS unsigned*)((LAS unsigned char*)cum - MOE_CUM + MISC_OFF + 128);
            unsigned old = 0u;
            if ((threadIdx.x & 63) == 0) old = __hip_atomic_fetch_add(lcnt, 1u, __ATOMIC_RELAXED, __HIP_MEMORY_SCOPE_WORKGROUP);
            old = (unsigned)__builtin_amdgcn_readfirstlane((int)old);
            if ((old & 7u) == 7u) {
                __builtin_amdgcn_fence(__ATOMIC_RELEASE, "agent"); asm volatile("s_waitcnt vmcnt(0)" ::: "memory");
                if ((threadIdx.x & 63) == 0) __hip_atomic_fetch_add(dep + (ui == R8 ? 64 : 0), 1u, __ATOMIC_RELAXED, __HIP_MEMORY_SCOPE_AGENT); } }
    }
};
__device__ __forceinline__ void moe_setup(const Frame& F) {
    LAS int* cum = (LAS int*)(F.lds + MOE_CUM); LAS int* cnt = cum + 40;
    const unsigned* gcnt = (const unsigned*)(F.ws + WS_CTL) + CW_CNT;
    if (F.tid < 32) cnt[F.tid] = (int)__hip_atomic_load(gcnt + 64 * F.tid, __ATOMIC_RELAXED, __HIP_MEMORY_SCOPE_AGENT);
    __syncthreads();
    if (F.tid == 0) { int s = 0; for (int e = 0; e < 32; ++e) { cum[e] = s; s += (cnt[e] + 255) >> 8; } cum[32] = s; }
    __syncthreads();
    for (int t = F.tid; t < cum[32]; t += NTHR) { int e = 0; for (int k = 1; k < 32; ++k) if (t >= cum[k]) e = k; cum[80 + t] = e; }
    __syncthreads();
}
struct AGather { const void* base; unsigned kstep; const int* list;
    static constexpr bool GATHER = true;
    __device__ __forceinline__ const void* unit_ptr(const pg8::Unit&) const { return base; }
    __device__ __forceinline__ unsigned lane_off(int, int) const { return 0u; }
    __device__ __forceinline__ size_t hstep() const { return 0; }
    __device__ __forceinline__ unsigned row_off(const pg8::Unit& u, int r) const { const int e = u.e & 255, j = u.e >> 8; const int rr = r < u.nrows ? r : 0;
        const int tk = list[(size_t)e * NTOK + j * 256 + rr]; return (unsigned)(tk >> 1) * (unsigned)(D * 2); } };
struct BGu { const bf16* W; __device__ __forceinline__ const void* ptr(const pg8::Unit& u) const { return W + (size_t)(u.e & 255) * 512 * 1024 + (size_t)u.pn * 256 * 1024; } };
struct BDn { const bf16* W; __device__ __forceinline__ const void* ptr(const pg8::Unit& u) const { return W + (size_t)(u.e & 255) * 1024 * 256 + (size_t)u.pn * 256 * 256; } };
struct EpiAct {
    static constexpr bool PERM = true; bf16* ACT;
    __device__ __forceinline__ void operator()(const f32x4 (&acc)[2][2][4][2], const pg8::Unit& u, int wr, int wc, int fr, int fq) const {
        const int row0 = u.pm * 256 + wr * 64 + fr, col0 = u.pn * 128 + wc * 32 + 8 * fq;
#pragma unroll
        for (int ai = 0; ai < 2; ++ai)
#pragma unroll
            for (int m = 0; m < 4; ++m) { float o[8];
#pragma unroll
                for (int n = 0; n < 2; ++n)
#pragma unroll
                    for (int j = 0; j < 4; ++j) { const float gt = acc[ai][0][m][n][j], up = acc[ai][1][m][n][j]; o[4 * n + j] = gt * sigmoidf_(gt) * up; }
                u32x4 w; w.x = pk2(o[0], o[1]); w.y = pk2(o[2], o[3]); w.z = pk2(o[4], o[5]); w.w = pk2(o[6], o[7]);
                *(u32x4*)(ACT + (size_t)(row0 + ai * 128 + m * 16) * DEXP + col0) = w; }
    }
};
struct EpiDown {
    static constexpr bool PERM = true; bf16* Y; const int* list;
    __device__ __forceinline__ void operator()(const f32x4 (&acc)[2][2][4][2], const pg8::Unit& u, int wr, int wc, int fr, int fq) const {
        const int e = u.e & 255, j = u.e >> 8; const int col0 = u.pn * 256 + wc * 32 + 8 * fq;
        int tks[2][4];
#pragma unroll
        for (int ai = 0; ai < 2; ++ai)
#pragma unroll
            for (int m = 0; m < 4; ++m) { const int r = ai * 128 + wr * 64 + m * 16 + fr; tks[ai][m] = r < u.nrows ? list[(size_t)e * NTOK + j * 256 + r] : -1; }
#pragma unroll
        for (int ai = 0; ai < 2; ++ai)
#pragma unroll
            for (int m = 0; m < 4; ++m) { const int tk = tks[ai][m];
                if (tk >= 0) { bf16* rowp = Y + (size_t)tk * D + col0;
#pragma unroll
                    for (int bj = 0; bj < 2; ++bj) { const f32x4 v0 = acc[ai][bj][m][0], v1 = acc[ai][bj][m][1];
                        u32x4 w; w.x = pk2(v0[0], v0[1]); w.y = pk2(v0[2], v0[3]); w.z = pk2(v1[0], v1[1]); w.w = pk2(v1[2], v1[3]);
                        *(u32x4*)(rowp + bj * 128) = w; } } }
    }
};

__device__ __forceinline__ void phase9(const Frame& F, ArgsR a) {
    unsigned char* ws = F.ws;
    const bf16* H1B = (const bf16*)(ws + WS_H1B); const bf16* Y = (const bf16*)(ws + WS_YBUF); const float* tokinfo = (const float*)(ws + WS_TOKINFO);
    const float* lg = a.in[24]; const float* lb = a.in[25];
    f32x4 gam[4], bet[4];
#pragma unroll
    for (int j = 0; j < 2; ++j) { gam[2 * j] = *(const f32x4*)(lg + 512 * j + 8 * F.lane); gam[2 * j + 1] = *(const f32x4*)(lg + 512 * j + 8 * F.lane + 4); bet[2 * j] = *(const f32x4*)(lb + 512 * j + 8 * F.lane); bet[2 * j + 1] = *(const f32x4*)(lb + 512 * j + 8 * F.lane + 4); }
    const int gw = F.bx * NWAVES + F.wave, NGW = F.G * NWAVES;
    u32x4 nh[2], ny0[2], ny1[2]; float nw0 = 0.f, nw1 = 0.f;
#define P9_LOAD(row_) do { const u32x4* hp_ = (const u32x4*)(H1B + (size_t)(row_) * D) + F.lane; const u32x4* y0_ = (const u32x4*)(Y + (size_t)((row_) * 2) * D) + F.lane; const u32x4* y1_ = (const u32x4*)(Y + (size_t)((row_) * 2 + 1) * D) + F.lane; \
        nh[0] = hp_[0]; nh[1] = hp_[64]; ny0[0] = y0_[0]; ny0[1] = y0_[64]; ny1[0] = y1_[0]; ny1[1] = y1_[64]; nw0 = tokinfo[(row_) * 2]; nw1 = tokinfo[(row_) * 2 + 1]; } while (0)
    if (gw < NTOK) P9_LOAD(gw);
    for (int row = gw; row < NTOK; row += NGW) {
        u32x4 h[2] = {nh[0], nh[1]}, p[2] = {ny0[0], ny0[1]}, q[2] = {ny1[0], ny1[1]}; const float w0 = nw0, w1 = nw1;
        if (row + NGW < NTOK) P9_LOAD(row + NGW);
        f32x4 v[4]; float s = 0.f;
#pragma unroll
        for (int j = 0; j < 2; ++j) {
            v[2 * j][0] = ALPHA * bflo(h[j].x) + w0 * bflo(p[j].x) + w1 * bflo(q[j].x); v[2 * j][1] = ALPHA * bfhi(h[j].x) + w0 * bfhi(p[j].x) + w1 * bfhi(q[j].x);
            v[2 * j][2] = ALPHA * bflo(h[j].y) + w0 * bflo(p[j].y) + w1 * bflo(q[j].y); v[2 * j][3] = ALPHA * bfhi(h[j].y) + w0 * bfhi(p[j].y) + w1 * bfhi(q[j].y);
            v[2 * j + 1][0] = ALPHA * bflo(h[j].z) + w0 * bflo(p[j].z) + w1 * bflo(q[j].z); v[2 * j + 1][1] = ALPHA * bfhi(h[j].z) + w0 * bfhi(p[j].z) + w1 * bfhi(q[j].z);
            v[2 * j + 1][2] = ALPHA * bflo(h[j].w) + w0 * bflo(p[j].w) + w1 * bflo(q[j].w); v[2 * j + 1][3] = ALPHA * bfhi(h[j].w) + w0 * bfhi(p[j].w) + w1 * bfhi(q[j].w); }
#pragma unroll
        for (int j = 0; j < 4; ++j) s += (v[j][0] + v[j][1]) + (v[j][2] + v[j][3]);
        const float mean = wave_sum_dpp(s) * (1.f / D); float s2 = 0.f;
#pragma unroll
        for (int j = 0; j < 4; ++j) { v[j] = v[j] - mean; s2 += (v[j][0] * v[j][0] + v[j][1] * v[j][1]) + (v[j][2] * v[j][2] + v[j][3] * v[j][3]); }
        const float rstd = 1.0f / sqrtf(wave_sum_dpp(s2) * (1.f / D) + 1e-5f);
        float* orow = a.out + (size_t)row * D + 8 * F.lane;
#pragma unroll
        for (int j = 0; j < 2; ++j) { *(f32x4*)(orow + 512 * j) = v[2 * j] * rstd * gam[2 * j] + bet[2 * j]; *(f32x4*)(orow + 512 * j + 4) = v[2 * j + 1] * rstd * gam[2 * j + 1] + bet[2 * j + 1]; }
    }
#undef P9_LOAD
}
#define MFMA32(a, b, c) __builtin_amdgcn_mfma_f32_32x32x16_bf16((a), (b), (c), 0, 0, 0)
__device__ __forceinline__ int crow(int r, int hi) { return (r & 3) + 8 * (r >> 2) + 4 * hi; }
__device__ __forceinline__ float gelu_tanh(float x) { const float u = 0.7978845608028654f * (x + 0.044715f * x * x * x); const float e = __builtin_amdgcn_exp2f(2.885390081777927f * u); return 0.5f * x * (2.0f - 2.0f * __builtin_amdgcn_rcpf(e + 1.0f)); }
constexpr int P2_AROW = 4096 + 16;
constexpr int P2_HID = 32 * P2_AROW;
constexpr int P2_HROW = 512 + 16;
__device__ __forceinline__ void phase2(const Frame& F, ArgsR a) {
    unsigned char* ws = F.ws;
    const bf16* ZA = (const bf16*)(ws + WS_ZA);
    { const float* gn = a.in[8]; bf16* CK = (bf16*)(ws + WS_CKVN);
      const int sub = F.lane >> 4, l16 = F.lane & 15;
      float gv[8];
#pragma unroll
      for (int j = 0; j < 8; ++j) gv[j] = gn[l16 * 8 + j];
      const int r4b = F.bx * NWAVES + F.wave, r4s = F.G * NWAVES;
      for (int r4 = r4b; r4 < NTOK / 4; r4 += 4 * r4s) { u32x4 wv[4];
#pragma unroll
          for (int t = 0; t < 4; ++t) { const int rr = r4 + t * r4s; const int row = (rr < NTOK / 4 ? rr : r4) * 4 + sub; wv[t] = *(const u32x4*)(ZA + (size_t)row * ZA_LD + ZC_CKV + l16 * 8); }
#pragma unroll
          for (int t = 0; t < 4; ++t) { const int rr = r4 + t * r4s; if (rr < NTOK / 4) { const int row = rr * 4 + sub; const u32x4 w = wv[t];
              float v[8] = { bflo(w.x), bfhi(w.x), bflo(w.y), bfhi(w.y), bflo(w.z), bfhi(w.z), bflo(w.w), bfhi(w.w) };
              float s2 = 0.f;
#pragma unroll
              for (int j = 0; j < 8; ++j) s2 += v[j] * v[j];
              s2 += __shfl_xor(s2, 1); s2 += __shfl_xor(s2, 2); s2 += __shfl_xor(s2, 4); s2 += __shfl_xor(s2, 8);
              const float rs = 1.0f / sqrtf(s2 * (1.0f / 128.0f) + 1e-6f);
              u32x4 o; o.x = pk2(v[0] * rs * gv[0], v[1] * rs * gv[1]); o.y = pk2(v[2] * rs * gv[2], v[3] * rs * gv[3]); o.z = pk2(v[4] * rs * gv[4], v[5] * rs * gv[5]); o.w = pk2(v[6] * rs * gv[6], v[7] * rs * gv[7]);
              *(u32x4*)(CK + (size_t)row * 128 + l16 * 8) = o; } } } }
    const int r32 = F.lane & 31, hi = F.lane >> 5;
    for (int u = F.bx; u < 256; u += F.G) {
        const int kv = u >> 7, rt = u & 127, R0 = rt * 32;
        const int zc = kv ? ZC_VC : ZC_KC;
        const bf16* W1T = (const bf16*)(ws + (kv ? WS_W1V : WS_W1K)); const bf16* W2T = (const bf16*)(ws + (kv ? WS_W2V : WS_W2K));
        const float* bias = (const float*)(ws + WS_BIASK) + (size_t)kv * 32 * 256;
        bf16* OUT = (bf16*)(ws + (kv ? WS_VCMP : WS_KCMP));
        __syncthreads();
        { u32x4 av[16];
#pragma unroll
          for (int i = 0; i < 16; ++i) { const int q = F.tid + NTHR * i; const int row = q >> 8, cq = q & 255, l = cq >> 3, dch = cq & 7;
              const int R = R0 + row, b = R >> 9, c = (R >> 1) & 255, g = R & 1; const int cc = c < NCMP ? c : NCMP - 1;
              av[i] = *(const u32x4*)(ZA + (size_t)(b * SEQ + 16 * cc + l) * ZA_LD + zc + g * 64 + dch * 8); }
#pragma unroll
          for (int i = 0; i < 16; ++i) { const int q = F.tid + NTHR * i; const int row = q >> 8, cq = q & 255; *(LAS u32x4*)(F.lds + row * P2_AROW + cq * 16) = av[i]; } }
        __syncthreads();
        f32x16 acc = {};
        { const bf16* bp = W1T + (size_t)(32 * F.wave + r32) * 2048 + 8 * hi; const LAS unsigned char* ap = F.lds + r32 * P2_AROW + 16 * hi;
          f32x16 acc1 = {};
#pragma unroll 1
          for (int s0 = 0; s0 < 128; s0 += 32) { bf16x8 bfr[32];
#pragma unroll
              for (int j = 0; j < 32; ++j) bfr[j] = *(const bf16x8*)(bp + (s0 + j) * 16);
#pragma unroll
              for (int j = 0; j < 32; j += 2) { const bf16x8 a0 = *(const LAS bf16x8*)(ap + (s0 + j) * 32), a1 = *(const LAS bf16x8*)(ap + (s0 + j + 1) * 32); acc = MFMA32(a0, bfr[j], acc); acc1 = MFMA32(a1, bfr[j + 1], acc1); } }
#pragma unroll
          for (int i = 0; i < 16; ++i) acc[i] += acc1[i]; }
        { float bs = 0.f;
#pragma unroll 8
          for (int j = 0; j < 32; ++j) bs += bias[j * 256 + 32 * F.wave + r32];
#pragma unroll
          for (int i = 0; i < 16; ++i) { const float h = gelu_tanh(acc[i] + bs); *(LAS unsigned short*)(F.lds + P2_HID + crow(i, hi) * P2_HROW + (32 * F.wave + r32) * 2) = (unsigned short)f2bf(h); } }
        __syncthreads();
        if (F.wave < 2) {
            f32x16 o2 = {};
            const bf16* bp = W2T + (size_t)(32 * F.wave + r32) * 256 + 8 * hi; const LAS unsigned char* ap = F.lds + P2_HID + r32 * P2_HROW + 16 * hi;
#pragma unroll
            for (int s = 0; s < 16; ++s) { const bf16x8 af = *(const LAS bf16x8*)(ap + s * 32); const bf16x8 bfr = *(const bf16x8*)(bp + s * 16); o2 = MFMA32(af, bfr, o2); }
#pragma unroll
            for (int i = 0; i < 16; ++i) OUT[(size_t)(R0 + crow(i, hi)) * 64 + 32 * F.wave + r32] = (bf16)f2bf(o2[i]);
        }
    }
    __syncthreads();
}

typedef short v4i16_t __attribute__((ext_vector_type(4)));
__device__ __forceinline__ s16x4 vtr(const LAS unsigned char* p) { return __builtin_bit_cast(s16x4, __builtin_amdgcn_ds_read_tr16_b64_v4i16((LAS v4i16_t*)p)); }
constexpr int NSA_K = 0;
constexpr int NSA_V = 16384;
constexpr int NSA_TB = 49152;
constexpr int NSA_TBP = 1032;
constexpr int NSA_SC = 65792;
constexpr int NSA_MSK = 82176;
constexpr int NSA_OF = 84224;
constexpr float C2 = 0.125f * LOG2E;

__device__ __forceinline__ int prefix_cnt(unsigned long long b) { return (int)__builtin_amdgcn_mbcnt_hi((unsigned)(b >> 32), __builtin_amdgcn_mbcnt_lo((unsigned)b, 0u)); }
__device__ __forceinline__ int sbcnt64(unsigned long long m) { int n; asm("s_bcnt1_i32_b64 %0, %1" : "=s"(n) : "s"(m) : "scc"); return n; }
__device__ __forceinline__ float halfmax(float v, int xaddr) { return fmaxf(v, __builtin_bit_cast(float, __builtin_amdgcn_ds_bpermute(xaddr, __builtin_bit_cast(int, v)))); }
__device__ __forceinline__ void nsa_tile(const bool nc4, const LAS unsigned char* Kb, const LAS unsigned char* Vb, const LAS float* tbh, const bf16x8 (&qr)[4], f32x16 (&o)[4], float& m, float& l,
                                         int kt, int tq, int kmul, int kadd, int dmax, bool selbit, int mode, float b31, int r32, int hi, int lane, int xaddr) {
    const int tqa = tq - kadd, qk = kmul == 16 ? (tqa >> 4) : tqa, rem = kmul == 16 ? (tqa & 15) : 0;
    const int ebase = qk - (kt * 64 + 4 * hi);
    const LAS unsigned char* vp0 = Vb + ((lane >> 4) & 1) * 32 + (lane & 3) * 8 + (4 * hi + ((lane & 15) >> 2)) * 64;
    bf16x8 kf[2][4];
#pragma unroll
    for (int hf = 0; hf < 2; ++hf)
#pragma unroll
        for (int d0 = 0; d0 < 4; ++d0) kf[hf][d0] = *(const LAS bf16x8*)(Kb + (2 * d0 + hi) * 1024 + (r32 + 32 * hf) * 16);
#pragma unroll
    for (int hf = 0; hf < 2; ++hf) {
        f32x16 s0 = {};
#pragma unroll
        for (int d0 = 0; d0 < 4; ++d0) asm volatile("" : "+v"(kf[hf][d0]));
#pragma unroll
        for (int d0 = 0; d0 < 4; ++d0) s0 = MFMA32(kf[hf][d0], qr[d0], s0);
        s16x4 vfl[4][2], vfh[4][2];
#pragma unroll
        for (int c = 0; c < 4; ++c) if (c < 2 || nc4)
#pragma unroll
            for (int s2 = 0; s2 < 2; ++s2) { const int s = 2 * hf + s2; vfl[c][s2] = vtr(vp0 + c * 4096 + s * 1024); vfh[c][s2] = vtr(vp0 + c * 4096 + s * 1024 + 512); }
        float tmax, mn, ps = 0.f;
        if (mode == 2) {
            float a0 = fmaxf(fmaxf(s0[0], s0[1]), s0[2]), a1 = fmaxf(fmaxf(s0[3], s0[4]), s0[5]);
            a0 = fmaxf(fmaxf(a0, s0[6]), s0[7]); a1 = fmaxf(fmaxf(a1, s0[8]), s0[9]); a0 = fmaxf(fmaxf(a0, s0[10]), s0[11]); a1 = fmaxf(fmaxf(a1, s0[12]), s0[13]); a0 = fmaxf(fmaxf(a0, s0[14]), s0[15]);
            const float cb = selbit ? b31 : NEGBIG;
            tmax = fmaxf(a0, a1) * C2 + cb;
            tmax = halfmax(tmax, xaddr);
            mn = fmaxf(m, tmax);
            const float cc = cb - mn;
#pragma unroll
            for (int r = 0; r < 16; ++r) { const float p0 = __builtin_amdgcn_exp2f(s0[r] * C2 + cc); s0[r] = p0; ps += p0; }
        } else if (mode == 1) {
            int eb1 = ebase; asm volatile("" : "+v"(eb1));
            const LAS float* tb1 = tbh + (eb1 - 96);
            float bv[16];
#pragma unroll
            for (int r = 0; r < 16; ++r) bv[r] = tb1[96 - ((r & 3) + 8 * (r >> 2) + 32 * hf)];
#pragma unroll
            for (int r = 0; r < 16; ++r) asm volatile("" : "+v"(bv[r]));
            tmax = NEGBIG;
#pragma unroll
            for (int r = 0; r < 16; ++r) { const float x = s0[r] * C2 + bv[r]; s0[r] = x; tmax = fmaxf(tmax, x); }
            tmax = selbit ? tmax : NEGBIG;
            tmax = halfmax(tmax, xaddr);
            mn = fmaxf(m, tmax);
            const float mne = selbit ? mn : 1e30f;
#pragma unroll
            for (int r = 0; r < 16; ++r) { const float p0 = __builtin_amdgcn_exp2f(s0[r] - mne); s0[r] = p0; ps += p0; }
        } else if (mode == 3) {
            int eb1 = ebase; asm volatile("" : "+v"(eb1));
            const LAS float* tb1 = tbh + (eb1 - 96);
            float bv[16];
#pragma unroll
            for (int r = 0; r < 16; ++r) bv[r] = tb1[96 - ((r & 3) + 8 * (r >> 2) + 32 * hf)];
#pragma unroll
            for (int r = 0; r < 16; ++r) asm volatile("" : "+v"(bv[r]));
            tmax = NEGBIG;
#pragma unroll
            for (int r = 0; r < 16; ++r) { const bool valid = (unsigned)(eb1 - ((r & 3) + 8 * (r >> 2) + 32 * hf)) < (unsigned)dmax;
                const float x = valid ? s0[r] * C2 + bv[r] : NEGBIG; s0[r] = x; tmax = fmaxf(tmax, x); }
            tmax = selbit ? tmax : NEGBIG;
            tmax = halfmax(tmax, xaddr);
            mn = fmaxf(m, tmax);
            const float mne = (selbit && mn > -1e29f) ? mn : 1e30f;
#pragma unroll
            for (int r = 0; r < 16; ++r) { const float p0 = __builtin_amdgcn_exp2f(s0[r] - mne); s0[r] = p0; ps += p0; }
        } else {
            tmax = NEGBIG;
            float bv[16];
            int eb0 = ebase; asm volatile("" : "+v"(eb0));
#pragma unroll
            for (int r = 0; r < 16; ++r) { const int dist = __mul24(eb0 - ((r & 3) + 8 * (r >> 2) + 32 * hf), kmul) + rem; int dc = dist < 0 ? 0 : dist; dc = dc > 1023 ? 1023 : dc; bv[r] = tbh[dc]; }
#pragma unroll
            for (int r = 0; r < 16; ++r) asm volatile("" : "+v"(bv[r]));
#pragma unroll
            for (int r = 0; r < 16; ++r) { const int dist = __mul24(eb0 - ((r & 3) + 8 * (r >> 2) + 32 * hf), kmul) + rem;
                const bool valid = selbit && dist >= 0 && dist < dmax;
                const float x = valid ? s0[r] * C2 + bv[r] : NEGBIG;
                s0[r] = x; tmax = fmaxf(tmax, x); }
            tmax = halfmax(tmax, xaddr);
            mn = fmaxf(m, tmax);
#pragma unroll
            for (int r = 0; r < 16; ++r) { const float p0 = s0[r] > -1e29f ? __builtin_amdgcn_exp2f(s0[r] - mn) : 0.f; s0[r] = p0; ps += p0; }
        }
        if (__any(mn != m)) {
            const float alpha = __builtin_amdgcn_exp2f(m - mn);
            l *= alpha;
#pragma unroll
            for (int c = 0; c < 4; ++c) if (c < 2 || nc4) {
#pragma unroll
                for (int r = 0; r < 16; ++r) o[c][r] *= alpha; }
        }
        m = mn;
        l += ps;
        u32x4 pw[2];
#pragma unroll
        for (int q = 0; q < 4; ++q) { pw[0][q] = pk2(s0[2 * q], s0[2 * q + 1]); pw[1][q] = pk2(s0[8 + 2 * q], s0[8 + 2 * q + 1]); }
#pragma unroll
        for (int c = 0; c < 4; ++c) if (c < 2 || nc4)
#pragma unroll
            for (int s2 = 0; s2 < 2; ++s2) { const s16x4 vl = vfl[c][s2], vh = vfh[c][s2];
                const bf16x8 vf = {vl[0], vl[1], vl[2], vl[3], vh[0], vh[1], vh[2], vh[3]};
                o[c] = MFMA32(vf, __builtin_bit_cast(bf16x8, pw[s2]), o[c]); }
    }
}

__device__ __forceinline__ void nsa_unit(const Frame& F, int b, int g, int qt) {
    unsigned char* ws = F.ws;
    const bf16* ZA = (const bf16*)(ws + WS_ZA);
    const int r32 = F.lane & 31, hi = F.lane >> 5, qi = r32 >> 2, hh = r32 & 3, head = g * 4 + hh;
    const int q0 = qt * 64, tq = q0 + 8 * F.wave + qi;
    const size_t zrow = (size_t)(b * SEQ + tq) * ZA_LD;
    const int srow = F.tid >> 3, sch = F.tid & 7;
    const f32x4* TBA4 = (const f32x4*)((const float*)(ws + WS_TBA) + (size_t)g * 4 * 1024);
    const f32x4 tbv0 = TBA4[F.tid], tbv1 = TBA4[F.tid + NTHR];
    const LAS float* tbh = (const LAS float*)(F.lds + NSA_TB) + hh * NSA_TBP;
    const int wq0 = q0 + 8 * F.wave;
    const float b31 = ((const float*)(ws + WS_TBA))[(size_t)head * 1024 + 1023];
    bf16x8 qr[4];
#pragma unroll
    for (int d0 = 0; d0 < 4; ++d0) qr[d0] = *(const bf16x8*)(ZA + zrow + ZC_QA + head * 64 + d0 * 16 + hi * 8);
    unsigned short graw[3];
#pragma unroll
    for (int i = 0; i < 3; ++i) graw[i] = ZA[zrow + ZC_GNSA + head * 3 + i];
    { LAS f32x4* tb4 = (LAS f32x4*)(F.lds + NSA_TB) + (F.tid >> 8) * (NSA_TBP / 4) + (F.tid & 255); tb4[0] = tbv0; tb4[2 * (NSA_TBP / 4)] = tbv1; }
    float gate[3];
#pragma unroll
    for (int i = 0; i < 3; ++i) gate[i] = sigmoidf_(bf2f(graw[i]));
    LAS float* ofw = (LAS float*)(F.lds + NSA_OF) + F.wave * 2048 + F.lane;
    unsigned mlo = 0u, mhi = 0u;
    const int xaddr = (F.lane ^ 32) << 2;
    u32x4 kreg, vreg = {0u, 0u, 0u, 0u};
    const bf16* kgp; size_t vdel, tstep;
#define NSA_SETUP(br_) do { const int b_ = (br_); const bf16* Kg_; size_t pitch_; int tl_; \
        if (b_ == 0) { Kg_ = (const bf16*)(ws + WS_KCMP) + (size_t)(b * 256) * 128 + g * 64; vdel = (size_t)((const bf16*)(ws + WS_VCMP) - (const bf16*)(ws + WS_KCMP)); pitch_ = 128; tl_ = 0; } \
        else { Kg_ = ZA + (size_t)(b * SEQ) * ZA_LD + (b_ == 1 ? ZC_KS : ZC_KW) + g * 64; vdel = 128; pitch_ = ZA_LD; tl_ = (b_ == 2 && qt > 8) ? qt - 8 : 0; } \
        kgp = Kg_ + (size_t)(tl_ * 64 + srow) * pitch_ + sch * 8; tstep = (size_t)64 * pitch_; } while (0)
#define NSA_GLOAD(kt_) do { kreg = *(const u32x4*)kgp; vreg = *(const u32x4*)(kgp + vdel); kgp += tstep; } while (0)
    NSA_SETUP(0); NSA_GLOAD(0);
#pragma nounroll
    for (int br = 0; br < 3; ++br) {
        const bool iscmp = br == 0;
        const int t_lo = iscmp ? 0 : ((br == 2 && qt > 8) ? qt - 8 : 0), t_hi = iscmp ? ((q0 + 32) >> 10) : qt;
        const int kmul = iscmp ? 16 : 1, kadd = iscmp ? 31 : 0, dmax = br == 2 ? 512 : 0x40000000;
        f32x16 o[4]; o[0] = f32x16{}; o[1] = f32x16{}; o[2] = f32x16{}; o[3] = f32x16{};
        float m = NEGBIG, l = 0.f;
#define NSA_LSTORE(kt_, buf_) do { \
        *(LAS u32x4*)(F.lds + NSA_K + (buf_) * 8192 + sch * 1024 + srow * 16) = kreg; \
        *(LAS u32x4*)(F.lds + NSA_V + (buf_) * 16384 + (sch >> 2) * 4096 + srow * 64 + (sch & 3) * 16) = vreg; \
        if (iscmp) { const int c_ = (kt_) * 64 + srow, jj_ = c_ >> 2, mm_ = c_ & 3; u32x4 mv_; \
            _Pragma("unroll") for (int i_ = 0; i_ < 4; ++i_) { const int j0_ = sch * 8 + 2 * i_, j1_ = j0_ + 1; \
                const unsigned e0_ = (c_ < NCMP) ? (mm_ < 3 ? (j0_ == jj_ ? 0x4000u : 0u) : ((j0_ == jj_ || j0_ == jj_ + 1) ? 0x3F80u : 0u)) : 0u; \
                const unsigned e1_ = (c_ < NCMP) ? (mm_ < 3 ? (j1_ == jj_ ? 0x4000u : 0u) : ((j1_ == jj_ || j1_ == jj_ + 1) ? 0x3F80u : 0u)) : 0u; \
                mv_[i_] = e0_ | (e1_ << 16); } \
            *(LAS u32x4*)(F.lds + NSA_V + (buf_) * 16384 + (2 + (sch >> 2)) * 4096 + srow * 64 + (sch & 3) * 16) = mv_; } } while (0)
        NSA_LSTORE(t_lo, 0);
        __syncthreads();
        int buf = 0;
#pragma nounroll
        for (int kt = t_lo; kt <= t_hi; ++kt) {
            const int ktn = kt + 1; const bool more = kt < t_hi;
            if (more) NSA_GLOAD(ktn);
            const bool selbit = br == 1 ? (((kt < 32 ? (mlo >> kt) : (mhi >> (kt - 32))) & 1u) != 0u) : true;
            int mode = 0;
            { const int dmin = wq0 - (64 * kt + 63), dmx = wq0 + 7 - 64 * kt;
              if (br == 1) mode = dmin >= 790 ? 2 : (dmin >= 0 ? 1 : 3);
              if (br == 0) mode = 16 * (((wq0 - 31) >> 4) - (64 * kt + 63)) >= 790 ? 2 : 0;
              if (br == 2) mode = (dmin >= 0 && dmx <= 511) ? 1 : 3; }
            if (__any(selbit))
                nsa_tile(iscmp, F.lds + NSA_K + buf * 8192, F.lds + NSA_V + buf * 16384, tbh, qr, o, m, l, kt, tq, kmul, kadd, dmax, selbit, mode, b31, r32, hi, F.lane, xaddr);
            if (more) NSA_LSTORE(ktn, buf ^ 1);
            __syncthreads();
            buf ^= 1;
        }
#undef NSA_LSTORE
        if (br < 2) { NSA_SETUP(br + 1); NSA_GLOAD(0); }
        l += __shfl_xor(l, 32);
        const float inv = l > 0.f ? 1.0f / l : 0.f;
        { const float sc = inv * (br == 0 ? gate[0] : br == 1 ? gate[1] : gate[2]);
#pragma unroll
            for (int c = 0; c < 2; ++c)
#pragma unroll
                for (int r = 0; r < 16; ++r) { const float prev = br == 0 ? 0.f : ofw[(c * 16 + r) * 64]; ofw[(c * 16 + r) * 64] = prev + o[c][r] * sc; } }
        if (iscmp) {
            LAS float* scw = (LAS float*)(F.lds + NSA_SC) + F.wave * 512;
#pragma unroll
            for (int c = 0; c < 2; ++c)
#pragma unroll
                for (int r = 0; r < 16; ++r) { float v = o[2 + c][r] * inv;
                    v += __builtin_bit_cast(float, __builtin_amdgcn_update_dpp(0, __builtin_bit_cast(int, v), 0xB1, 0xf, 0xf, true));
                    v += __builtin_bit_cast(float, __builtin_amdgcn_update_dpp(0, __builtin_bit_cast(int, v), 0x4E, 0xf, 0xf, true));
                    if (hh == 0) scw[qi * 64 + 32 * c + crow(r, hi)] = v; }
            LDS_WAIT();
            LAS unsigned* mskw = (LAS unsigned*)(F.lds + NSA_MSK) + F.wave * 16;
#pragma nounroll
            for (int q = 0; q < 8; q += 2) {
                unsigned key[2]; bool av[2];
#pragma unroll
                for (int u = 0; u < 2; ++u) { const int curq = (q0 + 8 * F.wave + q + u) >> 6, j = F.lane;
                    av[u] = j <= curq; const bool forced = (j == 0) || (j == curq) || (j == curq - 1);
                    const float sj = scw[(q + u) * 64 + j] + (forced ? 1e4f : 0.f);
                    key[u] = av[u] ? __builtin_bit_cast(unsigned, sj + 0.0f) + 1u : 0u; }
                unsigned T0 = 0u, T1 = 0u;
#pragma unroll
                for (int bit = 30; bit >= 0; --bit) { const unsigned c0 = T0 | (1u << bit), c1 = T1 | (1u << bit);
                    const int n0 = sbcnt64(__ballot(key[0] >= c0)), n1 = sbcnt64(__ballot(key[1] >= c1));
                    T0 = n0 >= 16 ? c0 : T0; T1 = n1 >= 16 ? c1 : T1; }
#pragma unroll
                for (int u = 0; u < 2; ++u) { const unsigned T = u ? T1 : T0;
                    const bool gt = key[u] > T, eq = key[u] == T;
                    const int need = 16 - sbcnt64(__ballot(gt));
                    const bool sel = (gt || (eq && prefix_cnt(__ballot(eq)) < need)) && av[u];
                    const unsigned long long bm = __ballot(sel);
                    if (F.lane == 0) { mskw[2 * (q + u)] = (unsigned)bm; mskw[2 * (q + u) + 1] = (unsigned)(bm >> 32); } } }
            LDS_WAIT();
            mlo = mskw[2 * qi]; mhi = mskw[2 * qi + 1];
        }
    }
#undef NSA_GLOAD
#undef NSA_SETUP
    bf16* OA = (bf16*)(ws + WS_OA) + (size_t)(b * SEQ + tq) * 512 + head * 64;
#pragma unroll
    for (int c = 0; c < 2; ++c)
#pragma unroll
        for (int r4 = 0; r4 < 4; ++r4) { u32x2 w; w.x = pk2(ofw[(c * 16 + 4 * r4) * 64], ofw[(c * 16 + 4 * r4 + 1) * 64]); w.y = pk2(ofw[(c * 16 + 4 * r4 + 2) * 64], ofw[(c * 16 + 4 * r4 + 3) * 64]);
            *(u32x2*)(OA + 32 * c + 8 * r4 + 4 * hi) = w; }
}
__device__ __forceinline__ void phase3(const Frame& F) {
    const bool xcd = (F.G == 256);
    const int pstart = xcd ? (F.bx >> 3) : F.bx, pstep = xcd ? 32 : F.G, pend = xcd ? 64 : 512;
#pragma nounroll
    for (int p2 = 2 * pstart; p2 < 2 * pend; p2 += (p2 & 1) ? 2 * pstep - 1 : 1) { const int p = p2 >> 1;
        const int b = xcd ? (F.bx & 7) : (p >> 6), g = (p >> 5) & 1, qt = p & 31;
        nsa_unit(F, b, g, (p2 & 1) ? qt : 63 - qt); }
    __syncthreads();
}

#define MFMA16(a, b, c) __builtin_amdgcn_mfma_f32_16x16x32_bf16((a), (b), (c), 0, 0, 0)
constexpr int DSA_SCP = 8200;
constexpr int DSA_SC = 0;
constexpr int DSA_LIST = 16 * DSA_SCP;
constexpr int DSA_NSEL = DSA_LIST + 8192;
constexpr int DSA_BIAS = DSA_NSEL + 64;
constexpr int DSA_HIST = DSA_BIAS + 1088;
constexpr int DSA_BKI = DSA_HIST + 8192;
constexpr int KSEL = 256;
__device__ __forceinline__ unsigned dsa_offb(unsigned row, unsigned ch) { return 256u * row + 16u * (ch ^ (((row & 3u) << 2) | ((row >> 2) & 3u))); }
__device__ __forceinline__ unsigned sortkey16(float x) { x = x + 0.0f; const unsigned short h = __builtin_bit_cast(unsigned short, (_Float16)x); return (h & 0x8000u) ? (unsigned)(unsigned short)~h : (unsigned)(h | 0x8000u); }

__device__ __forceinline__ void dsa_unit(const Frame& F, ArgsR a, int b, int qt16) {
    unsigned char* ws = F.ws;
    const bf16* ZA = (const bf16*)(ws + WS_ZA);
    const int lane = F.lane, l16 = lane & 15, quad = lane >> 4, q0 = qt16 * 16;
    __syncthreads();
#ifndef PROBE_DSA
#define PROBE_DSA 0
#endif
    for (int rep1_ = 0; rep1_ < (PROBE_DSA == 1 ? 2 : 1); ++rep1_) {
        const size_t qrow = (size_t)(b * SEQ + q0 + l16) * ZA_LD;
        bf16x8 qf[4][2];
#pragma unroll
        for (int i = 0; i < 4; ++i)
#pragma unroll
            for (int ks = 0; ks < 2; ++ks) qf[i][ks] = *(const bf16x8*)(ZA + qrow + ZC_QIDX + i * 64 + 32 * ks + 8 * quad);
        float wq[4];
#pragma unroll
        for (int i = 0; i < 4; ++i) wq[i] = bf2f(ZA[qrow + ZC_WIDX + i]) * 0.0625f;
        const int tq = q0 + l16, nkt = qt16 + 1;
        const bf16* kbase = ZA + (size_t)(b * SEQ + l16) * ZA_LD + ZC_KIDX + 8 * quad;
        bf16x8 ka[4][2], kn[4][2];
#define DSA_KLOAD(dst, kt0_) do { _Pragma("unroll") for (int t_ = 0; t_ < 4; ++t_) { const int k_ = (kt0_) + 8 * t_; const int kc_ = k_ < nkt ? k_ : nkt - 1; \
            dst[t_][0] = *(const bf16x8*)(kbase + (size_t)(kc_ * 16) * ZA_LD); dst[t_][1] = *(const bf16x8*)(kbase + (size_t)(kc_ * 16) * ZA_LD + 32); } } while (0)
        if (F.wave < nkt) DSA_KLOAD(ka, F.wave);
#pragma nounroll
        for (int kt0 = F.wave; kt0 < nkt; kt0 += 32) {
            if (kt0 + 32 < nkt) DSA_KLOAD(kn, kt0 + 32);
#pragma unroll
            for (int t = 0; t < 4; ++t) { const int kt = kt0 + 8 * t;
                if (kt < nkt) {
                    float idx[4] = {0.f, 0.f, 0.f, 0.f};
#pragma unroll
                    for (int i = 0; i < 4; ++i) { f32x4 acc = {0.f, 0.f, 0.f, 0.f}; acc = MFMA16(ka[t][0], qf[i][0], acc); acc = MFMA16(ka[t][1], qf[i][1], acc);
#pragma unroll
                        for (int r = 0; r < 4; ++r) idx[r] += fmaxf(acc[r], 0.f) * wq[i]; }
                    unsigned k16[4];
#pragma unroll
                    for (int r = 0; r < 4; ++r) { const int key = kt * 16 + 4 * quad + r; k16[r] = key <= tq ? sortkey16(idx[r]) : 0u; }
                    u32x2 w; w.x = k16[0] | (k16[1] << 16); w.y = k16[2] | (k16[3] << 16);
                    *(LAS u32x2*)(F.lds + DSA_SC + l16 * DSA_SCP + (kt * 16 + 4 * quad) * 2) = w; } }
#pragma unroll
            for (int t = 0; t < 4; ++t) { ka[t][0] = kn[t][0]; ka[t][1] = kn[t][1]; }
        }
#undef DSA_KLOAD
    }
    if (F.tid < 264) { const float* rb = a.in[11]; ((LAS float*)(F.lds + DSA_BIAS))[F.tid] = F.tid < 256 ? rb[(F.tid >> 3) * 16 + 8 + (F.tid & 7)] * LOG2E : NEGBIG; }
    __syncthreads();
    bf16x8 ql[2][4];
#pragma unroll
    for (int qq = 0; qq < 2; ++qq)
#pragma unroll
        for (int s2 = 0; s2 < 4; ++s2) { const bf16x8 v = *(const bf16x8*)(ZA + (size_t)(b * SEQ + q0 + 2 * F.wave + qq) * ZA_LD + ZC_QLAT + (l16 & 7) * 128 + 32 * s2 + 8 * quad); ql[qq][s2] = l16 < 8 ? v : (bf16x8){0, 0, 0, 0, 0, 0, 0, 0}; }
#pragma nounroll
    for (int qq = 0; qq < (PROBE_DSA == 2 ? 4 : 2); ++qq) {
        const int n = 2 * F.wave + (qq & 1), tq = q0 + n, N = tq + 1;
        LAS unsigned char* scq = F.lds + DSA_SC + n * DSA_SCP;
        LAS unsigned short* lst = (LAS unsigned short*)(F.lds + DSA_LIST) + n * 256;
        LAS unsigned short* bki = (LAS unsigned short*)(F.lds + DSA_BKI) + n * 256;
        if (N <= KSEL) {
            for (int s = lane; s < KSEL; s += 64) lst[s] = (unsigned short)(s < N ? s : 0);
            if (lane == 0) ((LAS int*)(F.lds + DSA_NSEL))[n] = N;
        } else {
            const int nit = (N + 255) >> 8;
            { const int it = nit - 1; const int s0 = 4 * (lane + 64 * it); u32x2 w = *(LAS u32x2*)(scq + s0 * 2);
              if (s0 + 0 > tq) w.x &= 0xffff0000u; if (s0 + 1 > tq) w.x &= 0x0000ffffu; if (s0 + 2 > tq) w.y &= 0xffff0000u; if (s0 + 3 > tq) w.y &= 0x0000ffffu;
              *(LAS u32x2*)(scq + s0 * 2) = w; }
            LDS_WAIT();
            LAS unsigned* hist = (LAS unsigned*)(F.lds + DSA_HIST) + F.wave * 256;
            unsigned T = 0u; int cgt = 0; int need = KSEL;
#pragma nounroll
            for (int lvl = 0; lvl < 2; ++lvl) {
                *(LAS u32x4*)(hist + 4 * lane) = (u32x4){0u, 0u, 0u, 0u};
                LDS_WAIT();
#pragma nounroll
                for (int it = 0; it < nit; ++it) { const u32x2 w = *(LAS u32x2*)(scq + (lane + 64 * it) * 8);
                    const unsigned k[4] = {w.x & 0xffffu, w.x >> 16, w.y & 0xffffu, w.y >> 16};
#pragma unroll
                    for (int e = 0; e < 4; ++e) { const bool in = lvl == 0 ? true : (k[e] >> 8) == (T >> 8); const unsigned bin = lvl == 0 ? (k[e] >> 8) : (k[e] & 255u);
                        if (in) __hip_atomic_fetch_add(hist + bin, 1u, __ATOMIC_RELAXED, __HIP_MEMORY_SCOPE_WORKGROUP); } }
                LDS_WAIT();
                const u32x4 h = *(LAS u32x4*)(hist + 4 * lane);
                const int sl = (int)(h.x + h.y + h.z + h.w); int suf = sl;
#pragma unroll
                for (int d = 1; d < 64; d <<= 1) { const int o = __shfl_down(suf, d); suf += (lane + d < 64) ? o : 0; }
                const int above = suf - sl;
                const bool here = above < need && above + sl >= need;
                int bsel = 4 * lane + 3, ca = above;
                if (ca + (int)h.w < need) { ca += (int)h.w; bsel = 4 * lane + 2; if (ca + (int)h.z < need) { ca += (int)h.z; bsel = 4 * lane + 1; if (ca + (int)h.y < need) { ca += (int)h.y; bsel = 4 * lane; } } }
                const unsigned long long bm = __ballot(here);
                const int src = bm ? (int)__builtin_ctzll(bm) : 0;
                const int B = __shfl(bsel, src), CA = __shfl(ca, src);
                if (lvl == 0) T = (unsigned)B << 8; else T |= (unsigned)B;
                cgt += CA; need -= CA;
                LDS_WAIT();
            }
            const int rties = KSEL - cgt;
            int tiebase = 0, outbase = 0;
#define DSA_PUT(pos_, idx_) do { const int p_ = (pos_); if (p_ >= 0 && p_ < KSEL) lst[p_] = (unsigned short)(idx_); } while (0)
#pragma nounroll
            for (int it = 0; it < nit; ++it) { const u32x2 w = *(LAS u32x2*)(scq + (lane + 64 * it) * 8);
                const unsigned k0 = w.x & 0xffffu, k1 = w.x >> 16, k2 = w.y & 0xffffu, k3 = w.y >> 16;
                const int sidx = 4 * (lane + 64 * it);
                const bool g0 = k0 > T, g1 = k1 > T, g2 = k2 > T, g3 = k3 > T;
                const unsigned long long bg0 = __ballot(g0), bg1 = __ballot(g1), bg2 = __ballot(g2), bg3 = __ballot(g3);
                if (bg0 | bg1 | bg2 | bg3) {
                    int pos = outbase + prefix_cnt(bg0) + prefix_cnt(bg1) + prefix_cnt(bg2) + prefix_cnt(bg3);
                    if (g0) { DSA_PUT(pos, sidx + 0); ++pos; }
                    if (g1) { DSA_PUT(pos, sidx + 1); ++pos; }
                    if (g2) { DSA_PUT(pos, sidx + 2); ++pos; }
                    if (g3) { DSA_PUT(pos, sidx + 3); ++pos; }
                    outbase += __popcll(bg0) + __popcll(bg1) + __popcll(bg2) + __popcll(bg3); }
                const bool e0 = k0 == T, e1 = k1 == T, e2 = k2 == T, e3 = k3 == T;
                const unsigned long long be0 = __ballot(e0), be1 = __ballot(e1), be2 = __ballot(e2), be3 = __ballot(e3);
                if ((be0 | be1 | be2 | be3) && tiebase < rties) {
                    const int t0 = tiebase + prefix_cnt(be0) + prefix_cnt(be1) + prefix_cnt(be2) + prefix_cnt(be3), t1 = t0 + (e0 ? 1 : 0), t2 = t1 + (e1 ? 1 : 0), t3 = t2 + (e2 ? 1 : 0);
                    if (e0 && t0 < rties) DSA_PUT(KSEL - 1 - t0, sidx + 0);
                    if (e1 && t1 < rties) DSA_PUT(KSEL - 1 - t1, sidx + 1);
                    if (e2 && t2 < rties) DSA_PUT(KSEL - 1 - t2, sidx + 2);
                    if (e3 && t3 < rties) DSA_PUT(KSEL - 1 - t3, sidx + 3);
                    tiebase += __popcll(be0) + __popcll(be1) + __popcll(be2) + __popcll(be3); } }
#undef DSA_PUT
            outbase = KSEL;
            if (lane == 0) ((LAS int*)(F.lds + DSA_NSEL))[n] = outbase < KSEL ? outbase : KSEL;
        }
        LDS_WAIT();
        { const int nsl = N < KSEL ? N : KSEL;
#pragma unroll
          for (int i = 0; i < 4; ++i) { const int e = lane + 64 * i; const int dist = tq - (int)lst[e];
              const int dpos = dist < 1 ? 1 : dist; int bl = 16 + (int)((__log2f((float)dpos) - 4.0f) * 2.66666675f); bl = bl > 31 ? 31 : bl;
              const int bk = dist < 1 ? 0 : (dpos < 16 ? dpos : bl);
              bki[e] = (unsigned short)(e < nsl ? bk * 32 : 1024); } }
    }
    LDS_WAIT();
    const bf16* CK = (const bf16*)(ws + WS_CKVN) + (size_t)(b * SEQ) * 128;
    LAS unsigned char* gb0 = F.lds + DSA_SC + (2 * F.wave) * DSA_SCP;
    const LAS unsigned char* biasb = F.lds + DSA_BIAS + (l16 & 7) * 4;
#define DSA_GATHER(chunk_, buf_) do { const unsigned key_ = lst[(chunk_) * 32 + (lane >> 1)]; const char* src_ = (const char*)CK + (key_ * 256u + (unsigned)(lane & 1) * 16u); \
        _Pragma("unroll") for (int c_ = 0; c_ < 8; ++c_) __builtin_amdgcn_global_load_lds((const unsigned*)(src_ + c_ * 32), (LAS unsigned*)(gb0 + (buf_) * 8192 + c_ * 1024), 16, 0, 0); } while (0)
    int tqs[2], nsels[2]; const LAS unsigned short* lsts[2]; const LAS unsigned short* bkis[2]; f32x4 o[2][8]; float ms[2], ls[2];
#pragma unroll
    for (int qq = 0; qq < 2; ++qq) { const int n = 2 * F.wave + qq; tqs[qq] = q0 + n; nsels[qq] = ((const LAS int*)(F.lds + DSA_NSEL))[n]; lsts[qq] = (const LAS unsigned short*)(F.lds + DSA_LIST) + n * 256; bkis[qq] = (const LAS unsigned short*)(F.lds + DSA_BKI) + n * 256;
#pragma unroll
        for (int c = 0; c < 8; ++c) o[qq][c] = (f32x4){0.f, 0.f, 0.f, 0.f};
        ms[qq] = NEGBIG; ls[qq] = 0.f; }
#pragma unroll
    for (int qq = 0; qq < 2; ++qq)
#pragma unroll
        for (int s2 = 0; s2 < 4; ++s2) asm volatile("" : "+v"(ql[qq][s2]));
    const int nch1 = (nsels[1] + 31) >> 5, nch = PROBE_DSA == 3 ? 2 * nch1 : nch1;
    LDS_WAIT();
    { const LAS unsigned short* lst = lsts[0]; DSA_GATHER(0, 0); }
    { const LAS unsigned short* lst = lsts[1]; DSA_GATHER(0, 1); }
    const unsigned offA = (unsigned)((quad >> 1) * 1024 + l16 * 32 + (quad & 1) * 16);
    const unsigned offT = (unsigned)((4 * quad + (l16 >> 2)) * 32 + 8 * (lane & 3));
#pragma nounroll
    for (int ch = 0; ch < nch; ++ch) {
#pragma unroll
        for (int qq = 0; qq < 2; ++qq) {
            const int chd = ch >= nch1 ? ch - nch1 : ch;
            const LAS unsigned short* lst = lsts[qq];
            const LAS unsigned char* gb = gb0 + qq * 8192;
            if (qq == 0 || ch + 1 < nch) asm volatile("s_waitcnt vmcnt(8)" ::: "memory"); else asm volatile("s_waitcnt vmcnt(0)" ::: "memory");
            f32x4 acc2[2]; float bvs[2][4];
#pragma unroll
            for (int rb = 0; rb < 2; ++rb) { f32x4 acc = {0.f, 0.f, 0.f, 0.f};
#pragma unroll
                for (int s2 = 0; s2 < 4; ++s2) { const bf16x8 af = *(const LAS bf16x8*)(gb + offA + rb * 512 + s2 * 2048); acc = MFMA16(af, ql[qq][s2], acc); }
                acc2[rb] = acc;
                const u32x2 kb = *(const LAS u32x2*)((const LAS unsigned char*)bkis[qq] + (chd * 32 + rb * 16 + 4 * quad) * 2);
                bvs[rb][0] = *(const LAS float*)(biasb + (kb.x & 0xffffu)); bvs[rb][1] = *(const LAS float*)(biasb + (kb.x >> 16));
                bvs[rb][2] = *(const LAS float*)(biasb + (kb.y & 0xffffu)); bvs[rb][3] = *(const LAS float*)(biasb + (kb.y >> 16)); }
#pragma unroll
            for (int rb = 0; rb < 2; ++rb)
#pragma unroll
                for (int r = 0; r < 4; ++r) asm volatile("" : "+v"(bvs[rb][r]));
            float x[2][4]; float tmax = NEGBIG;
#pragma unroll
            for (int rb = 0; rb < 2; ++rb)
#pragma unroll
                for (int r = 0; r < 4; ++r) { const float xv = acc2[rb][r] * C2 + bvs[rb][r]; x[rb][r] = xv; tmax = fmaxf(tmax, xv); }
            tmax = fmaxf(tmax, __shfl_xor(tmax, 16)); tmax = fmaxf(tmax, __shfl_xor(tmax, 32));
            const float mn = fmaxf(ms[qq], tmax); const bool resc = __any(mn != ms[qq]); const float alpha = __builtin_amdgcn_exp2f(ms[qq] - mn); ms[qq] = mn;
            float ps = 0.f;
#pragma unroll
            for (int rb = 0; rb < 2; ++rb)
#pragma unroll
                for (int r = 0; r < 4; ++r) { const float pv = __builtin_amdgcn_exp2f(x[rb][r] - mn); x[rb][r] = pv; ps += pv; }
            ls[qq] = ls[qq] * alpha + ps;
            if (resc) {
#pragma unroll
                for (int c = 0; c < 8; ++c) o[qq][c] = o[qq][c] * alpha; }
            u32x4 pw; pw.x = pk2(x[0][0], x[0][1]); pw.y = pk2(x[0][2], x[0][3]); pw.z = pk2(x[1][0], x[1][1]); pw.w = pk2(x[1][2], x[1][3]);
            const unsigned gba = (unsigned)(unsigned long long)gb + offT;
#pragma unroll
            for (int cb = 0; cb < 2; ++cb) {
                s16x4 v[8];
                if (cb == 0) asm volatile("ds_read_b64_tr_b16 %0, %8\n\tds_read_b64_tr_b16 %1, %8 offset:512\n\tds_read_b64_tr_b16 %2, %8 offset:1024\n\tds_read_b64_tr_b16 %3, %8 offset:1536\n\t"
                             "ds_read_b64_tr_b16 %4, %8 offset:2048\n\tds_read_b64_tr_b16 %5, %8 offset:2560\n\tds_read_b64_tr_b16 %6, %8 offset:3072\n\tds_read_b64_tr_b16 %7, %8 offset:3584\n\ts_waitcnt lgkmcnt(0)"
                             : "=&v"(v[0]), "=&v"(v[1]), "=&v"(v[2]), "=&v"(v[3]), "=&v"(v[4]), "=&v"(v[5]), "=&v"(v[6]), "=&v"(v[7]) : "v"(gba) : "memory");
                else asm volatile("ds_read_b64_tr_b16 %0, %8 offset:4096\n\tds_read_b64_tr_b16 %1, %8 offset:4608\n\tds_read_b64_tr_b16 %2, %8 offset:5120\n\tds_read_b64_tr_b16 %3, %8 offset:5632\n\t"
                             "ds_read_b64_tr_b16 %4, %8 offset:6144\n\tds_read_b64_tr_b16 %5, %8 offset:6656\n\tds_read_b64_tr_b16 %6, %8 offset:7168\n\tds_read_b64_tr_b16 %7, %8 offset:7680\n\ts_waitcnt lgkmcnt(0)"
                             : "=&v"(v[0]), "=&v"(v[1]), "=&v"(v[2]), "=&v"(v[3]), "=&v"(v[4]), "=&v"(v[5]), "=&v"(v[6]), "=&v"(v[7]) : "v"(gba) : "memory");
#pragma unroll
                for (int c4 = 0; c4 < 4; ++c4) { const int c = 4 * cb + c4; const s16x4 v0 = v[2 * c4], v1 = v[2 * c4 + 1];
                    const bf16x8 vf = {v0[0], v0[1], v0[2], v0[3], v1[0], v1[1], v1[2], v1[3]};
                    o[qq][c] = MFMA16(vf, __builtin_bit_cast(bf16x8, pw), o[qq][c]); }
            }
            LDS_WAIT();
            if (ch + 1 < nch) DSA_GATHER((ch + 1 >= nch1 ? ch + 1 - nch1 : ch + 1), qq);
        }
    }
#pragma unroll
    for (int qq = 0; qq < 2; ++qq) {
        float l = ls[qq]; const int tq = tqs[qq];
        l += __shfl_xor(l, 16); l += __shfl_xor(l, 32);
        const float inv = l > 0.f ? 1.0f / l : 0.f;
        if (l16 < 8) { bf16* op = (bf16*)(ws + WS_OLAT) + (size_t)(b * SEQ + tq) * 1024 + l16 * 128 + 4 * quad;
#pragma unroll
            for (int c = 0; c < 8; ++c) { u32x2 w; w.x = pk2(o[qq][c][0] * inv, o[qq][c][1] * inv); w.y = pk2(o[qq][c][2] * inv, o[qq][c][3] * inv); *(u32x2*)(op + 16 * c) = w; } }
    }
}
#undef DSA_GATHER
__device__ __forceinline__ void phase4(const Frame& F, ArgsR a) {
    const bool xcd = (F.G == 256);
    const int pstart = xcd ? (F.bx >> 3) : F.bx, pstep = xcd ? 32 : F.G, pend = xcd ? 128 : 1024;
#pragma nounroll
    for (int p2 = 2 * pstart; p2 < 2 * pend; p2 += (p2 & 1) ? 2 * pstep - 1 : 1) { const int p = p2 >> 1;
        const int b = xcd ? (F.bx & 7) : (p >> 7), j = p & 127;
        dsa_unit(F, a, b, (p2 & 1) ? j : 255 - j); }
    __syncthreads();
}

constexpr int NPHASE = 11;
__global__ void __launch_bounds__(NTHR, 2) fwd_kernel(Args args_by_value) {
    ArgsR args = *(const __attribute__((address_space(4))) Args*)__builtin_amdgcn_kernarg_segment_ptr();
    extern __shared__ __attribute__((aligned(16))) unsigned char lds_raw[];
    Frame F;
    F.lds = (LAS unsigned char*)lds_raw;
    F.tid = threadIdx.x; F.lane = F.tid & 63; F.wave = __builtin_amdgcn_readfirstlane(F.tid >> 6);
    F.G = gridDim.x; F.bx = blockIdx.x; F.ws = args.ws;
    unsigned char* ws = args.ws;
    volatile LAS unsigned* MISC = (volatile LAS unsigned*)(F.lds + MISC_OFF);
    if (F.tid < 64) MISC[F.tid] = 0u;
    __syncthreads();
    const int lo = args.ph_lo, hi = args.ph_hi;
    XcdBarrier bar; bar.bar = (unsigned*)(ws + WS_CTL) + CW_BAR; bar.x = 0; bar.st = nullptr;
    if (hi - lo > 1) bar = xcd_barrier_post((unsigned*)(ws + WS_CTL) + CW_BAR, MISC + 8);
#ifndef PH_MASK
#define PH_MASK 0xFFFF
#endif
#define IN(k) ((((PH_MASK) >> (k)) & 1) && lo <= (k) && (k) < hi)
#define SEAM(k) do { if (IN(k) && IN((k) + 1)) xcd_barrier(bar); } while (0)
#ifndef PROBE_PHASE
#define PROBE_PHASE -1
#endif
#define REPEAT(k) for (int rep_ = 0; rep_ < ((PROBE_PHASE) == (k) ? 2 : 1); ++rep_, ((PROBE_PHASE) == (k) && rep_ < 2 ? xcd_barrier(bar) : (void)0))

    if (IN(0)) REPEAT(0) { phase0(F, args); }
    SEAM(0);
    if (IN(1)) REPEAT(1) {
#ifndef PROBE_GEMM
#define PROBE_GEMM 0
#endif
        pg8::StaticOrder S; S.init(NTOK / 256, NZ / 256, F.G, F.bx, PROBE_GEMM == 1 ? 2 : 1);
        const APlain AA{ws + WS_XB, 128u, (unsigned)(D * 2)}; const BPlain BA{(const bf16*)(ws + WS_WINT), D};
        const EpiZ E{(bf16*)(ws + WS_ZA), (bf16*)(ws + WS_ZG)};
        pg8::gemm_phase(F.lds, D, S, AA, BA, E);
        { const int nu = (NTOK / 256) * (NZ / 256), rem = nu % F.G;
          if (rem != 0 && F.bx >= rem) p0_experts(F, args, (F.bx - rem) * NWAVES + F.wave, (F.G - rem) * NWAVES, 0, P0_EXP_ITEMS); }
    }
    SEAM(1);
    if (IN(2)) REPEAT(2) { phase2(F, args); }
    SEAM(2);
    if (IN(3)) REPEAT(3) { phase3(F); }
    if (IN(4)) REPEAT(4) { phase4(F, args); }
    SEAM(4);
    if (IN(5)) REPEAT(5) {
        pg8::StaticOrder S; S.init(NTOK / 256, D / 256, F.G, F.bx);
        { const APlain AA{ws + WS_OA, 128u, 1024u}; const BPlain BA{(const bf16*)(ws + WS_WAT), 512};
          const EpiGate<0> E{(const bf16*)(ws + WS_ZG), nullptr, (bf16*)(ws + WS_T1)};
          pg8::gemm_phase(F.lds, 512, S, AA, BA, E); }
        { const APlain AA{ws + WS_OLAT, 128u, 2048u}; const BPlain BA{(const bf16*)(ws + WS_WBT), 1024};
          const EpiGate<1> E{(const bf16*)(ws + WS_ZG), (const bf16*)(ws + WS_T1), (bf16*)(ws + WS_MERGED)};
          pg8::gemm_phase(F.lds, 1024, S, AA, BA, E); }
    }
    SEAM(5);
    if (IN(6)) REPEAT(6) {
        pg8::StaticOrder S; S.init(NTOK / 256, D / 256, F.G, F.bx, PROBE_GEMM == 6 ? 2 : 1);
        const APlain AA{ws + WS_MERGED, 128u, 2048u}; const BPlain BA{(const bf16*)(ws + WS_WOT), 1024};
        const EpiRes E{args.in[0], (bf16*)(ws + WS_H1)};
        pg8::gemm_phase(F.lds, 1024, S, AA, BA, E);
    }
    SEAM(6);
    if (IN(7)) { phase6(F, args); }
    SEAM(7);
    if (IN(8)) {
        moe_setup(F);
        const int vcu = (F.G % 8 == 0) ? (F.bx % 8) * (F.G / 8) + F.bx / 8 : F.bx;
        const MoeOrder S{F.G, vcu, 1, F.G == 256 ? 1 : 0, (const LAS int*)(F.lds + MOE_CUM), (unsigned*)(ws + WS_CTL) + CW_P8R};
        const AGather AA{ws + WS_H1B, 128u, (const int*)(ws + WS_LIST)}; const BGu BA{(const bf16*)(ws + WS_WGU)};
        const EpiAct E{(bf16*)(ws + WS_ACT)};
        pg8::gemm_phase(F.lds, 1024, S, AA, BA, E);
    }
    if (F.G != 256) SEAM(8);
    if (IN(9)) {
        moe_setup(F);
        const int vcu = (F.G % 8 == 0) ? (F.bx % 8) * (F.G / 8) + F.bx / 8 : F.bx;
        const MoeOrder S{F.G, vcu, 2, F.G == 256 ? 3 : 0, (const LAS int*)(F.lds + MOE_CUM), (unsigned*)(ws + WS_CTL) + CW_P8R};
        if (F.G == 256) { if (F.wave == 0) MoeOrder::wait_for(S.dep, 256u); __syncthreads(); }
        const APlain AA{ws + WS_ACT, 128u, 512u}; const BDn BA{(const bf16*)(ws + WS_WDT)};
        const EpiDown E{(bf16*)(ws + WS_YBUF), (const int*)(ws + WS_LIST)};
        pg8::gemm_phase(F.lds, 256, S, AA, BA, E);
    }
    SEAM(9);
    if (IN(10)) REPEAT(10) { phase9(F, args); }
#undef IN
#undef SEAM
#undef REPEAT
}

extern "C" void kernel_launch(void* const* d_in, const int* in_sizes, int n_in, void* d_out, int out_size, void* d_ws, size_t ws_size, hipStream_t stream) {
    static int grid = 0;
    if (grid == 0) {
        if (n_in != 26 || in_sizes[0] != NTOK * D || out_size != NTOK * D || ws_size < WS_END) {
            fprintf(stderr, "kernel_launch: unexpected problem: n_in %d in0 %d out %d ws %zu (need %zu)\n", n_in, n_in > 0 ? in_sizes[0] : -1, out_size, ws_size, (size_t)WS_END); grid = -1; return; }
        int dev = 0, cus = 0, per_cu = 0;
        if (hipGetDevice(&dev) != hipSuccess || hipDeviceGetAttribute(&cus, hipDeviceAttributeMultiprocessorCount, dev) != hipSuccess) { grid = -1; return; }
        if (hipFuncSetAttribute((const void*)fwd_kernel, hipFuncAttributeMaxDynamicSharedMemorySize, LDS_BYTES) != hipSuccess) { fprintf(stderr, "kernel_launch: hipFuncSetAttribute failed\n"); grid = -1; return; }
        if (hipOccupancyMaxActiveBlocksPerMultiprocessor(&per_cu, (const void*)fwd_kernel, NTHR, LDS_BYTES) != hipSuccess || per_cu < 1)
            fprintf(stderr, "kernel_launch: occupancy query reports %d\n", per_cu);
        (void)hipGetLastError();
        grid = cus;
    }
    if (grid < 0) return;
    if (hipMemsetAsync((char*)d_ws + WS_CTL, 0, CTL_ZERO_BYTES, stream) != hipSuccess) return;
    Args a{};
    for (int i = 0; i < 26; ++i) a.in[i] = (const float*)d_in[i];
    a.out = (float*)d_out; a.ws = (unsigned char*)d_ws;
#if MK_PER_PHASE
    for (int p = 0; p < NPHASE; ++p) { a.ph_lo = p; a.ph_hi = p + 1; hipLaunchKernelGGL(fwd_kernel, dim3(grid), dim3(NTHR), LDS_BYTES, stream, a); }
#else
    a.ph_lo = 0; a.ph_hi = NPHASE;
    hipLaunchKernelGGL(fwd_kernel, dim3(grid), dim3(NTHR), LDS_BYTES, stream, a);
#endif
}
```

```cpp
#include <hip/hip_runtime.h>
#include <cstdio>
#include <cstdint>

#ifndef MK_PER_PHASE
#define MK_PER_PHASE 0
#endif

#define GAS __attribute__((address_space(1)))
#define LAS __attribute__((address_space(3)))
typedef unsigned short bf16;
typedef short bf16x8 __attribute__((ext_vector_type(8)));
typedef short s16x4 __attribute__((ext_vector_type(4)));
typedef float f32x4 __attribute__((ext_vector_type(4)));
typedef float f32x16 __attribute__((ext_vector_type(16)));
typedef float f32x2 __attribute__((ext_vector_type(2)));
typedef unsigned u32x4 __attribute__((ext_vector_type(4)));
typedef unsigned u32x2 __attribute__((ext_vector_type(2)));

constexpr int D = 1024, BATCH = 8, SEQ = 4096, NTOK = BATCH * SEQ;
constexpr int D_IN = 4316;
constexpr int NCMP = 255;
constexpr float ALPHA = 1.189207115002721f;
constexpr float LOG2E = 1.4426950408889634f;
constexpr float NEGBIG = -1e30f;
constexpr int ZA_LD = 2816;
constexpr int ZC_QA = 0, ZC_KC = 512, ZC_VC = 640, ZC_KS = 768, ZC_VS = 896, ZC_KW = 1024, ZC_VW = 1152, ZC_QLAT = 1280, ZC_CKV = 2304,
              ZC_QIDX = 2432, ZC_KIDX = 2688, ZC_GNSA = 2752, ZC_WIDX = 2776;
constexpr int ZG_LD = 2048;
constexpr int NZ = ZA_LD + ZG_LD;
constexpr int NEXP = 32, DEXP = 256;
constexpr int MAXTILES = (2 * NTOK) / 256 + NEXP;

constexpr size_t MiB = 1u << 20;
constexpr size_t WS_CTL = 0, CTL_ZERO_BYTES = 1 * MiB;
constexpr size_t WS_WAT = 1 * MiB;
constexpr size_t WS_WBT = 2 * MiB;
constexpr size_t WS_WOT = 4 * MiB;
constexpr size_t WS_W1K = 6 * MiB;
constexpr size_t WS_W1V = 7 * MiB;
constexpr size_t WS_W2K = 8 * MiB;
constexpr size_t WS_W2V = 8 * MiB + 64 * 1024;
constexpr size_t WS_BIASK = 8 * MiB + 128 * 1024;
constexpr size_t WS_TBA = 8 * MiB + 256 * 1024;
constexpr size_t WS_TBB = 8 * MiB + 320 * 1024;
constexpr size_t WS_KCMP = 9 * MiB;
constexpr size_t WS_VCMP = 9 * MiB + 512 * 1024;
constexpr size_t WS_TOKINFO = 10 * MiB;
constexpr size_t WS_LIST = 11 * MiB;
constexpr size_t WS_WINT = 16 * MiB;
constexpr size_t WS_WGU = 32 * MiB;
constexpr size_t WS_WDT = 64 * MiB;
constexpr size_t WS_CKVN = 80 * MiB;
constexpr size_t WS_XB = 96 * MiB;
constexpr size_t WS_OLAT = 96 * MiB;
constexpr size_t WS_H1B = 96 * MiB;
constexpr size_t WS_ZA = 160 * MiB;
constexpr size_t WS_T1 = 160 * MiB;
constexpr size_t WS_ACT = 160 * MiB;
constexpr size_t WS_YBUF = 196 * MiB;
constexpr size_t WS_MERGED = 224 * MiB;
constexpr size_t WS_ZG = 336 * MiB;
constexpr size_t WS_H1 = 336 * MiB;
constexpr size_t WS_OA = 464 * MiB;
constexpr size_t WS_END = 496 * MiB;

constexpr int CW_BAR = 4096;
constexpr int CW_CNT = 16384;
constexpr int CW_P8R = 20480;

constexpr int LDS_BYTES = 163840;
constexpr int MISC_OFF = 160 * 1024 - 256;

__device__ __forceinline__ unsigned f2bf(float f) { unsigned u = __builtin_bit_cast(unsigned, f); return (u + 0x7fffu + ((u >> 16) & 1u)) >> 16; }
__device__ __forceinline__ unsigned pk2(float lo, float hi) { unsigned r; asm volatile("v_cvt_pk_bf16_f32 %0, %1, %2" : "=v"(r) : "v"(lo), "v"(hi)); return r; }
__device__ __forceinline__ float bf2f(unsigned short b) { return __builtin_bit_cast(float, ((unsigned)b) << 16); }
__device__ __forceinline__ float bflo(unsigned w) { return __builtin_bit_cast(float, w << 16); }
__device__ __forceinline__ float bfhi(unsigned w) { return __builtin_bit_cast(float, w & 0xffff0000u); }
__device__ __forceinline__ float wave_sum(float v) {
#pragma unroll
    for (int o = 1; o < 64; o <<= 1) v += __shfl_xor(v, o);
    return v;
}
__device__ __forceinline__ float sigmoidf_(float x) { return __builtin_amdgcn_rcpf(1.0f + __builtin_amdgcn_exp2f(-1.4426950408889634f * x)); }
#define LDS_WAIT() asm volatile("s_waitcnt lgkmcnt(0)" ::: "memory")
#define VM_WAIT() asm volatile("s_waitcnt vmcnt(0)" ::: "memory")

#define XB_TMO      128
#define XB_XCNT(j)  (256  + 64 * (j))
#define XB_XSUB(j)  (1280 + 64 * (j))
#define XB_XGEN(j)  (2304 + 64 * (j))
#define XB_TOP      3328
#define XB_TOPGEN   3392
#define XCD_BAR_WORDS 3456
#define XB_SPIN_CAP (1u << 18)
__device__ __forceinline__ unsigned xb_ld(unsigned* p)              { return __hip_atomic_load(p, __ATOMIC_RELAXED, __HIP_MEMORY_SCOPE_AGENT); }
__device__ __forceinline__ unsigned xb_add(unsigned* p, unsigned v) { return __hip_atomic_fetch_add(p, v, __ATOMIC_RELAXED, __HIP_MEMORY_SCOPE_AGENT); }
__device__ __forceinline__ unsigned xb_xcc_id() { return (unsigned)__builtin_amdgcn_s_getreg((3 << 11) | 20) & 0xFu; }
#define XB_SPIN(cond, bar) do { unsigned _sp = 0; while (cond) { __builtin_amdgcn_s_sleep(1); \
    if ((++_sp & 255u) == 0u) { if (xb_ld(&(bar)[XB_TMO])) break; if (_sp > XB_SPIN_CAP) { atomicAdd(&(bar)[XB_TMO], 1u); break; } } } } while (0)
struct XcdBarrier { unsigned* bar; unsigned x; volatile LAS unsigned* st; };
__device__ __forceinline__ XcdBarrier xcd_barrier_post(unsigned* bar, volatile LAS unsigned* st) {
    XcdBarrier b; b.bar = bar; b.x = xb_xcc_id(); b.st = st;
    if (threadIdx.x == 0) (void)xb_add(&bar[XB_XCNT(b.x)], 1u);
    return b;
}
__device__ __forceinline__ void xcd_barrier_complete(unsigned* bar, unsigned x, unsigned& nloc, unsigned& nx) {
    const unsigned G = gridDim.x * gridDim.y * gridDim.z;
    unsigned sum, cnt, mine, sp = 0u;
    for (;;) {
        sum = 0u; cnt = 0u; mine = 0u;
#pragma unroll
        for (unsigned j = 0; j < 16; ++j) { const unsigned c = xb_ld(&bar[XB_XCNT(j)]); sum += c; cnt += (c > 0u) ? 1u : 0u; mine = (j == x) ? c : mine; }
        if (sum == G) break;
        __builtin_amdgcn_s_sleep(1);
        if ((++sp & 255u) == 0u) { if (xb_ld(&bar[XB_TMO])) break; if (sp > XB_SPIN_CAP) { atomicAdd(&bar[XB_TMO], 1u); break; } }
    }
    nloc = mine > 0u ? mine : 1u; nx = cnt > 0u ? cnt : 1u;
}
__device__ __forceinline__ void xcd_barrier(const XcdBarrier& b) {
    asm volatile("s_waitcnt vmcnt(0)" ::: "memory");
    __syncthreads();
    if (threadIdx.x == 0) {
        unsigned* bar = b.bar;
        __builtin_amdgcn_s_waitcnt(0);
        unsigned nloc = b.st[0], nx = b.st[1];
        if (nloc == 0u) { xcd_barrier_complete(bar, b.x, nloc, nx); b.st[0] = nloc; b.st[1] = nx; }
        const unsigned old = xb_add(&bar[XB_XSUB(b.x)], 1u);
        const unsigned gen = old / nloc;
        if (old + 1u == (gen + 1u) * nloc) {
            __builtin_amdgcn_fence(__ATOMIC_RELEASE, "agent");
            asm volatile("s_waitcnt vmcnt(0)" ::: "memory");
            const unsigned og = xb_add(&bar[XB_TOP], 1u);
            const unsigned tg = og / nx;
            if (og + 1u == (tg + 1u) * nx) xb_add(&bar[XB_TOPGEN], 1u);
            else XB_SPIN(xb_ld(&bar[XB_TOPGEN]) == tg, bar);
            __builtin_amdgcn_fence(__ATOMIC_ACQUIRE, "agent");
            xb_add(&bar[XB_XGEN(b.x)], 1u);
            asm volatile("s_waitcnt vmcnt(0)" ::: "memory");
        } else {
            XB_SPIN(xb_ld(&bar[XB_XGEN(b.x)]) == gen, bar);
            __builtin_amdgcn_fence(__ATOMIC_ACQUIRE, "agent");
            asm volatile("s_waitcnt vmcnt(0)" ::: "memory");
        }
    }
    __syncthreads();
}

namespace pg8 {
constexpr int BM = 256, BK = 64, HALF = 128, HTB = HALF * BK * 2, STAGE_BYTES = 8 * HTB, NXCD = 8, WGM = 8;
__host__ __device__ __forceinline__ int lds_byte(int r, int c) { const int st = (r >> 4) * 2 + (c >> 5), rr = r & 15, cc = c & 31, ob = rr * 64 + cc * 2; return st * 1024 + (ob ^ (((ob >> 9) & 1) << 5)); }
__host__ __device__ __forceinline__ void stage_rc(int b, int& R, int& C) { const int st = b / 1024, sb = b % 1024, swz = sb ^ (((sb >> 9) & 1) << 5); R = (st >> 1) * 16 + swz / 64; C = (st & 1) * 32 + (swz % 64) / 2; }
__host__ __device__ __forceinline__ int perm32(int rho) { const int n = rho >> 4, i = rho & 15; return 8 * (i >> 2) + 4 * n + (i & 3); }
struct Unit { int pm, pn, e, nrows; };
struct StaticOrder {
    int nM, nN, nwg, G, c, dup;
    __device__ void init(int nM_, int nN_, int G_, int c_, int dup_ = 1) { nM = nM_; nN = nN_; nwg = nM * nN; G = G_; c = c_; dup = dup_; }
    __device__ bool next(int i, Unit& u) const {
        const long L0 = (long)i * G + c; if (L0 >= (long)nwg * dup) return false;
        const long L = L0 % nwg;
        int wgid = (int)L; { const int q = nwg / NXCD, r = nwg % NXCD, xcd = wgid % NXCD, off = wgid / NXCD; wgid = (xcd < r ? xcd * (q + 1) : r * (q + 1) + (xcd - r) * q) + off; }
        const int nig = WGM * nN, gid = wgid / nig, fm = gid * WGM, gsz = (nM - fm) < WGM ? (nM - fm) : WGM;
        u.pm = fm + ((wgid % nig) % gsz); u.pn = (wgid % nig) / gsz; u.e = 0; u.nrows = 256; return true;
    }
    __device__ __forceinline__ void done(int) const {}
};

template <class Epi, class Sched, class AAddr, class BAddr>
__device__ __forceinline__ void gemm_phase(LAS unsigned char* lds, const int K, const Sched& S, const AAddr& AA, const BAddr& BA, const Epi& E) {
    constexpr bool GA = AAddr::GATHER;
    const int tid = threadIdx.x, wid = __builtin_amdgcn_readfirstlane(tid >> 6), lane = tid & 63, wr = wid >> 2, wc = wid & 3, fr = lane & 15, fq = lane >> 4;
    const int nt = K / BK;
    unsigned voffA[2], voffB[2];
#pragma unroll
    for (int i = 0; i < 2; ++i) { int R, C; stage_rc(tid * 16 + i * 8192, R, C); const int Rb = Epi::PERM ? ((R & ~31) + perm32(R & 31)) : R;
        voffA[i] = GA ? 0u : AA.lane_off(R, C); voffB[i] = (unsigned)(Rb * K + C) * 2u; }
    const size_t kstepA = (size_t)AA.kstep, kstepB = (size_t)(BK * 2);
    const size_t hstepB = (size_t)HALF * K * 2, hstepA = GA ? 0 : AA.hstep();
    const unsigned ldsw = (unsigned)wid * 1024u;
    const int aoff = lds_byte(wr * 64 + fr, fq * 8), boff = lds_byte(wc * 32 + fr, fq * 8);
#define PG8_SA(b, h) (((b) * 2 + (h)) * HTB)
#define PG8_SB(b, h) ((4 + (b) * 2 + (h)) * HTB)
#define PG8_STAGE(bufoff, gbase, voff) do { _Pragma("unroll") for (int _i = 0; _i < 2; ++_i) \
        __builtin_amdgcn_global_load_lds((const unsigned*)((const char*)(gbase) + (voff)[_i]), (LAS unsigned*)(lds + (bufoff) + ldsw + _i * 8192), 16, 0, 0); } while (0)
#define PG8_STA_CUR(bufoff, h, kb) do { if constexpr (GA) { if (h) PG8_STAGE(bufoff, baseA + (kb), cof1); else PG8_STAGE(bufoff, baseA + (kb), cof0); } \
        else PG8_STAGE(bufoff, cA + (h) * hstepA + (kb), voffA); } while (0)
#define PG8_STA_SEL(bufoff, h, kb) do { if constexpr (GA) { if (h) PG8_STAGE(bufoff, baseA + (kb), sof1); else PG8_STAGE(bufoff, baseA + (kb), sof0); } \
        else PG8_STAGE(bufoff, sA + (h) * hstepA + (kb), voffA); } while (0)
#define PG8_LDA(dst, b, h) do { _Pragma("unroll") for (int m = 0; m < 4; ++m) _Pragma("unroll") for (int k = 0; k < 2; ++k) dst[m][k] = *(const LAS bf16x8*)(lds + PG8_SA(b, h) + aoff + m * 2048 + k * 1024); } while (0)
#define PG8_LDB(dst, b, h) do { _Pragma("unroll") for (int n = 0; n < 2; ++n) _Pragma("unroll") for (int k = 0; k < 2; ++k) dst[n][k] = *(const LAS bf16x8*)(lds + PG8_SB(b, h) + boff + n * 2048 + k * 1024); } while (0)
#define PG8_MMA(ai, bj, At, Bt) do { __builtin_amdgcn_s_setprio(1); _Pragma("unroll") for (int m = 0; m < 4; ++m) _Pragma("unroll") for (int n = 0; n < 2; ++n) _Pragma("unroll") for (int k = 0; k < 2; ++k) \
        acc[ai][bj][m][n] = __builtin_amdgcn_mfma_f32_16x16x32_bf16(Bt[n][k], At[m][k], acc[ai][bj][m][n], 0, 0, 0); __builtin_amdgcn_s_setprio(0); } while (0)
#define PG8_WAIT_V(n) asm volatile("s_waitcnt vmcnt(" #n ")" ::: "memory")
#define PG8_WAIT_L(n) asm volatile("s_waitcnt lgkmcnt(" #n ")" ::: "memory")
#define PG8_BAR __builtin_amdgcn_s_barrier()
#define PG8_SCHED __builtin_amdgcn_sched_barrier(0)
#define PG8_GOFF(u, o0, o1) do { _Pragma("unroll") for (int _i = 0; _i < 2; ++_i) { int R_, C_; stage_rc(tid * 16 + _i * 8192, R_, C_); \
        o0[_i] = AA.row_off(u, R_) + (unsigned)C_ * 2u; o1[_i] = AA.row_off(u, R_ + HALF) + (unsigned)C_ * 2u; } } while (0)
    Unit cur, nxt; int ui = 0;
    if (!S.next(0, cur)) return;
    f32x4 acc[2][2][4][2];
#pragma unroll
    for (int a = 0; a < 2; ++a)
#pragma unroll
        for (int b = 0; b < 2; ++b)
#pragma unroll
            for (int m = 0; m < 4; ++m)
#pragma unroll
                for (int n = 0; n < 2; ++n) acc[a][b][m][n] = (f32x4){0.f, 0.f, 0.f, 0.f};
    bf16x8 At[4][2], B0[2][2], B1[2][2];
    const char* const baseA = GA ? (const char*)AA.base : nullptr;
    const char* cA = GA ? nullptr : (const char*)AA.unit_ptr(cur);
    unsigned cof0[2] = {0u, 0u}, cof1[2] = {0u, 0u}, nof0[2] = {0u, 0u}, nof1[2] = {0u, 0u};
    if constexpr (GA) PG8_GOFF(cur, cof0, cof1);
    const char* cB = (const char*)BA.ptr(cur);
    PG8_STAGE(PG8_SB(0, 0), cB, voffB); PG8_STA_CUR(PG8_SA(0, 0), 0, 0); PG8_STAGE(PG8_SB(0, 1), cB + hstepB, voffB); PG8_STA_CUR(PG8_SA(0, 1), 1, 0);
    if (wr == 1) PG8_BAR;
    PG8_WAIT_V(4); PG8_BAR;
    PG8_STAGE(PG8_SB(1, 0), cB + kstepB, voffB); PG8_STA_CUR(PG8_SA(1, 0), 0, kstepA); PG8_STAGE(PG8_SB(1, 1), cB + hstepB + kstepB, voffB);
    PG8_WAIT_V(6); PG8_BAR;
    for (;;) {
        const bool has_next = S.next(ui + 1, nxt);
        const char* nB = cB; const char* nA = cA;
        if (has_next) { nB = (const char*)BA.ptr(nxt); if constexpr (GA) PG8_GOFF(nxt, nof0, nof1); else nA = (const char*)AA.unit_ptr(nxt); }
        else { if constexpr (GA) {
#pragma unroll
            for (int i = 0; i < 2; ++i) { nof0[i] = cof0[i]; nof1[i] = cof1[i]; } } }
#pragma nounroll
        for (int t = 0; t < nt; t += 2) {
            const bool last = (t == nt - 2);
            const size_t k1 = (size_t)(t + 1) * kstepA, k2 = last ? 0 : (size_t)(t + 2) * kstepA, k3 = k2 + kstepA;
            const char* b2 = last ? nB : cB + (size_t)(t + 2) * kstepB; const char* b3 = b2 + kstepB;
            const char* sA = last ? nA : cA;
            unsigned sof0[2], sof1[2];
#pragma unroll
            for (int i = 0; i < 2; ++i) { sof0[i] = last ? nof0[i] : cof0[i]; sof1[i] = last ? nof1[i] : cof1[i]; }
            PG8_LDB(B0, 0, 0); PG8_SCHED; PG8_LDA(At, 0, 0); PG8_STA_CUR(PG8_SA(1, 1), 1, k1);
            PG8_WAIT_L(8); PG8_BAR; PG8_WAIT_L(0); PG8_MMA(0, 0, At, B0); PG8_BAR; PG8_SCHED;
            PG8_LDB(B1, 0, 1); PG8_STAGE(PG8_SB(0, 0), b2, voffB);
            PG8_BAR; PG8_WAIT_L(0); PG8_MMA(0, 1, At, B1); PG8_BAR;
            PG8_LDA(At, 0, 1); PG8_STA_SEL(PG8_SA(0, 0), 0, k2);
            PG8_BAR; PG8_WAIT_L(0); PG8_MMA(1, 0, At, B0); PG8_BAR; PG8_SCHED;
            PG8_STAGE(PG8_SB(0, 1), b2 + hstepB, voffB);
            PG8_WAIT_V(6); PG8_BAR; PG8_MMA(1, 1, At, B1); PG8_BAR;
            PG8_LDB(B0, 1, 0); PG8_SCHED; PG8_LDA(At, 1, 0); PG8_STA_SEL(PG8_SA(0, 1), 1, k2);
            PG8_WAIT_L(8); PG8_BAR; PG8_WAIT_L(0); PG8_MMA(0, 0, At, B0); PG8_BAR; PG8_SCHED;
            PG8_LDB(B1, 1, 1); PG8_STAGE(PG8_SB(1, 0), b3, voffB);
            PG8_BAR; PG8_WAIT_L(0); PG8_MMA(0, 1, At, B1); PG8_BAR;
            PG8_LDA(At, 1, 1); PG8_STA_SEL(PG8_SA(1, 0), 0, k3);
            PG8_BAR; PG8_WAIT_L(0); PG8_MMA(1, 0, At, B0); PG8_BAR; PG8_SCHED;
            PG8_STAGE(PG8_SB(1, 1), b3 + hstepB, voffB);
            PG8_WAIT_V(6); PG8_BAR; PG8_MMA(1, 1, At, B1); PG8_BAR;
        }
        E(acc, cur, wr, wc, fr, fq);
        S.done(ui);
        if (!has_next) break;
#pragma unroll
        for (int a = 0; a < 2; ++a)
#pragma unroll
            for (int b = 0; b < 2; ++b)
#pragma unroll
                for (int m = 0; m < 4; ++m)
#pragma unroll
                    for (int n = 0; n < 2; ++n) acc[a][b][m][n] = (f32x4){0.f, 0.f, 0.f, 0.f};
        cur = nxt; cB = nB; cA = nA; ++ui;
        if constexpr (GA) {
#pragma unroll
            for (int i = 0; i < 2; ++i) { cof0[i] = nof0[i]; cof1[i] = nof1[i]; } }
    }
    PG8_WAIT_V(0);
    if (wr == 0) PG8_BAR;
    PG8_BAR;
#undef PG8_SA
#undef PG8_SB
#undef PG8_STAGE
#undef PG8_STA_CUR
#undef PG8_STA_SEL
#undef PG8_GOFF
#undef PG8_LDA
#undef PG8_LDB
#undef PG8_MMA
#undef PG8_WAIT_V
#undef PG8_WAIT_L
#undef PG8_BAR
#undef PG8_SCHED
}
}

constexpr int NWAVES = 8, NTHR = 512;
struct Args { const float* in[26]; float* out; unsigned char* ws; int ph_lo, ph_hi; unsigned repmask; int pad; };
typedef const __attribute__((address_space(4))) Args& ArgsR;
struct Frame {
    LAS unsigned char* lds;
    int tid, lane, wave, G, bx;
    unsigned char* ws;
};

struct APlain { const void* base; unsigned kstep; unsigned ld2;
    static constexpr bool GATHER = false;
    __device__ __forceinline__ const void* unit_ptr(const pg8::Unit& u) const { return (const char*)base + (size_t)u.pm * 256 * ld2; }
    __device__ __forceinline__ unsigned lane_off(int R, int C) const { return (unsigned)R * ld2 + (unsigned)C * 2u; }
    __device__ __forceinline__ size_t hstep() const { return (size_t)128 * ld2; }
    __device__ __forceinline__ unsigned row_off(const pg8::Unit&, int) const { return 0u; } };
struct BPlain { const bf16* Bt; int K;
    __device__ __forceinline__ const void* ptr(const pg8::Unit& u) const { return Bt + (size_t)u.pn * 256 * K; } };

struct EpiZ {
    static constexpr bool PERM = true;
    bf16* ZA; bf16* ZG;
    __device__ __forceinline__ void operator()(const f32x4 (&acc)[2][2][4][2], const pg8::Unit& u, int wr, int wc, int fr, int fq) const {
        const bool gate = u.pn >= 11;
        bf16* base = gate ? ZG : ZA; const int ld = gate ? ZG_LD : ZA_LD; const int colt = gate ? (u.pn - 11) * 256 : u.pn * 256;
        const int row0 = u.pm * 256 + wr * 64 + fr, col0 = colt + wc * 32 + 8 * fq;
#pragma unroll
        for (int ai = 0; ai < 2; ++ai)
#pragma unroll
            for (int m = 0; m < 4; ++m) { bf16* rowp = base + (size_t)(row0 + ai * 128 + m * 16) * ld + col0;
#pragma unroll
                for (int bj = 0; bj < 2; ++bj) { f32x4 v0 = acc[ai][bj][m][0], v1 = acc[ai][bj][m][1];
                    if (gate) {
#pragma unroll
                        for (int j = 0; j < 4; ++j) { v0[j] = sigmoidf_(v0[j]); v1[j] = sigmoidf_(v1[j]); } }
                    u32x4 w; w.x = pk2(v0[0], v0[1]); w.y = pk2(v0[2], v0[3]); w.z = pk2(v1[0], v1[1]); w.w = pk2(v1[2], v1[3]);
                    *(u32x4*)(rowp + bj * 128) = w; } }
    }
};
template <int MODE> struct EpiGate {
    static constexpr bool PERM = true;
    const bf16* ZG; const bf16* T1; bf16* O;
    __device__ __forceinline__ void operator()(const f32x4 (&acc)[2][2][4][2], const pg8::Unit& u, int wr, int wc, int fr, int fq) const {
        const int row0 = u.pm * 256 + wr * 64 + fr, col0 = u.pn * 256 + wc * 32 + 8 * fq;
#pragma unroll
        for (int ai = 0; ai < 2; ++ai) {
            u32x4 gv[4][2], tv[4][2];
#pragma unroll
            for (int m = 0; m < 4; ++m)
#pragma unroll
                for (int bj = 0; bj < 2; ++bj) { const size_t r = (size_t)(row0 + ai * 128 + m * 16); const int c = col0 + bj * 128;
                    gv[m][bj] = *(const u32x4*)(ZG + r * ZG_LD + MODE * 1024 + c); if (MODE == 1) tv[m][bj] = *(const u32x4*)(T1 + r * 1024 + c); }
#pragma unroll
            for (int m = 0; m < 4; ++m)
#pragma unroll
                for (int bj = 0; bj < 2; ++bj) { asm volatile("" : "+v"(gv[m][bj])); if (MODE == 1) asm volatile("" : "+v"(tv[m][bj])); }
#pragma unroll
            for (int m = 0; m < 4; ++m) { const size_t r = (size_t)(row0 + ai * 128 + m * 16);
#pragma unroll
                for (int bj = 0; bj < 2; ++bj) { const int c = col0 + bj * 128; const u32x4 g = gv[m][bj];
                    const f32x4 v0 = acc[ai][bj][m][0], v1 = acc[ai][bj][m][1];
                    float o[8] = { v0[0] * bflo(g.x), v0[1] * bfhi(g.x), v0[2] * bflo(g.y), v0[3] * bfhi(g.y), v1[0] * bflo(g.z), v1[1] * bfhi(g.z), v1[2] * bflo(g.w), v1[3] * bfhi(g.w) };
                    if (MODE == 1) { const u32x4 t = tv[m][bj];
                        o[0] += bflo(t.x); o[1] += bfhi(t.x); o[2] += bflo(t.y); o[3] += bfhi(t.y); o[4] += bflo(t.z); o[5] += bfhi(t.z); o[6] += bflo(t.w); o[7] += bfhi(t.w); }
                    u32x4 w; w.x = pk2(o[0], o[1]); w.y = pk2(o[2], o[3]); w.z = pk2(o[4], o[5]); w.w = pk2(o[6], o[7]);
                    *(u32x4*)(O + r * 1024 + c) = w; } }
        }
    }
};
struct EpiRes {
    static constexpr bool PERM = true;
    const float* X; bf16* O;
    __device__ __forceinline__ void operator()(const f32x4 (&acc)[2][2][4][2], const pg8::Unit& u, int wr, int wc, int fr, int fq) const {
        const int row0 = u.pm * 256 + wr * 64 + fr, col0 = u.pn * 256 + wc * 32 + 8 * fq;
#pragma unroll
        for (int ai = 0; ai < 2; ++ai) {
            f32x4 xv[4][2][2];
#pragma unroll
            for (int m = 0; m < 4; ++m)
#pragma unroll
                for (int bj = 0; bj < 2; ++bj) { const size_t off = (size_t)(row0 + ai * 128 + m * 16) * D + col0 + bj * 128; xv[m][bj][0] = *(const f32x4*)(X + off); xv[m][bj][1] = *(const f32x4*)(X + off + 4); }
#pragma unroll
            for (int m = 0; m < 4; ++m)
#pragma unroll
                for (int bj = 0; bj < 2; ++bj) { asm volatile("" : "+v"(xv[m][bj][0])); asm volatile("" : "+v"(xv[m][bj][1])); }
#pragma unroll
            for (int m = 0; m < 4; ++m)
#pragma unroll
                for (int bj = 0; bj < 2; ++bj) { const size_t off = (size_t)(row0 + ai * 128 + m * 16) * D + col0 + bj * 128;
                    const f32x4 v0 = xv[m][bj][0] * ALPHA + acc[ai][bj][m][0], v1 = xv[m][bj][1] * ALPHA + acc[ai][bj][m][1];
                    u32x4 w; w.x = pk2(v0[0], v0[1]); w.y = pk2(v0[2], v0[3]); w.z = pk2(v1[0], v1[1]); w.w = pk2(v1[2], v1[3]);
                    *(u32x4*)(O + off) = w; }
        }
    }
};

template <class F>
__device__ __forceinline__ void p0_tile(const F& f, bf16* WT, int ldk, int k0, int n0, LAS float* scr, int lane) {
    if constexpr (F::FOLD) {
        float bc[64];
#pragma unroll
        for (int d = 0; d < 64; ++d) bc[d] = f.bval(k0, d, n0 + (lane & 31));
#pragma unroll 4
        for (int i = 0; i < 32; ++i) { const int kk = 2 * i + (lane >> 5); const f32x4* ar = (const f32x4*)f.arow(k0 + kk, n0); f32x4 a4 = {0.f, 0.f, 0.f, 0.f};
#pragma unroll
            for (int q = 0; q < 16; ++q) { const f32x4 av = ar[q]; a4[0] += av[0] * bc[4 * q]; a4[1] += av[1] * bc[4 * q + 1]; a4[2] += av[2] * bc[4 * q + 2]; a4[3] += av[3] * bc[4 * q + 3]; }
            scr[kk * 33 + (lane & 31)] = (a4[0] + a4[1]) + (a4[2] + a4[3]); }
    } else {
        float v[32];
#pragma unroll
        for (int i = 0; i < 32; ++i) { const int kk = 2 * i + (lane >> 5); v[i] = f(k0 + kk, n0 + (lane & 31)); }
#pragma unroll
        for (int i = 0; i < 32; ++i) { const int kk = 2 * i + (lane >> 5); scr[kk * 33 + (lane & 31)] = v[i]; }
    }
    LDS_WAIT(); asm volatile("" ::: "memory");
    const int c = lane & 7;
#pragma unroll
    for (int j = 0; j < 4; ++j) { const int n = (lane >> 3) + 8 * j; const LAS float* s = scr + (8 * c) * 33 + n;
        u32x4 o; o.x = pk2(s[0 * 33], s[1 * 33]); o.y = pk2(s[2 * 33], s[3 * 33]); o.z = pk2(s[4 * 33], s[5 * 33]); o.w = pk2(s[6 * 33], s[7 * 33]);
        *(u32x4*)(WT + (size_t)(n0 + n) * ldk + k0 + 8 * c) = o; }
    LDS_WAIT(); asm volatile("" ::: "memory");
}
struct P0Item { const float* src; int N, noff; bf16* dst; int ldk, k0, n0; };
__device__ __forceinline__ void p0_item_load(const P0Item& it, float (&v)[32], int lane) {
#pragma unroll
    for (int i = 0; i < 32; ++i) { const int kk = 2 * i + (lane >> 5); v[i] = it.src[(size_t)(it.k0 + kk) * it.N + it.n0 + (lane & 31) + it.noff]; }
}
__device__ __forceinline__ void p0_item_finish(const P0Item& it, const float (&v)[32], LAS float* scr, int lane) {
#pragma unroll
    for (int i = 0; i < 32; ++i) { const int kk = 2 * i + (lane >> 5); scr[kk * 33 + (lane & 31)] = v[i]; }
    LDS_WAIT(); asm volatile("" ::: "memory");
    const int c = lane & 7;
#pragma unroll
    for (int j = 0; j < 4; ++j) { const int n = (lane >> 3) + 8 * j; const LAS float* s = scr + (8 * c) * 33 + n;
        u32x4 o; o.x = pk2(s[0 * 33], s[1 * 33]); o.y = pk2(s[2 * 33], s[3 * 33]); o.z = pk2(s[4 * 33], s[5 * 33]); o.w = pk2(s[6 * 33], s[7 * 33]);
        *(u32x4*)(it.dst + (size_t)(it.n0 + n) * it.ldk + it.k0 + 8 * c) = o; }
    LDS_WAIT(); asm volatile("" ::: "memory");
}
__device__ __forceinline__ int zsrc_col(int n) {
    if (n < 1280) return n;
    if (n < 2304) return -2;
    if (n < 2432) return 1816 + (n - 2304);
    if (n < 2688) return 1944 + (n - 2432);
    if (n < 2752) return 2200 + (n - 2688);
    if (n < 2776) return 1280 + (n - 2752);
    if (n < 2780) return 2264 + (n - 2776);
    if (n < 2816) return -1;
    if (n < 3840) return 2268 + (n - 2816);
    return 3292 + (n - 3840);
}
struct FWin { const float* w_in; static constexpr bool FOLD = false;
    __device__ __forceinline__ float operator()(int k, int n) const { const int s = zsrc_col(n); return s >= 0 ? w_in[(size_t)k * D_IN + s] : 0.f; } };
struct FWinQ { const float* w_in; const float* w_uk; static constexpr bool FOLD = true;
    __device__ __forceinline__ const float* arow(int k, int n0) const { return w_in + (size_t)k * D_IN + 1304 + ((n0 - 1280) >> 7) * 64; }
    __device__ __forceinline__ float bval(int, int d, int n) const { return w_uk[(size_t)((n - 1280) >> 7) * 64 * 128 + d * 128 + ((n - 1280) & 127)]; }
    __device__ __forceinline__ float operator()(int, int) const { return 0.f; } };
struct FWb { const float* w_uv; const float* w_bb; static constexpr bool FOLD = true;
    __device__ __forceinline__ const float* arow(int k, int) const { return w_uv + (size_t)k * 64; }
    __device__ __forceinline__ float bval(int k0, int d, int n) const { return w_bb[(size_t)((k0 >> 7) * 64 + d) * D + n]; }
    __device__ __forceinline__ float operator()(int, int) const { return 0.f; } };
struct FPlain { const float* W; int N; static constexpr bool FOLD = false; __device__ __forceinline__ float operator()(int k, int n) const { return W[(size_t)k * N + n]; } };
struct FOff { const float* W; int N; int noff; static constexpr bool FOLD = false;
    __device__ __forceinline__ float operator()(int k, int n) const { return W[(size_t)k * N + n + noff]; } };

__device__ __forceinline__ float rel_bucket_bias(const float* rel_bias, int dist, int head) {
    int b;
    if (dist < 16) b = dist;
    else { const float t = (__log2f((float)dist) - 4.0f) * 2.66666675f; b = 16 + (int)t; if (b > 31) b = 31; }
    return rel_bias[b * 16 + head];
}

constexpr int P0_EXP_ITEMS = NEXP * ((1024 / 64) * (512 / 32) + (256 / 64) * (1024 / 32)), P0_EXP_SPLIT = (P0_EXP_ITEMS * 2) / 3;
__device__ __forceinline__ void p0_experts(const Frame& F, ArgsR a, int wv, int nwv, int ibeg, int iend) {
    LAS float* scr = (LAS float*)(F.lds + F.wave * 16384);
    unsigned char* ws = F.ws;
    constexpr int I_GU = (1024 / 64) * (512 / 32), I_DN = (256 / 64) * (1024 / 32);
    const int gw = wv, NGW = nwv;
    {
        constexpr int NEI = NEXP * (I_GU + I_DN);
        auto mk = [&](int idx) { P0Item it; const int e = idx / (I_GU + I_DN); int r = idx - e * (I_GU + I_DN);
            if (r < I_GU) {
                const int n0 = (r % 16) * 32; const uintptr_t pg = (uintptr_t)a.in[21], pu = (uintptr_t)a.in[22];
                it.src = (const float*)(pg + (uintptr_t)((n0 >> 7) & 1) * (pu - pg)) + (size_t)e * D * DEXP; it.N = DEXP; it.noff = ((n0 >> 8) * 128 + (n0 & 127)) - n0;
                it.dst = (bf16*)(ws + WS_WGU) + (size_t)e * 512 * 1024; it.ldk = 1024; it.k0 = (r / 16) * 64; it.n0 = n0; }
            else { r -= I_GU; it.src = a.in[23] + (size_t)e * DEXP * D; it.N = D; it.noff = 0; it.dst = (bf16*)(ws + WS_WDT) + (size_t)e * 1024 * 256; it.ldk = 256; it.k0 = (r / 32) * 64; it.n0 = (r % 32) * 32; }
            return it; };
        float va[32], vb[32];
        {
        (void)NEI;
        int idx = ibeg + gw;
        if (idx < iend) { P0Item cur = mk(idx); p0_item_load(cur, va, F.lane);
            for (;;) {
                const int nidx = idx + NGW; const bool more = nidx < iend; P0Item nxt = cur;
                if (more) { nxt = mk(nidx); p0_item_load(nxt, vb, F.lane); }
                p0_item_finish(cur, va, scr, F.lane);
                if (!more) break;
#pragma unroll
                for (int i = 0; i < 32; ++i) va[i] = vb[i];
                cur = nxt; idx = nidx; } }
        }
    }
}
__device__ __forceinline__ void phase0(const Frame& F, ArgsR a) {
    LAS float* scr = (LAS float*)(F.lds + F.wave * 16384);
    const int gw = F.bx * NWAVES + F.wave, NGW = F.G * NWAVES;
    unsigned char* ws = F.ws;
    constexpr int I_WIN = (D / 64) * (NZ / 32);
    constexpr int I_WB = (1024 / 64) * (1024 / 32);
    constexpr int I_WA = (512 / 64) * (1024 / 32);
    constexpr int I_WO = I_WB;
    constexpr int I_W1 = (2048 / 64) * (256 / 32);
    constexpr int I_W2 = (256 / 64) * (64 / 32);
    constexpr int I_GU = (1024 / 64) * (512 / 32);
    constexpr int I_DN = (256 / 64) * (1024 / 32);
    constexpr int NITEMS = I_WIN + I_WB + I_WA + I_WO + 2 * I_W1 + 2 * I_W2;
    (void)NITEMS;
    constexpr int I_WINP = (D / 64) * ((NZ - 1024) / 32);
    for (int it = gw; it < 1024; it += NGW) {
        if (it < 512) { const int k0 = (it >> 5) * 64, n0 = 1280 + (it & 31) * 32; const FWinQ f{a.in[1], a.in[9]}; p0_tile(f, (bf16*)(ws + WS_WINT), D, k0, n0, scr, F.lane); }
        else { const int r = it - 512; const FWb f{a.in[10], a.in[13]}; p0_tile(f, (bf16*)(ws + WS_WBT), 1024, (r / 32) * 64, (r % 32) * 32, scr, F.lane); }
    }
    { constexpr int NPL = I_WINP + I_WA + I_WO + 2 * I_W1 + 2 * I_W2;
      const int pw0 = NGW > 1024 ? (gw >= 1024 ? gw - 1024 : -1) : gw, pws = NGW > 1024 ? NGW - 1024 : NGW;
      if (pw0 >= 0) for (int it = pw0; it < NPL; it += pws) {
        int r = it;
        if (r < I_WINP) { const int k0 = (r / 120) * 64; int nb = r % 120; nb = nb < 40 ? nb : nb + 32; const FWin f{a.in[1]}; p0_tile(f, (bf16*)(ws + WS_WINT), D, k0, nb * 32, scr, F.lane); continue; } r -= I_WINP;
        if (r < I_WA) { const FPlain f{a.in[12], D}; p0_tile(f, (bf16*)(ws + WS_WAT), 512, (r / 32) * 64, (r % 32) * 32, scr, F.lane); continue; } r -= I_WA;
        if (r < I_WO) { const FPlain f{a.in[14], D}; p0_tile(f, (bf16*)(ws + WS_WOT), 1024, (r / 32) * 64, (r % 32) * 32, scr, F.lane); continue; } r -= I_WO;
        if (r < I_W1) { const FPlain f{a.in[4], 256}; p0_tile(f, (bf16*)(ws + WS_W1K), 2048, (r / 8) * 64, (r % 8) * 32, scr, F.lane); continue; } r -= I_W1;
        if (r < I_W1) { const FPlain f{a.in[6], 256}; p0_tile(f, (bf16*)(ws + WS_W1V), 2048, (r / 8) * 64, (r % 8) * 32, scr, F.lane); continue; } r -= I_W1;
        if (r < I_W2) { const FPlain f{a.in[5], 64}; p0_tile(f, (bf16*)(ws + WS_W2K), 256, (r / 2) * 64, (r % 2) * 32, scr, F.lane); continue; } r -= I_W2;
        { const FPlain f{a.in[7], 64}; p0_tile(f, (bf16*)(ws + WS_W2V), 256, (r / 2) * 64, (r % 2) * 32, scr, F.lane); }
      } }
    { const int nu = (NTOK / 256) * (NZ / 256); if ((nu % F.G) == 0) p0_experts(F, a, gw, NGW, 0, P0_EXP_ITEMS); }
    { const f32x4* x4 = (const f32x4*)a.in[0]; u32x2* o = (u32x2*)(ws + WS_XB);
      const size_t total = (size_t)NTOK * D / 4, stride = (size_t)F.G * NTHR;
      for (size_t i0 = (size_t)F.bx * NTHR + F.tid; i0 < total; i0 += 8 * stride) { f32x4 v[8];
#pragma unroll
          for (int j = 0; j < 8; ++j) { const size_t i = i0 + j * stride; v[j] = i < total ? x4[i] : (f32x4){0.f, 0.f, 0.f, 0.f}; }
#pragma unroll
          for (int j = 0; j < 8; ++j) { const size_t i = i0 + j * stride; if (i < total) { u32x2 w; w.x = pk2(v[j][0], v[j][1]); w.y = pk2(v[j][2], v[j][3]); o[i] = w; } } } }
    if (F.bx < 64 && F.tid < 256) {
        const int kv = F.bx >> 5, j = F.bx & 31;
        const float* pe = (kv ? a.in[3] : a.in[2]) + 64 * j; const float* w1 = (kv ? a.in[6] : a.in[4]) + (size_t)(64 * j) * 256 + F.tid; float acc = 0.f;
#pragma unroll 16
        for (int k = 0; k < 64; ++k) acc += pe[k] * w1[(size_t)k * 256];
        ((float*)(ws + WS_BIASK))[(kv * 32 + j) * 256 + F.tid] = acc;
    }
    if (F.bx >= 64 && F.bx < 96) { const int idx = (F.bx - 64) * NTHR + F.tid;
        const int tab = idx >> 13, head = (idx >> 10) & 7, dist = idx & 1023;
        ((float*)(ws + (tab ? WS_TBB : WS_TBA)))[head * 1024 + dist] = rel_bucket_bias(a.in[11], dist, tab * 8 + head) * LOG2E; }
}

constexpr int NRT = 36;
constexpr int P6_WR = 0;
constexpr int P6_CNT = 147456;
constexpr int P6_ENT = 147456 + 512;
__device__ __forceinline__ float row16_sum(float v) {
    v += __builtin_bit_cast(float, __builtin_amdgcn_update_dpp(0, __builtin_bit_cast(int, v), 0xB1, 0xf, 0xf, true));
    v += __builtin_bit_cast(float, __builtin_amdgcn_update_dpp(0, __builtin_bit_cast(int, v), 0x4E, 0xf, 0xf, true));
    v += __builtin_bit_cast(float, __builtin_amdgcn_update_dpp(0, __builtin_bit_cast(int, v), 0x141, 0xf, 0xf, true));
    v += __builtin_bit_cast(float, __builtin_amdgcn_update_dpp(0, __builtin_bit_cast(int, v), 0x140, 0xf, 0xf, true));
    return v;
}
__device__ __forceinline__ float wave_sum_dpp(float v) { v = row16_sum(v); v += __shfl_xor(v, 16); v += __shfl_xor(v, 32); return v; }
__device__ __forceinline__ void phase6(const Frame& F, ArgsR a) {
    unsigned char* ws = F.ws;
    LAS float* WR = (LAS float*)(F.lds + P6_WR);
    LAS int* cntL = (LAS int*)(F.lds + P6_CNT); LAS int* baseL = cntL + 32;
    LAS int* ent = (LAS int*)(F.lds + P6_ENT);
    const float* w_grp = a.in[17]; const float* b_grp = a.in[18]; const float* w_rtr = a.in[19]; const float* b_rtr = a.in[20];
    {
        f32x4 wv[16], gv2[2];
#pragma unroll
        for (int i = 0; i < 16; ++i) wv[i] = *(const f32x4*)(w_rtr + 4 * (F.tid + NTHR * i));
#pragma unroll
        for (int i = 0; i < 2; ++i) gv2[i] = *(const f32x4*)(w_grp + 4 * (F.tid + NTHR * i));
#pragma unroll
        for (int i = 0; i < 16; ++i) { const int e = 4 * (F.tid + NTHR * i), k = e >> 5, o = e & 31;
#pragma unroll
            for (int c = 0; c < 4; ++c) WR[(4 + o + c) * 1024 + k] = wv[i][c]; }
#pragma unroll
        for (int i = 0; i < 2; ++i) { const int k = F.tid + NTHR * i;
#pragma unroll
            for (int c = 0; c < 4; ++c) WR[c * 1024 + k] = gv2[i][c]; }
    }
    if (F.tid < 65) cntL[F.tid] = 0;
    __syncthreads();
    const bf16* HP = (const bf16*)(ws + WS_H1); bf16* H1B = (bf16*)(ws + WS_H1B);
    const float* lg = a.in[15]; const float* lb = a.in[16];
    f32x2 gam[8], bet[8];
#pragma unroll
    for (int j = 0; j < 2; ++j)
#pragma unroll
        for (int q = 0; q < 4; ++q) { gam[4 * j + q] = *(const f32x2*)(lg + 512 * j + 8 * F.lane + 2 * q); bet[4 * j + q] = *(const f32x2*)(lb + 512 * j + 8 * F.lane + 2 * q); }
    unsigned* gcnt = (unsigned*)(ws + WS_CTL) + CW_CNT;
    int* list = (int*)(ws + WS_LIST); float* tokinfo = (float*)(ws + WS_TOKINFO);
    const int gw = F.bx * NWAVES + F.wave, NGW = F.G * NWAVES;
    u32x4 nx0, nx1;
    const int rpb = (NTOK + F.G - 1) / F.G, rbeg = F.bx * rpb, rend = (rbeg + rpb < NTOK) ? rbeg + rpb : NTOK;
    (void)gw; (void)NGW;
    if (rbeg + F.wave < rend) { const u32x4* hr = (const u32x4*)(HP + (size_t)(rbeg + F.wave) * D) + F.lane; nx0 = hr[0]; nx1 = hr[64]; }
    for (int row = rbeg + F.wave; row < rend; row += NWAVES) {
        const u32x4 r0 = nx0, r1 = nx1;
        if (row + NWAVES < rend) { const u32x4* hr = (const u32x4*)(HP + (size_t)(row + NWAVES) * D) + F.lane; nx0 = hr[0]; nx1 = hr[64]; }
        f32x2 v[8];
        v[0] = (f32x2){bflo(r0.x), bfhi(r0.x)}; v[1] = (f32x2){bflo(r0.y), bfhi(r0.y)}; v[2] = (f32x2){bflo(r0.z), bfhi(r0.z)}; v[3] = (f32x2){bflo(r0.w), bfhi(r0.w)};
        v[4] = (f32x2){bflo(r1.x), bfhi(r1.x)}; v[5] = (f32x2){bflo(r1.y), bfhi(r1.y)}; v[6] = (f32x2){bflo(r1.z), bfhi(r1.z)}; v[7] = (f32x2){bflo(r1.w), bfhi(r1.w)};
        f32x2 s2 = v[0];
#pragma unroll
        for (int q = 1; q < 8; ++q) s2 += v[q];
        const float mean = wave_sum_dpp(s2[0] + s2[1]) * (1.f / D);
        f32x2 q2 = {0.f, 0.f};
#pragma unroll
        for (int q = 0; q < 8; ++q) { v[q] = v[q] - mean; q2 += v[q] * v[q]; }
        const float rstd = 1.0f / sqrtf(wave_sum_dpp(q2[0] + q2[1]) * (1.f / D) + 1e-5f);
#pragma unroll
        for (int q = 0; q < 8; ++q) v[q] = v[q] * rstd * gam[q] + bet[q];
        { u32x4 w0, w1; w0.x = pk2(v[0][0], v[0][1]); w0.y = pk2(v[1][0], v[1][1]); w0.z = pk2(v[2][0], v[2][1]); w0.w = pk2(v[3][0], v[3][1]);
          w1.x = pk2(v[4][0], v[4][1]); w1.y = pk2(v[5][0], v[5][1]); w1.z = pk2(v[6][0], v[6][1]); w1.w = pk2(v[7][0], v[7][1]);
          u32x4* ob = (u32x4*)(H1B + (size_t)row * D) + F.lane; ob[0] = w0; ob[64] = w1; }
        auto rdot = [&](int o) { f32x2 p2 = {0.f, 0.f};
#pragma unroll
            for (int j = 0; j < 2; ++j) { const f32x4 wa = *(const LAS f32x4*)(WR + o * 1024 + 512 * j + 8 * F.lane), wb = *(const LAS f32x4*)(WR + o * 1024 + 512 * j + 8 * F.lane + 4);
                p2 += v[4 * j] * (f32x2){wa[0], wa[1]}; p2 += v[4 * j + 1] * (f32x2){wa[2], wa[3]}; p2 += v[4 * j + 2] * (f32x2){wb[0], wb[1]}; p2 += v[4 * j + 3] * (f32x2){wb[2], wb[3]}; }
            return row16_sum(p2[0] + p2[1]); };
        float g[4];
#pragma unroll
        for (int i = 0; i < 4; ++i) g[i] = rdot(i);
#pragma unroll
        for (int i = 0; i < 4; ++i) { float t = g[i]; t += __shfl_xor(t, 16); t += __shfl_xor(t, 32); g[i] = t + b_grp[i]; }
        int gs = 0; float gm = g[0];
#pragma unroll
        for (int i = 1; i < 4; ++i) if (g[i] > gm) { gm = g[i]; gs = i; }
        gs = __builtin_amdgcn_readfirstlane(gs);
        float gsum = 0.f;
#pragma unroll
        for (int i = 0; i < 4; ++i) gsum += __expf(g[i] - gm);
        const float pgrp = 1.0f / gsum;
        float el[8];
#pragma unroll
        for (int i = 0; i < 8; ++i) el[i] = rdot(4 + gs * 8 + i);
#pragma unroll
        for (int i = 0; i < 8; ++i) { float t = el[i]; t += __shfl_xor(t, 16); t += __shfl_xor(t, 32); el[i] = t + b_rtr[gs * 8 + i]; }
        int i1 = 0; float l1 = el[0];
#pragma unroll
        for (int i = 1; i < 8; ++i) if (el[i] > l1) { l1 = el[i]; i1 = i; }
        int i2 = -1; float l2 = -3.0e38f;
#pragma unroll
        for (int i = 0; i < 8; ++i) if (i != i1 && el[i] > l2) { l2 = el[i]; i2 = i; }
        const float e2 = __expf(l2 - l1), inv = 1.0f / (1.0f + e2);
        const float w0 = pgrp * inv, w1 = pgrp * e2 * inv;
        const int e0 = gs * 8 + i1, e1 = gs * 8 + i2;
        if (F.lane == 0) {
            const int p0 = atomicAdd((int*)&cntL[e0], 1), p1 = atomicAdd((int*)&cntL[e1], 1);
            const int n0 = atomicAdd((int*)&cntL[64], 2);
            ent[2 * n0] = (e0 << 16) | p0; ent[2 * n0 + 1] = row * 2;
            ent[2 * n0 + 2] = (e1 << 16) | p1; ent[2 * n0 + 3] = row * 2 + 1;
            tokinfo[row * 2] = w0; tokinfo[row * 2 + 1] = w1;
        }
    }
    __syncthreads();
    if (F.tid < 32) { const int c = cntL[F.tid]; baseL[F.tid] = c > 0 ? (int)__hip_atomic_fetch_add(gcnt + 64 * F.tid, (unsigned)c, __ATOMIC_RELAXED, __HIP_MEMORY_SCOPE_AGENT) : 0; }
    __syncthreads();
    const int nent = cntL[64];
    for (int i = F.tid; i < nent; i += NTHR) { const int ep = ent[2 * i], tk = ent[2 * i + 1]; const int e = ep >> 16, p = ep & 0xffff; list[(size_t)e * NTOK + baseL[e] + p] = tk; }
    __syncthreads();
}

constexpr int MOE_CUM = 131072;
struct MoeOrder {
    int G, c, NPs, mode; const LAS int* cum; unsigned* dep;
    __device__ __forceinline__ bool unit_of(int L, pg8::Unit& u) const {
        const int t = L >> NPs; if (t >= cum[32]) return false;
        const int e = cum[80 + t];
        const int j = t - cum[e]; u.pm = t; u.pn = L & ((1 << NPs) - 1); u.e = e | (j << 8); const int rem = cum[40 + e] - j * 256; u.nrows = rem < 256 ? rem : 256; return true; }
    static __device__ __forceinline__ void wait_for(const unsigned* w, unsigned need) {
        unsigned sp = 0;
        while (__hip_atomic_load(w, __ATOMIC_RELAXED, __HIP_MEMORY_SCOPE_AGENT) < need && ++sp < (1u << 22)) __builtin_amdgcn_s_sleep(2);
        __builtin_amdgcn_fence(__ATOMIC_ACQUIRE, "agent"); asm volatile("s_waitcnt vmcnt(0)" ::: "memory"); }
    __device__ bool next(int i, pg8::Unit& u) const {
        if (mode != 3) return unit_of(i * G + c, u);
        const int U8 = 2 * cum[32], R8 = U8 >> 8, nr = U8 & 255;
        const int na = R8 << 9, nb = 2 * U8 - na, S = (nr > 0 && R8 >= 2) ? 2 : 0, Jc = c < na ? (na - c + 255) >> 8 : 0;
        int L;
        if (c < nr) { L = c + 256 * (i + S); if (L >= na) return false; }
        else if (i < Jc) L = c + 256 * i;
        else { const int x = (c - nr) + (i - Jc) * (256 - nr); if (x >= S * nr + nb) return false;
            if (x < S * nr) L = x < nr ? x : x - nr + 256;
            else { L = na + (x - S * nr);
                if (__builtin_amdgcn_readfirstlane(threadIdx.x >> 6) == 0) wait_for(dep + 64, (unsigned)nr);
                asm volatile("" ::: "memory"); __builtin_amdgcn_s_barrier(); asm volatile("" ::: "memory"); } }
        return unit_of(L, u);
    }
    __device__ __forceinline__ void done(int ui) const {
        if (mode != 1) return;
        const int R8 = (2 * cum[32]) >> 8;
        if (ui == R8 - 1 || ui == R8) {
            asm volatile("s_waitcnt vmcnt(0)" ::: "memory");
            LAS unsigned* lcnt = (LAS unsigned*)((LAS unsigned char*)cum - MOE_CUM + MISC_OFF + 128);
            unsigned old = 0u;
            if ((threadIdx.x & 63) == 0) old = __hip_atomic_fetch_add(lcnt, 1u, __ATOMIC_RELAXED, __HIP_MEMORY_SCOPE_WORKGROUP);
            old = (unsigned)__builtin_amdgcn_readfirstlane((int)old);
            if ((old & 7u) == 7u) {
                __builtin_amdgcn_fence(__ATOMIC_RELEASE, "agent"); asm volatile("s_waitcnt vmcnt(0)" ::: "memory");
                if ((threadIdx.x & 63) == 0) __hip_atomic_fetch_add(dep + (ui == R8 ? 64 : 0), 1u, __ATOMIC_RELAXED, __HIP_MEMORY_SCOPE_AGENT); } }
    }
};
__device__ __forceinline__ void moe_setup(const Frame& F) {
    LAS int* cum = (LAS int*)(F.lds + MOE_CUM); LAS int* cnt = cum + 40;
    const unsigned* gcnt = (const unsigned*)(F.ws + WS_CTL) + CW_CNT;
    if (F.tid < 32) cnt[F.tid] = (int)__hip_atomic_load(gcnt + 64 * F.tid, __ATOMIC_RELAXED, __HIP_MEMORY_SCOPE_AGENT);
    __syncthreads();
    if (F.tid == 0) { int s = 0; for (int e = 0; e < 32; ++e) { cum[e] = s; s += (cnt[e] + 255) >> 8; } cum[32] = s; }
    __syncthreads();
    for (int t = F.tid; t < cum[32]; t += NTHR) { int e = 0; for (int k = 1; k < 32; ++k) if (t >= cum[k]) e = k; cum[80 + t] = e; }
    __syncthreads();
}
struct AGather { const void* base; unsigned kstep; const int* list;
    static constexpr bool GATHER = true;
    __device__ __forceinline__ const void* unit_ptr(const pg8::Unit&) const { return base; }
    __device__ __forceinline__ unsigned lane_off(int, int) const { return 0u; }
    __device__ __forceinline__ size_t hstep() const { return 0; }
    __device__ __forceinline__ unsigned row_off(const pg8::Unit& u, int r) const { const int e = u.e & 255, j = u.e >> 8; const int rr = r < u.nrows ? r : 0;
        const int tk = list[(size_t)e * NTOK + j * 256 + rr]; return (unsigned)(tk >> 1) * (unsigned)(D * 2); } };
struct BGu { const bf16* W; __device__ __forceinline__ const void* ptr(const pg8::Unit& u) const { return W + (size_t)(u.e & 255) * 512 * 1024 + (size_t)u.pn * 256 * 1024; } };
struct BDn { const bf16* W; __device__ __forceinline__ const void* ptr(const pg8::Unit& u) const { return W + (size_t)(u.e & 255) * 1024 * 256 + (size_t)u.pn * 256 * 256; } };
struct EpiAct {
    static constexpr bool PERM = true; bf16* ACT;
    __device__ __forceinline__ void operator()(const f32x4 (&acc)[2][2][4][2], const pg8::Unit& u, int wr, int wc, int fr, int fq) const {
        const int row0 = u.pm * 256 + wr * 64 + fr, col0 = u.pn * 128 + wc * 32 + 8 * fq;
#pragma unroll
        for (int ai = 0; ai < 2; ++ai)
#pragma unroll
            for (int m = 0; m < 4; ++m) { float o[8];
#pragma unroll
                for (int n = 0; n < 2; ++n)
#pragma unroll
                    for (int j = 0; j < 4; ++j) { const float gt = acc[ai][0][m][n][j], up = acc[ai][1][m][n][j]; o[4 * n + j] = gt * sigmoidf_(gt) * up; }
                u32x4 w; w.x = pk2(o[0], o[1]); w.y = pk2(o[2], o[3]); w.z = pk2(o[4], o[5]); w.w = pk2(o[6], o[7]);
                *(u32x4*)(ACT + (size_t)(row0 + ai * 128 + m * 16) * DEXP + col0) = w; }
    }
};
struct EpiDown {
    static constexpr bool PERM = true; bf16* Y; const int* list;
    __device__ __forceinline__ void operator()(const f32x4 (&acc)[2][2][4][2], const pg8::Unit& u, int wr, int wc, int fr, int fq) const {
        const int e = u.e & 255, j = u.e >> 8; const int col0 = u.pn * 256 + wc * 32 + 8 * fq;
        int tks[2][4];
#pragma unroll
        for (int ai = 0; ai < 2; ++ai)
#pragma unroll
            for (int m = 0; m < 4; ++m) { const int r = ai * 128 + wr * 64 + m * 16 + fr; tks[ai][m] = r < u.nrows ? list[(size_t)e * NTOK + j * 256 + r] : -1; }
#pragma unroll
        for (int ai = 0; ai < 2; ++ai)
#pragma unroll
            for (int m = 0; m < 4; ++m) { const int tk = tks[ai][m];
                if (tk >= 0) { bf16* rowp = Y + (size_t)tk * D + col0;
#pragma unroll
                    for (int bj = 0; bj < 2; ++bj) { const f32x4 v0 = acc[ai][bj][m][0], v1 = acc[ai][bj][m][1];
                        u32x4 w; w.x = pk2(v0[0], v0[1]); w.y = pk2(v0[2], v0[3]); w.z = pk2(v1[0], v1[1]); w.w = pk2(v1[2], v1[3]);
                        *(u32x4*)(rowp + bj * 128) = w; } } }
    }
};

__device__ __forceinline__ void phase9(const Frame& F, ArgsR a) {
    unsigned char* ws = F.ws;
    const bf16* H1B = (const bf16*)(ws + WS_H1B); const bf16* Y = (const bf16*)(ws + WS_YBUF); const float* tokinfo = (const float*)(ws + WS_TOKINFO);
    const float* lg = a.in[24]; const float* lb = a.in[25];
    f32x4 gam[4], bet[4];
#pragma unroll
    for (int j = 0; j < 2; ++j) { gam[2 * j] = *(const f32x4*)(lg + 512 * j + 8 * F.lane); gam[2 * j + 1] = *(const f32x4*)(lg + 512 * j + 8 * F.lane + 4); bet[2 * j] = *(const f32x4*)(lb + 512 * j + 8 * F.lane); bet[2 * j + 1] = *(const f32x4*)(lb + 512 * j + 8 * F.lane + 4); }
    const int gw = F.bx * NWAVES + F.wave, NGW = F.G * NWAVES;
    u32x4 nh[2], ny0[2], ny1[2]; float nw0 = 0.f, nw1 = 0.f;
#define P9_LOAD(row_) do { const u32x4* hp_ = (const u32x4*)(H1B + (size_t)(row_) * D) + F.lane; const u32x4* y0_ = (const u32x4*)(Y + (size_t)((row_) * 2) * D) + F.lane; const u32x4* y1_ = (const u32x4*)(Y + (size_t)((row_) * 2 + 1) * D) + F.lane; \
        nh[0] = hp_[0]; nh[1] = hp_[64]; ny0[0] = y0_[0]; ny0[1] = y0_[64]; ny1[0] = y1_[0]; ny1[1] = y1_[64]; nw0 = tokinfo[(row_) * 2]; nw1 = tokinfo[(row_) * 2 + 1]; } while (0)
    if (gw < NTOK) P9_LOAD(gw);
    for (int row = gw; row < NTOK; row += NGW) {
        u32x4 h[2] = {nh[0], nh[1]}, p[2] = {ny0[0], ny0[1]}, q[2] = {ny1[0], ny1[1]}; const float w0 = nw0, w1 = nw1;
        if (row + NGW < NTOK) P9_LOAD(row + NGW);
        f32x4 v[4]; float s = 0.f;
#pragma unroll
        for (int j = 0; j < 2; ++j) {
            v[2 * j][0] = ALPHA * bflo(h[j].x) + w0 * bflo(p[j].x) + w1 * bflo(q[j].x); v[2 * j][1] = ALPHA * bfhi(h[j].x) + w0 * bfhi(p[j].x) + w1 * bfhi(q[j].x);
            v[2 * j][2] = ALPHA * bflo(h[j].y) + w0 * bflo(p[j].y) + w1 * bflo(q[j].y); v[2 * j][3] = ALPHA * bfhi(h[j].y) + w0 * bfhi(p[j].y) + w1 * bfhi(q[j].y);
            v[2 * j + 1][0] = ALPHA * bflo(h[j].z) + w0 * bflo(p[j].z) + w1 * bflo(q[j].z); v[2 * j + 1][1] = ALPHA * bfhi(h[j].z) + w0 * bfhi(p[j].z) + w1 * bfhi(q[j].z);
            v[2 * j + 1][2] = ALPHA * bflo(h[j].w) + w0 * bflo(p[j].w) + w1 * bflo(q[j].w); v[2 * j + 1][3] = ALPHA * bfhi(h[j].w) + w0 * bfhi(p[j].w) + w1 * bfhi(q[j].w); }
#pragma unroll
        for (int j = 0; j < 4; ++j) s += (v[j][0] + v[j][1]) + (v[j][2] + v[j][3]);
        const float mean = wave_sum_dpp(s) * (1.f / D); float s2 = 0.f;
#pragma unroll
        for (int j = 0; j < 4; ++j) { v[j] = v[j] - mean; s2 += (v[j][0] * v[j][0] + v[j][1] * v[j][1]) + (v[j][2] * v[j][2] + v[j][3] * v[j][3]); }
        const float rstd = 1.0f / sqrtf(wave_sum_dpp(s2) * (1.f / D) + 1e-5f);
        float* orow = a.out + (size_t)row * D + 8 * F.lane;
#pragma unroll
        for (int j = 0; j < 2; ++j) { *(f32x4*)(orow + 512 * j) = v[2 * j] * rstd * gam[2 * j] + bet[2 * j]; *(f32x4*)(orow + 512 * j + 4) = v[2 * j + 1] * rstd * gam[2 * j + 1] + bet[2 * j + 1]; }
    }
#undef P9_LOAD
}
#define MFMA32(a, b, c) __builtin_amdgcn_mfma_f32_32x32x16_bf16((a), (b), (c), 0, 0, 0)
__device__ __forceinline__ int crow(int r, int hi) { return (r & 3) + 8 * (r >> 2) + 4 * hi; }
__device__ __forceinline__ float gelu_tanh(float x) { const float u = 0.7978845608028654f * (x + 0.044715f * x * x * x); const float e = __builtin_amdgcn_exp2f(2.885390081777927f * u); return 0.5f * x * (2.0f - 2.0f * __builtin_amdgcn_rcpf(e + 1.0f)); }
constexpr int P2_AROW = 4096 + 16;
constexpr int P2_HID = 32 * P2_AROW;
constexpr int P2_HROW = 512 + 16;
__device__ __forceinline__ void phase2(const Frame& F, ArgsR a) {
    unsigned char* ws = F.ws;
    const bf16* ZA = (const bf16*)(ws + WS_ZA);
    { const float* gn = a.in[8]; bf16* CK = (bf16*)(ws + WS_CKVN);
      const int sub = F.lane >> 4, l16 = F.lane & 15;
      float gv[8];
#pragma unroll
      for (int j = 0; j < 8; ++j) gv[j] = gn[l16 * 8 + j];
      const int r4b = F.bx * NWAVES + F.wave, r4s = F.G * NWAVES;
      for (int r4 = r4b; r4 < NTOK / 4; r4 += 4 * r4s) { u32x4 wv[4];
#pragma unroll
          for (int t = 0; t < 4; ++t) { const int rr = r4 + t * r4s; const int row = (rr < NTOK / 4 ? rr : r4) * 4 + sub; wv[t] = *(const u32x4*)(ZA + (size_t)row * ZA_LD + ZC_CKV + l16 * 8); }
#pragma unroll
          for (int t = 0; t < 4; ++t) { const int rr = r4 + t * r4s; if (rr < NTOK / 4) { const int row = rr * 4 + sub; const u32x4 w = wv[t];
              float v[8] = { bflo(w.x), bfhi(w.x), bflo(w.y), bfhi(w.y), bflo(w.z), bfhi(w.z), bflo(w.w), bfhi(w.w) };
              float s2 = 0.f;
#pragma unroll
              for (int j = 0; j < 8; ++j) s2 += v[j] * v[j];
              s2 += __shfl_xor(s2, 1); s2 += __shfl_xor(s2, 2); s2 += __shfl_xor(s2, 4); s2 += __shfl_xor(s2, 8);
              const float rs = 1.0f / sqrtf(s2 * (1.0f / 128.0f) + 1e-6f);
              u32x4 o; o.x = pk2(v[0] * rs * gv[0], v[1] * rs * gv[1]); o.y = pk2(v[2] * rs * gv[2], v[3] * rs * gv[3]); o.z = pk2(v[4] * rs * gv[4], v[5] * rs * gv[5]); o.w = pk2(v[6] * rs * gv[6], v[7] * rs * gv[7]);
              *(u32x4*)(CK + (size_t)row * 128 + l16 * 8) = o; } } } }
    const int r32 = F.lane & 31, hi = F.lane >> 5;
    for (int u = F.bx; u < 256; u += F.G) {
        const int kv = u >> 7, rt = u & 127, R0 = rt * 32;
        const int zc = kv ? ZC_VC : ZC_KC;
        const bf16* W1T = (const bf16*)(ws + (kv ? WS_W1V : WS_W1K)); const bf16* W2T = (const bf16*)(ws + (kv ? WS_W2V : WS_W2K));
        const float* bias = (const float*)(ws + WS_BIASK) + (size_t)kv * 32 * 256;
        bf16* OUT = (bf16*)(ws + (kv ? WS_VCMP : WS_KCMP));
        __syncthreads();
        { u32x4 av[16];
#pragma unroll
          for (int i = 0; i < 16; ++i) { const int q = F.tid + NTHR * i; const int row = q >> 8, cq = q & 255, l = cq >> 3, dch = cq & 7;
              const int R = R0 + row, b = R >> 9, c = (R >> 1) & 255, g = R & 1; const int cc = c < NCMP ? c : NCMP - 1;
              av[i] = *(const u32x4*)(ZA + (size_t)(b * SEQ + 16 * cc + l) * ZA_LD + zc + g * 64 + dch * 8); }
#pragma unroll
          for (int i = 0; i < 16; ++i) { const int q = F.tid + NTHR * i; const int row = q >> 8, cq = q & 255; *(LAS u32x4*)(F.lds + row * P2_AROW + cq * 16) = av[i]; } }
        __syncthreads();
        f32x16 acc = {};
        { const bf16* bp = W1T + (size_t)(32 * F.wave + r32) * 2048 + 8 * hi; const LAS unsigned char* ap = F.lds + r32 * P2_AROW + 16 * hi;
          f32x16 acc1 = {};
#pragma unroll 1
          for (int s0 = 0; s0 < 128; s0 += 32) { bf16x8 bfr[32];
#pragma unroll
              for (int j = 0; j < 32; ++j) bfr[j] = *(const bf16x8*)(bp + (s0 + j) * 16);
#pragma unroll
              for (int j = 0; j < 32; j += 2) { const bf16x8 a0 = *(const LAS bf16x8*)(ap + (s0 + j) * 32), a1 = *(const LAS bf16x8*)(ap + (s0 + j + 1) * 32); acc = MFMA32(a0, bfr[j], acc); acc1 = MFMA32(a1, bfr[j + 1], acc1); } }
#pragma unroll
          for (int i = 0; i < 16; ++i) acc[i] += acc1[i]; }
        { float bs = 0.f;
#pragma unroll 8
          for (int j = 0; j < 32; ++j) bs += bias[j * 256 + 32 * F.wave + r32];
#pragma unroll
          for (int i = 0; i < 16; ++i) { const float h = gelu_tanh(acc[i] + bs); *(LAS unsigned short*)(F.lds + P2_HID + crow(i, hi) * P2_HROW + (32 * F.wave + r32) * 2) = (unsigned short)f2bf(h); } }
        __syncthreads();
        if (F.wave < 2) {
            f32x16 o2 = {};
            const bf16* bp = W2T + (size_t)(32 * F.wave + r32) * 256 + 8 * hi; const LAS unsigned char* ap = F.lds + P2_HID + r32 * P2_HROW + 16 * hi;
#pragma unroll
            for (int s = 0; s < 16; ++s) { const bf16x8 af = *(const LAS bf16x8*)(ap + s * 32); const bf16x8 bfr = *(const bf16x8*)(bp + s * 16); o2 = MFMA32(af, bfr, o2); }
#pragma unroll
            for (int i = 0; i < 16; ++i) OUT[(size_t)(R0 + crow(i, hi)) * 64 + 32 * F.wave + r32] = (bf16)f2bf(o2[i]);
        }
    }
    __syncthreads();
}

typedef short v4i16_t __attribute__((ext_vector_type(4)));
__device__ __forceinline__ s16x4 vtr(const LAS unsigned char* p) { return __builtin_bit_cast(s16x4, __builtin_amdgcn_ds_read_tr16_b64_v4i16((LAS v4i16_t*)p)); }
constexpr int NSA_K = 0;
constexpr int NSA_V = 16384;
constexpr int NSA_TB = 49152;
constexpr int NSA_TBP = 1032;
constexpr int NSA_SC = 65792;
constexpr int NSA_MSK = 82176;
constexpr int NSA_OF = 84224;
constexpr float C2 = 0.125f * LOG2E;

__device__ __forceinline__ int prefix_cnt(unsigned long long b) { return (int)__builtin_amdgcn_mbcnt_hi((unsigned)(b >> 32), __builtin_amdgcn_mbcnt_lo((unsigned)b, 0u)); }
__device__ __forceinline__ int sbcnt64(unsigned long long m) { int n; asm("s_bcnt1_i32_b64 %0, %1" : "=s"(n) : "s"(m) : "scc"); return n; }
__device__ __forceinline__ float halfmax(float v, int xaddr) { return fmaxf(v, __builtin_bit_cast(float, __builtin_amdgcn_ds_bpermute(xaddr, __builtin_bit_cast(int, v)))); }
__device__ __forceinline__ void nsa_tile(const bool nc4, const LAS unsigned char* Kb, const LAS unsigned char* Vb, const LAS float* tbh, const bf16x8 (&qr)[4], f32x16 (&o)[4], float& m, float& l,
                                         int kt, int tq, int kmul, int kadd, int dmax, bool selbit, int mode, float b31, int r32, int hi, int lane, int xaddr) {
    const int tqa = tq - kadd, qk = kmul == 16 ? (tqa >> 4) : tqa, rem = kmul == 16 ? (tqa & 15) : 0;
    const int ebase = qk - (kt * 64 + 4 * hi);
    const LAS unsigned char* vp0 = Vb + ((lane >> 4) & 1) * 32 + (lane & 3) * 8 + (4 * hi + ((lane & 15) >> 2)) * 64;
    bf16x8 kf[2][4];
#pragma unroll
    for (int hf = 0; hf < 2; ++hf) {
#pragma unroll
        for (int d0 = 0; d0 < 4; ++d0) kf[hf][d0] = *(const LAS bf16x8*)(Kb + (2 * d0 + hi) * 1024 + (r32 + 32 * hf) * 16);
        asm volatile("" ::: "memory"); }
#pragma unroll
    for (int hf = 0; hf < 2; ++hf) {
        f32x16 s0 = {};
#pragma unroll
        for (int d0 = 0; d0 < 4; ++d0) asm volatile("" : "+v"(kf[hf][d0]));
#pragma unroll
        for (int d0 = 0; d0 < 4; ++d0) s0 = MFMA32(kf[hf][d0], qr[d0], s0);
        s16x4 vfl[4][2], vfh[4][2];
#pragma unroll
        for (int c = 0; c < 4; ++c) if (c < 2 || nc4)
#pragma unroll
            for (int s2 = 0; s2 < 2; ++s2) { const int s = 2 * hf + s2; vfl[c][s2] = vtr(vp0 + c * 4096 + s * 1024); vfh[c][s2] = vtr(vp0 + c * 4096 + s * 1024 + 512); }
        float tmax, mn, ps = 0.f;
        if (mode == 2) {
            float a0 = fmaxf(fmaxf(s0[0], s0[1]), s0[2]), a1 = fmaxf(fmaxf(s0[3], s0[4]), s0[5]);
            a0 = fmaxf(fmaxf(a0, s0[6]), s0[7]); a1 = fmaxf(fmaxf(a1, s0[8]), s0[9]); a0 = fmaxf(fmaxf(a0, s0[10]), s0[11]); a1 = fmaxf(fmaxf(a1, s0[12]), s0[13]); a0 = fmaxf(fmaxf(a0, s0[14]), s0[15]);
            const float cb = selbit ? b31 : NEGBIG;
            tmax = fmaxf(a0, a1) * C2 + cb;
            tmax = halfmax(tmax, xaddr);
            mn = fmaxf(m, tmax);
            const float cc = cb - mn;
#pragma unroll
            for (int r = 0; r < 16; ++r) { const float p0 = __builtin_amdgcn_exp2f(s0[r] * C2 + cc); s0[r] = p0; ps += p0; }
        } else if (mode == 1) {
            int eb1 = ebase; asm volatile("" : "+v"(eb1));
            unsigned tb1 = (unsigned)(unsigned long long)tbh + (unsigned)((eb1 - 96) * 4); asm volatile("" : "+v"(tb1));
            float bv[16];
#pragma unroll
            for (int r = 0; r < 16; ++r) bv[r] = *(const LAS float*)(tb1 + 4u * (unsigned)(96 - ((r & 3) + 8 * (r >> 2) + 32 * hf)));
#pragma unroll
            for (int r = 0; r < 16; ++r) asm volatile("" : "+v"(bv[r]));
            tmax = NEGBIG;
#pragma unroll
            for (int r = 0; r < 16; ++r) { const float x = s0[r] * C2 + bv[r]; s0[r] = x; tmax = fmaxf(tmax, x); }
            tmax = selbit ? tmax : NEGBIG;
            tmax = halfmax(tmax, xaddr);
            mn = fmaxf(m, tmax);
            const float mne = selbit ? mn : 1e30f;
#pragma unroll
            for (int r = 0; r < 16; ++r) { const float p0 = __builtin_amdgcn_exp2f(s0[r] - mne); s0[r] = p0; ps += p0; }
        } else if (mode == 3) {
            int eb1 = ebase; asm volatile("" : "+v"(eb1));
            unsigned tb1 = (unsigned)(unsigned long long)tbh + (unsigned)((eb1 - 96) * 4); asm volatile("" : "+v"(tb1));
            float bv[16];
#pragma unroll
            for (int r = 0; r < 16; ++r) bv[r] = *(const LAS float*)(tb1 + 4u * (unsigned)(96 - ((r & 3) + 8 * (r >> 2) + 32 * hf)));
#pragma unroll
            for (int r = 0; r < 16; ++r) asm volatile("" : "+v"(bv[r]));
            tmax = NEGBIG;
#pragma unroll
            for (int r = 0; r < 16; ++r) { const bool valid = (unsigned)(eb1 - ((r & 3) + 8 * (r >> 2) + 32 * hf)) < (unsigned)dmax;
                const float x = valid ? s0[r] * C2 + bv[r] : NEGBIG; s0[r] = x; tmax = fmaxf(tmax, x); }
            tmax = selbit ? tmax : NEGBIG;
            tmax = halfmax(tmax, xaddr);
            mn = fmaxf(m, tmax);
            const float mne = (selbit && mn > -1e29f) ? mn : 1e30f;
#pragma unroll
            for (int r = 0; r < 16; ++r) { const float p0 = __builtin_amdgcn_exp2f(s0[r] - mne); s0[r] = p0; ps += p0; }
        } else {
            tmax = NEGBIG;
            float bv[16];
            int eb0 = ebase; asm volatile("" : "+v"(eb0));
#pragma unroll
            for (int r = 0; r < 16; ++r) { const int dist = __mul24(eb0 - ((r & 3) + 8 * (r >> 2) + 32 * hf), kmul) + rem; int dc = dist < 0 ? 0 : dist; dc = dc > 1023 ? 1023 : dc; bv[r] = tbh[dc]; }
#pragma unroll
            for (int r = 0; r < 16; ++r) asm volatile("" : "+v"(bv[r]));
#pragma unroll
            for (int r = 0; r < 16; ++r) { const int dist = __mul24(eb0 - ((r & 3) + 8 * (r >> 2) + 32 * hf), kmul) + rem;
                const bool valid = selbit && dist >= 0 && dist < dmax;
                const float x = valid ? s0[r] * C2 + bv[r] : NEGBIG;
                s0[r] = x; tmax = fmaxf(tmax, x); }
            tmax = halfmax(tmax, xaddr);
            mn = fmaxf(m, tmax);
#pragma unroll
            for (int r = 0; r < 16; ++r) { const float p0 = s0[r] > -1e29f ? __builtin_amdgcn_exp2f(s0[r] - mn) : 0.f; s0[r] = p0; ps += p0; }
        }
        if (__any(mn != m)) {
            const float alpha = __builtin_amdgcn_exp2f(m - mn);
            l *= alpha;
#pragma unroll
            for (int c = 0; c < 4; ++c) if (c < 2 || nc4) {
#pragma unroll
                for (int r = 0; r < 16; ++r) o[c][r] *= alpha; }
        }
        m = mn;
        l += ps;
        u32x4 pw[2];
#pragma unroll
        for (int q = 0; q < 4; ++q) { pw[0][q] = pk2(s0[2 * q], s0[2 * q + 1]); pw[1][q] = pk2(s0[8 + 2 * q], s0[8 + 2 * q + 1]); }
#pragma unroll
        for (int c = 0; c < 4; ++c) if (c < 2 || nc4)
#pragma unroll
            for (int s2 = 0; s2 < 2; ++s2) { const s16x4 vl = vfl[c][s2], vh = vfh[c][s2];
                const bf16x8 vf = {vl[0], vl[1], vl[2], vl[3], vh[0], vh[1], vh[2], vh[3]};
                o[c] = MFMA32(vf, __builtin_bit_cast(bf16x8, pw[s2]), o[c]); }
    }
}

__device__ __forceinline__ void nsa_unit(const Frame& F, int b, int g, int qt) {
    unsigned char* ws = F.ws;
    const bf16* ZA = (const bf16*)(ws + WS_ZA);
    const int r32 = F.lane & 31, hi = F.lane >> 5, qi = r32 >> 2, hh = r32 & 3, head = g * 4 + hh;
    const int q0 = qt * 64, tq = q0 + 8 * F.wave + qi;
    const size_t zrow = (size_t)(b * SEQ + tq) * ZA_LD;
    const int srow = F.tid >> 3, sch = F.tid & 7;
    const f32x4* TBA4 = (const f32x4*)((const float*)(ws + WS_TBA) + (size_t)g * 4 * 1024);
    const f32x4 tbv0 = TBA4[F.tid], tbv1 = TBA4[F.tid + NTHR];
    const LAS float* tbh = (const LAS float*)(F.lds + NSA_TB) + hh * NSA_TBP;
    const int wq0 = q0 + 8 * F.wave;
    const float b31 = ((const float*)(ws + WS_TBA))[(size_t)head * 1024 + 1023];
    bf16x8 qr[4];
#pragma unroll
    for (int d0 = 0; d0 < 4; ++d0) qr[d0] = *(const bf16x8*)(ZA + zrow + ZC_QA + head * 64 + d0 * 16 + hi * 8);
    unsigned short graw[3];
#pragma unroll
    for (int i = 0; i < 3; ++i) graw[i] = ZA[zrow + ZC_GNSA + head * 3 + i];
    { LAS f32x4* tb4 = (LAS f32x4*)(F.lds + NSA_TB) + (F.tid >> 8) * (NSA_TBP / 4) + (F.tid & 255); tb4[0] = tbv0; tb4[2 * (NSA_TBP / 4)] = tbv1; }
    float gate[3];
#pragma unroll
    for (int i = 0; i < 3; ++i) gate[i] = sigmoidf_(bf2f(graw[i]));
    LAS float* ofw = (LAS float*)(F.lds + NSA_OF) + F.wave * 2048 + F.lane;
    unsigned mlo = 0u, mhi = 0u;
    const int xaddr = (F.lane ^ 32) << 2;
    u32x4 kreg, vreg = {0u, 0u, 0u, 0u};
    const bf16* kgp; size_t vdel, tstep;
#define NSA_SETUP(br_) do { const int b_ = (br_); const bf16* Kg_; size_t pitch_; int tl_; \
        if (b_ == 0) { Kg_ = (const bf16*)(ws + WS_KCMP) + (size_t)(b * 256) * 128 + g * 64; vdel = (size_t)((const bf16*)(ws + WS_VCMP) - (const bf16*)(ws + WS_KCMP)); pitch_ = 128; tl_ = 0; } \
        else { Kg_ = ZA + (size_t)(b * SEQ) * ZA_LD + (b_ == 1 ? ZC_KS : ZC_KW) + g * 64; vdel = 128; pitch_ = ZA_LD; tl_ = (b_ == 2 && qt > 8) ? qt - 8 : 0; } \
        kgp = Kg_ + (size_t)(tl_ * 64 + srow) * pitch_ + sch * 8; tstep = (size_t)64 * pitch_; } while (0)
#define NSA_GLOAD(kt_) do { kreg = *(const u32x4*)kgp; vreg = *(const u32x4*)(kgp + vdel); kgp += tstep; } while (0)
    NSA_SETUP(0); NSA_GLOAD(0);
#pragma nounroll
    for (int br = 0; br < 3; ++br) {
        const bool iscmp = br == 0;
        const int t_lo = iscmp ? 0 : ((br == 2 && qt > 8) ? qt - 8 : 0), t_hi = iscmp ? ((q0 + 32) >> 10) : qt;
        const int kmul = iscmp ? 16 : 1, kadd = iscmp ? 31 : 0, dmax = br == 2 ? 512 : 0x40000000;
        f32x16 o[4]; o[0] = f32x16{}; o[1] = f32x16{}; o[2] = f32x16{}; o[3] = f32x16{};
        float m = NEGBIG, l = 0.f;
#define NSA_LSTORE(kt_, buf_) do { \
        *(LAS u32x4*)(F.lds + NSA_K + (buf_) * 8192 + sch * 1024 + srow * 16) = kreg; \
        *(LAS u32x4*)(F.lds + NSA_V + (buf_) * 16384 + (sch >> 2) * 4096 + srow * 64 + (sch & 3) * 16) = vreg; \
        if (iscmp) { const int c_ = (kt_) * 64 + srow, jj_ = c_ >> 2, mm_ = c_ & 3; u32x4 mv_; \
            _Pragma("unroll") for (int i_ = 0; i_ < 4; ++i_) { const int j0_ = sch * 8 + 2 * i_, j1_ = j0_ + 1; \
                const unsigned e0_ = (c_ < NCMP) ? (mm_ < 3 ? (j0_ == jj_ ? 0x4000u : 0u) : ((j0_ == jj_ || j0_ == jj_ + 1) ? 0x3F80u : 0u)) : 0u; \
                const unsigned e1_ = (c_ < NCMP) ? (mm_ < 3 ? (j1_ == jj_ ? 0x4000u : 0u) : ((j1_ == jj_ || j1_ == jj_ + 1) ? 0x3F80u : 0u)) : 0u; \
                mv_[i_] = e0_ | (e1_ << 16); } \
            *(LAS u32x4*)(F.lds + NSA_V + (buf_) * 16384 + (2 + (sch >> 2)) * 4096 + srow * 64 + (sch & 3) * 16) = mv_; } } while (0)
        NSA_LSTORE(t_lo, 0);
        __syncthreads();
        int buf = 0;
#pragma nounroll
        for (int kt = t_lo; kt <= t_hi; ++kt) {
            const int ktn = kt + 1; const bool more = kt < t_hi;
            if (more) NSA_GLOAD(ktn);
            const bool selbit = br == 1 ? (((kt < 32 ? (mlo >> kt) : (mhi >> (kt - 32))) & 1u) != 0u) : true;
            int mode = 0;
            { const int dmin = wq0 - (64 * kt + 63), dmx = wq0 + 7 - 64 * kt;
              if (br == 1) mode = dmin >= 790 ? 2 : (dmin >= 0 ? 1 : 3);
              if (br == 0) mode = 16 * (((wq0 - 31) >> 4) - (64 * kt + 63)) >= 790 ? 2 : 0;
              if (br == 2) mode = (dmin >= 0 && dmx <= 511) ? 1 : 3; }
            if (__any(selbit))
                nsa_tile(iscmp, F.lds + NSA_K + buf * 8192, F.lds + NSA_V + buf * 16384, tbh, qr, o, m, l, kt, tq, kmul, kadd, dmax, selbit, mode, b31, r32, hi, F.lane, xaddr);
            if (more) NSA_LSTORE(ktn, buf ^ 1);
            __syncthreads();
            buf ^= 1;
        }
#undef NSA_LSTORE
        if (br < 2) { NSA_SETUP(br + 1); NSA_GLOAD(0); }
        l += __shfl_xor(l, 32);
        const float inv = l > 0.f ? 1.0f / l : 0.f;
        { const float sc = inv * (br == 0 ? gate[0] : br == 1 ? gate[1] : gate[2]);
#pragma unroll
            for (int c = 0; c < 2; ++c)
#pragma unroll
                for (int r = 0; r < 16; ++r) { const float prev = br == 0 ? 0.f : ofw[(c * 16 + r) * 64]; ofw[(c * 16 + r) * 64] = prev + o[c][r] * sc; } }
        if (iscmp) {
            LAS float* scw = (LAS float*)(F.lds + NSA_SC) + F.wave * 512;
#pragma unroll
            for (int c = 0; c < 2; ++c)
#pragma unroll
                for (int r = 0; r < 16; ++r) { float v = o[2 + c][r] * inv;
                    v += __builtin_bit_cast(float, __builtin_amdgcn_update_dpp(0, __builtin_bit_cast(int, v), 0xB1, 0xf, 0xf, true));
                    v += __builtin_bit_cast(float, __builtin_amdgcn_update_dpp(0, __builtin_bit_cast(int, v), 0x4E, 0xf, 0xf, true));
                    if (hh == 0) scw[qi * 64 + 32 * c + crow(r, hi)] = v; }
            LDS_WAIT();
            LAS unsigned* mskw = (LAS unsigned*)(F.lds + NSA_MSK) + F.wave * 16;
#pragma nounroll
            for (int q = 0; q < 8; q += 2) {
                unsigned key[2]; bool av[2];
#pragma unroll
                for (int u = 0; u < 2; ++u) { const int curq = (q0 + 8 * F.wave + q + u) >> 6, j = F.lane;
                    av[u] = j <= curq; const bool forced = (j == 0) || (j == curq) || (j == curq - 1);
                    const float sj = scw[(q + u) * 64 + j] + (forced ? 1e4f : 0.f);
                    key[u] = av[u] ? __builtin_bit_cast(unsigned, sj + 0.0f) + 1u : 0u; }
                unsigned T0 = 0u, T1 = 0u;
#pragma unroll
                for (int bit = 30; bit >= 0; --bit) { const unsigned c0 = T0 | (1u << bit), c1 = T1 | (1u << bit);
                    const int n0 = sbcnt64(__ballot(key[0] >= c0)), n1 = sbcnt64(__ballot(key[1] >= c1));
                    T0 = n0 >= 16 ? c0 : T0; T1 = n1 >= 16 ? c1 : T1; }
#pragma unroll
                for (int u = 0; u < 2; ++u) { const unsigned T = u ? T1 : T0;
                    const bool gt = key[u] > T, eq = key[u] == T;
                    const int need = 16 - sbcnt64(__ballot(gt));
                    const bool sel = (gt || (eq && prefix_cnt(__ballot(eq)) < need)) && av[u];
                    const unsigned long long bm = __ballot(sel);
                    if (F.lane == 0) { mskw[2 * (q + u)] = (unsigned)bm; mskw[2 * (q + u) + 1] = (unsigned)(bm >> 32); } } }
            LDS_WAIT();
            mlo = mskw[2 * qi]; mhi = mskw[2 * qi + 1];
        }
    }
#undef NSA_GLOAD
#undef NSA_SETUP
    bf16* OA = (bf16*)(ws + WS_OA) + (size_t)(b * SEQ + tq) * 512 + head * 64;
#pragma unroll
    for (int c = 0; c < 2; ++c)
#pragma unroll
        for (int r4 = 0; r4 < 4; ++r4) { u32x2 w; w.x = pk2(ofw[(c * 16 + 4 * r4) * 64], ofw[(c * 16 + 4 * r4 + 1) * 64]); w.y = pk2(ofw[(c * 16 + 4 * r4 + 2) * 64], ofw[(c * 16 + 4 * r4 + 3) * 64]);
            *(u32x2*)(OA + 32 * c + 8 * r4 + 4 * hi) = w; }
}
__device__ __forceinline__ void phase3(const Frame& F) {
    const bool xcd = (F.G == 256);
    const int pstart = xcd ? (F.bx >> 3) : F.bx, pstep = xcd ? 32 : F.G, pend = xcd ? 64 : 512;
#pragma nounroll
    for (int p2 = 2 * pstart; p2 < 2 * pend; p2 += (p2 & 1) ? 2 * pstep - 1 : 1) { const int p = p2 >> 1;
        const int b = xcd ? (F.bx & 7) : (p >> 6), g = (p >> 5) & 1, qt = p & 31;
        nsa_unit(F, b, g, (p2 & 1) ? qt : 63 - qt); }
    __syncthreads();
}

#define MFMA16(a, b, c) __builtin_amdgcn_mfma_f32_16x16x32_bf16((a), (b), (c), 0, 0, 0)
constexpr int DSA_SCP = 8200;
constexpr int DSA_SC = 0;
constexpr int DSA_LIST = 16 * DSA_SCP;
constexpr int DSA_NSEL = DSA_LIST + 8192;
constexpr int DSA_BIAS = DSA_NSEL + 64;
constexpr int DSA_HIST = DSA_BIAS + 1088;
constexpr int DSA_BKI = DSA_HIST + 8192;
constexpr int KSEL = 256;
__device__ __forceinline__ unsigned dsa_offb(unsigned row, unsigned ch) { return 256u * row + 16u * (ch ^ (((row & 3u) << 2) | ((row >> 2) & 3u))); }
__device__ __forceinline__ unsigned sortkey16(float x) { x = x + 0.0f; const unsigned short h = __builtin_bit_cast(unsigned short, (_Float16)x); return (h & 0x8000u) ? (unsigned)(unsigned short)~h : (unsigned)(h | 0x8000u); }

__device__ __forceinline__ void dsa_unit(const Frame& F, ArgsR a, int b, int qt16) {
    unsigned char* ws = F.ws;
    const bf16* ZA = (const bf16*)(ws + WS_ZA);
    const int lane = F.lane, l16 = lane & 15, quad = lane >> 4, q0 = qt16 * 16;
    __syncthreads();
#ifndef PROBE_DSA
#define PROBE_DSA 0
#endif
    for (int rep1_ = 0; rep1_ < (PROBE_DSA == 1 ? 2 : 1); ++rep1_) {
        const size_t qrow = (size_t)(b * SEQ + q0 + l16) * ZA_LD;
        bf16x8 qf[4][2];
#pragma unroll
        for (int i = 0; i < 4; ++i)
#pragma unroll
            for (int ks = 0; ks < 2; ++ks) qf[i][ks] = *(const bf16x8*)(ZA + qrow + ZC_QIDX + i * 64 + 32 * ks + 8 * quad);
        float wq[4];
#pragma unroll
        for (int i = 0; i < 4; ++i) wq[i] = bf2f(ZA[qrow + ZC_WIDX + i]) * 0.0625f;
        const int tq = q0 + l16, nkt = qt16 + 1;
        const bf16* kbase = ZA + (size_t)(b * SEQ + l16) * ZA_LD + ZC_KIDX + 8 * quad;
        bf16x8 ka[4][2], kn[4][2];
#define DSA_KLOAD(dst, kt0_) do { _Pragma("unroll") for (int t_ = 0; t_ < 4; ++t_) { const int k_ = (kt0_) + 8 * t_; const int kc_ = k_ < nkt ? k_ : nkt - 1; \
            dst[t_][0] = *(const bf16x8*)(kbase + (size_t)(kc_ * 16) * ZA_LD); dst[t_][1] = *(const bf16x8*)(kbase + (size_t)(kc_ * 16) * ZA_LD + 32); } } while (0)
        if (F.wave < nkt) DSA_KLOAD(ka, F.wave);
#pragma nounroll
        for (int kt0 = F.wave; kt0 < nkt; kt0 += 32) {
            if (kt0 + 32 < nkt) DSA_KLOAD(kn, kt0 + 32);
#pragma unroll
            for (int t = 0; t < 4; ++t) { const int kt = kt0 + 8 * t;
                if (kt < nkt) {
                    float idx[4] = {0.f, 0.f, 0.f, 0.f};
#pragma unroll
                    for (int i = 0; i < 4; ++i) { f32x4 acc = {0.f, 0.f, 0.f, 0.f}; acc = MFMA16(ka[t][0], qf[i][0], acc); acc = MFMA16(ka[t][1], qf[i][1], acc);
#pragma unroll
                        for (int r = 0; r < 4; ++r) idx[r] += fmaxf(acc[r], 0.f) * wq[i]; }
                    unsigned k16[4];
#pragma unroll
                    for (int r = 0; r < 4; ++r) { const int key = kt * 16 + 4 * quad + r; k16[r] = key <= tq ? sortkey16(idx[r]) : 0u; }
                    u32x2 w; w.x = k16[0] | (k16[1] << 16); w.y = k16[2] | (k16[3] << 16);
                    *(LAS u32x2*)(F.lds + DSA_SC + l16 * DSA_SCP + (kt * 16 + 4 * quad) * 2) = w; } }
#pragma unroll
            for (int t = 0; t < 4; ++t) { ka[t][0] = kn[t][0]; ka[t][1] = kn[t][1]; }
        }
#undef DSA_KLOAD
    }
    if (F.tid < 264) { const float* rb = a.in[11]; ((LAS float*)(F.lds + DSA_BIAS))[F.tid] = F.tid < 256 ? rb[(F.tid >> 3) * 16 + 8 + (F.tid & 7)] * LOG2E : NEGBIG; }
    __syncthreads();
    bf16x8 ql[2][4];
#pragma unroll
    for (int qq = 0; qq < 2; ++qq)
#pragma unroll
        for (int s2 = 0; s2 < 4; ++s2) { const bf16x8 v = *(const bf16x8*)(ZA + (size_t)(b * SEQ + q0 + 2 * F.wave + qq) * ZA_LD + ZC_QLAT + (l16 & 7) * 128 + 32 * s2 + 8 * quad); ql[qq][s2] = l16 < 8 ? v : (bf16x8){0, 0, 0, 0, 0, 0, 0, 0}; }
#pragma nounroll
    for (int qq = 0; qq < (PROBE_DSA == 2 ? 4 : 2); ++qq) {
        const int n = 2 * F.wave + (qq & 1), tq = q0 + n, N = tq + 1;
        LAS unsigned char* scq = F.lds + DSA_SC + n * DSA_SCP;
        LAS unsigned short* lst = (LAS unsigned short*)(F.lds + DSA_LIST) + n * 256;
        LAS unsigned short* bki = (LAS unsigned short*)(F.lds + DSA_BKI) + n * 256;
        if (N <= KSEL) {
            for (int s = lane; s < KSEL; s += 64) lst[s] = (unsigned short)(s < N ? s : 0);
            if (lane == 0) ((LAS int*)(F.lds + DSA_NSEL))[n] = N;
        } else {
            const int nit = (N + 255) >> 8;
            { const int it = nit - 1; const int s0 = 4 * (lane + 64 * it); u32x2 w = *(LAS u32x2*)(scq + s0 * 2);
              if (s0 + 0 > tq) w.x &= 0xffff0000u; if (s0 + 1 > tq) w.x &= 0x0000ffffu; if (s0 + 2 > tq) w.y &= 0xffff0000u; if (s0 + 3 > tq) w.y &= 0x0000ffffu;
              *(LAS u32x2*)(scq + s0 * 2) = w; }
            LDS_WAIT();
            LAS unsigned* hist = (LAS unsigned*)(F.lds + DSA_HIST) + F.wave * 256;
            unsigned T = 0u; int cgt = 0; int need = KSEL;
#pragma nounroll
            for (int lvl = 0; lvl < 2; ++lvl) {
                *(LAS u32x4*)(hist + 4 * lane) = (u32x4){0u, 0u, 0u, 0u};
                LDS_WAIT();
#pragma nounroll
                for (int it = 0; it < nit; ++it) { const u32x2 w = *(LAS u32x2*)(scq + (lane + 64 * it) * 8);
                    const unsigned k[4] = {w.x & 0xffffu, w.x >> 16, w.y & 0xffffu, w.y >> 16};
#pragma unroll
                    for (int e = 0; e < 4; ++e) { const bool in = lvl == 0 ? true : (k[e] >> 8) == (T >> 8); const unsigned bin = lvl == 0 ? (k[e] >> 8) : (k[e] & 255u);
                        if (in) __hip_atomic_fetch_add(hist + bin, 1u, __ATOMIC_RELAXED, __HIP_MEMORY_SCOPE_WORKGROUP); } }
                LDS_WAIT();
                const u32x4 h = *(LAS u32x4*)(hist + 4 * lane);
                const int sl = (int)(h.x + h.y + h.z + h.w); int suf = sl;
#pragma unroll
                for (int d = 1; d < 64; d <<= 1) { const int o = __shfl_down(suf, d); suf += (lane + d < 64) ? o : 0; }
                const int above = suf - sl;
                const bool here = above < need && above + sl >= need;
                int bsel = 4 * lane + 3, ca = above;
                if (ca + (int)h.w < need) { ca += (int)h.w; bsel = 4 * lane + 2; if (ca + (int)h.z < need) { ca += (int)h.z; bsel = 4 * lane + 1; if (ca + (int)h.y < need) { ca += (int)h.y; bsel = 4 * lane; } } }
                const unsigned long long bm = __ballot(here);
                const int src = bm ? (int)__builtin_ctzll(bm) : 0;
                const int B = __shfl(bsel, src), CA = __shfl(ca, src);
                if (lvl == 0) T = (unsigned)B << 8; else T |= (unsigned)B;
                cgt += CA; need -= CA;
                LDS_WAIT();
            }
            const int rties = KSEL - cgt;
            int tiebase = 0, outbase = 0;
#define DSA_PUT(pos_, idx_) do { const int p_ = (pos_); if (p_ >= 0 && p_ < KSEL) lst[p_] = (unsigned short)(idx_); } while (0)
#pragma nounroll
            for (int it = 0; it < nit; ++it) { const u32x2 w = *(LAS u32x2*)(scq + (lane + 64 * it) * 8);
                const unsigned k0 = w.x & 0xffffu, k1 = w.x >> 16, k2 = w.y & 0xffffu, k3 = w.y >> 16;
                const int sidx = 4 * (lane + 64 * it);
                const bool g0 = k0 > T, g1 = k1 > T, g2 = k2 > T, g3 = k3 > T;
                const unsigned long long bg0 = __ballot(g0), bg1 = __ballot(g1), bg2 = __ballot(g2), bg3 = __ballot(g3);
                if (bg0 | bg1 | bg2 | bg3) {
                    int pos = outbase + prefix_cnt(bg0) + prefix_cnt(bg1) + prefix_cnt(bg2) + prefix_cnt(bg3);
                    if (g0) { DSA_PUT(pos, sidx + 0); ++pos; }
                    if (g1) { DSA_PUT(pos, sidx + 1); ++pos; }
                    if (g2) { DSA_PUT(pos, sidx + 2); ++pos; }
                    if (g3) { DSA_PUT(pos, sidx + 3); ++pos; }
                    outbase += __popcll(bg0) + __popcll(bg1) + __popcll(bg2) + __popcll(bg3); }
                const bool e0 = k0 == T, e1 = k1 == T, e2 = k2 == T, e3 = k3 == T;
                const unsigned long long be0 = __ballot(e0), be1 = __ballot(e1), be2 = __ballot(e2), be3 = __ballot(e3);
                if ((be0 | be1 | be2 | be3) && tiebase < rties) {
                    const int t0 = tiebase + prefix_cnt(be0) + prefix_cnt(be1) + prefix_cnt(be2) + prefix_cnt(be3), t1 = t0 + (e0 ? 1 : 0), t2 = t1 + (e1 ? 1 : 0), t3 = t2 + (e2 ? 1 : 0);
                    if (e0 && t0 < rties) DSA_PUT(KSEL - 1 - t0, sidx + 0);
                    if (e1 && t1 < rties) DSA_PUT(KSEL - 1 - t1, sidx + 1);
                    if (e2 && t2 < rties) DSA_PUT(KSEL - 1 - t2, sidx + 2);
                    if (e3 && t3 < rties) DSA_PUT(KSEL - 1 - t3, sidx + 3);
                    tiebase += __popcll(be0) + __popcll(be1) + __popcll(be2) + __popcll(be3); } }
#undef DSA_PUT
            outbase = KSEL;
            if (lane == 0) ((LAS int*)(F.lds + DSA_NSEL))[n] = outbase < KSEL ? outbase : KSEL;
        }
        LDS_WAIT();
        { const int nsl = N < KSEL ? N : KSEL;
#pragma unroll
          for (int i = 0; i < 4; ++i) { const int e = lane + 64 * i; const int dist = tq - (int)lst[e];
              const int dpos = dist < 1 ? 1 : dist; int bl = 16 + (int)((__log2f((float)dpos) - 4.0f) * 2.66666675f); bl = bl > 31 ? 31 : bl;
              const int bk = dist < 1 ? 0 : (dpos < 16 ? dpos : bl);
              bki[e] = (unsigned short)(e < nsl ? bk * 32 : 1024); } }
    }
    LDS_WAIT();
    const bf16* CK = (const bf16*)(ws + WS_CKVN) + (size_t)(b * SEQ) * 128;
    LAS unsigned char* gb0 = F.lds + DSA_SC + (2 * F.wave) * DSA_SCP;
    const LAS unsigned char* biasb = F.lds + DSA_BIAS + (l16 & 7) * 4;
#define DSA_GATHER(chunk_, buf_) do { const unsigned key_ = lst[(chunk_) * 32 + (lane >> 1)]; const char* src_ = (const char*)CK + (key_ * 256u + (unsigned)(lane & 1) * 16u); \
        _Pragma("unroll") for (int c_ = 0; c_ < 8; ++c_) __builtin_amdgcn_global_load_lds((const unsigned*)(src_ + c_ * 32), (LAS unsigned*)(gb0 + (buf_) * 8192 + c_ * 1024), 16, 0, 0); } while (0)
    int tqs[2], nsels[2]; const LAS unsigned short* lsts[2]; const LAS unsigned short* bkis[2]; f32x4 o[2][8]; float ms[2], ls[2];
#pragma unroll
    for (int qq = 0; qq < 2; ++qq) { const int n = 2 * F.wave + qq; tqs[qq] = q0 + n; nsels[qq] = ((const LAS int*)(F.lds + DSA_NSEL))[n]; lsts[qq] = (const LAS unsigned short*)(F.lds + DSA_LIST) + n * 256; bkis[qq] = (const LAS unsigned short*)(F.lds + DSA_BKI) + n * 256;
#pragma unroll
        for (int c = 0; c < 8; ++c) o[qq][c] = (f32x4){0.f, 0.f, 0.f, 0.f};
        ms[qq] = NEGBIG; ls[qq] = 0.f; }
#pragma unroll
    for (int qq = 0; qq < 2; ++qq)
#pragma unroll
        for (int s2 = 0; s2 < 4; ++s2) asm volatile("" : "+v"(ql[qq][s2]));
    const int nch1 = (nsels[1] + 31) >> 5, nch = PROBE_DSA == 3 ? 2 * nch1 : nch1;
    LDS_WAIT();
    { const LAS unsigned short* lst = lsts[0]; DSA_GATHER(0, 0); }
    { const LAS unsigned short* lst = lsts[1]; DSA_GATHER(0, 1); }
    const unsigned offA = (unsigned)((quad >> 1) * 1024 + l16 * 32 + (quad & 1) * 16);
    const unsigned offT = (unsigned)((4 * quad + (l16 >> 2)) * 32 + 8 * (lane & 3));
#pragma nounroll
    for (int ch = 0; ch < nch; ++ch) {
#pragma unroll
        for (int qq = 0; qq < 2; ++qq) {
            const int chd = ch >= nch1 ? ch - nch1 : ch;
            const LAS unsigned short* lst = lsts[qq];
            const LAS unsigned char* gb = gb0 + qq * 8192;
            if (qq == 0 || ch + 1 < nch) asm volatile("s_waitcnt vmcnt(8)" ::: "memory"); else asm volatile("s_waitcnt vmcnt(0)" ::: "memory");
            f32x4 acc2[2]; float bvs[2][4];
#pragma unroll
            for (int rb = 0; rb < 2; ++rb) { f32x4 acc = {0.f, 0.f, 0.f, 0.f};
#pragma unroll
                for (int s2 = 0; s2 < 4; ++s2) { const bf16x8 af = *(const LAS bf16x8*)(gb + offA + rb * 512 + s2 * 2048); acc = MFMA16(af, ql[qq][s2], acc); }
                acc2[rb] = acc;
                const u32x2 kb = *(const LAS u32x2*)((const LAS unsigned char*)bkis[qq] + (chd * 32 + rb * 16 + 4 * quad) * 2);
                bvs[rb][0] = *(const LAS float*)(biasb + (kb.x & 0xffffu)); bvs[rb][1] = *(const LAS float*)(biasb + (kb.x >> 16));
                bvs[rb][2] = *(const LAS float*)(biasb + (kb.y & 0xffffu)); bvs[rb][3] = *(const LAS float*)(biasb + (kb.y >> 16)); }
#pragma unroll
            for (int rb = 0; rb < 2; ++rb)
#pragma unroll
                for (int r = 0; r < 4; ++r) asm volatile("" : "+v"(bvs[rb][r]));
            float x[2][4]; float tmax = NEGBIG;
#pragma unroll
            for (int rb = 0; rb < 2; ++rb)
#pragma unroll
                for (int r = 0; r < 4; ++r) { const float xv = acc2[rb][r] * C2 + bvs[rb][r]; x[rb][r] = xv; tmax = fmaxf(tmax, xv); }
            tmax = fmaxf(tmax, __shfl_xor(tmax, 16)); tmax = fmaxf(tmax, __shfl_xor(tmax, 32));
            const float mn = fmaxf(ms[qq], tmax); const bool resc = __any(mn != ms[qq]); const float alpha = __builtin_amdgcn_exp2f(ms[qq] - mn); ms[qq] = mn;
            float ps = 0.f;
#pragma unroll
            for (int rb = 0; rb < 2; ++rb)
#pragma unroll
                for (int r = 0; r < 4; ++r) { const float pv = __builtin_amdgcn_exp2f(x[rb][r] - mn); x[rb][r] = pv; ps += pv; }
            ls[qq] = ls[qq] * alpha + ps;
            if (resc) {
#pragma unroll
                for (int c = 0; c < 8; ++c) o[qq][c] = o[qq][c] * alpha; }
            u32x4 pw; pw.x = pk2(x[0][0], x[0][1]); pw.y = pk2(x[0][2], x[0][3]); pw.z = pk2(x[1][0], x[1][1]); pw.w = pk2(x[1][2], x[1][3]);
            const unsigned gba = (unsigned)(unsigned long long)gb + offT;
#pragma unroll
            for (int cb = 0; cb < 2; ++cb) {
                s16x4 v[8];
                if (cb == 0) asm volatile("ds_read_b64_tr_b16 %0, %8\n\tds_read_b64_tr_b16 %1, %8 offset:512\n\tds_read_b64_tr_b16 %2, %8 offset:1024\n\tds_read_b64_tr_b16 %3, %8 offset:1536\n\t"
                             "ds_read_b64_tr_b16 %4, %8 offset:2048\n\tds_read_b64_tr_b16 %5, %8 offset:2560\n\tds_read_b64_tr_b16 %6, %8 offset:3072\n\tds_read_b64_tr_b16 %7, %8 offset:3584\n\ts_waitcnt lgkmcnt(0)"
                             : "=&v"(v[0]), "=&v"(v[1]), "=&v"(v[2]), "=&v"(v[3]), "=&v"(v[4]), "=&v"(v[5]), "=&v"(v[6]), "=&v"(v[7]) : "v"(gba) : "memory");
                else asm volatile("ds_read_b64_tr_b16 %0, %8 offset:4096\n\tds_read_b64_tr_b16 %1, %8 offset:4608\n\tds_read_b64_tr_b16 %2, %8 offset:5120\n\tds_read_b64_tr_b16 %3, %8 offset:5632\n\t"
                             "ds_read_b64_tr_b16 %4, %8 offset:6144\n\tds_read_b64_tr_b16 %5, %8 offset:6656\n\tds_read_b64_tr_b16 %6, %8 offset:7168\n\tds_read_b64_tr_b16 %7, %8 offset:7680\n\ts_waitcnt lgkmcnt(0)"
                             : "=&v"(v[0]), "=&v"(v[1]), "=&v"(v[2]), "=&v"(v[3]), "=&v"(v[4]), "=&v"(v[5]), "=&v"(v[6]), "=&v"(v[7]) : "v"(gba) : "memory");
#pragma unroll
                for (int c4 = 0; c4 < 4; ++c4) { const int c = 4 * cb + c4; const s16x4 v0 = v[2 * c4], v1 = v[2 * c4 + 1];
                    const bf16x8 vf = {v0[0], v0[1], v0[2], v0[3], v1[0], v1[1], v1[2], v1[3]};
                    o[qq][c] = MFMA16(vf, __builtin_bit_cast(bf16x8, pw), o[qq][c]); }
            }
            LDS_WAIT();
            if (ch + 1 < nch) DSA_GATHER((ch + 1 >= nch1 ? ch + 1 - nch1 : ch + 1), qq);
        }
    }
#pragma unroll
    for (int qq = 0; qq < 2; ++qq) {
        float l = ls[qq]; const int tq = tqs[qq];
        l += __shfl_xor(l, 16); l += __shfl_xor(l, 32);
        const float inv = l > 0.f ? 1.0f / l : 0.f;
        if (l16 < 8) { bf16* op = (bf16*)(ws + WS_OLAT) + (size_t)(b * SEQ + tq) * 1024 + l16 * 128 + 4 * quad;
#pragma unroll
            for (int c = 0; c < 8; ++c) { u32x2 w; w.x = pk2(o[qq][c][0] * inv, o[qq][c][1] * inv); w.y = pk2(o[qq][c][2] * inv, o[qq][c][3] * inv); *(u32x2*)(op + 16 * c) = w; } }
    }
}
#undef DSA_GATHER
__device__ __forceinline__ void phase4(const Frame& F, ArgsR a) {
    const bool xcd = (F.G == 256);
    const int pstart = xcd ? (F.bx >> 3) : F.bx, pstep = xcd ? 32 : F.G, pend = xcd ? 128 : 1024;
#pragma nounroll
    for (int p2 = 2 * pstart; p2 < 2 * pend; p2 += (p2 & 1) ? 2 * pstep - 1 : 1) { const int p = p2 >> 1;
        const int b = xcd ? (F.bx & 7) : (p >> 7), j = p & 127;
        dsa_unit(F, a, b, (p2 & 1) ? j : 255 - j); }
    __syncthreads();
}

constexpr int NPHASE = 11;
__global__ void __launch_bounds__(NTHR, 2) fwd_kernel(Args args_by_value) {
    ArgsR args = *(const __attribute__((address_space(4))) Args*)__builtin_amdgcn_kernarg_segment_ptr();
    extern __shared__ __attribute__((aligned(16))) unsigned char lds_raw[];
    Frame F;
    F.lds = (LAS unsigned char*)lds_raw;
    F.tid = threadIdx.x; F.lane = F.tid & 63; F.wave = __builtin_amdgcn_readfirstlane(F.tid >> 6);
    F.G = gridDim.x; F.bx = blockIdx.x; F.ws = args.ws;
    unsigned char* ws = args.ws;
    volatile LAS unsigned* MISC = (volatile LAS unsigned*)(F.lds + MISC_OFF);
    if (F.tid < 64) MISC[F.tid] = 0u;
    __syncthreads();
    const int lo = args.ph_lo, hi = args.ph_hi;
    XcdBarrier bar; bar.bar = (unsigned*)(ws + WS_CTL) + CW_BAR; bar.x = 0; bar.st = nullptr;
    if (hi - lo > 1) bar = xcd_barrier_post((unsigned*)(ws + WS_CTL) + CW_BAR, MISC + 8);
#ifndef PH_MASK
#define PH_MASK 0xFFFF
#endif
#define IN(k) ((((PH_MASK) >> (k)) & 1) && lo <= (k) && (k) < hi)
#define SEAM(k) do { if (IN(k) && IN((k) + 1)) xcd_barrier(bar); } while (0)
#ifndef PROBE_PHASE
#define PROBE_PHASE -1
#endif
#define REPEAT(k) for (int rep_ = 0; rep_ < ((PROBE_PHASE) == (k) ? 2 : 1); ++rep_, ((PROBE_PHASE) == (k) && rep_ < 2 ? xcd_barrier(bar) : (void)0))

    if (IN(0)) REPEAT(0) { phase0(F, args); }
    SEAM(0);
    if (IN(1)) REPEAT(1) {
#ifndef PROBE_GEMM
#define PROBE_GEMM 0
#endif
        pg8::StaticOrder S; S.init(NTOK / 256, NZ / 256, F.G, F.bx, PROBE_GEMM == 1 ? 2 : 1);
        const APlain AA{ws + WS_XB, 128u, (unsigned)(D * 2)}; const BPlain BA{(const bf16*)(ws + WS_WINT), D};
        const EpiZ E{(bf16*)(ws + WS_ZA), (bf16*)(ws + WS_ZG)};
        pg8::gemm_phase(F.lds, D, S, AA, BA, E);
        { const int nu = (NTOK / 256) * (NZ / 256), rem = nu % F.G;
          if (rem != 0 && F.bx >= rem) p0_experts(F, args, (F.bx - rem) * NWAVES + F.wave, (F.G - rem) * NWAVES, 0, P0_EXP_ITEMS); }
    }
    SEAM(1);
    if (IN(2)) REPEAT(2) { phase2(F, args); }
    SEAM(2);
    if (IN(3)) REPEAT(3) { phase3(F); }
    if (IN(4)) REPEAT(4) { phase4(F, args); }
    SEAM(4);
    if (IN(5)) REPEAT(5) {
        pg8::StaticOrder S; S.init(NTOK / 256, D / 256, F.G, F.bx);
        { const APlain AA{ws + WS_OA, 128u, 1024u}; const BPlain BA{(const bf16*)(ws + WS_WAT), 512};
          const EpiGate<0> E{(const bf16*)(ws + WS_ZG), nullptr, (bf16*)(ws + WS_T1)};
          pg8::gemm_phase(F.lds, 512, S, AA, BA, E); }
        { const APlain AA{ws + WS_OLAT, 128u, 2048u}; const BPlain BA{(const bf16*)(ws + WS_WBT), 1024};
          const EpiGate<1> E{(const bf16*)(ws + WS_ZG), (const bf16*)(ws + WS_T1), (bf16*)(ws + WS_MERGED)};
          pg8::gemm_phase(F.lds, 1024, S, AA, BA, E); }
    }
    SEAM(5);
    if (IN(6)) REPEAT(6) {
        pg8::StaticOrder S; S.init(NTOK / 256, D / 256, F.G, F.bx, PROBE_GEMM == 6 ? 2 : 1);
        const APlain AA{ws + WS_MERGED, 128u, 2048u}; const BPlain BA{(const bf16*)(ws + WS_WOT), 1024};
        const EpiRes E{args.in[0], (bf16*)(ws + WS_H1)};
        pg8::gemm_phase(F.lds, 1024, S, AA, BA, E);
    }
    SEAM(6);
    if (IN(7)) { phase6(F, args); }
    SEAM(7);
    if (IN(8)) {
        moe_setup(F);
        const int vcu = (F.G % 8 == 0) ? (F.bx % 8) * (F.G / 8) + F.bx / 8 : F.bx;
        const MoeOrder S{F.G, vcu, 1, F.G == 256 ? 1 : 0, (const LAS int*)(F.lds + MOE_CUM), (unsigned*)(ws + WS_CTL) + CW_P8R};
        const AGather AA{ws + WS_H1B, 128u, (const int*)(ws + WS_LIST)}; const BGu BA{(const bf16*)(ws + WS_WGU)};
        const EpiAct E{(bf16*)(ws + WS_ACT)};
        pg8::gemm_phase(F.lds, 1024, S, AA, BA, E);
    }
    if (F.G != 256) SEAM(8);
    if (IN(9)) {
        moe_setup(F);
        const int vcu = (F.G % 8 == 0) ? (F.bx % 8) * (F.G / 8) + F.bx / 8 : F.bx;
        const MoeOrder S{F.G, vcu, 2, F.G == 256 ? 3 : 0, (const LAS int*)(F.lds + MOE_CUM), (unsigned*)(ws + WS_CTL) + CW_P8R};
        if (F.G == 256) { if (F.wave == 0) MoeOrder::wait_for(S.dep, 256u); __syncthreads(); }
        const APlain AA{ws + WS_ACT, 128u, 512u}; const BDn BA{(const bf16*)(ws + WS_WDT)};
        const EpiDown E{(bf16*)(ws + WS_YBUF), (const int*)(ws + WS_LIST)};
        pg8::gemm_phase(F.lds, 256, S, AA, BA, E);
    }
    SEAM(9);
    if (IN(10)) REPEAT(10) { phase9(F, args); }
#undef IN
#undef SEAM
#undef REPEAT
}

extern "C" void kernel_launch(void* const* d_in, const int* in_sizes, int n_in, void* d_out, int out_size, void* d_ws, size_t ws_size, hipStream_t stream) {
    static int grid = 0;
    if (grid == 0) {
        if (n_in != 26 || in_sizes[0] != NTOK * D || out_size != NTOK * D || ws_size < WS_END) {
            fprintf(stderr, "kernel_launch: unexpected problem: n_in %d in0 %d out %d ws %zu (need %zu)\n", n_in, n_in > 0 ? in_sizes[0] : -1, out_size, ws_size, (size_t)WS_END); grid = -1; return; }
        int dev = 0, cus = 0, per_cu = 0;
        if (hipGetDevice(&dev) != hipSuccess || hipDeviceGetAttribute(&cus, hipDeviceAttributeMultiprocessorCount, dev) != hipSuccess) { grid = -1; return; }
        if (hipFuncSetAttribute((const void*)fwd_kernel, hipFuncAttributeMaxDynamicSharedMemorySize, LDS_BYTES) != hipSuccess) { fprintf(stderr, "kernel_launch: hipFuncSetAttribute failed\n"); grid = -1; return; }
        if (hipOccupancyMaxActiveBlocksPerMultiprocessor(&per_cu, (const void*)fwd_kernel, NTHR, LDS_BYTES) != hipSuccess || per_cu < 1)
            fprintf(stderr, "kernel_launch: occupancy query reports %d\n", per_cu);
        (void)hipGetLastError();
        grid = cus;
    }
    if (grid < 0) return;
    if (hipMemsetAsync((char*)d_ws + WS_CTL, 0, CTL_ZERO_BYTES, stream) != hipSuccess) return;
    Args a{};
    for (int i = 0; i < 26; ++i) a.in[i] = (const float*)d_in[i];
    a.out = (float*)d_out; a.ws = (unsigned char*)d_ws;
#if MK_PER_PHASE
    for (int p = 0; p < NPHASE; ++p) { a.ph_lo = p; a.ph_hi = p + 1; hipLaunchKernelGGL(fwd_kernel, dim3(grid), dim3(NTHR), LDS_BYTES, stream, a); }
#else
    a.ph_lo = 0; a.ph_hi = NPHASE;
    hipLaunchKernelGGL(fwd_kernel, dim3(grid), dim3(NTHR), LDS_BYTES, stream, a);
#endif
}
```
